# Optimizing an MI355X kernel written in HIP

```python
import math
import jax
import jax.numpy as jnp
from jax import lax
import numpy as np

D_MODEL = 1024
BATCH = 16
SEQ = 2048
DEPTH = 1

MEM_TOKENS = 256
HYENA_WIDTH = 512
HYENA_ORDER = 2
FILTER_EMB = 33
FILTER_HIDDEN = 64
FILTER_OUT_SCALE = 0.1
HYENA_TARGET = 1e-2
HYENA_FAST_DECAY_PCT = 0.3
HYENA_SLOW_DECAY_PCT = 1.5
HYENA_MIN_DECAY = math.log(HYENA_TARGET) / HYENA_FAST_DECAY_PCT
HYENA_MAX_DECAY = math.log(HYENA_TARGET) / HYENA_SLOW_DECAY_PCT
DIFF_HEADS = 4
DIFF_HEAD_DIM = 64
DIFF_WIDTH = DIFF_HEADS * 2 * DIFF_HEAD_DIM
MEM_HEADS = 4
MEM_HEAD_DIM = 128
MEM_WIDTH = MEM_HEADS * MEM_HEAD_DIM
MIX_WIDTH = HYENA_WIDTH + DIFF_WIDTH + MEM_WIDTH
IN_WIDTH = 3 * HYENA_WIDTH + 3 * DIFF_WIDTH + MEM_WIDTH
D_FF = 2816
SHORT_CONV = 3
ROPE_THETA = 10000.0
Q_BLOCK = 128
LN_EPS = 1e-5
RMS_EPS = 1e-5
DEEPNORM_ALPHA = (2.0 * DEPTH) ** 0.25
DEEPNORM_BETA = (8.0 * DEPTH) ** -0.25

kernel_name = 'hybrid_hyena_diffattn_memory_encoder'


def layer_norm(x, g, b):
    xf = x.astype(jnp.float32)
    mu = jnp.mean(xf, axis=-1, keepdims=True)
    xc = xf - mu
    var = jnp.mean(xc * xc, axis=-1, keepdims=True)
    return (xc * lax.rsqrt(var + LN_EPS) * g.astype(jnp.float32) + b.astype(jnp.float32)).astype(x.dtype)


def dwconv3(x, w, b):
    xp = jnp.pad(x, ((0, 0), (1, 1), (0, 0)))
    return xp[:, :-2] * w[0] + xp[:, 1:-1] * w[1] + xp[:, 2:] * w[2] + b


def rope_tables(seq_len, dim):
    inv_freq = ROPE_THETA ** (-jnp.arange(0, dim, 2, dtype=jnp.float32) / dim)
    ang = jnp.arange(seq_len, dtype=jnp.float32)[:, None] * inv_freq[None, :]
    ang = jnp.concatenate([ang, ang], axis=-1)
    return jnp.cos(ang), jnp.sin(ang)


def apply_rope(t, cos, sin):
    half = t.shape[-1] // 2
    tf = t.astype(jnp.float32)
    rot = jnp.concatenate([-tf[..., half:], tf[..., :half]], axis=-1)
    return (tf * cos + rot * sin).astype(t.dtype)


def hyena_filter_spectrum(seq_len, w1, b1, freq, w2, b2, w3):
    f32 = jnp.float32
    t = jnp.linspace(0.0, 1.0, seq_len, dtype=f32)[:, None]
    bands = (FILTER_EMB - 1) // 2
    fr = jnp.linspace(1e-4, bands - 1, bands, dtype=f32)[None, :]
    w = 2.0 * math.pi * jnp.arange(seq_len, dtype=f32)[:, None] / seq_len
    z = jnp.concatenate([t, jnp.cos(fr * w), -jnp.sin(fr * w)], axis=-1)
    freq = freq.astype(f32)
    h = jnp.sin(freq * (z @ w1.astype(f32) + b1.astype(f32)))
    h = jnp.sin(freq * (h @ w2.astype(f32) + b2.astype(f32)))
    h = h @ w3.astype(f32)
    deltas = jnp.abs(jnp.linspace(HYENA_MIN_DECAY, HYENA_MAX_DECAY, HYENA_WIDTH, dtype=f32))
    decay = jnp.exp(-t * deltas[None, :])
    h = h.reshape(seq_len, HYENA_ORDER, 2, HYENA_WIDTH) * decay[:, None, None, :]
    h_fwd, h_bwd = h[:, :, 0], h[:, :, 1]
    k = jnp.concatenate([h_fwd, jnp.zeros_like(h_fwd[:1]), h_bwd[:0:-1]], axis=0)
    return jnp.fft.rfft(k, axis=0)


def fft_long_conv(z, k_f, bias):
    L = z.shape[1]
    z_f = jnp.fft.rfft(z, n=2 * L, axis=1)
    y = jnp.fft.irfft(z_f * k_f[None], n=2 * L, axis=1)[:, :L]
    return y + z * bias


def hyena_mixer(u, conv_w, conv_b, k_f, bias):
    u = dwconv3(u, conv_w, conv_b).astype(jnp.float32)
    v, x1, x2 = jnp.split(u, 3, axis=-1)
    bias = bias.astype(jnp.float32)
    z = x1 * fft_long_conv(v, k_f[:, 0], bias[0])
    z = x2 * fft_long_conv(z, k_f[:, 1], bias[1])
    return z


def diff_attention(q, k, v, lam_params, subln_g, lambda_init):
    B, S = q.shape[0], q.shape[1]
    d = DIFF_HEAD_DIM
    cos, sin = rope_tables(S, d)
    q = apply_rope(jnp.transpose(q, (0, 2, 3, 1, 4)), cos, sin)
    k = apply_rope(jnp.transpose(k, (0, 2, 3, 1, 4)), cos, sin)
    v = jnp.transpose(v, (0, 2, 1, 3))
    lp = lam_params.astype(jnp.float32)
    lam = jnp.exp(jnp.sum(lp[0] * lp[1])) - jnp.exp(jnp.sum(lp[2] * lp[3])) + lambda_init
    scale = d ** -0.5
    n_blk = S // Q_BLOCK
    q_blocks = jnp.moveaxis(q.reshape(B, DIFF_HEADS, 2, n_blk, Q_BLOCK, d), 3, 0)

    def attend(q_blk):
        s = jnp.einsum('bhcqd,bhckd->bhcqk', q_blk, k).astype(jnp.float32) * scale
        p = jax.nn.softmax(s, axis=-1)
        a = p[:, :, 0] - lam * p[:, :, 1]
        return jnp.einsum('bhqk,bhke->bhqe', a.astype(v.dtype), v)

    o = lax.map(attend, q_blocks)
    o = jnp.moveaxis(o, 0, 2).reshape(B, DIFF_HEADS, S, 2 * d)
    of = o.astype(jnp.float32)
    of = of * lax.rsqrt(jnp.mean(of * of, axis=-1, keepdims=True) + RMS_EPS)
    of = of * subln_g.astype(jnp.float32) * (1.0 - lambda_init)
    return jnp.transpose(of, (0, 2, 1, 3)).reshape(B, S, DIFF_WIDTH).astype(v.dtype)


def memory_attention(q, mem, w_kv):
    B, S = q.shape[0], q.shape[1]
    M = mem.shape[1]
    q = q.reshape(B, S, MEM_HEADS, MEM_HEAD_DIM)
    kv = mem @ w_kv
    k, v = jnp.split(kv, 2, axis=-1)
    k = k.reshape(B, M, MEM_HEADS, MEM_HEAD_DIM)
    v = v.reshape(B, M, MEM_HEADS, MEM_HEAD_DIM)
    s = jnp.einsum('bshd,bmhd->bhsm', q, k).astype(jnp.float32) * (MEM_HEAD_DIM ** -0.5)
    p = jax.nn.softmax(s, axis=-1)
    o = jnp.einsum('bhsm,bmhd->bshd', p.astype(v.dtype), v)
    return o.reshape(B, S, MEM_WIDTH)


def setup_inputs(seed: int = 0) -> dict:
    key = jax.random.key(seed)
    ks = jax.random.split(key, 24)
    f32 = jnp.float32

    def nrm(k, shape, scale):
        return jax.random.normal(k, shape, f32) * scale

    L = DEPTH
    return {
        'x': nrm(ks[0], (BATCH, SEQ, D_MODEL), 1.0),
        'mem': nrm(ks[1], (BATCH, MEM_TOKENS, D_MODEL), 1.0),
        'w_in': nrm(ks[2], (L, D_MODEL, IN_WIDTH), D_MODEL ** -0.5),
        'hy_conv_w': nrm(ks[3], (L, SHORT_CONV, 3 * HYENA_WIDTH), SHORT_CONV ** -0.5),
        'hy_conv_b': nrm(ks[4], (L, 3 * HYENA_WIDTH), 0.02),
        'hy_w1': nrm(ks[5], (L, FILTER_EMB, FILTER_HIDDEN), FILTER_EMB ** -0.5),
        'hy_b1': nrm(ks[6], (L, FILTER_HIDDEN), 0.1),
        'hy_freq': 1.0 + nrm(ks[7], (L, FILTER_HIDDEN), 0.1),
        'hy_w2': nrm(ks[8], (L, FILTER_HIDDEN, FILTER_HIDDEN), FILTER_HIDDEN ** -0.5),
        'hy_b2': nrm(ks[9], (L, FILTER_HIDDEN), 0.1),
        'hy_w3': nrm(ks[10], (L, FILTER_HIDDEN, 2 * HYENA_ORDER * HYENA_WIDTH), FILTER_OUT_SCALE * FILTER_HIDDEN ** -0.5),
        'hy_bias': nrm(ks[11], (L, HYENA_ORDER, HYENA_WIDTH), 0.5),
        'diff_lambda': nrm(ks[12], (L, 4, DIFF_HEAD_DIM), 0.1),
        'diff_subln_g': 1.0 + nrm(ks[13], (L, 2 * DIFF_HEAD_DIM), 0.02),
        'mem_w_kv': nrm(ks[14], (L, D_MODEL, 2 * MEM_WIDTH), D_MODEL ** -0.5),
        'w_out': nrm(ks[15], (L, MIX_WIDTH, D_MODEL), DEEPNORM_BETA * MIX_WIDTH ** -0.5),
        'ln1_g': 1.0 + nrm(ks[16], (L, D_MODEL), 0.02),
        'ln1_b': nrm(ks[17], (L, D_MODEL), 0.02),
        'ffn_w_up': nrm(ks[18], (L, D_MODEL, 2 * D_FF), D_MODEL ** -0.5),
        'ffn_conv_w': nrm(ks[19], (L, SHORT_CONV, 2 * D_FF), SHORT_CONV ** -0.5),
        'ffn_conv_b': nrm(ks[20], (L, 2 * D_FF), 0.02),
        'ffn_w_down': nrm(ks[21], (L, D_FF, D_MODEL), DEEPNORM_BETA * D_FF ** -0.5),
        'ln2_g': 1.0 + nrm(ks[22], (L, D_MODEL), 0.02),
        'ln2_b': nrm(ks[23], (L, D_MODEL), 0.02),
    }


def reference(x, mem, w_in, hy_conv_w, hy_conv_b, hy_w1, hy_b1, hy_freq, hy_w2, hy_b2, hy_w3,
              hy_bias, diff_lambda, diff_subln_g, mem_w_kv, w_out, ln1_g, ln1_b,
              ffn_w_up, ffn_conv_w, ffn_conv_b, ffn_w_down, ln2_g, ln2_b):
    B, S = x.shape[0], x.shape[1]
    s1 = 3 * HYENA_WIDTH
    s2 = s1 + DIFF_WIDTH
    s3 = s2 + DIFF_WIDTH
    s4 = s3 + DIFF_WIDTH
    for l in range(DEPTH):
        lambda_init = 0.8 - 0.6 * math.exp(-0.3 * l)
        proj = x @ w_in[l]
        hy_u, dq, dk, dv, mq = jnp.split(proj, [s1, s2, s3, s4], axis=-1)
        k_f = hyena_filter_spectrum(S, hy_w1[l], hy_b1[l], hy_freq[l], hy_w2[l], hy_b2[l], hy_w3[l])
        y_h = hyena_mixer(hy_u, hy_conv_w[l], hy_conv_b[l], k_f, hy_bias[l]).astype(x.dtype)
        y_d = diff_attention(dq.reshape(B, S, DIFF_HEADS, 2, DIFF_HEAD_DIM),
                             dk.reshape(B, S, DIFF_HEADS, 2, DIFF_HEAD_DIM),
                             dv.reshape(B, S, DIFF_HEADS, 2 * DIFF_HEAD_DIM),
                             diff_lambda[l], diff_subln_g[l], lambda_init)
        y_m = memory_attention(mq, mem, mem_w_kv[l])
        mix = jnp.concatenate([y_h, y_d, y_m], axis=-1) @ w_out[l]
        x = layer_norm(DEEPNORM_ALPHA * x + mix, ln1_g[l], ln1_b[l])
        h = dwconv3(x @ ffn_w_up[l], ffn_conv_w[l], ffn_conv_b[l])
        g, u = jnp.split(h, 2, axis=-1)
        y = (jax.nn.silu(g) * u) @ ffn_w_down[l]
        x = layer_norm(DEEPNORM_ALPHA * x + y, ln2_g[l], ln2_b[l])
    return x
```

```cpp
#include <hip/hip_runtime.h>
#include <hip/hip_cooperative_groups.h>
#include <cstdio>
#include <cstdint>
namespace cg = cooperative_groups;
#define LAS __attribute__((address_space(3)))
namespace pg8 {
#define PG8_LAS __attribute__((address_space(3)))
typedef unsigned short bf16_t;
typedef short bf16x8 __attribute__((ext_vector_type(8)));
typedef float f32x4 __attribute__((ext_vector_type(4)));
typedef unsigned u32x4 __attribute__((ext_vector_type(4)));
constexpr int BM = 256, BK = 64, HALF = 128, HTB = HALF * BK * 2  , STAGE_BYTES = 8 * HTB, NXCD = 8, WGM = 8;

__host__ __device__ __forceinline__ int lds_byte(int r, int c) { const int st = (r >> 4) * 2 + (c >> 5), rr = r & 15, cc = c & 31, ob = rr * 64 + cc * 2; return st * 1024 + (ob ^ (((ob >> 9) & 1) << 5)); }
__host__ __device__ __forceinline__ void stage_rc(int b, int& R, int& C) { const int st = b / 1024, sb = b % 1024, swz = sb ^ (((sb >> 9) & 1) << 5); R = (st >> 1) * 16 + swz / 64; C = (st & 1) * 32 + (swz % 64) / 2; }
__host__ __device__ __forceinline__ int perm32(int rho) { const int n = rho >> 4, i = rho & 15; return 8 * (i >> 2) + 4 * n + (i & 3); }

struct Unit { int pm, pn; };
struct Gemm { const bf16_t* A; const bf16_t* Bt; int M, N, K; };

struct StaticOrder {
    int nM, nN, nwg, G, c;
    __host__ __device__ void init(int M, int N, int G_, int c_) { nM = M / BM; nN = N / BM; nwg = nM * nN; G = G_; c = c_; }
    __host__ __device__ bool next(int i, Unit& u) const {
        const long L = (long)i * G + c; if (L >= nwg) return false;
        int wgid = (int)L; { const int q = nwg / NXCD, r = nwg % NXCD, xcd = wgid % NXCD, off = wgid / NXCD; wgid = (xcd < r ? xcd * (q + 1) : r * (q + 1) + (xcd - r) * q) + off; }
        const int nig = WGM * nN, gid = wgid / nig, fm = gid * WGM, gsz = (nM - fm) < WGM ? (nM - fm) : WGM;
        u.pm = fm + ((wgid % nig) % gsz); u.pn = (wgid % nig) / gsz; return true;
    }
    __device__ __forceinline__ void a_ready(const Unit&) const {}
    __device__ __forceinline__ void done(const Unit&) const {}
};
template <class Epi, class Sched, bool ALIGN_EPI = false, bool SP2 = false>
__device__ __forceinline__ void gemm_phase(PG8_LAS unsigned char* lds, const Gemm g, const Sched& S, const Epi& E) {
    int tid_l = threadIdx.x; asm volatile("" : "+v"(tid_l)); const int tid = tid_l, wid = __builtin_amdgcn_readfirstlane(tid >> 6), lane = tid & 63, wr = wid >> 2, wc = wid & 3, fr = lane & 15, fq = lane >> 4;
    const int K = g.K, nt = K / BK;
    unsigned voffA[2], voffB[2];
#pragma unroll
    for (int i = 0; i < 2; ++i) { int R, C; stage_rc(tid * 16 + i * 8192, R, C); const int Rb = Epi::PERM ? ((R & ~31) + perm32(R & 31)) : R;
        voffA[i] = (unsigned)(R * K + C) * 2u; voffB[i] = (unsigned)(Rb * K + C) * 2u; }
    const size_t kstep = (size_t)(BK * 2);
    const size_t hstep = (size_t)HALF * K * 2;
    const size_t tstep = 2 * hstep;
    const unsigned ldsw = (unsigned)wid * 1024u;
    const int aoff = lds_byte(wr * 64 + fr, fq * 8), boff = lds_byte(wc * 32 + fr, fq * 8);
#define PG8_SA(b, h) (((b) * 2 + (h)) * HTB)
#define PG8_SB(b, h) ((4 + (b) * 2 + (h)) * HTB)
#define PG8_STAGE(bufoff, gbase, voff) do { _Pragma("unroll") for (int _i = 0; _i < 2; ++_i) \
        __builtin_amdgcn_global_load_lds((const unsigned*)((const char*)(gbase) + (voff)[_i]), (PG8_LAS unsigned*)(lds + (bufoff) + ldsw + _i * 8192), 16, 0, 0); } while (0)
#define PG8_LDA(dst, b, h) do { _Pragma("unroll") for (int m = 0; m < 4; ++m) _Pragma("unroll") for (int k = 0; k < 2; ++k) dst[m][k] = *(const PG8_LAS bf16x8*)(lds + PG8_SA(b, h) + aoff + m * 2048 + k * 1024); } while (0)
#define PG8_LDB(dst, b, h) do { _Pragma("unroll") for (int n = 0; n < 2; ++n) _Pragma("unroll") for (int k = 0; k < 2; ++k) dst[n][k] = *(const PG8_LAS bf16x8*)(lds + PG8_SB(b, h) + boff + n * 2048 + k * 1024); } while (0)
#define PG8_MMA(ai, bj, At, Bt) do { __builtin_amdgcn_s_setprio(1); _Pragma("unroll") for (int m = 0; m < 4; ++m) _Pragma("unroll") for (int n = 0; n < 2; ++n) _Pragma("unroll") for (int k = 0; k < 2; ++k) \
        acc[ai][bj][m][n] = __builtin_amdgcn_mfma_f32_16x16x32_bf16(Bt[n][k], At[m][k], acc[ai][bj][m][n], 0, 0, 0); __builtin_amdgcn_s_setprio(0); } while (0)
#define PG8_WAIT_V(n) asm volatile("s_waitcnt vmcnt(" #n ")" ::: "memory")
#define PG8_WAIT_L(n) asm volatile("s_waitcnt lgkmcnt(" #n ")" ::: "memory")
#define PG8_BAR __builtin_amdgcn_s_barrier()
#define PG8_SCHED __builtin_amdgcn_sched_barrier(0)
    Unit cur, nxt; int ui = 0;
    if (!S.next(0, cur)) return;
    f32x4 acc[2][2][4][2];
#pragma unroll
    for (int a = 0; a < 2; ++a)
#pragma unroll
        for (int b = 0; b < 2; ++b)
#pragma unroll
            for (int m = 0; m < 4; ++m)
#pragma unroll
                for (int n = 0; n < 2; ++n) acc[a][b][m][n] = (f32x4){0.f, 0.f, 0.f, 0.f};
    bf16x8 At[4][2], B0[2][2], B1[2][2];
    const char* cA = (const char*)g.A + (size_t)cur.pm * tstep; const char* cB = (const char*)g.Bt + (size_t)cur.pn * tstep;
    S.a_ready(cur);
    if constexpr (SP2) {
        PG8_STAGE(PG8_SB(0, 0), cB, voffB); PG8_STAGE(PG8_SB(0, 1), cB + hstep, voffB); PG8_STAGE(PG8_SA(0, 0), cA, voffA); PG8_STAGE(PG8_SA(0, 1), cA + hstep, voffA);
        if (wr == 1) PG8_BAR;
        PG8_WAIT_V(2); PG8_BAR;
        PG8_STAGE(PG8_SB(1, 0), cB + kstep, voffB); PG8_STAGE(PG8_SA(1, 0), cA + kstep, voffA); PG8_STAGE(PG8_SB(1, 1), cB + hstep + kstep, voffB);
        PG8_WAIT_V(6); PG8_BAR;
    } else {
        PG8_STAGE(PG8_SB(0, 0), cB, voffB); PG8_STAGE(PG8_SA(0, 0), cA, voffA); PG8_STAGE(PG8_SB(0, 1), cB + hstep, voffB); PG8_STAGE(PG8_SA(0, 1), cA + hstep, voffA);
        if (wr == 1) PG8_BAR;
        PG8_WAIT_V(4); PG8_BAR;
        PG8_STAGE(PG8_SB(1, 0), cB + kstep, voffB); PG8_STAGE(PG8_SA(1, 0), cA + kstep, voffA); PG8_STAGE(PG8_SB(1, 1), cB + hstep + kstep, voffB);
        PG8_WAIT_V(6); PG8_BAR;
    }
    for (;;) {
        const bool has_next = S.next(ui + 1, nxt);
        const char* nA = has_next ? (const char*)g.A + (size_t)nxt.pm * tstep : cA; const char* nB = has_next ? (const char*)g.Bt + (size_t)nxt.pn * tstep : cB;
        for (int t = 0; t < nt; t += 2) {
            const bool last = (t == nt - 2);
            const char* a1 = cA + (size_t)(t + 1) * kstep;
            const char* a2 = last ? nA : cA + (size_t)(t + 2) * kstep; const char* b2 = last ? nB : cB + (size_t)(t + 2) * kstep;
            const char* a3 = a2 + kstep; const char* b3 = b2 + kstep;
            if (last && has_next) S.a_ready(nxt);
            if constexpr (SP2) {
            PG8_LDB(B0, 0, 0); PG8_LDB(B1, 0, 1); PG8_SCHED; PG8_LDA(At, 0, 0); PG8_STAGE(PG8_SA(1, 1), a1 + hstep, voffA);
            PG8_WAIT_V(8); PG8_WAIT_L(0); PG8_BAR; PG8_MMA(0, 0, At, B0); PG8_MMA(0, 1, At, B1); PG8_BAR; PG8_SCHED;
            PG8_LDA(At, 0, 1); PG8_STAGE(PG8_SB(0, 0), b2, voffB); PG8_STAGE(PG8_SB(0, 1), b2 + hstep, voffB); PG8_STAGE(PG8_SA(0, 0), a2, voffA);
            PG8_WAIT_V(8); PG8_WAIT_L(0); PG8_BAR; PG8_MMA(1, 0, At, B0); PG8_MMA(1, 1, At, B1); PG8_BAR; PG8_SCHED;
            PG8_LDB(B0, 1, 0); PG8_LDB(B1, 1, 1); PG8_SCHED; PG8_LDA(At, 1, 0); PG8_STAGE(PG8_SA(0, 1), a2 + hstep, voffA);
            PG8_WAIT_V(8); PG8_WAIT_L(0); PG8_BAR; PG8_MMA(0, 0, At, B0); PG8_MMA(0, 1, At, B1); PG8_BAR; PG8_SCHED;
            PG8_LDA(At, 1, 1); PG8_STAGE(PG8_SB(1, 0), b3, voffB); PG8_STAGE(PG8_SB(1, 1), b3 + hstep, voffB); PG8_STAGE(PG8_SA(1, 0), a3, voffA);
            PG8_WAIT_V(8); PG8_WAIT_L(0); PG8_BAR; PG8_MMA(1, 0, At, B0); PG8_MMA(1, 1, At, B1); PG8_BAR; PG8_SCHED;
            } else {
            PG8_LDB(B0, 0, 0); PG8_SCHED; PG8_LDA(At, 0, 0); PG8_STAGE(PG8_SA(1, 1), a1 + hstep, voffA);
            PG8_WAIT_L(8); PG8_BAR; PG8_WAIT_L(0); PG8_MMA(0, 0, At, B0); PG8_BAR; PG8_SCHED;
            PG8_LDB(B1, 0, 1); PG8_STAGE(PG8_SB(0, 0), b2, voffB);
            PG8_BAR; PG8_WAIT_L(0); PG8_MMA(0, 1, At, B1); PG8_BAR;
            PG8_LDA(At, 0, 1); PG8_STAGE(PG8_SA(0, 0), a2, voffA);
            PG8_BAR; PG8_WAIT_L(0); PG8_MMA(1, 0, At, B0); PG8_BAR; PG8_SCHED;
            PG8_STAGE(PG8_SB(0, 1), b2 + hstep, voffB);
            PG8_WAIT_V(6); PG8_BAR; PG8_MMA(1, 1, At, B1); PG8_BAR;
            PG8_LDB(B0, 1, 0); PG8_SCHED; PG8_LDA(At, 1, 0); PG8_STAGE(PG8_SA(0, 1), a2 + hstep, voffA);
            PG8_WAIT_L(8); PG8_BAR; PG8_WAIT_L(0); PG8_MMA(0, 0, At, B0); PG8_BAR; PG8_SCHED;
            PG8_LDB(B1, 1, 1); PG8_STAGE(PG8_SB(1, 0), b3, voffB);
            PG8_BAR; PG8_WAIT_L(0); PG8_MMA(0, 1, At, B1); PG8_BAR;
            PG8_LDA(At, 1, 1); PG8_STAGE(PG8_SA(1, 0), a3, voffA);
            PG8_BAR; PG8_WAIT_L(0); PG8_MMA(1, 0, At, B0); PG8_BAR; PG8_SCHED;
            PG8_STAGE(PG8_SB(1, 1), b3 + hstep, voffB);
            PG8_WAIT_V(6); PG8_BAR; PG8_MMA(1, 1, At, B1); PG8_BAR;
            }
        }
        if constexpr (ALIGN_EPI) { if (wr == 0) PG8_BAR; }
        if constexpr (!Epi::AFTER_DRAIN) { E(acc, cur, wr, wc, fr, fq); S.done(cur); }
        if (!has_next) break;
#pragma unroll
        for (int a = 0; a < 2; ++a)
#pragma unroll
            for (int b = 0; b < 2; ++b)
#pragma unroll
                for (int m = 0; m < 4; ++m)
#pragma unroll
                    for (int n = 0; n < 2; ++n) acc[a][b][m][n] = (f32x4){0.f, 0.f, 0.f, 0.f};
        cur = nxt; cA = nA; cB = nB; ++ui;
        if constexpr (ALIGN_EPI) { if (wr == 1) PG8_BAR; }
    }
    PG8_WAIT_V(0);
    if constexpr (!ALIGN_EPI) { if (wr == 0) PG8_BAR; }
    PG8_BAR;
    if constexpr (Epi::AFTER_DRAIN) { E.fused(acc, cur, wr, wc, fr, fq, lds, wid, lane); S.done(cur); }
#undef PG8_SA
#undef PG8_SB
#undef PG8_STAGE
#undef PG8_LDA
#undef PG8_LDB
#undef PG8_MMA
#undef PG8_WAIT_V
#undef PG8_WAIT_L
#undef PG8_BAR
#undef PG8_SCHED
}
}

using pg8::bf16_t; using pg8::bf16x8; using pg8::f32x4; using pg8::u32x4;
typedef float f32x16 __attribute__((ext_vector_type(16)));
typedef unsigned u32x2 __attribute__((ext_vector_type(2)));
typedef short bf16x4 __attribute__((ext_vector_type(4)));

constexpr int NB = 16, SEQ = 2048, DM = 1024, NT = NB * SEQ, MEMT = 256, NMT = NB * MEMT, HW = 512, INW = 3584, DFF = 2816, MIXW = 1536;
constexpr float ALPHA = 1.189207115002721f;
constexpr float LN_EPS = 1e-5f, RMS_EPS = 1e-5f;
constexpr int NTHR = 512, NWAVE = 8;
constexpr int LDS_BYTES = 139264;

constexpr size_t MiB = 1048576;
constexpr size_t WS_WALL = 0;
constexpr size_t WS_WKV  = 7 * MiB;
constexpr size_t WS_WOUT = 9 * MiB;
constexpr size_t WS_WUP  = 12 * MiB;
constexpr size_t WS_WDN  = 23 * MiB;
constexpr size_t WS_ROPE = 29 * MiB;
constexpr size_t WS_STAT = 29 * MiB + 524288;
constexpr size_t WS_XB   = 30 * MiB;
constexpr size_t WS_X1B  = 30 * MiB;
constexpr size_t WS_HTD  = 94 * MiB;
constexpr size_t WS_MEMB = 110 * MiB;
constexpr size_t WS_QKM  = 118 * MiB;
constexpr size_t WS_HT   = 214 * MiB;
constexpr size_t WS_KMEM = 342 * MiB;
constexpr size_t WS_VMT  = 346 * MiB;
constexpr size_t WS_KF   = 350 * MiB;
constexpr size_t WS_MIX  = 382 * MiB;
constexpr size_t WS_HH   = 96 * MiB;
constexpr size_t WS_ACT  = 272 * MiB;
constexpr size_t WS_END  = 478 * MiB;

__device__ __forceinline__ unsigned pk2(float lo, float hi) { unsigned r; asm volatile("v_cvt_pk_bf16_f32 %0, %1, %2" : "=v"(r) : "v"(lo), "v"(hi)); return r; }
__device__ __forceinline__ float bf2f(bf16_t v) { return __uint_as_float((unsigned)v << 16); }
__device__ __forceinline__ float lo2f(unsigned v) { return __uint_as_float(v << 16); }
__device__ __forceinline__ float hi2f(unsigned v) { return __uint_as_float(v & 0xffff0000u); }
#define LDS_WAIT() asm volatile("s_waitcnt lgkmcnt(0)" ::: "memory")

#ifndef FFT_HOST
#define FFT_FN __device__ __forceinline__
#define FFT_SYNC() __syncthreads()
typedef float cplx __attribute__((ext_vector_type(2)));
typedef LAS cplx* fftbuf_t;
FFT_FN float cos2pi(float r) { return __builtin_amdgcn_cosf(r); }
FFT_FN float sin2pi(float r) { return __builtin_amdgcn_sinf(r); }
#endif
FFT_FN cplx mk2(float x, float y) { cplx r; r.x = x; r.y = y; return r; }
FFT_FN cplx cadd(cplx a, cplx b) { return mk2(a.x + b.x, a.y + b.y); }
FFT_FN cplx csub(cplx a, cplx b) { return mk2(a.x - b.x, a.y - b.y); }
FFT_FN cplx cmul(cplx a, cplx b) { return mk2(a.x * b.x - a.y * b.y, a.x * b.y + a.y * b.x); }
template <bool INV> FFT_FN cplx muli(cplx a) { return INV ? mk2(-a.y, a.x) : mk2(a.y, -a.x); }
FFT_FN int padi(int i) { return i + (i >> 3); }

template <bool INV> FFT_FN void dft8(cplx (&v)[8]) {
    const float R = 0.70710678118654752f;
    const cplx a0 = cadd(v[0], v[4]), a1 = csub(v[0], v[4]), a2 = cadd(v[2], v[6]), a3 = muli<INV>(csub(v[2], v[6]));
    const cplx a4 = cadd(v[1], v[5]), a5 = csub(v[1], v[5]), a6 = cadd(v[3], v[7]), a7 = muli<INV>(csub(v[3], v[7]));
    const cplx b0 = cadd(a0, a2), b2 = csub(a0, a2), b1 = cadd(a1, a3), b3 = csub(a1, a3);
    const cplx b4 = cadd(a4, a6), b6 = muli<INV>(csub(a4, a6));
    const cplx t5 = cadd(a5, a7), t7 = csub(a5, a7);
    cplx b5, b7;
    if (!INV) { b5 = mk2((t5.x + t5.y) * R, (t5.y - t5.x) * R); b7 = mk2((t7.y - t7.x) * R, -(t7.x + t7.y) * R); }
    else      { b5 = mk2((t5.x - t5.y) * R, (t5.x + t5.y) * R); b7 = mk2(-(t7.x + t7.y) * R, (t7.x - t7.y) * R); }
    v[0] = cadd(b0, b4); v[4] = csub(b0, b4); v[1] = cadd(b1, b5); v[5] = csub(b1, b5);
    v[2] = cadd(b2, b6); v[6] = csub(b2, b6); v[3] = cadd(b3, b7); v[7] = csub(b3, b7);
}
template <int S, bool INV> FFT_FN void twid(cplx (&v)[8], int tid) {
    if (S > 1) {
        const int j = tid % S; const float rev = (float)j * (1.0f / (8.0f * S));
        const float c = cos2pi(rev), s = sin2pi(rev);
        const cplx w1 = mk2(c, INV ? s : -s);
        const cplx w2 = cmul(w1, w1), w3 = cmul(w2, w1), w4 = cmul(w2, w2), w5 = cmul(w4, w1), w6 = cmul(w4, w2), w7 = cmul(w4, w3);
        v[1] = cmul(v[1], w1); v[2] = cmul(v[2], w2); v[3] = cmul(v[3], w3); v[4] = cmul(v[4], w4);
        v[5] = cmul(v[5], w5); v[6] = cmul(v[6], w6); v[7] = cmul(v[7], w7);
    }
}
template <int S> FFT_FN void ld8(fftbuf_t X, int tid, cplx (&v)[8]) {
    const int base = (tid / S) * 8 * S + (tid % S);
#pragma unroll
    for (int k = 0; k < 8; ++k) v[k] = X[padi(base + S * k)];
}
template <int S> FFT_FN void st8(fftbuf_t X, int tid, const cplx (&v)[8]) {
    const int base = (tid / S) * 8 * S + (tid % S);
#pragma unroll
    for (int k = 0; k < 8; ++k) X[padi(base + S * k)] = v[k];
}
#ifndef FFT_HOST
FFT_FN void fft_fwd(fftbuf_t X, int tid, cplx (&v)[8]) {
    dft8<false>(v); twid<512, false>(v, tid); st8<512>(X, tid, v); FFT_SYNC();
    ld8<64>(X, tid, v); dft8<false>(v); twid<64, false>(v, tid); st8<64>(X, tid, v); FFT_SYNC();
    ld8<8>(X, tid, v); dft8<false>(v); twid<8, false>(v, tid); st8<8>(X, tid, v); FFT_SYNC();
    ld8<1>(X, tid, v); dft8<false>(v);
}
FFT_FN void fft_inv(fftbuf_t X, int tid, cplx (&v)[8]) {
    dft8<true>(v); st8<1>(X, tid, v); FFT_SYNC();
    ld8<8>(X, tid, v); twid<8, true>(v, tid); dft8<true>(v); st8<8>(X, tid, v); FFT_SYNC();
    ld8<64>(X, tid, v); twid<64, true>(v, tid); dft8<true>(v); st8<64>(X, tid, v); FFT_SYNC();
    ld8<512>(X, tid, v); twid<512, true>(v, tid); dft8<true>(v);
}
#endif

struct OneUnit { int pm, pn; bool on;
    __device__ __forceinline__ bool next(int i, pg8::Unit& u) const { if (!on || i > 0) return false; u.pm = pm; u.pn = pn; return true; }
    __device__ __forceinline__ void a_ready(const pg8::Unit&) const {}
    __device__ __forceinline__ void done(const pg8::Unit&) const {} };

struct EpiB {
    static constexpr bool PERM = true, AFTER_DRAIN = false;
    bf16_t* O; int ldc;
    __device__ __forceinline__ void operator()(const f32x4 (&acc)[2][2][4][2], const pg8::Unit& u, int wr, int wc, int fr, int fq) const {
        const int row0 = u.pm * 256 + wr * 64 + fr, col0 = u.pn * 256 + wc * 32 + 8 * fq;
#pragma unroll
        for (int ai = 0; ai < 2; ++ai)
#pragma unroll
            for (int m = 0; m < 4; ++m) { bf16_t* rowp = O + (size_t)(row0 + ai * 128 + m * 16) * ldc + col0;
#pragma unroll
                for (int bj = 0; bj < 2; ++bj) { const f32x4 v0 = acc[ai][bj][m][0], v1 = acc[ai][bj][m][1];
                    u32x4 w; w.x = pk2(v0[0], v0[1]); w.y = pk2(v0[2], v0[3]); w.z = pk2(v1[0], v1[1]); w.w = pk2(v1[2], v1[3]);
                    *(u32x4*)(rowp + bj * 128) = w; } }
    }
};
struct EpiRope {
    static constexpr bool PERM = true, AFTER_DRAIN = false;
    bf16_t* O; const float2* rope;
    __device__ __forceinline__ void operator()(const f32x4 (&acc)[2][2][4][2], const pg8::Unit& u, int wr, int wc, int fr, int fq) const {
        const int row0 = u.pm * 256 + wr * 64 + fr, col0 = u.pn * 256 + wc * 32 + 8 * fq;
        const bool rot = u.pn < 4;
#pragma unroll
        for (int ai = 0; ai < 2; ++ai)
#pragma unroll
            for (int m = 0; m < 4; ++m) { const int row = row0 + ai * 128 + m * 16; bf16_t* rowp = O + (size_t)row * MIXW + col0;
#pragma unroll
                for (int bj = 0; bj < 2; ++bj) { f32x4 v0 = acc[ai][bj][m][0], v1 = acc[ai][bj][m][1];
                    if (rot) { const int pos = row & (SEQ - 1), i0 = ((col0 + bj * 128) & 63) >> 1;
                        const f32x4* rp = (const f32x4*)(rope + pos * 32 + i0); const f32x4 r0 = rp[0], r1 = rp[1];
                        f32x4 o0, o1;
                        o0[0] = v0[0] * r0[0] - v0[1] * r0[1]; o0[1] = v0[1] * r0[0] + v0[0] * r0[1];
                        o0[2] = v0[2] * r0[2] - v0[3] * r0[3]; o0[3] = v0[3] * r0[2] + v0[2] * r0[3];
                        o1[0] = v1[0] * r1[0] - v1[1] * r1[1]; o1[1] = v1[1] * r1[0] + v1[0] * r1[1];
                        o1[2] = v1[2] * r1[2] - v1[3] * r1[3]; o1[3] = v1[3] * r1[2] + v1[2] * r1[3];
                        v0 = o0; v1 = o1; }
                    u32x4 w; w.x = pk2(v0[0], v0[1]); w.y = pk2(v0[2], v0[3]); w.z = pk2(v1[0], v1[1]); w.w = pk2(v1[2], v1[3]);
                    *(u32x4*)(rowp + bj * 128) = w; } }
    }
};
struct EpiRes {
    static constexpr bool PERM = false, AFTER_DRAIN = false;
    const float* X; float* O;
    __device__ __forceinline__ void operator()(const f32x4 (&acc)[2][2][4][2], const pg8::Unit& u, int wr, int wc, int fr, int fq) const {
        const int row0 = u.pm * 256 + wr * 64 + fr, col0 = u.pn * 256 + wc * 32 + 4 * fq;
#pragma unroll
        for (int ai = 0; ai < 2; ++ai)
#pragma unroll
            for (int m = 0; m < 4; ++m) { const size_t ro = (size_t)(row0 + ai * 128 + m * 16) * DM;
#pragma unroll
                for (int bj = 0; bj < 2; ++bj)
#pragma unroll
                    for (int n = 0; n < 2; ++n) { const int c = col0 + bj * 128 + 16 * n;
                        const f32x4 xv = *(const f32x4*)(X + ro + c); *(f32x4*)(O + ro + c) = acc[ai][bj][m][n] + xv * ALPHA; } }
    }
};
struct EpiRes2 {
    static constexpr bool PERM = false, AFTER_DRAIN = false;
    float* O; const float2* stat; const float* g; const float* b;
    __device__ __forceinline__ void operator()(const f32x4 (&acc)[2][2][4][2], const pg8::Unit& u, int wr, int wc, int fr, int fq) const {
        const int row0 = u.pm * 256 + wr * 64 + fr, col0 = u.pn * 256 + wc * 32 + 4 * fq;
#pragma unroll
        for (int bj = 0; bj < 2; ++bj)
#pragma unroll
            for (int n = 0; n < 2; ++n) { const int c = col0 + bj * 128 + 16 * n;
                const f32x4 gv = *(const f32x4*)(g + c), bv = *(const f32x4*)(b + c);
#pragma unroll
                for (int ai = 0; ai < 2; ++ai)
#pragma unroll
                    for (int m = 0; m < 4; ++m) { const int row = row0 + ai * 128 + m * 16; const float2 st = stat[row];
                        float* p = O + (size_t)row * DM + c; const f32x4 r1 = *(const f32x4*)p;
                        const f32x4 x1 = (r1 - st.x) * st.y * gv + bv; *(f32x4*)p = acc[ai][bj][m][n] + x1 * ALPHA; } }
    }
};

__device__ __forceinline__ int win_row(int n) {
    if (n < 1536) return 1536 + n;
    if (n < 2560) { const int q = n - 1536, blk = q >> 6, d = q & 63; return blk * 64 + 2 * (d & 31) + (d >> 5); }
    if (n < 3072) return 512 + n;
    return n - 2048;
}
template <int MODE> __device__ __forceinline__ void p0_transpose_item(const float* W, int K, int N, bf16_t* WT, LAS float* scr, int item, int lane) {
    const int nblk = N / 32, kb = item / nblk, nb = item % nblk, k0 = 64 * kb, n0 = 32 * nb;
#pragma unroll 8
    for (int i = 0; i < 32; ++i) { const int kk = 2 * i + (lane >> 5); scr[kk * 33 + (lane & 31)] = W[(size_t)(k0 + kk) * N + n0 + (lane & 31)]; }
    LDS_WAIT(); asm volatile("" ::: "memory");
    const int c = lane & 7;
#pragma unroll
    for (int j = 0; j < 4; ++j) { const int n = (lane >> 3) + 8 * j; const LAS float* s = scr + (8 * c) * 33 + n;
        u32x4 o; o.x = pk2(s[0 * 33], s[1 * 33]); o.y = pk2(s[2 * 33], s[3 * 33]); o.z = pk2(s[4 * 33], s[5 * 33]); o.w = pk2(s[6 * 33], s[7 * 33]);
        const int dr = (MODE == 1) ? win_row(n0 + n) : (n0 + n);
        *(u32x4*)(WT + (size_t)dr * K + k0 + 8 * c) = o; }
    LDS_WAIT(); asm volatile("" ::: "memory");
}
__device__ __forceinline__ void cvt_rows(const float* src, bf16_t* dst, size_t n8, int gw, int ngw, int lane) {
    for (size_t i = (size_t)gw * 64 + lane; i < n8; i += (size_t)ngw * 64) {
        const f32x4 a = ((const f32x4*)src)[2 * i], b = ((const f32x4*)src)[2 * i + 1];
        u32x4 w; w.x = pk2(a[0], a[1]); w.y = pk2(a[2], a[3]); w.z = pk2(b[0], b[1]); w.w = pk2(b[2], b[3]);
        ((u32x4*)dst)[i] = w; }
}
__device__ __forceinline__ void p0_filter_item(const float* w1, const float* b1, const float* fq, const float* w2, const float* b2, const float* w3, float* HTD, int item, int lane) {
    const int t0 = 2 * item; float h2v[2], tl[2];
#pragma unroll
    for (int tt = 0; tt < 2; ++tt) { const int t = t0 + tt; tl[tt] = (float)t * (1.0f / 2047.0f);
        const float w = 6.283185307179586f * (float)t / 2048.0f;
        float zk = 0.f;
        if (lane == 0) zk = tl[tt];
        else if (lane <= 16) { const float fr = 1e-4f + (float)(lane - 1) * ((15.0f - 1e-4f) / 15.0f); zk = cosf(fr * w); }
        else if (lane <= 32) { const float fr = 1e-4f + (float)(lane - 17) * ((15.0f - 1e-4f) / 15.0f); zk = -sinf(fr * w); }
        float a = b1[lane];
        for (int k = 0; k < 33; ++k) a += __shfl(zk, k) * w1[k * 64 + lane];
        const float h1 = sinf(fq[lane] * a);
        float a2 = b2[lane];
        for (int k = 0; k < 64; ++k) a2 += __shfl(h1, k) * w2[k * 64 + lane];
        h2v[tt] = sinf(fq[lane] * a2); }
    const float dmin = -15.350567286626973f, dmax = -3.0701134573253946f;
    for (int ih = 0; ih < 4; ++ih) {
        float acc0[8], acc1[8];
#pragma unroll
        for (int i = 0; i < 8; ++i) { acc0[i] = 0.f; acc1[i] = 0.f; }
        for (int j = 0; j < 64; ++j) { const float s0 = __shfl(h2v[0], j), s1 = __shfl(h2v[1], j); const float* wr = w3 + (size_t)j * 2048 + ih * 512 + lane;
#pragma unroll
            for (int i = 0; i < 8; ++i) { const float wv = wr[64 * i]; acc0[i] += s0 * wv; acc1[i] += s1 * wv; } }
#pragma unroll
        for (int i = 0; i < 8; ++i) { const int col = ih * 512 + 64 * i + lane, c = col & 511;
            const float delta = fabsf(dmin + (float)c * ((dmax - dmin) / 511.0f));
            float2 o; o.x = acc0[i] * expf(-tl[0] * delta); o.y = acc1[i] * expf(-tl[1] * delta);
            *(float2*)(HTD + (size_t)col * 2048 + t0) = o; }
    }
}
__device__ __forceinline__ void p0_prep(const float* const* in, unsigned char* ws, LAS unsigned char* lds, int tid) {
    const int lane = tid & 63, wave = tid >> 6, gw = blockIdx.x * NWAVE + wave, ngw = gridDim.x * NWAVE;
    LAS float* scr = (LAS float*)(lds + wave * 16384);
    bf16_t* WALL = (bf16_t*)(ws + WS_WALL);
    constexpr int I_IN = 16 * (INW / 32), I_KV = 16 * 32, I_OUT = 24 * 32, I_UP = 16 * (2 * DFF / 32), I_DN = (DFF / 64) * 32, NIT = I_IN + I_KV + I_OUT + I_UP + I_DN;
    for (int it = gw; it < NIT; it += ngw) { int r = it;
        if (r < I_IN) { p0_transpose_item<1>(in[2], DM, INW, WALL, scr, r, lane); continue; } r -= I_IN;
        if (r < I_KV) { p0_transpose_item<0>(in[14], DM, 1024, (bf16_t*)(ws + WS_WKV), scr, r, lane); continue; } r -= I_KV;
        if (r < I_OUT) { p0_transpose_item<0>(in[15], MIXW, DM, (bf16_t*)(ws + WS_WOUT), scr, r, lane); continue; } r -= I_OUT;
        if (r < I_UP) { p0_transpose_item<0>(in[18], DM, 2 * DFF, (bf16_t*)(ws + WS_WUP), scr, r, lane); continue; } r -= I_UP;
        p0_transpose_item<0>(in[21], DFF, DM, (bf16_t*)(ws + WS_WDN), scr, r, lane); }
    for (int it = ngw - 1 - gw; it < 1024; it += ngw) p0_filter_item(in[5], in[6], in[7], in[8], in[9], in[10], (float*)(ws + WS_HTD), it, lane);
    cvt_rows(in[0], (bf16_t*)(ws + WS_XB), (size_t)NT * DM / 8, gw, ngw, lane);
    cvt_rows(in[1], (bf16_t*)(ws + WS_MEMB), (size_t)NMT * DM / 8, gw, ngw, lane);
    float2* rope = (float2*)(ws + WS_ROPE);
    for (int i = blockIdx.x * NTHR + tid; i < SEQ * 32; i += gridDim.x * NTHR) { const int pos = i >> 5, f = i & 31;
        const float invf = powf(10000.0f, -(float)(2 * f) / 64.0f); const float ang = (float)pos * invf;
        float2 cs; cs.x = cosf(ang); cs.y = sinf(ang); rope[i] = cs; }
}

__device__ __forceinline__ void filter_fft_item(const float* HTD, float2* KF, LAS unsigned char* lds, int item, int tid) {
    const int o = item >> 9, c = item & 511;
    const float* rf = HTD + (size_t)((o * 2 + 0) * 512 + c) * 2048; const float* rb = HTD + (size_t)((o * 2 + 1) * 512 + c) * 2048;
    cplx v[8];
#pragma unroll
    for (int k = 0; k < 4; ++k) v[k] = mk2(rf[tid + 512 * k], 0.f);
    v[4] = mk2(tid == 0 ? 0.f : rb[2048 - tid], 0.f); v[5] = mk2(rb[1536 - tid], 0.f); v[6] = mk2(rb[1024 - tid], 0.f); v[7] = mk2(rb[512 - tid], 0.f);
    fft_fwd((LAS cplx*)lds, tid, v);
    float2* dst = KF + (size_t)(o * 512 + c) * 4096 + 8 * tid;
#pragma unroll
    for (int m = 0; m < 8; m += 2) { f32x4 w; w[0] = v[m].x * (1.f / 4096.f); w[1] = v[m].y * (1.f / 4096.f); w[2] = v[m + 1].x * (1.f / 4096.f); w[3] = v[m + 1].y * (1.f / 4096.f); *(f32x4*)(dst + m) = w; }
    __syncthreads();
}

__device__ __forceinline__ float conv3(const bf16_t* row, int n, float w0, float w1, float w2, float b) {
    float r = w1 * bf2f(row[n]) + b;
    if (n > 0) r += w0 * bf2f(row[n - 1]);
    if (n < SEQ - 1) r += w2 * bf2f(row[n + 1]);
    return r;
}
__device__ __forceinline__ void hyena_item(const bf16_t* HT, const float2* KF, const float* cw, const float* cb, const float* hb, bf16_t* MIX, LAS unsigned char* lds, int bp, int cgp, int tid0) {
    LAS cplx* X = (LAS cplx*)lds; LAS bf16_t* OT = (LAS bf16_t*)(lds + 36864);
    const int ba = 2 * bp;
#pragma unroll 1
    for (int cc = 0; cc < 8; ++cc) {
        const int c = cgp * 8 + cc;
        int tl_ = tid0; asm volatile("" : "+v"(tl_)); const int tid = tl_;
        const bf16_t* rv = HT + (size_t)c * NT + ba * SEQ; const bf16_t* r1 = HT + (size_t)(512 + c) * NT + ba * SEQ; const bf16_t* r2 = HT + (size_t)(1024 + c) * NT + ba * SEQ;
        cplx v[8]; float va[4], vb[4];
        { const float w0 = cw[c], w1 = cw[1536 + c], w2 = cw[3072 + c], b = cb[c];
#pragma unroll
          for (int k = 0; k < 4; ++k) { const int n = tid + 512 * k; va[k] = conv3(rv, n, w0, w1, w2, b); vb[k] = conv3(rv + SEQ, n, w0, w1, w2, b); v[k] = mk2(va[k], vb[k]); v[4 + k] = mk2(0.f, 0.f); } }
        fft_fwd(X, tid, v);
        { int t1_ = tid; asm volatile("" : "+v"(t1_)); const f32x4* kf = (const f32x4*)(KF + (size_t)c * 4096 + 8 * t1_);
#pragma unroll
          for (int m = 0; m < 8; m += 2) { const f32x4 w = kf[m >> 1]; v[m] = cmul(v[m], mk2(w[0], w[1])); v[m + 1] = cmul(v[m + 1], mk2(w[2], w[3])); } }
        fft_inv(X, tid, v);
        { int t2_ = tid; asm volatile("" : "+v"(t2_)); const float w0 = cw[512 + c], w1 = cw[1536 + 512 + c], w2 = cw[3072 + 512 + c], b = cb[512 + c], hb0 = hb[c];
#pragma unroll
          for (int k = 0; k < 4; ++k) { const int n = t2_ + 512 * k; const float xa = conv3(r1, n, w0, w1, w2, b), xb = conv3(r1 + SEQ, n, w0, w1, w2, b);
              va[k] = xa * (v[k].x + hb0 * va[k]); vb[k] = xb * (v[k].y + hb0 * vb[k]); v[k] = mk2(va[k], vb[k]); v[4 + k] = mk2(0.f, 0.f); } }
        fft_fwd(X, tid, v);
        { int t1_ = tid; asm volatile("" : "+v"(t1_)); const f32x4* kf = (const f32x4*)(KF + (size_t)(512 + c) * 4096 + 8 * t1_);
#pragma unroll
          for (int m = 0; m < 8; m += 2) { const f32x4 w = kf[m >> 1]; v[m] = cmul(v[m], mk2(w[0], w[1])); v[m + 1] = cmul(v[m + 1], mk2(w[2], w[3])); } }
        fft_inv(X, tid, v);
        { int t2_ = tid; asm volatile("" : "+v"(t2_)); const float w0 = cw[1024 + c], w1 = cw[1536 + 1024 + c], w2 = cw[3072 + 1024 + c], b = cb[1024 + c], hb1 = hb[512 + c];
#pragma unroll
          for (int k = 0; k < 4; ++k) { const int n = t2_ + 512 * k; const float xa = conv3(r2, n, w0, w1, w2, b), xb = conv3(r2 + SEQ, n, w0, w1, w2, b);
              const float oa = xa * (v[k].x + hb1 * va[k]), ob = xb * (v[k].y + hb1 * vb[k]);
              OT[n * 8 + cc] = (bf16_t)(pk2(oa, 0.f) & 0xffffu); OT[(SEQ + n) * 8 + cc] = (bf16_t)(pk2(ob, 0.f) & 0xffffu); } }
    }
    __syncthreads();
    int tw_ = tid0; asm volatile("" : "+v"(tw_)); const int tid = tw_;
#pragma unroll
    for (int i = 0; i < 8; ++i) { const int rowid = tid + 512 * i, bsel = rowid >> 11, n = rowid & (SEQ - 1);
        const u32x4 val = *(LAS u32x4*)(OT + rowid * 8);
        *(u32x4*)(MIX + (size_t)((ba + bsel) * SEQ + n) * MIXW + cgp * 8) = val; }
    __syncthreads();
}

constexpr int ATT_KP = 272, ATT_VP = 144, ATT_KB = 64 * ATT_KP, ATT_VB = 128 * ATT_VP, ATT_VOFF = 2 * ATT_KB;
template <int NC> __device__ __forceinline__ void attn_unit(LAS unsigned char* lds, const bf16_t* Qp, int ldq, const bf16_t* Kp, int ldk, const bf16_t* Vt, int ldv, int nkeys, float sl2,
                                                            bf16_t* Op, int ldo, float lam, const float* subg, int tid) {
    constexpr int NSTEP = (NC == 2) ? 4 : 8;
    const int lane = tid & 63, wave = tid >> 6, r = lane & 31, h = lane >> 5;
    const int qb = (NC == 2) ? (wave & 3) : wave, comp = (NC == 2) ? (wave >> 2) : 0, dbase = comp * 64;
    bf16x8 qf[NSTEP];
#pragma unroll
    for (int st = 0; st < NSTEP; ++st) qf[st] = *(const bf16x8*)(Qp + (size_t)(qb * 32 + r) * ldq + dbase + 16 * st + 8 * h);
    f32x16 o[4];
#pragma unroll
    for (int et = 0; et < 4; ++et)
#pragma unroll
        for (int i = 0; i < 16; ++i) o[et][i] = 0.f;
    float mold = -INFINITY, lsum = 0.f;
    const int kr0 = tid >> 4, kc = tid & 15, vr0 = tid >> 3, vc = tid & 7;
    const bf16_t* kg = Kp + (size_t)kr0 * ldk + kc * 8; const bf16_t* vg = Vt + (size_t)vr0 * ldv + vc * 8;
    const int kl = kr0 * ATT_KP + kc * 16, vl = ATT_VOFF + vr0 * ATT_VP + vc * 16;
    const int nt = nkeys / 64;
    u32x4 pk0, pk1, pv0, pv1;
    pk0 = *(const u32x4*)(kg); pk1 = *(const u32x4*)(kg + (size_t)32 * ldk); pv0 = *(const u32x4*)(vg); pv1 = *(const u32x4*)(vg + (size_t)64 * ldv);
    *(LAS u32x4*)(lds + kl) = pk0; *(LAS u32x4*)(lds + kl + 32 * ATT_KP) = pk1; *(LAS u32x4*)(lds + vl) = pv0; *(LAS u32x4*)(lds + vl + 64 * ATT_VP) = pv1;
    __syncthreads();
    for (int it = 0; it < nt; ++it) {
        const int cur = it & 1; const bool more = (it + 1 < nt);
        if (more) { const bf16_t* kg2 = kg + (size_t)(it + 1) * 64 * ldk; const bf16_t* vg2 = vg + (it + 1) * 64;
            pk0 = *(const u32x4*)(kg2); pk1 = *(const u32x4*)(kg2 + (size_t)32 * ldk); pv0 = *(const u32x4*)(vg2); pv1 = *(const u32x4*)(vg2 + (size_t)64 * ldv); }
        LAS unsigned char* Kb = lds + cur * ATT_KB; LAS unsigned char* Vb = lds + ATT_VOFF + cur * ATT_VB;
        f32x16 s[2];
#pragma unroll
        for (int kb = 0; kb < 2; ++kb) {
#pragma unroll
            for (int i = 0; i < 16; ++i) s[kb][i] = 0.f;
#pragma unroll
            for (int st = 0; st < NSTEP; ++st) { const bf16x8 a = *(const LAS bf16x8*)(Kb + (kb * 32 + r) * ATT_KP + (dbase + 16 * st + 8 * h) * 2);
                s[kb] = __builtin_amdgcn_mfma_f32_32x32x16_bf16(a, qf[st], s[kb], 0, 0, 0); } }
        float mx = s[0][0];
#pragma unroll
        for (int i = 1; i < 16; ++i) mx = fmaxf(mx, s[0][i]);
#pragma unroll
        for (int i = 0; i < 16; ++i) mx = fmaxf(mx, s[1][i]);
        mx = fmaxf(mx, __shfl_xor(mx, 32));
        const float mnew = fmaxf(mold, mx * sl2), alpha = __builtin_amdgcn_exp2f(mold - mnew); mold = mnew;
        float ps = 0.f;
#pragma unroll
        for (int kb = 0; kb < 2; ++kb)
#pragma unroll
            for (int i = 0; i < 16; ++i) { const float p = __builtin_amdgcn_exp2f(__builtin_fmaf(s[kb][i], sl2, -mnew)); s[kb][i] = p; ps += p; }
        lsum = lsum * alpha + ps;
#pragma unroll
        for (int et = 0; et < 4; ++et)
#pragma unroll
            for (int i = 0; i < 16; ++i) o[et][i] *= alpha;
#pragma unroll
        for (int kb = 0; kb < 2; ++kb)
#pragma unroll
            for (int s2 = 0; s2 < 2; ++s2) {
                u32x4 pw; pw.x = pk2(s[kb][8 * s2 + 0], s[kb][8 * s2 + 1]); pw.y = pk2(s[kb][8 * s2 + 2], s[kb][8 * s2 + 3]); pw.z = pk2(s[kb][8 * s2 + 4], s[kb][8 * s2 + 5]); pw.w = pk2(s[kb][8 * s2 + 6], s[kb][8 * s2 + 7]);
                const bf16x8 pf = __builtin_bit_cast(bf16x8, pw);
#pragma unroll
                for (int et = 0; et < 4; ++et) { const LAS unsigned char* vp = Vb + (et * 32 + r) * ATT_VP + (kb * 32 + 16 * s2 + 4 * h) * 2;
                    const u32x2 lo = *(const LAS u32x2*)vp, hi = *(const LAS u32x2*)(vp + 16);
                    u32x4 aw; aw.x = lo.x; aw.y = lo.y; aw.z = hi.x; aw.w = hi.y;
                    o[et] = __builtin_amdgcn_mfma_f32_32x32x16_bf16(__builtin_bit_cast(bf16x8, aw), pf, o[et], 0, 0, 0); } }
        if (more) { const int nb = cur ^ 1;
            *(LAS u32x4*)(lds + nb * ATT_KB + kl) = pk0; *(LAS u32x4*)(lds + nb * ATT_KB + kl + 32 * ATT_KP) = pk1;
            *(LAS u32x4*)(lds + nb * ATT_VB + vl) = pv0; *(LAS u32x4*)(lds + nb * ATT_VB + vl + 64 * ATT_VP) = pv1; }
        __syncthreads();
    }
    lsum += __shfl_xor(lsum, 32);
    const float inv = 1.0f / lsum;
    if (NC == 1) {
        bf16_t* orow = Op + (size_t)(qb * 32 + r) * ldo;
#pragma unroll
        for (int et = 0; et < 4; ++et)
#pragma unroll
            for (int g = 0; g < 4; ++g) { u32x2 w; w.x = pk2(o[et][4 * g] * inv, o[et][4 * g + 1] * inv); w.y = pk2(o[et][4 * g + 2] * inv, o[et][4 * g + 3] * inv);
                *(u32x2*)(orow + et * 32 + 8 * g + 4 * h) = w; }
    } else {
        LAS float* XL = (LAS float*)lds;
        if (comp == 1) {
#pragma unroll
            for (int et = 0; et < 4; ++et)
#pragma unroll
                for (int i = 0; i < 16; ++i) XL[(qb * 64 + et * 16 + i) * 64 + lane] = o[et][i] * inv;
        }
        __syncthreads();
        if (comp == 0) {
            float ss = 0.f;
#pragma unroll
            for (int et = 0; et < 4; ++et)
#pragma unroll
                for (int i = 0; i < 16; ++i) { const float ov = o[et][i] * inv - lam * XL[(qb * 64 + et * 16 + i) * 64 + lane]; o[et][i] = ov; ss += ov * ov; }
            ss += __shfl_xor(ss, 32);
            const float rs = rsqrtf(ss * (1.0f / 128.0f) + RMS_EPS) * 0.8f;
            bf16_t* orow = Op + (size_t)(qb * 32 + r) * ldo;
#pragma unroll
            for (int et = 0; et < 4; ++et)
#pragma unroll
                for (int g = 0; g < 4; ++g) { const int e = et * 32 + 8 * g + 4 * h; const f32x4 gv = *(const f32x4*)(subg + e);
                    u32x2 w; w.x = pk2(o[et][4 * g] * rs * gv[0], o[et][4 * g + 1] * rs * gv[1]); w.y = pk2(o[et][4 * g + 2] * rs * gv[2], o[et][4 * g + 3] * rs * gv[3]);
                    *(u32x2*)(orow + e) = w; }
        }
        __syncthreads();
    }
}

template <bool TO_BF16> __device__ __forceinline__ void ln_rows(float* io, bf16_t* ob, float2* stat, const float* g, const float* b, int tid) {
    const int lane = tid & 63, gw = blockIdx.x * NWAVE + (tid >> 6), ngw = gridDim.x * NWAVE;
    f32x4 gv[4], bv[4];
#pragma unroll
    for (int j = 0; j < 4; ++j) { gv[j] = ((const f32x4*)g)[lane + 64 * j]; bv[j] = ((const f32x4*)b)[lane + 64 * j]; }
    for (int row = gw; row < NT; row += ngw) {
        f32x4* xr = (f32x4*)(io + (size_t)row * DM) + lane; f32x4 v[4]; float s = 0.f;
#pragma unroll
        for (int j = 0; j < 4; ++j) { v[j] = xr[64 * j]; s += (v[j][0] + v[j][1]) + (v[j][2] + v[j][3]); }
#pragma unroll
        for (int o = 1; o < 64; o <<= 1) s += __shfl_xor(s, o);
        const float mean = s * (1.0f / DM); float s2 = 0.f;
#pragma unroll
        for (int j = 0; j < 4; ++j) { v[j] = v[j] - mean; s2 += (v[j][0] * v[j][0] + v[j][1] * v[j][1]) + (v[j][2] * v[j][2] + v[j][3] * v[j][3]); }
#pragma unroll
        for (int o = 1; o < 64; o <<= 1) s2 += __shfl_xor(s2, o);
        const float rstd = rsqrtf(s2 * (1.0f / DM) + LN_EPS);
        if (TO_BF16) {
            u32x2* o8 = (u32x2*)(ob + (size_t)row * DM) + lane;
#pragma unroll
            for (int j = 0; j < 4; ++j) { const f32x4 y = v[j] * rstd * gv[j] + bv[j]; u32x2 w; w.x = pk2(y[0], y[1]); w.y = pk2(y[2], y[3]); o8[64 * j] = w; }
            if (lane == 0) { float2 st; st.x = mean; st.y = rstd; stat[row] = st; }
        } else {
#pragma unroll
            for (int j = 0; j < 4; ++j) xr[64 * j] = v[j] * rstd * gv[j] + bv[j];
        }
    }
}

__device__ __forceinline__ void convgate_half(const bf16_t* HH, bf16_t* ACT, const float* cw, const float* cb, int half, int tid) {
    constexpr int NG = DFF / 8; const int total = (NT / 2) * NG;
    for (int idx = blockIdx.x * NTHR + tid; idx < total; idx += gridDim.x * NTHR) {
        const int rl = idx / NG, cg8 = idx - rl * NG, n0 = cg8 * 8, t = rl & (SEQ - 1);
        const bf16_t* hp = HH + (size_t)rl * (2 * DFF);
        float gsum[8], usum[8];
#pragma unroll
        for (int e = 0; e < 8; ++e) { gsum[e] = cb[n0 + e]; usum[e] = cb[DFF + n0 + e]; }
#pragma unroll
        for (int j = 0; j < 3; ++j) { const int tt = t + j - 1; if (tt < 0 || tt >= SEQ) continue;
            const u32x4 gq = *(const u32x4*)(hp + (ptrdiff_t)(j - 1) * (2 * DFF) + n0), uq = *(const u32x4*)(hp + (ptrdiff_t)(j - 1) * (2 * DFF) + DFF + n0);
            const float* wg = cw + (size_t)j * (2 * DFF) + n0; const float* wu = wg + DFF;
            const f32x4 wg0 = *(const f32x4*)wg, wg1 = *(const f32x4*)(wg + 4), wu0 = *(const f32x4*)wu, wu1 = *(const f32x4*)(wu + 4);
            gsum[0] += wg0[0] * lo2f(gq.x); gsum[1] += wg0[1] * hi2f(gq.x); gsum[2] += wg0[2] * lo2f(gq.y); gsum[3] += wg0[3] * hi2f(gq.y);
            gsum[4] += wg1[0] * lo2f(gq.z); gsum[5] += wg1[1] * hi2f(gq.z); gsum[6] += wg1[2] * lo2f(gq.w); gsum[7] += wg1[3] * hi2f(gq.w);
            usum[0] += wu0[0] * lo2f(uq.x); usum[1] += wu0[1] * hi2f(uq.x); usum[2] += wu0[2] * lo2f(uq.y); usum[3] += wu0[3] * hi2f(uq.y);
            usum[4] += wu1[0] * lo2f(uq.z); usum[5] += wu1[1] * hi2f(uq.z); usum[6] += wu1[2] * lo2f(uq.w); usum[7] += wu1[3] * hi2f(uq.w); }
        float a[8];
#pragma unroll
        for (int e = 0; e < 8; ++e) a[e] = gsum[e] / (1.0f + __expf(-gsum[e])) * usum[e];
        u32x4 w; w.x = pk2(a[0], a[1]); w.y = pk2(a[2], a[3]); w.z = pk2(a[4], a[5]); w.w = pk2(a[6], a[7]);
        *(u32x4*)(ACT + (size_t)(half * (NT / 2) + rl) * DFF + n0) = w;
    }
}

#ifndef PH_MASK
#define PH_MASK 0xFFFFFF
#endif
#define PH(k) ((PH_MASK >> (k)) & 1)
struct Args { const float* in[24]; float* out; unsigned char* ws; };
__global__ void __launch_bounds__(NTHR, 2) hybrid_fwd(Args a) {
    extern __shared__ __attribute__((aligned(16))) unsigned char smem[];
    LAS unsigned char* lds = (LAS unsigned char*)smem;
    cg::grid_group grid = cg::this_grid();
    const int G = gridDim.x;
#define NEWPHASE() int tid_ = threadIdx.x, cu_ = blockIdx.x; asm volatile("" : "+v"(tid_)); asm volatile("" : "+s"(cu_)); const int tid = tid_, cu = cu_; (void)tid; (void)cu;
    unsigned char* ws = a.ws;
    bf16_t* WALL = (bf16_t*)(ws + WS_WALL); bf16_t* XB = (bf16_t*)(ws + WS_XB); bf16_t* MEMB = (bf16_t*)(ws + WS_MEMB); bf16_t* WKV = (bf16_t*)(ws + WS_WKV);
    bf16_t* QKM = (bf16_t*)(ws + WS_QKM); bf16_t* HT = (bf16_t*)(ws + WS_HT); bf16_t* KMEM = (bf16_t*)(ws + WS_KMEM); bf16_t* VMT = (bf16_t*)(ws + WS_VMT);
    float2* KF = (float2*)(ws + WS_KF); bf16_t* MIX = (bf16_t*)(ws + WS_MIX); float2* STAT = (float2*)(ws + WS_STAT);
    bf16_t* X1B = (bf16_t*)(ws + WS_X1B); bf16_t* HH = (bf16_t*)(ws + WS_HH); bf16_t* ACT = (bf16_t*)(ws + WS_ACT);

    { NEWPHASE(); if (PH(0)) p0_prep(a.in, ws, lds, tid); }
    grid.sync();

    if (PH(1)) { NEWPHASE(); pg8::Gemm g{XB, WALL, NT, 1536, DM}; pg8::StaticOrder S; S.init(g.M, g.N, G, cu);
      EpiRope E{QKM, (const float2*)(ws + WS_ROPE)};
      pg8::gemm_phase<EpiRope, pg8::StaticOrder, true, true>(lds, g, S, E); }
    if (PH(2)) { NEWPHASE(); pg8::Gemm g{WALL + (size_t)1536 * DM, XB, 2048, NT, DM}; pg8::StaticOrder S; S.init(g.M, g.N, G, cu);
      EpiB E{HT, NT};
      pg8::gemm_phase<EpiB, pg8::StaticOrder, true, true>(lds, g, S, E); }
    if (PH(3)) { NEWPHASE(); const bool isK = cu < 32, on = cu < 64; const int c2 = cu - 32;
      pg8::Gemm g; EpiB E; OneUnit S;
      if (isK) { g = pg8::Gemm{MEMB, WKV, NMT, 512, DM}; E = EpiB{KMEM, 512}; S = OneUnit{cu >> 1, cu & 1, on}; }
      else { g = pg8::Gemm{WKV + (size_t)512 * DM, MEMB, 512, NMT, DM}; E = EpiB{VMT, NMT}; S = OneUnit{(c2 >> 4) & 1, c2 & 15, on}; }
      pg8::gemm_phase<EpiB, OneUnit, false, true>(lds, g, S, E);
      __syncthreads();
      if (!on) for (int it = cu - 64; it < 1024; it += G - 64) filter_fft_item((const float*)(ws + WS_HTD), KF, lds, it, tid); }
    grid.sync();

    { NEWPHASE(); const int xcd = cu & 7, j = cu >> 3;
      float lam;
      { const float* lp = a.in[12]; float s01 = 0.f, s23 = 0.f;
        for (int i = 0; i < 64; ++i) { s01 += lp[i] * lp[64 + i]; s23 += lp[128 + i] * lp[192 + i]; }
        lam = expf(s01) - expf(s23) + 0.2f; }
      if (PH(4)) for (int i = 0; i < 4; ++i) {
          const int bh = (i * 8 + xcd) * 2 + (j >> 4), qblk = j & 15, b = bh >> 2, hd = bh & 3;
          const size_t tok0 = (size_t)b * SEQ;
          attn_unit<2>(lds, QKM + (tok0 + qblk * 128) * MIXW + hd * 128, MIXW, QKM + tok0 * MIXW + 512 + hd * 128, MIXW,
                       HT + (size_t)(1536 + hd * 128) * NT + tok0, NT, SEQ, 0.125f * 1.4426950408889634f,
                       MIX + (tok0 + qblk * 128) * MIXW + 512 + hd * 128, MIXW, lam, a.in[13], tid); }
      if (PH(5)) for (int i = 0; i < 2; ++i) {
          const int bh = (i * 8 + xcd) * 4 + (j >> 3), qblk = j & 7, b = bh >> 2, hd = bh & 3;
          const size_t tok0 = (size_t)b * SEQ;
          attn_unit<1>(lds, QKM + (tok0 + qblk * 256) * MIXW + 1024 + hd * 128, MIXW, KMEM + (size_t)b * MEMT * 512 + hd * 128, 512,
                       VMT + (size_t)(hd * 128) * NMT + b * MEMT, NMT, MEMT, 0.08838834764831845f * 1.4426950408889634f,
                       MIX + (tok0 + qblk * 256) * MIXW + 1024 + hd * 128, MIXW, 0.f, nullptr, tid); }
      if (PH(6)) for (int i = 0; i < 2; ++i) {
          const int cgp = (i * 8 + xcd) * 4 + (j >> 3), bp = j & 7;
          hyena_item(HT, KF, a.in[3], a.in[4], a.in[11], MIX, lds, bp, cgp, tid); } }
    grid.sync();

    if (PH(7)) { NEWPHASE(); pg8::Gemm g{MIX, (const bf16_t*)(ws + WS_WOUT), NT, DM, MIXW}; pg8::StaticOrder S; S.init(g.M, g.N, G, cu);
      EpiRes E{a.in[0], a.out};
      pg8::gemm_phase<EpiRes, pg8::StaticOrder, true, true>(lds, g, S, E); }
    grid.sync();
    if (PH(8)) { NEWPHASE(); ln_rows<true>(a.out, X1B, STAT, a.in[16], a.in[17], tid); }
    grid.sync();
    for (int half = 0; half < 2; ++half) {
        if (PH(9)) { NEWPHASE(); pg8::Gemm g{X1B + (size_t)half * (NT / 2) * DM, (const bf16_t*)(ws + WS_WUP), NT / 2, 2 * DFF, DM}; pg8::StaticOrder S; S.init(g.M, g.N, G, cu);
          EpiB E{HH, 2 * DFF};
          pg8::gemm_phase<EpiB, pg8::StaticOrder, true, true>(lds, g, S, E); }
        grid.sync();
        if (PH(10)) { NEWPHASE(); convgate_half(HH, ACT, a.in[19], a.in[20], half, tid); }
        grid.sync();
    }
    if (PH(11)) { NEWPHASE(); pg8::Gemm g{ACT, (const bf16_t*)(ws + WS_WDN), NT, DM, DFF}; pg8::StaticOrder S; S.init(g.M, g.N, G, cu);
      EpiRes2 E{a.out, STAT, a.in[16], a.in[17]};
      pg8::gemm_phase<EpiRes2, pg8::StaticOrder, true, true>(lds, g, S, E); }
    grid.sync();
    if (PH(12)) { NEWPHASE(); ln_rows<false>(a.out, nullptr, nullptr, a.in[22], a.in[23], tid); }
}

extern "C" void kernel_launch(void* const* d_in, const int* in_sizes, int n_in, void* d_out, int out_size, void* d_ws, size_t ws_size, hipStream_t stream) {
    static int grid = 0;
    if (grid == 0) {
        if (n_in != 24 || out_size != NT * DM || ws_size < WS_END) { fprintf(stderr, "kernel_launch: unexpected shapes (n_in %d, out %d, ws %zu)\n", n_in, out_size, ws_size); grid = -1; return; }
        int dev = 0, cus = 0, per_cu = 0;
        hipGetDevice(&dev); hipDeviceGetAttribute(&cus, hipDeviceAttributeMultiprocessorCount, dev);
        if (hipFuncSetAttribute((const void*)hybrid_fwd, hipFuncAttributeMaxDynamicSharedMemorySize, LDS_BYTES) != hipSuccess) { fprintf(stderr, "kernel_launch: hipFuncSetAttribute failed\n"); grid = -1; return; }
        if (hipOccupancyMaxActiveBlocksPerMultiprocessor(&per_cu, (const void*)hybrid_fwd, NTHR, LDS_BYTES) != hipSuccess || per_cu < 1) { fprintf(stderr, "kernel_launch: occupancy query says %d\n", per_cu); per_cu = 1; }
        (void)hipGetLastError();
        grid = cus * per_cu;
        fprintf(stderr, "kernel_launch: grid %d (cus %d x %d)\n", grid, cus, per_cu);
    }
    if (grid < 0) return;
    Args a{};
    for (int i = 0; i < 24; ++i) a.in[i] = (const float*)d_in[i];
    a.out = (float*)d_out; a.ws = (unsigned char*)d_ws;
    void* args[] = {&a};
    const hipError_t e = hipLaunchCooperativeKernel((const void*)hybrid_fwd, dim3(grid), dim3(NTHR), args, LDS_BYTES, stream);
    if (e != hipSuccess) fprintf(stderr, "kernel_launch: cooperative launch failed: %s (grid %d)\n", hipGetErrorString(e), grid);
}
```

```cpp
#include <hip/hip_runtime.h>
#include <hip/hip_cooperative_groups.h>
#include <cstdio>
#include <cstdint>
namespace cg = cooperative_groups;
#define LAS __attribute__((address_space(3)))
namespace pg8 {
#define PG8_LAS __attribute__((address_space(3)))
typedef unsigned short bf16_t;
typedef short bf16x8 __attribute__((ext_vector_type(8)));
typedef float f32x4 __attribute__((ext_vector_type(4)));
typedef unsigned u32x4 __attribute__((ext_vector_type(4)));
constexpr int BM = 256, BK = 64, HALF = 128, HTB = HALF * BK * 2  , STAGE_BYTES = 8 * HTB, NXCD = 8, WGM = 8;

__host__ __device__ __forceinline__ int lds_byte(int r, int c) { const int st = (r >> 4) * 2 + (c >> 5), rr = r & 15, cc = c & 31, ob = rr * 64 + cc * 2; return st * 1024 + (ob ^ (((ob >> 9) & 1) << 5)); }
__host__ __device__ __forceinline__ void stage_rc(int b, int& R, int& C) { const int st = b / 1024, sb = b % 1024, swz = sb ^ (((sb >> 9) & 1) << 5); R = (st >> 1) * 16 + swz / 64; C = (st & 1) * 32 + (swz % 64) / 2; }
__host__ __device__ __forceinline__ int perm32(int rho) { const int n = rho >> 4, i = rho & 15; return 8 * (i >> 2) + 4 * n + (i & 3); }

struct Unit { int pm, pn; };
struct Gemm { const bf16_t* A; const bf16_t* Bt; int M, N, K; };

struct StaticOrder {
    int nM, nN, nwg, G, c;
    __host__ __device__ void init(int M, int N, int G_, int c_) { nM = M / BM; nN = N / BM; nwg = nM * nN; G = G_; c = c_; }
    __host__ __device__ bool next(int i, Unit& u) const {
        const long L = (long)i * G + c; if (L >= nwg) return false;
        int wgid = (int)L; { const int q = nwg / NXCD, r = nwg % NXCD, xcd = wgid % NXCD, off = wgid / NXCD; wgid = (xcd < r ? xcd * (q + 1) : r * (q + 1) + (xcd - r) * q) + off; }
        const int nig = WGM * nN, gid = wgid / nig, fm = gid * WGM, gsz = (nM - fm) < WGM ? (nM - fm) : WGM;
        u.pm = fm + ((wgid % nig) % gsz); u.pn = (wgid % nig) / gsz; return true;
    }
    __device__ __forceinline__ void a_ready(const Unit&) const {}
    __device__ __forceinline__ void done(const Unit&) const {}
};
template <class Epi, class Sched, bool ALIGN_EPI = false, bool SP2 = false>
__device__ __forceinline__ void gemm_phase(PG8_LAS unsigned char* lds, const Gemm g, const Sched& S, const Epi& E) {
    int tid_l = threadIdx.x; asm volatile("" : "+v"(tid_l)); const int tid = tid_l, wid = __builtin_amdgcn_readfirstlane(tid >> 6), lane = tid & 63, wr = wid >> 2, wc = wid & 3, fr = lane & 15, fq = lane >> 4;
    const int K = g.K, nt = K / BK;
    unsigned voffA[2], voffB[2];
#pragma unroll
    for (int i = 0; i < 2; ++i) { int R, C; stage_rc(tid * 16 + i * 8192, R, C); const int Rb = Epi::PERM ? ((R & ~31) + perm32(R & 31)) : R;
        voffA[i] = (unsigned)(R * K + C) * 2u; voffB[i] = (unsigned)(Rb * K + C) * 2u; }
    const size_t kstep = (size_t)(BK * 2);
    const size_t hstep = (size_t)HALF * K * 2;
    const size_t tstep = 2 * hstep;
    const unsigned ldsw = (unsigned)wid * 1024u;
    const int aoff = lds_byte(wr * 64 + fr, fq * 8), boff = lds_byte(wc * 32 + fr, fq * 8);
#define PG8_SA(b, h) (((b) * 2 + (h)) * HTB)
#define PG8_SB(b, h) ((4 + (b) * 2 + (h)) * HTB)
#define PG8_STAGE(bufoff, gbase, voff) do { _Pragma("unroll") for (int _i = 0; _i < 2; ++_i) \
        __builtin_amdgcn_global_load_lds((const unsigned*)((const char*)(gbase) + (voff)[_i]), (PG8_LAS unsigned*)(lds + (bufoff) + ldsw + _i * 8192), 16, 0, 0); } while (0)
#define PG8_LDA(dst, b, h) do { _Pragma("unroll") for (int m = 0; m < 4; ++m) _Pragma("unroll") for (int k = 0; k < 2; ++k) dst[m][k] = *(const PG8_LAS bf16x8*)(lds + PG8_SA(b, h) + aoff + m * 2048 + k * 1024); } while (0)
#define PG8_LDB(dst, b, h) do { _Pragma("unroll") for (int n = 0; n < 2; ++n) _Pragma("unroll") for (int k = 0; k < 2; ++k) dst[n][k] = *(const PG8_LAS bf16x8*)(lds + PG8_SB(b, h) + boff + n * 2048 + k * 1024); } while (0)
#define PG8_MMA(ai, bj, At, Bt) do { __builtin_amdgcn_s_setprio(1); _Pragma("unroll") for (int m = 0; m < 4; ++m) _Pragma("unroll") for (int n = 0; n < 2; ++n) _Pragma("unroll") for (int k = 0; k < 2; ++k) \
        acc[ai][bj][m][n] = __builtin_amdgcn_mfma_f32_16x16x32_bf16(Bt[n][k], At[m][k], acc[ai][bj][m][n], 0, 0, 0); __builtin_amdgcn_s_setprio(0); } while (0)
#define PG8_WAIT_V(n) asm volatile("s_waitcnt vmcnt(" #n ")" ::: "memory")
#define PG8_WAIT_L(n) asm volatile("s_waitcnt lgkmcnt(" #n ")" ::: "memory")
#define PG8_BAR __builtin_amdgcn_s_barrier()
#define PG8_SCHED __builtin_amdgcn_sched_barrier(0)
    Unit cur, nxt; int ui = 0;
    if (!S.next(0, cur)) return;
    f32x4 acc[2][2][4][2];
#pragma unroll
    for (int a = 0; a < 2; ++a)
#pragma unroll
        for (int b = 0; b < 2; ++b)
#pragma unroll
            for (int m = 0; m < 4; ++m)
#pragma unroll
                for (int n = 0; n < 2; ++n) acc[a][b][m][n] = (f32x4){0.f, 0.f, 0.f, 0.f};
    bf16x8 At[4][2], B0[2][2], B1[2][2];
    const char* cA = (const char*)g.A + (size_t)cur.pm * tstep; const char* cB = (const char*)g.Bt + (size_t)cur.pn * tstep;
    S.a_ready(cur);
    if constexpr (SP2) {
        PG8_STAGE(PG8_SB(0, 0), cB, voffB); PG8_STAGE(PG8_SB(0, 1), cB + hstep, voffB); PG8_STAGE(PG8_SA(0, 0), cA, voffA); PG8_STAGE(PG8_SA(0, 1), cA + hstep, voffA);
        if (wr == 1) PG8_BAR;
        PG8_WAIT_V(2); PG8_BAR;
        PG8_STAGE(PG8_SB(1, 0), cB + kstep, voffB); PG8_STAGE(PG8_SA(1, 0), cA + kstep, voffA); PG8_STAGE(PG8_SB(1, 1), cB + hstep + kstep, voffB);
        PG8_WAIT_V(6); PG8_BAR;
    } else {
        PG8_STAGE(PG8_SB(0, 0), cB, voffB); PG8_STAGE(PG8_SA(0, 0), cA, voffA); PG8_STAGE(PG8_SB(0, 1), cB + hstep, voffB); PG8_STAGE(PG8_SA(0, 1), cA + hstep, voffA);
        if (wr == 1) PG8_BAR;
        PG8_WAIT_V(4); PG8_BAR;
        PG8_STAGE(PG8_SB(1, 0), cB + kstep, voffB); PG8_STAGE(PG8_SA(1, 0), cA + kstep, voffA); PG8_STAGE(PG8_SB(1, 1), cB + hstep + kstep, voffB);
        PG8_WAIT_V(6); PG8_BAR;
    }
    for (;;) {
        const bool has_next = S.next(ui + 1, nxt);
        const char* nA = has_next ? (const char*)g.A + (size_t)nxt.pm * tstep : cA; const char* nB = has_next ? (const char*)g.Bt + (size_t)nxt.pn * tstep : cB;
        for (int t = 0; t < nt; t += 2) {
            const bool last = (t == nt - 2);
            const char* a1 = cA + (size_t)(t + 1) * kstep;
            const char* a2 = last ? nA : cA + (size_t)(t + 2) * kstep; const char* b2 = last ? nB : cB + (size_t)(t + 2) * kstep;
            const char* a3 = a2 + kstep; const char* b3 = b2 + kstep;
            if (last && has_next) S.a_ready(nxt);
            if constexpr (SP2) {
            PG8_LDB(B0, 0, 0); PG8_LDB(B1, 0, 1); PG8_SCHED; PG8_LDA(At, 0, 0); PG8_STAGE(PG8_SA(1, 1), a1 + hstep, voffA);
            PG8_WAIT_V(8); PG8_WAIT_L(0); PG8_BAR; PG8_MMA(0, 0, At, B0); PG8_MMA(0, 1, At, B1); PG8_BAR; PG8_SCHED;
            PG8_LDA(At, 0, 1); PG8_STAGE(PG8_SB(0, 0), b2, voffB); PG8_STAGE(PG8_SB(0, 1), b2 + hstep, voffB); PG8_STAGE(PG8_SA(0, 0), a2, voffA);
            PG8_WAIT_V(8); PG8_WAIT_L(0); PG8_BAR; PG8_MMA(1, 0, At, B0); PG8_MMA(1, 1, At, B1); PG8_BAR; PG8_SCHED;
            PG8_LDB(B0, 1, 0); PG8_LDB(B1, 1, 1); PG8_SCHED; PG8_LDA(At, 1, 0); PG8_STAGE(PG8_SA(0, 1), a2 + hstep, voffA);
            PG8_WAIT_V(8); PG8_WAIT_L(0); PG8_BAR; PG8_MMA(0, 0, At, B0); PG8_MMA(0, 1, At, B1); PG8_BAR; PG8_SCHED;
            PG8_LDA(At, 1, 1); PG8_STAGE(PG8_SB(1, 0), b3, voffB); PG8_STAGE(PG8_SB(1, 1), b3 + hstep, voffB); PG8_STAGE(PG8_SA(1, 0), a3, voffA);
            PG8_WAIT_V(8); PG8_WAIT_L(0); PG8_BAR; PG8_MMA(1, 0, At, B0); PG8_MMA(1, 1, At, B1); PG8_BAR; PG8_SCHED;
            } else {
            PG8_LDB(B0, 0, 0); PG8_SCHED; PG8_LDA(At, 0, 0); PG8_STAGE(PG8_SA(1, 1), a1 + hstep, voffA);
            PG8_WAIT_L(8); PG8_BAR; PG8_WAIT_L(0); PG8_MMA(0, 0, At, B0); PG8_BAR; PG8_SCHED;
            PG8_LDB(B1, 0, 1); PG8_STAGE(PG8_SB(0, 0), b2, voffB);
            PG8_BAR; PG8_WAIT_L(0); PG8_MMA(0, 1, At, B1); PG8_BAR;
            PG8_LDA(At, 0, 1); PG8_STAGE(PG8_SA(0, 0), a2, voffA);
            PG8_BAR; PG8_WAIT_L(0); PG8_MMA(1, 0, At, B0); PG8_BAR; PG8_SCHED;
            PG8_STAGE(PG8_SB(0, 1), b2 + hstep, voffB);
            PG8_WAIT_V(6); PG8_BAR; PG8_MMA(1, 1, At, B1); PG8_BAR;
            PG8_LDB(B0, 1, 0); PG8_SCHED; PG8_LDA(At, 1, 0); PG8_STAGE(PG8_SA(0, 1), a2 + hstep, voffA);
            PG8_WAIT_L(8); PG8_BAR; PG8_WAIT_L(0); PG8_MMA(0, 0, At, B0); PG8_BAR; PG8_SCHED;
            PG8_LDB(B1, 1, 1); PG8_STAGE(PG8_SB(1, 0), b3, voffB);
            PG8_BAR; PG8_WAIT_L(0); PG8_MMA(0, 1, At, B1); PG8_BAR;
            PG8_LDA(At, 1, 1); PG8_STAGE(PG8_SA(1, 0), a3, voffA);
            PG8_BAR; PG8_WAIT_L(0); PG8_MMA(1, 0, At, B0); PG8_BAR; PG8_SCHED;
            PG8_STAGE(PG8_SB(1, 1), b3 + hstep, voffB);
            PG8_WAIT_V(6); PG8_BAR; PG8_MMA(1, 1, At, B1); PG8_BAR;
            }
        }
        if constexpr (ALIGN_EPI) { if (wr == 0) PG8_BAR; }
        if constexpr (!Epi::AFTER_DRAIN) { E(acc, cur, wr, wc, fr, fq); S.done(cur); }
        if (!has_next) break;
#pragma unroll
        for (int a = 0; a < 2; ++a)
#pragma unroll
            for (int b = 0; b < 2; ++b)
#pragma unroll
                for (int m = 0; m < 4; ++m)
#pragma unroll
                    for (int n = 0; n < 2; ++n) acc[a][b][m][n] = (f32x4){0.f, 0.f, 0.f, 0.f};
        cur = nxt; cA = nA; cB = nB; ++ui;
        if constexpr (ALIGN_EPI) { if (wr == 1) PG8_BAR; }
    }
    PG8_WAIT_V(0);
    if constexpr (!ALIGN_EPI) { if (wr == 0) PG8_BAR; }
    PG8_BAR;
    if constexpr (Epi::AFTER_DRAIN) { E.fused(acc, cur, wr, wc, fr, fq, lds, wid, lane); S.done(cur); }
#undef PG8_SA
#undef PG8_SB
#undef PG8_STAGE
#undef PG8_LDA
#undef PG8_LDB
#undef PG8_MMA
#undef PG8_WAIT_V
#undef PG8_WAIT_L
#undef PG8_BAR
#undef PG8_SCHED
}
}

using pg8::bf16_t; using pg8::bf16x8; using pg8::f32x4; using pg8::u32x4;
typedef float f32x16 __attribute__((ext_vector_type(16)));
typedef unsigned u32x2 __attribute__((ext_vector_type(2)));
typedef short bf16x4 __attribute__((ext_vector_type(4)));

constexpr int NB = 16, SEQ = 2048, DM = 1024, NT = NB * SEQ, MEMT = 256, NMT = NB * MEMT, HW = 512, INW = 3584, DFF = 2816, MIXW = 1536;
constexpr float ALPHA = 1.189207115002721f;
constexpr float LN_EPS = 1e-5f, RMS_EPS = 1e-5f;
constexpr int NTHR = 512, NWAVE = 8;
constexpr int LDS_BYTES = 139264;

constexpr size_t MiB = 1048576;
constexpr size_t WS_WALL = 0;
constexpr size_t WS_WKV  = 7 * MiB;
constexpr size_t WS_WOUT = 9 * MiB;
constexpr size_t WS_WUP  = 12 * MiB;
constexpr size_t WS_WDN  = 23 * MiB;
constexpr size_t WS_ROPE = 29 * MiB;
constexpr size_t WS_STAT = 29 * MiB + 524288;
constexpr size_t WS_XB   = 30 * MiB;
constexpr size_t WS_X1B  = 30 * MiB;
constexpr size_t WS_HTD  = 94 * MiB;
constexpr size_t WS_MEMB = 110 * MiB;
constexpr size_t WS_QKM  = 118 * MiB;
constexpr size_t WS_HT   = 214 * MiB;
constexpr size_t WS_KMEM = 342 * MiB;
constexpr size_t WS_VMT  = 346 * MiB;
constexpr size_t WS_KF   = 350 * MiB;
constexpr size_t WS_MIX  = 382 * MiB;
constexpr size_t WS_HH   = 96 * MiB;
constexpr size_t WS_ACT  = 272 * MiB;
constexpr size_t WS_BAR  = 478 * MiB;
constexpr size_t WS_END  = 478 * MiB + 65536;

__device__ __forceinline__ unsigned pk2(float lo, float hi) { unsigned r; asm volatile("v_cvt_pk_bf16_f32 %0, %1, %2" : "=v"(r) : "v"(lo), "v"(hi)); return r; }
__device__ __forceinline__ float bf2f(bf16_t v) { return __uint_as_float((unsigned)v << 16); }
__device__ __forceinline__ float lo2f(unsigned v) { return __uint_as_float(v << 16); }
__device__ __forceinline__ float hi2f(unsigned v) { return __uint_as_float(v & 0xffff0000u); }
#define LDS_WAIT() asm volatile("s_waitcnt lgkmcnt(0)" ::: "memory")

#ifndef FFT_HOST
#define FFT_FN __device__ __forceinline__
#define FFT_SYNC() __syncthreads()
typedef float cplx __attribute__((ext_vector_type(2)));
typedef LAS cplx* fftbuf_t;
FFT_FN float cos2pi(float r) { return __builtin_amdgcn_cosf(r); }
FFT_FN float sin2pi(float r) { return __builtin_amdgcn_sinf(r); }
#endif
FFT_FN cplx mk2(float x, float y) { cplx r; r.x = x; r.y = y; return r; }
FFT_FN cplx cadd(cplx a, cplx b) { return mk2(a.x + b.x, a.y + b.y); }
FFT_FN cplx csub(cplx a, cplx b) { return mk2(a.x - b.x, a.y - b.y); }
FFT_FN cplx cmul(cplx a, cplx b) { return mk2(a.x * b.x - a.y * b.y, a.x * b.y + a.y * b.x); }
template <bool INV> FFT_FN cplx muli(cplx a) { return INV ? mk2(-a.y, a.x) : mk2(a.y, -a.x); }
FFT_FN int padi(int i) { return i + (i >> 3); }

template <bool INV> FFT_FN void dft8(cplx (&v)[8]) {
    const float R = 0.70710678118654752f;
    const cplx a0 = cadd(v[0], v[4]), a1 = csub(v[0], v[4]), a2 = cadd(v[2], v[6]), a3 = muli<INV>(csub(v[2], v[6]));
    const cplx a4 = cadd(v[1], v[5]), a5 = csub(v[1], v[5]), a6 = cadd(v[3], v[7]), a7 = muli<INV>(csub(v[3], v[7]));
    const cplx b0 = cadd(a0, a2), b2 = csub(a0, a2), b1 = cadd(a1, a3), b3 = csub(a1, a3);
    const cplx b4 = cadd(a4, a6), b6 = muli<INV>(csub(a4, a6));
    const cplx t5 = cadd(a5, a7), t7 = csub(a5, a7);
    cplx b5, b7;
    if (!INV) { b5 = mk2((t5.x + t5.y) * R, (t5.y - t5.x) * R); b7 = mk2((t7.y - t7.x) * R, -(t7.x + t7.y) * R); }
    else      { b5 = mk2((t5.x - t5.y) * R, (t5.x + t5.y) * R); b7 = mk2(-(t7.x + t7.y) * R, (t7.x - t7.y) * R); }
    v[0] = cadd(b0, b4); v[4] = csub(b0, b4); v[1] = cadd(b1, b5); v[5] = csub(b1, b5);
    v[2] = cadd(b2, b6); v[6] = csub(b2, b6); v[3] = cadd(b3, b7); v[7] = csub(b3, b7);
}
template <int S, bool INV> FFT_FN void twid(cplx (&v)[8], int tid) {
    if (S > 1) {
        const int j = tid % S; const float rev = (float)j * (1.0f / (8.0f * S));
        const float c = cos2pi(rev), s = sin2pi(rev);
        const cplx w1 = mk2(c, INV ? s : -s);
        const cplx w2 = cmul(w1, w1), w3 = cmul(w2, w1), w4 = cmul(w2, w2), w5 = cmul(w4, w1), w6 = cmul(w4, w2), w7 = cmul(w4, w3);
        v[1] = cmul(v[1], w1); v[2] = cmul(v[2], w2); v[3] = cmul(v[3], w3); v[4] = cmul(v[4], w4);
        v[5] = cmul(v[5], w5); v[6] = cmul(v[6], w6); v[7] = cmul(v[7], w7);
    }
}
template <int S> FFT_FN void ld8(fftbuf_t X, int tid, cplx (&v)[8]) {
    const int base = (tid / S) * 8 * S + (tid % S);
#pragma unroll
    for (int k = 0; k < 8; ++k) v[k] = X[padi(base + S * k)];
}
template <int S> FFT_FN void st8(fftbuf_t X, int tid, const cplx (&v)[8]) {
    const int base = (tid / S) * 8 * S + (tid % S);
#pragma unroll
    for (int k = 0; k < 8; ++k) X[padi(base + S * k)] = v[k];
}
#ifndef FFT_HOST
FFT_FN void fft_fwd(fftbuf_t X, int tid, cplx (&v)[8]) {
    dft8<false>(v); twid<512, false>(v, tid); st8<512>(X, tid, v); FFT_SYNC();
    ld8<64>(X, tid, v); dft8<false>(v); twid<64, false>(v, tid); st8<64>(X, tid, v); FFT_SYNC();
    ld8<8>(X, tid, v); dft8<false>(v); twid<8, false>(v, tid); st8<8>(X, tid, v); FFT_SYNC();
    ld8<1>(X, tid, v); dft8<false>(v);
}
FFT_FN void fft_inv(fftbuf_t X, int tid, cplx (&v)[8]) {
    dft8<true>(v); st8<1>(X, tid, v); FFT_SYNC();
    ld8<8>(X, tid, v); twid<8, true>(v, tid); dft8<true>(v); st8<8>(X, tid, v); FFT_SYNC();
    ld8<64>(X, tid, v); twid<64, true>(v, tid); dft8<true>(v); st8<64>(X, tid, v); FFT_SYNC();
    ld8<512>(X, tid, v); twid<512, true>(v, tid); dft8<true>(v);
}
#endif

struct OneUnit { int pm, pn; bool on;
    __device__ __forceinline__ bool next(int i, pg8::Unit& u) const { if (!on || i > 0) return false; u.pm = pm; u.pn = pn; return true; }
    __device__ __forceinline__ void a_ready(const pg8::Unit&) const {}
    __device__ __forceinline__ void done(const pg8::Unit&) const {} };

struct EpiB {
    static constexpr bool PERM = true, AFTER_DRAIN = false;
    bf16_t* O; int ldc;
    __device__ __forceinline__ void operator()(const f32x4 (&acc)[2][2][4][2], const pg8::Unit& u, int wr, int wc, int fr, int fq) const {
        const int row0 = u.pm * 256 + wr * 64 + fr, col0 = u.pn * 256 + wc * 32 + 8 * fq;
#pragma unroll
        for (int ai = 0; ai < 2; ++ai)
#pragma unroll
            for (int m = 0; m < 4; ++m) { bf16_t* rowp = O + (size_t)(row0 + ai * 128 + m * 16) * ldc + col0;
#pragma unroll
                for (int bj = 0; bj < 2; ++bj) { const f32x4 v0 = acc[ai][bj][m][0], v1 = acc[ai][bj][m][1];
                    u32x4 w; w.x = pk2(v0[0], v0[1]); w.y = pk2(v0[2], v0[3]); w.z = pk2(v1[0], v1[1]); w.w = pk2(v1[2], v1[3]);
                    *(u32x4*)(rowp + bj * 128) = w; } }
    }
};
struct EpiRope {
    static constexpr bool PERM = true, AFTER_DRAIN = false;
    bf16_t* O; const float2* rope;
    __device__ __forceinline__ void operator()(const f32x4 (&acc)[2][2][4][2], const pg8::Unit& u, int wr, int wc, int fr, int fq) const {
        const int row0 = u.pm * 256 + wr * 64 + fr, col0 = u.pn * 256 + wc * 32 + 8 * fq;
        const bool rot = u.pn < 4;
#pragma unroll
        for (int ai = 0; ai < 2; ++ai)
#pragma unroll
            for (int m = 0; m < 4; ++m) { const int row = row0 + ai * 128 + m * 16; bf16_t* rowp = O + (size_t)row * MIXW + col0;
#pragma unroll
                for (int bj = 0; bj < 2; ++bj) { f32x4 v0 = acc[ai][bj][m][0], v1 = acc[ai][bj][m][1];
                    if (rot) { const int pos = row & (SEQ - 1), i0 = ((col0 + bj * 128) & 63) >> 1;
                        const f32x4* rp = (const f32x4*)(rope + pos * 32 + i0); const f32x4 r0 = rp[0], r1 = rp[1];
                        f32x4 o0, o1;
                        o0[0] = v0[0] * r0[0] - v0[1] * r0[1]; o0[1] = v0[1] * r0[0] + v0[0] * r0[1];
                        o0[2] = v0[2] * r0[2] - v0[3] * r0[3]; o0[3] = v0[3] * r0[2] + v0[2] * r0[3];
                        o1[0] = v1[0] * r1[0] - v1[1] * r1[1]; o1[1] = v1[1] * r1[0] + v1[0] * r1[1];
                        o1[2] = v1[2] * r1[2] - v1[3] * r1[3]; o1[3] = v1[3] * r1[2] + v1[2] * r1[3];
                        v0 = o0; v1 = o1; }
                    u32x4 w; w.x = pk2(v0[0], v0[1]); w.y = pk2(v0[2], v0[3]); w.z = pk2(v1[0], v1[1]); w.w = pk2(v1[2], v1[3]);
                    *(u32x4*)(rowp + bj * 128) = w; } }
    }
};
struct EpiRes {
    static constexpr bool PERM = false, AFTER_DRAIN = false;
    const float* X; float* O;
    __device__ __forceinline__ void operator()(const f32x4 (&acc)[2][2][4][2], const pg8::Unit& u, int wr, int wc, int fr, int fq) const {
        const int row0 = u.pm * 256 + wr * 64 + fr, col0 = u.pn * 256 + wc * 32 + 4 * fq;
#pragma unroll
        for (int ai = 0; ai < 2; ++ai)
#pragma unroll
            for (int m = 0; m < 4; ++m) { const size_t ro = (size_t)(row0 + ai * 128 + m * 16) * DM;
#pragma unroll
                for (int bj = 0; bj < 2; ++bj)
#pragma unroll
                    for (int n = 0; n < 2; ++n) { const int c = col0 + bj * 128 + 16 * n;
                        const f32x4 xv = *(const f32x4*)(X + ro + c); *(f32x4*)(O + ro + c) = acc[ai][bj][m][n] + xv * ALPHA; } }
    }
};
struct EpiRes2 {
    static constexpr bool PERM = false, AFTER_DRAIN = false;
    float* O; const float2* stat; const float* g; const float* b;
    __device__ __forceinline__ void operator()(const f32x4 (&acc)[2][2][4][2], const pg8::Unit& u, int wr, int wc, int fr, int fq) const {
        const int row0 = u.pm * 256 + wr * 64 + fr, col0 = u.pn * 256 + wc * 32 + 4 * fq;
#pragma unroll
        for (int bj = 0; bj < 2; ++bj)
#pragma unroll
            for (int n = 0; n < 2; ++n) { const int c = col0 + bj * 128 + 16 * n;
                const f32x4 gv = *(const f32x4*)(g + c), bv = *(const f32x4*)(b + c);
#pragma unroll
                for (int ai = 0; ai < 2; ++ai)
#pragma unroll
                    for (int m = 0; m < 4; ++m) { const int row = row0 + ai * 128 + m * 16; const float2 st = stat[row];
                        float* p = O + (size_t)row * DM + c; const f32x4 r1 = *(const f32x4*)p;
                        const f32x4 x1 = (r1 - st.x) * st.y * gv + bv; *(f32x4*)p = acc[ai][bj][m][n] + x1 * ALPHA; } }
    }
};

__device__ __forceinline__ int win_row(int n) {
    if (n < 1536) return 1536 + n;
    if (n < 2560) { const int q = n - 1536, blk = q >> 6, d = q & 63; return blk * 64 + 2 * (d & 31) + (d >> 5); }
    if (n < 3072) return 512 + n;
    return n - 2048;
}
template <int MODE> __device__ __forceinline__ void p0_transpose_item(const float* W, int K, int N, bf16_t* WT, LAS float* scr, int item, int lane) {
    const int nblk = N / 32, kb = item / nblk, nb = item % nblk, k0 = 64 * kb, n0 = 32 * nb;
#pragma unroll 8
    for (int i = 0; i < 32; ++i) { const int kk = 2 * i + (lane >> 5); scr[kk * 33 + (lane & 31)] = W[(size_t)(k0 + kk) * N + n0 + (lane & 31)]; }
    LDS_WAIT(); asm volatile("" ::: "memory");
    const int c = lane & 7;
#pragma unroll
    for (int j = 0; j < 4; ++j) { const int n = (lane >> 3) + 8 * j; const LAS float* s = scr + (8 * c) * 33 + n;
        u32x4 o; o.x = pk2(s[0 * 33], s[1 * 33]); o.y = pk2(s[2 * 33], s[3 * 33]); o.z = pk2(s[4 * 33], s[5 * 33]); o.w = pk2(s[6 * 33], s[7 * 33]);
        const int dr = (MODE == 1) ? win_row(n0 + n) : (n0 + n);
        *(u32x4*)(WT + (size_t)dr * K + k0 + 8 * c) = o; }
    LDS_WAIT(); asm volatile("" ::: "memory");
}
__device__ __forceinline__ void cvt_rows(const float* src, bf16_t* dst, size_t n8, int gw, int ngw, int lane) {
    for (size_t i = (size_t)gw * 64 + lane; i < n8; i += (size_t)ngw * 64) {
        const f32x4 a = ((const f32x4*)src)[2 * i], b = ((const f32x4*)src)[2 * i + 1];
        u32x4 w; w.x = pk2(a[0], a[1]); w.y = pk2(a[2], a[3]); w.z = pk2(b[0], b[1]); w.w = pk2(b[2], b[3]);
        ((u32x4*)dst)[i] = w; }
}
__device__ __forceinline__ void p0_filter_item(const float* w1, const float* b1, const float* fq, const float* w2, const float* b2, const float* w3, float* HTD, int item, int lane) {
    const int t0 = 2 * (item >> 2), ih = item & 3; float h2v[2], tl[2];
    const float fql = fq[lane], b1l = b1[lane], b2l = b2[lane];
#pragma unroll
    for (int tt = 0; tt < 2; ++tt) { const int t = t0 + tt; tl[tt] = (float)t * (1.0f / 2047.0f);
        const float w = 6.283185307179586f * (float)t / 2048.0f;
        float zk = 0.f;
        if (lane == 0) zk = tl[tt];
        else if (lane <= 16) { const float fr = 1e-4f + (float)(lane - 1) * ((15.0f - 1e-4f) / 15.0f); zk = cosf(fr * w); }
        else if (lane <= 32) { const float fr = 1e-4f + (float)(lane - 17) * ((15.0f - 1e-4f) / 15.0f); zk = -sinf(fr * w); }
        float a = b1l;
#pragma unroll 11
        for (int k = 0; k < 33; ++k) a += __shfl(zk, k) * w1[k * 64 + lane];
        const float h1 = sinf(fql * a);
        float a2 = b2l;
#pragma unroll 16
        for (int k = 0; k < 64; ++k) a2 += __shfl(h1, k) * w2[k * 64 + lane];
        h2v[tt] = sinf(fql * a2); }
    const float dmin = -15.350567286626973f, dmax = -3.0701134573253946f;
    float acc0[8], acc1[8];
#pragma unroll
    for (int i = 0; i < 8; ++i) { acc0[i] = 0.f; acc1[i] = 0.f; }
#pragma unroll 4
    for (int j = 0; j < 64; ++j) { const float s0 = __shfl(h2v[0], j), s1 = __shfl(h2v[1], j); const float* wr = w3 + (size_t)j * 2048 + ih * 512 + lane;
#pragma unroll
        for (int i = 0; i < 8; ++i) { const float wv = wr[64 * i]; acc0[i] += s0 * wv; acc1[i] += s1 * wv; } }
#pragma unroll
    for (int i = 0; i < 8; ++i) { const int col = ih * 512 + 64 * i + lane, c = col & 511;
        const float delta = fabsf(dmin + (float)c * ((dmax - dmin) / 511.0f));
        float2 o; o.x = acc0[i] * expf(-tl[0] * delta); o.y = acc1[i] * expf(-tl[1] * delta);
        *(float2*)(HTD + (size_t)col * 2048 + t0) = o; }
}
__device__ __forceinline__ void p0_prep(const float* const* in, unsigned char* ws, LAS unsigned char* lds, int tid) {
    const int lane = tid & 63, wave = tid >> 6, gw = blockIdx.x * NWAVE + wave, ngw = gridDim.x * NWAVE;
    LAS float* scr = (LAS float*)(lds + wave * 16384);
    bf16_t* WALL = (bf16_t*)(ws + WS_WALL);
    constexpr int I_IN = 16 * (INW / 32), I_KV = 16 * 32, I_OUT = 24 * 32, I_UP = 16 * (2 * DFF / 32), I_DN = (DFF / 64) * 32, NIT = I_IN + I_KV + I_OUT + I_UP + I_DN;
    for (int it = gw; it < NIT; it += ngw) { int r = it;
        if (r < I_IN) { p0_transpose_item<1>(in[2], DM, INW, WALL, scr, r, lane); continue; } r -= I_IN;
        if (r < I_KV) { p0_transpose_item<0>(in[14], DM, 1024, (bf16_t*)(ws + WS_WKV), scr, r, lane); continue; } r -= I_KV;
        if (r < I_OUT) { p0_transpose_item<0>(in[15], MIXW, DM, (bf16_t*)(ws + WS_WOUT), scr, r, lane); continue; } r -= I_OUT;
        if (r < I_UP) { p0_transpose_item<0>(in[18], DM, 2 * DFF, (bf16_t*)(ws + WS_WUP), scr, r, lane); continue; } r -= I_UP;
        p0_transpose_item<0>(in[21], DFF, DM, (bf16_t*)(ws + WS_WDN), scr, r, lane); }
    for (int it = ngw - 1 - gw; it < 4096; it += ngw) p0_filter_item(in[5], in[6], in[7], in[8], in[9], in[10], (float*)(ws + WS_HTD), it, lane);
    cvt_rows(in[0], (bf16_t*)(ws + WS_XB), (size_t)NT * DM / 8, gw, ngw, lane);
    cvt_rows(in[1], (bf16_t*)(ws + WS_MEMB), (size_t)NMT * DM / 8, gw, ngw, lane);
    float2* rope = (float2*)(ws + WS_ROPE);
    for (int i = blockIdx.x * NTHR + tid; i < SEQ * 32; i += gridDim.x * NTHR) { const int pos = i >> 5, f = i & 31;
        const float invf = powf(10000.0f, -(float)(2 * f) / 64.0f); const float ang = (float)pos * invf;
        float2 cs; cs.x = cosf(ang); cs.y = sinf(ang); rope[i] = cs; }
}

__device__ __forceinline__ void filter_fft_item(const float* HTD, float2* KF, LAS unsigned char* lds, int item, int tid) {
    const int o = item >> 9, c = item & 511;
    const float* rf = HTD + (size_t)((o * 2 + 0) * 512 + c) * 2048; const float* rb = HTD + (size_t)((o * 2 + 1) * 512 + c) * 2048;
    cplx v[8];
#pragma unroll
    for (int k = 0; k < 4; ++k) v[k] = mk2(rf[tid + 512 * k], 0.f);
    v[4] = mk2(tid == 0 ? 0.f : rb[2048 - tid], 0.f); v[5] = mk2(rb[1536 - tid], 0.f); v[6] = mk2(rb[1024 - tid], 0.f); v[7] = mk2(rb[512 - tid], 0.f);
    fft_fwd((LAS cplx*)lds, tid, v);
    float2* dst = KF + (size_t)(o * 512 + c) * 4096 + 8 * tid;
#pragma unroll
    for (int m = 0; m < 8; m += 2) { f32x4 w; w[0] = v[m].x * (1.f / 4096.f); w[1] = v[m].y * (1.f / 4096.f); w[2] = v[m + 1].x * (1.f / 4096.f); w[3] = v[m + 1].y * (1.f / 4096.f); *(f32x4*)(dst + m) = w; }
    __syncthreads();
}

__device__ __forceinline__ float conv3(const bf16_t* row, int n, float w0, float w1, float w2, float b) {
    float r = w1 * bf2f(row[n]) + b;
    if (n > 0) r += w0 * bf2f(row[n - 1]);
    if (n < SEQ - 1) r += w2 * bf2f(row[n + 1]);
    return r;
}
__device__ __forceinline__ void hyena_item(const bf16_t* HT, const float2* KF, const float* cw, const float* cb, const float* hb, bf16_t* MIX, LAS unsigned char* lds, int bp, int cgp, int tid0) {
    LAS cplx* X = (LAS cplx*)lds; LAS bf16_t* OT = (LAS bf16_t*)(lds + 36864);
    const int ba = 2 * bp;
#pragma unroll 1
    for (int cc = 0; cc < 8; ++cc) {
        const int c = cgp * 8 + cc;
        int tl_ = tid0; asm volatile("" : "+v"(tl_)); const int tid = tl_;
        const bf16_t* rv = HT + (size_t)c * NT + ba * SEQ; const bf16_t* r1 = HT + (size_t)(512 + c) * NT + ba * SEQ; const bf16_t* r2 = HT + (size_t)(1024 + c) * NT + ba * SEQ;
        cplx v[8]; float va[4], vb[4];
        { const float w0 = cw[c], w1 = cw[1536 + c], w2 = cw[3072 + c], b = cb[c];
#pragma unroll
          for (int k = 0; k < 4; ++k) { const int n = tid + 512 * k; va[k] = conv3(rv, n, w0, w1, w2, b); vb[k] = conv3(rv + SEQ, n, w0, w1, w2, b); v[k] = mk2(va[k], vb[k]); v[4 + k] = mk2(0.f, 0.f); } }
        fft_fwd(X, tid, v);
        { int t1_ = tid; asm volatile("" : "+v"(t1_)); const f32x4* kf = (const f32x4*)(KF + (size_t)c * 4096 + 8 * t1_);
#pragma unroll
          for (int m = 0; m < 8; m += 2) { const f32x4 w = kf[m >> 1]; v[m] = cmul(v[m], mk2(w[0], w[1])); v[m + 1] = cmul(v[m + 1], mk2(w[2], w[3])); } }
        fft_inv(X, tid, v);
        { int t2_ = tid; asm volatile("" : "+v"(t2_)); const float w0 = cw[512 + c], w1 = cw[1536 + 512 + c], w2 = cw[3072 + 512 + c], b = cb[512 + c], hb0 = hb[c];
#pragma unroll
          for (int k = 0; k < 4; ++k) { const int n = t2_ + 512 * k; const float xa = conv3(r1, n, w0, w1, w2, b), xb = conv3(r1 + SEQ, n, w0, w1, w2, b);
              va[k] = xa * (v[k].x + hb0 * va[k]); vb[k] = xb * (v[k].y + hb0 * vb[k]); v[k] = mk2(va[k], vb[k]); v[4 + k] = mk2(0.f, 0.f); } }
        fft_fwd(X, tid, v);
        { int t1_ = tid; asm volatile("" : "+v"(t1_)); const f32x4* kf = (const f32x4*)(KF + (size_t)(512 + c) * 4096 + 8 * t1_);
#pragma unroll
          for (int m = 0; m < 8; m += 2) { const f32x4 w = kf[m >> 1]; v[m] = cmul(v[m], mk2(w[0], w[1])); v[m + 1] = cmul(v[m + 1], mk2(w[2], w[3])); } }
        fft_inv(X, tid, v);
        { int t2_ = tid; asm volatile("" : "+v"(t2_)); const float w0 = cw[1024 + c], w1 = cw[1536 + 1024 + c], w2 = cw[3072 + 1024 + c], b = cb[1024 + c], hb1 = hb[512 + c];
#pragma unroll
          for (int k = 0; k < 4; ++k) { const int n = t2_ + 512 * k; const float xa = conv3(r2, n, w0, w1, w2, b), xb = conv3(r2 + SEQ, n, w0, w1, w2, b);
              const float oa = xa * (v[k].x + hb1 * va[k]), ob = xb * (v[k].y + hb1 * vb[k]);
              OT[n * 8 + cc] = (bf16_t)(pk2(oa, 0.f) & 0xffffu); OT[(SEQ + n) * 8 + cc] = (bf16_t)(pk2(ob, 0.f) & 0xffffu); } }
    }
    __syncthreads();
    int tw_ = tid0; asm volatile("" : "+v"(tw_)); const int tid = tw_;
#pragma unroll
    for (int i = 0; i < 8; ++i) { const int rowid = tid + 512 * i, bsel = rowid >> 11, n = rowid & (SEQ - 1);
        const u32x4 val = *(LAS u32x4*)(OT + rowid * 8);
        *(u32x4*)(MIX + (size_t)((ba + bsel) * SEQ + n) * MIXW + cgp * 8) = val; }
    __syncthreads();
}

constexpr int ATT_KP = 272, ATT_VP = 144, ATT_KB = 64 * ATT_KP, ATT_VB = 128 * ATT_VP, ATT_VOFF = 2 * ATT_KB;
template <int NC> __device__ __forceinline__ void attn_unit(LAS unsigned char* lds, const bf16_t* Qp, int ldq, const bf16_t* Kp, int ldk, const bf16_t* Vt, int ldv, int nkeys, float sl2,
                                                            bf16_t* Op, int ldo, float lam, const float* subg, int tid) {
    constexpr int NSTEP = (NC == 2) ? 4 : 8;
    const int lane = tid & 63, wave = tid >> 6, r = lane & 31, h = lane >> 5;
    const int qb = (NC == 2) ? (wave & 3) : wave, comp = (NC == 2) ? (wave >> 2) : 0, dbase = comp * 64;
    bf16x8 qf[NSTEP];
#pragma unroll
    for (int st = 0; st < NSTEP; ++st) qf[st] = *(const bf16x8*)(Qp + (size_t)(qb * 32 + r) * ldq + dbase + 16 * st + 8 * h);
    f32x16 o[4];
#pragma unroll
    for (int et = 0; et < 4; ++et)
#pragma unroll
        for (int i = 0; i < 16; ++i) o[et][i] = 0.f;
    float mold = -INFINITY, lsum = 0.f;
    const int kr0 = tid >> 4, kc = tid & 15, vr0 = tid >> 3, vc = tid & 7;
    const bf16_t* kg = Kp + (size_t)kr0 * ldk + kc * 8; const bf16_t* vg = Vt + (size_t)vr0 * ldv + vc * 8;
    const int kl = kr0 * ATT_KP + kc * 16, vl = ATT_VOFF + vr0 * ATT_VP + vc * 16;
    const int nt = nkeys / 64;
    u32x4 pk0, pk1, pv0, pv1;
    pk0 = *(const u32x4*)(kg); pk1 = *(const u32x4*)(kg + (size_t)32 * ldk); pv0 = *(const u32x4*)(vg); pv1 = *(const u32x4*)(vg + (size_t)64 * ldv);
    *(LAS u32x4*)(lds + kl) = pk0; *(LAS u32x4*)(lds + kl + 32 * ATT_KP) = pk1; *(LAS u32x4*)(lds + vl) = pv0; *(LAS u32x4*)(lds + vl + 64 * ATT_VP) = pv1;
    __syncthreads();
    for (int it = 0; it < nt; ++it) {
        const int cur = it & 1; const bool more = (it + 1 < nt);
        if (more) { const bf16_t* kg2 = kg + (size_t)(it + 1) * 64 * ldk; const bf16_t* vg2 = vg + (it + 1) * 64;
            pk0 = *(const u32x4*)(kg2); pk1 = *(const u32x4*)(kg2 + (size_t)32 * ldk); pv0 = *(const u32x4*)(vg2); pv1 = *(const u32x4*)(vg2 + (size_t)64 * ldv); }
        LAS unsigned char* Kb = lds + cur * ATT_KB; LAS unsigned char* Vb = lds + ATT_VOFF + cur * ATT_VB;
        f32x16 s[2];
#pragma unroll
        for (int kb = 0; kb < 2; ++kb) {
#pragma unroll
            for (int i = 0; i < 16; ++i) s[kb][i] = 0.f;
#pragma unroll
            for (int st = 0; st < NSTEP; ++st) { const bf16x8 a = *(const LAS bf16x8*)(Kb + (kb * 32 + r) * ATT_KP + (dbase + 16 * st + 8 * h) * 2);
                s[kb] = __builtin_amdgcn_mfma_f32_32x32x16_bf16(a, qf[st], s[kb], 0, 0, 0); } }
        float mx = s[0][0];
#pragma unroll
        for (int i = 1; i < 16; ++i) mx = fmaxf(mx, s[0][i]);
#pragma unroll
        for (int i = 0; i < 16; ++i) mx = fmaxf(mx, s[1][i]);
        mx = fmaxf(mx, __shfl_xor(mx, 32));
        const float mnew = fmaxf(mold, mx * sl2), alpha = __builtin_amdgcn_exp2f(mold - mnew); mold = mnew;
        float ps = 0.f;
#pragma unroll
        for (int kb = 0; kb < 2; ++kb)
#pragma unroll
            for (int i = 0; i < 16; ++i) { const float p = __builtin_amdgcn_exp2f(__builtin_fmaf(s[kb][i], sl2, -mnew)); s[kb][i] = p; ps += p; }
        lsum = lsum * alpha + ps;
#pragma unroll
        for (int et = 0; et < 4; ++et)
#pragma unroll
            for (int i = 0; i < 16; ++i) o[et][i] *= alpha;
#pragma unroll
        for (int kb = 0; kb < 2; ++kb)
#pragma unroll
            for (int s2 = 0; s2 < 2; ++s2) {
                u32x4 pw; pw.x = pk2(s[kb][8 * s2 + 0], s[kb][8 * s2 + 1]); pw.y = pk2(s[kb][8 * s2 + 2], s[kb][8 * s2 + 3]); pw.z = pk2(s[kb][8 * s2 + 4], s[kb][8 * s2 + 5]); pw.w = pk2(s[kb][8 * s2 + 6], s[kb][8 * s2 + 7]);
                const bf16x8 pf = __builtin_bit_cast(bf16x8, pw);
#pragma unroll
                for (int et = 0; et < 4; ++et) { const LAS unsigned char* vp = Vb + (et * 32 + r) * ATT_VP + (kb * 32 + 16 * s2 + 4 * h) * 2;
                    const u32x2 lo = *(const LAS u32x2*)vp, hi = *(const LAS u32x2*)(vp + 16);
                    u32x4 aw; aw.x = lo.x; aw.y = lo.y; aw.z = hi.x; aw.w = hi.y;
                    o[et] = __builtin_amdgcn_mfma_f32_32x32x16_bf16(__builtin_bit_cast(bf16x8, aw), pf, o[et], 0, 0, 0); } }
        if (more) { const int nb = cur ^ 1;
            *(LAS u32x4*)(lds + nb * ATT_KB + kl) = pk0; *(LAS u32x4*)(lds + nb * ATT_KB + kl + 32 * ATT_KP) = pk1;
            *(LAS u32x4*)(lds + nb * ATT_VB + vl) = pv0; *(LAS u32x4*)(lds + nb * ATT_VB + vl + 64 * ATT_VP) = pv1; }
        __syncthreads();
    }
    lsum += __shfl_xor(lsum, 32);
    const float inv = 1.0f / lsum;
    if (NC == 1) {
        bf16_t* orow = Op + (size_t)(qb * 32 + r) * ldo;
#pragma unroll
        for (int et = 0; et < 4; ++et)
#pragma unroll
            for (int g = 0; g < 4; ++g) { u32x2 w; w.x = pk2(o[et][4 * g] * inv, o[et][4 * g + 1] * inv); w.y = pk2(o[et][4 * g + 2] * inv, o[et][4 * g + 3] * inv);
                *(u32x2*)(orow + et * 32 + 8 * g + 4 * h) = w; }
    } else {
        LAS float* XL = (LAS float*)lds;
        if (comp == 1) {
#pragma unroll
            for (int et = 0; et < 4; ++et)
#pragma unroll
                for (int i = 0; i < 16; ++i) XL[(qb * 64 + et * 16 + i) * 64 + lane] = o[et][i] * inv;
        }
        __syncthreads();
        if (comp == 0) {
            float ss = 0.f;
#pragma unroll
            for (int et = 0; et < 4; ++et)
#pragma unroll
                for (int i = 0; i < 16; ++i) { const float ov = o[et][i] * inv - lam * XL[(qb * 64 + et * 16 + i) * 64 + lane]; o[et][i] = ov; ss += ov * ov; }
            ss += __shfl_xor(ss, 32);
            const float rs = rsqrtf(ss * (1.0f / 128.0f) + RMS_EPS) * 0.8f;
            bf16_t* orow = Op + (size_t)(qb * 32 + r) * ldo;
#pragma unroll
            for (int et = 0; et < 4; ++et)
#pragma unroll
                for (int g = 0; g < 4; ++g) { const int e = et * 32 + 8 * g + 4 * h; const f32x4 gv = *(const f32x4*)(subg + e);
                    u32x2 w; w.x = pk2(o[et][4 * g] * rs * gv[0], o[et][4 * g + 1] * rs * gv[1]); w.y = pk2(o[et][4 * g + 2] * rs * gv[2], o[et][4 * g + 3] * rs * gv[3]);
                    *(u32x2*)(orow + e) = w; }
        }
        __syncthreads();
    }
}

template <bool TO_BF16> __device__ __forceinline__ void ln_rows(float* io, bf16_t* ob, float2* stat, const float* g, const float* b, int tid) {
    const int lane = tid & 63, gw = blockIdx.x * NWAVE + (tid >> 6), ngw = gridDim.x * NWAVE;
    f32x4 gv[4], bv[4];
#pragma unroll
    for (int j = 0; j < 4; ++j) { gv[j] = ((const f32x4*)g)[lane + 64 * j]; bv[j] = ((const f32x4*)b)[lane + 64 * j]; }
    for (int row = gw; row < NT; row += ngw) {
        f32x4* xr = (f32x4*)(io + (size_t)row * DM) + lane; f32x4 v[4]; float s = 0.f;
#pragma unroll
        for (int j = 0; j < 4; ++j) { v[j] = xr[64 * j]; s += (v[j][0] + v[j][1]) + (v[j][2] + v[j][3]); }
#pragma unroll
        for (int o = 1; o < 64; o <<= 1) s += __shfl_xor(s, o);
        const float mean = s * (1.0f / DM); float s2 = 0.f;
#pragma unroll
        for (int j = 0; j < 4; ++j) { v[j] = v[j] - mean; s2 += (v[j][0] * v[j][0] + v[j][1] * v[j][1]) + (v[j][2] * v[j][2] + v[j][3] * v[j][3]); }
#pragma unroll
        for (int o = 1; o < 64; o <<= 1) s2 += __shfl_xor(s2, o);
        const float rstd = rsqrtf(s2 * (1.0f / DM) + LN_EPS);
        if (TO_BF16) {
            u32x2* o8 = (u32x2*)(ob + (size_t)row * DM) + lane;
#pragma unroll
            for (int j = 0; j < 4; ++j) { const f32x4 y = v[j] * rstd * gv[j] + bv[j]; u32x2 w; w.x = pk2(y[0], y[1]); w.y = pk2(y[2], y[3]); o8[64 * j] = w; }
            if (lane == 0) { float2 st; st.x = mean; st.y = rstd; stat[row] = st; }
        } else {
#pragma unroll
            for (int j = 0; j < 4; ++j) xr[64 * j] = v[j] * rstd * gv[j] + bv[j];
        }
    }
}

__device__ __forceinline__ void convgate_half(const bf16_t* HH, bf16_t* ACT, const float* cw, const float* cb, int half, int tid) {
    constexpr int NG = DFF / 8; const int total = (NT / 2) * NG;
    for (int idx = blockIdx.x * NTHR + tid; idx < total; idx += gridDim.x * NTHR) {
        const int rl = idx / NG, cg8 = idx - rl * NG, n0 = cg8 * 8, t = rl & (SEQ - 1);
        const bf16_t* hp = HH + (size_t)rl * (2 * DFF);
        float gsum[8], usum[8];
#pragma unroll
        for (int e = 0; e < 8; ++e) { gsum[e] = cb[n0 + e]; usum[e] = cb[DFF + n0 + e]; }
#pragma unroll
        for (int j = 0; j < 3; ++j) { const int tt = t + j - 1; if (tt < 0 || tt >= SEQ) continue;
            const u32x4 gq = *(const u32x4*)(hp + (ptrdiff_t)(j - 1) * (2 * DFF) + n0), uq = *(const u32x4*)(hp + (ptrdiff_t)(j - 1) * (2 * DFF) + DFF + n0);
            const float* wg = cw + (size_t)j * (2 * DFF) + n0; const float* wu = wg + DFF;
            const f32x4 wg0 = *(const f32x4*)wg, wg1 = *(const f32x4*)(wg + 4), wu0 = *(const f32x4*)wu, wu1 = *(const f32x4*)(wu + 4);
            gsum[0] += wg0[0] * lo2f(gq.x); gsum[1] += wg0[1] * hi2f(gq.x); gsum[2] += wg0[2] * lo2f(gq.y); gsum[3] += wg0[3] * hi2f(gq.y);
            gsum[4] += wg1[0] * lo2f(gq.z); gsum[5] += wg1[1] * hi2f(gq.z); gsum[6] += wg1[2] * lo2f(gq.w); gsum[7] += wg1[3] * hi2f(gq.w);
            usum[0] += wu0[0] * lo2f(uq.x); usum[1] += wu0[1] * hi2f(uq.x); usum[2] += wu0[2] * lo2f(uq.y); usum[3] += wu0[3] * hi2f(uq.y);
            usum[4] += wu1[0] * lo2f(uq.z); usum[5] += wu1[1] * hi2f(uq.z); usum[6] += wu1[2] * lo2f(uq.w); usum[7] += wu1[3] * hi2f(uq.w); }
        float a[8];
#pragma unroll
        for (int e = 0; e < 8; ++e) a[e] = gsum[e] / (1.0f + __expf(-gsum[e])) * usum[e];
        u32x4 w; w.x = pk2(a[0], a[1]); w.y = pk2(a[2], a[3]); w.z = pk2(a[4], a[5]); w.w = pk2(a[6], a[7]);
        *(u32x4*)(ACT + (size_t)(half * (NT / 2) + rl) * DFF + n0) = w;
    }
}

#define XB_TMO      128
#define XB_XCNT(j)  (256  + 64 * (j))
#define XB_XSUB(j)  (1280 + 64 * (j))
#define XB_XGEN(j)  (2304 + 64 * (j))
#define XB_TOP      3328
#define XB_TOPGEN   3392
#define XCD_BAR_WORDS 3456
#define XB_SPIN_CAP (1u << 18)

__device__ __forceinline__ unsigned xb_ld(unsigned* p)              { return __hip_atomic_load(p, __ATOMIC_RELAXED, __HIP_MEMORY_SCOPE_AGENT); }
__device__ __forceinline__ unsigned xb_add(unsigned* p, unsigned v) { return __hip_atomic_fetch_add(p, v, __ATOMIC_RELAXED, __HIP_MEMORY_SCOPE_AGENT); }
__device__ __forceinline__ unsigned xb_xcc_id() { return (unsigned)__builtin_amdgcn_s_getreg((3 << 11) | 20) & 0xFu; }
#define XB_SPIN(cond, bar) do { unsigned _sp = 0; while (cond) { __builtin_amdgcn_s_sleep(1); \
    if ((++_sp & 255u) == 0u) { if (xb_ld(&(bar)[XB_TMO])) break; if (_sp > XB_SPIN_CAP) { atomicAdd(&(bar)[XB_TMO], 1u); break; } } } } while (0)

struct XcdBarrier {
    unsigned* bar; unsigned x;
    volatile LAS unsigned* st;
};

__device__ __forceinline__ XcdBarrier xcd_barrier_post(unsigned* bar, volatile LAS unsigned* st) {
    XcdBarrier b; b.bar = bar; b.x = xb_xcc_id(); b.st = st;
    if (threadIdx.x == 0) (void)xb_add(&bar[XB_XCNT(b.x)], 1u);
    return b;
}
__device__ __forceinline__ void xcd_barrier_complete(unsigned* bar, unsigned x, unsigned& nloc, unsigned& nx) {
    const unsigned G = gridDim.x * gridDim.y * gridDim.z;
    unsigned sum, cnt, mine, sp = 0u;
    for (;;) {
        sum = 0u; cnt = 0u; mine = 0u;
#pragma unroll
        for (unsigned j = 0; j < 16; ++j) { const unsigned c = xb_ld(&bar[XB_XCNT(j)]); sum += c; cnt += (c > 0u) ? 1u : 0u; mine = (j == x) ? c : mine; }
        if (sum == G) break;
        __builtin_amdgcn_s_sleep(1);
        if ((++sp & 255u) == 0u) { if (xb_ld(&bar[XB_TMO])) break; if (sp > XB_SPIN_CAP) { atomicAdd(&bar[XB_TMO], 1u); break; } }
    }
    nloc = mine > 0u ? mine : 1u; nx = cnt > 0u ? cnt : 1u;
}

__device__ __forceinline__ void xcd_barrier(const XcdBarrier& b) {
    asm volatile("s_waitcnt vmcnt(0)" ::: "memory");
    __syncthreads();
    if (threadIdx.x == 0) {
        unsigned* bar = b.bar;
        __builtin_amdgcn_s_waitcnt(0);
        unsigned nloc = b.st[0], nx = b.st[1];
        if (nloc == 0u) { xcd_barrier_complete(bar, b.x, nloc, nx); b.st[0] = nloc; b.st[1] = nx; }
        const unsigned old = xb_add(&bar[XB_XSUB(b.x)], 1u);
        const unsigned gen = old / nloc;
        if (old + 1u == (gen + 1u) * nloc) {
            __builtin_amdgcn_fence(__ATOMIC_RELEASE, "agent");
            asm volatile("s_waitcnt vmcnt(0)" ::: "memory");
            const unsigned og = xb_add(&bar[XB_TOP], 1u);
            const unsigned tg = og / nx;
            if (og + 1u == (tg + 1u) * nx) xb_add(&bar[XB_TOPGEN], 1u);
            else XB_SPIN(xb_ld(&bar[XB_TOPGEN]) == tg, bar);
            __builtin_amdgcn_fence(__ATOMIC_ACQUIRE, "agent");
            xb_add(&bar[XB_XGEN(b.x)], 1u);
            asm volatile("s_waitcnt vmcnt(0)" ::: "memory");
        } else {
            XB_SPIN(xb_ld(&bar[XB_XGEN(b.x)]) == gen, bar);
            __builtin_amdgcn_fence(__ATOMIC_ACQUIRE, "agent");
            asm volatile("s_waitcnt vmcnt(0)" ::: "memory");
        }
    }
    __syncthreads();
}

#ifndef PH_MASK
#define PH_MASK 0xFFFFFF
#endif
#define PH(k) ((PH_MASK >> (k)) & 1)
#ifndef REP_P0
#define REP_P0 1
#endif
#ifndef REP_G1
#define REP_G1 1
#endif
#ifndef REP_DIFF
#define REP_DIFF 1
#endif
#ifndef REP_HY
#define REP_HY 1
#endif
#ifndef REP_MEM
#define REP_MEM 1
#endif
struct Args { const float* in[24]; float* out; unsigned char* ws; };
__global__ void __launch_bounds__(NTHR, 2) hybrid_fwd(Args a) {
    extern __shared__ __attribute__((aligned(16))) unsigned char smem[];
    LAS unsigned char* lds = (LAS unsigned char*)smem;
    cg::grid_group grid = cg::this_grid();
    volatile LAS unsigned* bst = (volatile LAS unsigned*)(lds + 131072 + 64);
    if (threadIdx.x < 2) bst[threadIdx.x] = 0u;
    __syncthreads();
    const XcdBarrier bar = xcd_barrier_post((unsigned*)(a.ws + WS_BAR), bst);
    const int G = gridDim.x;
#define NEWPHASE() int tid_ = threadIdx.x, cu_ = blockIdx.x; asm volatile("" : "+v"(tid_)); asm volatile("" : "+s"(cu_)); const int tid = tid_, cu = cu_; (void)tid; (void)cu;
    unsigned char* ws = a.ws;
    bf16_t* WALL = (bf16_t*)(ws + WS_WALL); bf16_t* XB = (bf16_t*)(ws + WS_XB); bf16_t* MEMB = (bf16_t*)(ws + WS_MEMB); bf16_t* WKV = (bf16_t*)(ws + WS_WKV);
    bf16_t* QKM = (bf16_t*)(ws + WS_QKM); bf16_t* HT = (bf16_t*)(ws + WS_HT); bf16_t* KMEM = (bf16_t*)(ws + WS_KMEM); bf16_t* VMT = (bf16_t*)(ws + WS_VMT);
    float2* KF = (float2*)(ws + WS_KF); bf16_t* MIX = (bf16_t*)(ws + WS_MIX); float2* STAT = (float2*)(ws + WS_STAT);
    bf16_t* X1B = (bf16_t*)(ws + WS_X1B); bf16_t* HH = (bf16_t*)(ws + WS_HH); bf16_t* ACT = (bf16_t*)(ws + WS_ACT);

    for (int rep = 0; rep < REP_P0; ++rep) { NEWPHASE(); if (PH(0)) p0_prep(a.in, ws, lds, tid); }
    grid.sync();

    for (int rep = 0; rep < REP_G1; ++rep) {
    if (PH(1)) { NEWPHASE(); pg8::Gemm g{XB, WALL, NT, 1536, DM}; pg8::StaticOrder S; S.init(g.M, g.N, G, cu);
      EpiRope E{QKM, (const float2*)(ws + WS_ROPE)};
      pg8::gemm_phase<EpiRope, pg8::StaticOrder, true, true>(lds, g, S, E); }
    if (PH(2)) { NEWPHASE(); pg8::Gemm g{WALL + (size_t)1536 * DM, XB, 2048, NT, DM}; pg8::StaticOrder S; S.init(g.M, g.N, G, cu);
      EpiB E{HT, NT};
      pg8::gemm_phase<EpiB, pg8::StaticOrder, true, true>(lds, g, S, E); }
    }
    if (PH(3)) { NEWPHASE(); const bool isK = cu < 32, on = cu < 64; const int c2 = cu - 32;
      pg8::Gemm g; EpiB E; OneUnit S;
      if (isK) { g = pg8::Gemm{MEMB, WKV, NMT, 512, DM}; E = EpiB{KMEM, 512}; S = OneUnit{cu >> 1, cu & 1, on}; }
      else { g = pg8::Gemm{WKV + (size_t)512 * DM, MEMB, 512, NMT, DM}; E = EpiB{VMT, NMT}; S = OneUnit{(c2 >> 4) & 1, c2 & 15, on}; }
      pg8::gemm_phase<EpiB, OneUnit, false, true>(lds, g, S, E);
      __syncthreads();
      if (!on) for (int it = cu - 64; it < 1024; it += G - 64) filter_fft_item((const float*)(ws + WS_HTD), KF, lds, it, tid); }
    xcd_barrier(bar);

    { NEWPHASE(); const int xcd = cu & 7, j = cu >> 3;
      float lam;
      { const float* lp = a.in[12]; const int l6 = tid & 63; float s01 = lp[l6] * lp[64 + l6], s23 = lp[128 + l6] * lp[192 + l6];
#pragma unroll
        for (int o = 1; o < 64; o <<= 1) { s01 += __shfl_xor(s01, o); s23 += __shfl_xor(s23, o); }
        lam = expf(s01) - expf(s23) + 0.2f; }
      if (PH(4)) for (int i = 0; i < 4 * REP_DIFF; ++i) {
          const int bh = ((i & 3) * 8 + xcd) * 2 + (j >> 4), qblk = j & 15, b = bh >> 2, hd = bh & 3;
          const size_t tok0 = (size_t)b * SEQ;
          attn_unit<2>(lds, QKM + (tok0 + qblk * 128) * MIXW + hd * 128, MIXW, QKM + tok0 * MIXW + 512 + hd * 128, MIXW,
                       HT + (size_t)(1536 + hd * 128) * NT + tok0, NT, SEQ, 0.125f * 1.4426950408889634f,
                       MIX + (tok0 + qblk * 128) * MIXW + 512 + hd * 128, MIXW, lam, a.in[13], tid); }
      if (PH(5)) for (int i = 0; i < 2 * REP_MEM; ++i) {
          const int bh = ((i & 1) * 8 + xcd) * 4 + (j >> 3), qblk = j & 7, b = bh >> 2, hd = bh & 3;
          const size_t tok0 = (size_t)b * SEQ;
          attn_unit<1>(lds, QKM + (tok0 + qblk * 256) * MIXW + 1024 + hd * 128, MIXW, KMEM + (size_t)b * MEMT * 512 + hd * 128, 512,
                       VMT + (size_t)(hd * 128) * NMT + b * MEMT, NMT, MEMT, 0.08838834764831845f * 1.4426950408889634f,
                       MIX + (tok0 + qblk * 256) * MIXW + 1024 + hd * 128, MIXW, 0.f, nullptr, tid); }
      if (PH(6)) for (int i = 0; i < 2 * REP_HY; ++i) {
          const int cgp = ((i & 1) * 8 + xcd) * 4 + (j >> 3), bp = j & 7;
          hyena_item(HT, KF, a.in[3], a.in[4], a.in[11], MIX, lds, bp, cgp, tid); } }
    xcd_barrier(bar);

#ifdef REP_SYNC
    for (int rep = 0; rep < REP_SYNC; ++rep) xcd_barrier(bar);
#endif
    if (PH(7)) { NEWPHASE(); pg8::Gemm g{MIX, (const bf16_t*)(ws + WS_WOUT), NT, DM, MIXW}; pg8::StaticOrder S; S.init(g.M, g.N, G, cu);
      EpiRes E{a.in[0], a.out};
      pg8::gemm_phase<EpiRes, pg8::StaticOrder, true, true>(lds, g, S, E); }
    xcd_barrier(bar);
    if (PH(8)) { NEWPHASE(); ln_rows<true>(a.out, X1B, STAT, a.in[16], a.in[17], tid); }
    xcd_barrier(bar);
    for (int half = 0; half < 2; ++half) {
        if (PH(9)) { NEWPHASE(); pg8::Gemm g{X1B + (size_t)half * (NT / 2) * DM, (const bf16_t*)(ws + WS_WUP), NT / 2, 2 * DFF, DM}; pg8::StaticOrder S; S.init(g.M, g.N, G, cu);
          EpiB E{HH, 2 * DFF};
          pg8::gemm_phase<EpiB, pg8::StaticOrder, true, true>(lds, g, S, E); }
        xcd_barrier(bar);
        if (PH(10)) { NEWPHASE(); convgate_half(HH, ACT, a.in[19], a.in[20], half, tid); }
        xcd_barrier(bar);
    }
    if (PH(11)) { NEWPHASE(); pg8::Gemm g{ACT, (const bf16_t*)(ws + WS_WDN), NT, DM, DFF}; pg8::StaticOrder S; S.init(g.M, g.N, G, cu);
      EpiRes2 E{a.out, STAT, a.in[16], a.in[17]};
      pg8::gemm_phase<EpiRes2, pg8::StaticOrder, true, true>(lds, g, S, E); }
    xcd_barrier(bar);
    if (PH(12)) { NEWPHASE(); ln_rows<false>(a.out, nullptr, nullptr, a.in[22], a.in[23], tid); }
}

extern "C" void kernel_launch(void* const* d_in, const int* in_sizes, int n_in, void* d_out, int out_size, void* d_ws, size_t ws_size, hipStream_t stream) {
    static int grid = 0;
    if (grid == 0) {
        if (n_in != 24 || out_size != NT * DM || ws_size < WS_END) { fprintf(stderr, "kernel_launch: unexpected shapes (n_in %d, out %d, ws %zu)\n", n_in, out_size, ws_size); grid = -1; return; }
        int dev = 0, cus = 0, per_cu = 0;
        hipGetDevice(&dev); hipDeviceGetAttribute(&cus, hipDeviceAttributeMultiprocessorCount, dev);
        if (hipFuncSetAttribute((const void*)hybrid_fwd, hipFuncAttributeMaxDynamicSharedMemorySize, LDS_BYTES) != hipSuccess) { fprintf(stderr, "kernel_launch: hipFuncSetAttribute failed\n"); grid = -1; return; }
        if (hipOccupancyMaxActiveBlocksPerMultiprocessor(&per_cu, (const void*)hybrid_fwd, NTHR, LDS_BYTES) != hipSuccess || per_cu < 1) { fprintf(stderr, "kernel_launch: occupancy query says %d\n", per_cu); per_cu = 1; }
        (void)hipGetLastError();
        grid = cus * per_cu;
        fprintf(stderr, "kernel_launch: grid %d (cus %d x %d)\n", grid, cus, per_cu);
    }
    if (grid < 0) return;
    if (hipMemsetAsync((char*)d_ws + WS_BAR, 0, XCD_BAR_WORDS * 4, stream) != hipSuccess) { fprintf(stderr, "kernel_launch: memset failed\n"); return; }
    Args a{};
    for (int i = 0; i < 24; ++i) a.in[i] = (const float*)d_in[i];
    a.out = (float*)d_out; a.ws = (unsigned char*)d_ws;
    void* args[] = {&a};
    const hipError_t e = hipLaunchCooperativeKernel((const void*)hybrid_fwd, dim3(grid), dim3(NTHR), args, LDS_BYTES, stream);
    if (e != hipSuccess) fprintf(stderr, "kernel_launch: cooperative launch failed: %s (grid %d)\n", hipGetErrorString(e), grid);
}
```

```cpp
#include <hip/hip_runtime.h>
#include <hip/hip_cooperative_groups.h>
#include <cstdio>
#include <cstdint>
namespace cg = cooperative_groups;
#define LAS __attribute__((address_space(3)))
namespace pg8 {
#define PG8_LAS __attribute__((address_space(3)))
typedef unsigned short bf16_t;
typedef short bf16x8 __attribute__((ext_vector_type(8)));
typedef float f32x4 __attribute__((ext_vector_type(4)));
typedef unsigned u32x4 __attribute__((ext_vector_type(4)));
constexpr int BM = 256, BK = 64, HALF = 128, HTB = HALF * BK * 2  , STAGE_BYTES = 8 * HTB, NXCD = 8, WGM = 8;

__host__ __device__ __forceinline__ int lds_byte(int r, int c) { const int st = (r >> 4) * 2 + (c >> 5), rr = r & 15, cc = c & 31, ob = rr * 64 + cc * 2; return st * 1024 + (ob ^ (((ob >> 9) & 1) << 5)); }
__host__ __device__ __forceinline__ void stage_rc(int b, int& R, int& C) { const int st = b / 1024, sb = b % 1024, swz = sb ^ (((sb >> 9) & 1) << 5); R = (st >> 1) * 16 + swz / 64; C = (st & 1) * 32 + (swz % 64) / 2; }
__host__ __device__ __forceinline__ int perm32(int rho) { const int n = rho >> 4, i = rho & 15; return 8 * (i >> 2) + 4 * n + (i & 3); }

struct Unit { int pm, pn; };
struct Gemm { const bf16_t* A; const bf16_t* Bt; int M, N, K; };

struct StaticOrder {
    int nM, nN, nwg, G, c;
    __host__ __device__ void init(int M, int N, int G_, int c_) { nM = M / BM; nN = N / BM; nwg = nM * nN; G = G_; c = c_; }
    __host__ __device__ bool next(int i, Unit& u) const {
        const long L = (long)i * G + c; if (L >= nwg) return false;
        int wgid = (int)L; { const int q = nwg / NXCD, r = nwg % NXCD, xcd = wgid % NXCD, off = wgid / NXCD; wgid = (xcd < r ? xcd * (q + 1) : r * (q + 1) + (xcd - r) * q) + off; }
        const int nig = WGM * nN, gid = wgid / nig, fm = gid * WGM, gsz = (nM - fm) < WGM ? (nM - fm) : WGM;
        u.pm = fm + ((wgid % nig) % gsz); u.pn = (wgid % nig) / gsz; return true;
    }
    __device__ __forceinline__ void a_ready(const Unit&) const {}
    __device__ __forceinline__ void done(const Unit&) const {}
    __device__ __forceinline__ long a_off(const Unit& u, size_t tstep) const { return (long)((size_t)u.pm * tstep); }
};
template <class Epi, class Sched, bool ALIGN_EPI = false, bool SP2 = false>
__device__ __forceinline__ void gemm_phase(PG8_LAS unsigned char* lds, const Gemm g, const Sched& S, const Epi& E) {
    int tid_l = threadIdx.x; asm volatile("" : "+v"(tid_l)); const int tid = tid_l, wid = __builtin_amdgcn_readfirstlane(tid >> 6), lane = tid & 63, wr = wid >> 2, wc = wid & 3, fr = lane & 15, fq = lane >> 4;
    const int K = g.K, nt = K / BK;
    unsigned voffA[2], voffB[2];
#pragma unroll
    for (int i = 0; i < 2; ++i) { int R, C; stage_rc(tid * 16 + i * 8192, R, C); const int Rb = Epi::PERM ? ((R & ~31) + perm32(R & 31)) : R;
        voffA[i] = (unsigned)(R * K + C) * 2u; voffB[i] = (unsigned)(Rb * K + C) * 2u; }
    const size_t kstep = (size_t)(BK * 2);
    const size_t hstep = (size_t)HALF * K * 2;
    const size_t tstep = 2 * hstep;
    const unsigned ldsw = (unsigned)wid * 1024u;
    const int aoff = lds_byte(wr * 64 + fr, fq * 8), boff = lds_byte(wc * 32 + fr, fq * 8);
#define PG8_SA(b, h) (((b) * 2 + (h)) * HTB)
#define PG8_SB(b, h) ((4 + (b) * 2 + (h)) * HTB)
#define PG8_STAGE(bufoff, gbase, voff) do { _Pragma("unroll") for (int _i = 0; _i < 2; ++_i) \
        __builtin_amdgcn_global_load_lds((const unsigned*)((const char*)(gbase) + (voff)[_i]), (PG8_LAS unsigned*)(lds + (bufoff) + ldsw + _i * 8192), 16, 0, 0); } while (0)
#define PG8_LDA(dst, b, h) do { _Pragma("unroll") for (int m = 0; m < 4; ++m) _Pragma("unroll") for (int k = 0; k < 2; ++k) dst[m][k] = *(const PG8_LAS bf16x8*)(lds + PG8_SA(b, h) + aoff + m * 2048 + k * 1024); } while (0)
#define PG8_LDB(dst, b, h) do { _Pragma("unroll") for (int n = 0; n < 2; ++n) _Pragma("unroll") for (int k = 0; k < 2; ++k) dst[n][k] = *(const PG8_LAS bf16x8*)(lds + PG8_SB(b, h) + boff + n * 2048 + k * 1024); } while (0)
#define PG8_MMA(ai, bj, At, Bt) do { __builtin_amdgcn_s_setprio(1); _Pragma("unroll") for (int m = 0; m < 4; ++m) _Pragma("unroll") for (int n = 0; n < 2; ++n) _Pragma("unroll") for (int k = 0; k < 2; ++k) \
        acc[ai][bj][m][n] = __builtin_amdgcn_mfma_f32_16x16x32_bf16(Bt[n][k], At[m][k], acc[ai][bj][m][n], 0, 0, 0); __builtin_amdgcn_s_setprio(0); } while (0)
#define PG8_WAIT_V(n) asm volatile("s_waitcnt vmcnt(" #n ")" ::: "memory")
#define PG8_WAIT_L(n) asm volatile("s_waitcnt lgkmcnt(" #n ")" ::: "memory")
#define PG8_BAR __builtin_amdgcn_s_barrier()
#define PG8_SCHED __builtin_amdgcn_sched_barrier(0)
    Unit cur, nxt; int ui = 0;
    if (!S.next(0, cur)) return;
    f32x4 acc[2][2][4][2];
#pragma unroll
    for (int a = 0; a < 2; ++a)
#pragma unroll
        for (int b = 0; b < 2; ++b)
#pragma unroll
            for (int m = 0; m < 4; ++m)
#pragma unroll
                for (int n = 0; n < 2; ++n) acc[a][b][m][n] = (f32x4){0.f, 0.f, 0.f, 0.f};
    bf16x8 At[4][2], B0[2][2], B1[2][2];
    const char* cA = (const char*)g.A + S.a_off(cur, tstep); const char* cB = (const char*)g.Bt + (size_t)cur.pn * tstep;
    S.a_ready(cur);
    if constexpr (SP2) {
        PG8_STAGE(PG8_SB(0, 0), cB, voffB); PG8_STAGE(PG8_SB(0, 1), cB + hstep, voffB); PG8_STAGE(PG8_SA(0, 0), cA, voffA); PG8_STAGE(PG8_SA(0, 1), cA + hstep, voffA);
        if (wr == 1) PG8_BAR;
        PG8_WAIT_V(2); PG8_BAR;
        PG8_STAGE(PG8_SB(1, 0), cB + kstep, voffB); PG8_STAGE(PG8_SA(1, 0), cA + kstep, voffA); PG8_STAGE(PG8_SB(1, 1), cB + hstep + kstep, voffB);
        PG8_WAIT_V(6); PG8_BAR;
    } else {
        PG8_STAGE(PG8_SB(0, 0), cB, voffB); PG8_STAGE(PG8_SA(0, 0), cA, voffA); PG8_STAGE(PG8_SB(0, 1), cB + hstep, voffB); PG8_STAGE(PG8_SA(0, 1), cA + hstep, voffA);
        if (wr == 1) PG8_BAR;
        PG8_WAIT_V(4); PG8_BAR;
        PG8_STAGE(PG8_SB(1, 0), cB + kstep, voffB); PG8_STAGE(PG8_SA(1, 0), cA + kstep, voffA); PG8_STAGE(PG8_SB(1, 1), cB + hstep + kstep, voffB);
        PG8_WAIT_V(6); PG8_BAR;
    }
    for (;;) {
        const bool has_next = S.next(ui + 1, nxt);
        const char* nA = has_next ? (const char*)g.A + S.a_off(nxt, tstep) : cA; const char* nB = has_next ? (const char*)g.Bt + (size_t)nxt.pn * tstep : cB;
        for (int t = 0; t < nt; t += 2) {
            const bool last = (t == nt - 2);
            const char* a1 = cA + (size_t)(t + 1) * kstep;
            const char* a2 = last ? nA : cA + (size_t)(t + 2) * kstep; const char* b2 = last ? nB : cB + (size_t)(t + 2) * kstep;
            const char* a3 = a2 + kstep; const char* b3 = b2 + kstep;
            if (last && has_next) S.a_ready(nxt);
            if constexpr (SP2) {
            PG8_LDB(B0, 0, 0); PG8_LDB(B1, 0, 1); PG8_SCHED; PG8_LDA(At, 0, 0); PG8_STAGE(PG8_SA(1, 1), a1 + hstep, voffA);
            PG8_WAIT_V(8); PG8_WAIT_L(0); PG8_BAR; PG8_MMA(0, 0, At, B0); PG8_MMA(0, 1, At, B1); PG8_BAR; PG8_SCHED;
            PG8_LDA(At, 0, 1); PG8_STAGE(PG8_SB(0, 0), b2, voffB); PG8_STAGE(PG8_SB(0, 1), b2 + hstep, voffB); PG8_STAGE(PG8_SA(0, 0), a2, voffA);
            PG8_WAIT_V(8); PG8_WAIT_L(0); PG8_BAR; PG8_MMA(1, 0, At, B0); PG8_MMA(1, 1, At, B1); PG8_BAR; PG8_SCHED;
            PG8_LDB(B0, 1, 0); PG8_LDB(B1, 1, 1); PG8_SCHED; PG8_LDA(At, 1, 0); PG8_STAGE(PG8_SA(0, 1), a2 + hstep, voffA);
            PG8_WAIT_V(8); PG8_WAIT_L(0); PG8_BAR; PG8_MMA(0, 0, At, B0); PG8_MMA(0, 1, At, B1); PG8_BAR; PG8_SCHED;
            PG8_LDA(At, 1, 1); PG8_STAGE(PG8_SB(1, 0), b3, voffB); PG8_STAGE(PG8_SB(1, 1), b3 + hstep, voffB); PG8_STAGE(PG8_SA(1, 0), a3, voffA);
            PG8_WAIT_V(8); PG8_WAIT_L(0); PG8_BAR; PG8_MMA(1, 0, At, B0); PG8_MMA(1, 1, At, B1); PG8_BAR; PG8_SCHED;
            } else {
            PG8_LDB(B0, 0, 0); PG8_SCHED; PG8_LDA(At, 0, 0); PG8_STAGE(PG8_SA(1, 1), a1 + hstep, voffA);
            PG8_WAIT_L(8); PG8_BAR; PG8_WAIT_L(0); PG8_MMA(0, 0, At, B0); PG8_BAR; PG8_SCHED;
            PG8_LDB(B1, 0, 1); PG8_STAGE(PG8_SB(0, 0), b2, voffB);
            PG8_BAR; PG8_WAIT_L(0); PG8_MMA(0, 1, At, B1); PG8_BAR;
            PG8_LDA(At, 0, 1); PG8_STAGE(PG8_SA(0, 0), a2, voffA);
            PG8_BAR; PG8_WAIT_L(0); PG8_MMA(1, 0, At, B0); PG8_BAR; PG8_SCHED;
            PG8_STAGE(PG8_SB(0, 1), b2 + hstep, voffB);
            PG8_WAIT_V(6); PG8_BAR; PG8_MMA(1, 1, At, B1); PG8_BAR;
            PG8_LDB(B0, 1, 0); PG8_SCHED; PG8_LDA(At, 1, 0); PG8_STAGE(PG8_SA(0, 1), a2 + hstep, voffA);
            PG8_WAIT_L(8); PG8_BAR; PG8_WAIT_L(0); PG8_MMA(0, 0, At, B0); PG8_BAR; PG8_SCHED;
            PG8_LDB(B1, 1, 1); PG8_STAGE(PG8_SB(1, 0), b3, voffB);
            PG8_BAR; PG8_WAIT_L(0); PG8_MMA(0, 1, At, B1); PG8_BAR;
            PG8_LDA(At, 1, 1); PG8_STAGE(PG8_SA(1, 0), a3, voffA);
            PG8_BAR; PG8_WAIT_L(0); PG8_MMA(1, 0, At, B0); PG8_BAR; PG8_SCHED;
            PG8_STAGE(PG8_SB(1, 1), b3 + hstep, voffB);
            PG8_WAIT_V(6); PG8_BAR; PG8_MMA(1, 1, At, B1); PG8_BAR;
            }
        }
        if constexpr (ALIGN_EPI) { if (wr == 0) PG8_BAR; }
        if constexpr (!Epi::AFTER_DRAIN) { E(acc, cur, wr, wc, fr, fq); S.done(cur); }
        if (!has_next) break;
#pragma unroll
        for (int a = 0; a < 2; ++a)
#pragma unroll
            for (int b = 0; b < 2; ++b)
#pragma unroll
                for (int m = 0; m < 4; ++m)
#pragma unroll
                    for (int n = 0; n < 2; ++n) acc[a][b][m][n] = (f32x4){0.f, 0.f, 0.f, 0.f};
        cur = nxt; cA = nA; cB = nB; ++ui;
        if constexpr (ALIGN_EPI) { if (wr == 1) PG8_BAR; }
    }
    PG8_WAIT_V(0);
    if constexpr (!ALIGN_EPI) { if (wr == 0) PG8_BAR; }
    PG8_BAR;
    if constexpr (Epi::AFTER_DRAIN) { E.fused(acc, cur, wr, wc, fr, fq, lds, wid, lane); S.done(cur); }
#undef PG8_SA
#undef PG8_SB
#undef PG8_STAGE
#undef PG8_LDA
#undef PG8_LDB
#undef PG8_MMA
#undef PG8_WAIT_V
#undef PG8_WAIT_L
#undef PG8_BAR
#undef PG8_SCHED
}
}

using pg8::bf16_t; using pg8::bf16x8; using pg8::f32x4; using pg8::u32x4;
typedef float f32x16 __attribute__((ext_vector_type(16)));
typedef unsigned u32x2 __attribute__((ext_vector_type(2)));
typedef short bf16x4 __attribute__((ext_vector_type(4)));

constexpr int NB = 16, SEQ = 2048, DM = 1024, NT = NB * SEQ, MEMT = 256, NMT = NB * MEMT, HW = 512, INW = 3584, DFF = 2816, MIXW = 1536;
constexpr float ALPHA = 1.189207115002721f;
constexpr float LN_EPS = 1e-5f, RMS_EPS = 1e-5f;
constexpr int NTHR = 512, NWAVE = 8;
constexpr int LDS_BYTES = 143360;

constexpr size_t MiB = 1048576;
constexpr size_t WS_WALL = 0;
constexpr size_t WS_WKV  = 7 * MiB;
constexpr size_t WS_WOUT = 9 * MiB;
constexpr size_t WS_WUP  = 12 * MiB;
constexpr size_t WS_WDN  = 23 * MiB;
constexpr size_t WS_ROPE = 29 * MiB;
constexpr size_t WS_STAT = 29 * MiB + 524288;
constexpr size_t WS_XB   = 30 * MiB;
constexpr size_t WS_X1B  = 30 * MiB;
constexpr size_t WS_HTD  = 94 * MiB;
constexpr size_t WS_MEMB = 110 * MiB;
constexpr size_t WS_QKM  = 118 * MiB;
constexpr size_t WS_HT   = 214 * MiB;
constexpr size_t WS_KMEM = 342 * MiB;
constexpr size_t WS_VMT  = 346 * MiB;
constexpr size_t WS_KF   = 350 * MiB;
constexpr size_t WS_MIX  = 382 * MiB;
constexpr size_t WS_HH   = 96 * MiB;
constexpr size_t WS_ACT  = 272 * MiB;
constexpr size_t WS_BAR  = 478 * MiB;
constexpr size_t WS_END  = 478 * MiB + 65536;

__device__ __forceinline__ unsigned pk2(float lo, float hi) { unsigned r; asm volatile("v_cvt_pk_bf16_f32 %0, %1, %2" : "=v"(r) : "v"(lo), "v"(hi)); return r; }
__device__ __forceinline__ float bf2f(bf16_t v) { return __uint_as_float((unsigned)v << 16); }
__device__ __forceinline__ float lo2f(unsigned v) { return __uint_as_float(v << 16); }
__device__ __forceinline__ float hi2f(unsigned v) { return __uint_as_float(v & 0xffff0000u); }
#define LDS_WAIT() asm volatile("s_waitcnt lgkmcnt(0)" ::: "memory")

#ifndef FFT_HOST
#define FFT_FN __device__ __forceinline__
#define FFT_SYNC() __syncthreads()
typedef float cplx __attribute__((ext_vector_type(2)));
typedef LAS cplx* fftbuf_t;
FFT_FN float cos2pi(float r) { return __builtin_amdgcn_cosf(r); }
FFT_FN float sin2pi(float r) { return __builtin_amdgcn_sinf(r); }
#endif
FFT_FN cplx mk2(float x, float y) { cplx r; r.x = x; r.y = y; return r; }
FFT_FN cplx cadd(cplx a, cplx b) { return mk2(a.x + b.x, a.y + b.y); }
FFT_FN cplx csub(cplx a, cplx b) { return mk2(a.x - b.x, a.y - b.y); }
FFT_FN cplx cmul(cplx a, cplx b) { return mk2(a.x * b.x - a.y * b.y, a.x * b.y + a.y * b.x); }
template <bool INV> FFT_FN cplx muli(cplx a) { return INV ? mk2(-a.y, a.x) : mk2(a.y, -a.x); }
FFT_FN int padi(int i) { return i + (i >> 3); }

template <bool INV> FFT_FN void dft8(cplx (&v)[8]) {
    const float R = 0.70710678118654752f;
    const cplx a0 = cadd(v[0], v[4]), a1 = csub(v[0], v[4]), a2 = cadd(v[2], v[6]), a3 = muli<INV>(csub(v[2], v[6]));
    const cplx a4 = cadd(v[1], v[5]), a5 = csub(v[1], v[5]), a6 = cadd(v[3], v[7]), a7 = muli<INV>(csub(v[3], v[7]));
    const cplx b0 = cadd(a0, a2), b2 = csub(a0, a2), b1 = cadd(a1, a3), b3 = csub(a1, a3);
    const cplx b4 = cadd(a4, a6), b6 = muli<INV>(csub(a4, a6));
    const cplx t5 = cadd(a5, a7), t7 = csub(a5, a7);
    cplx b5, b7;
    if (!INV) { b5 = mk2((t5.x + t5.y) * R, (t5.y - t5.x) * R); b7 = mk2((t7.y - t7.x) * R, -(t7.x + t7.y) * R); }
    else      { b5 = mk2((t5.x - t5.y) * R, (t5.x + t5.y) * R); b7 = mk2(-(t7.x + t7.y) * R, (t7.x - t7.y) * R); }
    v[0] = cadd(b0, b4); v[4] = csub(b0, b4); v[1] = cadd(b1, b5); v[5] = csub(b1, b5);
    v[2] = cadd(b2, b6); v[6] = csub(b2, b6); v[3] = cadd(b3, b7); v[7] = csub(b3, b7);
}
template <int S, bool INV> FFT_FN void twid(cplx (&v)[8], int tid) {
    if (S > 1) {
        const int j = tid % S; const float rev = (float)j * (1.0f / (8.0f * S));
        const float c = cos2pi(rev), s = sin2pi(rev);
        const cplx w1 = mk2(c, INV ? s : -s);
        const cplx w2 = cmul(w1, w1), w3 = cmul(w2, w1), w4 = cmul(w2, w2), w5 = cmul(w4, w1), w6 = cmul(w4, w2), w7 = cmul(w4, w3);
        v[1] = cmul(v[1], w1); v[2] = cmul(v[2], w2); v[3] = cmul(v[3], w3); v[4] = cmul(v[4], w4);
        v[5] = cmul(v[5], w5); v[6] = cmul(v[6], w6); v[7] = cmul(v[7], w7);
    }
}
template <int S> FFT_FN void ld8(fftbuf_t X, int tid, cplx (&v)[8]) {
    const int base = (tid / S) * 8 * S + (tid % S);
#pragma unroll
    for (int k = 0; k < 8; ++k) v[k] = X[padi(base + S * k)];
}
template <int S> FFT_FN void st8(fftbuf_t X, int tid, const cplx (&v)[8]) {
    const int base = (tid / S) * 8 * S + (tid % S);
#pragma unroll
    for (int k = 0; k < 8; ++k) X[padi(base + S * k)] = v[k];
}
#ifndef FFT_HOST
FFT_FN void fft_fwd(fftbuf_t X, int tid, cplx (&v)[8]) {
    dft8<false>(v); twid<512, false>(v, tid); st8<512>(X, tid, v); FFT_SYNC();
    ld8<64>(X, tid, v); dft8<false>(v); twid<64, false>(v, tid); st8<64>(X, tid, v); FFT_SYNC();
    ld8<8>(X, tid, v); dft8<false>(v); twid<8, false>(v, tid); st8<8>(X, tid, v); FFT_SYNC();
    ld8<1>(X, tid, v); dft8<false>(v);
}
FFT_FN void fft_inv(fftbuf_t X, int tid, cplx (&v)[8]) {
    dft8<true>(v); st8<1>(X, tid, v); FFT_SYNC();
    ld8<8>(X, tid, v); twid<8, true>(v, tid); dft8<true>(v); st8<8>(X, tid, v); FFT_SYNC();
    ld8<64>(X, tid, v); twid<64, true>(v, tid); dft8<true>(v); st8<64>(X, tid, v); FFT_SYNC();
    ld8<512>(X, tid, v); twid<512, true>(v, tid); dft8<true>(v);
}
#endif

struct OneUnit { int pm, pn; bool on;
    __device__ __forceinline__ bool next(int i, pg8::Unit& u) const { if (!on || i > 0) return false; u.pm = pm; u.pn = pn; return true; }
    __device__ __forceinline__ void a_ready(const pg8::Unit&) const {}
    __device__ __forceinline__ void done(const pg8::Unit&) const {}
    __device__ __forceinline__ long a_off(const pg8::Unit& u, size_t tstep) const { return (long)((size_t)u.pm * tstep); } };

struct EpiB {
    static constexpr bool PERM = true, AFTER_DRAIN = false;
    bf16_t* O; int ldc;
    __device__ __forceinline__ void operator()(const f32x4 (&acc)[2][2][4][2], const pg8::Unit& u, int wr, int wc, int fr, int fq) const {
        const int row0 = u.pm * 256 + wr * 64 + fr, col0 = u.pn * 256 + wc * 32 + 8 * fq;
#pragma unroll
        for (int ai = 0; ai < 2; ++ai)
#pragma unroll
            for (int m = 0; m < 4; ++m) { bf16_t* rowp = O + (size_t)(row0 + ai * 128 + m * 16) * ldc + col0;
#pragma unroll
                for (int bj = 0; bj < 2; ++bj) { const f32x4 v0 = acc[ai][bj][m][0], v1 = acc[ai][bj][m][1];
                    u32x4 w; w.x = pk2(v0[0], v0[1]); w.y = pk2(v0[2], v0[3]); w.z = pk2(v1[0], v1[1]); w.w = pk2(v1[2], v1[3]);
                    *(u32x4*)(rowp + bj * 128) = w; } }
    }
};
struct EpiRope {
    static constexpr bool PERM = true, AFTER_DRAIN = false;
    bf16_t* O; const float2* rope;
    __device__ __forceinline__ void operator()(const f32x4 (&acc)[2][2][4][2], const pg8::Unit& u, int wr, int wc, int fr, int fq) const {
        const int row0 = u.pm * 256 + wr * 64 + fr, col0 = u.pn * 256 + wc * 32 + 8 * fq;
        const bool rot = u.pn < 4;
#pragma unroll
        for (int ai = 0; ai < 2; ++ai)
#pragma unroll
            for (int m = 0; m < 4; ++m) { const int row = row0 + ai * 128 + m * 16; bf16_t* rowp = O + (size_t)row * MIXW + col0;
#pragma unroll
                for (int bj = 0; bj < 2; ++bj) { f32x4 v0 = acc[ai][bj][m][0], v1 = acc[ai][bj][m][1];
                    if (rot) { const int pos = row & (SEQ - 1), i0 = ((col0 + bj * 128) & 63) >> 1;
                        const f32x4* rp = (const f32x4*)(rope + pos * 32 + i0); const f32x4 r0 = rp[0], r1 = rp[1];
                        f32x4 o0, o1;
                        o0[0] = v0[0] * r0[0] - v0[1] * r0[1]; o0[1] = v0[1] * r0[0] + v0[0] * r0[1];
                        o0[2] = v0[2] * r0[2] - v0[3] * r0[3]; o0[3] = v0[3] * r0[2] + v0[2] * r0[3];
                        o1[0] = v1[0] * r1[0] - v1[1] * r1[1]; o1[1] = v1[1] * r1[0] + v1[0] * r1[1];
                        o1[2] = v1[2] * r1[2] - v1[3] * r1[3]; o1[3] = v1[3] * r1[2] + v1[2] * r1[3];
                        v0 = o0; v1 = o1; }
                    u32x4 w; w.x = pk2(v0[0], v0[1]); w.y = pk2(v0[2], v0[3]); w.z = pk2(v1[0], v1[1]); w.w = pk2(v1[2], v1[3]);
                    *(u32x4*)(rowp + bj * 128) = w; } }
    }
};
struct EpiRes {
    static constexpr bool PERM = false, AFTER_DRAIN = false;
    const float* X; float* O;
    __device__ __forceinline__ void operator()(const f32x4 (&acc)[2][2][4][2], const pg8::Unit& u, int wr, int wc, int fr, int fq) const {
        const int row0 = u.pm * 256 + wr * 64 + fr, col0 = u.pn * 256 + wc * 32 + 4 * fq;
#pragma unroll
        for (int ai = 0; ai < 2; ++ai)
#pragma unroll
            for (int m = 0; m < 4; ++m) { const size_t ro = (size_t)(row0 + ai * 128 + m * 16) * DM;
#pragma unroll
                for (int bj = 0; bj < 2; ++bj)
#pragma unroll
                    for (int n = 0; n < 2; ++n) { const int c = col0 + bj * 128 + 16 * n;
                        const f32x4 xv = *(const f32x4*)(X + ro + c); *(f32x4*)(O + ro + c) = acc[ai][bj][m][n] + xv * ALPHA; } }
    }
};
struct EpiRes2 {
    static constexpr bool PERM = false, AFTER_DRAIN = false;
    float* O; const float2* stat; const float* g; const float* b;
    __device__ __forceinline__ void operator()(const f32x4 (&acc)[2][2][4][2], const pg8::Unit& u, int wr, int wc, int fr, int fq) const {
        const int row0 = u.pm * 256 + wr * 64 + fr, col0 = u.pn * 256 + wc * 32 + 4 * fq;
#pragma unroll
        for (int bj = 0; bj < 2; ++bj)
#pragma unroll
            for (int n = 0; n < 2; ++n) { const int c = col0 + bj * 128 + 16 * n;
                const f32x4 gv = *(const f32x4*)(g + c), bv = *(const f32x4*)(b + c);
#pragma unroll
                for (int ai = 0; ai < 2; ++ai)
#pragma unroll
                    for (int m = 0; m < 4; ++m) { const int row = row0 + ai * 128 + m * 16; const float2 st = stat[row];
                        float* p = O + (size_t)row * DM + c; const f32x4 r1 = *(const f32x4*)p;
                        const f32x4 x1 = (r1 - st.x) * st.y * gv + bv; *(f32x4*)p = acc[ai][bj][m][n] + x1 * ALPHA; } }
    }
};


struct FfnOrder : pg8::StaticOrder {
    __device__ __forceinline__ long a_off(const pg8::Unit& u, size_t) const { return ((long)u.pm * 254 - 1) * (long)(DM * 2); }
};
constexpr int FFN_MT = 130;
constexpr int XCH_OFF = 131072 + 1024;
__device__ __forceinline__ float dpp_ror1(float v)  { return __int_as_float(__builtin_amdgcn_update_dpp(0, __float_as_int(v), 0x121, 0xF, 0xF, false)); }
__device__ __forceinline__ float dpp_ror15(float v) { return __int_as_float(__builtin_amdgcn_update_dpp(0, __float_as_int(v), 0x12F, 0xF, 0xF, false)); }
struct EpiFfn {
    static constexpr bool PERM = true, AFTER_DRAIN = false;
    bf16_t* ACT; const float* cw; const float* cb; LAS unsigned char* lds;
    __device__ __forceinline__ void operator()(const f32x4 (&acc)[2][2][4][2], const pg8::Unit& u, int wr, int wc, int fr, int fq) const {
        LAS float* XC = (LAS float*)(lds + XCH_OFF);
        const int colw = wc * 32 + 8 * fq;
        if (fr == 0 || fr == 15) {
            const int edge = (fr == 15) ? 1 : 0, m = (fr == 15) ? 3 : 0;
#pragma unroll
            for (int ai = 0; ai < 2; ++ai)
#pragma unroll
                for (int bj = 0; bj < 2; ++bj)
#pragma unroll
                    for (int n = 0; n < 2; ++n) { const f32x4 v = (m == 0) ? acc[ai][bj][0][n] : acc[ai][bj][3][n];
                        *(LAS f32x4*)(XC + ((ai * 2 + wr) * 2 + edge) * 256 + bj * 128 + colw + 4 * n) = v; }
        }
        asm volatile("s_waitcnt lgkmcnt(0)" ::: "memory"); __builtin_amdgcn_s_barrier(); asm volatile("" ::: "memory");
        const int slot0 = wr * 64 + fr, row_base = u.pm * 254 - 1;
#pragma unroll
        for (int bj = 0; bj < 2; ++bj) {
            const int gc = (u.pn * 256 + bj * 128 + colw) >> 1;
            f32x4 wg[3], wu[3];
#pragma unroll
            for (int j = 0; j < 3; ++j) { wg[j] = *(const f32x4*)(cw + (size_t)j * (2 * DFF) + gc); wu[j] = *(const f32x4*)(cw + (size_t)j * (2 * DFF) + DFF + gc); }
            const f32x4 bg = *(const f32x4*)(cb + gc), bu = *(const f32x4*)(cb + DFF + gc);
#pragma unroll
            for (int ai = 0; ai < 2; ++ai) {
                const int gidx = ai * 2 + wr;
                f32x4 pe[2], ne[2];
#pragma unroll
                for (int n = 0; n < 2; ++n) {
                    pe[n] = (gidx > 0) ? *(const LAS f32x4*)(XC + (((gidx - 1) * 2) + 1) * 256 + bj * 128 + colw + 4 * n) : (f32x4){0.f, 0.f, 0.f, 0.f};
                    ne[n] = (gidx < 3) ? *(const LAS f32x4*)(XC + (((gidx + 1) * 2) + 0) * 256 + bj * 128 + colw + 4 * n) : (f32x4){0.f, 0.f, 0.f, 0.f}; }
#pragma unroll
                for (int m = 0; m < 4; ++m) {
                    const int slot = ai * 128 + slot0 + m * 16, row = row_base + slot, t = row & (SEQ - 1);
                    f32x4 hv[2];
#pragma unroll
                    for (int n = 0; n < 2; ++n) {
                        const f32x4 cur = acc[ai][bj][m][n], prv = acc[ai][bj][m == 0 ? 0 : m - 1][n], nxt = acc[ai][bj][m == 3 ? 3 : m + 1][n];
                        f32x4 up, dn;
#pragma unroll
                        for (int e = 0; e < 4; ++e) { up[e] = dpp_ror1(fr == 15 ? prv[e] : cur[e]); dn[e] = dpp_ror15(fr == 0 ? nxt[e] : cur[e]); }
                        if (m == 0 && fr == 0) up = pe[n];
                        if (m == 3 && fr == 15) dn = ne[n];
                        if (t == 0) up = (f32x4){0.f, 0.f, 0.f, 0.f};
                        if (t == SEQ - 1) dn = (f32x4){0.f, 0.f, 0.f, 0.f};
                        const f32x4 w0 = n ? wu[0] : wg[0], w1 = n ? wu[1] : wg[1], w2 = n ? wu[2] : wg[2], bb = n ? bu : bg;
                        hv[n] = w0 * up + w1 * cur + w2 * dn + bb; }
                    if (slot >= 1 && slot <= 254 && row < NT) {
                        float o[4];
#pragma unroll
                        for (int e = 0; e < 4; ++e) { const float g = hv[0][e]; o[e] = g / (1.0f + __expf(-g)) * hv[1][e]; }
                        u32x2 w; w.x = pk2(o[0], o[1]); w.y = pk2(o[2], o[3]);
                        *(u32x2*)(ACT + (size_t)row * DFF + gc) = w; }
                }
            }
        }
    }
};

__device__ __forceinline__ int win_row(int n) {
    if (n < 1536) return 1536 + n;
    if (n < 2560) { const int q = n - 1536, blk = q >> 6, d = q & 63; return blk * 64 + 2 * (d & 31) + (d >> 5); }
    if (n < 3072) return 512 + n;
    return n - 2048;
}
template <int MODE> __device__ __forceinline__ void p0_transpose_item(const float* W, int K, int N, bf16_t* WT, LAS float* scr, int item, int lane) {
    const int nblk = N / 32, kb = item / nblk, nb = item % nblk, k0 = 64 * kb, n0 = 32 * nb;
#pragma unroll 8
    for (int i = 0; i < 32; ++i) { const int kk = 2 * i + (lane >> 5); scr[kk * 33 + (lane & 31)] = W[(size_t)(k0 + kk) * N + n0 + (lane & 31)]; }
    LDS_WAIT(); asm volatile("" ::: "memory");
    const int c = lane & 7;
#pragma unroll
    for (int j = 0; j < 4; ++j) { const int n = (lane >> 3) + 8 * j; const LAS float* s = scr + (8 * c) * 33 + n;
        u32x4 o; o.x = pk2(s[0 * 33], s[1 * 33]); o.y = pk2(s[2 * 33], s[3 * 33]); o.z = pk2(s[4 * 33], s[5 * 33]); o.w = pk2(s[6 * 33], s[7 * 33]);
        const int nn = n0 + n; const int dr = (MODE == 1) ? win_row(nn) : (MODE == 2) ? ((nn < DFF) ? ((nn >> 2) * 8 + (nn & 3)) : (((nn - DFF) >> 2) * 8 + 4 + ((nn - DFF) & 3))) : nn;
        *(u32x4*)(WT + (size_t)dr * K + k0 + 8 * c) = o; }
    LDS_WAIT(); asm volatile("" ::: "memory");
}
__device__ __forceinline__ void cvt_rows(const float* src, bf16_t* dst, size_t n8, int gw, int ngw, int lane) {
    for (size_t i = (size_t)gw * 64 + lane; i < n8; i += (size_t)ngw * 64) {
        const f32x4 a = ((const f32x4*)src)[2 * i], b = ((const f32x4*)src)[2 * i + 1];
        u32x4 w; w.x = pk2(a[0], a[1]); w.y = pk2(a[2], a[3]); w.z = pk2(b[0], b[1]); w.w = pk2(b[2], b[3]);
        ((u32x4*)dst)[i] = w; }
}
__device__ __forceinline__ void p0_filter_item(const float* w1, const float* b1, const float* fq, const float* w2, const float* b2, const float* w3, float* HTD, int item, int lane) {
    const int t0 = 2 * (item >> 2), ih = item & 3; float h2v[2], tl[2];
    const float fql = fq[lane], b1l = b1[lane], b2l = b2[lane];
#pragma unroll
    for (int tt = 0; tt < 2; ++tt) { const int t = t0 + tt; tl[tt] = (float)t * (1.0f / 2047.0f);
        const float w = 6.283185307179586f * (float)t / 2048.0f;
        float zk = 0.f;
        if (lane == 0) zk = tl[tt];
        else if (lane <= 16) { const float fr = 1e-4f + (float)(lane - 1) * ((15.0f - 1e-4f) / 15.0f); zk = cosf(fr * w); }
        else if (lane <= 32) { const float fr = 1e-4f + (float)(lane - 17) * ((15.0f - 1e-4f) / 15.0f); zk = -sinf(fr * w); }
        float a = b1l;
#pragma unroll 11
        for (int k = 0; k < 33; ++k) a += __shfl(zk, k) * w1[k * 64 + lane];
        const float h1 = sinf(fql * a);
        float a2 = b2l;
#pragma unroll 16
        for (int k = 0; k < 64; ++k) a2 += __shfl(h1, k) * w2[k * 64 + lane];
        h2v[tt] = sinf(fql * a2); }
    const float dmin = -15.350567286626973f, dmax = -3.0701134573253946f;
    float acc0[8], acc1[8];
#pragma unroll
    for (int i = 0; i < 8; ++i) { acc0[i] = 0.f; acc1[i] = 0.f; }
#pragma unroll 4
    for (int j = 0; j < 64; ++j) { const float s0 = __shfl(h2v[0], j), s1 = __shfl(h2v[1], j); const float* wr = w3 + (size_t)j * 2048 + ih * 512 + lane;
#pragma unroll
        for (int i = 0; i < 8; ++i) { const float wv = wr[64 * i]; acc0[i] += s0 * wv; acc1[i] += s1 * wv; } }
#pragma unroll
    for (int i = 0; i < 8; ++i) { const int col = ih * 512 + 64 * i + lane, c = col & 511;
        const float delta = fabsf(dmin + (float)c * ((dmax - dmin) / 511.0f));
        float2 o; o.x = acc0[i] * expf(-tl[0] * delta); o.y = acc1[i] * expf(-tl[1] * delta);
        *(float2*)(HTD + (size_t)col * 2048 + t0) = o; }
}
__device__ __forceinline__ void p0_prep(const float* const* in, unsigned char* ws, LAS unsigned char* lds, int tid) {
    const int lane = tid & 63, wave = tid >> 6, gw = blockIdx.x * NWAVE + wave, ngw = gridDim.x * NWAVE;
    LAS float* scr = (LAS float*)(lds + wave * 16384);
    bf16_t* WALL = (bf16_t*)(ws + WS_WALL);
    constexpr int I_IN = 16 * (INW / 32), I_KV = 16 * 32, I_OUT = 24 * 32, I_UP = 16 * (2 * DFF / 32), I_DN = (DFF / 64) * 32, NIT = I_IN + I_KV + I_OUT + I_UP + I_DN;
    for (int it = gw; it < NIT; it += ngw) { int r = it;
        if (r < I_IN) { p0_transpose_item<1>(in[2], DM, INW, WALL, scr, r, lane); continue; } r -= I_IN;
        if (r < I_KV) { p0_transpose_item<0>(in[14], DM, 1024, (bf16_t*)(ws + WS_WKV), scr, r, lane); continue; } r -= I_KV;
        if (r < I_OUT) { p0_transpose_item<0>(in[15], MIXW, DM, (bf16_t*)(ws + WS_WOUT), scr, r, lane); continue; } r -= I_OUT;
        if (r < I_UP) { p0_transpose_item<2>(in[18], DM, 2 * DFF, (bf16_t*)(ws + WS_WUP), scr, r, lane); continue; } r -= I_UP;
        p0_transpose_item<0>(in[21], DFF, DM, (bf16_t*)(ws + WS_WDN), scr, r, lane); }
    for (int it = ngw - 1 - gw; it < 4096; it += ngw) p0_filter_item(in[5], in[6], in[7], in[8], in[9], in[10], (float*)(ws + WS_HTD), it, lane);
    cvt_rows(in[0], (bf16_t*)(ws + WS_XB), (size_t)NT * DM / 8, gw, ngw, lane);
    cvt_rows(in[1], (bf16_t*)(ws + WS_MEMB), (size_t)NMT * DM / 8, gw, ngw, lane);
    float2* rope = (float2*)(ws + WS_ROPE);
    for (int i = blockIdx.x * NTHR + tid; i < SEQ * 32; i += gridDim.x * NTHR) { const int pos = i >> 5, f = i & 31;
        const float invf = powf(10000.0f, -(float)(2 * f) / 64.0f); const float ang = (float)pos * invf;
        float2 cs; cs.x = cosf(ang); cs.y = sinf(ang); rope[i] = cs; }
}

__device__ __forceinline__ void filter_fft_item(const float* HTD, float2* KF, LAS unsigned char* lds, int item, int tid) {
    const int o = item >> 9, c = item & 511;
    const float* rf = HTD + (size_t)((o * 2 + 0) * 512 + c) * 2048; const float* rb = HTD + (size_t)((o * 2 + 1) * 512 + c) * 2048;
    cplx v[8];
#pragma unroll
    for (int k = 0; k < 4; ++k) v[k] = mk2(rf[tid + 512 * k], 0.f);
    v[4] = mk2(tid == 0 ? 0.f : rb[2048 - tid], 0.f); v[5] = mk2(rb[1536 - tid], 0.f); v[6] = mk2(rb[1024 - tid], 0.f); v[7] = mk2(rb[512 - tid], 0.f);
    fft_fwd((LAS cplx*)lds, tid, v);
    float2* dst = KF + (size_t)(o * 512 + c) * 4096 + 8 * tid;
#pragma unroll
    for (int m = 0; m < 8; m += 2) { f32x4 w; w[0] = v[m].x * (1.f / 4096.f); w[1] = v[m].y * (1.f / 4096.f); w[2] = v[m + 1].x * (1.f / 4096.f); w[3] = v[m + 1].y * (1.f / 4096.f); *(f32x4*)(dst + m) = w; }
    __syncthreads();
}

__device__ __forceinline__ float conv3(const bf16_t* row, int n, float w0, float w1, float w2, float b) {
    float r = w1 * bf2f(row[n]) + b;
    if (n > 0) r += w0 * bf2f(row[n - 1]);
    if (n < SEQ - 1) r += w2 * bf2f(row[n + 1]);
    return r;
}
__device__ __forceinline__ void hyena_item(const bf16_t* HT, const float2* KF, const float* cw, const float* cb, const float* hb, bf16_t* MIX, LAS unsigned char* lds, int bp, int cgp, int tid0) {
    LAS cplx* X = (LAS cplx*)lds; LAS bf16_t* OT = (LAS bf16_t*)(lds + 36864);
    const int ba = 2 * bp;
#pragma unroll 1
    for (int cc = 0; cc < 8; ++cc) {
        const int c = cgp * 8 + cc;
        int tl_ = tid0; asm volatile("" : "+v"(tl_)); const int tid = tl_;
        const bf16_t* rv = HT + (size_t)c * NT + ba * SEQ; const bf16_t* r1 = HT + (size_t)(512 + c) * NT + ba * SEQ; const bf16_t* r2 = HT + (size_t)(1024 + c) * NT + ba * SEQ;
        cplx v[8]; float va[4], vb[4];
        { const float w0 = cw[c], w1 = cw[1536 + c], w2 = cw[3072 + c], b = cb[c];
#pragma unroll
          for (int k = 0; k < 4; ++k) { const int n = tid + 512 * k; va[k] = conv3(rv, n, w0, w1, w2, b); vb[k] = conv3(rv + SEQ, n, w0, w1, w2, b); v[k] = mk2(va[k], vb[k]); v[4 + k] = mk2(0.f, 0.f); } }
        fft_fwd(X, tid, v);
        { int t1_ = tid; asm volatile("" : "+v"(t1_)); const f32x4* kf = (const f32x4*)(KF + (size_t)c * 4096 + 8 * t1_);
#pragma unroll
          for (int m = 0; m < 8; m += 2) { const f32x4 w = kf[m >> 1]; v[m] = cmul(v[m], mk2(w[0], w[1])); v[m + 1] = cmul(v[m + 1], mk2(w[2], w[3])); } }
        fft_inv(X, tid, v);
        { int t2_ = tid; asm volatile("" : "+v"(t2_)); const float w0 = cw[512 + c], w1 = cw[1536 + 512 + c], w2 = cw[3072 + 512 + c], b = cb[512 + c], hb0 = hb[c];
#pragma unroll
          for (int k = 0; k < 4; ++k) { const int n = t2_ + 512 * k; const float xa = conv3(r1, n, w0, w1, w2, b), xb = conv3(r1 + SEQ, n, w0, w1, w2, b);
              va[k] = xa * (v[k].x + hb0 * va[k]); vb[k] = xb * (v[k].y + hb0 * vb[k]); v[k] = mk2(va[k], vb[k]); v[4 + k] = mk2(0.f, 0.f); } }
        fft_fwd(X, tid, v);
        { int t1_ = tid; asm volatile("" : "+v"(t1_)); const f32x4* kf = (const f32x4*)(KF + (size_t)(512 + c) * 4096 + 8 * t1_);
#pragma unroll
          for (int m = 0; m < 8; m += 2) { const f32x4 w = kf[m >> 1]; v[m] = cmul(v[m], mk2(w[0], w[1])); v[m + 1] = cmul(v[m + 1], mk2(w[2], w[3])); } }
        fft_inv(X, tid, v);
        { int t2_ = tid; asm volatile("" : "+v"(t2_)); const float w0 = cw[1024 + c], w1 = cw[1536 + 1024 + c], w2 = cw[3072 + 1024 + c], b = cb[1024 + c], hb1 = hb[512 + c];
#pragma unroll
          for (int k = 0; k < 4; ++k) { const int n = t2_ + 512 * k; const float xa = conv3(r2, n, w0, w1, w2, b), xb = conv3(r2 + SEQ, n, w0, w1, w2, b);
              const float oa = xa * (v[k].x + hb1 * va[k]), ob = xb * (v[k].y + hb1 * vb[k]);
              OT[n * 8 + cc] = (bf16_t)(pk2(oa, 0.f) & 0xffffu); OT[(SEQ + n) * 8 + cc] = (bf16_t)(pk2(ob, 0.f) & 0xffffu); } }
    }
    __syncthreads();
    int tw_ = tid0; asm volatile("" : "+v"(tw_)); const int tid = tw_;
#pragma unroll
    for (int i = 0; i < 8; ++i) { const int rowid = tid + 512 * i, bsel = rowid >> 11, n = rowid & (SEQ - 1);
        const u32x4 val = *(LAS u32x4*)(OT + rowid * 8);
        *(u32x4*)(MIX + (size_t)((ba + bsel) * SEQ + n) * MIXW + cgp * 8) = val; }
    __syncthreads();
}

constexpr int ATT_KP = 272, ATT_VP = 144, ATT_KB = 64 * ATT_KP, ATT_VB = 128 * ATT_VP, ATT_VOFF = 2 * ATT_KB;
template <int NC> __device__ __forceinline__ void attn_unit(LAS unsigned char* lds, const bf16_t* Qp, int ldq, const bf16_t* Kp, int ldk, const bf16_t* Vt, int ldv, int nkeys, float sl2,
                                                            bf16_t* Op, int ldo, float lam, const float* subg, int tid) {
    constexpr int NSTEP = (NC == 2) ? 4 : 8;
    const int lane = tid & 63, wave = tid >> 6, r = lane & 31, h = lane >> 5;
    const int qb = (NC == 2) ? (wave & 3) : wave, comp = (NC == 2) ? (wave >> 2) : 0, dbase = comp * 64;
    bf16x8 qf[NSTEP];
#pragma unroll
    for (int st = 0; st < NSTEP; ++st) qf[st] = *(const bf16x8*)(Qp + (size_t)(qb * 32 + r) * ldq + dbase + 16 * st + 8 * h);
    f32x16 o[4];
#pragma unroll
    for (int et = 0; et < 4; ++et)
#pragma unroll
        for (int i = 0; i < 16; ++i) o[et][i] = 0.f;
    float mold = -INFINITY, lsum = 0.f;
    const int kr0 = tid >> 4, kc = tid & 15, vr0 = tid >> 3, vc = tid & 7;
    const bf16_t* kg = Kp + (size_t)kr0 * ldk + kc * 8; const bf16_t* vg = Vt + (size_t)vr0 * ldv + vc * 8;
    const int kl = kr0 * ATT_KP + kc * 16, vl = ATT_VOFF + vr0 * ATT_VP + vc * 16;
    const int nt = nkeys / 64;
    u32x4 pk0, pk1, pv0, pv1;
    pk0 = *(const u32x4*)(kg); pk1 = *(const u32x4*)(kg + (size_t)32 * ldk); pv0 = *(const u32x4*)(vg); pv1 = *(const u32x4*)(vg + (size_t)64 * ldv);
    *(LAS u32x4*)(lds + kl) = pk0; *(LAS u32x4*)(lds + kl + 32 * ATT_KP) = pk1; *(LAS u32x4*)(lds + vl) = pv0; *(LAS u32x4*)(lds + vl + 64 * ATT_VP) = pv1;
    __syncthreads();
    for (int it = 0; it < nt; ++it) {
        const int cur = it & 1; const bool more = (it + 1 < nt);
        if (more) { const bf16_t* kg2 = kg + (size_t)(it + 1) * 64 * ldk; const bf16_t* vg2 = vg + (it + 1) * 64;
            pk0 = *(const u32x4*)(kg2); pk1 = *(const u32x4*)(kg2 + (size_t)32 * ldk); pv0 = *(const u32x4*)(vg2); pv1 = *(const u32x4*)(vg2 + (size_t)64 * ldv); }
        LAS unsigned char* Kb = lds + cur * ATT_KB; LAS unsigned char* Vb = lds + ATT_VOFF + cur * ATT_VB;
        f32x16 s[2];
#pragma unroll
        for (int kb = 0; kb < 2; ++kb) {
#pragma unroll
            for (int i = 0; i < 16; ++i) s[kb][i] = 0.f;
#pragma unroll
            for (int st = 0; st < NSTEP; ++st) { const bf16x8 a = *(const LAS bf16x8*)(Kb + (kb * 32 + r) * ATT_KP + (dbase + 16 * st + 8 * h) * 2);
                s[kb] = __builtin_amdgcn_mfma_f32_32x32x16_bf16(a, qf[st], s[kb], 0, 0, 0); } }
        float mx = s[0][0];
#pragma unroll
        for (int i = 1; i < 16; ++i) mx = fmaxf(mx, s[0][i]);
#pragma unroll
        for (int i = 0; i < 16; ++i) mx = fmaxf(mx, s[1][i]);
        mx = fmaxf(mx, __shfl_xor(mx, 32));
        const float mnew = fmaxf(mold, mx * sl2), alpha = __builtin_amdgcn_exp2f(mold - mnew); mold = mnew;
        float ps = 0.f;
#pragma unroll
        for (int kb = 0; kb < 2; ++kb)
#pragma unroll
            for (int i = 0; i < 16; ++i) { const float p = __builtin_amdgcn_exp2f(__builtin_fmaf(s[kb][i], sl2, -mnew)); s[kb][i] = p; ps += p; }
        lsum = lsum * alpha + ps;
#pragma unroll
        for (int et = 0; et < 4; ++et)
#pragma unroll
            for (int i = 0; i < 16; ++i) o[et][i] *= alpha;
#pragma unroll
        for (int kb = 0; kb < 2; ++kb)
#pragma unroll
            for (int s2 = 0; s2 < 2; ++s2) {
                u32x4 pw; pw.x = pk2(s[kb][8 * s2 + 0], s[kb][8 * s2 + 1]); pw.y = pk2(s[kb][8 * s2 + 2], s[kb][8 * s2 + 3]); pw.z = pk2(s[kb][8 * s2 + 4], s[kb][8 * s2 + 5]); pw.w = pk2(s[kb][8 * s2 + 6], s[kb][8 * s2 + 7]);
                const bf16x8 pf = __builtin_bit_cast(bf16x8, pw);
#pragma unroll
                for (int et = 0; et < 4; ++et) { const LAS unsigned char* vp = Vb + (et * 32 + r) * ATT_VP + (kb * 32 + 16 * s2 + 4 * h) * 2;
                    const u32x2 lo = *(const LAS u32x2*)vp, hi = *(const LAS u32x2*)(vp + 16);
                    u32x4 aw; aw.x = lo.x; aw.y = lo.y; aw.z = hi.x; aw.w = hi.y;
                    o[et] = __builtin_amdgcn_mfma_f32_32x32x16_bf16(__builtin_bit_cast(bf16x8, aw), pf, o[et], 0, 0, 0); } }
        if (more) { const int nb = cur ^ 1;
            *(LAS u32x4*)(lds + nb * ATT_KB + kl) = pk0; *(LAS u32x4*)(lds + nb * ATT_KB + kl + 32 * ATT_KP) = pk1;
            *(LAS u32x4*)(lds + nb * ATT_VB + vl) = pv0; *(LAS u32x4*)(lds + nb * ATT_VB + vl + 64 * ATT_VP) = pv1; }
        __syncthreads();
    }
    lsum += __shfl_xor(lsum, 32);
    const float inv = 1.0f / lsum;
    if (NC == 1) {
        bf16_t* orow = Op + (size_t)(qb * 32 + r) * ldo;
#pragma unroll
        for (int et = 0; et < 4; ++et)
#pragma unroll
            for (int g = 0; g < 4; ++g) { u32x2 w; w.x = pk2(o[et][4 * g] * inv, o[et][4 * g + 1] * inv); w.y = pk2(o[et][4 * g + 2] * inv, o[et][4 * g + 3] * inv);
                *(u32x2*)(orow + et * 32 + 8 * g + 4 * h) = w; }
    } else {
        LAS float* XL = (LAS float*)lds;
        if (comp == 1) {
#pragma unroll
            for (int et = 0; et < 4; ++et)
#pragma unroll
                for (int i = 0; i < 16; ++i) XL[(qb * 64 + et * 16 + i) * 64 + lane] = o[et][i] * inv;
        }
        __syncthreads();
        if (comp == 0) {
            float ss = 0.f;
#pragma unroll
            for (int et = 0; et < 4; ++et)
#pragma unroll
                for (int i = 0; i < 16; ++i) { const float ov = o[et][i] * inv - lam * XL[(qb * 64 + et * 16 + i) * 64 + lane]; o[et][i] = ov; ss += ov * ov; }
            ss += __shfl_xor(ss, 32);
            const float rs = rsqrtf(ss * (1.0f / 128.0f) + RMS_EPS) * 0.8f;
            bf16_t* orow = Op + (size_t)(qb * 32 + r) * ldo;
#pragma unroll
            for (int et = 0; et < 4; ++et)
#pragma unroll
                for (int g = 0; g < 4; ++g) { const int e = et * 32 + 8 * g + 4 * h; const f32x4 gv = *(const f32x4*)(subg + e);
                    u32x2 w; w.x = pk2(o[et][4 * g] * rs * gv[0], o[et][4 * g + 1] * rs * gv[1]); w.y = pk2(o[et][4 * g + 2] * rs * gv[2], o[et][4 * g + 3] * rs * gv[3]);
                    *(u32x2*)(orow + e) = w; }
        }
        __syncthreads();
    }
}

template <bool TO_BF16> __device__ __forceinline__ void ln_rows(float* io, bf16_t* ob, float2* stat, const float* g, const float* b, int tid) {
    const int lane = tid & 63, gw = blockIdx.x * NWAVE + (tid >> 6), ngw = gridDim.x * NWAVE;
    f32x4 gv[4], bv[4];
#pragma unroll
    for (int j = 0; j < 4; ++j) { gv[j] = ((const f32x4*)g)[lane + 64 * j]; bv[j] = ((const f32x4*)b)[lane + 64 * j]; }
    for (int row = gw; row < NT; row += ngw) {
        f32x4* xr = (f32x4*)(io + (size_t)row * DM) + lane; f32x4 v[4]; float s = 0.f;
#pragma unroll
        for (int j = 0; j < 4; ++j) { v[j] = xr[64 * j]; s += (v[j][0] + v[j][1]) + (v[j][2] + v[j][3]); }
#pragma unroll
        for (int o = 1; o < 64; o <<= 1) s += __shfl_xor(s, o);
        const float mean = s * (1.0f / DM); float s2 = 0.f;
#pragma unroll
        for (int j = 0; j < 4; ++j) { v[j] = v[j] - mean; s2 += (v[j][0] * v[j][0] + v[j][1] * v[j][1]) + (v[j][2] * v[j][2] + v[j][3] * v[j][3]); }
#pragma unroll
        for (int o = 1; o < 64; o <<= 1) s2 += __shfl_xor(s2, o);
        const float rstd = rsqrtf(s2 * (1.0f / DM) + LN_EPS);
        if (TO_BF16) {
            u32x2* o8 = (u32x2*)(ob + (size_t)row * DM) + lane;
#pragma unroll
            for (int j = 0; j < 4; ++j) { const f32x4 y = v[j] * rstd * gv[j] + bv[j]; u32x2 w; w.x = pk2(y[0], y[1]); w.y = pk2(y[2], y[3]); o8[64 * j] = w; }
            if (lane == 0) { float2 st; st.x = mean; st.y = rstd; stat[row] = st; }
        } else {
#pragma unroll
            for (int j = 0; j < 4; ++j) xr[64 * j] = v[j] * rstd * gv[j] + bv[j];
        }
    }
}

__device__ __forceinline__ void convgate_half(const bf16_t* HH, bf16_t* ACT, const float* cw, const float* cb, int half, int tid) {
    constexpr int NG = DFF / 8; const int total = (NT / 2) * NG;
    for (int idx = blockIdx.x * NTHR + tid; idx < total; idx += gridDim.x * NTHR) {
        const int rl = idx / NG, cg8 = idx - rl * NG, n0 = cg8 * 8, t = rl & (SEQ - 1);
        const bf16_t* hp = HH + (size_t)rl * (2 * DFF);
        float gsum[8], usum[8];
#pragma unroll
        for (int e = 0; e < 8; ++e) { gsum[e] = cb[n0 + e]; usum[e] = cb[DFF + n0 + e]; }
#pragma unroll
        for (int j = 0; j < 3; ++j) { const int tt = t + j - 1; if (tt < 0 || tt >= SEQ) continue;
            const u32x4 gq = *(const u32x4*)(hp + (ptrdiff_t)(j - 1) * (2 * DFF) + n0), uq = *(const u32x4*)(hp + (ptrdiff_t)(j - 1) * (2 * DFF) + DFF + n0);
            const float* wg = cw + (size_t)j * (2 * DFF) + n0; const float* wu = wg + DFF;
            const f32x4 wg0 = *(const f32x4*)wg, wg1 = *(const f32x4*)(wg + 4), wu0 = *(const f32x4*)wu, wu1 = *(const f32x4*)(wu + 4);
            gsum[0] += wg0[0] * lo2f(gq.x); gsum[1] += wg0[1] * hi2f(gq.x); gsum[2] += wg0[2] * lo2f(gq.y); gsum[3] += wg0[3] * hi2f(gq.y);
            gsum[4] += wg1[0] * lo2f(gq.z); gsum[5] += wg1[1] * hi2f(gq.z); gsum[6] += wg1[2] * lo2f(gq.w); gsum[7] += wg1[3] * hi2f(gq.w);
            usum[0] += wu0[0] * lo2f(uq.x); usum[1] += wu0[1] * hi2f(uq.x); usum[2] += wu0[2] * lo2f(uq.y); usum[3] += wu0[3] * hi2f(uq.y);
            usum[4] += wu1[0] * lo2f(uq.z); usum[5] += wu1[1] * hi2f(uq.z); usum[6] += wu1[2] * lo2f(uq.w); usum[7] += wu1[3] * hi2f(uq.w); }
        float a[8];
#pragma unroll
        for (int e = 0; e < 8; ++e) a[e] = gsum[e] / (1.0f + __expf(-gsum[e])) * usum[e];
        u32x4 w; w.x = pk2(a[0], a[1]); w.y = pk2(a[2], a[3]); w.z = pk2(a[4], a[5]); w.w = pk2(a[6], a[7]);
        *(u32x4*)(ACT + (size_t)(half * (NT / 2) + rl) * DFF + n0) = w;
    }
}

#define XB_TMO      128
#define XB_XCNT(j)  (256  + 64 * (j))
#define XB_XSUB(j)  (1280 + 64 * (j))
#define XB_XGEN(j)  (2304 + 64 * (j))
#define XB_TOP      3328
#define XB_TOPGEN   3392
#define XCD_BAR_WORDS 3456
#define XB_SPIN_CAP (1u << 18)

__device__ __forceinline__ unsigned xb_ld(unsigned* p)              { return __hip_atomic_load(p, __ATOMIC_RELAXED, __HIP_MEMORY_SCOPE_AGENT); }
__device__ __forceinline__ unsigned xb_add(unsigned* p, unsigned v) { return __hip_atomic_fetch_add(p, v, __ATOMIC_RELAXED, __HIP_MEMORY_SCOPE_AGENT); }
__device__ __forceinline__ unsigned xb_xcc_id() { return (unsigned)__builtin_amdgcn_s_getreg((3 << 11) | 20) & 0xFu; }
#define XB_SPIN(cond, bar) do { unsigned _sp = 0; while (cond) { __builtin_amdgcn_s_sleep(1); \
    if ((++_sp & 255u) == 0u) { if (xb_ld(&(bar)[XB_TMO])) break; if (_sp > XB_SPIN_CAP) { atomicAdd(&(bar)[XB_TMO], 1u); break; } } } } while (0)

struct XcdBarrier {
    unsigned* bar; unsigned x;
    volatile LAS unsigned* st;
};

__device__ __forceinline__ XcdBarrier xcd_barrier_post(unsigned* bar, volatile LAS unsigned* st) {
    XcdBarrier b; b.bar = bar; b.x = xb_xcc_id(); b.st = st;
    if (threadIdx.x == 0) (void)xb_add(&bar[XB_XCNT(b.x)], 1u);
    return b;
}
__device__ __forceinline__ void xcd_barrier_complete(unsigned* bar, unsigned x, unsigned& nloc, unsigned& nx) {
    const unsigned G = gridDim.x * gridDim.y * gridDim.z;
    unsigned sum, cnt, mine, sp = 0u;
    for (;;) {
        sum = 0u; cnt = 0u; mine = 0u;
#pragma unroll
        for (unsigned j = 0; j < 16; ++j) { const unsigned c = xb_ld(&bar[XB_XCNT(j)]); sum += c; cnt += (c > 0u) ? 1u : 0u; mine = (j == x) ? c : mine; }
        if (sum == G) break;
        __builtin_amdgcn_s_sleep(1);
        if ((++sp & 255u) == 0u) { if (xb_ld(&bar[XB_TMO])) break; if (sp > XB_SPIN_CAP) { atomicAdd(&bar[XB_TMO], 1u); break; } }
    }
    nloc = mine > 0u ? mine : 1u; nx = cnt > 0u ? cnt : 1u;
}

__device__ __forceinline__ void xcd_barrier(const XcdBarrier& b) {
    asm volatile("s_waitcnt vmcnt(0)" ::: "memory");
    __syncthreads();
    if (threadIdx.x == 0) {
        unsigned* bar = b.bar;
        __builtin_amdgcn_s_waitcnt(0);
        unsigned nloc = b.st[0], nx = b.st[1];
        if (nloc == 0u) { xcd_barrier_complete(bar, b.x, nloc, nx); b.st[0] = nloc; b.st[1] = nx; }
        const unsigned old = xb_add(&bar[XB_XSUB(b.x)], 1u);
        const unsigned gen = old / nloc;
        if (old + 1u == (gen + 1u) * nloc) {
            __builtin_amdgcn_fence(__ATOMIC_RELEASE, "agent");
            asm volatile("s_waitcnt vmcnt(0)" ::: "memory");
            const unsigned og = xb_add(&bar[XB_TOP], 1u);
            const unsigned tg = og / nx;
            if (og + 1u == (tg + 1u) * nx) xb_add(&bar[XB_TOPGEN], 1u);
            else XB_SPIN(xb_ld(&bar[XB_TOPGEN]) == tg, bar);
            __builtin_amdgcn_fence(__ATOMIC_ACQUIRE, "agent");
            xb_add(&bar[XB_XGEN(b.x)], 1u);
            asm volatile("s_waitcnt vmcnt(0)" ::: "memory");
        } else {
            XB_SPIN(xb_ld(&bar[XB_XGEN(b.x)]) == gen, bar);
            __builtin_amdgcn_fence(__ATOMIC_ACQUIRE, "agent");
            asm volatile("s_waitcnt vmcnt(0)" ::: "memory");
        }
    }
    __syncthreads();
}

#ifndef PH_MASK
#define PH_MASK 0xFFFFFF
#endif
#define PH(k) ((PH_MASK >> (k)) & 1)
#ifndef REP_P0
#define REP_P0 1
#endif
#ifndef REP_G1
#define REP_G1 1
#endif
#ifndef REP_DIFF
#define REP_DIFF 1
#endif
#ifndef REP_HY
#define REP_HY 1
#endif
#ifndef REP_MEM
#define REP_MEM 1
#endif
struct Args { const float* in[24]; float* out; unsigned char* ws; };
__global__ void __launch_bounds__(NTHR, 2) hybrid_fwd(Args a) {
    extern __shared__ __attribute__((aligned(16))) unsigned char smem[];
    LAS unsigned char* lds = (LAS unsigned char*)smem;
    cg::grid_group grid = cg::this_grid();
    volatile LAS unsigned* bst = (volatile LAS unsigned*)(lds + 131072 + 64);
    if (threadIdx.x < 2) bst[threadIdx.x] = 0u;
    __syncthreads();
    const XcdBarrier bar = xcd_barrier_post((unsigned*)(a.ws + WS_BAR), bst);
    const int G = gridDim.x;
#define NEWPHASE() int tid_ = threadIdx.x, cu_ = blockIdx.x; asm volatile("" : "+v"(tid_)); asm volatile("" : "+s"(cu_)); const int tid = tid_, cu = cu_; (void)tid; (void)cu;
    unsigned char* ws = a.ws;
    bf16_t* WALL = (bf16_t*)(ws + WS_WALL); bf16_t* XB = (bf16_t*)(ws + WS_XB); bf16_t* MEMB = (bf16_t*)(ws + WS_MEMB); bf16_t* WKV = (bf16_t*)(ws + WS_WKV);
    bf16_t* QKM = (bf16_t*)(ws + WS_QKM); bf16_t* HT = (bf16_t*)(ws + WS_HT); bf16_t* KMEM = (bf16_t*)(ws + WS_KMEM); bf16_t* VMT = (bf16_t*)(ws + WS_VMT);
    float2* KF = (float2*)(ws + WS_KF); bf16_t* MIX = (bf16_t*)(ws + WS_MIX); float2* STAT = (float2*)(ws + WS_STAT);
    bf16_t* X1B = (bf16_t*)(ws + WS_X1B); bf16_t* HH = (bf16_t*)(ws + WS_HH); bf16_t* ACT = (bf16_t*)(ws + WS_ACT);

    for (int rep = 0; rep < REP_P0; ++rep) { NEWPHASE(); if (PH(0)) p0_prep(a.in, ws, lds, tid); }
    grid.sync();

    for (int rep = 0; rep < REP_G1; ++rep) {
    if (PH(1)) { NEWPHASE(); pg8::Gemm g{XB, WALL, NT, 1536, DM}; pg8::StaticOrder S; S.init(g.M, g.N, G, cu);
      EpiRope E{QKM, (const float2*)(ws + WS_ROPE)};
      pg8::gemm_phase<EpiRope, pg8::StaticOrder, true, true>(lds, g, S, E); }
    if (PH(2)) { NEWPHASE(); pg8::Gemm g{WALL + (size_t)1536 * DM, XB, 2048, NT, DM}; pg8::StaticOrder S; S.init(g.M, g.N, G, cu);
      EpiB E{HT, NT};
      pg8::gemm_phase<EpiB, pg8::StaticOrder, true, true>(lds, g, S, E); }
    }
    if (PH(3)) { NEWPHASE(); const bool isK = cu < 32, on = cu < 64; const int c2 = cu - 32;
      pg8::Gemm g; EpiB E; OneUnit S;
      if (isK) { g = pg8::Gemm{MEMB, WKV, NMT, 512, DM}; E = EpiB{KMEM, 512}; S = OneUnit{cu >> 1, cu & 1, on}; }
      else { g = pg8::Gemm{WKV + (size_t)512 * DM, MEMB, 512, NMT, DM}; E = EpiB{VMT, NMT}; S = OneUnit{(c2 >> 4) & 1, c2 & 15, on}; }
      pg8::gemm_phase<EpiB, OneUnit, false, true>(lds, g, S, E);
      __syncthreads();
      if (!on) for (int it = cu - 64; it < 1024; it += G - 64) filter_fft_item((const float*)(ws + WS_HTD), KF, lds, it, tid); }
    xcd_barrier(bar);

    { NEWPHASE(); const int xcd = cu & 7, j = cu >> 3;
      float lam;
      { const float* lp = a.in[12]; const int l6 = tid & 63; float s01 = lp[l6] * lp[64 + l6], s23 = lp[128 + l6] * lp[192 + l6];
#pragma unroll
        for (int o = 1; o < 64; o <<= 1) { s01 += __shfl_xor(s01, o); s23 += __shfl_xor(s23, o); }
        lam = expf(s01) - expf(s23) + 0.2f; }
      if (PH(4)) for (int i = 0; i < 4 * REP_DIFF; ++i) {
          const int bh = ((i & 3) * 8 + xcd) * 2 + (j >> 4), qblk = j & 15, b = bh >> 2, hd = bh & 3;
          const size_t tok0 = (size_t)b * SEQ;
          attn_unit<2>(lds, QKM + (tok0 + qblk * 128) * MIXW + hd * 128, MIXW, QKM + tok0 * MIXW + 512 + hd * 128, MIXW,
                       HT + (size_t)(1536 + hd * 128) * NT + tok0, NT, SEQ, 0.125f * 1.4426950408889634f,
                       MIX + (tok0 + qblk * 128) * MIXW + 512 + hd * 128, MIXW, lam, a.in[13], tid); }
      if (PH(5)) for (int i = 0; i < 2 * REP_MEM; ++i) {
          const int bh = ((i & 1) * 8 + xcd) * 4 + (j >> 3), qblk = j & 7, b = bh >> 2, hd = bh & 3;
          const size_t tok0 = (size_t)b * SEQ;
          attn_unit<1>(lds, QKM + (tok0 + qblk * 256) * MIXW + 1024 + hd * 128, MIXW, KMEM + (size_t)b * MEMT * 512 + hd * 128, 512,
                       VMT + (size_t)(hd * 128) * NMT + b * MEMT, NMT, MEMT, 0.08838834764831845f * 1.4426950408889634f,
                       MIX + (tok0 + qblk * 256) * MIXW + 1024 + hd * 128, MIXW, 0.f, nullptr, tid); }
      if (PH(6)) for (int i = 0; i < 2 * REP_HY; ++i) {
          const int cgp = ((i & 1) * 8 + xcd) * 4 + (j >> 3), bp = j & 7;
          hyena_item(HT, KF, a.in[3], a.in[4], a.in[11], MIX, lds, bp, cgp, tid); } }
    xcd_barrier(bar);

#ifdef REP_SYNC
    for (int rep = 0; rep < REP_SYNC; ++rep) xcd_barrier(bar);
#endif
    if (PH(7)) { NEWPHASE(); pg8::Gemm g{MIX, (const bf16_t*)(ws + WS_WOUT), NT, DM, MIXW}; pg8::StaticOrder S; S.init(g.M, g.N, G, cu);
      EpiRes E{a.in[0], a.out};
      pg8::gemm_phase<EpiRes, pg8::StaticOrder, true, true>(lds, g, S, E); }
    xcd_barrier(bar);
    if (PH(8)) { NEWPHASE(); ln_rows<true>(a.out, X1B, STAT, a.in[16], a.in[17], tid); }
    xcd_barrier(bar);
    if (PH(9)) { NEWPHASE(); pg8::Gemm g{X1B, (const bf16_t*)(ws + WS_WUP), FFN_MT * 256, 2 * DFF, DM}; FfnOrder S; S.init(g.M, g.N, G, cu);
      EpiFfn E{ACT, a.in[19], a.in[20], lds};
      pg8::gemm_phase<EpiFfn, FfnOrder, true, true>(lds, g, S, E); }
    xcd_barrier(bar);
    if (PH(11)) { NEWPHASE(); pg8::Gemm g{ACT, (const bf16_t*)(ws + WS_WDN), NT, DM, DFF}; pg8::StaticOrder S; S.init(g.M, g.N, G, cu);
      EpiRes2 E{a.out, STAT, a.in[16], a.in[17]};
      pg8::gemm_phase<EpiRes2, pg8::StaticOrder, true, true>(lds, g, S, E); }
    xcd_barrier(bar);
    if (PH(12)) { NEWPHASE(); ln_rows<false>(a.out, nullptr, nullptr, a.in[22], a.in[23], tid); }
}

extern "C" void kernel_launch(void* const* d_in, const int* in_sizes, int n_in, void* d_out, int out_size, void* d_ws, size_t ws_size, hipStream_t stream) {
    static int grid = 0;
    if (grid == 0) {
        if (n_in != 24 || out_size != NT * DM || ws_size < WS_END) { fprintf(stderr, "kernel_launch: unexpected shapes (n_in %d, out %d, ws %zu)\n", n_in, out_size, ws_size); grid = -1; return; }
        int dev = 0, cus = 0, per_cu = 0;
        hipGetDevice(&dev); hipDeviceGetAttribute(&cus, hipDeviceAttributeMultiprocessorCount, dev);
        if (hipFuncSetAttribute((const void*)hybrid_fwd, hipFuncAttributeMaxDynamicSharedMemorySize, LDS_BYTES) != hipSuccess) { fprintf(stderr, "kernel_launch: hipFuncSetAttribute failed\n"); grid = -1; return; }
        if (hipOccupancyMaxActiveBlocksPerMultiprocessor(&per_cu, (const void*)hybrid_fwd, NTHR, LDS_BYTES) != hipSuccess || per_cu < 1) { fprintf(stderr, "kernel_launch: occupancy query says %d\n", per_cu); per_cu = 1; }
        (void)hipGetLastError();
        grid = cus * per_cu;
        fprintf(stderr, "kernel_launch: grid %d (cus %d x %d)\n", grid, cus, per_cu);
    }
    if (grid < 0) return;
    if (hipMemsetAsync((char*)d_ws + WS_BAR, 0, XCD_BAR_WORDS * 4, stream) != hipSuccess) { fprintf(stderr, "kernel_launch: memset failed\n"); return; }
    Args a{};
    for (int i = 0; i < 24; ++i) a.in[i] = (const float*)d_in[i];
    a.out = (float*)d_out; a.ws = (unsigned char*)d_ws;
    void* args[] = {&a};
    const hipError_t e = hipLaunchCooperativeKernel((const void*)hybrid_fwd, dim3(grid), dim3(NTHR), args, LDS_BYTES, stream);
    if (e != hipSuccess) fprintf(stderr, "kernel_launch: cooperative launch failed: %s (grid %d)\n", hipGetErrorString(e), grid);
}
```

```cpp
#include <hip/hip_runtime.h>
#include <hip/hip_cooperative_groups.h>
#include <cstdio>
#include <cstdint>
namespace cg = cooperative_groups;
#define LAS __attribute__((address_space(3)))
namespace pg8 {
#define PG8_LAS __attribute__((address_space(3)))
typedef unsigned short bf16_t;
typedef short bf16x8 __attribute__((ext_vector_type(8)));
typedef float f32x4 __attribute__((ext_vector_type(4)));
typedef unsigned u32x4 __attribute__((ext_vector_type(4)));
constexpr int BM = 256, BK = 64, HALF = 128, HTB = HALF * BK * 2  , STAGE_BYTES = 8 * HTB, NXCD = 8, WGM = 8;

__host__ __device__ __forceinline__ int lds_byte(int r, int c) { const int st = (r >> 4) * 2 + (c >> 5), rr = r & 15, cc = c & 31, ob = rr * 64 + cc * 2; return st * 1024 + (ob ^ (((ob >> 9) & 1) << 5)); }
__host__ __device__ __forceinline__ void stage_rc(int b, int& R, int& C) { const int st = b / 1024, sb = b % 1024, swz = sb ^ (((sb >> 9) & 1) << 5); R = (st >> 1) * 16 + swz / 64; C = (st & 1) * 32 + (swz % 64) / 2; }
__host__ __device__ __forceinline__ int perm32(int rho) { const int n = rho >> 4, i = rho & 15; return 8 * (i >> 2) + 4 * n + (i & 3); }

struct Unit { int pm, pn; };
struct Gemm { const bf16_t* A; const bf16_t* Bt; int M, N, K; };

struct StaticOrder {
    int nM, nN, nwg, G, c;
    __host__ __device__ void init(int M, int N, int G_, int c_) { nM = M / BM; nN = N / BM; nwg = nM * nN; G = G_; c = c_; }
    __host__ __device__ bool next(int i, Unit& u) const {
        const long L = (long)i * G + c; if (L >= nwg) return false;
        int wgid = (int)L; { const int q = nwg / NXCD, r = nwg % NXCD, xcd = wgid % NXCD, off = wgid / NXCD; wgid = (xcd < r ? xcd * (q + 1) : r * (q + 1) + (xcd - r) * q) + off; }
        const int nig = WGM * nN, gid = wgid / nig, fm = gid * WGM, gsz = (nM - fm) < WGM ? (nM - fm) : WGM;
        u.pm = fm + ((wgid % nig) % gsz); u.pn = (wgid % nig) / gsz; return true;
    }
    __device__ __forceinline__ void a_ready(const Unit&) const {}
    __device__ __forceinline__ void done(const Unit&) const {}
    __device__ __forceinline__ long a_off(const Unit& u, size_t tstep) const { return (long)((size_t)u.pm * tstep); }
};
template <class Epi, class Sched, bool ALIGN_EPI = false, bool SP2 = false>
__device__ __forceinline__ void gemm_phase(PG8_LAS unsigned char* lds, const Gemm g, const Sched& S, const Epi& E) {
    int tid_l = threadIdx.x; asm volatile("" : "+v"(tid_l)); const int tid = tid_l, wid = __builtin_amdgcn_readfirstlane(tid >> 6), lane = tid & 63, wr = wid >> 2, wc = wid & 3, fr = lane & 15, fq = lane >> 4;
    const int K = g.K, nt = K / BK;
    unsigned voffA[2], voffB[2];
#pragma unroll
    for (int i = 0; i < 2; ++i) { int R, C; stage_rc(tid * 16 + i * 8192, R, C); const int Rb = Epi::PERM ? ((R & ~31) + perm32(R & 31)) : R;
        voffA[i] = (unsigned)(R * K + C) * 2u; voffB[i] = (unsigned)(Rb * K + C) * 2u; }
    const size_t kstep = (size_t)(BK * 2);
    const size_t hstep = (size_t)HALF * K * 2;
    const size_t tstep = 2 * hstep;
    const unsigned ldsw = (unsigned)wid * 1024u;
    const int aoff = lds_byte(wr * 64 + fr, fq * 8), boff = lds_byte(wc * 32 + fr, fq * 8);
#define PG8_SA(b, h) (((b) * 2 + (h)) * HTB)
#define PG8_SB(b, h) ((4 + (b) * 2 + (h)) * HTB)
#define PG8_STAGE(bufoff, gbase, voff) do { _Pragma("unroll") for (int _i = 0; _i < 2; ++_i) \
        __builtin_amdgcn_global_load_lds((const unsigned*)((const char*)(gbase) + (voff)[_i]), (PG8_LAS unsigned*)(lds + (bufoff) + ldsw + _i * 8192), 16, 0, 0); } while (0)
#define PG8_LDA(dst, b, h) do { _Pragma("unroll") for (int m = 0; m < 4; ++m) _Pragma("unroll") for (int k = 0; k < 2; ++k) dst[m][k] = *(const PG8_LAS bf16x8*)(lds + PG8_SA(b, h) + aoff + m * 2048 + k * 1024); } while (0)
#define PG8_LDB(dst, b, h) do { _Pragma("unroll") for (int n = 0; n < 2; ++n) _Pragma("unroll") for (int k = 0; k < 2; ++k) dst[n][k] = *(const PG8_LAS bf16x8*)(lds + PG8_SB(b, h) + boff + n * 2048 + k * 1024); } while (0)
#define PG8_MMA(ai, bj, At, Bt) do { __builtin_amdgcn_s_setprio(1); _Pragma("unroll") for (int m = 0; m < 4; ++m) _Pragma("unroll") for (int n = 0; n < 2; ++n) _Pragma("unroll") for (int k = 0; k < 2; ++k) \
        acc[ai][bj][m][n] = __builtin_amdgcn_mfma_f32_16x16x32_bf16(Bt[n][k], At[m][k], acc[ai][bj][m][n], 0, 0, 0); __builtin_amdgcn_s_setprio(0); } while (0)
#define PG8_WAIT_V(n) asm volatile("s_waitcnt vmcnt(" #n ")" ::: "memory")
#define PG8_WAIT_L(n) asm volatile("s_waitcnt lgkmcnt(" #n ")" ::: "memory")
#define PG8_BAR __builtin_amdgcn_s_barrier()
#define PG8_SCHED __builtin_amdgcn_sched_barrier(0)
    Unit cur, nxt; int ui = 0;
    if (!S.next(0, cur)) return;
    f32x4 acc[2][2][4][2];
#pragma unroll
    for (int a = 0; a < 2; ++a)
#pragma unroll
        for (int b = 0; b < 2; ++b)
#pragma unroll
            for (int m = 0; m < 4; ++m)
#pragma unroll
                for (int n = 0; n < 2; ++n) acc[a][b][m][n] = (f32x4){0.f, 0.f, 0.f, 0.f};
    bf16x8 At[4][2], B0[2][2], B1[2][2];
    const char* cA = (const char*)g.A + S.a_off(cur, tstep); const char* cB = (const char*)g.Bt + (size_t)cur.pn * tstep;
    S.a_ready(cur);
    if constexpr (SP2) {
        PG8_STAGE(PG8_SB(0, 0), cB, voffB); PG8_STAGE(PG8_SB(0, 1), cB + hstep, voffB); PG8_STAGE(PG8_SA(0, 0), cA, voffA); PG8_STAGE(PG8_SA(0, 1), cA + hstep, voffA);
        if (wr == 1) PG8_BAR;
        PG8_WAIT_V(2); PG8_BAR;
        PG8_STAGE(PG8_SB(1, 0), cB + kstep, voffB); PG8_STAGE(PG8_SA(1, 0), cA + kstep, voffA); PG8_STAGE(PG8_SB(1, 1), cB + hstep + kstep, voffB);
        PG8_WAIT_V(6); PG8_BAR;
    } else {
        PG8_STAGE(PG8_SB(0, 0), cB, voffB); PG8_STAGE(PG8_SA(0, 0), cA, voffA); PG8_STAGE(PG8_SB(0, 1), cB + hstep, voffB); PG8_STAGE(PG8_SA(0, 1), cA + hstep, voffA);
        if (wr == 1) PG8_BAR;
        PG8_WAIT_V(4); PG8_BAR;
        PG8_STAGE(PG8_SB(1, 0), cB + kstep, voffB); PG8_STAGE(PG8_SA(1, 0), cA + kstep, voffA); PG8_STAGE(PG8_SB(1, 1), cB + hstep + kstep, voffB);
        PG8_WAIT_V(6); PG8_BAR;
    }
    for (;;) {
        const bool has_next = S.next(ui + 1, nxt);
        const char* nA = has_next ? (const char*)g.A + S.a_off(nxt, tstep) : cA; const char* nB = has_next ? (const char*)g.Bt + (size_t)nxt.pn * tstep : cB;
        for (int t = 0; t < nt; t += 2) {
            const bool last = (t == nt - 2);
            const char* a1 = cA + (size_t)(t + 1) * kstep;
            const char* a2 = last ? nA : cA + (size_t)(t + 2) * kstep; const char* b2 = last ? nB : cB + (size_t)(t + 2) * kstep;
            const char* a3 = a2 + kstep; const char* b3 = b2 + kstep;
            if (last && has_next) S.a_ready(nxt);
            if constexpr (SP2) {
            PG8_LDB(B0, 0, 0); PG8_LDB(B1, 0, 1); PG8_SCHED; PG8_LDA(At, 0, 0); PG8_STAGE(PG8_SA(1, 1), a1 + hstep, voffA);
            PG8_WAIT_V(8); PG8_WAIT_L(0); PG8_BAR; PG8_MMA(0, 0, At, B0); PG8_MMA(0, 1, At, B1); PG8_BAR; PG8_SCHED;
            PG8_LDA(At, 0, 1); PG8_STAGE(PG8_SB(0, 0), b2, voffB); PG8_STAGE(PG8_SB(0, 1), b2 + hstep, voffB); PG8_STAGE(PG8_SA(0, 0), a2, voffA);
            PG8_WAIT_V(8); PG8_WAIT_L(0); PG8_BAR; PG8_MMA(1, 0, At, B0); PG8_MMA(1, 1, At, B1); PG8_BAR; PG8_SCHED;
            PG8_LDB(B0, 1, 0); PG8_LDB(B1, 1, 1); PG8_SCHED; PG8_LDA(At, 1, 0); PG8_STAGE(PG8_SA(0, 1), a2 + hstep, voffA);
            PG8_WAIT_V(8); PG8_WAIT_L(0); PG8_BAR; PG8_MMA(0, 0, At, B0); PG8_MMA(0, 1, At, B1); PG8_BAR; PG8_SCHED;
            PG8_LDA(At, 1, 1); PG8_STAGE(PG8_SB(1, 0), b3, voffB); PG8_STAGE(PG8_SB(1, 1), b3 + hstep, voffB); PG8_STAGE(PG8_SA(1, 0), a3, voffA);
            PG8_WAIT_V(8); PG8_WAIT_L(0); PG8_BAR; PG8_MMA(1, 0, At, B0); PG8_MMA(1, 1, At, B1); PG8_BAR; PG8_SCHED;
            } else {
            PG8_LDB(B0, 0, 0); PG8_SCHED; PG8_LDA(At, 0, 0); PG8_STAGE(PG8_SA(1, 1), a1 + hstep, voffA);
            PG8_WAIT_L(8); PG8_BAR; PG8_WAIT_L(0); PG8_MMA(0, 0, At, B0); PG8_BAR; PG8_SCHED;
            PG8_LDB(B1, 0, 1); PG8_STAGE(PG8_SB(0, 0), b2, voffB);
            PG8_BAR; PG8_WAIT_L(0); PG8_MMA(0, 1, At, B1); PG8_BAR;
            PG8_LDA(At, 0, 1); PG8_STAGE(PG8_SA(0, 0), a2, voffA);
            PG8_BAR; PG8_WAIT_L(0); PG8_MMA(1, 0, At, B0); PG8_BAR; PG8_SCHED;
            PG8_STAGE(PG8_SB(0, 1), b2 + hstep, voffB);
            PG8_WAIT_V(6); PG8_BAR; PG8_MMA(1, 1, At, B1); PG8_BAR;
            PG8_LDB(B0, 1, 0); PG8_SCHED; PG8_LDA(At, 1, 0); PG8_STAGE(PG8_SA(0, 1), a2 + hstep, voffA);
            PG8_WAIT_L(8); PG8_BAR; PG8_WAIT_L(0); PG8_MMA(0, 0, At, B0); PG8_BAR; PG8_SCHED;
            PG8_LDB(B1, 1, 1); PG8_STAGE(PG8_SB(1, 0), b3, voffB);
            PG8_BAR; PG8_WAIT_L(0); PG8_MMA(0, 1, At, B1); PG8_BAR;
            PG8_LDA(At, 1, 1); PG8_STAGE(PG8_SA(1, 0), a3, voffA);
            PG8_BAR; PG8_WAIT_L(0); PG8_MMA(1, 0, At, B0); PG8_BAR; PG8_SCHED;
            PG8_STAGE(PG8_SB(1, 1), b3 + hstep, voffB);
            PG8_WAIT_V(6); PG8_BAR; PG8_MMA(1, 1, At, B1); PG8_BAR;
            }
        }
        if constexpr (ALIGN_EPI) { if (wr == 0) PG8_BAR; }
        if constexpr (!Epi::AFTER_DRAIN) { E(acc, cur, wr, wc, fr, fq); S.done(cur); }
        if (!has_next) break;
#pragma unroll
        for (int a = 0; a < 2; ++a)
#pragma unroll
            for (int b = 0; b < 2; ++b)
#pragma unroll
                for (int m = 0; m < 4; ++m)
#pragma unroll
                    for (int n = 0; n < 2; ++n) acc[a][b][m][n] = (f32x4){0.f, 0.f, 0.f, 0.f};
        cur = nxt; cA = nA; cB = nB; ++ui;
        if constexpr (ALIGN_EPI) { if (wr == 1) PG8_BAR; }
    }
    PG8_WAIT_V(0);
    if constexpr (!ALIGN_EPI) { if (wr == 0) PG8_BAR; }
    PG8_BAR;
    if constexpr (Epi::AFTER_DRAIN) { E.fused(acc, cur, wr, wc, fr, fq, lds, wid, lane); S.done(cur); }
#undef PG8_SA
#undef PG8_SB
#undef PG8_STAGE
#undef PG8_LDA
#undef PG8_LDB
#undef PG8_MMA
#undef PG8_WAIT_V
#undef PG8_WAIT_L
#undef PG8_BAR
#undef PG8_SCHED
}
}

using pg8::bf16_t; using pg8::bf16x8; using pg8::f32x4; using pg8::u32x4;
typedef float f32x16 __attribute__((ext_vector_type(16)));
typedef unsigned u32x2 __attribute__((ext_vector_type(2)));
typedef short bf16x4 __attribute__((ext_vector_type(4)));

constexpr int NB = 16, SEQ = 2048, DM = 1024, NT = NB * SEQ, MEMT = 256, NMT = NB * MEMT, HW = 512, INW = 3584, DFF = 2816, MIXW = 1536;
constexpr float ALPHA = 1.189207115002721f;
constexpr float LN_EPS = 1e-5f, RMS_EPS = 1e-5f;
constexpr int NTHR = 512, NWAVE = 8;
constexpr int LDS_BYTES = 143360;

constexpr size_t MiB = 1048576;
constexpr size_t WS_WALL = 0;
constexpr size_t WS_WKV  = 7 * MiB;
constexpr size_t WS_WOUT = 9 * MiB;
constexpr size_t WS_WUP  = 12 * MiB;
constexpr size_t WS_WDN  = 23 * MiB;
constexpr size_t WS_ROPE = 29 * MiB;
constexpr size_t WS_STAT = 29 * MiB + 524288;
constexpr size_t WS_XB   = 30 * MiB;
constexpr size_t WS_X1B  = 30 * MiB;
constexpr size_t WS_HTD  = 94 * MiB;
constexpr size_t WS_MEMB = 110 * MiB;
constexpr size_t WS_QKM  = 118 * MiB;
constexpr size_t WS_HT   = 214 * MiB;
constexpr size_t WS_KMEM = 342 * MiB;
constexpr size_t WS_VMT  = 346 * MiB;
constexpr size_t WS_KF   = 350 * MiB;
constexpr size_t WS_MIX  = 382 * MiB;
constexpr size_t WS_HH   = 96 * MiB;
constexpr size_t WS_ACT  = 272 * MiB;
constexpr size_t WS_BAR  = 478 * MiB;
constexpr size_t WS_END  = 478 * MiB + 65536;

__device__ __forceinline__ unsigned pk2(float lo, float hi) { unsigned r; asm volatile("v_cvt_pk_bf16_f32 %0, %1, %2" : "=v"(r) : "v"(lo), "v"(hi)); return r; }
__device__ __forceinline__ float bf2f(bf16_t v) { return __uint_as_float((unsigned)v << 16); }
__device__ __forceinline__ float lo2f(unsigned v) { return __uint_as_float(v << 16); }
__device__ __forceinline__ float hi2f(unsigned v) { return __uint_as_float(v & 0xffff0000u); }
#define LDS_WAIT() asm volatile("s_waitcnt lgkmcnt(0)" ::: "memory")

#ifndef FFT_HOST
#define FFT_FN __device__ __forceinline__
#define FFT_SYNC() __syncthreads()
typedef float cplx __attribute__((ext_vector_type(2)));
typedef LAS cplx* fftbuf_t;
FFT_FN float cos2pi(float r) { return __builtin_amdgcn_cosf(r); }
FFT_FN float sin2pi(float r) { return __builtin_amdgcn_sinf(r); }
#endif
FFT_FN cplx mk2(float x, float y) { cplx r; r.x = x; r.y = y; return r; }
FFT_FN cplx cadd(cplx a, cplx b) { return mk2(a.x + b.x, a.y + b.y); }
FFT_FN cplx csub(cplx a, cplx b) { return mk2(a.x - b.x, a.y - b.y); }
FFT_FN cplx cmul(cplx a, cplx b) { return mk2(a.x * b.x - a.y * b.y, a.x * b.y + a.y * b.x); }
template <bool INV> FFT_FN cplx muli(cplx a) { return INV ? mk2(-a.y, a.x) : mk2(a.y, -a.x); }
FFT_FN int padi(int i) { return i + (i >> 3); }

template <bool INV> FFT_FN void dft8(cplx (&v)[8]) {
    const float R = 0.70710678118654752f;
    const cplx a0 = cadd(v[0], v[4]), a1 = csub(v[0], v[4]), a2 = cadd(v[2], v[6]), a3 = muli<INV>(csub(v[2], v[6]));
    const cplx a4 = cadd(v[1], v[5]), a5 = csub(v[1], v[5]), a6 = cadd(v[3], v[7]), a7 = muli<INV>(csub(v[3], v[7]));
    const cplx b0 = cadd(a0, a2), b2 = csub(a0, a2), b1 = cadd(a1, a3), b3 = csub(a1, a3);
    const cplx b4 = cadd(a4, a6), b6 = muli<INV>(csub(a4, a6));
    const cplx t5 = cadd(a5, a7), t7 = csub(a5, a7);
    cplx b5, b7;
    if (!INV) { b5 = mk2((t5.x + t5.y) * R, (t5.y - t5.x) * R); b7 = mk2((t7.y - t7.x) * R, -(t7.x + t7.y) * R); }
    else      { b5 = mk2((t5.x - t5.y) * R, (t5.x + t5.y) * R); b7 = mk2(-(t7.x + t7.y) * R, (t7.x - t7.y) * R); }
    v[0] = cadd(b0, b4); v[4] = csub(b0, b4); v[1] = cadd(b1, b5); v[5] = csub(b1, b5);
    v[2] = cadd(b2, b6); v[6] = csub(b2, b6); v[3] = cadd(b3, b7); v[7] = csub(b3, b7);
}
template <int S, bool INV> FFT_FN void twid(cplx (&v)[8], int tid) {
    if (S > 1) {
        const int j = tid % S; const float rev = (float)j * (1.0f / (8.0f * S));
        const float c = cos2pi(rev), s = sin2pi(rev);
        const cplx w1 = mk2(c, INV ? s : -s);
        const cplx w2 = cmul(w1, w1), w3 = cmul(w2, w1), w4 = cmul(w2, w2), w5 = cmul(w4, w1), w6 = cmul(w4, w2), w7 = cmul(w4, w3);
        v[1] = cmul(v[1], w1); v[2] = cmul(v[2], w2); v[3] = cmul(v[3], w3); v[4] = cmul(v[4], w4);
        v[5] = cmul(v[5], w5); v[6] = cmul(v[6], w6); v[7] = cmul(v[7], w7);
    }
}
template <int S> FFT_FN void ld8(fftbuf_t X, int tid, cplx (&v)[8]) {
    const int base = (tid / S) * 8 * S + (tid % S);
#pragma unroll
    for (int k = 0; k < 8; ++k) v[k] = X[padi(base + S * k)];
}
template <int S> FFT_FN void st8(fftbuf_t X, int tid, const cplx (&v)[8]) {
    const int base = (tid / S) * 8 * S + (tid % S);
#pragma unroll
    for (int k = 0; k < 8; ++k) X[padi(base + S * k)] = v[k];
}
#ifndef FFT_HOST
template <int S> FFT_FN void twid_fill(fftbuf_t TW, int tid) {
    constexpr int P = (S == 512) ? 0 : (S == 64) ? 1 : 2;
    const int j = tid % S; const float rev = (float)j * (1.0f / (8.0f * S));
    const cplx w1 = mk2(cos2pi(rev), -sin2pi(rev)), w2 = cmul(w1, w1), w4 = cmul(w2, w2);
    TW[(3 * P + 0) * 512 + tid] = w1; TW[(3 * P + 1) * 512 + tid] = w2; TW[(3 * P + 2) * 512 + tid] = w4;
}
template <int S, bool INV> FFT_FN void twidL(cplx (&v)[8], fftbuf_t TW, int tid) {
    constexpr int P = (S == 512) ? 0 : (S == 64) ? 1 : 2;
    cplx w1 = TW[(3 * P + 0) * 512 + tid], w2 = TW[(3 * P + 1) * 512 + tid], w4 = TW[(3 * P + 2) * 512 + tid];
    if (INV) { w1.y = -w1.y; w2.y = -w2.y; w4.y = -w4.y; }
    const cplx w3 = cmul(w2, w1), w5 = cmul(w4, w1), w6 = cmul(w4, w2), w7 = cmul(w4, w3);
    v[1] = cmul(v[1], w1); v[2] = cmul(v[2], w2); v[3] = cmul(v[3], w3); v[4] = cmul(v[4], w4);
    v[5] = cmul(v[5], w5); v[6] = cmul(v[6], w6); v[7] = cmul(v[7], w7);
}
FFT_FN void fft_fwdL(fftbuf_t X, fftbuf_t TW, int tid, cplx (&v)[8]) {
    dft8<false>(v); twidL<512, false>(v, TW, tid); st8<512>(X, tid, v); FFT_SYNC();
    ld8<64>(X, tid, v); dft8<false>(v); twidL<64, false>(v, TW, tid); st8<64>(X, tid, v); FFT_SYNC();
    ld8<8>(X, tid, v); dft8<false>(v); twidL<8, false>(v, TW, tid); st8<8>(X, tid, v); FFT_SYNC();
    ld8<1>(X, tid, v); dft8<false>(v);
}
FFT_FN void fft_invL(fftbuf_t X, fftbuf_t TW, int tid, cplx (&v)[8]) {
    dft8<true>(v); st8<1>(X, tid, v); FFT_SYNC();
    ld8<8>(X, tid, v); twidL<8, true>(v, TW, tid); dft8<true>(v); st8<8>(X, tid, v); FFT_SYNC();
    ld8<64>(X, tid, v); twidL<64, true>(v, TW, tid); dft8<true>(v); st8<64>(X, tid, v); FFT_SYNC();
    ld8<512>(X, tid, v); twidL<512, true>(v, TW, tid); dft8<true>(v);
}
FFT_FN void fft_fwd(fftbuf_t X, int tid, cplx (&v)[8]) {
    dft8<false>(v); twid<512, false>(v, tid); st8<512>(X, tid, v); FFT_SYNC();
    ld8<64>(X, tid, v); dft8<false>(v); twid<64, false>(v, tid); st8<64>(X, tid, v); FFT_SYNC();
    ld8<8>(X, tid, v); dft8<false>(v); twid<8, false>(v, tid); st8<8>(X, tid, v); FFT_SYNC();
    ld8<1>(X, tid, v); dft8<false>(v);
}
FFT_FN void fft_inv(fftbuf_t X, int tid, cplx (&v)[8]) {
    dft8<true>(v); st8<1>(X, tid, v); FFT_SYNC();
    ld8<8>(X, tid, v); twid<8, true>(v, tid); dft8<true>(v); st8<8>(X, tid, v); FFT_SYNC();
    ld8<64>(X, tid, v); twid<64, true>(v, tid); dft8<true>(v); st8<64>(X, tid, v); FFT_SYNC();
    ld8<512>(X, tid, v); twid<512, true>(v, tid); dft8<true>(v);
}
#endif

struct OneUnit { int pm, pn; bool on;
    __device__ __forceinline__ bool next(int i, pg8::Unit& u) const { if (!on || i > 0) return false; u.pm = pm; u.pn = pn; return true; }
    __device__ __forceinline__ void a_ready(const pg8::Unit&) const {}
    __device__ __forceinline__ void done(const pg8::Unit&) const {}
    __device__ __forceinline__ long a_off(const pg8::Unit& u, size_t tstep) const { return (long)((size_t)u.pm * tstep); } };

struct EpiB {
    static constexpr bool PERM = true, AFTER_DRAIN = false;
    bf16_t* O; int ldc;
    __device__ __forceinline__ void operator()(const f32x4 (&acc)[2][2][4][2], const pg8::Unit& u, int wr, int wc, int fr, int fq) const {
        const int row0 = u.pm * 256 + wr * 64 + fr, col0 = u.pn * 256 + wc * 32 + 8 * fq;
#pragma unroll
        for (int ai = 0; ai < 2; ++ai)
#pragma unroll
            for (int m = 0; m < 4; ++m) { bf16_t* rowp = O + (size_t)(row0 + ai * 128 + m * 16) * ldc + col0;
#pragma unroll
                for (int bj = 0; bj < 2; ++bj) { const f32x4 v0 = acc[ai][bj][m][0], v1 = acc[ai][bj][m][1];
                    u32x4 w; w.x = pk2(v0[0], v0[1]); w.y = pk2(v0[2], v0[3]); w.z = pk2(v1[0], v1[1]); w.w = pk2(v1[2], v1[3]);
                    *(u32x4*)(rowp + bj * 128) = w; } }
    }
};
struct EpiRope {
    static constexpr bool PERM = true, AFTER_DRAIN = false;
    bf16_t* O; const float2* rope;
    __device__ __forceinline__ void operator()(const f32x4 (&acc)[2][2][4][2], const pg8::Unit& u, int wr, int wc, int fr, int fq) const {
        const int row0 = u.pm * 256 + wr * 64 + fr, col0 = u.pn * 256 + wc * 32 + 8 * fq;
        const bool rot = u.pn < 4;
#pragma unroll
        for (int ai = 0; ai < 2; ++ai)
#pragma unroll
            for (int m = 0; m < 4; ++m) { const int row = row0 + ai * 128 + m * 16; bf16_t* rowp = O + (size_t)row * MIXW + col0;
#pragma unroll
                for (int bj = 0; bj < 2; ++bj) { f32x4 v0 = acc[ai][bj][m][0], v1 = acc[ai][bj][m][1];
                    if (rot) { const int pos = row & (SEQ - 1), i0 = ((col0 + bj * 128) & 63) >> 1;
                        const f32x4* rp = (const f32x4*)(rope + pos * 32 + i0); const f32x4 r0 = rp[0], r1 = rp[1];
                        f32x4 o0, o1;
                        o0[0] = v0[0] * r0[0] - v0[1] * r0[1]; o0[1] = v0[1] * r0[0] + v0[0] * r0[1];
                        o0[2] = v0[2] * r0[2] - v0[3] * r0[3]; o0[3] = v0[3] * r0[2] + v0[2] * r0[3];
                        o1[0] = v1[0] * r1[0] - v1[1] * r1[1]; o1[1] = v1[1] * r1[0] + v1[0] * r1[1];
                        o1[2] = v1[2] * r1[2] - v1[3] * r1[3]; o1[3] = v1[3] * r1[2] + v1[2] * r1[3];
                        v0 = o0; v1 = o1; }
                    u32x4 w; w.x = pk2(v0[0], v0[1]); w.y = pk2(v0[2], v0[3]); w.z = pk2(v1[0], v1[1]); w.w = pk2(v1[2], v1[3]);
                    *(u32x4*)(rowp + bj * 128) = w; } }
    }
};
struct EpiRes {
    static constexpr bool PERM = false, AFTER_DRAIN = false;
    const float* X; float* O;
    __device__ __forceinline__ void operator()(const f32x4 (&acc)[2][2][4][2], const pg8::Unit& u, int wr, int wc, int fr, int fq) const {
        const int row0 = u.pm * 256 + wr * 64 + fr, col0 = u.pn * 256 + wc * 32 + 4 * fq;
#pragma unroll
        for (int ai = 0; ai < 2; ++ai)
#pragma unroll
            for (int m = 0; m < 4; ++m) { const size_t ro = (size_t)(row0 + ai * 128 + m * 16) * DM;
#pragma unroll
                for (int bj = 0; bj < 2; ++bj)
#pragma unroll
                    for (int n = 0; n < 2; ++n) { const int c = col0 + bj * 128 + 16 * n;
                        const f32x4 xv = *(const f32x4*)(X + ro + c); *(f32x4*)(O + ro + c) = acc[ai][bj][m][n] + xv * ALPHA; } }
    }
};
struct EpiRes2 {
    static constexpr bool PERM = false, AFTER_DRAIN = false;
    float* O; const float2* stat; const float* g; const float* b;
    __device__ __forceinline__ void operator()(const f32x4 (&acc)[2][2][4][2], const pg8::Unit& u, int wr, int wc, int fr, int fq) const {
        const int row0 = u.pm * 256 + wr * 64 + fr, col0 = u.pn * 256 + wc * 32 + 4 * fq;
#pragma unroll
        for (int bj = 0; bj < 2; ++bj)
#pragma unroll
            for (int n = 0; n < 2; ++n) { const int c = col0 + bj * 128 + 16 * n;
                const f32x4 gv = *(const f32x4*)(g + c), bv = *(const f32x4*)(b + c);
#pragma unroll
                for (int ai = 0; ai < 2; ++ai)
#pragma unroll
                    for (int m = 0; m < 4; ++m) { const int row = row0 + ai * 128 + m * 16; const float2 st = stat[row];
                        float* p = O + (size_t)row * DM + c; const f32x4 r1 = *(const f32x4*)p;
                        const f32x4 x1 = (r1 - st.x) * st.y * gv + bv; *(f32x4*)p = acc[ai][bj][m][n] + x1 * ALPHA; } }
    }
};


struct FfnOrder : pg8::StaticOrder {
    __device__ __forceinline__ long a_off(const pg8::Unit& u, size_t) const { return ((long)u.pm * 254 - 1) * (long)(DM * 2); }
};
constexpr int FFN_MT = 130;
constexpr int XCH_OFF = 131072 + 1024;
__device__ __forceinline__ float dpp_ror1(float v)  { return __int_as_float(__builtin_amdgcn_update_dpp(0, __float_as_int(v), 0x121, 0xF, 0xF, false)); }
__device__ __forceinline__ float dpp_ror15(float v) { return __int_as_float(__builtin_amdgcn_update_dpp(0, __float_as_int(v), 0x12F, 0xF, 0xF, false)); }
struct EpiFfn {
    static constexpr bool PERM = true, AFTER_DRAIN = false;
    bf16_t* ACT; const float* cw; const float* cb; LAS unsigned char* lds;
    __device__ __forceinline__ void operator()(const f32x4 (&acc)[2][2][4][2], const pg8::Unit& u, int wr, int wc, int fr, int fq) const {
        LAS float* XC = (LAS float*)(lds + XCH_OFF);
        const int colw = wc * 32 + 8 * fq;
        if (fr == 0 || fr == 15) {
            const int edge = (fr == 15) ? 1 : 0, m = (fr == 15) ? 3 : 0;
#pragma unroll
            for (int ai = 0; ai < 2; ++ai)
#pragma unroll
                for (int bj = 0; bj < 2; ++bj)
#pragma unroll
                    for (int n = 0; n < 2; ++n) { const f32x4 v = (m == 0) ? acc[ai][bj][0][n] : acc[ai][bj][3][n];
                        *(LAS f32x4*)(XC + ((ai * 2 + wr) * 2 + edge) * 256 + bj * 128 + colw + 4 * n) = v; }
        }
        asm volatile("s_waitcnt lgkmcnt(0)" ::: "memory"); __builtin_amdgcn_s_barrier(); asm volatile("" ::: "memory");
        const int slot0 = wr * 64 + fr, row_base = u.pm * 254 - 1;
#pragma unroll
        for (int bj = 0; bj < 2; ++bj) {
            const int gc = (u.pn * 256 + bj * 128 + colw) >> 1;
            f32x4 wg[3], wu[3];
#pragma unroll
            for (int j = 0; j < 3; ++j) { wg[j] = *(const f32x4*)(cw + (size_t)j * (2 * DFF) + gc); wu[j] = *(const f32x4*)(cw + (size_t)j * (2 * DFF) + DFF + gc); }
            const f32x4 bg = *(const f32x4*)(cb + gc), bu = *(const f32x4*)(cb + DFF + gc);
#pragma unroll
            for (int ai = 0; ai < 2; ++ai) {
                const int gidx = ai * 2 + wr;
                f32x4 pe[2], ne[2];
#pragma unroll
                for (int n = 0; n < 2; ++n) {
                    pe[n] = (gidx > 0) ? *(const LAS f32x4*)(XC + (((gidx - 1) * 2) + 1) * 256 + bj * 128 + colw + 4 * n) : (f32x4){0.f, 0.f, 0.f, 0.f};
                    ne[n] = (gidx < 3) ? *(const LAS f32x4*)(XC + (((gidx + 1) * 2) + 0) * 256 + bj * 128 + colw + 4 * n) : (f32x4){0.f, 0.f, 0.f, 0.f}; }
#pragma unroll
                for (int m = 0; m < 4; ++m) {
                    const int slot = ai * 128 + slot0 + m * 16, row = row_base + slot, t = row & (SEQ - 1);
                    f32x4 hv[2];
#pragma unroll
                    for (int n = 0; n < 2; ++n) {
                        const f32x4 cur = acc[ai][bj][m][n], prv = acc[ai][bj][m == 0 ? 0 : m - 1][n], nxt = acc[ai][bj][m == 3 ? 3 : m + 1][n];
                        f32x4 up, dn;
#pragma unroll
                        for (int e = 0; e < 4; ++e) { up[e] = dpp_ror1(fr == 15 ? prv[e] : cur[e]); dn[e] = dpp_ror15(fr == 0 ? nxt[e] : cur[e]); }
                        if (m == 0 && fr == 0) up = pe[n];
                        if (m == 3 && fr == 15) dn = ne[n];
                        if (t == 0) up = (f32x4){0.f, 0.f, 0.f, 0.f};
                        if (t == SEQ - 1) dn = (f32x4){0.f, 0.f, 0.f, 0.f};
                        const f32x4 w0 = n ? wu[0] : wg[0], w1 = n ? wu[1] : wg[1], w2 = n ? wu[2] : wg[2], bb = n ? bu : bg;
                        hv[n] = w0 * up + w1 * cur + w2 * dn + bb; }
                    if (slot >= 1 && slot <= 254 && row < NT) {
                        float o[4];
#pragma unroll
                        for (int e = 0; e < 4; ++e) { const float g = hv[0][e]; o[e] = g / (1.0f + __expf(-g)) * hv[1][e]; }
                        u32x2 w; w.x = pk2(o[0], o[1]); w.y = pk2(o[2], o[3]);
                        *(u32x2*)(ACT + (size_t)row * DFF + gc) = w; }
                }
            }
        }
    }
};

__device__ __forceinline__ int win_row(int n) {
    if (n < 1536) return 1536 + n;
    if (n < 2560) { const int q = n - 1536, blk = q >> 6, d = q & 63; return blk * 64 + 2 * (d & 31) + (d >> 5); }
    if (n < 3072) return 512 + n;
    return n - 2048;
}
template <int MODE> __device__ __forceinline__ void p0_transpose_item(const float* W, int K, int N, bf16_t* WT, LAS float* scr, int item, int lane) {
    const int nblk = N / 32, kb = item / nblk, nb = item % nblk, k0 = 64 * kb, n0 = 32 * nb;
#pragma unroll 8
    for (int i = 0; i < 32; ++i) { const int kk = 2 * i + (lane >> 5); scr[kk * 33 + (lane & 31)] = W[(size_t)(k0 + kk) * N + n0 + (lane & 31)]; }
    LDS_WAIT(); asm volatile("" ::: "memory");
    const int c = lane & 7;
#pragma unroll
    for (int j = 0; j < 4; ++j) { const int n = (lane >> 3) + 8 * j; const LAS float* s = scr + (8 * c) * 33 + n;
        u32x4 o; o.x = pk2(s[0 * 33], s[1 * 33]); o.y = pk2(s[2 * 33], s[3 * 33]); o.z = pk2(s[4 * 33], s[5 * 33]); o.w = pk2(s[6 * 33], s[7 * 33]);
        const int nn = n0 + n; const int dr = (MODE == 1) ? win_row(nn) : (MODE == 2) ? ((nn < DFF) ? ((nn >> 2) * 8 + (nn & 3)) : (((nn - DFF) >> 2) * 8 + 4 + ((nn - DFF) & 3))) : nn;
        *(u32x4*)(WT + (size_t)dr * K + k0 + 8 * c) = o; }
    LDS_WAIT(); asm volatile("" ::: "memory");
}
__device__ __forceinline__ void cvt_rows(const float* src, bf16_t* dst, size_t n8, int gw, int ngw, int lane) {
    for (size_t i = (size_t)gw * 64 + lane; i < n8; i += (size_t)ngw * 64) {
        const f32x4 a = ((const f32x4*)src)[2 * i], b = ((const f32x4*)src)[2 * i + 1];
        u32x4 w; w.x = pk2(a[0], a[1]); w.y = pk2(a[2], a[3]); w.z = pk2(b[0], b[1]); w.w = pk2(b[2], b[3]);
        ((u32x4*)dst)[i] = w; }
}
__device__ __forceinline__ void p0_filter_item(const float* w1, const float* b1, const float* fq, const float* w2, const float* b2, const float* w3, float* HTD, int item, int lane) {
    const int t0 = 2 * (item >> 2), ih = item & 3; float h2v[2], tl[2];
    const float fql = fq[lane], b1l = b1[lane], b2l = b2[lane];
#pragma unroll
    for (int tt = 0; tt < 2; ++tt) { const int t = t0 + tt; tl[tt] = (float)t * (1.0f / 2047.0f);
        const float w = 6.283185307179586f * (float)t / 2048.0f;
        float zk = 0.f;
        if (lane == 0) zk = tl[tt];
        else if (lane <= 16) { const float fr = 1e-4f + (float)(lane - 1) * ((15.0f - 1e-4f) / 15.0f); zk = cosf(fr * w); }
        else if (lane <= 32) { const float fr = 1e-4f + (float)(lane - 17) * ((15.0f - 1e-4f) / 15.0f); zk = -sinf(fr * w); }
        float a = b1l;
#pragma unroll 11
        for (int k = 0; k < 33; ++k) a += __shfl(zk, k) * w1[k * 64 + lane];
        const float h1 = sinf(fql * a);
        float a2 = b2l;
#pragma unroll 16
        for (int k = 0; k < 64; ++k) a2 += __shfl(h1, k) * w2[k * 64 + lane];
        h2v[tt] = sinf(fql * a2); }
    const float dmin = -15.350567286626973f, dmax = -3.0701134573253946f;
    float acc0[8], acc1[8];
#pragma unroll
    for (int i = 0; i < 8; ++i) { acc0[i] = 0.f; acc1[i] = 0.f; }
#pragma unroll 4
    for (int j = 0; j < 64; ++j) { const float s0 = __shfl(h2v[0], j), s1 = __shfl(h2v[1], j); const float* wr = w3 + (size_t)j * 2048 + ih * 512 + lane;
#pragma unroll
        for (int i = 0; i < 8; ++i) { const float wv = wr[64 * i]; acc0[i] += s0 * wv; acc1[i] += s1 * wv; } }
#pragma unroll
    for (int i = 0; i < 8; ++i) { const int col = ih * 512 + 64 * i + lane, c = col & 511;
        const float delta = fabsf(dmin + (float)c * ((dmax - dmin) / 511.0f));
        float2 o; o.x = acc0[i] * expf(-tl[0] * delta); o.y = acc1[i] * expf(-tl[1] * delta);
        *(float2*)(HTD + (size_t)col * 2048 + t0) = o; }
}
__device__ __forceinline__ void p0_prep(const float* const* in, unsigned char* ws, LAS unsigned char* lds, int tid) {
    const int lane = tid & 63, wave = tid >> 6, gw = blockIdx.x * NWAVE + wave, ngw = gridDim.x * NWAVE;
    LAS float* scr = (LAS float*)(lds + wave * 16384);
    bf16_t* WALL = (bf16_t*)(ws + WS_WALL);
    constexpr int I_IN = 16 * (INW / 32), I_KV = 16 * 32, I_OUT = 24 * 32, I_UP = 16 * (2 * DFF / 32), I_DN = (DFF / 64) * 32, NIT = I_IN + I_KV + I_OUT + I_UP + I_DN;
    for (int it = gw; it < NIT; it += ngw) { int r = it;
        if (r < I_IN) { p0_transpose_item<1>(in[2], DM, INW, WALL, scr, r, lane); continue; } r -= I_IN;
        if (r < I_KV) { p0_transpose_item<0>(in[14], DM, 1024, (bf16_t*)(ws + WS_WKV), scr, r, lane); continue; } r -= I_KV;
        if (r < I_OUT) { p0_transpose_item<0>(in[15], MIXW, DM, (bf16_t*)(ws + WS_WOUT), scr, r, lane); continue; } r -= I_OUT;
        if (r < I_UP) { p0_transpose_item<2>(in[18], DM, 2 * DFF, (bf16_t*)(ws + WS_WUP), scr, r, lane); continue; } r -= I_UP;
        p0_transpose_item<0>(in[21], DFF, DM, (bf16_t*)(ws + WS_WDN), scr, r, lane); }
    for (int it = ngw - 1 - gw; it < 4096; it += ngw) p0_filter_item(in[5], in[6], in[7], in[8], in[9], in[10], (float*)(ws + WS_HTD), it, lane);
    cvt_rows(in[0], (bf16_t*)(ws + WS_XB), (size_t)NT * DM / 8, gw, ngw, lane);
    cvt_rows(in[1], (bf16_t*)(ws + WS_MEMB), (size_t)NMT * DM / 8, gw, ngw, lane);
    float2* rope = (float2*)(ws + WS_ROPE);
    for (int i = blockIdx.x * NTHR + tid; i < SEQ * 32; i += gridDim.x * NTHR) { const int pos = i >> 5, f = i & 31;
        const float invf = powf(10000.0f, -(float)(2 * f) / 64.0f); const float ang = (float)pos * invf;
        float2 cs; cs.x = cosf(ang); cs.y = sinf(ang); rope[i] = cs; }
}

__device__ __forceinline__ void filter_fft_item(const float* HTD, float2* KF, LAS unsigned char* lds, int item, int tid) {
    const int o = item >> 9, c = item & 511;
    const float* rf = HTD + (size_t)((o * 2 + 0) * 512 + c) * 2048; const float* rb = HTD + (size_t)((o * 2 + 1) * 512 + c) * 2048;
    cplx v[8];
#pragma unroll
    for (int k = 0; k < 4; ++k) v[k] = mk2(rf[tid + 512 * k], 0.f);
    v[4] = mk2(tid == 0 ? 0.f : rb[2048 - tid], 0.f); v[5] = mk2(rb[1536 - tid], 0.f); v[6] = mk2(rb[1024 - tid], 0.f); v[7] = mk2(rb[512 - tid], 0.f);
    fft_fwd((LAS cplx*)lds, tid, v);
    float2* dst = KF + (size_t)(o * 512 + c) * 4096 + 8 * tid;
#pragma unroll
    for (int m = 0; m < 8; m += 2) { f32x4 w; w[0] = v[m].x * (1.f / 4096.f); w[1] = v[m].y * (1.f / 4096.f); w[2] = v[m + 1].x * (1.f / 4096.f); w[3] = v[m + 1].y * (1.f / 4096.f); *(f32x4*)(dst + m) = w; }
    __syncthreads();
}

constexpr int HY_SEG = 2064, HY_STG_OFF = 36864;
__device__ __forceinline__ float conv3s(const LAS bf16_t* seg, int n, float w0, float w1, float w2, float b) {
    return w0 * bf2f(seg[7 + n]) + w1 * bf2f(seg[8 + n]) + w2 * bf2f(seg[9 + n]) + b;
}
__device__ __forceinline__ void hyena_item(const bf16_t* HT, const float2* KF, const float* cw, const float* cb, const float* hb, bf16_t* MIX, LAS unsigned char* lds, int bp, int cgp, int tid0) {
    LAS cplx* X = (LAS cplx*)lds; LAS bf16_t* STG = (LAS bf16_t*)(lds + HY_STG_OFF); LAS cplx* TW = (LAS cplx*)(lds + 65536);
    const int ba = 2 * bp;
    twid_fill<512>(TW, tid0); twid_fill<64>(TW, tid0); twid_fill<8>(TW, tid0);
    u32x4 oacc[8];
#pragma unroll
    for (int i = 0; i < 8; ++i) oacc[i] = (u32x4){0u, 0u, 0u, 0u};
    if (tid0 < 12) { const int sg = tid0 >> 1; STG[sg * HY_SEG + ((tid0 & 1) ? 2056 : 7)] = 0; }
    { const int c = cgp * 8;
#pragma unroll
      for (int i = 0; i < 3; ++i) { const int id = tid0 + 512 * i, sg = id >> 8, ch = id & 255;
          const u32x4 q = *(const u32x4*)(HT + (size_t)((sg >> 1) * 512 + c) * NT + (ba + (sg & 1)) * SEQ + ch * 8);
          *(LAS u32x4*)(STG + sg * HY_SEG + 8 + ch * 8) = q; } }
    __syncthreads();
#pragma unroll 1
    for (int cc = 0; cc < 8; ++cc) {
        const int c = cgp * 8 + cc;
        int tl_ = tid0; asm volatile("" : "+v"(tl_)); const int tid = tl_;
        u32x4 nx[3];
        if (cc < 7) {
#pragma unroll
            for (int i = 0; i < 3; ++i) { const int id = tid + 512 * i, sg = id >> 8, ch = id & 255;
                nx[i] = *(const u32x4*)(HT + (size_t)((sg >> 1) * 512 + c + 1) * NT + (ba + (sg & 1)) * SEQ + ch * 8); } }
        f32x4 kf[4];
        { const f32x4* kp = (const f32x4*)(KF + (size_t)c * 4096 + 8 * tid);
#pragma unroll
          for (int m = 0; m < 4; ++m) kf[m] = kp[m]; }
        cplx v[8]; float va[4], vb[4];
        { const float w0 = cw[c], w1 = cw[1536 + c], w2 = cw[3072 + c], b = cb[c];
#pragma unroll
          for (int k = 0; k < 4; ++k) { const int n = tid + 512 * k; va[k] = conv3s(STG, n, w0, w1, w2, b); vb[k] = conv3s(STG + HY_SEG, n, w0, w1, w2, b); v[k] = mk2(va[k], vb[k]); v[4 + k] = mk2(0.f, 0.f); } }
        fft_fwdL(X, TW, tid, v);
#pragma unroll
        for (int m = 0; m < 8; m += 2) { const f32x4 w = kf[m >> 1]; v[m] = cmul(v[m], mk2(w[0], w[1])); v[m + 1] = cmul(v[m + 1], mk2(w[2], w[3])); }
        { const f32x4* kp = (const f32x4*)(KF + (size_t)(512 + c) * 4096 + 8 * tid);
#pragma unroll
          for (int m = 0; m < 4; ++m) kf[m] = kp[m]; }
        fft_invL(X, TW, tid, v);
        { const float w0 = cw[512 + c], w1 = cw[1536 + 512 + c], w2 = cw[3072 + 512 + c], b = cb[512 + c], hb0 = hb[c];
#pragma unroll
          for (int k = 0; k < 4; ++k) { const int n = tid + 512 * k; const float xa = conv3s(STG + 2 * HY_SEG, n, w0, w1, w2, b), xb = conv3s(STG + 3 * HY_SEG, n, w0, w1, w2, b);
              va[k] = xa * (v[k].x + hb0 * va[k]); vb[k] = xb * (v[k].y + hb0 * vb[k]); v[k] = mk2(va[k], vb[k]); v[4 + k] = mk2(0.f, 0.f); } }
        fft_fwdL(X, TW, tid, v);
#pragma unroll
        for (int m = 0; m < 8; m += 2) { const f32x4 w = kf[m >> 1]; v[m] = cmul(v[m], mk2(w[0], w[1])); v[m + 1] = cmul(v[m + 1], mk2(w[2], w[3])); }
        fft_invL(X, TW, tid, v);
        { const float w0 = cw[1024 + c], w1 = cw[1536 + 1024 + c], w2 = cw[3072 + 1024 + c], b = cb[1024 + c], hb1 = hb[512 + c];
#pragma unroll
          for (int k = 0; k < 4; ++k) { const int n = tid + 512 * k; const float xa = conv3s(STG + 4 * HY_SEG, n, w0, w1, w2, b), xb = conv3s(STG + 5 * HY_SEG, n, w0, w1, w2, b);
              const float oa = xa * (v[k].x + hb1 * va[k]), ob = xb * (v[k].y + hb1 * vb[k]);
              const unsigned pw = pk2(oa, ob);
#pragma unroll
              for (int hh = 0; hh < 2; ++hh) { u32x4& o = oacc[2 * k + hh]; const unsigned nw = hh ? (pw & 0xffff0000u) : (pw << 16);
                  o.x = __builtin_amdgcn_alignbit(o.y, o.x, 16); o.y = __builtin_amdgcn_alignbit(o.z, o.y, 16); o.z = __builtin_amdgcn_alignbit(o.w, o.z, 16); o.w = (o.w >> 16) | nw; } } }
        __syncthreads();
        if (cc < 7) {
#pragma unroll
            for (int i = 0; i < 3; ++i) { const int id = tid + 512 * i, sg = id >> 8, ch = id & 255; *(LAS u32x4*)(STG + sg * HY_SEG + 8 + ch * 8) = nx[i]; } }
        __syncthreads();
    }
    int tw_ = tid0; asm volatile("" : "+v"(tw_)); const int tid = tw_;
#pragma unroll
    for (int k = 0; k < 4; ++k)
#pragma unroll
        for (int hh = 0; hh < 2; ++hh) *(u32x4*)(MIX + (size_t)((ba + hh) * SEQ + tid + 512 * k) * MIXW + cgp * 8) = oacc[2 * k + hh];
}

constexpr int ATT_KP = 272, ATT_VP = 144, ATT_KB = 64 * ATT_KP, ATT_VB = 128 * ATT_VP, ATT_VOFF = 2 * ATT_KB;
template <int NC> __device__ __forceinline__ void attn_unit(LAS unsigned char* lds, const bf16_t* Qp, int ldq, const bf16_t* Kp, int ldk, const bf16_t* Vt, int ldv, int nkeys, float sl2,
                                                            bf16_t* Op, int ldo, float lam, const float* subg, int tid) {
    constexpr int NSTEP = (NC == 2) ? 4 : 8;
    const int lane = tid & 63, wave = tid >> 6, r = lane & 31, h = lane >> 5;
    const int qb = (NC == 2) ? (wave & 3) : wave, comp = (NC == 2) ? (wave >> 2) : 0, dbase = comp * 64;
    bf16x8 qf[NSTEP];
#pragma unroll
    for (int st = 0; st < NSTEP; ++st) qf[st] = *(const bf16x8*)(Qp + (size_t)(qb * 32 + r) * ldq + dbase + 16 * st + 8 * h);
    f32x16 o[4];
#pragma unroll
    for (int et = 0; et < 4; ++et)
#pragma unroll
        for (int i = 0; i < 16; ++i) o[et][i] = 0.f;
    float mold = -INFINITY, lsum = 0.f;
    const int kr0 = tid >> 4, kc = tid & 15, vr0 = tid >> 3, vc = tid & 7;
    const bf16_t* kg = Kp + (size_t)kr0 * ldk + kc * 8; const bf16_t* vg = Vt + (size_t)vr0 * ldv + vc * 8;
    const int kl = kr0 * ATT_KP + kc * 16, vl = ATT_VOFF + vr0 * ATT_VP + vc * 16;
    const int nt = nkeys / 64;
    u32x4 pk0, pk1, pv0, pv1;
    pk0 = *(const u32x4*)(kg); pk1 = *(const u32x4*)(kg + (size_t)32 * ldk); pv0 = *(const u32x4*)(vg); pv1 = *(const u32x4*)(vg + (size_t)64 * ldv);
    *(LAS u32x4*)(lds + kl) = pk0; *(LAS u32x4*)(lds + kl + 32 * ATT_KP) = pk1; *(LAS u32x4*)(lds + vl) = pv0; *(LAS u32x4*)(lds + vl + 64 * ATT_VP) = pv1;
    __syncthreads();
    for (int it = 0; it < nt; ++it) {
        const int cur = it & 1; const bool more = (it + 1 < nt);
        if (more) { const bf16_t* kg2 = kg + (size_t)(it + 1) * 64 * ldk; const bf16_t* vg2 = vg + (it + 1) * 64;
            pk0 = *(const u32x4*)(kg2); pk1 = *(const u32x4*)(kg2 + (size_t)32 * ldk); pv0 = *(const u32x4*)(vg2); pv1 = *(const u32x4*)(vg2 + (size_t)64 * ldv); }
        LAS unsigned char* Kb = lds + cur * ATT_KB; LAS unsigned char* Vb = lds + ATT_VOFF + cur * ATT_VB;
        f32x16 s[2];
#pragma unroll
        for (int kb = 0; kb < 2; ++kb) {
#pragma unroll
            for (int i = 0; i < 16; ++i) s[kb][i] = 0.f;
#pragma unroll
            for (int st = 0; st < NSTEP; ++st) { const bf16x8 a = *(const LAS bf16x8*)(Kb + (kb * 32 + r) * ATT_KP + (dbase + 16 * st + 8 * h) * 2);
                s[kb] = __builtin_amdgcn_mfma_f32_32x32x16_bf16(a, qf[st], s[kb], 0, 0, 0); } }
        float mx = s[0][0];
#pragma unroll
        for (int i = 1; i < 16; ++i) mx = fmaxf(mx, s[0][i]);
#pragma unroll
        for (int i = 0; i < 16; ++i) mx = fmaxf(mx, s[1][i]);
        mx = fmaxf(mx, __shfl_xor(mx, 32));
        const float mnew = fmaxf(mold, mx * sl2), alpha = __builtin_amdgcn_exp2f(mold - mnew); mold = mnew;
        float ps = 0.f;
#pragma unroll
        for (int kb = 0; kb < 2; ++kb)
#pragma unroll
            for (int i = 0; i < 16; ++i) { const float p = __builtin_amdgcn_exp2f(__builtin_fmaf(s[kb][i], sl2, -mnew)); s[kb][i] = p; ps += p; }
        lsum = lsum * alpha + ps;
#pragma unroll
        for (int et = 0; et < 4; ++et)
#pragma unroll
            for (int i = 0; i < 16; ++i) o[et][i] *= alpha;
#pragma unroll
        for (int kb = 0; kb < 2; ++kb)
#pragma unroll
            for (int s2 = 0; s2 < 2; ++s2) {
                u32x4 pw; pw.x = pk2(s[kb][8 * s2 + 0], s[kb][8 * s2 + 1]); pw.y = pk2(s[kb][8 * s2 + 2], s[kb][8 * s2 + 3]); pw.z = pk2(s[kb][8 * s2 + 4], s[kb][8 * s2 + 5]); pw.w = pk2(s[kb][8 * s2 + 6], s[kb][8 * s2 + 7]);
                const bf16x8 pf = __builtin_bit_cast(bf16x8, pw);
#pragma unroll
                for (int et = 0; et < 4; ++et) { const LAS unsigned char* vp = Vb + (et * 32 + r) * ATT_VP + (kb * 32 + 16 * s2 + 4 * h) * 2;
                    const u32x2 lo = *(const LAS u32x2*)vp, hi = *(const LAS u32x2*)(vp + 16);
                    u32x4 aw; aw.x = lo.x; aw.y = lo.y; aw.z = hi.x; aw.w = hi.y;
                    o[et] = __builtin_amdgcn_mfma_f32_32x32x16_bf16(__builtin_bit_cast(bf16x8, aw), pf, o[et], 0, 0, 0); } }
        if (more) { const int nb = cur ^ 1;
            *(LAS u32x4*)(lds + nb * ATT_KB + kl) = pk0; *(LAS u32x4*)(lds + nb * ATT_KB + kl + 32 * ATT_KP) = pk1;
            *(LAS u32x4*)(lds + nb * ATT_VB + vl) = pv0; *(LAS u32x4*)(lds + nb * ATT_VB + vl + 64 * ATT_VP) = pv1; }
        __syncthreads();
    }
    lsum += __shfl_xor(lsum, 32);
    const float inv = 1.0f / lsum;
    if (NC == 1) {
        bf16_t* orow = Op + (size_t)(qb * 32 + r) * ldo;
#pragma unroll
        for (int et = 0; et < 4; ++et)
#pragma unroll
            for (int g = 0; g < 4; ++g) { u32x2 w; w.x = pk2(o[et][4 * g] * inv, o[et][4 * g + 1] * inv); w.y = pk2(o[et][4 * g + 2] * inv, o[et][4 * g + 3] * inv);
                *(u32x2*)(orow + et * 32 + 8 * g + 4 * h) = w; }
    } else {
        LAS float* XL = (LAS float*)lds;
        if (comp == 1) {
#pragma unroll
            for (int et = 0; et < 4; ++et)
#pragma unroll
                for (int i = 0; i < 16; ++i) XL[(qb * 64 + et * 16 + i) * 64 + lane] = o[et][i] * inv;
        }
        __syncthreads();
        if (comp == 0) {
            float ss = 0.f;
#pragma unroll
            for (int et = 0; et < 4; ++et)
#pragma unroll
                for (int i = 0; i < 16; ++i) { const float ov = o[et][i] * inv - lam * XL[(qb * 64 + et * 16 + i) * 64 + lane]; o[et][i] = ov; ss += ov * ov; }
            ss += __shfl_xor(ss, 32);
            const float rs = rsqrtf(ss * (1.0f / 128.0f) + RMS_EPS) * 0.8f;
            bf16_t* orow = Op + (size_t)(qb * 32 + r) * ldo;
#pragma unroll
            for (int et = 0; et < 4; ++et)
#pragma unroll
                for (int g = 0; g < 4; ++g) { const int e = et * 32 + 8 * g + 4 * h; const f32x4 gv = *(const f32x4*)(subg + e);
                    u32x2 w; w.x = pk2(o[et][4 * g] * rs * gv[0], o[et][4 * g + 1] * rs * gv[1]); w.y = pk2(o[et][4 * g + 2] * rs * gv[2], o[et][4 * g + 3] * rs * gv[3]);
                    *(u32x2*)(orow + e) = w; }
        }
        __syncthreads();
    }
}

template <bool TO_BF16> __device__ __forceinline__ void ln_rows(float* io, bf16_t* ob, float2* stat, const float* g, const float* b, int tid) {
    const int lane = tid & 63, gw = blockIdx.x * NWAVE + (tid >> 6), ngw = gridDim.x * NWAVE;
    f32x4 gv[4], bv[4];
#pragma unroll
    for (int j = 0; j < 4; ++j) { gv[j] = ((const f32x4*)g)[lane + 64 * j]; bv[j] = ((const f32x4*)b)[lane + 64 * j]; }
    for (int row = gw; row < NT; row += ngw) {
        f32x4* xr = (f32x4*)(io + (size_t)row * DM) + lane; f32x4 v[4]; float s = 0.f;
#pragma unroll
        for (int j = 0; j < 4; ++j) { v[j] = xr[64 * j]; s += (v[j][0] + v[j][1]) + (v[j][2] + v[j][3]); }
#pragma unroll
        for (int o = 1; o < 64; o <<= 1) s += __shfl_xor(s, o);
        const float mean = s * (1.0f / DM); float s2 = 0.f;
#pragma unroll
        for (int j = 0; j < 4; ++j) { v[j] = v[j] - mean; s2 += (v[j][0] * v[j][0] + v[j][1] * v[j][1]) + (v[j][2] * v[j][2] + v[j][3] * v[j][3]); }
#pragma unroll
        for (int o = 1; o < 64; o <<= 1) s2 += __shfl_xor(s2, o);
        const float rstd = rsqrtf(s2 * (1.0f / DM) + LN_EPS);
        if (TO_BF16) {
            u32x2* o8 = (u32x2*)(ob + (size_t)row * DM) + lane;
#pragma unroll
            for (int j = 0; j < 4; ++j) { const f32x4 y = v[j] * rstd * gv[j] + bv[j]; u32x2 w; w.x = pk2(y[0], y[1]); w.y = pk2(y[2], y[3]); o8[64 * j] = w; }
            if (lane == 0) { float2 st; st.x = mean; st.y = rstd; stat[row] = st; }
        } else {
#pragma unroll
            for (int j = 0; j < 4; ++j) xr[64 * j] = v[j] * rstd * gv[j] + bv[j];
        }
    }
}

__device__ __forceinline__ void convgate_half(const bf16_t* HH, bf16_t* ACT, const float* cw, const float* cb, int half, int tid) {
    constexpr int NG = DFF / 8; const int total = (NT / 2) * NG;
    for (int idx = blockIdx.x * NTHR + tid; idx < total; idx += gridDim.x * NTHR) {
        const int rl = idx / NG, cg8 = idx - rl * NG, n0 = cg8 * 8, t = rl & (SEQ - 1);
        const bf16_t* hp = HH + (size_t)rl * (2 * DFF);
        float gsum[8], usum[8];
#pragma unroll
        for (int e = 0; e < 8; ++e) { gsum[e] = cb[n0 + e]; usum[e] = cb[DFF + n0 + e]; }
#pragma unroll
        for (int j = 0; j < 3; ++j) { const int tt = t + j - 1; if (tt < 0 || tt >= SEQ) continue;
            const u32x4 gq = *(const u32x4*)(hp + (ptrdiff_t)(j - 1) * (2 * DFF) + n0), uq = *(const u32x4*)(hp + (ptrdiff_t)(j - 1) * (2 * DFF) + DFF + n0);
            const float* wg = cw + (size_t)j * (2 * DFF) + n0; const float* wu = wg + DFF;
            const f32x4 wg0 = *(const f32x4*)wg, wg1 = *(const f32x4*)(wg + 4), wu0 = *(const f32x4*)wu, wu1 = *(const f32x4*)(wu + 4);
            gsum[0] += wg0[0] * lo2f(gq.x); gsum[1] += wg0[1] * hi2f(gq.x); gsum[2] += wg0[2] * lo2f(gq.y); gsum[3] += wg0[3] * hi2f(gq.y);
            gsum[4] += wg1[0] * lo2f(gq.z); gsum[5] += wg1[1] * hi2f(gq.z); gsum[6] += wg1[2] * lo2f(gq.w); gsum[7] += wg1[3] * hi2f(gq.w);
            usum[0] += wu0[0] * lo2f(uq.x); usum[1] += wu0[1] * hi2f(uq.x); usum[2] += wu0[2] * lo2f(uq.y); usum[3] += wu0[3] * hi2f(uq.y);
            usum[4] += wu1[0] * lo2f(uq.z); usum[5] += wu1[1] * hi2f(uq.z); usum[6] += wu1[2] * lo2f(uq.w); usum[7] += wu1[3] * hi2f(uq.w); }
        float a[8];
#pragma unroll
        for (int e = 0; e < 8; ++e) a[e] = gsum[e] / (1.0f + __expf(-gsum[e])) * usum[e];
        u32x4 w; w.x = pk2(a[0], a[1]); w.y = pk2(a[2], a[3]); w.z = pk2(a[4], a[5]); w.w = pk2(a[6], a[7]);
        *(u32x4*)(ACT + (size_t)(half * (NT / 2) + rl) * DFF + n0) = w;
    }
}

#define XB_TMO      128
#define XB_XCNT(j)  (256  + 64 * (j))
#define XB_XSUB(j)  (1280 + 64 * (j))
#define XB_XGEN(j)  (2304 + 64 * (j))
#define XB_TOP      3328
#define XB_TOPGEN   3392
#define XCD_BAR_WORDS 3456
#define XB_SPIN_CAP (1u << 18)

__device__ __forceinline__ unsigned xb_ld(unsigned* p)              { return __hip_atomic_load(p, __ATOMIC_RELAXED, __HIP_MEMORY_SCOPE_AGENT); }
__device__ __forceinline__ unsigned xb_add(unsigned* p, unsigned v) { return __hip_atomic_fetch_add(p, v, __ATOMIC_RELAXED, __HIP_MEMORY_SCOPE_AGENT); }
__device__ __forceinline__ unsigned xb_xcc_id() { return (unsigned)__builtin_amdgcn_s_getreg((3 << 11) | 20) & 0xFu; }
#define XB_SPIN(cond, bar) do { unsigned _sp = 0; while (cond) { __builtin_amdgcn_s_sleep(1); \
    if ((++_sp & 255u) == 0u) { if (xb_ld(&(bar)[XB_TMO])) break; if (_sp > XB_SPIN_CAP) { atomicAdd(&(bar)[XB_TMO], 1u); break; } } } } while (0)

struct XcdBarrier {
    unsigned* bar; unsigned x;
    volatile LAS unsigned* st;
};

__device__ __forceinline__ XcdBarrier xcd_barrier_post(unsigned* bar, volatile LAS unsigned* st) {
    XcdBarrier b; b.bar = bar; b.x = xb_xcc_id(); b.st = st;
    if (threadIdx.x == 0) (void)xb_add(&bar[XB_XCNT(b.x)], 1u);
    return b;
}
__device__ __forceinline__ void xcd_barrier_complete(unsigned* bar, unsigned x, unsigned& nloc, unsigned& nx) {
    const unsigned G = gridDim.x * gridDim.y * gridDim.z;
    unsigned sum, cnt, mine, sp = 0u;
    for (;;) {
        sum = 0u; cnt = 0u; mine = 0u;
#pragma unroll
        for (unsigned j = 0; j < 16; ++j) { const unsigned c = xb_ld(&bar[XB_XCNT(j)]); sum += c; cnt += (c > 0u) ? 1u : 0u; mine = (j == x) ? c : mine; }
        if (sum == G) break;
        __builtin_amdgcn_s_sleep(1);
        if ((++sp & 255u) == 0u) { if (xb_ld(&bar[XB_TMO])) break; if (sp > XB_SPIN_CAP) { atomicAdd(&bar[XB_TMO], 1u); break; } }
    }
    nloc = mine > 0u ? mine : 1u; nx = cnt > 0u ? cnt : 1u;
}

__device__ __forceinline__ void xcd_barrier(const XcdBarrier& b) {
    asm volatile("s_waitcnt vmcnt(0)" ::: "memory");
    __syncthreads();
    if (threadIdx.x == 0) {
        unsigned* bar = b.bar;
        __builtin_amdgcn_s_waitcnt(0);
        unsigned nloc = b.st[0], nx = b.st[1];
        if (nloc == 0u) { xcd_barrier_complete(bar, b.x, nloc, nx); b.st[0] = nloc; b.st[1] = nx; }
        const unsigned old = xb_add(&bar[XB_XSUB(b.x)], 1u);
        const unsigned gen = old / nloc;
        if (old + 1u == (gen + 1u) * nloc) {
            __builtin_amdgcn_fence(__ATOMIC_RELEASE, "agent");
            asm volatile("s_waitcnt vmcnt(0)" ::: "memory");
            const unsigned og = xb_add(&bar[XB_TOP], 1u);
            const unsigned tg = og / nx;
            if (og + 1u == (tg + 1u) * nx) xb_add(&bar[XB_TOPGEN], 1u);
            else XB_SPIN(xb_ld(&bar[XB_TOPGEN]) == tg, bar);
            __builtin_amdgcn_fence(__ATOMIC_ACQUIRE, "agent");
            xb_add(&bar[XB_XGEN(b.x)], 1u);
            asm volatile("s_waitcnt vmcnt(0)" ::: "memory");
        } else {
            XB_SPIN(xb_ld(&bar[XB_XGEN(b.x)]) == gen, bar);
            __builtin_amdgcn_fence(__ATOMIC_ACQUIRE, "agent");
            asm volatile("s_waitcnt vmcnt(0)" ::: "memory");
        }
    }
    __syncthreads();
}

#ifndef PH_MASK
#define PH_MASK 0xFFFFFF
#endif
#define PH(k) ((PH_MASK >> (k)) & 1)
#ifndef REP_P0
#define REP_P0 1
#endif
#ifndef REP_G1
#define REP_G1 1
#endif
#ifndef REP_DIFF
#define REP_DIFF 1
#endif
#ifndef REP_HY
#define REP_HY 1
#endif
#ifndef REP_MEM
#define REP_MEM 1
#endif
struct Args { const float* in[24]; float* out; unsigned char* ws; };
__global__ void __launch_bounds__(NTHR, 2) hybrid_fwd(Args a) {
    extern __shared__ __attribute__((aligned(16))) unsigned char smem[];
    LAS unsigned char* lds = (LAS unsigned char*)smem;
    cg::grid_group grid = cg::this_grid();
    volatile LAS unsigned* bst = (volatile LAS unsigned*)(lds + 131072 + 64);
    if (threadIdx.x < 2) bst[threadIdx.x] = 0u;
    __syncthreads();
    const XcdBarrier bar = xcd_barrier_post((unsigned*)(a.ws + WS_BAR), bst);
    const int G = gridDim.x;
#define NEWPHASE() int tid_ = threadIdx.x, cu_ = blockIdx.x; asm volatile("" : "+v"(tid_)); asm volatile("" : "+s"(cu_)); const int tid = tid_, cu = cu_; (void)tid; (void)cu;
    unsigned char* ws = a.ws;
    bf16_t* WALL = (bf16_t*)(ws + WS_WALL); bf16_t* XB = (bf16_t*)(ws + WS_XB); bf16_t* MEMB = (bf16_t*)(ws + WS_MEMB); bf16_t* WKV = (bf16_t*)(ws + WS_WKV);
    bf16_t* QKM = (bf16_t*)(ws + WS_QKM); bf16_t* HT = (bf16_t*)(ws + WS_HT); bf16_t* KMEM = (bf16_t*)(ws + WS_KMEM); bf16_t* VMT = (bf16_t*)(ws + WS_VMT);
    float2* KF = (float2*)(ws + WS_KF); bf16_t* MIX = (bf16_t*)(ws + WS_MIX); float2* STAT = (float2*)(ws + WS_STAT);
    bf16_t* X1B = (bf16_t*)(ws + WS_X1B); bf16_t* HH = (bf16_t*)(ws + WS_HH); bf16_t* ACT = (bf16_t*)(ws + WS_ACT);

    for (int rep = 0; rep < REP_P0; ++rep) { NEWPHASE(); if (PH(0)) p0_prep(a.in, ws, lds, tid); }
    grid.sync();

    for (int rep = 0; rep < REP_G1; ++rep) {
    if (PH(1)) { NEWPHASE(); pg8::Gemm g{XB, WALL, NT, 1536, DM}; pg8::StaticOrder S; S.init(g.M, g.N, G, cu);
      EpiRope E{QKM, (const float2*)(ws + WS_ROPE)};
      pg8::gemm_phase<EpiRope, pg8::StaticOrder, true, true>(lds, g, S, E); }
    if (PH(2)) { NEWPHASE(); pg8::Gemm g{WALL + (size_t)1536 * DM, XB, 2048, NT, DM}; pg8::StaticOrder S; S.init(g.M, g.N, G, cu);
      EpiB E{HT, NT};
      pg8::gemm_phase<EpiB, pg8::StaticOrder, true, true>(lds, g, S, E); }
    }
    if (PH(3)) { NEWPHASE(); const bool isK = cu < 32, on = cu < 64; const int c2 = cu - 32;
      pg8::Gemm g; EpiB E; OneUnit S;
      if (isK) { g = pg8::Gemm{MEMB, WKV, NMT, 512, DM}; E = EpiB{KMEM, 512}; S = OneUnit{cu >> 1, cu & 1, on}; }
      else { g = pg8::Gemm{WKV + (size_t)512 * DM, MEMB, 512, NMT, DM}; E = EpiB{VMT, NMT}; S = OneUnit{(c2 >> 4) & 1, c2 & 15, on}; }
      pg8::gemm_phase<EpiB, OneUnit, false, true>(lds, g, S, E);
      __syncthreads();
      if (!on) for (int it = cu - 64; it < 1024; it += G - 64) filter_fft_item((const float*)(ws + WS_HTD), KF, lds, it, tid); }
    xcd_barrier(bar);

    { NEWPHASE(); const int xcd = cu & 7, j = cu >> 3;
      float lam;
      { const float* lp = a.in[12]; const int l6 = tid & 63; float s01 = lp[l6] * lp[64 + l6], s23 = lp[128 + l6] * lp[192 + l6];
#pragma unroll
        for (int o = 1; o < 64; o <<= 1) { s01 += __shfl_xor(s01, o); s23 += __shfl_xor(s23, o); }
        lam = expf(s01) - expf(s23) + 0.2f; }
      if (PH(4)) for (int i = 0; i < 4 * REP_DIFF; ++i) {
          const int bh = ((i & 3) * 8 + xcd) * 2 + (j >> 4), qblk = j & 15, b = bh >> 2, hd = bh & 3;
          const size_t tok0 = (size_t)b * SEQ;
          attn_unit<2>(lds, QKM + (tok0 + qblk * 128) * MIXW + hd * 128, MIXW, QKM + tok0 * MIXW + 512 + hd * 128, MIXW,
                       HT + (size_t)(1536 + hd * 128) * NT + tok0, NT, SEQ, 0.125f * 1.4426950408889634f,
                       MIX + (tok0 + qblk * 128) * MIXW + 512 + hd * 128, MIXW, lam, a.in[13], tid); }
      if (PH(5)) for (int i = 0; i < 2 * REP_MEM; ++i) {
          const int bh = ((i & 1) * 8 + xcd) * 4 + (j >> 3), qblk = j & 7, b = bh >> 2, hd = bh & 3;
          const size_t tok0 = (size_t)b * SEQ;
          attn_unit<1>(lds, QKM + (tok0 + qblk * 256) * MIXW + 1024 + hd * 128, MIXW, KMEM + (size_t)b * MEMT * 512 + hd * 128, 512,
                       VMT + (size_t)(hd * 128) * NMT + b * MEMT, NMT, MEMT, 0.08838834764831845f * 1.4426950408889634f,
                       MIX + (tok0 + qblk * 256) * MIXW + 1024 + hd * 128, MIXW, 0.f, nullptr, tid); }
      if (PH(6)) for (int i = 0; i < 2 * REP_HY; ++i) {
          const int cgp = ((i & 1) * 8 + xcd) * 4 + (j >> 3), bp = j & 7;
          hyena_item(HT, KF, a.in[3], a.in[4], a.in[11], MIX, lds, bp, cgp, tid); } }
    xcd_barrier(bar);

#ifdef REP_SYNC
    for (int rep = 0; rep < REP_SYNC; ++rep) xcd_barrier(bar);
#endif
    if (PH(7)) { NEWPHASE(); pg8::Gemm g{MIX, (const bf16_t*)(ws + WS_WOUT), NT, DM, MIXW}; pg8::StaticOrder S; S.init(g.M, g.N, G, cu);
      EpiRes E{a.in[0], a.out};
      pg8::gemm_phase<EpiRes, pg8::StaticOrder, true, true>(lds, g, S, E); }
    xcd_barrier(bar);
    if (PH(8)) { NEWPHASE(); ln_rows<true>(a.out, X1B, STAT, a.in[16], a.in[17], tid); }
    xcd_barrier(bar);
    if (PH(9)) { NEWPHASE(); pg8::Gemm g{X1B, (const bf16_t*)(ws + WS_WUP), FFN_MT * 256, 2 * DFF, DM}; FfnOrder S; S.init(g.M, g.N, G, cu);
      EpiFfn E{ACT, a.in[19], a.in[20], lds};
      pg8::gemm_phase<EpiFfn, FfnOrder, true, true>(lds, g, S, E); }
    xcd_barrier(bar);
    if (PH(11)) { NEWPHASE(); pg8::Gemm g{ACT, (const bf16_t*)(ws + WS_WDN), NT, DM, DFF}; pg8::StaticOrder S; S.init(g.M, g.N, G, cu);
      EpiRes2 E{a.out, STAT, a.in[16], a.in[17]};
      pg8::gemm_phase<EpiRes2, pg8::StaticOrder, true, true>(lds, g, S, E); }
    xcd_barrier(bar);
    if (PH(12)) { NEWPHASE(); ln_rows<false>(a.out, nullptr, nullptr, a.in[22], a.in[23], tid); }
}

extern "C" void kernel_launch(void* const* d_in, const int* in_sizes, int n_in, void* d_out, int out_size, void* d_ws, size_t ws_size, hipStream_t stream) {
    static int grid = 0;
    if (grid == 0) {
        if (n_in != 24 || out_size != NT * DM || ws_size < WS_END) { fprintf(stderr, "kernel_launch: unexpected shapes (n_in %d, out %d, ws %zu)\n", n_in, out_size, ws_size); grid = -1; return; }
        int dev = 0, cus = 0, per_cu = 0;
        hipGetDevice(&dev); hipDeviceGetAttribute(&cus, hipDeviceAttributeMultiprocessorCount, dev);
        if (hipFuncSetAttribute((const void*)hybrid_fwd, hipFuncAttributeMaxDynamicSharedMemorySize, LDS_BYTES) != hipSuccess) { fprintf(stderr, "kernel_launch: hipFuncSetAttribute failed\n"); grid = -1; return; }
        if (hipOccupancyMaxActiveBlocksPerMultiprocessor(&per_cu, (const void*)hybrid_fwd, NTHR, LDS_BYTES) != hipSuccess || per_cu < 1) { fprintf(stderr, "kernel_launch: occupancy query says %d\n", per_cu); per_cu = 1; }
        (void)hipGetLastError();
        grid = cus * per_cu;
        fprintf(stderr, "kernel_launch: grid %d (cus %d x %d)\n", grid, cus, per_cu);
    }
    if (grid < 0) return;
    if (hipMemsetAsync((char*)d_ws + WS_BAR, 0, XCD_BAR_WORDS * 4, stream) != hipSuccess) { fprintf(stderr, "kernel_launch: memset failed\n"); return; }
    Args a{};
    for (int i = 0; i < 24; ++i) a.in[i] = (const float*)d_in[i];
    a.out = (float*)d_out; a.ws = (unsigned char*)d_ws;
    void* args[] = {&a};
    const hipError_t e = hipLaunchCooperativeKernel((const void*)hybrid_fwd, dim3(grid), dim3(NTHR), args, LDS_BYTES, stream);
    if (e != hipSuccess) fprintf(stderr, "kernel_launch: cooperative launch failed: %s (grid %d)\n", hipGetErrorString(e), grid);
}
```

```cpp
#include <hip/hip_runtime.h>
#include <hip/hip_cooperative_groups.h>
#include <cstdio>
#include <cstdint>
namespace cg = cooperative_groups;
#define LAS __attribute__((address_space(3)))
namespace pg8 {
#define PG8_LAS __attribute__((address_space(3)))
typedef unsigned short bf16_t;
typedef short bf16x8 __attribute__((ext_vector_type(8)));
typedef float f32x4 __attribute__((ext_vector_type(4)));
typedef unsigned u32x4 __attribute__((ext_vector_type(4)));
constexpr int BM = 256, BK = 64, HALF = 128, HTB = HALF * BK * 2  , STAGE_BYTES = 8 * HTB, NXCD = 8, WGM = 8;

__host__ __device__ __forceinline__ int lds_byte(int r, int c) { const int st = (r >> 4) * 2 + (c >> 5), rr = r & 15, cc = c & 31, ob = rr * 64 + cc * 2; return st * 1024 + (ob ^ (((ob >> 9) & 1) << 5)); }
__host__ __device__ __forceinline__ void stage_rc(int b, int& R, int& C) { const int st = b / 1024, sb = b % 1024, swz = sb ^ (((sb >> 9) & 1) << 5); R = (st >> 1) * 16 + swz / 64; C = (st & 1) * 32 + (swz % 64) / 2; }
__host__ __device__ __forceinline__ int perm32(int rho) { const int n = rho >> 4, i = rho & 15; return 8 * (i >> 2) + 4 * n + (i & 3); }

struct Unit { int pm, pn; };
struct Gemm { const bf16_t* A; const bf16_t* Bt; int M, N, K; };

struct StaticOrder {
    int nM, nN, nwg, G, c;
    __host__ __device__ void init(int M, int N, int G_, int c_) { nM = M / BM; nN = N / BM; nwg = nM * nN; G = G_; c = c_; }
    __host__ __device__ bool next(int i, Unit& u) const {
        const long L = (long)i * G + c; if (L >= nwg) return false;
        int wgid = (int)L; { const int q = nwg / NXCD, r = nwg % NXCD, xcd = wgid % NXCD, off = wgid / NXCD; wgid = (xcd < r ? xcd * (q + 1) : r * (q + 1) + (xcd - r) * q) + off; }
        const int nig = WGM * nN, gid = wgid / nig, fm = gid * WGM, gsz = (nM - fm) < WGM ? (nM - fm) : WGM;
        u.pm = fm + ((wgid % nig) % gsz); u.pn = (wgid % nig) / gsz; return true;
    }
    __device__ __forceinline__ void a_ready(const Unit&) const {}
    __device__ __forceinline__ void done(const Unit&) const {}
    __device__ __forceinline__ long a_off(const Unit& u, size_t tstep) const { return (long)((size_t)u.pm * tstep); }
};
template <class Epi, class Sched, bool ALIGN_EPI = false, bool SP2 = false>
__device__ __forceinline__ void gemm_phase(PG8_LAS unsigned char* lds, const Gemm g, const Sched& S, const Epi& E) {
    int tid_l = threadIdx.x; asm volatile("" : "+v"(tid_l)); const int tid = tid_l, wid = __builtin_amdgcn_readfirstlane(tid >> 6), lane = tid & 63, wr = wid >> 2, wc = wid & 3, fr = lane & 15, fq = lane >> 4;
    const int K = g.K, nt = K / BK;
    unsigned voffA[2], voffB[2];
#pragma unroll
    for (int i = 0; i < 2; ++i) { int R, C; stage_rc(tid * 16 + i * 8192, R, C); const int Rb = Epi::PERM ? ((R & ~31) + perm32(R & 31)) : R;
        voffA[i] = (unsigned)(R * K + C) * 2u; voffB[i] = (unsigned)(Rb * K + C) * 2u; }
    const size_t kstep = (size_t)(BK * 2);
    const size_t hstep = (size_t)HALF * K * 2;
    const size_t tstep = 2 * hstep;
    const unsigned ldsw = (unsigned)wid * 1024u;
    const int aoff = lds_byte(wr * 64 + fr, fq * 8), boff = lds_byte(wc * 32 + fr, fq * 8);
#define PG8_SA(b, h) (((b) * 2 + (h)) * HTB)
#define PG8_SB(b, h) ((4 + (b) * 2 + (h)) * HTB)
#define PG8_STAGE(bufoff, gbase, voff) do { _Pragma("unroll") for (int _i = 0; _i < 2; ++_i) \
        __builtin_amdgcn_global_load_lds((const unsigned*)((const char*)(gbase) + (voff)[_i]), (PG8_LAS unsigned*)(lds + (bufoff) + ldsw + _i * 8192), 16, 0, 0); } while (0)
#define PG8_LDA(dst, b, h) do { _Pragma("unroll") for (int m = 0; m < 4; ++m) _Pragma("unroll") for (int k = 0; k < 2; ++k) dst[m][k] = *(const PG8_LAS bf16x8*)(lds + PG8_SA(b, h) + aoff + m * 2048 + k * 1024); } while (0)
#define PG8_LDB(dst, b, h) do { _Pragma("unroll") for (int n = 0; n < 2; ++n) _Pragma("unroll") for (int k = 0; k < 2; ++k) dst[n][k] = *(const PG8_LAS bf16x8*)(lds + PG8_SB(b, h) + boff + n * 2048 + k * 1024); } while (0)
#define PG8_MMA(ai, bj, At, Bt) do { __builtin_amdgcn_s_setprio(1); _Pragma("unroll") for (int m = 0; m < 4; ++m) _Pragma("unroll") for (int n = 0; n < 2; ++n) _Pragma("unroll") for (int k = 0; k < 2; ++k) \
        acc[ai][bj][m][n] = __builtin_amdgcn_mfma_f32_16x16x32_bf16(Bt[n][k], At[m][k], acc[ai][bj][m][n], 0, 0, 0); __builtin_amdgcn_s_setprio(0); } while (0)
#define PG8_WAIT_V(n) asm volatile("s_waitcnt vmcnt(" #n ")" ::: "memory")
#define PG8_WAIT_L(n) asm volatile("s_waitcnt lgkmcnt(" #n ")" ::: "memory")
#define PG8_BAR __builtin_amdgcn_s_barrier()
#define PG8_SCHED __builtin_amdgcn_sched_barrier(0)
    Unit cur, nxt; int ui = 0;
    if (!S.next(0, cur)) return;
    f32x4 acc[2][2][4][2];
#pragma unroll
    for (int a = 0; a < 2; ++a)
#pragma unroll
        for (int b = 0; b < 2; ++b)
#pragma unroll
            for (int m = 0; m < 4; ++m)
#pragma unroll
                for (int n = 0; n < 2; ++n) acc[a][b][m][n] = (f32x4){0.f, 0.f, 0.f, 0.f};
    bf16x8 At[4][2], B0[2][2], B1[2][2];
    const char* cA = (const char*)g.A + S.a_off(cur, tstep); const char* cB = (const char*)g.Bt + (size_t)cur.pn * tstep;
    S.a_ready(cur);
    if constexpr (SP2) {
        PG8_STAGE(PG8_SB(0, 0), cB, voffB); PG8_STAGE(PG8_SB(0, 1), cB + hstep, voffB); PG8_STAGE(PG8_SA(0, 0), cA, voffA); PG8_STAGE(PG8_SA(0, 1), cA + hstep, voffA);
        if (wr == 1) PG8_BAR;
        PG8_WAIT_V(2); PG8_BAR;
        PG8_STAGE(PG8_SB(1, 0), cB + kstep, voffB); PG8_STAGE(PG8_SA(1, 0), cA + kstep, voffA); PG8_STAGE(PG8_SB(1, 1), cB + hstep + kstep, voffB);
        PG8_WAIT_V(6); PG8_BAR;
    } else {
        PG8_STAGE(PG8_SB(0, 0), cB, voffB); PG8_STAGE(PG8_SA(0, 0), cA, voffA); PG8_STAGE(PG8_SB(0, 1), cB + hstep, voffB); PG8_STAGE(PG8_SA(0, 1), cA + hstep, voffA);
        if (wr == 1) PG8_BAR;
        PG8_WAIT_V(4); PG8_BAR;
        PG8_STAGE(PG8_SB(1, 0), cB + kstep, voffB); PG8_STAGE(PG8_SA(1, 0), cA + kstep, voffA); PG8_STAGE(PG8_SB(1, 1), cB + hstep + kstep, voffB);
        PG8_WAIT_V(6); PG8_BAR;
    }
    for (;;) {
        const bool has_next = S.next(ui + 1, nxt);
        const char* nA = has_next ? (const char*)g.A + S.a_off(nxt, tstep) : cA; const char* nB = has_next ? (const char*)g.Bt + (size_t)nxt.pn * tstep : cB;
        for (int t = 0; t < nt; t += 2) {
            const bool last = (t == nt - 2);
            const char* a1 = cA + (size_t)(t + 1) * kstep;
            const char* a2 = last ? nA : cA + (size_t)(t + 2) * kstep; const char* b2 = last ? nB : cB + (size_t)(t + 2) * kstep;
            const char* a3 = a2 + kstep; const char* b3 = b2 + kstep;
            if (last && has_next) S.a_ready(nxt);
            if constexpr (SP2) {
            PG8_LDB(B0, 0, 0); PG8_LDB(B1, 0, 1); PG8_SCHED; PG8_LDA(At, 0, 0); PG8_STAGE(PG8_SA(1, 1), a1 + hstep, voffA);
            PG8_WAIT_V(8); PG8_WAIT_L(0); PG8_BAR; PG8_MMA(0, 0, At, B0); PG8_MMA(0, 1, At, B1); PG8_BAR; PG8_SCHED;
            PG8_LDA(At, 0, 1); PG8_STAGE(PG8_SB(0, 0), b2, voffB); PG8_STAGE(PG8_SB(0, 1), b2 + hstep, voffB); PG8_STAGE(PG8_SA(0, 0), a2, voffA);
            PG8_WAIT_V(8); PG8_WAIT_L(0); PG8_BAR; PG8_MMA(1, 0, At, B0); PG8_MMA(1, 1, At, B1); PG8_BAR; PG8_SCHED;
            PG8_LDB(B0, 1, 0); PG8_LDB(B1, 1, 1); PG8_SCHED; PG8_LDA(At, 1, 0); PG8_STAGE(PG8_SA(0, 1), a2 + hstep, voffA);
            PG8_WAIT_V(8); PG8_WAIT_L(0); PG8_BAR; PG8_MMA(0, 0, At, B0); PG8_MMA(0, 1, At, B1); PG8_BAR; PG8_SCHED;
            PG8_LDA(At, 1, 1); PG8_STAGE(PG8_SB(1, 0), b3, voffB); PG8_STAGE(PG8_SB(1, 1), b3 + hstep, voffB); PG8_STAGE(PG8_SA(1, 0), a3, voffA);
            PG8_WAIT_V(8); PG8_WAIT_L(0); PG8_BAR; PG8_MMA(1, 0, At, B0); PG8_MMA(1, 1, At, B1); PG8_BAR; PG8_SCHED;
            } else {
            PG8_LDB(B0, 0, 0); PG8_SCHED; PG8_LDA(At, 0, 0); PG8_STAGE(PG8_SA(1, 1), a1 + hstep, voffA);
            PG8_WAIT_L(8); PG8_BAR; PG8_WAIT_L(0); PG8_MMA(0, 0, At, B0); PG8_BAR; PG8_SCHED;
            PG8_LDB(B1, 0, 1); PG8_STAGE(PG8_SB(0, 0), b2, voffB);
            PG8_BAR; PG8_WAIT_L(0); PG8_MMA(0, 1, At, B1); PG8_BAR;
            PG8_LDA(At, 0, 1); PG8_STAGE(PG8_SA(0, 0), a2, voffA);
            PG8_BAR; PG8_WAIT_L(0); PG8_MMA(1, 0, At, B0); PG8_BAR; PG8_SCHED;
            PG8_STAGE(PG8_SB(0, 1), b2 + hstep, voffB);
            PG8_WAIT_V(6); PG8_BAR; PG8_MMA(1, 1, At, B1); PG8_BAR;
            PG8_LDB(B0, 1, 0); PG8_SCHED; PG8_LDA(At, 1, 0); PG8_STAGE(PG8_SA(0, 1), a2 + hstep, voffA);
            PG8_WAIT_L(8); PG8_BAR; PG8_WAIT_L(0); PG8_MMA(0, 0, At, B0); PG8_BAR; PG8_SCHED;
            PG8_LDB(B1, 1, 1); PG8_STAGE(PG8_SB(1, 0), b3, voffB);
            PG8_BAR; PG8_WAIT_L(0); PG8_MMA(0, 1, At, B1); PG8_BAR;
            PG8_LDA(At, 1, 1); PG8_STAGE(PG8_SA(1, 0), a3, voffA);
            PG8_BAR; PG8_WAIT_L(0); PG8_MMA(1, 0, At, B0); PG8_BAR; PG8_SCHED;
            PG8_STAGE(PG8_SB(1, 1), b3 + hstep, voffB);
            PG8_WAIT_V(6); PG8_BAR; PG8_MMA(1, 1, At, B1); PG8_BAR;
            }
        }
        if constexpr (ALIGN_EPI) { if (wr == 0) PG8_BAR; }
        if constexpr (!Epi::AFTER_DRAIN) { E(acc, cur, wr, wc, fr, fq); S.done(cur); }
        if (!has_next) break;
#pragma unroll
        for (int a = 0; a < 2; ++a)
#pragma unroll
            for (int b = 0; b < 2; ++b)
#pragma unroll
                for (int m = 0; m < 4; ++m)
#pragma unroll
                    for (int n = 0; n < 2; ++n) acc[a][b][m][n] = (f32x4){0.f, 0.f, 0.f, 0.f};
        cur = nxt; cA = nA; cB = nB; ++ui;
        if constexpr (ALIGN_EPI) { if (wr == 1) PG8_BAR; }
    }
    PG8_WAIT_V(0);
    if constexpr (!ALIGN_EPI) { if (wr == 0) PG8_BAR; }
    PG8_BAR;
    if constexpr (Epi::AFTER_DRAIN) { E.fused(acc, cur, wr, wc, fr, fq, lds, wid, lane); S.done(cur); }
#undef PG8_SA
#undef PG8_SB
#undef PG8_STAGE
#undef PG8_LDA
#undef PG8_LDB
#undef PG8_MMA
#undef PG8_WAIT_V
#undef PG8_WAIT_L
#undef PG8_BAR
#undef PG8_SCHED
}
}

using pg8::bf16_t; using pg8::bf16x8; using pg8::f32x4; using pg8::u32x4;
typedef float f32x16 __attribute__((ext_vector_type(16)));
typedef unsigned u32x2 __attribute__((ext_vector_type(2)));
typedef short bf16x4 __attribute__((ext_vector_type(4)));

constexpr int NB = 16, SEQ = 2048, DM = 1024, NT = NB * SEQ, MEMT = 256, NMT = NB * MEMT, HW = 512, INW = 3584, DFF = 2816, MIXW = 1536;
constexpr float ALPHA = 1.189207115002721f;
constexpr float LN_EPS = 1e-5f, RMS_EPS = 1e-5f;
constexpr int NTHR = 512, NWAVE = 8;
constexpr int LDS_BYTES = 143360;

constexpr size_t MiB = 1048576;
constexpr size_t WS_WALL = 0;
constexpr size_t WS_WKV  = 7 * MiB;
constexpr size_t WS_WOUT = 9 * MiB;
constexpr size_t WS_WUP  = 12 * MiB;
constexpr size_t WS_WDN  = 23 * MiB;
constexpr size_t WS_ROPE = 29 * MiB;
constexpr size_t WS_STAT = 29 * MiB + 524288;
constexpr size_t WS_XB   = 30 * MiB;
constexpr size_t WS_X1B  = 30 * MiB;
constexpr size_t WS_HTD  = 94 * MiB;
constexpr size_t WS_MEMB = 110 * MiB;
constexpr size_t WS_QKM  = 118 * MiB;
constexpr size_t WS_HT   = 214 * MiB;
constexpr size_t WS_KMEM = 342 * MiB;
constexpr size_t WS_VMT  = 346 * MiB;
constexpr size_t WS_KF   = 350 * MiB;
constexpr size_t WS_MIX  = 382 * MiB;
constexpr size_t WS_HH   = 96 * MiB;
constexpr size_t WS_ACT  = 272 * MiB;
constexpr size_t WS_BAR  = 478 * MiB;
constexpr size_t WS_END  = 478 * MiB + 65536;

__device__ __forceinline__ unsigned pk2(float lo, float hi) { unsigned r; asm volatile("v_cvt_pk_bf16_f32 %0, %1, %2" : "=v"(r) : "v"(lo), "v"(hi)); return r; }
__device__ __forceinline__ float bf2f(bf16_t v) { return __uint_as_float((unsigned)v << 16); }
__device__ __forceinline__ float lo2f(unsigned v) { return __uint_as_float(v << 16); }
__device__ __forceinline__ float hi2f(unsigned v) { return __uint_as_float(v & 0xffff0000u); }
#define LDS_WAIT() asm volatile("s_waitcnt lgkmcnt(0)" ::: "memory")

#ifndef FFT_HOST
#define FFT_FN __device__ __forceinline__
#define FFT_SYNC() __syncthreads()
typedef float cplx __attribute__((ext_vector_type(2)));
typedef LAS cplx* fftbuf_t;
FFT_FN float cos2pi(float r) { return __builtin_amdgcn_cosf(r); }
FFT_FN float sin2pi(float r) { return __builtin_amdgcn_sinf(r); }
#endif
FFT_FN cplx mk2(float x, float y) { cplx r; r.x = x; r.y = y; return r; }
FFT_FN cplx cadd(cplx a, cplx b) { return mk2(a.x + b.x, a.y + b.y); }
FFT_FN cplx csub(cplx a, cplx b) { return mk2(a.x - b.x, a.y - b.y); }
FFT_FN cplx cmul(cplx a, cplx b) { return mk2(a.x * b.x - a.y * b.y, a.x * b.y + a.y * b.x); }
template <bool INV> FFT_FN cplx muli(cplx a) { return INV ? mk2(-a.y, a.x) : mk2(a.y, -a.x); }
FFT_FN int padi(int i) { return i + (i >> 3); }

template <bool INV> FFT_FN void dft8(cplx (&v)[8]) {
    const float R = 0.70710678118654752f;
    const cplx a0 = cadd(v[0], v[4]), a1 = csub(v[0], v[4]), a2 = cadd(v[2], v[6]), a3 = muli<INV>(csub(v[2], v[6]));
    const cplx a4 = cadd(v[1], v[5]), a5 = csub(v[1], v[5]), a6 = cadd(v[3], v[7]), a7 = muli<INV>(csub(v[3], v[7]));
    const cplx b0 = cadd(a0, a2), b2 = csub(a0, a2), b1 = cadd(a1, a3), b3 = csub(a1, a3);
    const cplx b4 = cadd(a4, a6), b6 = muli<INV>(csub(a4, a6));
    const cplx t5 = cadd(a5, a7), t7 = csub(a5, a7);
    cplx b5, b7;
    if (!INV) { b5 = mk2((t5.x + t5.y) * R, (t5.y - t5.x) * R); b7 = mk2((t7.y - t7.x) * R, -(t7.x + t7.y) * R); }
    else      { b5 = mk2((t5.x - t5.y) * R, (t5.x + t5.y) * R); b7 = mk2(-(t7.x + t7.y) * R, (t7.x - t7.y) * R); }
    v[0] = cadd(b0, b4); v[4] = csub(b0, b4); v[1] = cadd(b1, b5); v[5] = csub(b1, b5);
    v[2] = cadd(b2, b6); v[6] = csub(b2, b6); v[3] = cadd(b3, b7); v[7] = csub(b3, b7);
}
template <int S, bool INV> FFT_FN void twid(cplx (&v)[8], int tid) {
    if (S > 1) {
        const int j = tid % S; const float rev = (float)j * (1.0f / (8.0f * S));
        const float c = cos2pi(rev), s = sin2pi(rev);
        const cplx w1 = mk2(c, INV ? s : -s);
        const cplx w2 = cmul(w1, w1), w3 = cmul(w2, w1), w4 = cmul(w2, w2), w5 = cmul(w4, w1), w6 = cmul(w4, w2), w7 = cmul(w4, w3);
        v[1] = cmul(v[1], w1); v[2] = cmul(v[2], w2); v[3] = cmul(v[3], w3); v[4] = cmul(v[4], w4);
        v[5] = cmul(v[5], w5); v[6] = cmul(v[6], w6); v[7] = cmul(v[7], w7);
    }
}
template <int S> FFT_FN void ld8(fftbuf_t X, int tid, cplx (&v)[8]) {
    const int base = (tid / S) * 8 * S + (tid % S);
#pragma unroll
    for (int k = 0; k < 8; ++k) v[k] = X[padi(base + S * k)];
}
template <int S> FFT_FN void st8(fftbuf_t X, int tid, const cplx (&v)[8]) {
    const int base = (tid / S) * 8 * S + (tid % S);
#pragma unroll
    for (int k = 0; k < 8; ++k) X[padi(base + S * k)] = v[k];
}
#ifndef FFT_HOST
template <int S> FFT_FN void twid_fill(fftbuf_t TW, int tid) {
    constexpr int P = (S == 512) ? 0 : (S == 64) ? 1 : 2;
    const int j = tid % S; const float rev = (float)j * (1.0f / (8.0f * S));
    const cplx w1 = mk2(cos2pi(rev), -sin2pi(rev)), w2 = cmul(w1, w1), w4 = cmul(w2, w2);
    TW[(3 * P + 0) * 512 + tid] = w1; TW[(3 * P + 1) * 512 + tid] = w2; TW[(3 * P + 2) * 512 + tid] = w4;
}
template <int S, bool INV> FFT_FN void twidL(cplx (&v)[8], fftbuf_t TW, int tid) {
    constexpr int P = (S == 512) ? 0 : (S == 64) ? 1 : 2;
    cplx w1 = TW[(3 * P + 0) * 512 + tid], w2 = TW[(3 * P + 1) * 512 + tid], w4 = TW[(3 * P + 2) * 512 + tid];
    if (INV) { w1.y = -w1.y; w2.y = -w2.y; w4.y = -w4.y; }
    const cplx w3 = cmul(w2, w1), w5 = cmul(w4, w1), w6 = cmul(w4, w2), w7 = cmul(w4, w3);
    v[1] = cmul(v[1], w1); v[2] = cmul(v[2], w2); v[3] = cmul(v[3], w3); v[4] = cmul(v[4], w4);
    v[5] = cmul(v[5], w5); v[6] = cmul(v[6], w6); v[7] = cmul(v[7], w7);
}
FFT_FN void fft_fwdL(fftbuf_t X, fftbuf_t TW, int tid, cplx (&v)[8]) {
    dft8<false>(v); twidL<512, false>(v, TW, tid); st8<512>(X, tid, v); FFT_SYNC();
    ld8<64>(X, tid, v); dft8<false>(v); twidL<64, false>(v, TW, tid); st8<64>(X, tid, v); FFT_SYNC();
    ld8<8>(X, tid, v); dft8<false>(v); twidL<8, false>(v, TW, tid); st8<8>(X, tid, v); FFT_SYNC();
    ld8<1>(X, tid, v); dft8<false>(v);
}
FFT_FN void fft_invL(fftbuf_t X, fftbuf_t TW, int tid, cplx (&v)[8]) {
    dft8<true>(v); st8<1>(X, tid, v); FFT_SYNC();
    ld8<8>(X, tid, v); twidL<8, true>(v, TW, tid); dft8<true>(v); st8<8>(X, tid, v); FFT_SYNC();
    ld8<64>(X, tid, v); twidL<64, true>(v, TW, tid); dft8<true>(v); st8<64>(X, tid, v); FFT_SYNC();
    ld8<512>(X, tid, v); twidL<512, true>(v, TW, tid); dft8<true>(v);
}
FFT_FN void fft_fwd(fftbuf_t X, int tid, cplx (&v)[8]) {
    dft8<false>(v); twid<512, false>(v, tid); st8<512>(X, tid, v); FFT_SYNC();
    ld8<64>(X, tid, v); dft8<false>(v); twid<64, false>(v, tid); st8<64>(X, tid, v); FFT_SYNC();
    ld8<8>(X, tid, v); dft8<false>(v); twid<8, false>(v, tid); st8<8>(X, tid, v); FFT_SYNC();
    ld8<1>(X, tid, v); dft8<false>(v);
}
FFT_FN void fft_inv(fftbuf_t X, int tid, cplx (&v)[8]) {
    dft8<true>(v); st8<1>(X, tid, v); FFT_SYNC();
    ld8<8>(X, tid, v); twid<8, true>(v, tid); dft8<true>(v); st8<8>(X, tid, v); FFT_SYNC();
    ld8<64>(X, tid, v); twid<64, true>(v, tid); dft8<true>(v); st8<64>(X, tid, v); FFT_SYNC();
    ld8<512>(X, tid, v); twid<512, true>(v, tid); dft8<true>(v);
}
#endif

struct OneUnit { int pm, pn; bool on;
    __device__ __forceinline__ bool next(int i, pg8::Unit& u) const { if (!on || i > 0) return false; u.pm = pm; u.pn = pn; return true; }
    __device__ __forceinline__ void a_ready(const pg8::Unit&) const {}
    __device__ __forceinline__ void done(const pg8::Unit&) const {}
    __device__ __forceinline__ long a_off(const pg8::Unit& u, size_t tstep) const { return (long)((size_t)u.pm * tstep); } };

struct EpiB {
    static constexpr bool PERM = true, AFTER_DRAIN = false;
    bf16_t* O; int ldc;
    __device__ __forceinline__ void operator()(const f32x4 (&acc)[2][2][4][2], const pg8::Unit& u, int wr, int wc, int fr, int fq) const {
        const int row0 = u.pm * 256 + wr * 64 + fr, col0 = u.pn * 256 + wc * 32 + 8 * fq;
#pragma unroll
        for (int ai = 0; ai < 2; ++ai)
#pragma unroll
            for (int m = 0; m < 4; ++m) { bf16_t* rowp = O + (size_t)(row0 + ai * 128 + m * 16) * ldc + col0;
#pragma unroll
                for (int bj = 0; bj < 2; ++bj) { const f32x4 v0 = acc[ai][bj][m][0], v1 = acc[ai][bj][m][1];
                    u32x4 w; w.x = pk2(v0[0], v0[1]); w.y = pk2(v0[2], v0[3]); w.z = pk2(v1[0], v1[1]); w.w = pk2(v1[2], v1[3]);
                    *(u32x4*)(rowp + bj * 128) = w; } }
    }
};
struct EpiRope {
    static constexpr bool PERM = true, AFTER_DRAIN = false;
    bf16_t* O; const float2* rope;
    __device__ __forceinline__ void operator()(const f32x4 (&acc)[2][2][4][2], const pg8::Unit& u, int wr, int wc, int fr, int fq) const {
        const int row0 = u.pm * 256 + wr * 64 + fr, col0 = u.pn * 256 + wc * 32 + 8 * fq;
        const bool rot = u.pn < 4;
#pragma unroll
        for (int ai = 0; ai < 2; ++ai)
#pragma unroll
            for (int m = 0; m < 4; ++m) { const int row = row0 + ai * 128 + m * 16; bf16_t* rowp = O + (size_t)row * MIXW + col0;
#pragma unroll
                for (int bj = 0; bj < 2; ++bj) { f32x4 v0 = acc[ai][bj][m][0], v1 = acc[ai][bj][m][1];
                    if (rot) { const int pos = row & (SEQ - 1), i0 = ((col0 + bj * 128) & 63) >> 1;
                        const f32x4* rp = (const f32x4*)(rope + pos * 32 + i0); const f32x4 r0 = rp[0], r1 = rp[1];
                        f32x4 o0, o1;
                        o0[0] = v0[0] * r0[0] - v0[1] * r0[1]; o0[1] = v0[1] * r0[0] + v0[0] * r0[1];
                        o0[2] = v0[2] * r0[2] - v0[3] * r0[3]; o0[3] = v0[3] * r0[2] + v0[2] * r0[3];
                        o1[0] = v1[0] * r1[0] - v1[1] * r1[1]; o1[1] = v1[1] * r1[0] + v1[0] * r1[1];
                        o1[2] = v1[2] * r1[2] - v1[3] * r1[3]; o1[3] = v1[3] * r1[2] + v1[2] * r1[3];
                        v0 = o0; v1 = o1; }
                    u32x4 w; w.x = pk2(v0[0], v0[1]); w.y = pk2(v0[2], v0[3]); w.z = pk2(v1[0], v1[1]); w.w = pk2(v1[2], v1[3]);
                    *(u32x4*)(rowp + bj * 128) = w; } }
    }
};
struct EpiRes {
    static constexpr bool PERM = false, AFTER_DRAIN = false;
    const float* X; float* O;
    __device__ __forceinline__ void operator()(const f32x4 (&acc)[2][2][4][2], const pg8::Unit& u, int wr, int wc, int fr, int fq) const {
        const int row0 = u.pm * 256 + wr * 64 + fr, col0 = u.pn * 256 + wc * 32 + 4 * fq;
#pragma unroll
        for (int ai = 0; ai < 2; ++ai)
#pragma unroll
            for (int m = 0; m < 4; ++m) { const size_t ro = (size_t)(row0 + ai * 128 + m * 16) * DM;
#pragma unroll
                for (int bj = 0; bj < 2; ++bj)
#pragma unroll
                    for (int n = 0; n < 2; ++n) { const int c = col0 + bj * 128 + 16 * n;
                        const f32x4 xv = *(const f32x4*)(X + ro + c); *(f32x4*)(O + ro + c) = acc[ai][bj][m][n] + xv * ALPHA; } }
    }
};
struct EpiRes2 {
    static constexpr bool PERM = false, AFTER_DRAIN = false;
    float* O; const float2* stat; const float* g; const float* b;
    __device__ __forceinline__ void operator()(const f32x4 (&acc)[2][2][4][2], const pg8::Unit& u, int wr, int wc, int fr, int fq) const {
        const int row0 = u.pm * 256 + wr * 64 + fr, col0 = u.pn * 256 + wc * 32 + 4 * fq;
#pragma unroll
        for (int bj = 0; bj < 2; ++bj)
#pragma unroll
            for (int n = 0; n < 2; ++n) { const int c = col0 + bj * 128 + 16 * n;
                const f32x4 gv = *(const f32x4*)(g + c), bv = *(const f32x4*)(b + c);
#pragma unroll
                for (int ai = 0; ai < 2; ++ai)
#pragma unroll
                    for (int m = 0; m < 4; ++m) { const int row = row0 + ai * 128 + m * 16; const float2 st = stat[row];
                        float* p = O + (size_t)row * DM + c; const f32x4 r1 = *(const f32x4*)p;
                        const f32x4 x1 = (r1 - st.x) * st.y * gv + bv; *(f32x4*)p = acc[ai][bj][m][n] + x1 * ALPHA; } }
    }
};


struct FfnOrder : pg8::StaticOrder {
    __device__ __forceinline__ long a_off(const pg8::Unit& u, size_t) const { return ((long)u.pm * 254 - 1) * (long)(DM * 2); }
};
constexpr int FFN_MT = 130;
constexpr int XCH_OFF = 131072 + 1024;
__device__ __forceinline__ float dpp_ror1(float v)  { return __int_as_float(__builtin_amdgcn_update_dpp(0, __float_as_int(v), 0x121, 0xF, 0xF, false)); }
__device__ __forceinline__ float dpp_ror15(float v) { return __int_as_float(__builtin_amdgcn_update_dpp(0, __float_as_int(v), 0x12F, 0xF, 0xF, false)); }
struct EpiFfn {
    static constexpr bool PERM = true, AFTER_DRAIN = false;
    bf16_t* ACT; const float* cw; const float* cb; LAS unsigned char* lds;
    __device__ __forceinline__ void operator()(const f32x4 (&acc)[2][2][4][2], const pg8::Unit& u, int wr, int wc, int fr, int fq) const {
        LAS float* XC = (LAS float*)(lds + XCH_OFF);
        const int colw = wc * 32 + 8 * fq;
        if (fr == 0 || fr == 15) {
            const int edge = (fr == 15) ? 1 : 0, m = (fr == 15) ? 3 : 0;
#pragma unroll
            for (int ai = 0; ai < 2; ++ai)
#pragma unroll
                for (int bj = 0; bj < 2; ++bj)
#pragma unroll
                    for (int n = 0; n < 2; ++n) { const f32x4 v = (m == 0) ? acc[ai][bj][0][n] : acc[ai][bj][3][n];
                        *(LAS f32x4*)(XC + ((ai * 2 + wr) * 2 + edge) * 256 + bj * 128 + colw + 4 * n) = v; }
        }
        asm volatile("s_waitcnt lgkmcnt(0)" ::: "memory"); __builtin_amdgcn_s_barrier(); asm volatile("" ::: "memory");
        const int slot0 = wr * 64 + fr, row_base = u.pm * 254 - 1;
#pragma unroll
        for (int bj = 0; bj < 2; ++bj) {
            const int gc = (u.pn * 256 + bj * 128 + colw) >> 1;
            f32x4 wg[3], wu[3];
#pragma unroll
            for (int j = 0; j < 3; ++j) { wg[j] = *(const f32x4*)(cw + (size_t)j * (2 * DFF) + gc); wu[j] = *(const f32x4*)(cw + (size_t)j * (2 * DFF) + DFF + gc); }
            const f32x4 bg = *(const f32x4*)(cb + gc), bu = *(const f32x4*)(cb + DFF + gc);
#pragma unroll
            for (int ai = 0; ai < 2; ++ai) {
                const int gidx = ai * 2 + wr;
                f32x4 pe[2], ne[2];
#pragma unroll
                for (int n = 0; n < 2; ++n) {
                    pe[n] = (gidx > 0) ? *(const LAS f32x4*)(XC + (((gidx - 1) * 2) + 1) * 256 + bj * 128 + colw + 4 * n) : (f32x4){0.f, 0.f, 0.f, 0.f};
                    ne[n] = (gidx < 3) ? *(const LAS f32x4*)(XC + (((gidx + 1) * 2) + 0) * 256 + bj * 128 + colw + 4 * n) : (f32x4){0.f, 0.f, 0.f, 0.f}; }
#pragma unroll
                for (int m = 0; m < 4; ++m) {
                    const int slot = ai * 128 + slot0 + m * 16, row = row_base + slot, t = row & (SEQ - 1);
                    f32x4 hv[2];
#pragma unroll
                    for (int n = 0; n < 2; ++n) {
                        const f32x4 cur = acc[ai][bj][m][n], prv = acc[ai][bj][m == 0 ? 0 : m - 1][n], nxt = acc[ai][bj][m == 3 ? 3 : m + 1][n];
                        f32x4 up, dn;
#pragma unroll
                        for (int e = 0; e < 4; ++e) { up[e] = dpp_ror1(fr == 15 ? prv[e] : cur[e]); dn[e] = dpp_ror15(fr == 0 ? nxt[e] : cur[e]); }
                        if (m == 0 && fr == 0) up = pe[n];
                        if (m == 3 && fr == 15) dn = ne[n];
                        if (t == 0) up = (f32x4){0.f, 0.f, 0.f, 0.f};
                        if (t == SEQ - 1) dn = (f32x4){0.f, 0.f, 0.f, 0.f};
                        const f32x4 w0 = n ? wu[0] : wg[0], w1 = n ? wu[1] : wg[1], w2 = n ? wu[2] : wg[2], bb = n ? bu : bg;
                        hv[n] = w0 * up + w1 * cur + w2 * dn + bb; }
                    if (slot >= 1 && slot <= 254 && row < NT) {
                        float o[4];
#pragma unroll
                        for (int e = 0; e < 4; ++e) { const float g = hv[0][e]; o[e] = g / (1.0f + __expf(-g)) * hv[1][e]; }
                        u32x2 w; w.x = pk2(o[0], o[1]); w.y = pk2(o[2], o[3]);
                        *(u32x2*)(ACT + (size_t)row * DFF + gc) = w; }
                }
            }
        }
    }
};

__device__ __forceinline__ int win_row(int n) {
    if (n < 1536) return 1536 + n;
    if (n < 2560) { const int q = n - 1536, blk = q >> 6, d = q & 63; return blk * 64 + 2 * (d & 31) + (d >> 5); }
    if (n < 3072) return 512 + n;
    return n - 2048;
}
template <int MODE> __device__ __forceinline__ void p0_transpose_item(const float* W, int K, int N, bf16_t* WT, LAS float* scr, int item, int lane) {
    const int nblk = N / 32, kb = item / nblk, nb = item % nblk, k0 = 64 * kb, n0 = 32 * nb;
#pragma unroll 8
    for (int i = 0; i < 32; ++i) { const int kk = 2 * i + (lane >> 5); scr[kk * 33 + (lane & 31)] = W[(size_t)(k0 + kk) * N + n0 + (lane & 31)]; }
    LDS_WAIT(); asm volatile("" ::: "memory");
    const int c = lane & 7;
#pragma unroll
    for (int j = 0; j < 4; ++j) { const int n = (lane >> 3) + 8 * j; const LAS float* s = scr + (8 * c) * 33 + n;
        u32x4 o; o.x = pk2(s[0 * 33], s[1 * 33]); o.y = pk2(s[2 * 33], s[3 * 33]); o.z = pk2(s[4 * 33], s[5 * 33]); o.w = pk2(s[6 * 33], s[7 * 33]);
        const int nn = n0 + n; const int dr = (MODE == 1) ? win_row(nn) : (MODE == 2) ? ((nn < DFF) ? ((nn >> 2) * 8 + (nn & 3)) : (((nn - DFF) >> 2) * 8 + 4 + ((nn - DFF) & 3))) : nn;
        *(u32x4*)(WT + (size_t)dr * K + k0 + 8 * c) = o; }
    LDS_WAIT(); asm volatile("" ::: "memory");
}
__device__ __forceinline__ void cvt_rows(const float* src, bf16_t* dst, size_t n8, int gw, int ngw, int lane) {
    for (size_t i = (size_t)gw * 64 + lane; i < n8; i += (size_t)ngw * 64) {
        const f32x4 a = ((const f32x4*)src)[2 * i], b = ((const f32x4*)src)[2 * i + 1];
        u32x4 w; w.x = pk2(a[0], a[1]); w.y = pk2(a[2], a[3]); w.z = pk2(b[0], b[1]); w.w = pk2(b[2], b[3]);
        ((u32x4*)dst)[i] = w; }
}
__device__ __forceinline__ void p0_filter_item(const float* w1, const float* b1, const float* fq, const float* w2, const float* b2, const float* w3, float* HTD, int item, int lane) {
    const int t0 = 2 * (item >> 2), ih = item & 3; float h2v[2], tl[2];
    const float fql = fq[lane], b1l = b1[lane], b2l = b2[lane];
#pragma unroll
    for (int tt = 0; tt < 2; ++tt) { const int t = t0 + tt; tl[tt] = (float)t * (1.0f / 2047.0f);
        const float w = 6.283185307179586f * (float)t / 2048.0f;
        float zk = 0.f;
        if (lane == 0) zk = tl[tt];
        else if (lane <= 16) { const float fr = 1e-4f + (float)(lane - 1) * ((15.0f - 1e-4f) / 15.0f); zk = cosf(fr * w); }
        else if (lane <= 32) { const float fr = 1e-4f + (float)(lane - 17) * ((15.0f - 1e-4f) / 15.0f); zk = -sinf(fr * w); }
        float a = b1l;
#pragma unroll 11
        for (int k = 0; k < 33; ++k) a += __shfl(zk, k) * w1[k * 64 + lane];
        const float h1 = sinf(fql * a);
        float a2 = b2l;
#pragma unroll 16
        for (int k = 0; k < 64; ++k) a2 += __shfl(h1, k) * w2[k * 64 + lane];
        h2v[tt] = sinf(fql * a2); }
    const float dmin = -15.350567286626973f, dmax = -3.0701134573253946f;
    float acc0[8], acc1[8];
#pragma unroll
    for (int i = 0; i < 8; ++i) { acc0[i] = 0.f; acc1[i] = 0.f; }
#pragma unroll 8
    for (int j = 0; j < 64; ++j) { const float s0 = __shfl(h2v[0], j), s1 = __shfl(h2v[1], j); const float* wr = w3 + (size_t)j * 2048 + ih * 512 + lane;
#pragma unroll
        for (int i = 0; i < 8; ++i) { const float wv = wr[64 * i]; acc0[i] += s0 * wv; acc1[i] += s1 * wv; } }
#pragma unroll
    for (int i = 0; i < 8; ++i) { const int col = ih * 512 + 64 * i + lane, c = col & 511;
        const float delta = fabsf(dmin + (float)c * ((dmax - dmin) / 511.0f));
        float2 o; o.x = acc0[i] * expf(-tl[0] * delta); o.y = acc1[i] * expf(-tl[1] * delta);
        *(float2*)(HTD + (size_t)col * 2048 + t0) = o; }
}
__device__ __forceinline__ void p0_prep(const float* const* in, unsigned char* ws, LAS unsigned char* lds, int tid) {
    const int lane = tid & 63, wave = tid >> 6, gw = blockIdx.x * NWAVE + wave, ngw = gridDim.x * NWAVE;
    LAS float* scr = (LAS float*)(lds + wave * 16384);
    bf16_t* WALL = (bf16_t*)(ws + WS_WALL);
    constexpr int I_IN = 16 * (INW / 32), I_KV = 16 * 32, I_OUT = 24 * 32, I_UP = 16 * (2 * DFF / 32), I_DN = (DFF / 64) * 32, NIT = I_IN + I_KV + I_OUT + I_UP + I_DN;
    for (int it = gw; it < NIT; it += ngw) { int r = it;
        if (r < I_IN) { p0_transpose_item<1>(in[2], DM, INW, WALL, scr, r, lane); continue; } r -= I_IN;
        if (r < I_KV) { p0_transpose_item<0>(in[14], DM, 1024, (bf16_t*)(ws + WS_WKV), scr, r, lane); continue; } r -= I_KV;
        if (r < I_OUT) { p0_transpose_item<0>(in[15], MIXW, DM, (bf16_t*)(ws + WS_WOUT), scr, r, lane); continue; } r -= I_OUT;
        if (r < I_UP) { p0_transpose_item<2>(in[18], DM, 2 * DFF, (bf16_t*)(ws + WS_WUP), scr, r, lane); continue; } r -= I_UP;
        p0_transpose_item<0>(in[21], DFF, DM, (bf16_t*)(ws + WS_WDN), scr, r, lane); }
    for (int it = ngw - 1 - gw; it < 4096; it += ngw) p0_filter_item(in[5], in[6], in[7], in[8], in[9], in[10], (float*)(ws + WS_HTD), it, lane);
    cvt_rows(in[0], (bf16_t*)(ws + WS_XB), (size_t)NT * DM / 8, gw, ngw, lane);
    cvt_rows(in[1], (bf16_t*)(ws + WS_MEMB), (size_t)NMT * DM / 8, gw, ngw, lane);
    float2* rope = (float2*)(ws + WS_ROPE);
    for (int i = blockIdx.x * NTHR + tid; i < SEQ * 32; i += gridDim.x * NTHR) { const int pos = i >> 5, f = i & 31;
        const float invf = powf(10000.0f, -(float)(2 * f) / 64.0f); const float ang = (float)pos * invf;
        float2 cs; cs.x = cosf(ang); cs.y = sinf(ang); rope[i] = cs; }
}

__device__ __forceinline__ void filter_fft_item(const float* HTD, float2* KF, LAS unsigned char* lds, int item, int tid) {
    const int o = item >> 9, c = item & 511;
    const float* rf = HTD + (size_t)((o * 2 + 0) * 512 + c) * 2048; const float* rb = HTD + (size_t)((o * 2 + 1) * 512 + c) * 2048;
    cplx v[8];
#pragma unroll
    for (int k = 0; k < 4; ++k) v[k] = mk2(rf[tid + 512 * k], 0.f);
    v[4] = mk2(tid == 0 ? 0.f : rb[2048 - tid], 0.f); v[5] = mk2(rb[1536 - tid], 0.f); v[6] = mk2(rb[1024 - tid], 0.f); v[7] = mk2(rb[512 - tid], 0.f);
    fft_fwd((LAS cplx*)lds, tid, v);
    float2* dst = KF + (size_t)(o * 512 + c) * 4096 + 8 * tid;
#pragma unroll
    for (int m = 0; m < 8; m += 2) { f32x4 w; w[0] = v[m].x * (1.f / 4096.f); w[1] = v[m].y * (1.f / 4096.f); w[2] = v[m + 1].x * (1.f / 4096.f); w[3] = v[m + 1].y * (1.f / 4096.f); *(f32x4*)(dst + m) = w; }
    __syncthreads();
}

constexpr int HY_SEG = 2064, HY_STG_OFF = 36864;
__device__ __forceinline__ float conv3s(const LAS bf16_t* seg, int n, float w0, float w1, float w2, float b) {
    return w0 * bf2f(seg[7 + n]) + w1 * bf2f(seg[8 + n]) + w2 * bf2f(seg[9 + n]) + b;
}
__device__ __forceinline__ void hyena_item(const bf16_t* HT, const float2* KF, const float* cw, const float* cb, const float* hb, bf16_t* MIX, LAS unsigned char* lds, int bp, int cgp, int tid0) {
    LAS cplx* X = (LAS cplx*)lds; LAS bf16_t* STG = (LAS bf16_t*)(lds + HY_STG_OFF); LAS cplx* TW = (LAS cplx*)(lds + 65536);
    const int ba = 2 * bp;
    twid_fill<512>(TW, tid0); twid_fill<64>(TW, tid0); twid_fill<8>(TW, tid0);
    u32x4 oacc[8];
#pragma unroll
    for (int i = 0; i < 8; ++i) oacc[i] = (u32x4){0u, 0u, 0u, 0u};
    if (tid0 < 12) { const int sg = tid0 >> 1; STG[sg * HY_SEG + ((tid0 & 1) ? 2056 : 7)] = 0; }
    { const int c = cgp * 8;
#pragma unroll
      for (int i = 0; i < 3; ++i) { const int id = tid0 + 512 * i, sg = id >> 8, ch = id & 255;
          const u32x4 q = *(const u32x4*)(HT + (size_t)((sg >> 1) * 512 + c) * NT + (ba + (sg & 1)) * SEQ + ch * 8);
          *(LAS u32x4*)(STG + sg * HY_SEG + 8 + ch * 8) = q; } }
    __syncthreads();
#pragma unroll 1
    for (int cc = 0; cc < 8; ++cc) {
        const int c = cgp * 8 + cc;
        int tl_ = tid0; asm volatile("" : "+v"(tl_)); const int tid = tl_;
        u32x4 nx[3];
        if (cc < 7) {
#pragma unroll
            for (int i = 0; i < 3; ++i) { const int id = tid + 512 * i, sg = id >> 8, ch = id & 255;
                nx[i] = *(const u32x4*)(HT + (size_t)((sg >> 1) * 512 + c + 1) * NT + (ba + (sg & 1)) * SEQ + ch * 8); } }
        f32x4 kf[4];
        { const f32x4* kp = (const f32x4*)(KF + (size_t)c * 4096 + 8 * tid);
#pragma unroll
          for (int m = 0; m < 4; ++m) kf[m] = kp[m]; }
        cplx v[8]; float va[4], vb[4];
        { const float w0 = cw[c], w1 = cw[1536 + c], w2 = cw[3072 + c], b = cb[c];
#pragma unroll
          for (int k = 0; k < 4; ++k) { const int n = tid + 512 * k; va[k] = conv3s(STG, n, w0, w1, w2, b); vb[k] = conv3s(STG + HY_SEG, n, w0, w1, w2, b); v[k] = mk2(va[k], vb[k]); v[4 + k] = mk2(0.f, 0.f); } }
        fft_fwdL(X, TW, tid, v);
#pragma unroll
        for (int m = 0; m < 8; m += 2) { const f32x4 w = kf[m >> 1]; v[m] = cmul(v[m], mk2(w[0], w[1])); v[m + 1] = cmul(v[m + 1], mk2(w[2], w[3])); }
        { const f32x4* kp = (const f32x4*)(KF + (size_t)(512 + c) * 4096 + 8 * tid);
#pragma unroll
          for (int m = 0; m < 4; ++m) kf[m] = kp[m]; }
        fft_invL(X, TW, tid, v);
        { const float w0 = cw[512 + c], w1 = cw[1536 + 512 + c], w2 = cw[3072 + 512 + c], b = cb[512 + c], hb0 = hb[c];
#pragma unroll
          for (int k = 0; k < 4; ++k) { const int n = tid + 512 * k; const float xa = conv3s(STG + 2 * HY_SEG, n, w0, w1, w2, b), xb = conv3s(STG + 3 * HY_SEG, n, w0, w1, w2, b);
              va[k] = xa * (v[k].x + hb0 * va[k]); vb[k] = xb * (v[k].y + hb0 * vb[k]); v[k] = mk2(va[k], vb[k]); v[4 + k] = mk2(0.f, 0.f); } }
        fft_fwdL(X, TW, tid, v);
#pragma unroll
        for (int m = 0; m < 8; m += 2) { const f32x4 w = kf[m >> 1]; v[m] = cmul(v[m], mk2(w[0], w[1])); v[m + 1] = cmul(v[m + 1], mk2(w[2], w[3])); }
        fft_invL(X, TW, tid, v);
        { const float w0 = cw[1024 + c], w1 = cw[1536 + 1024 + c], w2 = cw[3072 + 1024 + c], b = cb[1024 + c], hb1 = hb[512 + c];
#pragma unroll
          for (int k = 0; k < 4; ++k) { const int n = tid + 512 * k; const float xa = conv3s(STG + 4 * HY_SEG, n, w0, w1, w2, b), xb = conv3s(STG + 5 * HY_SEG, n, w0, w1, w2, b);
              const float oa = xa * (v[k].x + hb1 * va[k]), ob = xb * (v[k].y + hb1 * vb[k]);
              const unsigned pw = pk2(oa, ob);
#pragma unroll
              for (int hh = 0; hh < 2; ++hh) { u32x4& o = oacc[2 * k + hh]; const unsigned nw = hh ? (pw & 0xffff0000u) : (pw << 16);
                  o.x = __builtin_amdgcn_alignbit(o.y, o.x, 16); o.y = __builtin_amdgcn_alignbit(o.z, o.y, 16); o.z = __builtin_amdgcn_alignbit(o.w, o.z, 16); o.w = (o.w >> 16) | nw; } } }
        __syncthreads();
        if (cc < 7) {
#pragma unroll
            for (int i = 0; i < 3; ++i) { const int id = tid + 512 * i, sg = id >> 8, ch = id & 255; *(LAS u32x4*)(STG + sg * HY_SEG + 8 + ch * 8) = nx[i]; } }
        __syncthreads();
    }
    int tw_ = tid0; asm volatile("" : "+v"(tw_)); const int tid = tw_;
#pragma unroll
    for (int k = 0; k < 4; ++k)
#pragma unroll
        for (int hh = 0; hh < 2; ++hh) *(u32x4*)(MIX + (size_t)((ba + hh) * SEQ + tid + 512 * k) * MIXW + cgp * 8) = oacc[2 * k + hh];
}

constexpr int ATT_KP = 272, ATT_VP = 144, ATT_KB = 64 * ATT_KP, ATT_VB = 128 * ATT_VP, ATT_VOFF = 2 * ATT_KB;
template <int NC> __device__ __forceinline__ void attn_unit(LAS unsigned char* lds, const bf16_t* Qp, int ldq, const bf16_t* Kp, int ldk, const bf16_t* Vt, int ldv, int nkeys, float sl2,
                                                            bf16_t* Op, int ldo, float lam, const float* subg, int tid) {
    constexpr int NSTEP = (NC == 2) ? 4 : 8;
    const int lane = tid & 63, wave = tid >> 6, r = lane & 31, h = lane >> 5;
    const int qb = (NC == 2) ? (wave & 3) : wave, comp = (NC == 2) ? (wave >> 2) : 0, dbase = comp * 64;
    bf16x8 qf[NSTEP];
#pragma unroll
    for (int st = 0; st < NSTEP; ++st) qf[st] = *(const bf16x8*)(Qp + (size_t)(qb * 32 + r) * ldq + dbase + 16 * st + 8 * h);
    f32x16 o[4];
#pragma unroll
    for (int et = 0; et < 4; ++et)
#pragma unroll
        for (int i = 0; i < 16; ++i) o[et][i] = 0.f;
    float mold = -INFINITY, lsum = 0.f;
    const int kr0 = tid >> 4, kc = tid & 15, vr0 = tid >> 3, vc = tid & 7;
    const bf16_t* kg = Kp + (size_t)kr0 * ldk + kc * 8; const bf16_t* vg = Vt + (size_t)vr0 * ldv + vc * 8;
    const int kl = kr0 * ATT_KP + kc * 16, vl = ATT_VOFF + vr0 * ATT_VP + vc * 16;
    const int nt = nkeys / 64;
    u32x4 pk0, pk1, pv0, pv1;
    pk0 = *(const u32x4*)(kg); pk1 = *(const u32x4*)(kg + (size_t)32 * ldk); pv0 = *(const u32x4*)(vg); pv1 = *(const u32x4*)(vg + (size_t)64 * ldv);
    *(LAS u32x4*)(lds + kl) = pk0; *(LAS u32x4*)(lds + kl + 32 * ATT_KP) = pk1; *(LAS u32x4*)(lds + vl) = pv0; *(LAS u32x4*)(lds + vl + 64 * ATT_VP) = pv1;
    __syncthreads();
    for (int it = 0; it < nt; ++it) {
        const int cur = it & 1; const bool more = (it + 1 < nt);
        if (more) { const bf16_t* kg2 = kg + (size_t)(it + 1) * 64 * ldk; const bf16_t* vg2 = vg + (it + 1) * 64;
            pk0 = *(const u32x4*)(kg2); pk1 = *(const u32x4*)(kg2 + (size_t)32 * ldk); pv0 = *(const u32x4*)(vg2); pv1 = *(const u32x4*)(vg2 + (size_t)64 * ldv); }
        LAS unsigned char* Kb = lds + cur * ATT_KB; LAS unsigned char* Vb = lds + ATT_VOFF + cur * ATT_VB;
        f32x16 s[2];
#pragma unroll
        for (int kb = 0; kb < 2; ++kb) {
#pragma unroll
            for (int i = 0; i < 16; ++i) s[kb][i] = 0.f;
#pragma unroll
            for (int st = 0; st < NSTEP; ++st) { const bf16x8 a = *(const LAS bf16x8*)(Kb + (kb * 32 + r) * ATT_KP + (dbase + 16 * st + 8 * h) * 2);
                s[kb] = __builtin_amdgcn_mfma_f32_32x32x16_bf16(a, qf[st], s[kb], 0, 0, 0); } }
        float mx = s[0][0];
#pragma unroll
        for (int i = 1; i < 16; ++i) mx = fmaxf(mx, s[0][i]);
#pragma unroll
        for (int i = 0; i < 16; ++i) mx = fmaxf(mx, s[1][i]);
        mx = fmaxf(mx, __shfl_xor(mx, 32));
        const float mnew = fmaxf(mold, mx * sl2), alpha = __builtin_amdgcn_exp2f(mold - mnew); mold = mnew;
        float ps = 0.f;
#pragma unroll
        for (int kb = 0; kb < 2; ++kb)
#pragma unroll
            for (int i = 0; i < 16; ++i) { const float p = __builtin_amdgcn_exp2f(__builtin_fmaf(s[kb][i], sl2, -mnew)); s[kb][i] = p; ps += p; }
        lsum = lsum * alpha + ps;
#pragma unroll
        for (int et = 0; et < 4; ++et)
#pragma unroll
            for (int i = 0; i < 16; ++i) o[et][i] *= alpha;
#pragma unroll
        for (int kb = 0; kb < 2; ++kb)
#pragma unroll
            for (int s2 = 0; s2 < 2; ++s2) {
                u32x4 pw; pw.x = pk2(s[kb][8 * s2 + 0], s[kb][8 * s2 + 1]); pw.y = pk2(s[kb][8 * s2 + 2], s[kb][8 * s2 + 3]); pw.z = pk2(s[kb][8 * s2 + 4], s[kb][8 * s2 + 5]); pw.w = pk2(s[kb][8 * s2 + 6], s[kb][8 * s2 + 7]);
                const bf16x8 pf = __builtin_bit_cast(bf16x8, pw);
#pragma unroll
                for (int et = 0; et < 4; ++et) { const LAS unsigned char* vp = Vb + (et * 32 + r) * ATT_VP + (kb * 32 + 16 * s2 + 4 * h) * 2;
                    const u32x2 lo = *(const LAS u32x2*)vp, hi = *(const LAS u32x2*)(vp + 16);
                    u32x4 aw; aw.x = lo.x; aw.y = lo.y; aw.z = hi.x; aw.w = hi.y;
                    o[et] = __builtin_amdgcn_mfma_f32_32x32x16_bf16(__builtin_bit_cast(bf16x8, aw), pf, o[et], 0, 0, 0); } }
        if (more) { const int nb = cur ^ 1;
            *(LAS u32x4*)(lds + nb * ATT_KB + kl) = pk0; *(LAS u32x4*)(lds + nb * ATT_KB + kl + 32 * ATT_KP) = pk1;
            *(LAS u32x4*)(lds + nb * ATT_VB + vl) = pv0; *(LAS u32x4*)(lds + nb * ATT_VB + vl + 64 * ATT_VP) = pv1; }
        __syncthreads();
    }
    lsum += __shfl_xor(lsum, 32);
    const float inv = 1.0f / lsum;
    if (NC == 1) {
        bf16_t* orow = Op + (size_t)(qb * 32 + r) * ldo;
#pragma unroll
        for (int et = 0; et < 4; ++et)
#pragma unroll
            for (int g = 0; g < 4; ++g) { u32x2 w; w.x = pk2(o[et][4 * g] * inv, o[et][4 * g + 1] * inv); w.y = pk2(o[et][4 * g + 2] * inv, o[et][4 * g + 3] * inv);
                *(u32x2*)(orow + et * 32 + 8 * g + 4 * h) = w; }
    } else {
        LAS float* XL = (LAS float*)lds;
        if (comp == 1) {
#pragma unroll
            for (int et = 0; et < 4; ++et)
#pragma unroll
                for (int i = 0; i < 16; ++i) XL[(qb * 64 + et * 16 + i) * 64 + lane] = o[et][i] * inv;
        }
        __syncthreads();
        if (comp == 0) {
            float ss = 0.f;
#pragma unroll
            for (int et = 0; et < 4; ++et)
#pragma unroll
                for (int i = 0; i < 16; ++i) { const float ov = o[et][i] * inv - lam * XL[(qb * 64 + et * 16 + i) * 64 + lane]; o[et][i] = ov; ss += ov * ov; }
            ss += __shfl_xor(ss, 32);
            const float rs = rsqrtf(ss * (1.0f / 128.0f) + RMS_EPS) * 0.8f;
            bf16_t* orow = Op + (size_t)(qb * 32 + r) * ldo;
#pragma unroll
            for (int et = 0; et < 4; ++et)
#pragma unroll
                for (int g = 0; g < 4; ++g) { const int e = et * 32 + 8 * g + 4 * h; const f32x4 gv = *(const f32x4*)(subg + e);
                    u32x2 w; w.x = pk2(o[et][4 * g] * rs * gv[0], o[et][4 * g + 1] * rs * gv[1]); w.y = pk2(o[et][4 * g + 2] * rs * gv[2], o[et][4 * g + 3] * rs * gv[3]);
                    *(u32x2*)(orow + e) = w; }
        }
        __syncthreads();
    }
}

template <bool TO_BF16> __device__ __forceinline__ void ln_rows(float* io, bf16_t* ob, float2* stat, const float* g, const float* b, int tid) {
    const int lane = tid & 63, gw = blockIdx.x * NWAVE + (tid >> 6), ngw = gridDim.x * NWAVE;
    f32x4 gv[4], bv[4];
#pragma unroll
    for (int j = 0; j < 4; ++j) { gv[j] = ((const f32x4*)g)[lane + 64 * j]; bv[j] = ((const f32x4*)b)[lane + 64 * j]; }
    for (int row = gw; row < NT; row += ngw) {
        f32x4* xr = (f32x4*)(io + (size_t)row * DM) + lane; f32x4 v[4]; float s = 0.f;
#pragma unroll
        for (int j = 0; j < 4; ++j) { v[j] = xr[64 * j]; s += (v[j][0] + v[j][1]) + (v[j][2] + v[j][3]); }
#pragma unroll
        for (int o = 1; o < 64; o <<= 1) s += __shfl_xor(s, o);
        const float mean = s * (1.0f / DM); float s2 = 0.f;
#pragma unroll
        for (int j = 0; j < 4; ++j) { v[j] = v[j] - mean; s2 += (v[j][0] * v[j][0] + v[j][1] * v[j][1]) + (v[j][2] * v[j][2] + v[j][3] * v[j][3]); }
#pragma unroll
        for (int o = 1; o < 64; o <<= 1) s2 += __shfl_xor(s2, o);
        const float rstd = rsqrtf(s2 * (1.0f / DM) + LN_EPS);
        if (TO_BF16) {
            u32x2* o8 = (u32x2*)(ob + (size_t)row * DM) + lane;
#pragma unroll
            for (int j = 0; j < 4; ++j) { const f32x4 y = v[j] * rstd * gv[j] + bv[j]; u32x2 w; w.x = pk2(y[0], y[1]); w.y = pk2(y[2], y[3]); o8[64 * j] = w; }
            if (lane == 0) { float2 st; st.x = mean; st.y = rstd; stat[row] = st; }
        } else {
#pragma unroll
            for (int j = 0; j < 4; ++j) xr[64 * j] = v[j] * rstd * gv[j] + bv[j];
        }
    }
}

__device__ __forceinline__ void convgate_half(const bf16_t* HH, bf16_t* ACT, const float* cw, const float* cb, int half, int tid) {
    constexpr int NG = DFF / 8; const int total = (NT / 2) * NG;
    for (int idx = blockIdx.x * NTHR + tid; idx < total; idx += gridDim.x * NTHR) {
        const int rl = idx / NG, cg8 = idx - rl * NG, n0 = cg8 * 8, t = rl & (SEQ - 1);
        const bf16_t* hp = HH + (size_t)rl * (2 * DFF);
        float gsum[8], usum[8];
#pragma unroll
        for (int e = 0; e < 8; ++e) { gsum[e] = cb[n0 + e]; usum[e] = cb[DFF + n0 + e]; }
#pragma unroll
        for (int j = 0; j < 3; ++j) { const int tt = t + j - 1; if (tt < 0 || tt >= SEQ) continue;
            const u32x4 gq = *(const u32x4*)(hp + (ptrdiff_t)(j - 1) * (2 * DFF) + n0), uq = *(const u32x4*)(hp + (ptrdiff_t)(j - 1) * (2 * DFF) + DFF + n0);
            const float* wg = cw + (size_t)j * (2 * DFF) + n0; const float* wu = wg + DFF;
            const f32x4 wg0 = *(const f32x4*)wg, wg1 = *(const f32x4*)(wg + 4), wu0 = *(const f32x4*)wu, wu1 = *(const f32x4*)(wu + 4);
            gsum[0] += wg0[0] * lo2f(gq.x); gsum[1] += wg0[1] * hi2f(gq.x); gsum[2] += wg0[2] * lo2f(gq.y); gsum[3] += wg0[3] * hi2f(gq.y);
            gsum[4] += wg1[0] * lo2f(gq.z); gsum[5] += wg1[1] * hi2f(gq.z); gsum[6] += wg1[2] * lo2f(gq.w); gsum[7] += wg1[3] * hi2f(gq.w);
            usum[0] += wu0[0] * lo2f(uq.x); usum[1] += wu0[1] * hi2f(uq.x); usum[2] += wu0[2] * lo2f(uq.y); usum[3] += wu0[3] * hi2f(uq.y);
            usum[4] += wu1[0] * lo2f(uq.z); usum[5] += wu1[1] * hi2f(uq.z); usum[6] += wu1[2] * lo2f(uq.w); usum[7] += wu1[3] * hi2f(uq.w); }
        float a[8];
#pragma unroll
        for (int e = 0; e < 8; ++e) a[e] = gsum[e] / (1.0f + __expf(-gsum[e])) * usum[e];
        u32x4 w; w.x = pk2(a[0], a[1]); w.y = pk2(a[2], a[3]); w.z = pk2(a[4], a[5]); w.w = pk2(a[6], a[7]);
        *(u32x4*)(ACT + (size_t)(half * (NT / 2) + rl) * DFF + n0) = w;
    }
}

#define XB_TMO      128
#define XB_XCNT(j)  (256  + 64 * (j))
#define XB_XSUB(j)  (1280 + 64 * (j))
#define XB_XGEN(j)  (2304 + 64 * (j))
#define XB_TOP      3328
#define XB_TOPGEN   3392
#define XCD_BAR_WORDS 3456
#define XB_SPIN_CAP (1u << 18)

__device__ __forceinline__ unsigned xb_ld(unsigned* p)              { return __hip_atomic_load(p, __ATOMIC_RELAXED, __HIP_MEMORY_SCOPE_AGENT); }
__device__ __forceinline__ unsigned xb_add(unsigned* p, unsigned v) { return __hip_atomic_fetch_add(p, v, __ATOMIC_RELAXED, __HIP_MEMORY_SCOPE_AGENT); }
__device__ __forceinline__ unsigned xb_xcc_id() { return (unsigned)__builtin_amdgcn_s_getreg((3 << 11) | 20) & 0xFu; }
#define XB_SPIN(cond, bar) do { unsigned _sp = 0; while (cond) { __builtin_amdgcn_s_sleep(1); \
    if ((++_sp & 255u) == 0u) { if (xb_ld(&(bar)[XB_TMO])) break; if (_sp > XB_SPIN_CAP) { atomicAdd(&(bar)[XB_TMO], 1u); break; } } } } while (0)

struct XcdBarrier {
    unsigned* bar; unsigned x;
    volatile LAS unsigned* st;
};

__device__ __forceinline__ XcdBarrier xcd_barrier_post(unsigned* bar, volatile LAS unsigned* st) {
    XcdBarrier b; b.bar = bar; b.x = xb_xcc_id(); b.st = st;
    if (threadIdx.x == 0) (void)xb_add(&bar[XB_XCNT(b.x)], 1u);
    return b;
}
__device__ __forceinline__ void xcd_barrier_complete(unsigned* bar, unsigned x, unsigned& nloc, unsigned& nx) {
    const unsigned G = gridDim.x * gridDim.y * gridDim.z;
    unsigned sum, cnt, mine, sp = 0u;
    for (;;) {
        sum = 0u; cnt = 0u; mine = 0u;
#pragma unroll
        for (unsigned j = 0; j < 16; ++j) { const unsigned c = xb_ld(&bar[XB_XCNT(j)]); sum += c; cnt += (c > 0u) ? 1u : 0u; mine = (j == x) ? c : mine; }
        if (sum == G) break;
        __builtin_amdgcn_s_sleep(1);
        if ((++sp & 255u) == 0u) { if (xb_ld(&bar[XB_TMO])) break; if (sp > XB_SPIN_CAP) { atomicAdd(&bar[XB_TMO], 1u); break; } }
    }
    nloc = mine > 0u ? mine : 1u; nx = cnt > 0u ? cnt : 1u;
}

__device__ __forceinline__ void xcd_barrier(const XcdBarrier& b) {
    asm volatile("s_waitcnt vmcnt(0)" ::: "memory");
    __syncthreads();
    if (threadIdx.x == 0) {
        unsigned* bar = b.bar;
        __builtin_amdgcn_s_waitcnt(0);
        unsigned nloc = b.st[0], nx = b.st[1];
        if (nloc == 0u) { xcd_barrier_complete(bar, b.x, nloc, nx); b.st[0] = nloc; b.st[1] = nx; }
        const unsigned old = xb_add(&bar[XB_XSUB(b.x)], 1u);
        const unsigned gen = old / nloc;
        if (old + 1u == (gen + 1u) * nloc) {
            __builtin_amdgcn_fence(__ATOMIC_RELEASE, "agent");
            asm volatile("s_waitcnt vmcnt(0)" ::: "memory");
            const unsigned og = xb_add(&bar[XB_TOP], 1u);
            const unsigned tg = og / nx;
            if (og + 1u == (tg + 1u) * nx) xb_add(&bar[XB_TOPGEN], 1u);
            else XB_SPIN(xb_ld(&bar[XB_TOPGEN]) == tg, bar);
            __builtin_amdgcn_fence(__ATOMIC_ACQUIRE, "agent");
            xb_add(&bar[XB_XGEN(b.x)], 1u);
            asm volatile("s_waitcnt vmcnt(0)" ::: "memory");
        } else {
            XB_SPIN(xb_ld(&bar[XB_XGEN(b.x)]) == gen, bar);
            __builtin_amdgcn_fence(__ATOMIC_ACQUIRE, "agent");
            asm volatile("s_waitcnt vmcnt(0)" ::: "memory");
        }
    }
    __syncthreads();
}

#ifndef PH_MASK
#define PH_MASK 0xFFFFFF
#endif
#define PH(k) ((PH_MASK >> (k)) & 1)
#ifndef REP_P0
#define REP_P0 1
#endif
#ifndef REP_G1
#define REP_G1 1
#endif
#ifndef REP_DIFF
#define REP_DIFF 1
#endif
#ifndef REP_HY
#define REP_HY 1
#endif
#ifndef REP_MEM
#define REP_MEM 1
#endif
#ifndef REP_G3
#define REP_G3 1
#endif
#ifndef REP_G4
#define REP_G4 1
#endif
#ifndef REP_LN1
#define REP_LN1 1
#endif
struct Args { const float* in[24]; float* out; unsigned char* ws; };
__global__ void __launch_bounds__(NTHR, 2) hybrid_fwd(Args a) {
    extern __shared__ __attribute__((aligned(16))) unsigned char smem[];
    LAS unsigned char* lds = (LAS unsigned char*)smem;
    cg::grid_group grid = cg::this_grid();
    volatile LAS unsigned* bst = (volatile LAS unsigned*)(lds + 131072 + 64);
    if (threadIdx.x < 2) bst[threadIdx.x] = 0u;
    __syncthreads();
    const XcdBarrier bar = xcd_barrier_post((unsigned*)(a.ws + WS_BAR), bst);
    const int G = gridDim.x;
#define NEWPHASE() int tid_ = threadIdx.x, cu_ = blockIdx.x; asm volatile("" : "+v"(tid_)); asm volatile("" : "+s"(cu_)); const int tid = tid_, cu = cu_; (void)tid; (void)cu;
    unsigned char* ws = a.ws;
    bf16_t* WALL = (bf16_t*)(ws + WS_WALL); bf16_t* XB = (bf16_t*)(ws + WS_XB); bf16_t* MEMB = (bf16_t*)(ws + WS_MEMB); bf16_t* WKV = (bf16_t*)(ws + WS_WKV);
    bf16_t* QKM = (bf16_t*)(ws + WS_QKM); bf16_t* HT = (bf16_t*)(ws + WS_HT); bf16_t* KMEM = (bf16_t*)(ws + WS_KMEM); bf16_t* VMT = (bf16_t*)(ws + WS_VMT);
    float2* KF = (float2*)(ws + WS_KF); bf16_t* MIX = (bf16_t*)(ws + WS_MIX); float2* STAT = (float2*)(ws + WS_STAT);
    bf16_t* X1B = (bf16_t*)(ws + WS_X1B); bf16_t* HH = (bf16_t*)(ws + WS_HH); bf16_t* ACT = (bf16_t*)(ws + WS_ACT);

    for (int rep = 0; rep < REP_P0; ++rep) { NEWPHASE(); if (PH(0)) p0_prep(a.in, ws, lds, tid); }
    if (a.ws == nullptr) grid.sync();
    xcd_barrier(bar);

    for (int rep = 0; rep < REP_G1; ++rep) {
    if (PH(1)) { NEWPHASE(); pg8::Gemm g{XB, WALL, NT, 1536, DM}; pg8::StaticOrder S; S.init(g.M, g.N, G, cu);
      EpiRope E{QKM, (const float2*)(ws + WS_ROPE)};
      pg8::gemm_phase<EpiRope, pg8::StaticOrder, true, true>(lds, g, S, E); }
    if (PH(2)) { NEWPHASE(); pg8::Gemm g{WALL + (size_t)1536 * DM, XB, 2048, NT, DM}; pg8::StaticOrder S; S.init(g.M, g.N, G, cu);
      EpiB E{HT, NT};
      pg8::gemm_phase<EpiB, pg8::StaticOrder, true, true>(lds, g, S, E); }
    }
    if (PH(3)) { NEWPHASE(); const bool isK = cu < 32, on = cu < 64; const int c2 = cu - 32;
      pg8::Gemm g; EpiB E; OneUnit S;
      if (isK) { g = pg8::Gemm{MEMB, WKV, NMT, 512, DM}; E = EpiB{KMEM, 512}; S = OneUnit{cu >> 1, cu & 1, on}; }
      else { g = pg8::Gemm{WKV + (size_t)512 * DM, MEMB, 512, NMT, DM}; E = EpiB{VMT, NMT}; S = OneUnit{(c2 >> 4) & 1, c2 & 15, on}; }
      pg8::gemm_phase<EpiB, OneUnit, false, true>(lds, g, S, E);
      __syncthreads();
      if (!on) for (int it = cu - 64; it < 1024; it += G - 64) filter_fft_item((const float*)(ws + WS_HTD), KF, lds, it, tid); }
    xcd_barrier(bar);

    { NEWPHASE(); const int xcd = cu & 7, j = cu >> 3;
      float lam;
      { const float* lp = a.in[12]; const int l6 = tid & 63; float s01 = lp[l6] * lp[64 + l6], s23 = lp[128 + l6] * lp[192 + l6];
#pragma unroll
        for (int o = 1; o < 64; o <<= 1) { s01 += __shfl_xor(s01, o); s23 += __shfl_xor(s23, o); }
        lam = expf(s01) - expf(s23) + 0.2f; }
      if (PH(4)) for (int i = 0; i < 4 * REP_DIFF; ++i) {
          const int bh = ((i & 3) * 8 + xcd) * 2 + (j >> 4), qblk = j & 15, b = bh >> 2, hd = bh & 3;
          const size_t tok0 = (size_t)b * SEQ;
          attn_unit<2>(lds, QKM + (tok0 + qblk * 128) * MIXW + hd * 128, MIXW, QKM + tok0 * MIXW + 512 + hd * 128, MIXW,
                       HT + (size_t)(1536 + hd * 128) * NT + tok0, NT, SEQ, 0.125f * 1.4426950408889634f,
                       MIX + (tok0 + qblk * 128) * MIXW + 512 + hd * 128, MIXW, lam, a.in[13], tid); }
      if (PH(5)) for (int i = 0; i < 2 * REP_MEM; ++i) {
          const int bh = ((i & 1) * 8 + xcd) * 4 + (j >> 3), qblk = j & 7, b = bh >> 2, hd = bh & 3;
          const size_t tok0 = (size_t)b * SEQ;
          attn_unit<1>(lds, QKM + (tok0 + qblk * 256) * MIXW + 1024 + hd * 128, MIXW, KMEM + (size_t)b * MEMT * 512 + hd * 128, 512,
                       VMT + (size_t)(hd * 128) * NMT + b * MEMT, NMT, MEMT, 0.08838834764831845f * 1.4426950408889634f,
                       MIX + (tok0 + qblk * 256) * MIXW + 1024 + hd * 128, MIXW, 0.f, nullptr, tid); }
      if (PH(6)) for (int i = 0; i < 2 * REP_HY; ++i) {
          const int cgp = ((i & 1) * 8 + xcd) * 4 + (j >> 3), bp = j & 7;
          hyena_item(HT, KF, a.in[3], a.in[4], a.in[11], MIX, lds, bp, cgp, tid); } }
    xcd_barrier(bar);

#ifdef REP_SYNC
    for (int rep = 0; rep < REP_SYNC; ++rep) xcd_barrier(bar);
#endif
    for (int rep = 0; rep < REP_G3; ++rep) if (PH(7)) { NEWPHASE(); pg8::Gemm g{MIX, (const bf16_t*)(ws + WS_WOUT), NT, DM, MIXW}; pg8::StaticOrder S; S.init(g.M, g.N, G, cu);
      EpiRes E{a.in[0], a.out};
      pg8::gemm_phase<EpiRes, pg8::StaticOrder, true, true>(lds, g, S, E); }
    xcd_barrier(bar);
    for (int rep = 0; rep < REP_LN1; ++rep) if (PH(8)) { NEWPHASE(); ln_rows<true>(a.out, X1B, STAT, a.in[16], a.in[17], tid); }
    xcd_barrier(bar);
    for (int rep = 0; rep < REP_G4; ++rep) if (PH(9)) { NEWPHASE(); pg8::Gemm g{X1B, (const bf16_t*)(ws + WS_WUP), FFN_MT * 256, 2 * DFF, DM}; FfnOrder S; S.init(g.M, g.N, G, cu);
      EpiFfn E{ACT, a.in[19], a.in[20], lds};
      pg8::gemm_phase<EpiFfn, FfnOrder, true, true>(lds, g, S, E); }
    xcd_barrier(bar);
    if (PH(11)) { NEWPHASE(); pg8::Gemm g{ACT, (const bf16_t*)(ws + WS_WDN), NT, DM, DFF}; pg8::StaticOrder S; S.init(g.M, g.N, G, cu);
      EpiRes2 E{a.out, STAT, a.in[16], a.in[17]};
      pg8::gemm_phase<EpiRes2, pg8::StaticOrder, true, true>(lds, g, S, E); }
    xcd_barrier(bar);
    if (PH(12)) { NEWPHASE(); ln_rows<false>(a.out, nullptr, nullptr, a.in[22], a.in[23], tid); }
}

extern "C" void kernel_launch(void* const* d_in, const int* in_sizes, int n_in, void* d_out, int out_size, void* d_ws, size_t ws_size, hipStream_t stream) {
    static int grid = 0;
    if (grid == 0) {
        if (n_in != 24 || out_size != NT * DM || ws_size < WS_END) { fprintf(stderr, "kernel_launch: unexpected shapes (n_in %d, out %d, ws %zu)\n", n_in, out_size, ws_size); grid = -1; return; }
        int dev = 0, cus = 0, per_cu = 0;
        hipGetDevice(&dev); hipDeviceGetAttribute(&cus, hipDeviceAttributeMultiprocessorCount, dev);
        if (hipFuncSetAttribute((const void*)hybrid_fwd, hipFuncAttributeMaxDynamicSharedMemorySize, LDS_BYTES) != hipSuccess) { fprintf(stderr, "kernel_launch: hipFuncSetAttribute failed\n"); grid = -1; return; }
        if (hipOccupancyMaxActiveBlocksPerMultiprocessor(&per_cu, (const void*)hybrid_fwd, NTHR, LDS_BYTES) != hipSuccess || per_cu < 1) { fprintf(stderr, "kernel_launch: occupancy query says %d\n", per_cu); per_cu = 1; }
        (void)hipGetLastError();
        grid = cus * per_cu;
        fprintf(stderr, "kernel_launch: grid %d (cus %d x %d)\n", grid, cus, per_cu);
    }
    if (grid < 0) return;
    if (hipMemsetAsync((char*)d_ws + WS_BAR, 0, XCD_BAR_WORDS * 4, stream) != hipSuccess) { fprintf(stderr, "kernel_launch: memset failed\n"); return; }
    Args a{};
    for (int i = 0; i < 24; ++i) a.in[i] = (const float*)d_in[i];
    a.out = (float*)d_out; a.ws = (unsigned char*)d_ws;
    void* args[] = {&a};
    const hipError_t e = hipLaunchCooperativeKernel((const void*)hybrid_fwd, dim3(grid), dim3(NTHR), args, LDS_BYTES, stream);
    if (e != hipSuccess) fprintf(stderr, "kernel_launch: cooperative launch failed: %s (grid %d)\n", hipGetErrorString(e), grid);
}
```

```cpp
#include <hip/hip_runtime.h>
#include <hip/hip_cooperative_groups.h>
#include <cstdio>
#include <cstdint>
namespace cg = cooperative_groups;
#define LAS __attribute__((address_space(3)))
namespace pg8 {
#define PG8_LAS __attribute__((address_space(3)))
typedef unsigned short bf16_t;
typedef short bf16x8 __attribute__((ext_vector_type(8)));
typedef float f32x4 __attribute__((ext_vector_type(4)));
typedef unsigned u32x4 __attribute__((ext_vector_type(4)));
constexpr int BM = 256, BK = 64, HALF = 128, HTB = HALF * BK * 2  , STAGE_BYTES = 8 * HTB, NXCD = 8, WGM = 8;

__host__ __device__ __forceinline__ int lds_byte(int r, int c) { const int st = (r >> 4) * 2 + (c >> 5), rr = r & 15, cc = c & 31, ob = rr * 64 + cc * 2; return st * 1024 + (ob ^ (((ob >> 9) & 1) << 5)); }
__host__ __device__ __forceinline__ void stage_rc(int b, int& R, int& C) { const int st = b / 1024, sb = b % 1024, swz = sb ^ (((sb >> 9) & 1) << 5); R = (st >> 1) * 16 + swz / 64; C = (st & 1) * 32 + (swz % 64) / 2; }
__host__ __device__ __forceinline__ int perm32(int rho) { const int n = rho >> 4, i = rho & 15; return 8 * (i >> 2) + 4 * n + (i & 3); }

struct Unit { int pm, pn; };
struct Gemm { const bf16_t* A; const bf16_t* Bt; int M, N, K; };

struct StaticOrder {
    int nM, nN, nwg, G, c;
    __host__ __device__ void init(int M, int N, int G_, int c_) { nM = M / BM; nN = N / BM; nwg = nM * nN; G = G_; c = c_; }
    __host__ __device__ bool next(int i, Unit& u) const {
        const long L = (long)i * G + c; if (L >= nwg) return false;
        int wgid = (int)L; { const int q = nwg / NXCD, r = nwg % NXCD, xcd = wgid % NXCD, off = wgid / NXCD; wgid = (xcd < r ? xcd * (q + 1) : r * (q + 1) + (xcd - r) * q) + off; }
        const int nig = WGM * nN, gid = wgid / nig, fm = gid * WGM, gsz = (nM - fm) < WGM ? (nM - fm) : WGM;
        u.pm = fm + ((wgid % nig) % gsz); u.pn = (wgid % nig) / gsz; return true;
    }
    __device__ __forceinline__ void a_ready(const Unit&) const {}
    __device__ __forceinline__ void done(const Unit&) const {}
    __device__ __forceinline__ long a_off(const Unit& u, size_t tstep) const { return (long)((size_t)u.pm * tstep); }
};
template <class Epi, class Sched, bool ALIGN_EPI = false, bool SP2 = false>
__device__ __forceinline__ void gemm_phase(PG8_LAS unsigned char* lds, const Gemm g, const Sched& S, const Epi& E) {
    int tid_l = threadIdx.x; asm volatile("" : "+v"(tid_l)); const int tid = tid_l, wid = __builtin_amdgcn_readfirstlane(tid >> 6), lane = tid & 63, wr = wid >> 2, wc = wid & 3, fr = lane & 15, fq = lane >> 4;
    const int K = g.K, nt = K / BK;
    unsigned voffA[2], voffB[2];
#pragma unroll
    for (int i = 0; i < 2; ++i) { int R, C; stage_rc(tid * 16 + i * 8192, R, C); const int Rb = Epi::PERM ? ((R & ~31) + perm32(R & 31)) : R;
        voffA[i] = (unsigned)(R * K + C) * 2u; voffB[i] = (unsigned)(Rb * K + C) * 2u; }
    const size_t kstep = (size_t)(BK * 2);
    const size_t hstep = (size_t)HALF * K * 2;
    const size_t tstep = 2 * hstep;
    const unsigned ldsw = (unsigned)wid * 1024u;
    const int aoff = lds_byte(wr * 64 + fr, fq * 8), boff = lds_byte(wc * 32 + fr, fq * 8);
#define PG8_SA(b, h) (((b) * 2 + (h)) * HTB)
#define PG8_SB(b, h) ((4 + (b) * 2 + (h)) * HTB)
#define PG8_STAGE(bufoff, gbase, voff) do { _Pragma("unroll") for (int _i = 0; _i < 2; ++_i) \
        __builtin_amdgcn_global_load_lds((const unsigned*)((const char*)(gbase) + (voff)[_i]), (PG8_LAS unsigned*)(lds + (bufoff) + ldsw + _i * 8192), 16, 0, 0); } while (0)
#define PG8_LDA(dst, b, h) do { _Pragma("unroll") for (int m = 0; m < 4; ++m) _Pragma("unroll") for (int k = 0; k < 2; ++k) dst[m][k] = *(const PG8_LAS bf16x8*)(lds + PG8_SA(b, h) + aoff + m * 2048 + k * 1024); } while (0)
#define PG8_LDB(dst, b, h) do { _Pragma("unroll") for (int n = 0; n < 2; ++n) _Pragma("unroll") for (int k = 0; k < 2; ++k) dst[n][k] = *(const PG8_LAS bf16x8*)(lds + PG8_SB(b, h) + boff + n * 2048 + k * 1024); } while (0)
#define PG8_MMA(ai, bj, At, Bt) do { __builtin_amdgcn_s_setprio(1); _Pragma("unroll") for (int m = 0; m < 4; ++m) _Pragma("unroll") for (int n = 0; n < 2; ++n) _Pragma("unroll") for (int k = 0; k < 2; ++k) \
        acc[ai][bj][m][n] = __builtin_amdgcn_mfma_f32_16x16x32_bf16(Bt[n][k], At[m][k], acc[ai][bj][m][n], 0, 0, 0); __builtin_amdgcn_s_setprio(0); } while (0)
#define PG8_WAIT_V(n) asm volatile("s_waitcnt vmcnt(" #n ")" ::: "memory")
#define PG8_WAIT_L(n) asm volatile("s_waitcnt lgkmcnt(" #n ")" ::: "memory")
#define PG8_BAR __builtin_amdgcn_s_barrier()
#define PG8_SCHED __builtin_amdgcn_sched_barrier(0)
    Unit cur, nxt; int ui = 0;
    if (!S.next(0, cur)) return;
    f32x4 acc[2][2][4][2];
#pragma unroll
    for (int a = 0; a < 2; ++a)
#pragma unroll
        for (int b = 0; b < 2; ++b)
#pragma unroll
            for (int m = 0; m < 4; ++m)
#pragma unroll
                for (int n = 0; n < 2; ++n) acc[a][b][m][n] = (f32x4){0.f, 0.f, 0.f, 0.f};
    bf16x8 At[4][2], B0[2][2], B1[2][2];
    const char* cA = (const char*)g.A + S.a_off(cur, tstep); const char* cB = (const char*)g.Bt + (size_t)cur.pn * tstep;
    S.a_ready(cur);
    if constexpr (SP2) {
        PG8_STAGE(PG8_SB(0, 0), cB, voffB); PG8_STAGE(PG8_SB(0, 1), cB + hstep, voffB); PG8_STAGE(PG8_SA(0, 0), cA, voffA); PG8_STAGE(PG8_SA(0, 1), cA + hstep, voffA);
        if (wr == 1) PG8_BAR;
        PG8_WAIT_V(2); PG8_BAR;
        PG8_STAGE(PG8_SB(1, 0), cB + kstep, voffB); PG8_STAGE(PG8_SA(1, 0), cA + kstep, voffA); PG8_STAGE(PG8_SB(1, 1), cB + hstep + kstep, voffB);
        PG8_WAIT_V(6); PG8_BAR;
    } else {
        PG8_STAGE(PG8_SB(0, 0), cB, voffB); PG8_STAGE(PG8_SA(0, 0), cA, voffA); PG8_STAGE(PG8_SB(0, 1), cB + hstep, voffB); PG8_STAGE(PG8_SA(0, 1), cA + hstep, voffA);
        if (wr == 1) PG8_BAR;
        PG8_WAIT_V(4); PG8_BAR;
        PG8_STAGE(PG8_SB(1, 0), cB + kstep, voffB); PG8_STAGE(PG8_SA(1, 0), cA + kstep, voffA); PG8_STAGE(PG8_SB(1, 1), cB + hstep + kstep, voffB);
        PG8_WAIT_V(6); PG8_BAR;
    }
    for (;;) {
        const bool has_next = S.next(ui + 1, nxt);
        const char* nA = has_next ? (const char*)g.A + S.a_off(nxt, tstep) : cA; const char* nB = has_next ? (const char*)g.Bt + (size_t)nxt.pn * tstep : cB;
        for (int t = 0; t < nt; t += 2) {
            const bool last = (t == nt - 2);
            const char* a1 = cA + (size_t)(t + 1) * kstep;
            const char* a2 = last ? nA : cA + (size_t)(t + 2) * kstep; const char* b2 = last ? nB : cB + (size_t)(t + 2) * kstep;
            const char* a3 = a2 + kstep; const char* b3 = b2 + kstep;
            if (last && has_next) S.a_ready(nxt);
            if constexpr (SP2) {
            PG8_LDB(B0, 0, 0); PG8_LDB(B1, 0, 1); PG8_SCHED; PG8_LDA(At, 0, 0); PG8_STAGE(PG8_SA(1, 1), a1 + hstep, voffA);
            PG8_WAIT_V(8); PG8_WAIT_L(0); PG8_BAR; PG8_MMA(0, 0, At, B0); PG8_MMA(0, 1, At, B1); PG8_BAR; PG8_SCHED;
            PG8_LDA(At, 0, 1); PG8_STAGE(PG8_SB(0, 0), b2, voffB); PG8_STAGE(PG8_SB(0, 1), b2 + hstep, voffB); PG8_STAGE(PG8_SA(0, 0), a2, voffA);
            PG8_WAIT_V(8); PG8_WAIT_L(0); PG8_BAR; PG8_MMA(1, 0, At, B0); PG8_MMA(1, 1, At, B1); PG8_BAR; PG8_SCHED;
            PG8_LDB(B0, 1, 0); PG8_LDB(B1, 1, 1); PG8_SCHED; PG8_LDA(At, 1, 0); PG8_STAGE(PG8_SA(0, 1), a2 + hstep, voffA);
            PG8_WAIT_V(8); PG8_WAIT_L(0); PG8_BAR; PG8_MMA(0, 0, At, B0); PG8_MMA(0, 1, At, B1); PG8_BAR; PG8_SCHED;
            PG8_LDA(At, 1, 1); PG8_STAGE(PG8_SB(1, 0), b3, voffB); PG8_STAGE(PG8_SB(1, 1), b3 + hstep, voffB); PG8_STAGE(PG8_SA(1, 0), a3, voffA);
            PG8_WAIT_V(8); PG8_WAIT_L(0); PG8_BAR; PG8_MMA(1, 0, At, B0); PG8_MMA(1, 1, At, B1); PG8_BAR; PG8_SCHED;
            } else {
            PG8_LDB(B0, 0, 0); PG8_SCHED; PG8_LDA(At, 0, 0); PG8_STAGE(PG8_SA(1, 1), a1 + hstep, voffA);
            PG8_WAIT_L(8); PG8_BAR; PG8_WAIT_L(0); PG8_MMA(0, 0, At, B0); PG8_BAR; PG8_SCHED;
            PG8_LDB(B1, 0, 1); PG8_STAGE(PG8_SB(0, 0), b2, voffB);
            PG8_BAR; PG8_WAIT_L(0); PG8_MMA(0, 1, At, B1); PG8_BAR;
            PG8_LDA(At, 0, 1); PG8_STAGE(PG8_SA(0, 0), a2, voffA);
            PG8_BAR; PG8_WAIT_L(0); PG8_MMA(1, 0, At, B0); PG8_BAR; PG8_SCHED;
            PG8_STAGE(PG8_SB(0, 1), b2 + hstep, voffB);
            PG8_WAIT_V(6); PG8_BAR; PG8_MMA(1, 1, At, B1); PG8_BAR;
            PG8_LDB(B0, 1, 0); PG8_SCHED; PG8_LDA(At, 1, 0); PG8_STAGE(PG8_SA(0, 1), a2 + hstep, voffA);
            PG8_WAIT_L(8); PG8_BAR; PG8_WAIT_L(0); PG8_MMA(0, 0, At, B0); PG8_BAR; PG8_SCHED;
            PG8_LDB(B1, 1, 1); PG8_STAGE(PG8_SB(1, 0), b3, voffB);
            PG8_BAR; PG8_WAIT_L(0); PG8_MMA(0, 1, At, B1); PG8_BAR;
            PG8_LDA(At, 1, 1); PG8_STAGE(PG8_SA(1, 0), a3, voffA);
            PG8_BAR; PG8_WAIT_L(0); PG8_MMA(1, 0, At, B0); PG8_BAR; PG8_SCHED;
            PG8_STAGE(PG8_SB(1, 1), b3 + hstep, voffB);
            PG8_WAIT_V(6); PG8_BAR; PG8_MMA(1, 1, At, B1); PG8_BAR;
            }
        }
        if constexpr (ALIGN_EPI) { if (wr == 0) PG8_BAR; }
        if constexpr (!Epi::AFTER_DRAIN) { E(acc, cur, wr, wc, fr, fq); S.done(cur); }
        if (!has_next) break;
#pragma unroll
        for (int a = 0; a < 2; ++a)
#pragma unroll
            for (int b = 0; b < 2; ++b)
#pragma unroll
                for (int m = 0; m < 4; ++m)
#pragma unroll
                    for (int n = 0; n < 2; ++n) acc[a][b][m][n] = (f32x4){0.f, 0.f, 0.f, 0.f};
        cur = nxt; cA = nA; cB = nB; ++ui;
        if constexpr (ALIGN_EPI) { if (wr == 1) PG8_BAR; }
    }
    PG8_WAIT_V(0);
    if constexpr (!ALIGN_EPI) { if (wr == 0) PG8_BAR; }
    PG8_BAR;
    if constexpr (Epi::AFTER_DRAIN) { E.fused(acc, cur, wr, wc, fr, fq, lds, wid, lane); S.done(cur); }
#undef PG8_SA
#undef PG8_SB
#undef PG8_STAGE
#undef PG8_LDA
#undef PG8_LDB
#undef PG8_MMA
#undef PG8_WAIT_V
#undef PG8_WAIT_L
#undef PG8_BAR
#undef PG8_SCHED
}
}

using pg8::bf16_t; using pg8::bf16x8; using pg8::f32x4; using pg8::u32x4;
typedef float f32x16 __attribute__((ext_vector_type(16)));
typedef unsigned u32x2 __attribute__((ext_vector_type(2)));
typedef short bf16x4 __attribute__((ext_vector_type(4)));

constexpr int NB = 16, SEQ = 2048, DM = 1024, NT = NB * SEQ, MEMT = 256, NMT = NB * MEMT, HW = 512, INW = 3584, DFF = 2816, MIXW = 1536;
constexpr float ALPHA = 1.189207115002721f;
constexpr float LN_EPS = 1e-5f, RMS_EPS = 1e-5f;
constexpr int NTHR = 512, NWAVE = 8;
constexpr int LDS_BYTES = 151552;

constexpr size_t MiB = 1048576;
constexpr size_t WS_WALL = 0;
constexpr size_t WS_WKV  = 7 * MiB;
constexpr size_t WS_WOUT = 9 * MiB;
constexpr size_t WS_WUP  = 12 * MiB;
constexpr size_t WS_WDN  = 23 * MiB;
constexpr size_t WS_ROPE = 29 * MiB;
constexpr size_t WS_STAT = 29 * MiB + 524288;
constexpr size_t WS_XB   = 30 * MiB;
constexpr size_t WS_X1B  = 30 * MiB;
constexpr size_t WS_HTD  = 94 * MiB;
constexpr size_t WS_MEMB = 110 * MiB;
constexpr size_t WS_QKM  = 118 * MiB;
constexpr size_t WS_HT   = 214 * MiB;
constexpr size_t WS_KMEM = 342 * MiB;
constexpr size_t WS_VMT  = 346 * MiB;
constexpr size_t WS_KF   = 350 * MiB;
constexpr size_t WS_MIX  = 382 * MiB;
constexpr size_t WS_HH   = 96 * MiB;
constexpr size_t WS_ACT  = 272 * MiB;
constexpr size_t WS_BAR  = 478 * MiB;
constexpr size_t WS_END  = 478 * MiB + 65536;

__device__ __forceinline__ unsigned pk2(float lo, float hi) { unsigned r; asm volatile("v_cvt_pk_bf16_f32 %0, %1, %2" : "=v"(r) : "v"(lo), "v"(hi)); return r; }
__device__ __forceinline__ float bf2f(bf16_t v) { return __uint_as_float((unsigned)v << 16); }
__device__ __forceinline__ float lo2f(unsigned v) { return __uint_as_float(v << 16); }
__device__ __forceinline__ float hi2f(unsigned v) { return __uint_as_float(v & 0xffff0000u); }
#define LDS_WAIT() asm volatile("s_waitcnt lgkmcnt(0)" ::: "memory")

#ifndef FFT_HOST
#define FFT_FN __device__ __forceinline__
#define FFT_SYNC() __syncthreads()
typedef float cplx __attribute__((ext_vector_type(2)));
typedef LAS cplx* fftbuf_t;
FFT_FN float cos2pi(float r) { return __builtin_amdgcn_cosf(r); }
FFT_FN float sin2pi(float r) { return __builtin_amdgcn_sinf(r); }
#endif
FFT_FN cplx mk2(float x, float y) { cplx r; r.x = x; r.y = y; return r; }
FFT_FN cplx cadd(cplx a, cplx b) { return mk2(a.x + b.x, a.y + b.y); }
FFT_FN cplx csub(cplx a, cplx b) { return mk2(a.x - b.x, a.y - b.y); }
FFT_FN cplx cmul(cplx a, cplx b) { return mk2(a.x * b.x - a.y * b.y, a.x * b.y + a.y * b.x); }
template <bool INV> FFT_FN cplx muli(cplx a) { return INV ? mk2(-a.y, a.x) : mk2(a.y, -a.x); }
FFT_FN int padi(int i) { return i + (i >> 3); }

template <bool INV> FFT_FN void dft8(cplx (&v)[8]) {
    const float R = 0.70710678118654752f;
    const cplx a0 = cadd(v[0], v[4]), a1 = csub(v[0], v[4]), a2 = cadd(v[2], v[6]), a3 = muli<INV>(csub(v[2], v[6]));
    const cplx a4 = cadd(v[1], v[5]), a5 = csub(v[1], v[5]), a6 = cadd(v[3], v[7]), a7 = muli<INV>(csub(v[3], v[7]));
    const cplx b0 = cadd(a0, a2), b2 = csub(a0, a2), b1 = cadd(a1, a3), b3 = csub(a1, a3);
    const cplx b4 = cadd(a4, a6), b6 = muli<INV>(csub(a4, a6));
    const cplx t5 = cadd(a5, a7), t7 = csub(a5, a7);
    cplx b5, b7;
    if (!INV) { b5 = mk2((t5.x + t5.y) * R, (t5.y - t5.x) * R); b7 = mk2((t7.y - t7.x) * R, -(t7.x + t7.y) * R); }
    else      { b5 = mk2((t5.x - t5.y) * R, (t5.x + t5.y) * R); b7 = mk2(-(t7.x + t7.y) * R, (t7.x - t7.y) * R); }
    v[0] = cadd(b0, b4); v[4] = csub(b0, b4); v[1] = cadd(b1, b5); v[5] = csub(b1, b5);
    v[2] = cadd(b2, b6); v[6] = csub(b2, b6); v[3] = cadd(b3, b7); v[7] = csub(b3, b7);
}
template <int S, bool INV> FFT_FN void twid(cplx (&v)[8], int tid) {
    if (S > 1) {
        const int j = tid % S; const float rev = (float)j * (1.0f / (8.0f * S));
        const float c = cos2pi(rev), s = sin2pi(rev);
        const cplx w1 = mk2(c, INV ? s : -s);
        const cplx w2 = cmul(w1, w1), w3 = cmul(w2, w1), w4 = cmul(w2, w2), w5 = cmul(w4, w1), w6 = cmul(w4, w2), w7 = cmul(w4, w3);
        v[1] = cmul(v[1], w1); v[2] = cmul(v[2], w2); v[3] = cmul(v[3], w3); v[4] = cmul(v[4], w4);
        v[5] = cmul(v[5], w5); v[6] = cmul(v[6], w6); v[7] = cmul(v[7], w7);
    }
}
template <int S> FFT_FN void ld8(fftbuf_t X, int tid, cplx (&v)[8]) {
    const int base = (tid / S) * 8 * S + (tid % S);
#pragma unroll
    for (int k = 0; k < 8; ++k) v[k] = X[padi(base + S * k)];
}
template <int S> FFT_FN void st8(fftbuf_t X, int tid, const cplx (&v)[8]) {
    const int base = (tid / S) * 8 * S + (tid % S);
#pragma unroll
    for (int k = 0; k < 8; ++k) X[padi(base + S * k)] = v[k];
}
#ifndef FFT_HOST
template <int S> FFT_FN void twid_fill(fftbuf_t TW, int tid) {
    constexpr int P = (S == 512) ? 0 : (S == 64) ? 1 : 2;
    const int j = tid % S; const float rev = (float)j * (1.0f / (8.0f * S));
    const cplx w1 = mk2(cos2pi(rev), -sin2pi(rev)), w2 = cmul(w1, w1), w4 = cmul(w2, w2);
    TW[(3 * P + 0) * 512 + tid] = w1; TW[(3 * P + 1) * 512 + tid] = w2; TW[(3 * P + 2) * 512 + tid] = w4;
}
template <int S, bool INV> FFT_FN void twidL(cplx (&v)[8], fftbuf_t TW, int tid) {
    constexpr int P = (S == 512) ? 0 : (S == 64) ? 1 : 2;
    cplx w1 = TW[(3 * P + 0) * 512 + tid], w2 = TW[(3 * P + 1) * 512 + tid], w4 = TW[(3 * P + 2) * 512 + tid];
    if (INV) { w1.y = -w1.y; w2.y = -w2.y; w4.y = -w4.y; }
    const cplx w3 = cmul(w2, w1), w5 = cmul(w4, w1), w6 = cmul(w4, w2), w7 = cmul(w4, w3);
    v[1] = cmul(v[1], w1); v[2] = cmul(v[2], w2); v[3] = cmul(v[3], w3); v[4] = cmul(v[4], w4);
    v[5] = cmul(v[5], w5); v[6] = cmul(v[6], w6); v[7] = cmul(v[7], w7);
}
FFT_FN void fft_fwdL(fftbuf_t X, fftbuf_t TW, int tid, cplx (&v)[8]) {
    dft8<false>(v); twidL<512, false>(v, TW, tid); st8<512>(X, tid, v); FFT_SYNC();
    ld8<64>(X, tid, v); dft8<false>(v); twidL<64, false>(v, TW, tid); st8<64>(X, tid, v); FFT_SYNC();
    ld8<8>(X, tid, v); dft8<false>(v); twidL<8, false>(v, TW, tid); st8<8>(X, tid, v); FFT_SYNC();
    ld8<1>(X, tid, v); dft8<false>(v);
}
FFT_FN void fft_invL(fftbuf_t X, fftbuf_t TW, int tid, cplx (&v)[8]) {
    dft8<true>(v); st8<1>(X, tid, v); FFT_SYNC();
    ld8<8>(X, tid, v); twidL<8, true>(v, TW, tid); dft8<true>(v); st8<8>(X, tid, v); FFT_SYNC();
    ld8<64>(X, tid, v); twidL<64, true>(v, TW, tid); dft8<true>(v); st8<64>(X, tid, v); FFT_SYNC();
    ld8<512>(X, tid, v); twidL<512, true>(v, TW, tid); dft8<true>(v);
}
FFT_FN void fft_fwd(fftbuf_t X, int tid, cplx (&v)[8]) {
    dft8<false>(v); twid<512, false>(v, tid); st8<512>(X, tid, v); FFT_SYNC();
    ld8<64>(X, tid, v); dft8<false>(v); twid<64, false>(v, tid); st8<64>(X, tid, v); FFT_SYNC();
    ld8<8>(X, tid, v); dft8<false>(v); twid<8, false>(v, tid); st8<8>(X, tid, v); FFT_SYNC();
    ld8<1>(X, tid, v); dft8<false>(v);
}
FFT_FN void fft_inv(fftbuf_t X, int tid, cplx (&v)[8]) {
    dft8<true>(v); st8<1>(X, tid, v); FFT_SYNC();
    ld8<8>(X, tid, v); twid<8, true>(v, tid); dft8<true>(v); st8<8>(X, tid, v); FFT_SYNC();
    ld8<64>(X, tid, v); twid<64, true>(v, tid); dft8<true>(v); st8<64>(X, tid, v); FFT_SYNC();
    ld8<512>(X, tid, v); twid<512, true>(v, tid); dft8<true>(v);
}
#endif

struct OneUnit { int pm, pn; bool on;
    __device__ __forceinline__ bool next(int i, pg8::Unit& u) const { if (!on || i > 0) return false; u.pm = pm; u.pn = pn; return true; }
    __device__ __forceinline__ void a_ready(const pg8::Unit&) const {}
    __device__ __forceinline__ void done(const pg8::Unit&) const {}
    __device__ __forceinline__ long a_off(const pg8::Unit& u, size_t tstep) const { return (long)((size_t)u.pm * tstep); } };

struct EpiB {
    static constexpr bool PERM = true, AFTER_DRAIN = false;
    bf16_t* O; int ldc;
    __device__ __forceinline__ void operator()(const f32x4 (&acc)[2][2][4][2], const pg8::Unit& u, int wr, int wc, int fr, int fq) const {
        const int row0 = u.pm * 256 + wr * 64 + fr, col0 = u.pn * 256 + wc * 32 + 8 * fq;
#pragma unroll
        for (int ai = 0; ai < 2; ++ai)
#pragma unroll
            for (int m = 0; m < 4; ++m) { bf16_t* rowp = O + (size_t)(row0 + ai * 128 + m * 16) * ldc + col0;
#pragma unroll
                for (int bj = 0; bj < 2; ++bj) { const f32x4 v0 = acc[ai][bj][m][0], v1 = acc[ai][bj][m][1];
                    u32x4 w; w.x = pk2(v0[0], v0[1]); w.y = pk2(v0[2], v0[3]); w.z = pk2(v1[0], v1[1]); w.w = pk2(v1[2], v1[3]);
                    *(u32x4*)(rowp + bj * 128) = w; } }
    }
};
struct EpiRope {
    static constexpr bool PERM = true, AFTER_DRAIN = false;
    bf16_t* O; const float2* rope;
    __device__ __forceinline__ void operator()(const f32x4 (&acc)[2][2][4][2], const pg8::Unit& u, int wr, int wc, int fr, int fq) const {
        const int row0 = u.pm * 256 + wr * 64 + fr, col0 = u.pn * 256 + wc * 32 + 8 * fq;
        const bool rot = u.pn < 4;
#pragma unroll
        for (int ai = 0; ai < 2; ++ai)
#pragma unroll
            for (int m = 0; m < 4; ++m) { const int row = row0 + ai * 128 + m * 16; bf16_t* rowp = O + (size_t)row * MIXW + col0;
#pragma unroll
                for (int bj = 0; bj < 2; ++bj) { f32x4 v0 = acc[ai][bj][m][0], v1 = acc[ai][bj][m][1];
                    if (rot) { const int pos = row & (SEQ - 1), i0 = ((col0 + bj * 128) & 63) >> 1;
                        const f32x4* rp = (const f32x4*)(rope + pos * 32 + i0); const f32x4 r0 = rp[0], r1 = rp[1];
                        f32x4 o0, o1;
                        o0[0] = v0[0] * r0[0] - v0[1] * r0[1]; o0[1] = v0[1] * r0[0] + v0[0] * r0[1];
                        o0[2] = v0[2] * r0[2] - v0[3] * r0[3]; o0[3] = v0[3] * r0[2] + v0[2] * r0[3];
                        o1[0] = v1[0] * r1[0] - v1[1] * r1[1]; o1[1] = v1[1] * r1[0] + v1[0] * r1[1];
                        o1[2] = v1[2] * r1[2] - v1[3] * r1[3]; o1[3] = v1[3] * r1[2] + v1[2] * r1[3];
                        v0 = o0; v1 = o1; }
                    u32x4 w; w.x = pk2(v0[0], v0[1]); w.y = pk2(v0[2], v0[3]); w.z = pk2(v1[0], v1[1]); w.w = pk2(v1[2], v1[3]);
                    *(u32x4*)(rowp + bj * 128) = w; } }
    }
};
struct EpiRes {
    static constexpr bool PERM = false, AFTER_DRAIN = false;
    const float* X; float* O;
    __device__ __forceinline__ void operator()(const f32x4 (&acc)[2][2][4][2], const pg8::Unit& u, int wr, int wc, int fr, int fq) const {
        const int row0 = u.pm * 256 + wr * 64 + fr, col0 = u.pn * 256 + wc * 32 + 4 * fq;
#pragma unroll
        for (int ai = 0; ai < 2; ++ai)
#pragma unroll
            for (int m = 0; m < 4; ++m) { const size_t ro = (size_t)(row0 + ai * 128 + m * 16) * DM;
#pragma unroll
                for (int bj = 0; bj < 2; ++bj)
#pragma unroll
                    for (int n = 0; n < 2; ++n) { const int c = col0 + bj * 128 + 16 * n;
                        const f32x4 xv = *(const f32x4*)(X + ro + c); *(f32x4*)(O + ro + c) = acc[ai][bj][m][n] + xv * ALPHA; } }
    }
};
struct EpiRes2 {
    static constexpr bool PERM = false, AFTER_DRAIN = false;
    const float* R; float* O; const float2* stat; const float* g; const float* b;
    __device__ __forceinline__ void operator()(const f32x4 (&acc)[2][2][4][2], const pg8::Unit& u, int wr, int wc, int fr, int fq) const {
        const int row0 = u.pm * 256 + wr * 64 + fr, col0 = u.pn * 256 + wc * 32 + 4 * fq;
#pragma unroll
        for (int bj = 0; bj < 2; ++bj)
#pragma unroll
            for (int n = 0; n < 2; ++n) { const int c = col0 + bj * 128 + 16 * n;
                const f32x4 gv = *(const f32x4*)(g + c), bv = *(const f32x4*)(b + c);
#pragma unroll
                for (int ai = 0; ai < 2; ++ai)
#pragma unroll
                    for (int m = 0; m < 4; ++m) { const int row = row0 + ai * 128 + m * 16; const float2 st = stat[row];
                        const size_t off = (size_t)row * DM + c; const f32x4 r1 = *(const f32x4*)(R + off);
                        const f32x4 x1 = (r1 - st.x) * st.y * gv + bv; *(f32x4*)(O + off) = acc[ai][bj][m][n] + x1 * ALPHA; } }
    }
};


struct RevOrder : pg8::StaticOrder {
    __device__ __forceinline__ bool next(int i, pg8::Unit& u) const { const int rounds = (nwg + G - 1) / G; if (i >= rounds) return false; return pg8::StaticOrder::next(rounds - 1 - i, u); }
};
constexpr int CWL_OFF = 131072 + 1024 + 8192;
struct FfnOrder : pg8::StaticOrder {
    const float* cw; const float* cb; LAS unsigned char* lds; mutable int cnt;
    __device__ __forceinline__ long a_off(const pg8::Unit& u, size_t) const { return ((long)u.pm * 254 - 1) * (long)(DM * 2); }
    __device__ __forceinline__ void a_ready(const pg8::Unit& u) const {
        const int tid = threadIdx.x, w = __builtin_amdgcn_readfirstlane(tid >> 6), lane = tid & 63, buf = cnt & 1; ++cnt;
        const float* src = (w < 3) ? cw + (size_t)w * (2 * DFF) : (w < 6) ? cw + (size_t)(w - 3) * (2 * DFF) + DFF : (w == 6) ? cb : cb + DFF;
        src += u.pn * 128 + lane * 4;
        if (lane < 32) __builtin_amdgcn_global_load_lds((const unsigned*)src, (LAS unsigned*)(lds + CWL_OFF + buf * 4096 + w * 512), 16, 0, 0);
    }
};
constexpr int FFN_MT = 130;
constexpr int XCH_OFF = 131072 + 1024;
__device__ __forceinline__ float dpp_ror1(float v)  { return __int_as_float(__builtin_amdgcn_update_dpp(0, __float_as_int(v), 0x121, 0xF, 0xF, false)); }
__device__ __forceinline__ float dpp_ror15(float v) { return __int_as_float(__builtin_amdgcn_update_dpp(0, __float_as_int(v), 0x12F, 0xF, 0xF, false)); }
struct EpiFfn {
    static constexpr bool PERM = true, AFTER_DRAIN = false;
    bf16_t* ACT; LAS unsigned char* lds; mutable int ecnt;
    __device__ __forceinline__ void operator()(const f32x4 (&acc)[2][2][4][2], const pg8::Unit& u, int wr, int wc, int fr, int fq) const {
        LAS float* XC = (LAS float*)(lds + XCH_OFF);
        const LAS float* WL = (const LAS float*)(lds + CWL_OFF + (ecnt & 1) * 4096); ++ecnt;
        const int colw = wc * 32 + 8 * fq;
        if (fr == 0 || fr == 15) {
            const int edge = (fr == 15) ? 1 : 0, m = (fr == 15) ? 3 : 0;
#pragma unroll
            for (int ai = 0; ai < 2; ++ai)
#pragma unroll
                for (int bj = 0; bj < 2; ++bj)
#pragma unroll
                    for (int n = 0; n < 2; ++n) { const f32x4 v = (m == 0) ? acc[ai][bj][0][n] : acc[ai][bj][3][n];
                        *(LAS f32x4*)(XC + ((ai * 2 + wr) * 2 + edge) * 256 + bj * 128 + colw + 4 * n) = v; }
        }
        asm volatile("s_waitcnt lgkmcnt(0)" ::: "memory"); __builtin_amdgcn_s_barrier(); asm volatile("" ::: "memory");
        const int slot0 = wr * 64 + fr, row_base = u.pm * 254 - 1;
#pragma unroll
        for (int bj = 0; bj < 2; ++bj) {
            const int gc = (u.pn * 256 + bj * 128 + colw) >> 1;
            const LAS float* wl = WL + ((bj * 128 + colw) >> 1);
            f32x4 wg[3], wu[3];
#pragma unroll
            for (int j = 0; j < 3; ++j) { wg[j] = *(const LAS f32x4*)(wl + j * 128); wu[j] = *(const LAS f32x4*)(wl + (3 + j) * 128); }
            const f32x4 bg = *(const LAS f32x4*)(wl + 6 * 128), bu = *(const LAS f32x4*)(wl + 7 * 128);
#pragma unroll
            for (int ai = 0; ai < 2; ++ai) {
                const int gidx = ai * 2 + wr;
                f32x4 pe[2], ne[2];
#pragma unroll
                for (int n = 0; n < 2; ++n) {
                    pe[n] = (gidx > 0) ? *(const LAS f32x4*)(XC + (((gidx - 1) * 2) + 1) * 256 + bj * 128 + colw + 4 * n) : (f32x4){0.f, 0.f, 0.f, 0.f};
                    ne[n] = (gidx < 3) ? *(const LAS f32x4*)(XC + (((gidx + 1) * 2) + 0) * 256 + bj * 128 + colw + 4 * n) : (f32x4){0.f, 0.f, 0.f, 0.f}; }
#pragma unroll
                for (int m = 0; m < 4; ++m) {
                    const int slot = ai * 128 + slot0 + m * 16, row = row_base + slot, t = row & (SEQ - 1);
                    f32x4 hv[2];
#pragma unroll
                    for (int n = 0; n < 2; ++n) {
                        const f32x4 cur = acc[ai][bj][m][n], prv = acc[ai][bj][m == 0 ? 0 : m - 1][n], nxt = acc[ai][bj][m == 3 ? 3 : m + 1][n];
                        f32x4 up, dn;
#pragma unroll
                        for (int e = 0; e < 4; ++e) { up[e] = dpp_ror1(fr == 15 ? prv[e] : cur[e]); dn[e] = dpp_ror15(fr == 0 ? nxt[e] : cur[e]); }
                        if (m == 0 && fr == 0) up = pe[n];
                        if (m == 3 && fr == 15) dn = ne[n];
                        if (t == 0) up = (f32x4){0.f, 0.f, 0.f, 0.f};
                        if (t == SEQ - 1) dn = (f32x4){0.f, 0.f, 0.f, 0.f};
                        const f32x4 w0 = n ? wu[0] : wg[0], w1 = n ? wu[1] : wg[1], w2 = n ? wu[2] : wg[2], bb = n ? bu : bg;
                        hv[n] = w0 * up + w1 * cur + w2 * dn + bb; }
                    if (slot >= 1 && slot <= 254 && row < NT) {
                        float o[4];
#pragma unroll
                        for (int e = 0; e < 4; ++e) { const float g = hv[0][e]; o[e] = g * __builtin_amdgcn_rcpf(1.0f + __expf(-g)) * hv[1][e]; }
                        u32x2 w; w.x = pk2(o[0], o[1]); w.y = pk2(o[2], o[3]);
                        *(u32x2*)(ACT + (size_t)row * DFF + gc) = w; }
                }
            }
        }
    }
};

__device__ __forceinline__ int win_row(int n) {
    if (n < 1536) return 1536 + n;
    if (n < 2560) { const int q = n - 1536, blk = q >> 6, d = q & 63; return blk * 64 + 2 * (d & 31) + (d >> 5); }
    if (n < 3072) return 512 + n;
    return n - 2048;
}
template <int MODE> __device__ __forceinline__ void p0_transpose_item(const float* W, int K, int N, bf16_t* WT, LAS float* scr, int item, int lane) {
    const int nblk = N / 32, kb = item / nblk, nb = item % nblk, k0 = 64 * kb, n0 = 32 * nb;
#pragma unroll 8
    for (int i = 0; i < 32; ++i) { const int kk = 2 * i + (lane >> 5); scr[kk * 33 + (lane & 31)] = W[(size_t)(k0 + kk) * N + n0 + (lane & 31)]; }
    LDS_WAIT(); asm volatile("" ::: "memory");
    const int c = lane & 7;
#pragma unroll
    for (int j = 0; j < 4; ++j) { const int n = (lane >> 3) + 8 * j; const LAS float* s = scr + (8 * c) * 33 + n;
        u32x4 o; o.x = pk2(s[0 * 33], s[1 * 33]); o.y = pk2(s[2 * 33], s[3 * 33]); o.z = pk2(s[4 * 33], s[5 * 33]); o.w = pk2(s[6 * 33], s[7 * 33]);
        const int nn = n0 + n; const int dr = (MODE == 1) ? win_row(nn) : (MODE == 2) ? ((nn < DFF) ? ((nn >> 2) * 8 + (nn & 3)) : (((nn - DFF) >> 2) * 8 + 4 + ((nn - DFF) & 3))) : nn;
        *(u32x4*)(WT + (size_t)dr * K + k0 + 8 * c) = o; }
    LDS_WAIT(); asm volatile("" ::: "memory");
}
__device__ __forceinline__ void cvt_rows(const float* src, bf16_t* dst, size_t n8, int gw, int ngw, int lane) {
    const size_t stride = (size_t)ngw * 64;
    for (size_t i = (size_t)gw * 64 + lane; i < n8; i += 4 * stride) {
        f32x4 a[4], c[4];
#pragma unroll
        for (int u = 0; u < 4; ++u) { const size_t k = i + u * stride; if (k < n8) { a[u] = ((const f32x4*)src)[2 * k]; c[u] = ((const f32x4*)src)[2 * k + 1]; } }
#pragma unroll
        for (int u = 0; u < 4; ++u) { const size_t k = i + u * stride; if (k < n8) {
            u32x4 w; w.x = pk2(a[u][0], a[u][1]); w.y = pk2(a[u][2], a[u][3]); w.z = pk2(c[u][0], c[u][1]); w.w = pk2(c[u][2], c[u][3]);
            ((u32x4*)dst)[k] = w; } }
    }
}
__device__ __forceinline__ void p0_filter_item(const float* w1, const float* b1, const float* fq, const float* w2, const float* b2, const float* w3, float* HTD, int item, int lane) {
    const int t0 = 2 * (item >> 2), ih = item & 3; float h2v[2], tl[2];
    const float fql = fq[lane], b1l = b1[lane], b2l = b2[lane];
#pragma unroll
    for (int tt = 0; tt < 2; ++tt) { const int t = t0 + tt; tl[tt] = (float)t * (1.0f / 2047.0f);
        const float w = 6.283185307179586f * (float)t / 2048.0f;
        float zk = 0.f;
        if (lane == 0) zk = tl[tt];
        else if (lane <= 16) { const float fr = 1e-4f + (float)(lane - 1) * ((15.0f - 1e-4f) / 15.0f); zk = cosf(fr * w); }
        else if (lane <= 32) { const float fr = 1e-4f + (float)(lane - 17) * ((15.0f - 1e-4f) / 15.0f); zk = -sinf(fr * w); }
        float a = b1l;
#pragma unroll 11
        for (int k = 0; k < 33; ++k) a += __shfl(zk, k) * w1[k * 64 + lane];
        const float h1 = sinf(fql * a);
        float a2 = b2l;
#pragma unroll 16
        for (int k = 0; k < 64; ++k) a2 += __shfl(h1, k) * w2[k * 64 + lane];
        h2v[tt] = sinf(fql * a2); }
    const float dmin = -15.350567286626973f, dmax = -3.0701134573253946f;
    float acc0[8], acc1[8];
#pragma unroll
    for (int i = 0; i < 8; ++i) { acc0[i] = 0.f; acc1[i] = 0.f; }
#pragma unroll 8
    for (int j = 0; j < 64; ++j) { const float s0 = __shfl(h2v[0], j), s1 = __shfl(h2v[1], j); const float* wr = w3 + (size_t)j * 2048 + ih * 512 + lane;
#pragma unroll
        for (int i = 0; i < 8; ++i) { const float wv = wr[64 * i]; acc0[i] += s0 * wv; acc1[i] += s1 * wv; } }
#pragma unroll
    for (int i = 0; i < 8; ++i) { const int col = ih * 512 + 64 * i + lane, c = col & 511;
        const float delta = fabsf(dmin + (float)c * ((dmax - dmin) / 511.0f));
        float2 o; o.x = acc0[i] * expf(-tl[0] * delta); o.y = acc1[i] * expf(-tl[1] * delta);
        *(float2*)(HTD + (size_t)col * 2048 + t0) = o; }
}
__device__ __forceinline__ void p0_prep(const float* const* in, unsigned char* ws, LAS unsigned char* lds, int tid) {
    const int lane = tid & 63, wave = tid >> 6, gw = blockIdx.x * NWAVE + wave, ngw = gridDim.x * NWAVE;
    LAS float* scr = (LAS float*)(lds + wave * 16384);
    bf16_t* WALL = (bf16_t*)(ws + WS_WALL);
    constexpr int I_IN = 16 * (INW / 32), I_KV = 16 * 32, I_OUT = 24 * 32, I_UP = 16 * (2 * DFF / 32), I_DN = (DFF / 64) * 32, NIT = I_IN + I_KV + I_OUT + I_UP + I_DN;
    for (int it = gw; it < NIT; it += ngw) { int r = it;
        if (r < I_IN) { p0_transpose_item<1>(in[2], DM, INW, WALL, scr, r, lane); continue; } r -= I_IN;
        if (r < I_KV) { p0_transpose_item<0>(in[14], DM, 1024, (bf16_t*)(ws + WS_WKV), scr, r, lane); continue; } r -= I_KV;
        if (r < I_OUT) { p0_transpose_item<0>(in[15], MIXW, DM, (bf16_t*)(ws + WS_WOUT), scr, r, lane); continue; } r -= I_OUT;
        if (r < I_UP) { p0_transpose_item<2>(in[18], DM, 2 * DFF, (bf16_t*)(ws + WS_WUP), scr, r, lane); continue; } r -= I_UP;
        p0_transpose_item<0>(in[21], DFF, DM, (bf16_t*)(ws + WS_WDN), scr, r, lane); }
    for (int it = ngw - 1 - gw; it < 4096; it += ngw) p0_filter_item(in[5], in[6], in[7], in[8], in[9], in[10], (float*)(ws + WS_HTD), it, lane);
    cvt_rows(in[0], (bf16_t*)(ws + WS_XB), (size_t)NT * DM / 8, gw, ngw, lane);
    cvt_rows(in[1], (bf16_t*)(ws + WS_MEMB), (size_t)NMT * DM / 8, gw, ngw, lane);
    float2* rope = (float2*)(ws + WS_ROPE);
    for (int i = blockIdx.x * NTHR + tid; i < SEQ * 32; i += gridDim.x * NTHR) { const int pos = i >> 5, f = i & 31;
        const float invf = powf(10000.0f, -(float)(2 * f) / 64.0f); const float ang = (float)pos * invf;
        float2 cs; cs.x = cosf(ang); cs.y = sinf(ang); rope[i] = cs; }
}

__device__ __forceinline__ void filter_fft_item(const float* HTD, float2* KF, LAS unsigned char* lds, int item, int tid) {
    const int o = item >> 9, c = item & 511;
    const float* rf = HTD + (size_t)((o * 2 + 0) * 512 + c) * 2048; const float* rb = HTD + (size_t)((o * 2 + 1) * 512 + c) * 2048;
    cplx v[8];
#pragma unroll
    for (int k = 0; k < 4; ++k) v[k] = mk2(rf[tid + 512 * k], 0.f);
    v[4] = mk2(tid == 0 ? 0.f : rb[2048 - tid], 0.f); v[5] = mk2(rb[1536 - tid], 0.f); v[6] = mk2(rb[1024 - tid], 0.f); v[7] = mk2(rb[512 - tid], 0.f);
    fft_fwd((LAS cplx*)lds, tid, v);
    float2* dst = KF + (size_t)(o * 512 + c) * 4096 + 8 * tid;
#pragma unroll
    for (int m = 0; m < 8; m += 2) { f32x4 w; w[0] = v[m].x * (1.f / 4096.f); w[1] = v[m].y * (1.f / 4096.f); w[2] = v[m + 1].x * (1.f / 4096.f); w[3] = v[m + 1].y * (1.f / 4096.f); *(f32x4*)(dst + m) = w; }
    __syncthreads();
}

constexpr int HY_SEG = 2064, HY_STG_OFF = 36864;
__device__ __forceinline__ float conv3s(const LAS bf16_t* seg, int n, float w0, float w1, float w2, float b) {
    return w0 * bf2f(seg[7 + n]) + w1 * bf2f(seg[8 + n]) + w2 * bf2f(seg[9 + n]) + b;
}
__device__ __forceinline__ void hyena_item(const bf16_t* HT, const float2* KF, const float* cw, const float* cb, const float* hb, bf16_t* MIX, LAS unsigned char* lds, int bp, int cgp, int tid0) {
    LAS cplx* X = (LAS cplx*)lds; LAS bf16_t* STG = (LAS bf16_t*)(lds + HY_STG_OFF); LAS cplx* TW = (LAS cplx*)(lds + 65536);
    const int ba = 2 * bp;
    twid_fill<512>(TW, tid0); twid_fill<64>(TW, tid0); twid_fill<8>(TW, tid0);
    u32x4 oacc[8];
#pragma unroll
    for (int i = 0; i < 8; ++i) oacc[i] = (u32x4){0u, 0u, 0u, 0u};
    if (tid0 < 12) { const int sg = tid0 >> 1; STG[sg * HY_SEG + ((tid0 & 1) ? 2056 : 7)] = 0; }
    { const int c = cgp * 8;
#pragma unroll
      for (int i = 0; i < 3; ++i) { const int id = tid0 + 512 * i, sg = id >> 8, ch = id & 255;
          const u32x4 q = *(const u32x4*)(HT + (size_t)((sg >> 1) * 512 + c) * NT + (ba + (sg & 1)) * SEQ + ch * 8);
          *(LAS u32x4*)(STG + sg * HY_SEG + 8 + ch * 8) = q; } }
    __syncthreads();
#pragma unroll 1
    for (int cc = 0; cc < 8; ++cc) {
        const int c = cgp * 8 + cc;
        int tl_ = tid0; asm volatile("" : "+v"(tl_)); const int tid = tl_;
        u32x4 nx[3];
        if (cc < 7) {
#pragma unroll
            for (int i = 0; i < 3; ++i) { const int id = tid + 512 * i, sg = id >> 8, ch = id & 255;
                nx[i] = *(const u32x4*)(HT + (size_t)((sg >> 1) * 512 + c + 1) * NT + (ba + (sg & 1)) * SEQ + ch * 8); } }
        f32x4 kf[4];
        { const f32x4* kp = (const f32x4*)(KF + (size_t)c * 4096 + 8 * tid);
#pragma unroll
          for (int m = 0; m < 4; ++m) kf[m] = kp[m]; }
        cplx v[8]; float va[4], vb[4];
        { const float w0 = cw[c], w1 = cw[1536 + c], w2 = cw[3072 + c], b = cb[c];
#pragma unroll
          for (int k = 0; k < 4; ++k) { const int n = tid + 512 * k; va[k] = conv3s(STG, n, w0, w1, w2, b); vb[k] = conv3s(STG + HY_SEG, n, w0, w1, w2, b); v[k] = mk2(va[k], vb[k]); v[4 + k] = mk2(0.f, 0.f); } }
        fft_fwdL(X, TW, tid, v);
#pragma unroll
        for (int m = 0; m < 8; m += 2) { const f32x4 w = kf[m >> 1]; v[m] = cmul(v[m], mk2(w[0], w[1])); v[m + 1] = cmul(v[m + 1], mk2(w[2], w[3])); }
        { const f32x4* kp = (const f32x4*)(KF + (size_t)(512 + c) * 4096 + 8 * tid);
#pragma unroll
          for (int m = 0; m < 4; ++m) kf[m] = kp[m]; }
        fft_invL(X, TW, tid, v);
        { const float w0 = cw[512 + c], w1 = cw[1536 + 512 + c], w2 = cw[3072 + 512 + c], b = cb[512 + c], hb0 = hb[c];
#pragma unroll
          for (int k = 0; k < 4; ++k) { const int n = tid + 512 * k; const float xa = conv3s(STG + 2 * HY_SEG, n, w0, w1, w2, b), xb = conv3s(STG + 3 * HY_SEG, n, w0, w1, w2, b);
              va[k] = xa * (v[k].x + hb0 * va[k]); vb[k] = xb * (v[k].y + hb0 * vb[k]); v[k] = mk2(va[k], vb[k]); v[4 + k] = mk2(0.f, 0.f); } }
        fft_fwdL(X, TW, tid, v);
#pragma unroll
        for (int m = 0; m < 8; m += 2) { const f32x4 w = kf[m >> 1]; v[m] = cmul(v[m], mk2(w[0], w[1])); v[m + 1] = cmul(v[m + 1], mk2(w[2], w[3])); }
        fft_invL(X, TW, tid, v);
        { const float w0 = cw[1024 + c], w1 = cw[1536 + 1024 + c], w2 = cw[3072 + 1024 + c], b = cb[1024 + c], hb1 = hb[512 + c];
#pragma unroll
          for (int k = 0; k < 4; ++k) { const int n = tid + 512 * k; const float xa = conv3s(STG + 4 * HY_SEG, n, w0, w1, w2, b), xb = conv3s(STG + 5 * HY_SEG, n, w0, w1, w2, b);
              const float oa = xa * (v[k].x + hb1 * va[k]), ob = xb * (v[k].y + hb1 * vb[k]);
              const unsigned pw = pk2(oa, ob);
#pragma unroll
              for (int hh = 0; hh < 2; ++hh) { u32x4& o = oacc[2 * k + hh]; const unsigned nw = hh ? (pw & 0xffff0000u) : (pw << 16);
                  o.x = __builtin_amdgcn_alignbit(o.y, o.x, 16); o.y = __builtin_amdgcn_alignbit(o.z, o.y, 16); o.z = __builtin_amdgcn_alignbit(o.w, o.z, 16); o.w = (o.w >> 16) | nw; } } }
        __syncthreads();
        if (cc < 7) {
#pragma unroll
            for (int i = 0; i < 3; ++i) { const int id = tid + 512 * i, sg = id >> 8, ch = id & 255; *(LAS u32x4*)(STG + sg * HY_SEG + 8 + ch * 8) = nx[i]; } }
        __syncthreads();
    }
    int tw_ = tid0; asm volatile("" : "+v"(tw_)); const int tid = tw_;
#pragma unroll
    for (int k = 0; k < 4; ++k)
#pragma unroll
        for (int hh = 0; hh < 2; ++hh) *(u32x4*)(MIX + (size_t)((ba + hh) * SEQ + tid + 512 * k) * MIXW + cgp * 8) = oacc[2 * k + hh];
}

constexpr int ATT_KP = 272, ATT_VP = 144, ATT_KB = 64 * ATT_KP, ATT_VB = 128 * ATT_VP, ATT_VOFF = 2 * ATT_KB;
template <int NC> __device__ __forceinline__ void attn_unit(LAS unsigned char* lds, const bf16_t* Qp, int ldq, const bf16_t* Kp, int ldk, const bf16_t* Vt, int ldv, int nkeys, float sl2,
                                                            bf16_t* Op, int ldo, float lam, const float* subg, int tid) {
    constexpr int NSTEP = (NC == 2) ? 4 : 8;
    const int lane = tid & 63, wave = tid >> 6, r = lane & 31, h = lane >> 5;
    const int qb = (NC == 2) ? (wave & 3) : wave, comp = (NC == 2) ? (wave >> 2) : 0, dbase = comp * 64;
    bf16x8 qf[NSTEP];
#pragma unroll
    for (int st = 0; st < NSTEP; ++st) qf[st] = *(const bf16x8*)(Qp + (size_t)(qb * 32 + r) * ldq + dbase + 16 * st + 8 * h);
    f32x16 o[4];
#pragma unroll
    for (int et = 0; et < 4; ++et)
#pragma unroll
        for (int i = 0; i < 16; ++i) o[et][i] = 0.f;
    float mold = -INFINITY, lsum = 0.f;
    const int kr0 = tid >> 4, kc = tid & 15, vr0 = tid >> 3, vc = tid & 7;
    const bf16_t* kg = Kp + (size_t)kr0 * ldk + kc * 8; const bf16_t* vg = Vt + (size_t)vr0 * ldv + vc * 8;
    const int kl = kr0 * ATT_KP + kc * 16, vl = ATT_VOFF + vr0 * ATT_VP + vc * 16;
    const int nt = nkeys / 64;
    u32x4 pk0, pk1, pv0, pv1;
    pk0 = *(const u32x4*)(kg); pk1 = *(const u32x4*)(kg + (size_t)32 * ldk); pv0 = *(const u32x4*)(vg); pv1 = *(const u32x4*)(vg + (size_t)64 * ldv);
    *(LAS u32x4*)(lds + kl) = pk0; *(LAS u32x4*)(lds + kl + 32 * ATT_KP) = pk1; *(LAS u32x4*)(lds + vl) = pv0; *(LAS u32x4*)(lds + vl + 64 * ATT_VP) = pv1;
    __syncthreads();
    for (int it = 0; it < nt; ++it) {
        const int cur = it & 1; const bool more = (it + 1 < nt);
        if (more) { const bf16_t* kg2 = kg + (size_t)(it + 1) * 64 * ldk; const bf16_t* vg2 = vg + (it + 1) * 64;
            pk0 = *(const u32x4*)(kg2); pk1 = *(const u32x4*)(kg2 + (size_t)32 * ldk); pv0 = *(const u32x4*)(vg2); pv1 = *(const u32x4*)(vg2 + (size_t)64 * ldv); }
        LAS unsigned char* Kb = lds + cur * ATT_KB; LAS unsigned char* Vb = lds + ATT_VOFF + cur * ATT_VB;
        f32x16 s[2];
#pragma unroll
        for (int kb = 0; kb < 2; ++kb) {
#pragma unroll
            for (int i = 0; i < 16; ++i) s[kb][i] = 0.f;
#pragma unroll
            for (int st = 0; st < NSTEP; ++st) { const bf16x8 a = *(const LAS bf16x8*)(Kb + (kb * 32 + r) * ATT_KP + (dbase + 16 * st + 8 * h) * 2);
                s[kb] = __builtin_amdgcn_mfma_f32_32x32x16_bf16(a, qf[st], s[kb], 0, 0, 0); } }
        float mx = s[0][0];
#pragma unroll
        for (int i = 1; i < 16; ++i) mx = fmaxf(mx, s[0][i]);
#pragma unroll
        for (int i = 0; i < 16; ++i) mx = fmaxf(mx, s[1][i]);
        mx = fmaxf(mx, __shfl_xor(mx, 32));
        const float mnew = fmaxf(mold, mx * sl2), alpha = __builtin_amdgcn_exp2f(mold - mnew); mold = mnew;
        float ps = 0.f;
#pragma unroll
        for (int kb = 0; kb < 2; ++kb)
#pragma unroll
            for (int i = 0; i < 16; ++i) { const float p = __builtin_amdgcn_exp2f(__builtin_fmaf(s[kb][i], sl2, -mnew)); s[kb][i] = p; ps += p; }
        lsum = lsum * alpha + ps;
#pragma unroll
        for (int et = 0; et < 4; ++et)
#pragma unroll
            for (int i = 0; i < 16; ++i) o[et][i] *= alpha;
#pragma unroll
        for (int kb = 0; kb < 2; ++kb)
#pragma unroll
            for (int s2 = 0; s2 < 2; ++s2) {
                u32x4 pw; pw.x = pk2(s[kb][8 * s2 + 0], s[kb][8 * s2 + 1]); pw.y = pk2(s[kb][8 * s2 + 2], s[kb][8 * s2 + 3]); pw.z = pk2(s[kb][8 * s2 + 4], s[kb][8 * s2 + 5]); pw.w = pk2(s[kb][8 * s2 + 6], s[kb][8 * s2 + 7]);
                const bf16x8 pf = __builtin_bit_cast(bf16x8, pw);
#pragma unroll
                for (int et = 0; et < 4; ++et) { const LAS unsigned char* vp = Vb + (et * 32 + r) * ATT_VP + (kb * 32 + 16 * s2 + 4 * h) * 2;
                    const u32x2 lo = *(const LAS u32x2*)vp, hi = *(const LAS u32x2*)(vp + 16);
                    u32x4 aw; aw.x = lo.x; aw.y = lo.y; aw.z = hi.x; aw.w = hi.y;
                    o[et] = __builtin_amdgcn_mfma_f32_32x32x16_bf16(__builtin_bit_cast(bf16x8, aw), pf, o[et], 0, 0, 0); } }
        if (more) { const int nb = cur ^ 1;
            *(LAS u32x4*)(lds + nb * ATT_KB + kl) = pk0; *(LAS u32x4*)(lds + nb * ATT_KB + kl + 32 * ATT_KP) = pk1;
            *(LAS u32x4*)(lds + nb * ATT_VB + vl) = pv0; *(LAS u32x4*)(lds + nb * ATT_VB + vl + 64 * ATT_VP) = pv1; }
        __syncthreads();
    }
    lsum += __shfl_xor(lsum, 32);
    const float inv = 1.0f / lsum;
    if (NC == 1) {
        bf16_t* orow = Op + (size_t)(qb * 32 + r) * ldo;
#pragma unroll
        for (int et = 0; et < 4; ++et)
#pragma unroll
            for (int g = 0; g < 4; ++g) { u32x2 w; w.x = pk2(o[et][4 * g] * inv, o[et][4 * g + 1] * inv); w.y = pk2(o[et][4 * g + 2] * inv, o[et][4 * g + 3] * inv);
                *(u32x2*)(orow + et * 32 + 8 * g + 4 * h) = w; }
    } else {
        LAS float* XL = (LAS float*)lds;
        if (comp == 1) {
#pragma unroll
            for (int et = 0; et < 4; ++et)
#pragma unroll
                for (int i = 0; i < 16; ++i) XL[(qb * 64 + et * 16 + i) * 64 + lane] = o[et][i] * inv;
        }
        __syncthreads();
        if (comp == 0) {
            float ss = 0.f;
#pragma unroll
            for (int et = 0; et < 4; ++et)
#pragma unroll
                for (int i = 0; i < 16; ++i) { const float ov = o[et][i] * inv - lam * XL[(qb * 64 + et * 16 + i) * 64 + lane]; o[et][i] = ov; ss += ov * ov; }
            ss += __shfl_xor(ss, 32);
            const float rs = rsqrtf(ss * (1.0f / 128.0f) + RMS_EPS) * 0.8f;
            bf16_t* orow = Op + (size_t)(qb * 32 + r) * ldo;
#pragma unroll
            for (int et = 0; et < 4; ++et)
#pragma unroll
                for (int g = 0; g < 4; ++g) { const int e = et * 32 + 8 * g + 4 * h; const f32x4 gv = *(const f32x4*)(subg + e);
                    u32x2 w; w.x = pk2(o[et][4 * g] * rs * gv[0], o[et][4 * g + 1] * rs * gv[1]); w.y = pk2(o[et][4 * g + 2] * rs * gv[2], o[et][4 * g + 3] * rs * gv[3]);
                    *(u32x2*)(orow + e) = w; }
        }
        __syncthreads();
    }
}

template <bool TO_BF16> __device__ __forceinline__ void ln_rows(float* io, bf16_t* ob, float2* stat, const float* g, const float* b, int tid, float* alt = nullptr) {
    const int lane = tid & 63, gw = blockIdx.x * NWAVE + (tid >> 6), ngw = gridDim.x * NWAVE;
    f32x4 gv[4], bv[4];
#pragma unroll
    for (int j = 0; j < 4; ++j) { gv[j] = ((const f32x4*)g)[lane + 64 * j]; bv[j] = ((const f32x4*)b)[lane + 64 * j]; }
    for (int row0 = gw; row0 < NT; row0 += 2 * ngw) {
        f32x4 v[2][4];
#pragma unroll
        for (int u = 0; u < 2; ++u) { const int row = row0 + u * ngw; if (row < NT) { const f32x4* xr = (const f32x4*)(io + (size_t)row * DM) + lane;
#pragma unroll
            for (int j = 0; j < 4; ++j) v[u][j] = xr[64 * j]; } }
#pragma unroll
        for (int u = 0; u < 2; ++u) { const int row = row0 + u * ngw; if (row >= NT) continue;
            float s = 0.f;
#pragma unroll
            for (int j = 0; j < 4; ++j) s += (v[u][j][0] + v[u][j][1]) + (v[u][j][2] + v[u][j][3]);
#pragma unroll
            for (int o = 1; o < 64; o <<= 1) s += __shfl_xor(s, o);
            const float mean = s * (1.0f / DM); float s2 = 0.f;
#pragma unroll
            for (int j = 0; j < 4; ++j) { v[u][j] = v[u][j] - mean; s2 += (v[u][j][0] * v[u][j][0] + v[u][j][1] * v[u][j][1]) + (v[u][j][2] * v[u][j][2] + v[u][j][3] * v[u][j][3]); }
#pragma unroll
            for (int o = 1; o < 64; o <<= 1) s2 += __shfl_xor(s2, o);
            const float rstd = rsqrtf(s2 * (1.0f / DM) + LN_EPS);
            if (TO_BF16) {
                u32x2* o8 = (u32x2*)(ob + (size_t)row * DM) + lane;
#pragma unroll
                for (int j = 0; j < 4; ++j) { const f32x4 y = v[u][j] * rstd * gv[j] + bv[j]; u32x2 w; w.x = pk2(y[0], y[1]); w.y = pk2(y[2], y[3]); o8[64 * j] = w; }
                if (lane == 0) { float2 st; st.x = mean; st.y = rstd; stat[row] = st; }
            } else {
                f32x4* wr_ = (alt ? (f32x4*)(alt + (size_t)row * DM) : (f32x4*)(io + (size_t)row * DM)) + lane;
#pragma unroll
                for (int j = 0; j < 4; ++j) wr_[64 * j] = v[u][j] * rstd * gv[j] + bv[j];
            }
        }
    }
}

__device__ __forceinline__ void convgate_half(const bf16_t* HH, bf16_t* ACT, const float* cw, const float* cb, int half, int tid) {
    constexpr int NG = DFF / 8; const int total = (NT / 2) * NG;
    for (int idx = blockIdx.x * NTHR + tid; idx < total; idx += gridDim.x * NTHR) {
        const int rl = idx / NG, cg8 = idx - rl * NG, n0 = cg8 * 8, t = rl & (SEQ - 1);
        const bf16_t* hp = HH + (size_t)rl * (2 * DFF);
        float gsum[8], usum[8];
#pragma unroll
        for (int e = 0; e < 8; ++e) { gsum[e] = cb[n0 + e]; usum[e] = cb[DFF + n0 + e]; }
#pragma unroll
        for (int j = 0; j < 3; ++j) { const int tt = t + j - 1; if (tt < 0 || tt >= SEQ) continue;
            const u32x4 gq = *(const u32x4*)(hp + (ptrdiff_t)(j - 1) * (2 * DFF) + n0), uq = *(const u32x4*)(hp + (ptrdiff_t)(j - 1) * (2 * DFF) + DFF + n0);
            const float* wg = cw + (size_t)j * (2 * DFF) + n0; const float* wu = wg + DFF;
            const f32x4 wg0 = *(const f32x4*)wg, wg1 = *(const f32x4*)(wg + 4), wu0 = *(const f32x4*)wu, wu1 = *(const f32x4*)(wu + 4);
            gsum[0] += wg0[0] * lo2f(gq.x); gsum[1] += wg0[1] * hi2f(gq.x); gsum[2] += wg0[2] * lo2f(gq.y); gsum[3] += wg0[3] * hi2f(gq.y);
            gsum[4] += wg1[0] * lo2f(gq.z); gsum[5] += wg1[1] * hi2f(gq.z); gsum[6] += wg1[2] * lo2f(gq.w); gsum[7] += wg1[3] * hi2f(gq.w);
            usum[0] += wu0[0] * lo2f(uq.x); usum[1] += wu0[1] * hi2f(uq.x); usum[2] += wu0[2] * lo2f(uq.y); usum[3] += wu0[3] * hi2f(uq.y);
            usum[4] += wu1[0] * lo2f(uq.z); usum[5] += wu1[1] * hi2f(uq.z); usum[6] += wu1[2] * lo2f(uq.w); usum[7] += wu1[3] * hi2f(uq.w); }
        float a[8];
#pragma unroll
        for (int e = 0; e < 8; ++e) a[e] = gsum[e] / (1.0f + __expf(-gsum[e])) * usum[e];
        u32x4 w; w.x = pk2(a[0], a[1]); w.y = pk2(a[2], a[3]); w.z = pk2(a[4], a[5]); w.w = pk2(a[6], a[7]);
        *(u32x4*)(ACT + (size_t)(half * (NT / 2) + rl) * DFF + n0) = w;
    }
}

#define XB_TMO      128
#define XB_XCNT(j)  (256  + 64 * (j))
#define XB_XSUB(j)  (1280 + 64 * (j))
#define XB_XGEN(j)  (2304 + 64 * (j))
#define XB_TOP      3328
#define XB_TOPGEN   3392
#define XCD_BAR_WORDS 3456
#define XB_SPIN_CAP (1u << 18)

__device__ __forceinline__ unsigned xb_ld(unsigned* p)              { return __hip_atomic_load(p, __ATOMIC_RELAXED, __HIP_MEMORY_SCOPE_AGENT); }
__device__ __forceinline__ unsigned xb_add(unsigned* p, unsigned v) { return __hip_atomic_fetch_add(p, v, __ATOMIC_RELAXED, __HIP_MEMORY_SCOPE_AGENT); }
__device__ __forceinline__ unsigned xb_xcc_id() { return (unsigned)__builtin_amdgcn_s_getreg((3 << 11) | 20) & 0xFu; }
#define XB_SPIN(cond, bar) do { unsigned _sp = 0; while (cond) { __builtin_amdgcn_s_sleep(1); \
    if ((++_sp & 255u) == 0u) { if (xb_ld(&(bar)[XB_TMO])) break; if (_sp > XB_SPIN_CAP) { atomicAdd(&(bar)[XB_TMO], 1u); break; } } } } while (0)

struct XcdBarrier {
    unsigned* bar; unsigned x;
    volatile LAS unsigned* st;
};

__device__ __forceinline__ XcdBarrier xcd_barrier_post(unsigned* bar, volatile LAS unsigned* st) {
    XcdBarrier b; b.bar = bar; b.x = xb_xcc_id(); b.st = st;
    if (threadIdx.x == 0) (void)xb_add(&bar[XB_XCNT(b.x)], 1u);
    return b;
}
__device__ __forceinline__ void xcd_barrier_complete(unsigned* bar, unsigned x, unsigned& nloc, unsigned& nx) {
    const unsigned G = gridDim.x * gridDim.y * gridDim.z;
    unsigned sum, cnt, mine, sp = 0u;
    for (;;) {
        sum = 0u; cnt = 0u; mine = 0u;
#pragma unroll
        for (unsigned j = 0; j < 16; ++j) { const unsigned c = xb_ld(&bar[XB_XCNT(j)]); sum += c; cnt += (c > 0u) ? 1u : 0u; mine = (j == x) ? c : mine; }
        if (sum == G) break;
        __builtin_amdgcn_s_sleep(1);
        if ((++sp & 255u) == 0u) { if (xb_ld(&bar[XB_TMO])) break; if (sp > XB_SPIN_CAP) { atomicAdd(&bar[XB_TMO], 1u); break; } }
    }
    nloc = mine > 0u ? mine : 1u; nx = cnt > 0u ? cnt : 1u;
}

__device__ __forceinline__ void xcd_barrier(const XcdBarrier& b) {
    asm volatile("s_waitcnt vmcnt(0)" ::: "memory");
    __syncthreads();
    if (threadIdx.x == 0) {
        unsigned* bar = b.bar;
        __builtin_amdgcn_s_waitcnt(0);
        unsigned nloc = b.st[0], nx = b.st[1];
        if (nloc == 0u) { xcd_barrier_complete(bar, b.x, nloc, nx); b.st[0] = nloc; b.st[1] = nx; }
        const unsigned old = xb_add(&bar[XB_XSUB(b.x)], 1u);
        const unsigned gen = old / nloc;
        if (old + 1u == (gen + 1u) * nloc) {
            __builtin_amdgcn_fence(__ATOMIC_RELEASE, "agent");
            asm volatile("s_waitcnt vmcnt(0)" ::: "memory");
            const unsigned og = xb_add(&bar[XB_TOP], 1u);
            const unsigned tg = og / nx;
            if (og + 1u == (tg + 1u) * nx) xb_add(&bar[XB_TOPGEN], 1u);
            else XB_SPIN(xb_ld(&bar[XB_TOPGEN]) == tg, bar);
            __builtin_amdgcn_fence(__ATOMIC_ACQUIRE, "agent");
            xb_add(&bar[XB_XGEN(b.x)], 1u);
            asm volatile("s_waitcnt vmcnt(0)" ::: "memory");
        } else {
            XB_SPIN(xb_ld(&bar[XB_XGEN(b.x)]) == gen, bar);
            __builtin_amdgcn_fence(__ATOMIC_ACQUIRE, "agent");
            asm volatile("s_waitcnt vmcnt(0)" ::: "memory");
        }
    }
    __syncthreads();
}

#ifndef PH_MASK
#define PH_MASK 0xFFFFFF
#endif
#define PH(k) ((PH_MASK >> (k)) & 1)
#ifndef G5ORDER
#define G5ORDER pg8::StaticOrder
#endif
#ifndef REP_P0
#define REP_P0 1
#endif
#ifndef REP_G1
#define REP_G1 1
#endif
#ifndef REP_DIFF
#define REP_DIFF 1
#endif
#ifndef REP_HY
#define REP_HY 1
#endif
#ifndef REP_MEM
#define REP_MEM 1
#endif
#ifndef REP_G3
#define REP_G3 1
#endif
#ifndef REP_G4
#define REP_G4 1
#endif
#ifndef REP_LN1
#define REP_LN1 1
#endif
struct Args { const float* in[24]; float* out; unsigned char* ws; };
__global__ void __launch_bounds__(NTHR, 2) hybrid_fwd(Args a) {
    extern __shared__ __attribute__((aligned(16))) unsigned char smem[];
    LAS unsigned char* lds = (LAS unsigned char*)smem;
    cg::grid_group grid = cg::this_grid();
    volatile LAS unsigned* bst = (volatile LAS unsigned*)(lds + 131072 + 64);
    if (threadIdx.x < 2) bst[threadIdx.x] = 0u;
    __syncthreads();
    const XcdBarrier bar = xcd_barrier_post((unsigned*)(a.ws + WS_BAR), bst);
    const int G = gridDim.x;
#define NEWPHASE() int tid_ = threadIdx.x, cu_ = blockIdx.x; asm volatile("" : "+v"(tid_)); asm volatile("" : "+s"(cu_)); const int tid = tid_, cu = cu_; (void)tid; (void)cu;
    unsigned char* ws = a.ws;
    bf16_t* WALL = (bf16_t*)(ws + WS_WALL); bf16_t* XB = (bf16_t*)(ws + WS_XB); bf16_t* MEMB = (bf16_t*)(ws + WS_MEMB); bf16_t* WKV = (bf16_t*)(ws + WS_WKV);
    bf16_t* QKM = (bf16_t*)(ws + WS_QKM); bf16_t* HT = (bf16_t*)(ws + WS_HT); bf16_t* KMEM = (bf16_t*)(ws + WS_KMEM); bf16_t* VMT = (bf16_t*)(ws + WS_VMT);
    float2* KF = (float2*)(ws + WS_KF); bf16_t* MIX = (bf16_t*)(ws + WS_MIX); float2* STAT = (float2*)(ws + WS_STAT);
    bf16_t* X1B = (bf16_t*)(ws + WS_X1B); bf16_t* HH = (bf16_t*)(ws + WS_HH); bf16_t* ACT = (bf16_t*)(ws + WS_ACT);

    for (int rep = 0; rep < REP_P0; ++rep) { NEWPHASE(); if (PH(0)) p0_prep(a.in, ws, lds, tid); }
    if (a.ws == nullptr) grid.sync();
    xcd_barrier(bar);

    for (int rep = 0; rep < REP_G1; ++rep) {
    if (PH(1)) { NEWPHASE(); pg8::Gemm g{XB, WALL, NT, 1536, DM}; pg8::StaticOrder S; S.init(g.M, g.N, G, cu);
      EpiRope E{QKM, (const float2*)(ws + WS_ROPE)};
      pg8::gemm_phase<EpiRope, pg8::StaticOrder, true, true>(lds, g, S, E); }
    if (PH(2)) { NEWPHASE(); pg8::Gemm g{WALL + (size_t)1536 * DM, XB, 2048, NT, DM}; pg8::StaticOrder S; S.init(g.M, g.N, G, cu);
      EpiB E{HT, NT};
      pg8::gemm_phase<EpiB, pg8::StaticOrder, true, true>(lds, g, S, E); }
    }
    if (PH(3)) { NEWPHASE(); const bool isK = cu < 32, on = cu < 64; const int c2 = cu - 32;
      pg8::Gemm g; EpiB E; OneUnit S;
      if (isK) { g = pg8::Gemm{MEMB, WKV, NMT, 512, DM}; E = EpiB{KMEM, 512}; S = OneUnit{cu >> 1, cu & 1, on}; }
      else { g = pg8::Gemm{WKV + (size_t)512 * DM, MEMB, 512, NMT, DM}; E = EpiB{VMT, NMT}; S = OneUnit{(c2 >> 4) & 1, c2 & 15, on}; }
      pg8::gemm_phase<EpiB, OneUnit, false, true>(lds, g, S, E);
      __syncthreads();
      if (!on) for (int it = cu - 64; it < 1024; it += G - 64) filter_fft_item((const float*)(ws + WS_HTD), KF, lds, it, tid); }
    xcd_barrier(bar);

    { NEWPHASE(); const int xcd = cu & 7, j = cu >> 3;
      float lam;
      { const float* lp = a.in[12]; const int l6 = tid & 63; float s01 = lp[l6] * lp[64 + l6], s23 = lp[128 + l6] * lp[192 + l6];
#pragma unroll
        for (int o = 1; o < 64; o <<= 1) { s01 += __shfl_xor(s01, o); s23 += __shfl_xor(s23, o); }
        lam = expf(s01) - expf(s23) + 0.2f; }
      if (PH(4)) for (int i = 0; i < 4 * REP_DIFF; ++i) {
          const int bh = ((i & 3) * 8 + xcd) * 2 + (j >> 4), qblk = j & 15, b = bh >> 2, hd = bh & 3;
          const size_t tok0 = (size_t)b * SEQ;
          attn_unit<2>(lds, QKM + (tok0 + qblk * 128) * MIXW + hd * 128, MIXW, QKM + tok0 * MIXW + 512 + hd * 128, MIXW,
                       HT + (size_t)(1536 + hd * 128) * NT + tok0, NT, SEQ, 0.125f * 1.4426950408889634f,
                       MIX + (tok0 + qblk * 128) * MIXW + 512 + hd * 128, MIXW, lam, a.in[13], tid); }
      if (PH(5)) for (int i = 0; i < 2 * REP_MEM; ++i) {
          const int bh = ((i & 1) * 8 + xcd) * 4 + (j >> 3), qblk = j & 7, b = bh >> 2, hd = bh & 3;
          const size_t tok0 = (size_t)b * SEQ;
          attn_unit<1>(lds, QKM + (tok0 + qblk * 256) * MIXW + 1024 + hd * 128, MIXW, KMEM + (size_t)b * MEMT * 512 + hd * 128, 512,
                       VMT + (size_t)(hd * 128) * NMT + b * MEMT, NMT, MEMT, 0.08838834764831845f * 1.4426950408889634f,
                       MIX + (tok0 + qblk * 256) * MIXW + 1024 + hd * 128, MIXW, 0.f, nullptr, tid); }
      if (PH(6)) for (int i = 0; i < 2 * REP_HY; ++i) {
          const int cgp = ((i & 1) * 8 + xcd) * 4 + (j >> 3), bp = j & 7;
          hyena_item(HT, KF, a.in[3], a.in[4], a.in[11], MIX, lds, bp, cgp, tid); } }
    xcd_barrier(bar);

#ifdef REP_SYNC
    for (int rep = 0; rep < REP_SYNC; ++rep) xcd_barrier(bar);
#endif
    for (int rep = 0; rep < REP_G3; ++rep) if (PH(7)) { NEWPHASE(); pg8::Gemm g{MIX, (const bf16_t*)(ws + WS_WOUT), NT, DM, MIXW}; pg8::StaticOrder S; S.init(g.M, g.N, G, cu);
      EpiRes E{a.in[0], a.out};
      pg8::gemm_phase<EpiRes, pg8::StaticOrder, true, true>(lds, g, S, E); }
    xcd_barrier(bar);
    for (int rep = 0; rep < REP_LN1; ++rep) if (PH(8)) { NEWPHASE(); ln_rows<true>(a.out, X1B, STAT, a.in[16], a.in[17], tid); }
    xcd_barrier(bar);
    for (int rep = 0; rep < REP_G4; ++rep) if (PH(9)) { NEWPHASE(); pg8::Gemm g{X1B, (const bf16_t*)(ws + WS_WUP), FFN_MT * 256, 2 * DFF, DM}; FfnOrder S; S.init(g.M, g.N, G, cu); S.cw = a.in[19]; S.cb = a.in[20]; S.lds = lds; S.cnt = 0;
      EpiFfn E{ACT, lds, 0};
      pg8::gemm_phase<EpiFfn, FfnOrder, true, true>(lds, g, S, E); }
    xcd_barrier(bar);
    if (PH(11)) { NEWPHASE(); pg8::Gemm g{ACT, (const bf16_t*)(ws + WS_WDN), NT, DM, DFF}; G5ORDER S; S.init(g.M, g.N, G, cu);
      EpiRes2 E{a.out, a.out, STAT, a.in[16], a.in[17]};
#ifdef REP_G5
      { EpiRes2 E2{a.out, (float*)(ws + WS_HH), STAT, a.in[16], a.in[17]}; pg8::gemm_phase<EpiRes2, G5ORDER, true, true>(lds, g, S, E2); xcd_barrier(bar); }
#endif
      pg8::gemm_phase<EpiRes2, G5ORDER, true, true>(lds, g, S, E); }
    xcd_barrier(bar);
#ifdef REP_LN2
    { NEWPHASE(); ln_rows<false>(a.out, nullptr, nullptr, a.in[22], a.in[23], tid, (float*)(ws + WS_HH)); xcd_barrier(bar); }
#endif
    if (PH(12)) { NEWPHASE(); ln_rows<false>(a.out, nullptr, nullptr, a.in[22], a.in[23], tid); }
}

extern "C" void kernel_launch(void* const* d_in, const int* in_sizes, int n_in, void* d_out, int out_size, void* d_ws, size_t ws_size, hipStream_t stream) {
    static int grid = 0;
    if (grid == 0) {
        if (n_in != 24 || out_size != NT * DM || ws_size < WS_END) { fprintf(stderr, "kernel_launch: unexpected shapes (n_in %d, out %d, ws %zu)\n", n_in, out_size, ws_size); grid = -1; return; }
        int dev = 0, cus = 0, per_cu = 0;
        hipGetDevice(&dev); hipDeviceGetAttribute(&cus, hipDeviceAttributeMultiprocessorCount, dev);
        if (hipFuncSetAttribute((const void*)hybrid_fwd, hipFuncAttributeMaxDynamicSharedMemorySize, LDS_BYTES) != hipSuccess) { fprintf(stderr, "kernel_launch: hipFuncSetAttribute failed\n"); grid = -1; return; }
        if (hipOccupancyMaxActiveBlocksPerMultiprocessor(&per_cu, (const void*)hybrid_fwd, NTHR, LDS_BYTES) != hipSuccess || per_cu < 1) { fprintf(stderr, "kernel_launch: occupancy query says %d\n", per_cu); per_cu = 1; }
        (void)hipGetLastError();
        grid = cus * per_cu;
        fprintf(stderr, "kernel_launch: grid %d (cus %d x %d)\n", grid, cus, per_cu);
    }
    if (grid < 0) return;
    if (hipMemsetAsync((char*)d_ws + WS_BAR, 0, XCD_BAR_WORDS * 4, stream) != hipSuccess) { fprintf(stderr, "kernel_launch: memset failed\n"); return; }
    Args a{};
    for (int i = 0; i < 24; ++i) a.in[i] = (const float*)d_in[i];
    a.out = (float*)d_out; a.ws = (unsigned char*)d_ws;
    void* args[] = {&a};
    const hipError_t e = hipLaunchCooperativeKernel((const void*)hybrid_fwd, dim3(grid), dim3(NTHR), args, LDS_BYTES, stream);
    if (e != hipSuccess) fprintf(stderr, "kernel_launch: cooperative launch failed: %s (grid %d)\n", hipGetErrorString(e), grid);
}
```

```cpp
#include <hip/hip_runtime.h>
#include <hip/hip_cooperative_groups.h>
#include <cstdio>
#include <cstdint>
namespace cg = cooperative_groups;
#define LAS __attribute__((address_space(3)))
namespace pg8 {
#define PG8_LAS __attribute__((address_space(3)))
typedef unsigned short bf16_t;
typedef short bf16x8 __attribute__((ext_vector_type(8)));
typedef float f32x4 __attribute__((ext_vector_type(4)));
typedef unsigned u32x4 __attribute__((ext_vector_type(4)));
constexpr int BM = 256, BK = 64, HALF = 128, HTB = HALF * BK * 2  , STAGE_BYTES = 8 * HTB, NXCD = 8, WGM = 8;

__host__ __device__ __forceinline__ int lds_byte(int r, int c) { const int st = (r >> 4) * 2 + (c >> 5), rr = r & 15, cc = c & 31, ob = rr * 64 + cc * 2; return st * 1024 + (ob ^ (((ob >> 9) & 1) << 5)); }
__host__ __device__ __forceinline__ void stage_rc(int b, int& R, int& C) { const int st = b / 1024, sb = b % 1024, swz = sb ^ (((sb >> 9) & 1) << 5); R = (st >> 1) * 16 + swz / 64; C = (st & 1) * 32 + (swz % 64) / 2; }
__host__ __device__ __forceinline__ int perm32(int rho) { const int n = rho >> 4, i = rho & 15; return 8 * (i >> 2) + 4 * n + (i & 3); }

struct Unit { int pm, pn; };
struct Gemm { const bf16_t* A; const bf16_t* Bt; int M, N, K; };

struct StaticOrder {
    int nM, nN, nwg, G, c;
    __host__ __device__ void init(int M, int N, int G_, int c_) { nM = M / BM; nN = N / BM; nwg = nM * nN; G = G_; c = c_; }
    __host__ __device__ bool next(int i, Unit& u) const {
        const long L = (long)i * G + c; if (L >= nwg) return false;
        int wgid = (int)L; { const int q = nwg / NXCD, r = nwg % NXCD, xcd = wgid % NXCD, off = wgid / NXCD; wgid = (xcd < r ? xcd * (q + 1) : r * (q + 1) + (xcd - r) * q) + off; }
        const int nig = WGM * nN, gid = wgid / nig, fm = gid * WGM, gsz = (nM - fm) < WGM ? (nM - fm) : WGM;
        u.pm = fm + ((wgid % nig) % gsz); u.pn = (wgid % nig) / gsz; return true;
    }
    __device__ __forceinline__ void a_ready(const Unit&) const {}
    __device__ __forceinline__ void done(const Unit&) const {}
    __device__ __forceinline__ long a_off(const Unit& u, size_t tstep) const { return (long)((size_t)u.pm * tstep); }
    __device__ __forceinline__ int lda(int K) const { return K; }
    __device__ __forceinline__ size_t kstep_a() const { return (size_t)(BK * 2); }
};
template <class Epi, class Sched, bool ALIGN_EPI = false, bool SP2 = false>
__device__ __forceinline__ void gemm_phase(PG8_LAS unsigned char* lds, const Gemm g, const Sched& S, const Epi& E) {
    int tid_l = threadIdx.x; asm volatile("" : "+v"(tid_l)); const int tid = tid_l, wid = __builtin_amdgcn_readfirstlane(tid >> 6), lane = tid & 63, wr = wid >> 2, wc = wid & 3, fr = lane & 15, fq = lane >> 4;
    const int K = g.K, nt = K / BK;
    unsigned voffA[2], voffB[2];
    const int lda = S.lda(K);
#pragma unroll
    for (int i = 0; i < 2; ++i) { int R, C; stage_rc(tid * 16 + i * 8192, R, C); const int Rb = Epi::PERM ? ((R & ~31) + perm32(R & 31)) : R;
        voffA[i] = (unsigned)(R * lda + C) * 2u; voffB[i] = (unsigned)(Rb * K + C) * 2u; }
    const size_t kstep = (size_t)(BK * 2);
    const size_t hstep = (size_t)HALF * K * 2;
    const size_t tstep = 2 * hstep;
    const size_t kstepA = S.kstep_a(), hstepA = (size_t)HALF * lda * 2, tstepA = 2 * hstepA;
    const unsigned ldsw = (unsigned)wid * 1024u;
    const int aoff = lds_byte(wr * 64 + fr, fq * 8), boff = lds_byte(wc * 32 + fr, fq * 8);
#define PG8_SA(b, h) (((b) * 2 + (h)) * HTB)
#define PG8_SB(b, h) ((4 + (b) * 2 + (h)) * HTB)
#define PG8_STAGE(bufoff, gbase, voff) do { _Pragma("unroll") for (int _i = 0; _i < 2; ++_i) \
        __builtin_amdgcn_global_load_lds((const unsigned*)((const char*)(gbase) + (voff)[_i]), (PG8_LAS unsigned*)(lds + (bufoff) + ldsw + _i * 8192), 16, 0, 0); } while (0)
#define PG8_LDA(dst, b, h) do { _Pragma("unroll") for (int m = 0; m < 4; ++m) _Pragma("unroll") for (int k = 0; k < 2; ++k) dst[m][k] = *(const PG8_LAS bf16x8*)(lds + PG8_SA(b, h) + aoff + m * 2048 + k * 1024); } while (0)
#define PG8_LDB(dst, b, h) do { _Pragma("unroll") for (int n = 0; n < 2; ++n) _Pragma("unroll") for (int k = 0; k < 2; ++k) dst[n][k] = *(const PG8_LAS bf16x8*)(lds + PG8_SB(b, h) + boff + n * 2048 + k * 1024); } while (0)
#define PG8_MMA(ai, bj, At, Bt) do { __builtin_amdgcn_s_setprio(1); _Pragma("unroll") for (int m = 0; m < 4; ++m) _Pragma("unroll") for (int n = 0; n < 2; ++n) _Pragma("unroll") for (int k = 0; k < 2; ++k) \
        acc[ai][bj][m][n] = __builtin_amdgcn_mfma_f32_16x16x32_bf16(Bt[n][k], At[m][k], acc[ai][bj][m][n], 0, 0, 0); __builtin_amdgcn_s_setprio(0); } while (0)
#define PG8_WAIT_V(n) asm volatile("s_waitcnt vmcnt(" #n ")" ::: "memory")
#define PG8_WAIT_L(n) asm volatile("s_waitcnt lgkmcnt(" #n ")" ::: "memory")
#define PG8_BAR __builtin_amdgcn_s_barrier()
#define PG8_SCHED __builtin_amdgcn_sched_barrier(0)
    Unit cur, nxt; int ui = 0;
    if (!S.next(0, cur)) return;
    f32x4 acc[2][2][4][2];
#pragma unroll
    for (int a = 0; a < 2; ++a)
#pragma unroll
        for (int b = 0; b < 2; ++b)
#pragma unroll
            for (int m = 0; m < 4; ++m)
#pragma unroll
                for (int n = 0; n < 2; ++n) acc[a][b][m][n] = (f32x4){0.f, 0.f, 0.f, 0.f};
    bf16x8 At[4][2], B0[2][2], B1[2][2];
    const char* cA = (const char*)g.A + S.a_off(cur, tstepA); const char* cB = (const char*)g.Bt + (size_t)cur.pn * tstep;
    S.a_ready(cur);
    if constexpr (SP2) {
        PG8_STAGE(PG8_SB(0, 0), cB, voffB); PG8_STAGE(PG8_SB(0, 1), cB + hstep, voffB); PG8_STAGE(PG8_SA(0, 0), cA, voffA); PG8_STAGE(PG8_SA(0, 1), cA + hstepA, voffA);
        if (wr == 1) PG8_BAR;
        PG8_WAIT_V(2); PG8_BAR;
        PG8_STAGE(PG8_SB(1, 0), cB + kstep, voffB); PG8_STAGE(PG8_SA(1, 0), cA + kstepA, voffA); PG8_STAGE(PG8_SB(1, 1), cB + hstep + kstep, voffB);
        PG8_WAIT_V(6); PG8_BAR;
    } else {
        PG8_STAGE(PG8_SB(0, 0), cB, voffB); PG8_STAGE(PG8_SA(0, 0), cA, voffA); PG8_STAGE(PG8_SB(0, 1), cB + hstep, voffB); PG8_STAGE(PG8_SA(0, 1), cA + hstepA, voffA);
        if (wr == 1) PG8_BAR;
        PG8_WAIT_V(4); PG8_BAR;
        PG8_STAGE(PG8_SB(1, 0), cB + kstep, voffB); PG8_STAGE(PG8_SA(1, 0), cA + kstepA, voffA); PG8_STAGE(PG8_SB(1, 1), cB + hstep + kstep, voffB);
        PG8_WAIT_V(6); PG8_BAR;
    }
    for (;;) {
        const bool has_next = S.next(ui + 1, nxt);
        const char* nA = has_next ? (const char*)g.A + S.a_off(nxt, tstepA) : cA; const char* nB = has_next ? (const char*)g.Bt + (size_t)nxt.pn * tstep : cB;
        for (int t = 0; t < nt; t += 2) {
            const bool last = (t == nt - 2);
            const char* a1 = cA + (size_t)(t + 1) * kstepA;
            const char* a2 = last ? nA : cA + (size_t)(t + 2) * kstepA; const char* b2 = last ? nB : cB + (size_t)(t + 2) * kstep;
            const char* a3 = a2 + kstepA; const char* b3 = b2 + kstep;
            if (last && has_next) S.a_ready(nxt);
            if constexpr (SP2) {
            PG8_LDB(B0, 0, 0); PG8_LDB(B1, 0, 1); PG8_SCHED; PG8_LDA(At, 0, 0); PG8_STAGE(PG8_SA(1, 1), a1 + hstepA, voffA);
            PG8_WAIT_V(8); PG8_WAIT_L(0); PG8_BAR; PG8_MMA(0, 0, At, B0); PG8_MMA(0, 1, At, B1); PG8_BAR; PG8_SCHED;
            PG8_LDA(At, 0, 1); PG8_STAGE(PG8_SB(0, 0), b2, voffB); PG8_STAGE(PG8_SB(0, 1), b2 + hstep, voffB); PG8_STAGE(PG8_SA(0, 0), a2, voffA);
            PG8_WAIT_V(8); PG8_WAIT_L(0); PG8_BAR; PG8_MMA(1, 0, At, B0); PG8_MMA(1, 1, At, B1); PG8_BAR; PG8_SCHED;
            PG8_LDB(B0, 1, 0); PG8_LDB(B1, 1, 1); PG8_SCHED; PG8_LDA(At, 1, 0); PG8_STAGE(PG8_SA(0, 1), a2 + hstepA, voffA);
            PG8_WAIT_V(8); PG8_WAIT_L(0); PG8_BAR; PG8_MMA(0, 0, At, B0); PG8_MMA(0, 1, At, B1); PG8_BAR; PG8_SCHED;
            PG8_LDA(At, 1, 1); PG8_STAGE(PG8_SB(1, 0), b3, voffB); PG8_STAGE(PG8_SB(1, 1), b3 + hstep, voffB); PG8_STAGE(PG8_SA(1, 0), a3, voffA);
            PG8_WAIT_V(8); PG8_WAIT_L(0); PG8_BAR; PG8_MMA(1, 0, At, B0); PG8_MMA(1, 1, At, B1); PG8_BAR; PG8_SCHED;
            } else {
            PG8_LDB(B0, 0, 0); PG8_SCHED; PG8_LDA(At, 0, 0); PG8_STAGE(PG8_SA(1, 1), a1 + hstepA, voffA);
            PG8_WAIT_L(8); PG8_BAR; PG8_WAIT_L(0); PG8_MMA(0, 0, At, B0); PG8_BAR; PG8_SCHED;
            PG8_LDB(B1, 0, 1); PG8_STAGE(PG8_SB(0, 0), b2, voffB);
            PG8_BAR; PG8_WAIT_L(0); PG8_MMA(0, 1, At, B1); PG8_BAR;
            PG8_LDA(At, 0, 1); PG8_STAGE(PG8_SA(0, 0), a2, voffA);
            PG8_BAR; PG8_WAIT_L(0); PG8_MMA(1, 0, At, B0); PG8_BAR; PG8_SCHED;
            PG8_STAGE(PG8_SB(0, 1), b2 + hstep, voffB);
            PG8_WAIT_V(6); PG8_BAR; PG8_MMA(1, 1, At, B1); PG8_BAR;
            PG8_LDB(B0, 1, 0); PG8_SCHED; PG8_LDA(At, 1, 0); PG8_STAGE(PG8_SA(0, 1), a2 + hstepA, voffA);
            PG8_WAIT_L(8); PG8_BAR; PG8_WAIT_L(0); PG8_MMA(0, 0, At, B0); PG8_BAR; PG8_SCHED;
            PG8_LDB(B1, 1, 1); PG8_STAGE(PG8_SB(1, 0), b3, voffB);
            PG8_BAR; PG8_WAIT_L(0); PG8_MMA(0, 1, At, B1); PG8_BAR;
            PG8_LDA(At, 1, 1); PG8_STAGE(PG8_SA(1, 0), a3, voffA);
            PG8_BAR; PG8_WAIT_L(0); PG8_MMA(1, 0, At, B0); PG8_BAR; PG8_SCHED;
            PG8_STAGE(PG8_SB(1, 1), b3 + hstep, voffB);
            PG8_WAIT_V(6); PG8_BAR; PG8_MMA(1, 1, At, B1); PG8_BAR;
            }
        }
        if constexpr (ALIGN_EPI) { if (wr == 0) PG8_BAR; }
        if constexpr (!Epi::AFTER_DRAIN) { E(acc, cur, wr, wc, fr, fq); S.done(cur); }
        if (!has_next) break;
#pragma unroll
        for (int a = 0; a < 2; ++a)
#pragma unroll
            for (int b = 0; b < 2; ++b)
#pragma unroll
                for (int m = 0; m < 4; ++m)
#pragma unroll
                    for (int n = 0; n < 2; ++n) acc[a][b][m][n] = (f32x4){0.f, 0.f, 0.f, 0.f};
        cur = nxt; cA = nA; cB = nB; ++ui;
        if constexpr (ALIGN_EPI) { if (wr == 1) PG8_BAR; }
    }
    PG8_WAIT_V(0);
    if constexpr (!ALIGN_EPI) { if (wr == 0) PG8_BAR; }
    PG8_BAR;
    if constexpr (Epi::AFTER_DRAIN) { E.fused(acc, cur, wr, wc, fr, fq, lds, wid, lane); S.done(cur); }
#undef PG8_SA
#undef PG8_SB
#undef PG8_STAGE
#undef PG8_LDA
#undef PG8_LDB
#undef PG8_MMA
#undef PG8_WAIT_V
#undef PG8_WAIT_L
#undef PG8_BAR
#undef PG8_SCHED
}
}

using pg8::bf16_t; using pg8::bf16x8; using pg8::f32x4; using pg8::u32x4;
typedef float f32x16 __attribute__((ext_vector_type(16)));
typedef unsigned u32x2 __attribute__((ext_vector_type(2)));
typedef short bf16x4 __attribute__((ext_vector_type(4)));

constexpr int NB = 16, SEQ = 2048, DM = 1024, NT = NB * SEQ, MEMT = 256, NMT = NB * MEMT, HW = 512, INW = 3584, DFF = 2816, MIXW = 1536;
constexpr float ALPHA = 1.189207115002721f;
constexpr float LN_EPS = 1e-5f, RMS_EPS = 1e-5f;
constexpr int NTHR = 512, NWAVE = 8;
constexpr int LDS_BYTES = 151552;

constexpr size_t MiB = 1048576;
constexpr size_t WS_WALL = 0;
constexpr size_t WS_WKV  = 7 * MiB;
constexpr size_t WS_WOUT = 9 * MiB;
constexpr size_t WS_WUP  = 12 * MiB;
constexpr size_t WS_WDN  = 23 * MiB;
constexpr size_t WS_ROPE = 29 * MiB;
constexpr size_t WS_STAT = 29 * MiB + 524288;
constexpr size_t WS_XB   = 30 * MiB;
constexpr size_t WS_X1B  = 30 * MiB;
constexpr size_t WS_HTD  = 94 * MiB;
constexpr size_t WS_MEMB = 110 * MiB;
constexpr size_t WS_QKM  = 118 * MiB;
constexpr size_t WS_HT   = 214 * MiB;
constexpr size_t WS_KMEM = 342 * MiB;
constexpr size_t WS_VMT  = 346 * MiB;
constexpr size_t WS_KF   = 350 * MiB;
constexpr size_t WS_MIX  = 382 * MiB;
constexpr size_t WS_HH   = 96 * MiB;
constexpr size_t WS_ACT  = 272 * MiB;
constexpr size_t WS_BAR  = 478 * MiB;
constexpr size_t WS_END  = 478 * MiB + 65536;

__device__ __forceinline__ unsigned pk2(float lo, float hi) { unsigned r; asm volatile("v_cvt_pk_bf16_f32 %0, %1, %2" : "=v"(r) : "v"(lo), "v"(hi)); return r; }
__device__ __forceinline__ float bf2f(bf16_t v) { return __uint_as_float((unsigned)v << 16); }
__device__ __forceinline__ float lo2f(unsigned v) { return __uint_as_float(v << 16); }
__device__ __forceinline__ float hi2f(unsigned v) { return __uint_as_float(v & 0xffff0000u); }
#define LDS_WAIT() asm volatile("s_waitcnt lgkmcnt(0)" ::: "memory")

#ifndef FFT_HOST
#define FFT_FN __device__ __forceinline__
#define FFT_SYNC() __syncthreads()
typedef float cplx __attribute__((ext_vector_type(2)));
typedef LAS cplx* fftbuf_t;
FFT_FN float cos2pi(float r) { return __builtin_amdgcn_cosf(r); }
FFT_FN float sin2pi(float r) { return __builtin_amdgcn_sinf(r); }
#endif
FFT_FN cplx mk2(float x, float y) { cplx r; r.x = x; r.y = y; return r; }
FFT_FN cplx cadd(cplx a, cplx b) { return mk2(a.x + b.x, a.y + b.y); }
FFT_FN cplx csub(cplx a, cplx b) { return mk2(a.x - b.x, a.y - b.y); }
FFT_FN cplx cmul(cplx a, cplx b) { return mk2(a.x * b.x - a.y * b.y, a.x * b.y + a.y * b.x); }
template <bool INV> FFT_FN cplx muli(cplx a) { return INV ? mk2(-a.y, a.x) : mk2(a.y, -a.x); }
FFT_FN int padi(int i) { return i + (i >> 3); }

template <bool INV> FFT_FN void dft8(cplx (&v)[8]) {
    const float R = 0.70710678118654752f;
    const cplx a0 = cadd(v[0], v[4]), a1 = csub(v[0], v[4]), a2 = cadd(v[2], v[6]), a3 = muli<INV>(csub(v[2], v[6]));
    const cplx a4 = cadd(v[1], v[5]), a5 = csub(v[1], v[5]), a6 = cadd(v[3], v[7]), a7 = muli<INV>(csub(v[3], v[7]));
    const cplx b0 = cadd(a0, a2), b2 = csub(a0, a2), b1 = cadd(a1, a3), b3 = csub(a1, a3);
    const cplx b4 = cadd(a4, a6), b6 = muli<INV>(csub(a4, a6));
    const cplx t5 = cadd(a5, a7), t7 = csub(a5, a7);
    cplx b5, b7;
    if (!INV) { b5 = mk2((t5.x + t5.y) * R, (t5.y - t5.x) * R); b7 = mk2((t7.y - t7.x) * R, -(t7.x + t7.y) * R); }
    else      { b5 = mk2((t5.x - t5.y) * R, (t5.x + t5.y) * R); b7 = mk2(-(t7.x + t7.y) * R, (t7.x - t7.y) * R); }
    v[0] = cadd(b0, b4); v[4] = csub(b0, b4); v[1] = cadd(b1, b5); v[5] = csub(b1, b5);
    v[2] = cadd(b2, b6); v[6] = csub(b2, b6); v[3] = cadd(b3, b7); v[7] = csub(b3, b7);
}
template <int S, bool INV> FFT_FN void twid(cplx (&v)[8], int tid) {
    if (S > 1) {
        const int j = tid % S; const float rev = (float)j * (1.0f / (8.0f * S));
        const float c = cos2pi(rev), s = sin2pi(rev);
        const cplx w1 = mk2(c, INV ? s : -s);
        const cplx w2 = cmul(w1, w1), w3 = cmul(w2, w1), w4 = cmul(w2, w2), w5 = cmul(w4, w1), w6 = cmul(w4, w2), w7 = cmul(w4, w3);
        v[1] = cmul(v[1], w1); v[2] = cmul(v[2], w2); v[3] = cmul(v[3], w3); v[4] = cmul(v[4], w4);
        v[5] = cmul(v[5], w5); v[6] = cmul(v[6], w6); v[7] = cmul(v[7], w7);
    }
}
template <int S> FFT_FN void ld8(fftbuf_t X, int tid, cplx (&v)[8]) {
    const int base = (tid / S) * 8 * S + (tid % S);
#pragma unroll
    for (int k = 0; k < 8; ++k) v[k] = X[padi(base + S * k)];
}
template <int S> FFT_FN void st8(fftbuf_t X, int tid, const cplx (&v)[8]) {
    const int base = (tid / S) * 8 * S + (tid % S);
#pragma unroll
    for (int k = 0; k < 8; ++k) X[padi(base + S * k)] = v[k];
}
#ifndef FFT_HOST
template <int S> FFT_FN void twid_fill(fftbuf_t TW, int tid) {
    constexpr int P = (S == 512) ? 0 : (S == 64) ? 1 : 2;
    const int j = tid % S; const float rev = (float)j * (1.0f / (8.0f * S));
    const cplx w1 = mk2(cos2pi(rev), -sin2pi(rev)), w2 = cmul(w1, w1), w4 = cmul(w2, w2);
    TW[(3 * P + 0) * 512 + tid] = w1; TW[(3 * P + 1) * 512 + tid] = w2; TW[(3 * P + 2) * 512 + tid] = w4;
}
template <int S, bool INV> FFT_FN void twidL(cplx (&v)[8], fftbuf_t TW, int tid) {
    constexpr int P = (S == 512) ? 0 : (S == 64) ? 1 : 2;
    cplx w1 = TW[(3 * P + 0) * 512 + tid], w2 = TW[(3 * P + 1) * 512 + tid], w4 = TW[(3 * P + 2) * 512 + tid];
    if (INV) { w1.y = -w1.y; w2.y = -w2.y; w4.y = -w4.y; }
    const cplx w3 = cmul(w2, w1), w5 = cmul(w4, w1), w6 = cmul(w4, w2), w7 = cmul(w4, w3);
    v[1] = cmul(v[1], w1); v[2] = cmul(v[2], w2); v[3] = cmul(v[3], w3); v[4] = cmul(v[4], w4);
    v[5] = cmul(v[5], w5); v[6] = cmul(v[6], w6); v[7] = cmul(v[7], w7);
}
FFT_FN void fft_fwdL(fftbuf_t X, fftbuf_t TW, int tid, cplx (&v)[8]) {
    dft8<false>(v); twidL<512, false>(v, TW, tid); st8<512>(X, tid, v); FFT_SYNC();
    ld8<64>(X, tid, v); dft8<false>(v); twidL<64, false>(v, TW, tid); st8<64>(X, tid, v); FFT_SYNC();
    ld8<8>(X, tid, v); dft8<false>(v); twidL<8, false>(v, TW, tid); st8<8>(X, tid, v); FFT_SYNC();
    ld8<1>(X, tid, v); dft8<false>(v);
}
FFT_FN void fft_invL(fftbuf_t X, fftbuf_t TW, int tid, cplx (&v)[8]) {
    dft8<true>(v); st8<1>(X, tid, v); FFT_SYNC();
    ld8<8>(X, tid, v); twidL<8, true>(v, TW, tid); dft8<true>(v); st8<8>(X, tid, v); FFT_SYNC();
    ld8<64>(X, tid, v); twidL<64, true>(v, TW, tid); dft8<true>(v); st8<64>(X, tid, v); FFT_SYNC();
    ld8<512>(X, tid, v); twidL<512, true>(v, TW, tid); dft8<true>(v);
}
FFT_FN void fft_fwd(fftbuf_t X, int tid, cplx (&v)[8]) {
    dft8<false>(v); twid<512, false>(v, tid); st8<512>(X, tid, v); FFT_SYNC();
    ld8<64>(X, tid, v); dft8<false>(v); twid<64, false>(v, tid); st8<64>(X, tid, v); FFT_SYNC();
    ld8<8>(X, tid, v); dft8<false>(v); twid<8, false>(v, tid); st8<8>(X, tid, v); FFT_SYNC();
    ld8<1>(X, tid, v); dft8<false>(v);
}
FFT_FN void fft_inv(fftbuf_t X, int tid, cplx (&v)[8]) {
    dft8<true>(v); st8<1>(X, tid, v); FFT_SYNC();
    ld8<8>(X, tid, v); twid<8, true>(v, tid); dft8<true>(v); st8<8>(X, tid, v); FFT_SYNC();
    ld8<64>(X, tid, v); twid<64, true>(v, tid); dft8<true>(v); st8<64>(X, tid, v); FFT_SYNC();
    ld8<512>(X, tid, v); twid<512, true>(v, tid); dft8<true>(v);
}
#endif

struct OneUnit { int pm, pn; bool on;
    __device__ __forceinline__ bool next(int i, pg8::Unit& u) const { if (!on || i > 0) return false; u.pm = pm; u.pn = pn; return true; }
    __device__ __forceinline__ void a_ready(const pg8::Unit&) const {}
    __device__ __forceinline__ void done(const pg8::Unit&) const {}
    __device__ __forceinline__ long a_off(const pg8::Unit& u, size_t tstep) const { return (long)((size_t)u.pm * tstep); }
    __device__ __forceinline__ int lda(int K) const { return K; }
    __device__ __forceinline__ size_t kstep_a() const { return 128; } };

struct EpiB {
    static constexpr bool PERM = true, AFTER_DRAIN = false;
    bf16_t* O; int ldc;
    __device__ __forceinline__ void operator()(const f32x4 (&acc)[2][2][4][2], const pg8::Unit& u, int wr, int wc, int fr, int fq) const {
        const int row0 = u.pm * 256 + wr * 64 + fr, col0 = u.pn * 256 + wc * 32 + 8 * fq;
#pragma unroll
        for (int ai = 0; ai < 2; ++ai)
#pragma unroll
            for (int m = 0; m < 4; ++m) { bf16_t* rowp = O + (size_t)(row0 + ai * 128 + m * 16) * ldc + col0;
#pragma unroll
                for (int bj = 0; bj < 2; ++bj) { const f32x4 v0 = acc[ai][bj][m][0], v1 = acc[ai][bj][m][1];
                    u32x4 w; w.x = pk2(v0[0], v0[1]); w.y = pk2(v0[2], v0[3]); w.z = pk2(v1[0], v1[1]); w.w = pk2(v1[2], v1[3]);
                    *(u32x4*)(rowp + bj * 128) = w; } }
    }
};
struct EpiRope {
    static constexpr bool PERM = true, AFTER_DRAIN = false;
    bf16_t* O; const float2* rope;
    __device__ __forceinline__ void operator()(const f32x4 (&acc)[2][2][4][2], const pg8::Unit& u, int wr, int wc, int fr, int fq) const {
        const int row0 = u.pm * 256 + wr * 64 + fr, col0 = u.pn * 256 + wc * 32 + 8 * fq;
        const bool rot = u.pn < 4;
#pragma unroll
        for (int ai = 0; ai < 2; ++ai)
#pragma unroll
            for (int m = 0; m < 4; ++m) { const int row = row0 + ai * 128 + m * 16; bf16_t* rowp = O + (size_t)row * MIXW + col0;
#pragma unroll
                for (int bj = 0; bj < 2; ++bj) { f32x4 v0 = acc[ai][bj][m][0], v1 = acc[ai][bj][m][1];
                    if (rot) { const int pos = row & (SEQ - 1), i0 = ((col0 + bj * 128) & 63) >> 1;
                        const f32x4* rp = (const f32x4*)(rope + pos * 32 + i0); const f32x4 r0 = rp[0], r1 = rp[1];
                        f32x4 o0, o1;
                        o0[0] = v0[0] * r0[0] - v0[1] * r0[1]; o0[1] = v0[1] * r0[0] + v0[0] * r0[1];
                        o0[2] = v0[2] * r0[2] - v0[3] * r0[3]; o0[3] = v0[3] * r0[2] + v0[2] * r0[3];
                        o1[0] = v1[0] * r1[0] - v1[1] * r1[1]; o1[1] = v1[1] * r1[0] + v1[0] * r1[1];
                        o1[2] = v1[2] * r1[2] - v1[3] * r1[3]; o1[3] = v1[3] * r1[2] + v1[2] * r1[3];
                        v0 = o0; v1 = o1; }
                    u32x4 w; w.x = pk2(v0[0], v0[1]); w.y = pk2(v0[2], v0[3]); w.z = pk2(v1[0], v1[1]); w.w = pk2(v1[2], v1[3]);
                    *(u32x4*)(rowp + bj * 128) = w; } }
    }
};
struct EpiRes {
    static constexpr bool PERM = false, AFTER_DRAIN = false;
    const float* X; float* O;
    __device__ __forceinline__ void operator()(const f32x4 (&acc)[2][2][4][2], const pg8::Unit& u, int wr, int wc, int fr, int fq) const {
        const int row0 = u.pm * 256 + wr * 64 + fr, col0 = u.pn * 256 + wc * 32 + 4 * fq;
#pragma unroll
        for (int ai = 0; ai < 2; ++ai) {
            f32x4 xv[4][2][2];
#pragma unroll
            for (int m = 0; m < 4; ++m)
#pragma unroll
                for (int bj = 0; bj < 2; ++bj)
#pragma unroll
                    for (int n = 0; n < 2; ++n) xv[m][bj][n] = *(const f32x4*)(X + (size_t)(row0 + ai * 128 + m * 16) * DM + col0 + bj * 128 + 16 * n);
            asm volatile("" ::: "memory");
#pragma unroll
            for (int m = 0; m < 4; ++m)
#pragma unroll
                for (int bj = 0; bj < 2; ++bj)
#pragma unroll
                    for (int n = 0; n < 2; ++n) *(f32x4*)(O + (size_t)(row0 + ai * 128 + m * 16) * DM + col0 + bj * 128 + 16 * n) = acc[ai][bj][m][n] + xv[m][bj][n] * ALPHA;
        }
    }
};
struct EpiRes2 {
    static constexpr bool PERM = false, AFTER_DRAIN = false;
    const float* R; float* O; const float2* stat; const float* g; const float* b;
    __device__ __forceinline__ void operator()(const f32x4 (&acc)[2][2][4][2], const pg8::Unit& u, int wr, int wc, int fr, int fq) const {
        const int row0 = u.pm * 256 + wr * 64 + fr, col0 = u.pn * 256 + wc * 32 + 4 * fq;
#pragma unroll
        for (int ai = 0; ai < 2; ++ai)
#pragma unroll
            for (int bj = 0; bj < 2; ++bj) {
                f32x4 rv[4][2], gv[2], bv[2]; float2 st[4];
#pragma unroll
                for (int m = 0; m < 4; ++m) { const int row = row0 + ai * 128 + m * 16; st[m] = stat[row];
#pragma unroll
                    for (int n = 0; n < 2; ++n) rv[m][n] = *(const f32x4*)(R + (size_t)row * DM + col0 + bj * 128 + 16 * n); }
#pragma unroll
                for (int n = 0; n < 2; ++n) { gv[n] = *(const f32x4*)(g + col0 + bj * 128 + 16 * n); bv[n] = *(const f32x4*)(b + col0 + bj * 128 + 16 * n); }
                asm volatile("" ::: "memory");
#pragma unroll
                for (int m = 0; m < 4; ++m)
#pragma unroll
                    for (int n = 0; n < 2; ++n) { const f32x4 x1 = (rv[m][n] - st[m].x) * st[m].y * gv[n] + bv[n];
                        *(f32x4*)(O + (size_t)(row0 + ai * 128 + m * 16) * DM + col0 + bj * 128 + 16 * n) = acc[ai][bj][m][n] + x1 * ALPHA; }
            }
    }
};

struct KbOrder : pg8::StaticOrder {
    __device__ __forceinline__ int lda(int) const { return 64; }
    __device__ __forceinline__ size_t kstep_a() const { return (size_t)NT * 64 * 2; }
};
struct RevOrder : pg8::StaticOrder {
    __device__ __forceinline__ bool next(int i, pg8::Unit& u) const { const int rounds = (nwg + G - 1) / G; if (i >= rounds) return false; return pg8::StaticOrder::next(rounds - 1 - i, u); }
};
constexpr int CWL_OFF = 131072 + 1024 + 8192;
struct FfnOrder : pg8::StaticOrder {
    const float* cw; const float* cb; LAS unsigned char* lds; mutable int cnt;
    __device__ __forceinline__ long a_off(const pg8::Unit& u, size_t) const { return ((long)u.pm * 254 - 1) * (long)(DM * 2); }
    __device__ __forceinline__ void a_ready(const pg8::Unit& u) const {
        const int tid = threadIdx.x, w = __builtin_amdgcn_readfirstlane(tid >> 6), lane = tid & 63, buf = cnt & 1; ++cnt;
        const float* src = (w < 3) ? cw + (size_t)w * (2 * DFF) : (w < 6) ? cw + (size_t)(w - 3) * (2 * DFF) + DFF : (w == 6) ? cb : cb + DFF;
        src += u.pn * 128 + lane * 4;
        if (lane < 32) __builtin_amdgcn_global_load_lds((const unsigned*)src, (LAS unsigned*)(lds + CWL_OFF + buf * 4096 + w * 512), 16, 0, 0);
    }
};
constexpr int FFN_MT = 130;
constexpr int XCH_OFF = 131072 + 1024;
__device__ __forceinline__ float dpp_ror1(float v)  { return __int_as_float(__builtin_amdgcn_update_dpp(0, __float_as_int(v), 0x121, 0xF, 0xF, false)); }
__device__ __forceinline__ float dpp_ror15(float v) { return __int_as_float(__builtin_amdgcn_update_dpp(0, __float_as_int(v), 0x12F, 0xF, 0xF, false)); }
struct EpiFfn {
    static constexpr bool PERM = true, AFTER_DRAIN = false;
    bf16_t* ACT; LAS unsigned char* lds; mutable int ecnt;
    __device__ __forceinline__ void operator()(const f32x4 (&acc)[2][2][4][2], const pg8::Unit& u, int wr, int wc, int fr, int fq) const {
        LAS float* XC = (LAS float*)(lds + XCH_OFF);
        const LAS float* WL = (const LAS float*)(lds + CWL_OFF + (ecnt & 1) * 4096); ++ecnt;
        const int colw = wc * 32 + 8 * fq;
        if (fr == 0 || fr == 15) {
            const int edge = (fr == 15) ? 1 : 0, m = (fr == 15) ? 3 : 0;
#pragma unroll
            for (int ai = 0; ai < 2; ++ai)
#pragma unroll
                for (int bj = 0; bj < 2; ++bj)
#pragma unroll
                    for (int n = 0; n < 2; ++n) { const f32x4 v = (m == 0) ? acc[ai][bj][0][n] : acc[ai][bj][3][n];
                        *(LAS f32x4*)(XC + ((ai * 2 + wr) * 2 + edge) * 256 + bj * 128 + colw + 4 * n) = v; }
        }
        asm volatile("s_waitcnt lgkmcnt(0)" ::: "memory"); __builtin_amdgcn_s_barrier(); asm volatile("" ::: "memory");
        const int slot0 = wr * 64 + fr, row_base = u.pm * 254 - 1;
#pragma unroll
        for (int bj = 0; bj < 2; ++bj) {
            const int gc = (u.pn * 256 + bj * 128 + colw) >> 1;
            const LAS float* wl = WL + ((bj * 128 + colw) >> 1);
            f32x4 wg[3], wu[3];
#pragma unroll
            for (int j = 0; j < 3; ++j) { wg[j] = *(const LAS f32x4*)(wl + j * 128); wu[j] = *(const LAS f32x4*)(wl + (3 + j) * 128); }
            const f32x4 bg = *(const LAS f32x4*)(wl + 6 * 128), bu = *(const LAS f32x4*)(wl + 7 * 128);
#pragma unroll
            for (int ai = 0; ai < 2; ++ai) {
                const int gidx = ai * 2 + wr;
                f32x4 pe[2], ne[2];
#pragma unroll
                for (int n = 0; n < 2; ++n) {
                    pe[n] = (gidx > 0) ? *(const LAS f32x4*)(XC + (((gidx - 1) * 2) + 1) * 256 + bj * 128 + colw + 4 * n) : (f32x4){0.f, 0.f, 0.f, 0.f};
                    ne[n] = (gidx < 3) ? *(const LAS f32x4*)(XC + (((gidx + 1) * 2) + 0) * 256 + bj * 128 + colw + 4 * n) : (f32x4){0.f, 0.f, 0.f, 0.f}; }
#pragma unroll
                for (int m = 0; m < 4; ++m) {
                    const int slot = ai * 128 + slot0 + m * 16, row = row_base + slot, t = row & (SEQ - 1);
                    f32x4 hv[2];
#pragma unroll
                    for (int n = 0; n < 2; ++n) {
                        const f32x4 cur = acc[ai][bj][m][n], prv = acc[ai][bj][m == 0 ? 0 : m - 1][n], nxt = acc[ai][bj][m == 3 ? 3 : m + 1][n];
                        f32x4 up, dn;
#pragma unroll
                        for (int e = 0; e < 4; ++e) { up[e] = dpp_ror1(fr == 15 ? prv[e] : cur[e]); dn[e] = dpp_ror15(fr == 0 ? nxt[e] : cur[e]); }
                        if (m == 0 && fr == 0) up = pe[n];
                        if (m == 3 && fr == 15) dn = ne[n];
                        if (t == 0) up = (f32x4){0.f, 0.f, 0.f, 0.f};
                        if (t == SEQ - 1) dn = (f32x4){0.f, 0.f, 0.f, 0.f};
                        const f32x4 w0 = n ? wu[0] : wg[0], w1 = n ? wu[1] : wg[1], w2 = n ? wu[2] : wg[2], bb = n ? bu : bg;
                        hv[n] = w0 * up + w1 * cur + w2 * dn + bb; }
                    if (slot >= 1 && slot <= 254 && row < NT) {
                        float o[4];
#pragma unroll
                        for (int e = 0; e < 4; ++e) { const float g = hv[0][e]; o[e] = g * __builtin_amdgcn_rcpf(1.0f + __expf(-g)) * hv[1][e]; }
                        u32x2 w; w.x = pk2(o[0], o[1]); w.y = pk2(o[2], o[3]);
                        *(u32x2*)(ACT + ((size_t)(gc >> 6) * NT + row) * 64 + (gc & 63)) = w; }
                }
            }
        }
    }
};

__device__ __forceinline__ int win_row(int n) {
    if (n < 1536) return 1536 + n;
    if (n < 2560) { const int q = n - 1536, blk = q >> 6, d = q & 63; return blk * 64 + 2 * (d & 31) + (d >> 5); }
    if (n < 3072) return 512 + n;
    return n - 2048;
}
template <int MODE> __device__ __forceinline__ void p0_transpose_item(const float* W, int K, int N, bf16_t* WT, LAS float* scr, int item, int lane) {
    const int nblk = N / 32, kb = item / nblk, nb = item % nblk, k0 = 64 * kb, n0 = 32 * nb;
#pragma unroll 8
    for (int i = 0; i < 32; ++i) { const int kk = 2 * i + (lane >> 5); scr[kk * 33 + (lane & 31)] = W[(size_t)(k0 + kk) * N + n0 + (lane & 31)]; }
    LDS_WAIT(); asm volatile("" ::: "memory");
    const int c = lane & 7;
#pragma unroll
    for (int j = 0; j < 4; ++j) { const int n = (lane >> 3) + 8 * j; const LAS float* s = scr + (8 * c) * 33 + n;
        u32x4 o; o.x = pk2(s[0 * 33], s[1 * 33]); o.y = pk2(s[2 * 33], s[3 * 33]); o.z = pk2(s[4 * 33], s[5 * 33]); o.w = pk2(s[6 * 33], s[7 * 33]);
        const int nn = n0 + n; const int dr = (MODE == 1) ? win_row(nn) : (MODE == 2) ? ((nn < DFF) ? ((nn >> 2) * 8 + (nn & 3)) : (((nn - DFF) >> 2) * 8 + 4 + ((nn - DFF) & 3))) : nn;
        *(u32x4*)(WT + (size_t)dr * K + k0 + 8 * c) = o; }
    LDS_WAIT(); asm volatile("" ::: "memory");
}
__device__ __forceinline__ void cvt_rows(const float* src, bf16_t* dst, size_t n8, int gw, int ngw, int lane) {
    const size_t stride = (size_t)ngw * 64;
    for (size_t i = (size_t)gw * 64 + lane; i < n8; i += 4 * stride) {
        f32x4 a[4], c[4];
#pragma unroll
        for (int u = 0; u < 4; ++u) { const size_t k = i + u * stride; if (k < n8) { a[u] = ((const f32x4*)src)[2 * k]; c[u] = ((const f32x4*)src)[2 * k + 1]; } }
#pragma unroll
        for (int u = 0; u < 4; ++u) { const size_t k = i + u * stride; if (k < n8) {
            u32x4 w; w.x = pk2(a[u][0], a[u][1]); w.y = pk2(a[u][2], a[u][3]); w.z = pk2(c[u][0], c[u][1]); w.w = pk2(c[u][2], c[u][3]);
            ((u32x4*)dst)[k] = w; } }
    }
}
__device__ __forceinline__ void p0_filter_item(const float* w1, const float* b1, const float* fq, const float* w2, const float* b2, const float* w3, float* HTD, int item, int lane) {
    const int t0 = 2 * (item >> 2), ih = item & 3; float h2v[2], tl[2];
    const float fql = fq[lane], b1l = b1[lane], b2l = b2[lane];
#pragma unroll
    for (int tt = 0; tt < 2; ++tt) { const int t = t0 + tt; tl[tt] = (float)t * (1.0f / 2047.0f);
        const float w = 6.283185307179586f * (float)t / 2048.0f;
        float zk = 0.f;
        if (lane == 0) zk = tl[tt];
        else if (lane <= 16) { const float fr = 1e-4f + (float)(lane - 1) * ((15.0f - 1e-4f) / 15.0f); zk = cosf(fr * w); }
        else if (lane <= 32) { const float fr = 1e-4f + (float)(lane - 17) * ((15.0f - 1e-4f) / 15.0f); zk = -sinf(fr * w); }
        float a = b1l;
#pragma unroll 11
        for (int k = 0; k < 33; ++k) a += __shfl(zk, k) * w1[k * 64 + lane];
        const float h1 = sinf(fql * a);
        float a2 = b2l;
#pragma unroll 16
        for (int k = 0; k < 64; ++k) a2 += __shfl(h1, k) * w2[k * 64 + lane];
        h2v[tt] = sinf(fql * a2); }
    const float dmin = -15.350567286626973f, dmax = -3.0701134573253946f;
    float acc0[8], acc1[8];
#pragma unroll
    for (int i = 0; i < 8; ++i) { acc0[i] = 0.f; acc1[i] = 0.f; }
#pragma unroll 8
    for (int j = 0; j < 64; ++j) { const float s0 = __shfl(h2v[0], j), s1 = __shfl(h2v[1], j); const float* wr = w3 + (size_t)j * 2048 + ih * 512 + lane;
#pragma unroll
        for (int i = 0; i < 8; ++i) { const float wv = wr[64 * i]; acc0[i] += s0 * wv; acc1[i] += s1 * wv; } }
#pragma unroll
    for (int i = 0; i < 8; ++i) { const int col = ih * 512 + 64 * i + lane, c = col & 511;
        const float delta = fabsf(dmin + (float)c * ((dmax - dmin) / 511.0f));
        float2 o; o.x = acc0[i] * expf(-tl[0] * delta); o.y = acc1[i] * expf(-tl[1] * delta);
        *(float2*)(HTD + (size_t)col * 2048 + t0) = o; }
}
__device__ __forceinline__ void p0_prep(const float* const* in, unsigned char* ws, LAS unsigned char* lds, int tid) {
    const int lane = tid & 63, wave = tid >> 6, gw = blockIdx.x * NWAVE + wave, ngw = gridDim.x * NWAVE;
    LAS float* scr = (LAS float*)(lds + wave * 16384);
    bf16_t* WALL = (bf16_t*)(ws + WS_WALL);
    constexpr int I_IN = 16 * (INW / 32), I_KV = 16 * 32, I_OUT = 24 * 32, I_UP = 16 * (2 * DFF / 32), I_DN = (DFF / 64) * 32, NIT = I_IN + I_KV + I_OUT + I_UP + I_DN;
    for (int it = gw; it < NIT; it += ngw) { int r = it;
        if (r < I_IN) { p0_transpose_item<1>(in[2], DM, INW, WALL, scr, r, lane); continue; } r -= I_IN;
        if (r < I_KV) { p0_transpose_item<0>(in[14], DM, 1024, (bf16_t*)(ws + WS_WKV), scr, r, lane); continue; } r -= I_KV;
        if (r < I_OUT) { p0_transpose_item<0>(in[15], MIXW, DM, (bf16_t*)(ws + WS_WOUT), scr, r, lane); continue; } r -= I_OUT;
        if (r < I_UP) { p0_transpose_item<2>(in[18], DM, 2 * DFF, (bf16_t*)(ws + WS_WUP), scr, r, lane); continue; } r -= I_UP;
        p0_transpose_item<0>(in[21], DFF, DM, (bf16_t*)(ws + WS_WDN), scr, r, lane); }
    for (int it = ngw - 1 - gw; it < 4096; it += ngw) p0_filter_item(in[5], in[6], in[7], in[8], in[9], in[10], (float*)(ws + WS_HTD), it, lane);
    cvt_rows(in[0], (bf16_t*)(ws + WS_XB), (size_t)NT * DM / 8, gw, ngw, lane);
    cvt_rows(in[1], (bf16_t*)(ws + WS_MEMB), (size_t)NMT * DM / 8, gw, ngw, lane);
    float2* rope = (float2*)(ws + WS_ROPE);
    for (int i = blockIdx.x * NTHR + tid; i < SEQ * 32; i += gridDim.x * NTHR) { const int pos = i >> 5, f = i & 31;
        const float invf = powf(10000.0f, -(float)(2 * f) / 64.0f); const float ang = (float)pos * invf;
        float2 cs; cs.x = cosf(ang); cs.y = sinf(ang); rope[i] = cs; }
}

__device__ __forceinline__ void filter_fft_item(const float* HTD, float2* KF, LAS unsigned char* lds, int item, int tid) {
    const int o = item >> 9, c = item & 511;
    const float* rf = HTD + (size_t)((o * 2 + 0) * 512 + c) * 2048; const float* rb = HTD + (size_t)((o * 2 + 1) * 512 + c) * 2048;
    cplx v[8];
#pragma unroll
    for (int k = 0; k < 4; ++k) v[k] = mk2(rf[tid + 512 * k], 0.f);
    v[4] = mk2(tid == 0 ? 0.f : rb[2048 - tid], 0.f); v[5] = mk2(rb[1536 - tid], 0.f); v[6] = mk2(rb[1024 - tid], 0.f); v[7] = mk2(rb[512 - tid], 0.f);
    fft_fwd((LAS cplx*)lds, tid, v);
    float2* dst = KF + (size_t)(o * 512 + c) * 4096 + 8 * tid;
#pragma unroll
    for (int m = 0; m < 8; m += 2) { f32x4 w; w[0] = v[m].x * (1.f / 4096.f); w[1] = v[m].y * (1.f / 4096.f); w[2] = v[m + 1].x * (1.f / 4096.f); w[3] = v[m + 1].y * (1.f / 4096.f); *(f32x4*)(dst + m) = w; }
    __syncthreads();
}

constexpr int HY_SEG = 2064, HY_STG_OFF = 36864;
__device__ __forceinline__ float conv3s(const LAS bf16_t* seg, int n, float w0, float w1, float w2, float b) {
    return w0 * bf2f(seg[7 + n]) + w1 * bf2f(seg[8 + n]) + w2 * bf2f(seg[9 + n]) + b;
}
__device__ __forceinline__ void hyena_item(const bf16_t* HT, const float2* KF, const float* cw, const float* cb, const float* hb, bf16_t* MIX, LAS unsigned char* lds, int bp, int cgp, int tid0) {
    LAS cplx* X = (LAS cplx*)lds; LAS bf16_t* STG = (LAS bf16_t*)(lds + HY_STG_OFF); LAS cplx* TW = (LAS cplx*)(lds + 65536);
    const int ba = 2 * bp;
    twid_fill<512>(TW, tid0); twid_fill<64>(TW, tid0); twid_fill<8>(TW, tid0);
    u32x4 oacc[8];
#pragma unroll
    for (int i = 0; i < 8; ++i) oacc[i] = (u32x4){0u, 0u, 0u, 0u};
    if (tid0 < 12) { const int sg = tid0 >> 1; STG[sg * HY_SEG + ((tid0 & 1) ? 2056 : 7)] = 0; }
    { const int c = cgp * 8;
#pragma unroll
      for (int i = 0; i < 3; ++i) { const int id = tid0 + 512 * i, sg = id >> 8, ch = id & 255;
          const u32x4 q = *(const u32x4*)(HT + (size_t)((sg >> 1) * 512 + c) * NT + (ba + (sg & 1)) * SEQ + ch * 8);
          *(LAS u32x4*)(STG + sg * HY_SEG + 8 + ch * 8) = q; } }
    __syncthreads();
#pragma unroll 1
    for (int cc = 0; cc < 8; ++cc) {
        const int c = cgp * 8 + cc;
        int tl_ = tid0; asm volatile("" : "+v"(tl_)); const int tid = tl_;
        u32x4 nx[3];
        if (cc < 7) {
#pragma unroll
            for (int i = 0; i < 3; ++i) { const int id = tid + 512 * i, sg = id >> 8, ch = id & 255;
                nx[i] = *(const u32x4*)(HT + (size_t)((sg >> 1) * 512 + c + 1) * NT + (ba + (sg & 1)) * SEQ + ch * 8); } }
        f32x4 kf[4];
        { const f32x4* kp = (const f32x4*)(KF + (size_t)c * 4096 + 8 * tid);
#pragma unroll
          for (int m = 0; m < 4; ++m) kf[m] = kp[m]; }
        cplx v[8]; float va[4], vb[4];
        { const float w0 = cw[c], w1 = cw[1536 + c], w2 = cw[3072 + c], b = cb[c];
#pragma unroll
          for (int k = 0; k < 4; ++k) { const int n = tid + 512 * k; va[k] = conv3s(STG, n, w0, w1, w2, b); vb[k] = conv3s(STG + HY_SEG, n, w0, w1, w2, b); v[k] = mk2(va[k], vb[k]); v[4 + k] = mk2(0.f, 0.f); } }
        fft_fwdL(X, TW, tid, v);
#pragma unroll
        for (int m = 0; m < 8; m += 2) { const f32x4 w = kf[m >> 1]; v[m] = cmul(v[m], mk2(w[0], w[1])); v[m + 1] = cmul(v[m + 1], mk2(w[2], w[3])); }
        { const f32x4* kp = (const f32x4*)(KF + (size_t)(512 + c) * 4096 + 8 * tid);
#pragma unroll
          for (int m = 0; m < 4; ++m) kf[m] = kp[m]; }
        fft_invL(X, TW, tid, v);
        { const float w0 = cw[512 + c], w1 = cw[1536 + 512 + c], w2 = cw[3072 + 512 + c], b = cb[512 + c], hb0 = hb[c];
#pragma unroll
          for (int k = 0; k < 4; ++k) { const int n = tid + 512 * k; const float xa = conv3s(STG + 2 * HY_SEG, n, w0, w1, w2, b), xb = conv3s(STG + 3 * HY_SEG, n, w0, w1, w2, b);
              va[k] = xa * (v[k].x + hb0 * va[k]); vb[k] = xb * (v[k].y + hb0 * vb[k]); v[k] = mk2(va[k], vb[k]); v[4 + k] = mk2(0.f, 0.f); } }
        fft_fwdL(X, TW, tid, v);
#pragma unroll
        for (int m = 0; m < 8; m += 2) { const f32x4 w = kf[m >> 1]; v[m] = cmul(v[m], mk2(w[0], w[1])); v[m + 1] = cmul(v[m + 1], mk2(w[2], w[3])); }
        fft_invL(X, TW, tid, v);
        { const float w0 = cw[1024 + c], w1 = cw[1536 + 1024 + c], w2 = cw[3072 + 1024 + c], b = cb[1024 + c], hb1 = hb[512 + c];
#pragma unroll
          for (int k = 0; k < 4; ++k) { const int n = tid + 512 * k; const float xa = conv3s(STG + 4 * HY_SEG, n, w0, w1, w2, b), xb = conv3s(STG + 5 * HY_SEG, n, w0, w1, w2, b);
              const float oa = xa * (v[k].x + hb1 * va[k]), ob = xb * (v[k].y + hb1 * vb[k]);
              const unsigned pw = pk2(oa, ob);
#pragma unroll
              for (int hh = 0; hh < 2; ++hh) { u32x4& o = oacc[2 * k + hh]; const unsigned nw = hh ? (pw & 0xffff0000u) : (pw << 16);
                  o.x = __builtin_amdgcn_alignbit(o.y, o.x, 16); o.y = __builtin_amdgcn_alignbit(o.z, o.y, 16); o.z = __builtin_amdgcn_alignbit(o.w, o.z, 16); o.w = (o.w >> 16) | nw; } } }
        __syncthreads();
        if (cc < 7) {
#pragma unroll
            for (int i = 0; i < 3; ++i) { const int id = tid + 512 * i, sg = id >> 8, ch = id & 255; *(LAS u32x4*)(STG + sg * HY_SEG + 8 + ch * 8) = nx[i]; } }
        __syncthreads();
    }
    int tw_ = tid0; asm volatile("" : "+v"(tw_)); const int tid = tw_;
#pragma unroll
    for (int k = 0; k < 4; ++k)
#pragma unroll
        for (int hh = 0; hh < 2; ++hh) *(u32x4*)(MIX + (size_t)((ba + hh) * SEQ + tid + 512 * k) * MIXW + cgp * 8) = oacc[2 * k + hh];
}

constexpr int ATT_KP = 272, ATT_VP = 144, ATT_KB = 64 * ATT_KP, ATT_VB = 128 * ATT_VP, ATT_VOFF = 2 * ATT_KB;
template <int NC> __device__ __forceinline__ void attn_unit(LAS unsigned char* lds, const bf16_t* Qp, int ldq, const bf16_t* Kp, int ldk, const bf16_t* Vt, int ldv, int nkeys, float sl2,
                                                            bf16_t* Op, int ldo, float lam, const float* subg, int tid) {
    constexpr int NSTEP = (NC == 2) ? 4 : 8;
    const int lane = tid & 63, wave = tid >> 6, r = lane & 31, h = lane >> 5;
    const int qb = (NC == 2) ? (wave & 3) : wave, comp = (NC == 2) ? (wave >> 2) : 0, dbase = comp * 64;
    bf16x8 qf[NSTEP];
#pragma unroll
    for (int st = 0; st < NSTEP; ++st) qf[st] = *(const bf16x8*)(Qp + (size_t)(qb * 32 + r) * ldq + dbase + 16 * st + 8 * h);
    f32x16 o[4];
#pragma unroll
    for (int et = 0; et < 4; ++et)
#pragma unroll
        for (int i = 0; i < 16; ++i) o[et][i] = 0.f;
    float mold = -INFINITY, lsum = 0.f;
    const int kr0 = tid >> 4, kc = tid & 15, vr0 = tid >> 3, vc = tid & 7;
    const bf16_t* kg = Kp + (size_t)kr0 * ldk + kc * 8; const bf16_t* vg = Vt + (size_t)vr0 * ldv + vc * 8;
    const int kl = kr0 * ATT_KP + kc * 16, vl = ATT_VOFF + vr0 * ATT_VP + vc * 16;
    const int nt = nkeys / 64;
    u32x4 pk0, pk1, pv0, pv1;
    pk0 = *(const u32x4*)(kg); pk1 = *(const u32x4*)(kg + (size_t)32 * ldk); pv0 = *(const u32x4*)(vg); pv1 = *(const u32x4*)(vg + (size_t)64 * ldv);
    *(LAS u32x4*)(lds + kl) = pk0; *(LAS u32x4*)(lds + kl + 32 * ATT_KP) = pk1; *(LAS u32x4*)(lds + vl) = pv0; *(LAS u32x4*)(lds + vl + 64 * ATT_VP) = pv1;
    __syncthreads();
    for (int it = 0; it < nt; ++it) {
        const int cur = it & 1; const bool more = (it + 1 < nt);
        if (more) { const bf16_t* kg2 = kg + (size_t)(it + 1) * 64 * ldk; const bf16_t* vg2 = vg + (it + 1) * 64;
            pk0 = *(const u32x4*)(kg2); pk1 = *(const u32x4*)(kg2 + (size_t)32 * ldk); pv0 = *(const u32x4*)(vg2); pv1 = *(const u32x4*)(vg2 + (size_t)64 * ldv); }
        LAS unsigned char* Kb = lds + cur * ATT_KB; LAS unsigned char* Vb = lds + ATT_VOFF + cur * ATT_VB;
        f32x16 s[2];
#pragma unroll
        for (int kb = 0; kb < 2; ++kb) {
#pragma unroll
            for (int i = 0; i < 16; ++i) s[kb][i] = 0.f;
#pragma unroll
            for (int st = 0; st < NSTEP; ++st) { const bf16x8 a = *(const LAS bf16x8*)(Kb + (kb * 32 + r) * ATT_KP + (dbase + 16 * st + 8 * h) * 2);
                s[kb] = __builtin_amdgcn_mfma_f32_32x32x16_bf16(a, qf[st], s[kb], 0, 0, 0); } }
        float mx = s[0][0];
#pragma unroll
        for (int i = 1; i < 16; ++i) mx = fmaxf(mx, s[0][i]);
#pragma unroll
        for (int i = 0; i < 16; ++i) mx = fmaxf(mx, s[1][i]);
        mx = fmaxf(mx, __shfl_xor(mx, 32));
        const float mnew = fmaxf(mold, mx * sl2), alpha = __builtin_amdgcn_exp2f(mold - mnew); mold = mnew;
        float ps = 0.f;
#pragma unroll
        for (int kb = 0; kb < 2; ++kb)
#pragma unroll
            for (int i = 0; i < 16; ++i) { const float p = __builtin_amdgcn_exp2f(__builtin_fmaf(s[kb][i], sl2, -mnew)); s[kb][i] = p; ps += p; }
        lsum = lsum * alpha + ps;
#pragma unroll
        for (int et = 0; et < 4; ++et)
#pragma unroll
            for (int i = 0; i < 16; ++i) o[et][i] *= alpha;
#pragma unroll
        for (int kb = 0; kb < 2; ++kb)
#pragma unroll
            for (int s2 = 0; s2 < 2; ++s2) {
                u32x4 pw; pw.x = pk2(s[kb][8 * s2 + 0], s[kb][8 * s2 + 1]); pw.y = pk2(s[kb][8 * s2 + 2], s[kb][8 * s2 + 3]); pw.z = pk2(s[kb][8 * s2 + 4], s[kb][8 * s2 + 5]); pw.w = pk2(s[kb][8 * s2 + 6], s[kb][8 * s2 + 7]);
                const bf16x8 pf = __builtin_bit_cast(bf16x8, pw);
#pragma unroll
                for (int et = 0; et < 4; ++et) { const LAS unsigned char* vp = Vb + (et * 32 + r) * ATT_VP + (kb * 32 + 16 * s2 + 4 * h) * 2;
                    const u32x2 lo = *(const LAS u32x2*)vp, hi = *(const LAS u32x2*)(vp + 16);
                    u32x4 aw; aw.x = lo.x; aw.y = lo.y; aw.z = hi.x; aw.w = hi.y;
                    o[et] = __builtin_amdgcn_mfma_f32_32x32x16_bf16(__builtin_bit_cast(bf16x8, aw), pf, o[et], 0, 0, 0); } }
        if (more) { const int nb = cur ^ 1;
            *(LAS u32x4*)(lds + nb * ATT_KB + kl) = pk0; *(LAS u32x4*)(lds + nb * ATT_KB + kl + 32 * ATT_KP) = pk1;
            *(LAS u32x4*)(lds + nb * ATT_VB + vl) = pv0; *(LAS u32x4*)(lds + nb * ATT_VB + vl + 64 * ATT_VP) = pv1; }
        __syncthreads();
    }
    lsum += __shfl_xor(lsum, 32);
    const float inv = 1.0f / lsum;
    if (NC == 1) {
        bf16_t* orow = Op + (size_t)(qb * 32 + r) * ldo;
#pragma unroll
        for (int et = 0; et < 4; ++et)
#pragma unroll
            for (int g = 0; g < 4; ++g) { u32x2 w; w.x = pk2(o[et][4 * g] * inv, o[et][4 * g + 1] * inv); w.y = pk2(o[et][4 * g + 2] * inv, o[et][4 * g + 3] * inv);
                *(u32x2*)(orow + et * 32 + 8 * g + 4 * h) = w; }
    } else {
        LAS float* XL = (LAS float*)lds;
        if (comp == 1) {
#pragma unroll
            for (int et = 0; et < 4; ++et)
#pragma unroll
                for (int i = 0; i < 16; ++i) XL[(qb * 64 + et * 16 + i) * 64 + lane] = o[et][i] * inv;
        }
        __syncthreads();
        if (comp == 0) {
            float ss = 0.f;
#pragma unroll
            for (int et = 0; et < 4; ++et)
#pragma unroll
                for (int i = 0; i < 16; ++i) { const float ov = o[et][i] * inv - lam * XL[(qb * 64 + et * 16 + i) * 64 + lane]; o[et][i] = ov; ss += ov * ov; }
            ss += __shfl_xor(ss, 32);
            const float rs = rsqrtf(ss * (1.0f / 128.0f) + RMS_EPS) * 0.8f;
            bf16_t* orow = Op + (size_t)(qb * 32 + r) * ldo;
#pragma unroll
            for (int et = 0; et < 4; ++et)
#pragma unroll
                for (int g = 0; g < 4; ++g) { const int e = et * 32 + 8 * g + 4 * h; const f32x4 gv = *(const f32x4*)(subg + e);
                    u32x2 w; w.x = pk2(o[et][4 * g] * rs * gv[0], o[et][4 * g + 1] * rs * gv[1]); w.y = pk2(o[et][4 * g + 2] * rs * gv[2], o[et][4 * g + 3] * rs * gv[3]);
                    *(u32x2*)(orow + e) = w; }
        }
        __syncthreads();
    }
}

template <bool TO_BF16> __device__ __forceinline__ void ln_rows(float* io, bf16_t* ob, float2* stat, const float* g, const float* b, int tid, float* alt = nullptr) {
    const int lane = tid & 63, gw = blockIdx.x * NWAVE + (tid >> 6), ngw = gridDim.x * NWAVE;
    f32x4 gv[4], bv[4];
#pragma unroll
    for (int j = 0; j < 4; ++j) { gv[j] = ((const f32x4*)g)[lane + 64 * j]; bv[j] = ((const f32x4*)b)[lane + 64 * j]; }
    for (int row0 = gw; row0 < NT; row0 += 2 * ngw) {
        f32x4 v[2][4];
#pragma unroll
        for (int u = 0; u < 2; ++u) { const int row = row0 + u * ngw; if (row < NT) { const f32x4* xr = (const f32x4*)(io + (size_t)row * DM) + lane;
#pragma unroll
            for (int j = 0; j < 4; ++j) v[u][j] = xr[64 * j]; } }
#pragma unroll
        for (int u = 0; u < 2; ++u) { const int row = row0 + u * ngw; if (row >= NT) continue;
            float s = 0.f;
#pragma unroll
            for (int j = 0; j < 4; ++j) s += (v[u][j][0] + v[u][j][1]) + (v[u][j][2] + v[u][j][3]);
#pragma unroll
            for (int o = 1; o < 64; o <<= 1) s += __shfl_xor(s, o);
            const float mean = s * (1.0f / DM); float s2 = 0.f;
#pragma unroll
            for (int j = 0; j < 4; ++j) { v[u][j] = v[u][j] - mean; s2 += (v[u][j][0] * v[u][j][0] + v[u][j][1] * v[u][j][1]) + (v[u][j][2] * v[u][j][2] + v[u][j][3] * v[u][j][3]); }
#pragma unroll
            for (int o = 1; o < 64; o <<= 1) s2 += __shfl_xor(s2, o);
            const float rstd = rsqrtf(s2 * (1.0f / DM) + LN_EPS);
            if (TO_BF16) {
                u32x2* o8 = (u32x2*)(ob + (size_t)row * DM) + lane;
#pragma unroll
                for (int j = 0; j < 4; ++j) { const f32x4 y = v[u][j] * rstd * gv[j] + bv[j]; u32x2 w; w.x = pk2(y[0], y[1]); w.y = pk2(y[2], y[3]); o8[64 * j] = w; }
                if (lane == 0) { float2 st; st.x = mean; st.y = rstd; stat[row] = st; }
            } else {
                f32x4* wr_ = (alt ? (f32x4*)(alt + (size_t)row * DM) : (f32x4*)(io + (size_t)row * DM)) + lane;
#pragma unroll
                for (int j = 0; j < 4; ++j) wr_[64 * j] = v[u][j] * rstd * gv[j] + bv[j];
            }
        }
    }
}

__device__ __forceinline__ void convgate_half(const bf16_t* HH, bf16_t* ACT, const float* cw, const float* cb, int half, int tid) {
    constexpr int NG = DFF / 8; const int total = (NT / 2) * NG;
    for (int idx = blockIdx.x * NTHR + tid; idx < total; idx += gridDim.x * NTHR) {
        const int rl = idx / NG, cg8 = idx - rl * NG, n0 = cg8 * 8, t = rl & (SEQ - 1);
        const bf16_t* hp = HH + (size_t)rl * (2 * DFF);
        float gsum[8], usum[8];
#pragma unroll
        for (int e = 0; e < 8; ++e) { gsum[e] = cb[n0 + e]; usum[e] = cb[DFF + n0 + e]; }
#pragma unroll
        for (int j = 0; j < 3; ++j) { const int tt = t + j - 1; if (tt < 0 || tt >= SEQ) continue;
            const u32x4 gq = *(const u32x4*)(hp + (ptrdiff_t)(j - 1) * (2 * DFF) + n0), uq = *(const u32x4*)(hp + (ptrdiff_t)(j - 1) * (2 * DFF) + DFF + n0);
            const float* wg = cw + (size_t)j * (2 * DFF) + n0; const float* wu = wg + DFF;
            const f32x4 wg0 = *(const f32x4*)wg, wg1 = *(const f32x4*)(wg + 4), wu0 = *(const f32x4*)wu, wu1 = *(const f32x4*)(wu + 4);
            gsum[0] += wg0[0] * lo2f(gq.x); gsum[1] += wg0[1] * hi2f(gq.x); gsum[2] += wg0[2] * lo2f(gq.y); gsum[3] += wg0[3] * hi2f(gq.y);
            gsum[4] += wg1[0] * lo2f(gq.z); gsum[5] += wg1[1] * hi2f(gq.z); gsum[6] += wg1[2] * lo2f(gq.w); gsum[7] += wg1[3] * hi2f(gq.w);
            usum[0] += wu0[0] * lo2f(uq.x); usum[1] += wu0[1] * hi2f(uq.x); usum[2] += wu0[2] * lo2f(uq.y); usum[3] += wu0[3] * hi2f(uq.y);
            usum[4] += wu1[0] * lo2f(uq.z); usum[5] += wu1[1] * hi2f(uq.z); usum[6] += wu1[2] * lo2f(uq.w); usum[7] += wu1[3] * hi2f(uq.w); }
        float a[8];
#pragma unroll
        for (int e = 0; e < 8; ++e) a[e] = gsum[e] / (1.0f + __expf(-gsum[e])) * usum[e];
        u32x4 w; w.x = pk2(a[0], a[1]); w.y = pk2(a[2], a[3]); w.z = pk2(a[4], a[5]); w.w = pk2(a[6], a[7]);
        *(u32x4*)(ACT + (size_t)(half * (NT / 2) + rl) * DFF + n0) = w;
    }
}

#define XB_TMO      128
#define XB_XCNT(j)  (256  + 64 * (j))
#define XB_XSUB(j)  (1280 + 64 * (j))
#define XB_XGEN(j)  (2304 + 64 * (j))
#define XB_TOP      3328
#define XB_TOPGEN   3392
#define XCD_BAR_WORDS 3456
#define XB_SPIN_CAP (1u << 18)

__device__ __forceinline__ unsigned xb_ld(unsigned* p)              { return __hip_atomic_load(p, __ATOMIC_RELAXED, __HIP_MEMORY_SCOPE_AGENT); }
__device__ __forceinline__ unsigned xb_add(unsigned* p, unsigned v) { return __hip_atomic_fetch_add(p, v, __ATOMIC_RELAXED, __HIP_MEMORY_SCOPE_AGENT); }
__device__ __forceinline__ unsigned xb_xcc_id() { return (unsigned)__builtin_amdgcn_s_getreg((3 << 11) | 20) & 0xFu; }
#define XB_SPIN(cond, bar) do { unsigned _sp = 0; while (cond) { __builtin_amdgcn_s_sleep(1); \
    if ((++_sp & 255u) == 0u) { if (xb_ld(&(bar)[XB_TMO])) break; if (_sp > XB_SPIN_CAP) { atomicAdd(&(bar)[XB_TMO], 1u); break; } } } } while (0)

struct XcdBarrier {
    unsigned* bar; unsigned x;
    volatile LAS unsigned* st;
};

__device__ __forceinline__ XcdBarrier xcd_barrier_post(unsigned* bar, volatile LAS unsigned* st) {
    XcdBarrier b; b.bar = bar; b.x = xb_xcc_id(); b.st = st;
    if (threadIdx.x == 0) (void)xb_add(&bar[XB_XCNT(b.x)], 1u);
    return b;
}
__device__ __forceinline__ void xcd_barrier_complete(unsigned* bar, unsigned x, unsigned& nloc, unsigned& nx) {
    const unsigned G = gridDim.x * gridDim.y * gridDim.z;
    unsigned sum, cnt, mine, sp = 0u;
    for (;;) {
        sum = 0u; cnt = 0u; mine = 0u;
#pragma unroll
        for (unsigned j = 0; j < 16; ++j) { const unsigned c = xb_ld(&bar[XB_XCNT(j)]); sum += c; cnt += (c > 0u) ? 1u : 0u; mine = (j == x) ? c : mine; }
        if (sum == G) break;
        __builtin_amdgcn_s_sleep(1);
        if ((++sp & 255u) == 0u) { if (xb_ld(&bar[XB_TMO])) break; if (sp > XB_SPIN_CAP) { atomicAdd(&bar[XB_TMO], 1u); break; } }
    }
    nloc = mine > 0u ? mine : 1u; nx = cnt > 0u ? cnt : 1u;
}

__device__ __forceinline__ void xcd_barrier(const XcdBarrier& b) {
    asm volatile("s_waitcnt vmcnt(0)" ::: "memory");
    __syncthreads();
    if (threadIdx.x == 0) {
        unsigned* bar = b.bar;
        __builtin_amdgcn_s_waitcnt(0);
        unsigned nloc = b.st[0], nx = b.st[1];
        if (nloc == 0u) { xcd_barrier_complete(bar, b.x, nloc, nx); b.st[0] = nloc; b.st[1] = nx; }
        const unsigned old = xb_add(&bar[XB_XSUB(b.x)], 1u);
        const unsigned gen = old / nloc;
        if (old + 1u == (gen + 1u) * nloc) {
            __builtin_amdgcn_fence(__ATOMIC_RELEASE, "agent");
            asm volatile("s_waitcnt vmcnt(0)" ::: "memory");
            const unsigned og = xb_add(&bar[XB_TOP], 1u);
            const unsigned tg = og / nx;
            if (og + 1u == (tg + 1u) * nx) xb_add(&bar[XB_TOPGEN], 1u);
            else XB_SPIN(xb_ld(&bar[XB_TOPGEN]) == tg, bar);
            __builtin_amdgcn_fence(__ATOMIC_ACQUIRE, "agent");
            xb_add(&bar[XB_XGEN(b.x)], 1u);
            asm volatile("s_waitcnt vmcnt(0)" ::: "memory");
        } else {
            XB_SPIN(xb_ld(&bar[XB_XGEN(b.x)]) == gen, bar);
            __builtin_amdgcn_fence(__ATOMIC_ACQUIRE, "agent");
            asm volatile("s_waitcnt vmcnt(0)" ::: "memory");
        }
    }
    __syncthreads();
}

#ifndef PH_MASK
#define PH_MASK 0xFFFFFF
#endif
#define PH(k) ((PH_MASK >> (k)) & 1)
#ifndef G5ORDER
#define G5ORDER KbOrder
#endif
#ifndef REP_P0
#define REP_P0 1
#endif
#ifndef REP_G1
#define REP_G1 1
#endif
#ifndef REP_DIFF
#define REP_DIFF 1
#endif
#ifndef REP_HY
#define REP_HY 1
#endif
#ifndef REP_MEM
#define REP_MEM 1
#endif
#ifndef REP_G3
#define REP_G3 1
#endif
#ifndef REP_G4
#define REP_G4 1
#endif
#ifndef REP_LN1
#define REP_LN1 1
#endif
struct Args { const float* in[24]; float* out; unsigned char* ws; };
__global__ void __launch_bounds__(NTHR, 2) hybrid_fwd(Args a) {
    extern __shared__ __attribute__((aligned(16))) unsigned char smem[];
    LAS unsigned char* lds = (LAS unsigned char*)smem;
    cg::grid_group grid = cg::this_grid();
    volatile LAS unsigned* bst = (volatile LAS unsigned*)(lds + 131072 + 64);
    if (threadIdx.x < 2) bst[threadIdx.x] = 0u;
    __syncthreads();
    const XcdBarrier bar = xcd_barrier_post((unsigned*)(a.ws + WS_BAR), bst);
    const int G = gridDim.x;
#define NEWPHASE() int tid_ = threadIdx.x, cu_ = blockIdx.x; asm volatile("" : "+v"(tid_)); asm volatile("" : "+s"(cu_)); const int tid = tid_, cu = cu_; (void)tid; (void)cu;
    unsigned char* ws = a.ws;
    bf16_t* WALL = (bf16_t*)(ws + WS_WALL); bf16_t* XB = (bf16_t*)(ws + WS_XB); bf16_t* MEMB = (bf16_t*)(ws + WS_MEMB); bf16_t* WKV = (bf16_t*)(ws + WS_WKV);
    bf16_t* QKM = (bf16_t*)(ws + WS_QKM); bf16_t* HT = (bf16_t*)(ws + WS_HT); bf16_t* KMEM = (bf16_t*)(ws + WS_KMEM); bf16_t* VMT = (bf16_t*)(ws + WS_VMT);
    float2* KF = (float2*)(ws + WS_KF); bf16_t* MIX = (bf16_t*)(ws + WS_MIX); float2* STAT = (float2*)(ws + WS_STAT);
    bf16_t* X1B = (bf16_t*)(ws + WS_X1B); bf16_t* HH = (bf16_t*)(ws + WS_HH); bf16_t* ACT = (bf16_t*)(ws + WS_ACT);

    for (int rep = 0; rep < REP_P0; ++rep) { NEWPHASE(); if (PH(0)) p0_prep(a.in, ws, lds, tid); }
    if (a.ws == nullptr) grid.sync();
    xcd_barrier(bar);

    for (int rep = 0; rep < REP_G1; ++rep) {
    if (PH(1)) { NEWPHASE(); pg8::Gemm g{XB, WALL, NT, 1536, DM}; pg8::StaticOrder S; S.init(g.M, g.N, G, cu);
      EpiRope E{QKM, (const float2*)(ws + WS_ROPE)};
      pg8::gemm_phase<EpiRope, pg8::StaticOrder, true, true>(lds, g, S, E); }
    if (PH(2)) { NEWPHASE(); pg8::Gemm g{WALL + (size_t)1536 * DM, XB, 2048, NT, DM}; pg8::StaticOrder S; S.init(g.M, g.N, G, cu);
      EpiB E{HT, NT};
      pg8::gemm_phase<EpiB, pg8::StaticOrder, true, true>(lds, g, S, E); }
    }
    if (PH(3)) { NEWPHASE(); const bool isK = cu < 32, on = cu < 64; const int c2 = cu - 32;
      pg8::Gemm g; EpiB E; OneUnit S;
      if (isK) { g = pg8::Gemm{MEMB, WKV, NMT, 512, DM}; E = EpiB{KMEM, 512}; S = OneUnit{cu >> 1, cu & 1, on}; }
      else { g = pg8::Gemm{WKV + (size_t)512 * DM, MEMB, 512, NMT, DM}; E = EpiB{VMT, NMT}; S = OneUnit{(c2 >> 4) & 1, c2 & 15, on}; }
      pg8::gemm_phase<EpiB, OneUnit, false, true>(lds, g, S, E);
      __syncthreads();
      if (!on) for (int it = cu - 64; it < 1024; it += G - 64) filter_fft_item((const float*)(ws + WS_HTD), KF, lds, it, tid); }
    xcd_barrier(bar);

    { NEWPHASE(); const int xcd = cu & 7, j = cu >> 3;
      float lam;
      { const float* lp = a.in[12]; const int l6 = tid & 63; float s01 = lp[l6] * lp[64 + l6], s23 = lp[128 + l6] * lp[192 + l6];
#pragma unroll
        for (int o = 1; o < 64; o <<= 1) { s01 += __shfl_xor(s01, o); s23 += __shfl_xor(s23, o); }
        lam = expf(s01) - expf(s23) + 0.2f; }
      if (PH(4)) for (int i = 0; i < 4 * REP_DIFF; ++i) {
          const int bh = ((i & 3) * 8 + xcd) * 2 + (j >> 4), qblk = j & 15, b = bh >> 2, hd = bh & 3;
          const size_t tok0 = (size_t)b * SEQ;
          attn_unit<2>(lds, QKM + (tok0 + qblk * 128) * MIXW + hd * 128, MIXW, QKM + tok0 * MIXW + 512 + hd * 128, MIXW,
                       HT + (size_t)(1536 + hd * 128) * NT + tok0, NT, SEQ, 0.125f * 1.4426950408889634f,
                       MIX + (tok0 + qblk * 128) * MIXW + 512 + hd * 128, MIXW, lam, a.in[13], tid); }
      if (PH(5)) for (int i = 0; i < 2 * REP_MEM; ++i) {
          const int bh = ((i & 1) * 8 + xcd) * 4 + (j >> 3), qblk = j & 7, b = bh >> 2, hd = bh & 3;
          const size_t tok0 = (size_t)b * SEQ;
          attn_unit<1>(lds, QKM + (tok0 + qblk * 256) * MIXW + 1024 + hd * 128, MIXW, KMEM + (size_t)b * MEMT * 512 + hd * 128, 512,
                       VMT + (size_t)(hd * 128) * NMT + b * MEMT, NMT, MEMT, 0.08838834764831845f * 1.4426950408889634f,
                       MIX + (tok0 + qblk * 256) * MIXW + 1024 + hd * 128, MIXW, 0.f, nullptr, tid); }
      if (PH(6)) for (int i = 0; i < 2 * REP_HY; ++i) {
          const int cgp = ((i & 1) * 8 + xcd) * 4 + (j >> 3), bp = j & 7;
          hyena_item(HT, KF, a.in[3], a.in[4], a.in[11], MIX, lds, bp, cgp, tid); } }
    xcd_barrier(bar);

#ifdef REP_SYNC
    for (int rep = 0; rep < REP_SYNC; ++rep) xcd_barrier(bar);
#endif
    for (int rep = 0; rep < REP_G3; ++rep) if (PH(7)) { NEWPHASE(); pg8::Gemm g{MIX, (const bf16_t*)(ws + WS_WOUT), NT, DM, MIXW}; pg8::StaticOrder S; S.init(g.M, g.N, G, cu);
      EpiRes E{a.in[0], a.out};
      pg8::gemm_phase<EpiRes, pg8::StaticOrder, true, true>(lds, g, S, E); }
    xcd_barrier(bar);
    for (int rep = 0; rep < REP_LN1; ++rep) if (PH(8)) { NEWPHASE(); ln_rows<true>(a.out, X1B, STAT, a.in[16], a.in[17], tid); }
    xcd_barrier(bar);
    for (int rep = 0; rep < REP_G4; ++rep) if (PH(9)) { NEWPHASE(); pg8::Gemm g{X1B, (const bf16_t*)(ws + WS_WUP), FFN_MT * 256, 2 * DFF, DM}; FfnOrder S; S.init(g.M, g.N, G, cu); S.cw = a.in[19]; S.cb = a.in[20]; S.lds = lds; S.cnt = 0;
      EpiFfn E{ACT, lds, 0};
      pg8::gemm_phase<EpiFfn, FfnOrder, true, true>(lds, g, S, E); }
    xcd_barrier(bar);
    if (PH(11)) { NEWPHASE(); pg8::Gemm g{ACT, (const bf16_t*)(ws + WS_WDN), NT, DM, DFF}; G5ORDER S; S.init(g.M, g.N, G, cu);
      EpiRes2 E{a.out, a.out, STAT, a.in[16], a.in[17]};
#ifdef REP_G5
      { EpiRes2 E2{a.out, (float*)(ws + WS_HH), STAT, a.in[16], a.in[17]}; pg8::gemm_phase<EpiRes2, G5ORDER, true, true>(lds, g, S, E2); xcd_barrier(bar); }
#endif
      pg8::gemm_phase<EpiRes2, G5ORDER, true, true>(lds, g, S, E); }
    xcd_barrier(bar);
#ifdef REP_LN2
    { NEWPHASE(); ln_rows<false>(a.out, nullptr, nullptr, a.in[22], a.in[23], tid, (float*)(ws + WS_HH)); xcd_barrier(bar); }
#endif
    if (PH(12)) { NEWPHASE(); ln_rows<false>(a.out, nullptr, nullptr, a.in[22], a.in[23], tid); }
}

extern "C" void kernel_launch(void* const* d_in, const int* in_sizes, int n_in, void* d_out, int out_size, void* d_ws, size_t ws_size, hipStream_t stream) {
    static int grid = 0;
    if (grid == 0) {
        if (n_in != 24 || out_size != NT * DM || ws_size < WS_END) { fprintf(stderr, "kernel_launch: unexpected shapes (n_in %d, out %d, ws %zu)\n", n_in, out_size, ws_size); grid = -1; return; }
        int dev = 0, cus = 0, per_cu = 0;
        hipGetDevice(&dev); hipDeviceGetAttribute(&cus, hipDeviceAttributeMultiprocessorCount, dev);
        if (hipFuncSetAttribute((const void*)hybrid_fwd, hipFuncAttributeMaxDynamicSharedMemorySize, LDS_BYTES) != hipSuccess) { fprintf(stderr, "kernel_launch: hipFuncSetAttribute failed\n"); grid = -1; return; }
        if (hipOccupancyMaxActiveBlocksPerMultiprocessor(&per_cu, (const void*)hybrid_fwd, NTHR, LDS_BYTES) != hipSuccess || per_cu < 1) { fprintf(stderr, "kernel_launch: occupancy query says %d\n", per_cu); per_cu = 1; }
        (void)hipGetLastError();
        grid = cus * per_cu;
        fprintf(stderr, "kernel_launch: grid %d (cus %d x %d)\n", grid, cus, per_cu);
    }
    if (grid < 0) return;
    if (hipMemsetAsync((char*)d_ws + WS_BAR, 0, XCD_BAR_WORDS * 4, stream) != hipSuccess) { fprintf(stderr, "kernel_launch: memset failed\n"); return; }
    Args a{};
    for (int i = 0; i < 24; ++i) a.in[i] = (const float*)d_in[i];
    a.out = (float*)d_out; a.ws = (unsigned char*)d_ws;
    void* args[] = {&a};
    const hipError_t e = hipLaunchCooperativeKernel((const void*)hybrid_fwd, dim3(grid), dim3(NTHR), args, LDS_BYTES, stream);
    if (e != hipSuccess) fprintf(stderr, "kernel_launch: cooperative launch failed: %s (grid %d)\n", hipGetErrorString(e), grid);
}
```

```cpp
#include <hip/hip_runtime.h>
#include <hip/hip_cooperative_groups.h>
#include <cstdio>
#include <cstdint>
namespace cg = cooperative_groups;
#define LAS __attribute__((address_space(3)))
namespace pg8 {
#define PG8_LAS __attribute__((address_space(3)))
typedef unsigned short bf16_t;
typedef short bf16x8 __attribute__((ext_vector_type(8)));
typedef float f32x4 __attribute__((ext_vector_type(4)));
typedef unsigned u32x4 __attribute__((ext_vector_type(4)));
constexpr int BM = 256, BK = 64, HALF = 128, HTB = HALF * BK * 2  , STAGE_BYTES = 8 * HTB, NXCD = 8, WGM = 8;

__host__ __device__ __forceinline__ int lds_byte(int r, int c) { const int st = (r >> 4) * 2 + (c >> 5), rr = r & 15, cc = c & 31, ob = rr * 64 + cc * 2; return st * 1024 + (ob ^ (((ob >> 9) & 1) << 5)); }
__host__ __device__ __forceinline__ void stage_rc(int b, int& R, int& C) { const int st = b / 1024, sb = b % 1024, swz = sb ^ (((sb >> 9) & 1) << 5); R = (st >> 1) * 16 + swz / 64; C = (st & 1) * 32 + (swz % 64) / 2; }
__host__ __device__ __forceinline__ int perm32(int rho) { const int n = rho >> 4, i = rho & 15; return 8 * (i >> 2) + 4 * n + (i & 3); }

struct Unit { int pm, pn; };
struct Gemm { const bf16_t* A; const bf16_t* Bt; int M, N, K; };

struct StaticOrder {
    int nM, nN, nwg, G, c;
    __host__ __device__ void init(int M, int N, int G_, int c_) { nM = M / BM; nN = N / BM; nwg = nM * nN; G = G_; c = c_; }
    __host__ __device__ bool next(int i, Unit& u) const {
        const long L = (long)i * G + c; if (L >= nwg) return false;
        int wgid = (int)L; { const int q = nwg / NXCD, r = nwg % NXCD, xcd = wgid % NXCD, off = wgid / NXCD; wgid = (xcd < r ? xcd * (q + 1) : r * (q + 1) + (xcd - r) * q) + off; }
        const int nig = WGM * nN, gid = wgid / nig, fm = gid * WGM, gsz = (nM - fm) < WGM ? (nM - fm) : WGM;
        u.pm = fm + ((wgid % nig) % gsz); u.pn = (wgid % nig) / gsz; return true;
    }
    __device__ __forceinline__ void a_ready(const Unit&) const {}
    __device__ __forceinline__ void done(const Unit&) const {}
    __device__ __forceinline__ long a_off(const Unit& u, size_t tstep) const { return (long)((size_t)u.pm * tstep); }
    __device__ __forceinline__ int lda(int K) const { return K; }
    __device__ __forceinline__ size_t kstep_a() const { return (size_t)(BK * 2); }
};
template <class Epi, class Sched, bool ALIGN_EPI = false, bool SP2 = false>
__device__ __forceinline__ void gemm_phase(PG8_LAS unsigned char* lds, const Gemm g, const Sched& S, const Epi& E) {
    int tid_l = threadIdx.x; asm volatile("" : "+v"(tid_l)); const int tid = tid_l, wid = __builtin_amdgcn_readfirstlane(tid >> 6), lane = tid & 63, wr = wid >> 2, wc = wid & 3, fr = lane & 15, fq = lane >> 4;
    const int K = g.K, nt = K / BK;
    unsigned voffA[2], voffB[2];
    const int lda = S.lda(K);
#pragma unroll
    for (int i = 0; i < 2; ++i) { int R, C; stage_rc(tid * 16 + i * 8192, R, C); const int Rb = Epi::PERM ? ((R & ~31) + perm32(R & 31)) : R;
        voffA[i] = (unsigned)(R * lda + C) * 2u; voffB[i] = (unsigned)(Rb * K + C) * 2u; }
    const size_t kstep = (size_t)(BK * 2);
    const size_t hstep = (size_t)HALF * K * 2;
    const size_t tstep = 2 * hstep;
    const size_t kstepA = S.kstep_a(), hstepA = (size_t)HALF * lda * 2, tstepA = 2 * hstepA;
    const unsigned ldsw = (unsigned)wid * 1024u;
    const int aoff = lds_byte(wr * 64 + fr, fq * 8), boff = lds_byte(wc * 32 + fr, fq * 8);
#define PG8_SA(b, h) (((b) * 2 + (h)) * HTB)
#define PG8_SB(b, h) ((4 + (b) * 2 + (h)) * HTB)
#define PG8_STAGE(bufoff, gbase, voff) do { _Pragma("unroll") for (int _i = 0; _i < 2; ++_i) \
        __builtin_amdgcn_global_load_lds((const unsigned*)((const char*)(gbase) + (voff)[_i]), (PG8_LAS unsigned*)(lds + (bufoff) + ldsw + _i * 8192), 16, 0, 0); } while (0)
#define PG8_LDA(dst, b, h) do { _Pragma("unroll") for (int m = 0; m < 4; ++m) _Pragma("unroll") for (int k = 0; k < 2; ++k) dst[m][k] = *(const PG8_LAS bf16x8*)(lds + PG8_SA(b, h) + aoff + m * 2048 + k * 1024); } while (0)
#define PG8_LDB(dst, b, h) do { _Pragma("unroll") for (int n = 0; n < 2; ++n) _Pragma("unroll") for (int k = 0; k < 2; ++k) dst[n][k] = *(const PG8_LAS bf16x8*)(lds + PG8_SB(b, h) + boff + n * 2048 + k * 1024); } while (0)
#define PG8_MMA(ai, bj, At, Bt) do { __builtin_amdgcn_s_setprio(1); _Pragma("unroll") for (int m = 0; m < 4; ++m) _Pragma("unroll") for (int n = 0; n < 2; ++n) _Pragma("unroll") for (int k = 0; k < 2; ++k) \
        acc[ai][bj][m][n] = __builtin_amdgcn_mfma_f32_16x16x32_bf16(Bt[n][k], At[m][k], acc[ai][bj][m][n], 0, 0, 0); __builtin_amdgcn_s_setprio(0); } while (0)
#define PG8_WAIT_V(n) asm volatile("s_waitcnt vmcnt(" #n ")" ::: "memory")
#define PG8_WAIT_L(n) asm volatile("s_waitcnt lgkmcnt(" #n ")" ::: "memory")
#define PG8_BAR __builtin_amdgcn_s_barrier()
#define PG8_SCHED __builtin_amdgcn_sched_barrier(0)
    Unit cur, nxt; int ui = 0;
    if (!S.next(0, cur)) return;
    f32x4 acc[2][2][4][2];
#pragma unroll
    for (int a = 0; a < 2; ++a)
#pragma unroll
        for (int b = 0; b < 2; ++b)
#pragma unroll
            for (int m = 0; m < 4; ++m)
#pragma unroll
                for (int n = 0; n < 2; ++n) acc[a][b][m][n] = (f32x4){0.f, 0.f, 0.f, 0.f};
    bf16x8 At[4][2], B0[2][2], B1[2][2];
    const char* cA = (const char*)g.A + S.a_off(cur, tstepA); const char* cB = (const char*)g.Bt + (size_t)cur.pn * tstep;
    S.a_ready(cur);
    if constexpr (SP2) {
        PG8_STAGE(PG8_SB(0, 0), cB, voffB); PG8_STAGE(PG8_SB(0, 1), cB + hstep, voffB); PG8_STAGE(PG8_SA(0, 0), cA, voffA); PG8_STAGE(PG8_SA(0, 1), cA + hstepA, voffA);
        if (wr == 1) PG8_BAR;
        PG8_WAIT_V(2); PG8_BAR;
        PG8_STAGE(PG8_SB(1, 0), cB + kstep, voffB); PG8_STAGE(PG8_SA(1, 0), cA + kstepA, voffA); PG8_STAGE(PG8_SB(1, 1), cB + hstep + kstep, voffB);
        PG8_WAIT_V(6); PG8_BAR;
    } else {
        PG8_STAGE(PG8_SB(0, 0), cB, voffB); PG8_STAGE(PG8_SA(0, 0), cA, voffA); PG8_STAGE(PG8_SB(0, 1), cB + hstep, voffB); PG8_STAGE(PG8_SA(0, 1), cA + hstepA, voffA);
        if (wr == 1) PG8_BAR;
        PG8_WAIT_V(4); PG8_BAR;
        PG8_STAGE(PG8_SB(1, 0), cB + kstep, voffB); PG8_STAGE(PG8_SA(1, 0), cA + kstepA, voffA); PG8_STAGE(PG8_SB(1, 1), cB + hstep + kstep, voffB);
        PG8_WAIT_V(6); PG8_BAR;
    }
    for (;;) {
        const bool has_next = S.next(ui + 1, nxt);
        const char* nA = has_next ? (const char*)g.A + S.a_off(nxt, tstepA) : cA; const char* nB = has_next ? (const char*)g.Bt + (size_t)nxt.pn * tstep : cB;
        for (int t = 0; t < nt; t += 2) {
            const bool last = (t == nt - 2);
            const char* a1 = cA + (size_t)(t + 1) * kstepA;
            const char* a2 = last ? nA : cA + (size_t)(t + 2) * kstepA; const char* b2 = last ? nB : cB + (size_t)(t + 2) * kstep;
            const char* a3 = a2 + kstepA; const char* b3 = b2 + kstep;
            if (last && has_next) S.a_ready(nxt);
            if constexpr (SP2) {
            PG8_LDB(B0, 0, 0); PG8_LDB(B1, 0, 1); PG8_SCHED; PG8_LDA(At, 0, 0); PG8_STAGE(PG8_SA(1, 1), a1 + hstepA, voffA);
            PG8_WAIT_V(8); PG8_WAIT_L(0); PG8_BAR; PG8_MMA(0, 0, At, B0); PG8_MMA(0, 1, At, B1); PG8_BAR; PG8_SCHED;
            PG8_LDA(At, 0, 1); PG8_STAGE(PG8_SB(0, 0), b2, voffB); PG8_STAGE(PG8_SB(0, 1), b2 + hstep, voffB); PG8_STAGE(PG8_SA(0, 0), a2, voffA);
            PG8_WAIT_V(8); PG8_WAIT_L(0); PG8_BAR; PG8_MMA(1, 0, At, B0); PG8_MMA(1, 1, At, B1); PG8_BAR; PG8_SCHED;
            PG8_LDB(B0, 1, 0); PG8_LDB(B1, 1, 1); PG8_SCHED; PG8_LDA(At, 1, 0); PG8_STAGE(PG8_SA(0, 1), a2 + hstepA, voffA);
            PG8_WAIT_V(8); PG8_WAIT_L(0); PG8_BAR; PG8_MMA(0, 0, At, B0); PG8_MMA(0, 1, At, B1); PG8_BAR; PG8_SCHED;
            PG8_LDA(At, 1, 1); PG8_STAGE(PG8_SB(1, 0), b3, voffB); PG8_STAGE(PG8_SB(1, 1), b3 + hstep, voffB); PG8_STAGE(PG8_SA(1, 0), a3, voffA);
            PG8_WAIT_V(8); PG8_WAIT_L(0); PG8_BAR; PG8_MMA(1, 0, At, B0); PG8_MMA(1, 1, At, B1); PG8_BAR; PG8_SCHED;
            } else {
            PG8_LDB(B0, 0, 0); PG8_SCHED; PG8_LDA(At, 0, 0); PG8_STAGE(PG8_SA(1, 1), a1 + hstepA, voffA);
            PG8_WAIT_L(8); PG8_BAR; PG8_WAIT_L(0); PG8_MMA(0, 0, At, B0); PG8_BAR; PG8_SCHED;
            PG8_LDB(B1, 0, 1); PG8_STAGE(PG8_SB(0, 0), b2, voffB);
            PG8_BAR; PG8_WAIT_L(0); PG8_MMA(0, 1, At, B1); PG8_BAR;
            PG8_LDA(At, 0, 1); PG8_STAGE(PG8_SA(0, 0), a2, voffA);
            PG8_BAR; PG8_WAIT_L(0); PG8_MMA(1, 0, At, B0); PG8_BAR; PG8_SCHED;
            PG8_STAGE(PG8_SB(0, 1), b2 + hstep, voffB);
            PG8_WAIT_V(6); PG8_BAR; PG8_MMA(1, 1, At, B1); PG8_BAR;
            PG8_LDB(B0, 1, 0); PG8_SCHED; PG8_LDA(At, 1, 0); PG8_STAGE(PG8_SA(0, 1), a2 + hstepA, voffA);
            PG8_WAIT_L(8); PG8_BAR; PG8_WAIT_L(0); PG8_MMA(0, 0, At, B0); PG8_BAR; PG8_SCHED;
            PG8_LDB(B1, 1, 1); PG8_STAGE(PG8_SB(1, 0), b3, voffB);
            PG8_BAR; PG8_WAIT_L(0); PG8_MMA(0, 1, At, B1); PG8_BAR;
            PG8_LDA(At, 1, 1); PG8_STAGE(PG8_SA(1, 0), a3, voffA);
            PG8_BAR; PG8_WAIT_L(0); PG8_MMA(1, 0, At, B0); PG8_BAR; PG8_SCHED;
            PG8_STAGE(PG8_SB(1, 1), b3 + hstep, voffB);
            PG8_WAIT_V(6); PG8_BAR; PG8_MMA(1, 1, At, B1); PG8_BAR;
            }
        }
        if constexpr (ALIGN_EPI) { if (wr == 0) PG8_BAR; }
        if constexpr (!Epi::AFTER_DRAIN) { E(acc, cur, wr, wc, fr, fq); S.done(cur); }
        if (!has_next) break;
#pragma unroll
        for (int a = 0; a < 2; ++a)
#pragma unroll
            for (int b = 0; b < 2; ++b)
#pragma unroll
                for (int m = 0; m < 4; ++m)
#pragma unroll
                    for (int n = 0; n < 2; ++n) acc[a][b][m][n] = (f32x4){0.f, 0.f, 0.f, 0.f};
        cur = nxt; cA = nA; cB = nB; ++ui;
        if constexpr (ALIGN_EPI) { if (wr == 1) PG8_BAR; }
    }
    PG8_WAIT_V(0);
    if constexpr (!ALIGN_EPI) { if (wr == 0) PG8_BAR; }
    PG8_BAR;
    if constexpr (Epi::AFTER_DRAIN) { E.fused(acc, cur, wr, wc, fr, fq, lds, wid, lane); S.done(cur); }
#undef PG8_SA
#undef PG8_SB
#undef PG8_STAGE
#undef PG8_LDA
#undef PG8_LDB
#undef PG8_MMA
#undef PG8_WAIT_V
#undef PG8_WAIT_L
#undef PG8_BAR
#undef PG8_SCHED
}
}

using pg8::bf16_t; using pg8::bf16x8; using pg8::f32x4; using pg8::u32x4;
typedef float f32x16 __attribute__((ext_vector_type(16)));
typedef unsigned u32x2 __attribute__((ext_vector_type(2)));
typedef short bf16x4 __attribute__((ext_vector_type(4)));

constexpr int NB = 16, SEQ = 2048, DM = 1024, NT = NB * SEQ, MEMT = 256, NMT = NB * MEMT, HW = 512, INW = 3584, DFF = 2816, MIXW = 1536;
constexpr float ALPHA = 1.189207115002721f;
constexpr float LN_EPS = 1e-5f, RMS_EPS = 1e-5f;
constexpr int NTHR = 512, NWAVE = 8;
constexpr int LDS_BYTES = 151552;

constexpr size_t MiB = 1048576;
constexpr size_t WS_WALL = 0;
constexpr size_t WS_WKV  = 7 * MiB;
constexpr size_t WS_WOUT = 9 * MiB;
constexpr size_t WS_WUP  = 12 * MiB;
constexpr size_t WS_WDN  = 23 * MiB;
constexpr size_t WS_ROPE = 29 * MiB;
constexpr size_t WS_STAT = 29 * MiB + 524288;
constexpr size_t WS_XB   = 30 * MiB;
constexpr size_t WS_X1B  = 30 * MiB;
constexpr size_t WS_HTD  = 94 * MiB;
constexpr size_t WS_MEMB = 110 * MiB;
constexpr size_t WS_QKM  = 118 * MiB;
constexpr size_t WS_HT   = 214 * MiB;
constexpr size_t WS_KMEM = 342 * MiB;
constexpr size_t WS_VMT  = 346 * MiB;
constexpr size_t WS_KF   = 350 * MiB;
constexpr size_t WS_MIX  = 382 * MiB;
constexpr size_t WS_HH   = 96 * MiB;
constexpr size_t WS_ACT  = 272 * MiB;
constexpr size_t WS_BAR  = 478 * MiB;
constexpr size_t WS_END  = 478 * MiB + 65536;

__device__ __forceinline__ unsigned pk2(float lo, float hi) { unsigned r; asm volatile("v_cvt_pk_bf16_f32 %0, %1, %2" : "=v"(r) : "v"(lo), "v"(hi)); return r; }
__device__ __forceinline__ float bf2f(bf16_t v) { return __uint_as_float((unsigned)v << 16); }
__device__ __forceinline__ float lo2f(unsigned v) { return __uint_as_float(v << 16); }
__device__ __forceinline__ float hi2f(unsigned v) { return __uint_as_float(v & 0xffff0000u); }
#define LDS_WAIT() asm volatile("s_waitcnt lgkmcnt(0)" ::: "memory")

#ifndef FFT_HOST
#define FFT_FN __device__ __forceinline__
#define FFT_SYNC() __syncthreads()
typedef float cplx __attribute__((ext_vector_type(2)));
typedef LAS cplx* fftbuf_t;
FFT_FN float cos2pi(float r) { return __builtin_amdgcn_cosf(r); }
FFT_FN float sin2pi(float r) { return __builtin_amdgcn_sinf(r); }
#endif
FFT_FN cplx mk2(float x, float y) { cplx r; r.x = x; r.y = y; return r; }
FFT_FN cplx cadd(cplx a, cplx b) { return mk2(a.x + b.x, a.y + b.y); }
FFT_FN cplx csub(cplx a, cplx b) { return mk2(a.x - b.x, a.y - b.y); }
FFT_FN cplx cmul(cplx a, cplx b) { return mk2(a.x * b.x - a.y * b.y, a.x * b.y + a.y * b.x); }
template <bool INV> FFT_FN cplx muli(cplx a) { return INV ? mk2(-a.y, a.x) : mk2(a.y, -a.x); }
FFT_FN int padi(int i) { return i + (i >> 3); }

template <bool INV> FFT_FN void dft8(cplx (&v)[8]) {
    const float R = 0.70710678118654752f;
    const cplx a0 = cadd(v[0], v[4]), a1 = csub(v[0], v[4]), a2 = cadd(v[2], v[6]), a3 = muli<INV>(csub(v[2], v[6]));
    const cplx a4 = cadd(v[1], v[5]), a5 = csub(v[1], v[5]), a6 = cadd(v[3], v[7]), a7 = muli<INV>(csub(v[3], v[7]));
    const cplx b0 = cadd(a0, a2), b2 = csub(a0, a2), b1 = cadd(a1, a3), b3 = csub(a1, a3);
    const cplx b4 = cadd(a4, a6), b6 = muli<INV>(csub(a4, a6));
    const cplx t5 = cadd(a5, a7), t7 = csub(a5, a7);
    cplx b5, b7;
    if (!INV) { b5 = mk2((t5.x + t5.y) * R, (t5.y - t5.x) * R); b7 = mk2((t7.y - t7.x) * R, -(t7.x + t7.y) * R); }
    else      { b5 = mk2((t5.x - t5.y) * R, (t5.x + t5.y) * R); b7 = mk2(-(t7.x + t7.y) * R, (t7.x - t7.y) * R); }
    v[0] = cadd(b0, b4); v[4] = csub(b0, b4); v[1] = cadd(b1, b5); v[5] = csub(b1, b5);
    v[2] = cadd(b2, b6); v[6] = csub(b2, b6); v[3] = cadd(b3, b7); v[7] = csub(b3, b7);
}
template <int S, bool INV> FFT_FN void twid(cplx (&v)[8], int tid) {
    if (S > 1) {
        const int j = tid % S; const float rev = (float)j * (1.0f / (8.0f * S));
        const float c = cos2pi(rev), s = sin2pi(rev);
        const cplx w1 = mk2(c, INV ? s : -s);
        const cplx w2 = cmul(w1, w1), w3 = cmul(w2, w1), w4 = cmul(w2, w2), w5 = cmul(w4, w1), w6 = cmul(w4, w2), w7 = cmul(w4, w3);
        v[1] = cmul(v[1], w1); v[2] = cmul(v[2], w2); v[3] = cmul(v[3], w3); v[4] = cmul(v[4], w4);
        v[5] = cmul(v[5], w5); v[6] = cmul(v[6], w6); v[7] = cmul(v[7], w7);
    }
}
template <int S> FFT_FN void ld8(fftbuf_t X, int tid, cplx (&v)[8]) {
    const int base = (tid / S) * 8 * S + (tid % S);
#pragma unroll
    for (int k = 0; k < 8; ++k) v[k] = X[padi(base + S * k)];
}
template <int S> FFT_FN void st8(fftbuf_t X, int tid, const cplx (&v)[8]) {
    const int base = (tid / S) * 8 * S + (tid % S);
#pragma unroll
    for (int k = 0; k < 8; ++k) X[padi(base + S * k)] = v[k];
}
#ifndef FFT_HOST
template <int S> FFT_FN void twid_fill(fftbuf_t TW, int tid) {
    constexpr int P = (S == 512) ? 0 : (S == 64) ? 1 : 2;
    const int j = tid % S; const float rev = (float)j * (1.0f / (8.0f * S));
    const cplx w1 = mk2(cos2pi(rev), -sin2pi(rev)), w2 = cmul(w1, w1), w4 = cmul(w2, w2);
    TW[(3 * P + 0) * 512 + tid] = w1; TW[(3 * P + 1) * 512 + tid] = w2; TW[(3 * P + 2) * 512 + tid] = w4;
}
template <int S, bool INV> FFT_FN void twidL(cplx (&v)[8], fftbuf_t TW, int tid) {
    constexpr int P = (S == 512) ? 0 : (S == 64) ? 1 : 2;
    cplx w1 = TW[(3 * P + 0) * 512 + tid], w2 = TW[(3 * P + 1) * 512 + tid], w4 = TW[(3 * P + 2) * 512 + tid];
    if (INV) { w1.y = -w1.y; w2.y = -w2.y; w4.y = -w4.y; }
    const cplx w3 = cmul(w2, w1), w5 = cmul(w4, w1), w6 = cmul(w4, w2), w7 = cmul(w4, w3);
    v[1] = cmul(v[1], w1); v[2] = cmul(v[2], w2); v[3] = cmul(v[3], w3); v[4] = cmul(v[4], w4);
    v[5] = cmul(v[5], w5); v[6] = cmul(v[6], w6); v[7] = cmul(v[7], w7);
}
FFT_FN void fft_fwdL(fftbuf_t X, fftbuf_t TW, int tid, cplx (&v)[8]) {
    dft8<false>(v); twidL<512, false>(v, TW, tid); st8<512>(X, tid, v); FFT_SYNC();
    ld8<64>(X, tid, v); dft8<false>(v); twidL<64, false>(v, TW, tid); st8<64>(X, tid, v); FFT_SYNC();
    ld8<8>(X, tid, v); dft8<false>(v); twidL<8, false>(v, TW, tid); st8<8>(X, tid, v); FFT_SYNC();
    ld8<1>(X, tid, v); dft8<false>(v);
}
FFT_FN void fft_invL(fftbuf_t X, fftbuf_t TW, int tid, cplx (&v)[8]) {
    dft8<true>(v); st8<1>(X, tid, v); FFT_SYNC();
    ld8<8>(X, tid, v); twidL<8, true>(v, TW, tid); dft8<true>(v); st8<8>(X, tid, v); FFT_SYNC();
    ld8<64>(X, tid, v); twidL<64, true>(v, TW, tid); dft8<true>(v); st8<64>(X, tid, v); FFT_SYNC();
    ld8<512>(X, tid, v); twidL<512, true>(v, TW, tid); dft8<true>(v);
}
FFT_FN void fft_fwd(fftbuf_t X, int tid, cplx (&v)[8]) {
    dft8<false>(v); twid<512, false>(v, tid); st8<512>(X, tid, v); FFT_SYNC();
    ld8<64>(X, tid, v); dft8<false>(v); twid<64, false>(v, tid); st8<64>(X, tid, v); FFT_SYNC();
    ld8<8>(X, tid, v); dft8<false>(v); twid<8, false>(v, tid); st8<8>(X, tid, v); FFT_SYNC();
    ld8<1>(X, tid, v); dft8<false>(v);
}
FFT_FN void fft_inv(fftbuf_t X, int tid, cplx (&v)[8]) {
    dft8<true>(v); st8<1>(X, tid, v); FFT_SYNC();
    ld8<8>(X, tid, v); twid<8, true>(v, tid); dft8<true>(v); st8<8>(X, tid, v); FFT_SYNC();
    ld8<64>(X, tid, v); twid<64, true>(v, tid); dft8<true>(v); st8<64>(X, tid, v); FFT_SYNC();
    ld8<512>(X, tid, v); twid<512, true>(v, tid); dft8<true>(v);
}
#endif

struct OneUnit { int pm, pn; bool on;
    __device__ __forceinline__ bool next(int i, pg8::Unit& u) const { if (!on || i > 0) return false; u.pm = pm; u.pn = pn; return true; }
    __device__ __forceinline__ void a_ready(const pg8::Unit&) const {}
    __device__ __forceinline__ void done(const pg8::Unit&) const {}
    __device__ __forceinline__ long a_off(const pg8::Unit& u, size_t tstep) const { return (long)((size_t)u.pm * tstep); }
    __device__ __forceinline__ int lda(int K) const { return K; }
    __device__ __forceinline__ size_t kstep_a() const { return 128; } };

struct EpiB {
    static constexpr bool PERM = true, AFTER_DRAIN = false;
    bf16_t* O; int ldc;
    __device__ __forceinline__ void operator()(const f32x4 (&acc)[2][2][4][2], const pg8::Unit& u, int wr, int wc, int fr, int fq) const {
        const int row0 = u.pm * 256 + wr * 64 + fr, col0 = u.pn * 256 + wc * 32 + 8 * fq;
#pragma unroll
        for (int ai = 0; ai < 2; ++ai)
#pragma unroll
            for (int m = 0; m < 4; ++m) { bf16_t* rowp = O + (size_t)(row0 + ai * 128 + m * 16) * ldc + col0;
#pragma unroll
                for (int bj = 0; bj < 2; ++bj) { const f32x4 v0 = acc[ai][bj][m][0], v1 = acc[ai][bj][m][1];
                    u32x4 w; w.x = pk2(v0[0], v0[1]); w.y = pk2(v0[2], v0[3]); w.z = pk2(v1[0], v1[1]); w.w = pk2(v1[2], v1[3]);
                    *(u32x4*)(rowp + bj * 128) = w; } }
    }
};
struct EpiRope {
    static constexpr bool PERM = true, AFTER_DRAIN = false;
    bf16_t* O; const float2* rope;
    __device__ __forceinline__ void operator()(const f32x4 (&acc)[2][2][4][2], const pg8::Unit& u, int wr, int wc, int fr, int fq) const {
        const int row0 = u.pm * 256 + wr * 64 + fr, col0 = u.pn * 256 + wc * 32 + 8 * fq;
        const bool rot = u.pn < 4;
#pragma unroll
        for (int ai = 0; ai < 2; ++ai)
#pragma unroll
            for (int m = 0; m < 4; ++m) { const int row = row0 + ai * 128 + m * 16; bf16_t* rowp = O + (size_t)row * MIXW + col0;
#pragma unroll
                for (int bj = 0; bj < 2; ++bj) { f32x4 v0 = acc[ai][bj][m][0], v1 = acc[ai][bj][m][1];
                    if (rot) { const int pos = row & (SEQ - 1), i0 = ((col0 + bj * 128) & 63) >> 1;
                        const f32x4* rp = (const f32x4*)(rope + pos * 32 + i0); const f32x4 r0 = rp[0], r1 = rp[1];
                        f32x4 o0, o1;
                        o0[0] = v0[0] * r0[0] - v0[1] * r0[1]; o0[1] = v0[1] * r0[0] + v0[0] * r0[1];
                        o0[2] = v0[2] * r0[2] - v0[3] * r0[3]; o0[3] = v0[3] * r0[2] + v0[2] * r0[3];
                        o1[0] = v1[0] * r1[0] - v1[1] * r1[1]; o1[1] = v1[1] * r1[0] + v1[0] * r1[1];
                        o1[2] = v1[2] * r1[2] - v1[3] * r1[3]; o1[3] = v1[3] * r1[2] + v1[2] * r1[3];
                        v0 = o0; v1 = o1; }
                    u32x4 w; w.x = pk2(v0[0], v0[1]); w.y = pk2(v0[2], v0[3]); w.z = pk2(v1[0], v1[1]); w.w = pk2(v1[2], v1[3]);
                    *(u32x4*)(rowp + bj * 128) = w; } }
    }
};
struct EpiRes {
    static constexpr bool PERM = false, AFTER_DRAIN = false;
    const float* X; float* O;
    __device__ __forceinline__ void operator()(const f32x4 (&acc)[2][2][4][2], const pg8::Unit& u, int wr, int wc, int fr, int fq) const {
        const int row0 = u.pm * 256 + wr * 64 + fr, col0 = u.pn * 256 + wc * 32 + 4 * fq;
#pragma unroll
        for (int ai = 0; ai < 2; ++ai) {
            f32x4 xv[4][2][2];
#pragma unroll
            for (int m = 0; m < 4; ++m)
#pragma unroll
                for (int bj = 0; bj < 2; ++bj)
#pragma unroll
                    for (int n = 0; n < 2; ++n) xv[m][bj][n] = *(const f32x4*)(X + (size_t)(row0 + ai * 128 + m * 16) * DM + col0 + bj * 128 + 16 * n);
            asm volatile("" ::: "memory");
#pragma unroll
            for (int m = 0; m < 4; ++m)
#pragma unroll
                for (int bj = 0; bj < 2; ++bj)
#pragma unroll
                    for (int n = 0; n < 2; ++n) *(f32x4*)(O + (size_t)(row0 + ai * 128 + m * 16) * DM + col0 + bj * 128 + 16 * n) = acc[ai][bj][m][n] + xv[m][bj][n] * ALPHA;
        }
    }
};
struct EpiRes2 {
    static constexpr bool PERM = false, AFTER_DRAIN = false;
    const float* R; float* O; const float2* stat; const float* g; const float* b;
    __device__ __forceinline__ void operator()(const f32x4 (&acc)[2][2][4][2], const pg8::Unit& u, int wr, int wc, int fr, int fq) const {
        const int row0 = u.pm * 256 + wr * 64 + fr, col0 = u.pn * 256 + wc * 32 + 4 * fq;
#pragma unroll
        for (int ai = 0; ai < 2; ++ai)
#pragma unroll
            for (int bj = 0; bj < 2; ++bj) {
                f32x4 rv[4][2], gv[2], bv[2]; float2 st[4];
#pragma unroll
                for (int m = 0; m < 4; ++m) { const int row = row0 + ai * 128 + m * 16; st[m] = stat[row];
#pragma unroll
                    for (int n = 0; n < 2; ++n) rv[m][n] = *(const f32x4*)(R + (size_t)row * DM + col0 + bj * 128 + 16 * n); }
#pragma unroll
                for (int n = 0; n < 2; ++n) { gv[n] = *(const f32x4*)(g + col0 + bj * 128 + 16 * n); bv[n] = *(const f32x4*)(b + col0 + bj * 128 + 16 * n); }
                asm volatile("" ::: "memory");
#pragma unroll
                for (int m = 0; m < 4; ++m)
#pragma unroll
                    for (int n = 0; n < 2; ++n) { const f32x4 x1 = (rv[m][n] - st[m].x) * st[m].y * gv[n] + bv[n];
                        *(f32x4*)(O + (size_t)(row0 + ai * 128 + m * 16) * DM + col0 + bj * 128 + 16 * n) = acc[ai][bj][m][n] + x1 * ALPHA; }
            }
    }
};

struct KbOrder : pg8::StaticOrder {
    __device__ __forceinline__ int lda(int) const { return 64; }
    __device__ __forceinline__ size_t kstep_a() const { return (size_t)NT * 64 * 2; }
};
struct RevOrder : pg8::StaticOrder {
    __device__ __forceinline__ bool next(int i, pg8::Unit& u) const { const int rounds = (nwg + G - 1) / G; if (i >= rounds) return false; return pg8::StaticOrder::next(rounds - 1 - i, u); }
};
constexpr int CWL_OFF = 131072 + 1024 + 8192;
struct FfnOrder : pg8::StaticOrder {
    const float* cw; const float* cb; LAS unsigned char* lds; mutable int cnt;
    __device__ __forceinline__ long a_off(const pg8::Unit& u, size_t) const { return ((long)u.pm * 254 - 1) * (long)(DM * 2); }
    __device__ __forceinline__ void a_ready(const pg8::Unit& u) const {
        const int tid = threadIdx.x, w = __builtin_amdgcn_readfirstlane(tid >> 6), lane = tid & 63, buf = cnt & 1; ++cnt;
        const float* src = (w < 3) ? cw + (size_t)w * (2 * DFF) : (w < 6) ? cw + (size_t)(w - 3) * (2 * DFF) + DFF : (w == 6) ? cb : cb + DFF;
        src += u.pn * 128 + lane * 4;
        if (lane < 32) __builtin_amdgcn_global_load_lds((const unsigned*)src, (LAS unsigned*)(lds + CWL_OFF + buf * 4096 + w * 512), 16, 0, 0);
    }
};
constexpr int FFN_MT = 130;
constexpr int XCH_OFF = 131072 + 1024;
__device__ __forceinline__ float dpp_ror1(float v)  { return __int_as_float(__builtin_amdgcn_update_dpp(0, __float_as_int(v), 0x121, 0xF, 0xF, false)); }
__device__ __forceinline__ float dpp_ror15(float v) { return __int_as_float(__builtin_amdgcn_update_dpp(0, __float_as_int(v), 0x12F, 0xF, 0xF, false)); }
struct EpiFfn {
    static constexpr bool PERM = true, AFTER_DRAIN = false;
    bf16_t* ACT; LAS unsigned char* lds; mutable int ecnt;
    __device__ __forceinline__ void operator()(const f32x4 (&acc)[2][2][4][2], const pg8::Unit& u, int wr, int wc, int fr, int fq) const {
        LAS float* XC = (LAS float*)(lds + XCH_OFF);
        const LAS float* WL = (const LAS float*)(lds + CWL_OFF + (ecnt & 1) * 4096); ++ecnt;
        const int colw = wc * 32 + 8 * fq;
        if (fr == 0 || fr == 15) {
            const int edge = (fr == 15) ? 1 : 0, m = (fr == 15) ? 3 : 0;
#pragma unroll
            for (int ai = 0; ai < 2; ++ai)
#pragma unroll
                for (int bj = 0; bj < 2; ++bj)
#pragma unroll
                    for (int n = 0; n < 2; ++n) { const f32x4 v = (m == 0) ? acc[ai][bj][0][n] : acc[ai][bj][3][n];
                        *(LAS f32x4*)(XC + ((ai * 2 + wr) * 2 + edge) * 256 + bj * 128 + colw + 4 * n) = v; }
        }
        asm volatile("s_waitcnt lgkmcnt(0)" ::: "memory"); __builtin_amdgcn_s_barrier(); asm volatile("" ::: "memory");
        const int slot0 = wr * 64 + fr, row_base = u.pm * 254 - 1;
#pragma unroll
        for (int bj = 0; bj < 2; ++bj) {
            const int gc = (u.pn * 256 + bj * 128 + colw) >> 1;
            const LAS float* wl = WL + ((bj * 128 + colw) >> 1);
            f32x4 wg[3], wu[3];
#pragma unroll
            for (int j = 0; j < 3; ++j) { wg[j] = *(const LAS f32x4*)(wl + j * 128); wu[j] = *(const LAS f32x4*)(wl + (3 + j) * 128); }
            const f32x4 bg = *(const LAS f32x4*)(wl + 6 * 128), bu = *(const LAS f32x4*)(wl + 7 * 128);
#pragma unroll
            for (int ai = 0; ai < 2; ++ai) {
                const int gidx = ai * 2 + wr;
                f32x4 pe[2], ne[2];
#pragma unroll
                for (int n = 0; n < 2; ++n) {
                    pe[n] = (gidx > 0) ? *(const LAS f32x4*)(XC + (((gidx - 1) * 2) + 1) * 256 + bj * 128 + colw + 4 * n) : (f32x4){0.f, 0.f, 0.f, 0.f};
                    ne[n] = (gidx < 3) ? *(const LAS f32x4*)(XC + (((gidx + 1) * 2) + 0) * 256 + bj * 128 + colw + 4 * n) : (f32x4){0.f, 0.f, 0.f, 0.f}; }
#pragma unroll
                for (int m = 0; m < 4; ++m) {
                    const int slot = ai * 128 + slot0 + m * 16, row = row_base + slot, t = row & (SEQ - 1);
                    f32x4 hv[2];
#pragma unroll
                    for (int n = 0; n < 2; ++n) {
                        const f32x4 cur = acc[ai][bj][m][n], prv = acc[ai][bj][m == 0 ? 0 : m - 1][n], nxt = acc[ai][bj][m == 3 ? 3 : m + 1][n];
                        f32x4 up, dn;
#pragma unroll
                        for (int e = 0; e < 4; ++e) { up[e] = dpp_ror1(fr == 15 ? prv[e] : cur[e]); dn[e] = dpp_ror15(fr == 0 ? nxt[e] : cur[e]); }
                        if (m == 0 && fr == 0) up = pe[n];
                        if (m == 3 && fr == 15) dn = ne[n];
                        if (t == 0) up = (f32x4){0.f, 0.f, 0.f, 0.f};
                        if (t == SEQ - 1) dn = (f32x4){0.f, 0.f, 0.f, 0.f};
                        const f32x4 w0 = n ? wu[0] : wg[0], w1 = n ? wu[1] : wg[1], w2 = n ? wu[2] : wg[2], bb = n ? bu : bg;
                        hv[n] = w0 * up + w1 * cur + w2 * dn + bb; }
                    if (slot >= 1 && slot <= 254 && row < NT) {
                        float o[4];
#pragma unroll
                        for (int e = 0; e < 4; ++e) { const float g = hv[0][e]; o[e] = g * __builtin_amdgcn_rcpf(1.0f + __expf(-g)) * hv[1][e]; }
                        u32x2 w; w.x = pk2(o[0], o[1]); w.y = pk2(o[2], o[3]);
                        *(u32x2*)(ACT + ((size_t)(gc >> 6) * NT + row) * 64 + (gc & 63)) = w; }
                }
            }
        }
    }
};

__device__ __forceinline__ int win_row(int n) {
    if (n < 1536) return 1536 + n;
    if (n < 2560) { const int q = n - 1536, blk = q >> 6, d = q & 63; return blk * 64 + 2 * (d & 31) + (d >> 5); }
    if (n < 3072) return 512 + n;
    return n - 2048;
}
template <int MODE> __device__ __forceinline__ void p0_transpose_item(const float* W, int K, int N, bf16_t* WT, LAS float* scr, int item, int lane) {
    const int nblk = N / 32, kb = item / nblk, nb = item % nblk, k0 = 64 * kb, n0 = 32 * nb;
    f32x4 q[8];
#pragma unroll
    for (int i = 0; i < 8; ++i) q[i] = *(const f32x4*)(W + (size_t)(k0 + 8 * i + (lane >> 3)) * N + n0 + 4 * (lane & 7));
#pragma unroll
    for (int i = 0; i < 8; ++i) { LAS float* d = scr + (8 * i + (lane >> 3)) * 33 + 4 * (lane & 7); d[0] = q[i][0]; d[1] = q[i][1]; d[2] = q[i][2]; d[3] = q[i][3]; }
    LDS_WAIT(); asm volatile("" ::: "memory");
    const int c = lane & 7;
#pragma unroll
    for (int j = 0; j < 4; ++j) { const int n = (lane >> 3) + 8 * j; const LAS float* s = scr + (8 * c) * 33 + n;
        u32x4 o; o.x = pk2(s[0 * 33], s[1 * 33]); o.y = pk2(s[2 * 33], s[3 * 33]); o.z = pk2(s[4 * 33], s[5 * 33]); o.w = pk2(s[6 * 33], s[7 * 33]);
        const int nn = n0 + n; const int dr = (MODE == 1) ? win_row(nn) : (MODE == 2) ? ((nn < DFF) ? ((nn >> 2) * 8 + (nn & 3)) : (((nn - DFF) >> 2) * 8 + 4 + ((nn - DFF) & 3))) : nn;
        *(u32x4*)(WT + (size_t)dr * K + k0 + 8 * c) = o; }
    LDS_WAIT(); asm volatile("" ::: "memory");
}
__device__ __forceinline__ void cvt_rows(const float* src, bf16_t* dst, size_t n8, int gw, int ngw, int lane) {
    const size_t stride = (size_t)ngw * 64;
    for (size_t i = (size_t)gw * 64 + lane; i < n8; i += 4 * stride) {
        f32x4 a[4], c[4];
#pragma unroll
        for (int u = 0; u < 4; ++u) { const size_t k = i + u * stride; if (k < n8) { a[u] = ((const f32x4*)src)[2 * k]; c[u] = ((const f32x4*)src)[2 * k + 1]; } }
#pragma unroll
        for (int u = 0; u < 4; ++u) { const size_t k = i + u * stride; if (k < n8) {
            u32x4 w; w.x = pk2(a[u][0], a[u][1]); w.y = pk2(a[u][2], a[u][3]); w.z = pk2(c[u][0], c[u][1]); w.w = pk2(c[u][2], c[u][3]);
            ((u32x4*)dst)[k] = w; } }
    }
}
__device__ __forceinline__ void p0_filter_item(const LAS float* w1, const float* b1, const float* fq, const LAS float* w2, const float* b2, const float* w3, float* HTD, int item, int lane) {
    const int t0 = 2 * (item >> 2), ih = item & 3; float h2v[2], tl[2];
    const float fql = fq[lane], b1l = b1[lane], b2l = b2[lane];
#pragma unroll
    for (int tt = 0; tt < 2; ++tt) { const int t = t0 + tt; tl[tt] = (float)t * (1.0f / 2047.0f);
        const float w = 6.283185307179586f * (float)t / 2048.0f;
        float zk = 0.f;
        if (lane == 0) zk = tl[tt];
        else if (lane <= 16) { const float fr = 1e-4f + (float)(lane - 1) * ((15.0f - 1e-4f) / 15.0f); zk = cosf(fr * w); }
        else if (lane <= 32) { const float fr = 1e-4f + (float)(lane - 17) * ((15.0f - 1e-4f) / 15.0f); zk = -sinf(fr * w); }
        float a = b1l;
#pragma unroll 11
        for (int k = 0; k < 33; ++k) a += __shfl(zk, k) * w1[k * 64 + lane];
        const float h1 = sinf(fql * a);
        float a2 = b2l;
#pragma unroll 16
        for (int k = 0; k < 64; ++k) a2 += __shfl(h1, k) * w2[k * 64 + lane];
        h2v[tt] = sinf(fql * a2); }
    const float dmin = -15.350567286626973f, dmax = -3.0701134573253946f;
    float acc0[8], acc1[8];
#pragma unroll
    for (int i = 0; i < 8; ++i) { acc0[i] = 0.f; acc1[i] = 0.f; }
#pragma unroll 8
    for (int j = 0; j < 64; ++j) { const float s0 = __shfl(h2v[0], j), s1 = __shfl(h2v[1], j); const float* wr = w3 + (size_t)j * 2048 + ih * 512 + lane;
#pragma unroll
        for (int i = 0; i < 8; ++i) { const float wv = wr[64 * i]; acc0[i] += s0 * wv; acc1[i] += s1 * wv; } }
#pragma unroll
    for (int i = 0; i < 8; ++i) { const int col = ih * 512 + 64 * i + lane, c = col & 511;
        const float delta = fabsf(dmin + (float)c * ((dmax - dmin) / 511.0f));
        float2 o; o.x = acc0[i] * expf(-tl[0] * delta); o.y = acc1[i] * expf(-tl[1] * delta);
        *(float2*)(HTD + (size_t)col * 2048 + t0) = o; }
}
__device__ __forceinline__ void p0_prep(const float* const* in, unsigned char* ws, LAS unsigned char* lds, int tid) {
    const int lane = tid & 63, wave = __builtin_amdgcn_readfirstlane(tid >> 6), gw = blockIdx.x * NWAVE + wave, ngw = gridDim.x * NWAVE;
    LAS float* scr = (LAS float*)(lds + wave * 8704);
    LAS float* W1L = (LAS float*)(lds + 69632); LAS float* W2L = W1L + 33 * 64;
    for (int i = tid; i < 33 * 64; i += NTHR) W1L[i] = in[5][i];
    for (int i = tid; i < 64 * 64; i += NTHR) W2L[i] = in[8][i];
    __syncthreads();
    bf16_t* WALL = (bf16_t*)(ws + WS_WALL);
    constexpr int I_IN = 16 * (INW / 32), I_KV = 16 * 32, I_OUT = 24 * 32, I_UP = 16 * (2 * DFF / 32), I_DN = (DFF / 64) * 32, NIT = I_IN + I_KV + I_OUT + I_UP + I_DN;
    for (int it = gw; it < NIT; it += ngw) { int r = it;
        if (r < I_IN) { p0_transpose_item<1>(in[2], DM, INW, WALL, scr, r, lane); continue; } r -= I_IN;
        if (r < I_KV) { p0_transpose_item<0>(in[14], DM, 1024, (bf16_t*)(ws + WS_WKV), scr, r, lane); continue; } r -= I_KV;
        if (r < I_OUT) { p0_transpose_item<0>(in[15], MIXW, DM, (bf16_t*)(ws + WS_WOUT), scr, r, lane); continue; } r -= I_OUT;
        if (r < I_UP) { p0_transpose_item<2>(in[18], DM, 2 * DFF, (bf16_t*)(ws + WS_WUP), scr, r, lane); continue; } r -= I_UP;
        p0_transpose_item<0>(in[21], DFF, DM, (bf16_t*)(ws + WS_WDN), scr, r, lane); }
    for (int it = ngw - 1 - gw; it < 4096; it += ngw) p0_filter_item(W1L, in[6], in[7], W2L, in[9], in[10], (float*)(ws + WS_HTD), it, lane);
    cvt_rows(in[0], (bf16_t*)(ws + WS_XB), (size_t)NT * DM / 8, gw, ngw, lane);
    cvt_rows(in[1], (bf16_t*)(ws + WS_MEMB), (size_t)NMT * DM / 8, gw, ngw, lane);
    float2* rope = (float2*)(ws + WS_ROPE);
    for (int i = blockIdx.x * NTHR + tid; i < SEQ * 32; i += gridDim.x * NTHR) { const int pos = i >> 5, f = i & 31;
        const float invf = powf(10000.0f, -(float)(2 * f) / 64.0f); const float ang = (float)pos * invf;
        float2 cs; cs.x = cosf(ang); cs.y = sinf(ang); rope[i] = cs; }
}

__device__ __forceinline__ void filter_fft_item(const float* HTD, float2* KF, LAS unsigned char* lds, int item, int tid) {
    const int o = item >> 9, c = item & 511;
    const float* rf = HTD + (size_t)((o * 2 + 0) * 512 + c) * 2048; const float* rb = HTD + (size_t)((o * 2 + 1) * 512 + c) * 2048;
    cplx v[8];
#pragma unroll
    for (int k = 0; k < 4; ++k) v[k] = mk2(rf[tid + 512 * k], 0.f);
    v[4] = mk2(tid == 0 ? 0.f : rb[2048 - tid], 0.f); v[5] = mk2(rb[1536 - tid], 0.f); v[6] = mk2(rb[1024 - tid], 0.f); v[7] = mk2(rb[512 - tid], 0.f);
    fft_fwd((LAS cplx*)lds, tid, v);
    float2* dst = KF + (size_t)(o * 512 + c) * 4096 + 8 * tid;
#pragma unroll
    for (int m = 0; m < 8; m += 2) { f32x4 w; w[0] = v[m].x * (1.f / 4096.f); w[1] = v[m].y * (1.f / 4096.f); w[2] = v[m + 1].x * (1.f / 4096.f); w[3] = v[m + 1].y * (1.f / 4096.f); *(f32x4*)(dst + m) = w; }
    __syncthreads();
}

constexpr int HY_SEG = 2064, HY_STG_OFF = 36864;
__device__ __forceinline__ float conv3s(const LAS bf16_t* seg, int n, float w0, float w1, float w2, float b) {
    return w0 * bf2f(seg[7 + n]) + w1 * bf2f(seg[8 + n]) + w2 * bf2f(seg[9 + n]) + b;
}
__device__ __forceinline__ void hyena_item(const bf16_t* HT, const float2* KF, const float* cw, const float* cb, const float* hb, bf16_t* MIX, LAS unsigned char* lds, int bp, int cgp, int tid0) {
    LAS cplx* X = (LAS cplx*)lds; LAS bf16_t* STG = (LAS bf16_t*)(lds + HY_STG_OFF); LAS cplx* TW = (LAS cplx*)(lds + 65536);
    const int ba = 2 * bp;
    twid_fill<512>(TW, tid0); twid_fill<64>(TW, tid0); twid_fill<8>(TW, tid0);
    u32x4 oacc[8];
#pragma unroll
    for (int i = 0; i < 8; ++i) oacc[i] = (u32x4){0u, 0u, 0u, 0u};
    if (tid0 < 12) { const int sg = tid0 >> 1; STG[sg * HY_SEG + ((tid0 & 1) ? 2056 : 7)] = 0; }
    { const int c = cgp * 8;
#pragma unroll
      for (int i = 0; i < 3; ++i) { const int id = tid0 + 512 * i, sg = id >> 8, ch = id & 255;
          const u32x4 q = *(const u32x4*)(HT + (size_t)((sg >> 1) * 512 + c) * NT + (ba + (sg & 1)) * SEQ + ch * 8);
          *(LAS u32x4*)(STG + sg * HY_SEG + 8 + ch * 8) = q; } }
    __syncthreads();
#pragma unroll 1
    for (int cc = 0; cc < 8; ++cc) {
        const int c = cgp * 8 + cc;
        int tl_ = tid0; asm volatile("" : "+v"(tl_)); const int tid = tl_;
        u32x4 nx[3];
        if (cc < 7) {
#pragma unroll
            for (int i = 0; i < 3; ++i) { const int id = tid + 512 * i, sg = id >> 8, ch = id & 255;
                nx[i] = *(const u32x4*)(HT + (size_t)((sg >> 1) * 512 + c + 1) * NT + (ba + (sg & 1)) * SEQ + ch * 8); } }
        f32x4 kf[4];
        { const f32x4* kp = (const f32x4*)(KF + (size_t)c * 4096 + 8 * tid);
#pragma unroll
          for (int m = 0; m < 4; ++m) kf[m] = kp[m]; }
        cplx v[8]; float va[4], vb[4];
        { const float w0 = cw[c], w1 = cw[1536 + c], w2 = cw[3072 + c], b = cb[c];
#pragma unroll
          for (int k = 0; k < 4; ++k) { const int n = tid + 512 * k; va[k] = conv3s(STG, n, w0, w1, w2, b); vb[k] = conv3s(STG + HY_SEG, n, w0, w1, w2, b); v[k] = mk2(va[k], vb[k]); v[4 + k] = mk2(0.f, 0.f); } }
        fft_fwdL(X, TW, tid, v);
#pragma unroll
        for (int m = 0; m < 8; m += 2) { const f32x4 w = kf[m >> 1]; v[m] = cmul(v[m], mk2(w[0], w[1])); v[m + 1] = cmul(v[m + 1], mk2(w[2], w[3])); }
        { const f32x4* kp = (const f32x4*)(KF + (size_t)(512 + c) * 4096 + 8 * tid);
#pragma unroll
          for (int m = 0; m < 4; ++m) kf[m] = kp[m]; }
        fft_invL(X, TW, tid, v);
        { const float w0 = cw[512 + c], w1 = cw[1536 + 512 + c], w2 = cw[3072 + 512 + c], b = cb[512 + c], hb0 = hb[c];
#pragma unroll
          for (int k = 0; k < 4; ++k) { const int n = tid + 512 * k; const float xa = conv3s(STG + 2 * HY_SEG, n, w0, w1, w2, b), xb = conv3s(STG + 3 * HY_SEG, n, w0, w1, w2, b);
              va[k] = xa * (v[k].x + hb0 * va[k]); vb[k] = xb * (v[k].y + hb0 * vb[k]); v[k] = mk2(va[k], vb[k]); v[4 + k] = mk2(0.f, 0.f); } }
        fft_fwdL(X, TW, tid, v);
#pragma unroll
        for (int m = 0; m < 8; m += 2) { const f32x4 w = kf[m >> 1]; v[m] = cmul(v[m], mk2(w[0], w[1])); v[m + 1] = cmul(v[m + 1], mk2(w[2], w[3])); }
        fft_invL(X, TW, tid, v);
        { const float w0 = cw[1024 + c], w1 = cw[1536 + 1024 + c], w2 = cw[3072 + 1024 + c], b = cb[1024 + c], hb1 = hb[512 + c];
#pragma unroll
          for (int k = 0; k < 4; ++k) { const int n = tid + 512 * k; const float xa = conv3s(STG + 4 * HY_SEG, n, w0, w1, w2, b), xb = conv3s(STG + 5 * HY_SEG, n, w0, w1, w2, b);
              const float oa = xa * (v[k].x + hb1 * va[k]), ob = xb * (v[k].y + hb1 * vb[k]);
              const unsigned pw = pk2(oa, ob);
#pragma unroll
              for (int hh = 0; hh < 2; ++hh) { u32x4& o = oacc[2 * k + hh]; const unsigned nw = hh ? (pw & 0xffff0000u) : (pw << 16);
                  o.x = __builtin_amdgcn_alignbit(o.y, o.x, 16); o.y = __builtin_amdgcn_alignbit(o.z, o.y, 16); o.z = __builtin_amdgcn_alignbit(o.w, o.z, 16); o.w = (o.w >> 16) | nw; } } }
        __syncthreads();
        if (cc < 7) {
#pragma unroll
            for (int i = 0; i < 3; ++i) { const int id = tid + 512 * i, sg = id >> 8, ch = id & 255; *(LAS u32x4*)(STG + sg * HY_SEG + 8 + ch * 8) = nx[i]; } }
        __syncthreads();
    }
    int tw_ = tid0; asm volatile("" : "+v"(tw_)); const int tid = tw_;
#pragma unroll
    for (int k = 0; k < 4; ++k)
#pragma unroll
        for (int hh = 0; hh < 2; ++hh) *(u32x4*)(MIX + (size_t)((ba + hh) * SEQ + tid + 512 * k) * MIXW + cgp * 8) = oacc[2 * k + hh];
}

constexpr int ATT_KP = 272, ATT_VP = 144, ATT_KB = 64 * ATT_KP, ATT_VB = 128 * ATT_VP, ATT_VOFF = 2 * ATT_KB;
template <int NC> __device__ __forceinline__ void attn_unit(LAS unsigned char* lds, const bf16_t* Qp, int ldq, const bf16_t* Kp, int ldk, const bf16_t* Vt, int ldv, int nkeys, float sl2,
                                                            bf16_t* Op, int ldo, float lam, const float* subg, int tid) {
    constexpr int NSTEP = (NC == 2) ? 4 : 8;
    const int lane = tid & 63, wave = tid >> 6, r = lane & 31, h = lane >> 5;
    const int qb = (NC == 2) ? (wave & 3) : wave, comp = (NC == 2) ? (wave >> 2) : 0, dbase = comp * 64;
    bf16x8 qf[NSTEP];
#pragma unroll
    for (int st = 0; st < NSTEP; ++st) qf[st] = *(const bf16x8*)(Qp + (size_t)(qb * 32 + r) * ldq + dbase + 16 * st + 8 * h);
    f32x16 o[4];
#pragma unroll
    for (int et = 0; et < 4; ++et)
#pragma unroll
        for (int i = 0; i < 16; ++i) o[et][i] = 0.f;
    float mold = -INFINITY, lsum = 0.f;
    const int kr0 = tid >> 4, kc = tid & 15, vr0 = tid >> 3, vc = tid & 7;
    const bf16_t* kg = Kp + (size_t)kr0 * ldk + kc * 8; const bf16_t* vg = Vt + (size_t)vr0 * ldv + vc * 8;
    const int kl = kr0 * ATT_KP + kc * 16, vl = ATT_VOFF + vr0 * ATT_VP + vc * 16;
    const int nt = nkeys / 64;
    u32x4 pk0, pk1, pv0, pv1;
    pk0 = *(const u32x4*)(kg); pk1 = *(const u32x4*)(kg + (size_t)32 * ldk); pv0 = *(const u32x4*)(vg); pv1 = *(const u32x4*)(vg + (size_t)64 * ldv);
    *(LAS u32x4*)(lds + kl) = pk0; *(LAS u32x4*)(lds + kl + 32 * ATT_KP) = pk1; *(LAS u32x4*)(lds + vl) = pv0; *(LAS u32x4*)(lds + vl + 64 * ATT_VP) = pv1;
    __syncthreads();
    for (int it = 0; it < nt; ++it) {
        const int cur = it & 1; const bool more = (it + 1 < nt);
        if (more) { const bf16_t* kg2 = kg + (size_t)(it + 1) * 64 * ldk; const bf16_t* vg2 = vg + (it + 1) * 64;
            pk0 = *(const u32x4*)(kg2); pk1 = *(const u32x4*)(kg2 + (size_t)32 * ldk); pv0 = *(const u32x4*)(vg2); pv1 = *(const u32x4*)(vg2 + (size_t)64 * ldv); }
        LAS unsigned char* Kb = lds + cur * ATT_KB; LAS unsigned char* Vb = lds + ATT_VOFF + cur * ATT_VB;
        f32x16 s[2];
#pragma unroll
        for (int kb = 0; kb < 2; ++kb) {
#pragma unroll
            for (int i = 0; i < 16; ++i) s[kb][i] = 0.f;
#pragma unroll
            for (int st = 0; st < NSTEP; ++st) { const bf16x8 a = *(const LAS bf16x8*)(Kb + (kb * 32 + r) * ATT_KP + (dbase + 16 * st + 8 * h) * 2);
                s[kb] = __builtin_amdgcn_mfma_f32_32x32x16_bf16(a, qf[st], s[kb], 0, 0, 0); } }
        float mx = s[0][0];
#pragma unroll
        for (int i = 1; i < 16; ++i) mx = fmaxf(mx, s[0][i]);
#pragma unroll
        for (int i = 0; i < 16; ++i) mx = fmaxf(mx, s[1][i]);
        mx = fmaxf(mx, __shfl_xor(mx, 32));
        const float mnew = fmaxf(mold, mx * sl2), alpha = __builtin_amdgcn_exp2f(mold - mnew); mold = mnew;
        float ps = 0.f;
#pragma unroll
        for (int kb = 0; kb < 2; ++kb)
#pragma unroll
            for (int i = 0; i < 16; ++i) { const float p = __builtin_amdgcn_exp2f(__builtin_fmaf(s[kb][i], sl2, -mnew)); s[kb][i] = p; ps += p; }
        lsum = lsum * alpha + ps;
#pragma unroll
        for (int et = 0; et < 4; ++et)
#pragma unroll
            for (int i = 0; i < 16; ++i) o[et][i] *= alpha;
#pragma unroll
        for (int kb = 0; kb < 2; ++kb)
#pragma unroll
            for (int s2 = 0; s2 < 2; ++s2) {
                u32x4 pw; pw.x = pk2(s[kb][8 * s2 + 0], s[kb][8 * s2 + 1]); pw.y = pk2(s[kb][8 * s2 + 2], s[kb][8 * s2 + 3]); pw.z = pk2(s[kb][8 * s2 + 4], s[kb][8 * s2 + 5]); pw.w = pk2(s[kb][8 * s2 + 6], s[kb][8 * s2 + 7]);
                const bf16x8 pf = __builtin_bit_cast(bf16x8, pw);
#pragma unroll
                for (int et = 0; et < 4; ++et) { const LAS unsigned char* vp = Vb + (et * 32 + r) * ATT_VP + (kb * 32 + 16 * s2 + 4 * h) * 2;
                    const u32x2 lo = *(const LAS u32x2*)vp, hi = *(const LAS u32x2*)(vp + 16);
                    u32x4 aw; aw.x = lo.x; aw.y = lo.y; aw.z = hi.x; aw.w = hi.y;
                    o[et] = __builtin_amdgcn_mfma_f32_32x32x16_bf16(__builtin_bit_cast(bf16x8, aw), pf, o[et], 0, 0, 0); } }
        if (more) { const int nb = cur ^ 1;
            *(LAS u32x4*)(lds + nb * ATT_KB + kl) = pk0; *(LAS u32x4*)(lds + nb * ATT_KB + kl + 32 * ATT_KP) = pk1;
            *(LAS u32x4*)(lds + nb * ATT_VB + vl) = pv0; *(LAS u32x4*)(lds + nb * ATT_VB + vl + 64 * ATT_VP) = pv1; }
        __syncthreads();
    }
    lsum += __shfl_xor(lsum, 32);
    const float inv = 1.0f / lsum;
    if (NC == 1) {
        bf16_t* orow = Op + (size_t)(qb * 32 + r) * ldo;
#pragma unroll
        for (int et = 0; et < 4; ++et)
#pragma unroll
            for (int g = 0; g < 4; ++g) { u32x2 w; w.x = pk2(o[et][4 * g] * inv, o[et][4 * g + 1] * inv); w.y = pk2(o[et][4 * g + 2] * inv, o[et][4 * g + 3] * inv);
                *(u32x2*)(orow + et * 32 + 8 * g + 4 * h) = w; }
    } else {
        LAS float* XL = (LAS float*)lds;
        if (comp == 1) {
#pragma unroll
            for (int et = 0; et < 4; ++et)
#pragma unroll
                for (int i = 0; i < 16; ++i) XL[(qb * 64 + et * 16 + i) * 64 + lane] = o[et][i] * inv;
        }
        __syncthreads();
        if (comp == 0) {
            float ss = 0.f;
#pragma unroll
            for (int et = 0; et < 4; ++et)
#pragma unroll
                for (int i = 0; i < 16; ++i) { const float ov = o[et][i] * inv - lam * XL[(qb * 64 + et * 16 + i) * 64 + lane]; o[et][i] = ov; ss += ov * ov; }
            ss += __shfl_xor(ss, 32);
            const float rs = rsqrtf(ss * (1.0f / 128.0f) + RMS_EPS) * 0.8f;
            bf16_t* orow = Op + (size_t)(qb * 32 + r) * ldo;
#pragma unroll
            for (int et = 0; et < 4; ++et)
#pragma unroll
                for (int g = 0; g < 4; ++g) { const int e = et * 32 + 8 * g + 4 * h; const f32x4 gv = *(const f32x4*)(subg + e);
                    u32x2 w; w.x = pk2(o[et][4 * g] * rs * gv[0], o[et][4 * g + 1] * rs * gv[1]); w.y = pk2(o[et][4 * g + 2] * rs * gv[2], o[et][4 * g + 3] * rs * gv[3]);
                    *(u32x2*)(orow + e) = w; }
        }
        __syncthreads();
    }
}

template <bool TO_BF16> __device__ __forceinline__ void ln_rows(float* io, bf16_t* ob, float2* stat, const float* g, const float* b, int tid, float* alt = nullptr) {
    const int lane = tid & 63, gw = blockIdx.x * NWAVE + (tid >> 6), ngw = gridDim.x * NWAVE;
    f32x4 gv[4], bv[4];
#pragma unroll
    for (int j = 0; j < 4; ++j) { gv[j] = ((const f32x4*)g)[lane + 64 * j]; bv[j] = ((const f32x4*)b)[lane + 64 * j]; }
    for (int row0 = gw; row0 < NT; row0 += 2 * ngw) {
        f32x4 v[2][4];
#pragma unroll
        for (int u = 0; u < 2; ++u) { const int row = row0 + u * ngw; if (row < NT) { const f32x4* xr = (const f32x4*)(io + (size_t)row * DM) + lane;
#pragma unroll
            for (int j = 0; j < 4; ++j) v[u][j] = xr[64 * j]; } }
#pragma unroll
        for (int u = 0; u < 2; ++u) { const int row = row0 + u * ngw; if (row >= NT) continue;
            float s = 0.f;
#pragma unroll
            for (int j = 0; j < 4; ++j) s += (v[u][j][0] + v[u][j][1]) + (v[u][j][2] + v[u][j][3]);
#pragma unroll
            for (int o = 1; o < 64; o <<= 1) s += __shfl_xor(s, o);
            const float mean = s * (1.0f / DM); float s2 = 0.f;
#pragma unroll
            for (int j = 0; j < 4; ++j) { v[u][j] = v[u][j] - mean; s2 += (v[u][j][0] * v[u][j][0] + v[u][j][1] * v[u][j][1]) + (v[u][j][2] * v[u][j][2] + v[u][j][3] * v[u][j][3]); }
#pragma unroll
            for (int o = 1; o < 64; o <<= 1) s2 += __shfl_xor(s2, o);
            const float rstd = rsqrtf(s2 * (1.0f / DM) + LN_EPS);
            if (TO_BF16) {
                u32x2* o8 = (u32x2*)(ob + (size_t)row * DM) + lane;
#pragma unroll
                for (int j = 0; j < 4; ++j) { const f32x4 y = v[u][j] * rstd * gv[j] + bv[j]; u32x2 w; w.x = pk2(y[0], y[1]); w.y = pk2(y[2], y[3]); o8[64 * j] = w; }
                if (lane == 0) { float2 st; st.x = mean; st.y = rstd; stat[row] = st; }
            } else {
                f32x4* wr_ = (alt ? (f32x4*)(alt + (size_t)row * DM) : (f32x4*)(io + (size_t)row * DM)) + lane;
#pragma unroll
                for (int j = 0; j < 4; ++j) wr_[64 * j] = v[u][j] * rstd * gv[j] + bv[j];
            }
        }
    }
}

__device__ __forceinline__ void convgate_half(const bf16_t* HH, bf16_t* ACT, const float* cw, const float* cb, int half, int tid) {
    constexpr int NG = DFF / 8; const int total = (NT / 2) * NG;
    for (int idx = blockIdx.x * NTHR + tid; idx < total; idx += gridDim.x * NTHR) {
        const int rl = idx / NG, cg8 = idx - rl * NG, n0 = cg8 * 8, t = rl & (SEQ - 1);
        const bf16_t* hp = HH + (size_t)rl * (2 * DFF);
        float gsum[8], usum[8];
#pragma unroll
        for (int e = 0; e < 8; ++e) { gsum[e] = cb[n0 + e]; usum[e] = cb[DFF + n0 + e]; }
#pragma unroll
        for (int j = 0; j < 3; ++j) { const int tt = t + j - 1; if (tt < 0 || tt >= SEQ) continue;
            const u32x4 gq = *(const u32x4*)(hp + (ptrdiff_t)(j - 1) * (2 * DFF) + n0), uq = *(const u32x4*)(hp + (ptrdiff_t)(j - 1) * (2 * DFF) + DFF + n0);
            const float* wg = cw + (size_t)j * (2 * DFF) + n0; const float* wu = wg + DFF;
            const f32x4 wg0 = *(const f32x4*)wg, wg1 = *(const f32x4*)(wg + 4), wu0 = *(const f32x4*)wu, wu1 = *(const f32x4*)(wu + 4);
            gsum[0] += wg0[0] * lo2f(gq.x); gsum[1] += wg0[1] * hi2f(gq.x); gsum[2] += wg0[2] * lo2f(gq.y); gsum[3] += wg0[3] * hi2f(gq.y);
            gsum[4] += wg1[0] * lo2f(gq.z); gsum[5] += wg1[1] * hi2f(gq.z); gsum[6] += wg1[2] * lo2f(gq.w); gsum[7] += wg1[3] * hi2f(gq.w);
            usum[0] += wu0[0] * lo2f(uq.x); usum[1] += wu0[1] * hi2f(uq.x); usum[2] += wu0[2] * lo2f(uq.y); usum[3] += wu0[3] * hi2f(uq.y);
            usum[4] += wu1[0] * lo2f(uq.z); usum[5] += wu1[1] * hi2f(uq.z); usum[6] += wu1[2] * lo2f(uq.w); usum[7] += wu1[3] * hi2f(uq.w); }
        float a[8];
#pragma unroll
        for (int e = 0; e < 8; ++e) a[e] = gsum[e] / (1.0f + __expf(-gsum[e])) * usum[e];
        u32x4 w; w.x = pk2(a[0], a[1]); w.y = pk2(a[2], a[3]); w.z = pk2(a[4], a[5]); w.w = pk2(a[6], a[7]);
        *(u32x4*)(ACT + (size_t)(half * (NT / 2) + rl) * DFF + n0) = w;
    }
}

#define XB_TMO      128
#define XB_XCNT(j)  (256  + 64 * (j))
#define XB_XSUB(j)  (1280 + 64 * (j))
#define XB_XGEN(j)  (2304 + 64 * (j))
#define XB_TOP      3328
#define XB_TOPGEN   3392
#define XCD_BAR_WORDS 3456
#define XB_SPIN_CAP (1u << 18)

__device__ __forceinline__ unsigned xb_ld(unsigned* p)              { return __hip_atomic_load(p, __ATOMIC_RELAXED, __HIP_MEMORY_SCOPE_AGENT); }
__device__ __forceinline__ unsigned xb_add(unsigned* p, unsigned v) { return __hip_atomic_fetch_add(p, v, __ATOMIC_RELAXED, __HIP_MEMORY_SCOPE_AGENT); }
__device__ __forceinline__ unsigned xb_xcc_id() { return (unsigned)__builtin_amdgcn_s_getreg((3 << 11) | 20) & 0xFu; }
#define XB_SPIN(cond, bar) do { unsigned _sp = 0; while (cond) { __builtin_amdgcn_s_sleep(1); \
    if ((++_sp & 255u) == 0u) { if (xb_ld(&(bar)[XB_TMO])) break; if (_sp > XB_SPIN_CAP) { atomicAdd(&(bar)[XB_TMO], 1u); break; } } } } while (0)

struct XcdBarrier {
    unsigned* bar; unsigned x;
    volatile LAS unsigned* st;
};

__device__ __forceinline__ XcdBarrier xcd_barrier_post(unsigned* bar, volatile LAS unsigned* st) {
    XcdBarrier b; b.bar = bar; b.x = xb_xcc_id(); b.st = st;
    if (threadIdx.x == 0) (void)xb_add(&bar[XB_XCNT(b.x)], 1u);
    return b;
}
__device__ __forceinline__ void xcd_barrier_complete(unsigned* bar, unsigned x, unsigned& nloc, unsigned& nx) {
    const unsigned G = gridDim.x * gridDim.y * gridDim.z;
    unsigned sum, cnt, mine, sp = 0u;
    for (;;) {
        sum = 0u; cnt = 0u; mine = 0u;
#pragma unroll
        for (unsigned j = 0; j < 16; ++j) { const unsigned c = xb_ld(&bar[XB_XCNT(j)]); sum += c; cnt += (c > 0u) ? 1u : 0u; mine = (j == x) ? c : mine; }
        if (sum == G) break;
        __builtin_amdgcn_s_sleep(1);
        if ((++sp & 255u) == 0u) { if (xb_ld(&bar[XB_TMO])) break; if (sp > XB_SPIN_CAP) { atomicAdd(&bar[XB_TMO], 1u); break; } }
    }
    nloc = mine > 0u ? mine : 1u; nx = cnt > 0u ? cnt : 1u;
}

__device__ __forceinline__ void xcd_barrier(const XcdBarrier& b) {
    asm volatile("s_waitcnt vmcnt(0)" ::: "memory");
    __syncthreads();
    if (threadIdx.x == 0) {
        unsigned* bar = b.bar;
        __builtin_amdgcn_s_waitcnt(0);
        unsigned nloc = b.st[0], nx = b.st[1];
        if (nloc == 0u) { xcd_barrier_complete(bar, b.x, nloc, nx); b.st[0] = nloc; b.st[1] = nx; }
        const unsigned old = xb_add(&bar[XB_XSUB(b.x)], 1u);
        const unsigned gen = old / nloc;
        if (old + 1u == (gen + 1u) * nloc) {
            __builtin_amdgcn_fence(__ATOMIC_RELEASE, "agent");
            asm volatile("s_waitcnt vmcnt(0)" ::: "memory");
            const unsigned og = xb_add(&bar[XB_TOP], 1u);
            const unsigned tg = og / nx;
            if (og + 1u == (tg + 1u) * nx) xb_add(&bar[XB_TOPGEN], 1u);
            else XB_SPIN(xb_ld(&bar[XB_TOPGEN]) == tg, bar);
            __builtin_amdgcn_fence(__ATOMIC_ACQUIRE, "agent");
            xb_add(&bar[XB_XGEN(b.x)], 1u);
            asm volatile("s_waitcnt vmcnt(0)" ::: "memory");
        } else {
            XB_SPIN(xb_ld(&bar[XB_XGEN(b.x)]) == gen, bar);
            __builtin_amdgcn_fence(__ATOMIC_ACQUIRE, "agent");
            asm volatile("s_waitcnt vmcnt(0)" ::: "memory");
        }
    }
    __syncthreads();
}

#ifndef PH_MASK
#define PH_MASK 0xFFFFFF
#endif
#define PH(k) ((PH_MASK >> (k)) & 1)
#ifndef G5ORDER
#define G5ORDER KbOrder
#endif
#ifndef REP_P0
#define REP_P0 1
#endif
#ifndef REP_G1
#define REP_G1 1
#endif
#ifndef REP_DIFF
#define REP_DIFF 1
#endif
#ifndef REP_HY
#define REP_HY 1
#endif
#ifndef REP_MEM
#define REP_MEM 1
#endif
#ifndef REP_G3
#define REP_G3 1
#endif
#ifndef REP_G4
#define REP_G4 1
#endif
#ifndef REP_LN1
#define REP_LN1 1
#endif
struct Args { const float* in[24]; float* out; unsigned char* ws; };
__global__ void __launch_bounds__(NTHR, 2) hybrid_fwd(Args a) {
    extern __shared__ __attribute__((aligned(16))) unsigned char smem[];
    LAS unsigned char* lds = (LAS unsigned char*)smem;
    cg::grid_group grid = cg::this_grid();
    volatile LAS unsigned* bst = (volatile LAS unsigned*)(lds + 131072 + 64);
    if (threadIdx.x < 2) bst[threadIdx.x] = 0u;
    __syncthreads();
    const XcdBarrier bar = xcd_barrier_post((unsigned*)(a.ws + WS_BAR), bst);
    const int G = gridDim.x;
#define NEWPHASE() int tid_ = threadIdx.x, cu_ = blockIdx.x; asm volatile("" : "+v"(tid_)); asm volatile("" : "+s"(cu_)); const int tid = tid_, cu = cu_; (void)tid; (void)cu;
    unsigned char* ws = a.ws;
    bf16_t* WALL = (bf16_t*)(ws + WS_WALL); bf16_t* XB = (bf16_t*)(ws + WS_XB); bf16_t* MEMB = (bf16_t*)(ws + WS_MEMB); bf16_t* WKV = (bf16_t*)(ws + WS_WKV);
    bf16_t* QKM = (bf16_t*)(ws + WS_QKM); bf16_t* HT = (bf16_t*)(ws + WS_HT); bf16_t* KMEM = (bf16_t*)(ws + WS_KMEM); bf16_t* VMT = (bf16_t*)(ws + WS_VMT);
    float2* KF = (float2*)(ws + WS_KF); bf16_t* MIX = (bf16_t*)(ws + WS_MIX); float2* STAT = (float2*)(ws + WS_STAT);
    bf16_t* X1B = (bf16_t*)(ws + WS_X1B); bf16_t* HH = (bf16_t*)(ws + WS_HH); bf16_t* ACT = (bf16_t*)(ws + WS_ACT);

    for (int rep = 0; rep < REP_P0; ++rep) { NEWPHASE(); if (PH(0)) p0_prep(a.in, ws, lds, tid); }
    if (a.ws == nullptr) grid.sync();
    xcd_barrier(bar);

    for (int rep = 0; rep < REP_G1; ++rep) {
    if (PH(1)) { NEWPHASE(); pg8::Gemm g{XB, WALL, NT, 1536, DM}; pg8::StaticOrder S; S.init(g.M, g.N, G, cu);
      EpiRope E{QKM, (const float2*)(ws + WS_ROPE)};
      pg8::gemm_phase<EpiRope, pg8::StaticOrder, true, true>(lds, g, S, E); }
    if (PH(2)) { NEWPHASE(); pg8::Gemm g{WALL + (size_t)1536 * DM, XB, 2048, NT, DM}; pg8::StaticOrder S; S.init(g.M, g.N, G, cu);
      EpiB E{HT, NT};
      pg8::gemm_phase<EpiB, pg8::StaticOrder, true, true>(lds, g, S, E); }
    }
    if (PH(3)) { NEWPHASE(); const bool isK = cu < 32, on = cu < 64; const int c2 = cu - 32;
      pg8::Gemm g; EpiB E; OneUnit S;
      if (isK) { g = pg8::Gemm{MEMB, WKV, NMT, 512, DM}; E = EpiB{KMEM, 512}; S = OneUnit{cu >> 1, cu & 1, on}; }
      else { g = pg8::Gemm{WKV + (size_t)512 * DM, MEMB, 512, NMT, DM}; E = EpiB{VMT, NMT}; S = OneUnit{(c2 >> 4) & 1, c2 & 15, on}; }
      pg8::gemm_phase<EpiB, OneUnit, false, true>(lds, g, S, E);
      __syncthreads();
      if (!on) for (int it = cu - 64; it < 1024; it += G - 64) filter_fft_item((const float*)(ws + WS_HTD), KF, lds, it, tid); }
    xcd_barrier(bar);

    { NEWPHASE(); const int xcd = cu & 7, j = cu >> 3;
      float lam;
      { const float* lp = a.in[12]; const int l6 = tid & 63; float s01 = lp[l6] * lp[64 + l6], s23 = lp[128 + l6] * lp[192 + l6];
#pragma unroll
        for (int o = 1; o < 64; o <<= 1) { s01 += __shfl_xor(s01, o); s23 += __shfl_xor(s23, o); }
        lam = expf(s01) - expf(s23) + 0.2f; }
      if (PH(4)) for (int i = 0; i < 4 * REP_DIFF; ++i) {
          const int bh = ((i & 3) * 8 + xcd) * 2 + (j >> 4), qblk = j & 15, b = bh >> 2, hd = bh & 3;
          const size_t tok0 = (size_t)b * SEQ;
          attn_unit<2>(lds, QKM + (tok0 + qblk * 128) * MIXW + hd * 128, MIXW, QKM + tok0 * MIXW + 512 + hd * 128, MIXW,
                       HT + (size_t)(1536 + hd * 128) * NT + tok0, NT, SEQ, 0.125f * 1.4426950408889634f,
                       MIX + (tok0 + qblk * 128) * MIXW + 512 + hd * 128, MIXW, lam, a.in[13], tid); }
      if (PH(5)) for (int i = 0; i < 2 * REP_MEM; ++i) {
          const int bh = ((i & 1) * 8 + xcd) * 4 + (j >> 3), qblk = j & 7, b = bh >> 2, hd = bh & 3;
          const size_t tok0 = (size_t)b * SEQ;
          attn_unit<1>(lds, QKM + (tok0 + qblk * 256) * MIXW + 1024 + hd * 128, MIXW, KMEM + (size_t)b * MEMT * 512 + hd * 128, 512,
                       VMT + (size_t)(hd * 128) * NMT + b * MEMT, NMT, MEMT, 0.08838834764831845f * 1.4426950408889634f,
                       MIX + (tok0 + qblk * 256) * MIXW + 1024 + hd * 128, MIXW, 0.f, nullptr, tid); }
      if (PH(6)) for (int i = 0; i < 2 * REP_HY; ++i) {
          const int cgp = ((i & 1) * 8 + xcd) * 4 + (j >> 3), bp = j & 7;
          hyena_item(HT, KF, a.in[3], a.in[4], a.in[11], MIX, lds, bp, cgp, tid); } }
    xcd_barrier(bar);

#ifdef REP_SYNC
    for (int rep = 0; rep < REP_SYNC; ++rep) xcd_barrier(bar);
#endif
    for (int rep = 0; rep < REP_G3; ++rep) if (PH(7)) { NEWPHASE(); pg8::Gemm g{MIX, (const bf16_t*)(ws + WS_WOUT), NT, DM, MIXW}; pg8::StaticOrder S; S.init(g.M, g.N, G, cu);
      EpiRes E{a.in[0], a.out};
      pg8::gemm_phase<EpiRes, pg8::StaticOrder, true, true>(lds, g, S, E); }
    xcd_barrier(bar);
    for (int rep = 0; rep < REP_LN1; ++rep) if (PH(8)) { NEWPHASE(); ln_rows<true>(a.out, X1B, STAT, a.in[16], a.in[17], tid); }
    xcd_barrier(bar);
    for (int rep = 0; rep < REP_G4; ++rep) if (PH(9)) { NEWPHASE(); pg8::Gemm g{X1B, (const bf16_t*)(ws + WS_WUP), FFN_MT * 256, 2 * DFF, DM}; FfnOrder S; S.init(g.M, g.N, G, cu); S.cw = a.in[19]; S.cb = a.in[20]; S.lds = lds; S.cnt = 0;
      EpiFfn E{ACT, lds, 0};
      pg8::gemm_phase<EpiFfn, FfnOrder, true, true>(lds, g, S, E); }
    xcd_barrier(bar);
    if (PH(11)) { NEWPHASE(); pg8::Gemm g{ACT, (const bf16_t*)(ws + WS_WDN), NT, DM, DFF}; G5ORDER S; S.init(g.M, g.N, G, cu);
      EpiRes2 E{a.out, a.out, STAT, a.in[16], a.in[17]};
#ifdef REP_G5
      { EpiRes2 E2{a.out, (float*)(ws + WS_HH), STAT, a.in[16], a.in[17]}; pg8::gemm_phase<EpiRes2, G5ORDER, true, true>(lds, g, S, E2); xcd_barrier(bar); }
#endif
      pg8::gemm_phase<EpiRes2, G5ORDER, true, true>(lds, g, S, E); }
    xcd_barrier(bar);
#ifdef REP_LN2
    { NEWPHASE(); ln_rows<false>(a.out, nullptr, nullptr, a.in[22], a.in[23], tid, (float*)(ws + WS_HH)); xcd_barrier(bar); }
#endif
    if (PH(12)) { NEWPHASE(); ln_rows<false>(a.out, nullptr, nullptr, a.in[22], a.in[23], tid); }
}

extern "C" void kernel_launch(void* const* d_in, const int* in_sizes, int n_in, void* d_out, int out_size, void* d_ws, size_t ws_size, hipStream_t stream) {
    static int grid = 0;
    if (grid == 0) {
        if (n_in != 24 || out_size != NT * DM || ws_size < WS_END) { fprintf(stderr, "kernel_launch: unexpected shapes (n_in %d, out %d, ws %zu)\n", n_in, out_size, ws_size); grid = -1; return; }
        int dev = 0, cus = 0, per_cu = 0;
        hipGetDevice(&dev); hipDeviceGetAttribute(&cus, hipDeviceAttributeMultiprocessorCount, dev);
        if (hipFuncSetAttribute((const void*)hybrid_fwd, hipFuncAttributeMaxDynamicSharedMemorySize, LDS_BYTES) != hipSuccess) { fprintf(stderr, "kernel_launch: hipFuncSetAttribute failed\n"); grid = -1; return; }
        if (hipOccupancyMaxActiveBlocksPerMultiprocessor(&per_cu, (const void*)hybrid_fwd, NTHR, LDS_BYTES) != hipSuccess || per_cu < 1) { fprintf(stderr, "kernel_launch: occupancy query says %d\n", per_cu); per_cu = 1; }
        (void)hipGetLastError();
        grid = cus * per_cu;
        fprintf(stderr, "kernel_launch: grid %d (cus %d x %d)\n", grid, cus, per_cu);
    }
    if (grid < 0) return;
    if (hipMemsetAsync((char*)d_ws + WS_BAR, 0, XCD_BAR_WORDS * 4, stream) != hipSuccess) { fprintf(stderr, "kernel_launch: memset failed\n"); return; }
    Args a{};
    for (int i = 0; i < 24; ++i) a.in[i] = (const float*)d_in[i];
    a.out = (float*)d_out; a.ws = (unsigned char*)d_ws;
    void* args[] = {&a};
    const hipError_t e = hipLaunchCooperativeKernel((const void*)hybrid_fwd, dim3(grid), dim3(NTHR), args, LDS_BYTES, stream);
    if (e != hipSuccess) fprintf(stderr, "kernel_launch: cooperative launch failed: %s (grid %d)\n", hipGetErrorString(e), grid);
}
```

```cpp
#include <hip/hip_runtime.h>
#include <hip/hip_cooperative_groups.h>
#include <cstdio>
#include <cstdint>
namespace cg = cooperative_groups;
#define LAS __attribute__((address_space(3)))
namespace pg8 {
#define PG8_LAS __attribute__((address_space(3)))
typedef unsigned short bf16_t;
typedef short bf16x8 __attribute__((ext_vector_type(8)));
typedef float f32x4 __attribute__((ext_vector_type(4)));
typedef unsigned u32x4 __attribute__((ext_vector_type(4)));
constexpr int BM = 256, BK = 64, HALF = 128, HTB = HALF * BK * 2  , STAGE_BYTES = 8 * HTB, NXCD = 8, WGM = 8;

__host__ __device__ __forceinline__ int lds_byte(int r, int c) { const int st = (r >> 4) * 2 + (c >> 5), rr = r & 15, cc = c & 31, ob = rr * 64 + cc * 2; return st * 1024 + (ob ^ (((ob >> 9) & 1) << 5)); }
__host__ __device__ __forceinline__ void stage_rc(int b, int& R, int& C) { const int st = b / 1024, sb = b % 1024, swz = sb ^ (((sb >> 9) & 1) << 5); R = (st >> 1) * 16 + swz / 64; C = (st & 1) * 32 + (swz % 64) / 2; }
__host__ __device__ __forceinline__ int perm32(int rho) { const int n = rho >> 4, i = rho & 15; return 8 * (i >> 2) + 4 * n + (i & 3); }

struct Unit { int pm, pn; };
struct Gemm { const bf16_t* A; const bf16_t* Bt; int M, N, K; };

struct StaticOrder {
    int nM, nN, nwg, G, c;
    __host__ __device__ void init(int M, int N, int G_, int c_) { nM = M / BM; nN = N / BM; nwg = nM * nN; G = G_; c = c_; }
    __host__ __device__ bool next(int i, Unit& u) const {
        const long L = (long)i * G + c; if (L >= nwg) return false;
        int wgid = (int)L; { const int q = nwg / NXCD, r = nwg % NXCD, xcd = wgid % NXCD, off = wgid / NXCD; wgid = (xcd < r ? xcd * (q + 1) : r * (q + 1) + (xcd - r) * q) + off; }
        const int nig = WGM * nN, gid = wgid / nig, fm = gid * WGM, gsz = (nM - fm) < WGM ? (nM - fm) : WGM;
        u.pm = fm + ((wgid % nig) % gsz); u.pn = (wgid % nig) / gsz; return true;
    }
    __device__ __forceinline__ void a_ready(const Unit&) const {}
    __device__ __forceinline__ void done(const Unit&) const {}
    __device__ __forceinline__ long a_off(const Unit& u, size_t tstep) const { return (long)((size_t)u.pm * tstep); }
    __device__ __forceinline__ int lda(int K) const { return K; }
    __device__ __forceinline__ size_t kstep_a() const { return (size_t)(BK * 2); }
};
template <class Epi, class Sched, bool ALIGN_EPI = false, bool SP2 = false>
__device__ __forceinline__ void gemm_phase(PG8_LAS unsigned char* lds, const Gemm g, const Sched& S, const Epi& E) {
    int tid_l = threadIdx.x; asm volatile("" : "+v"(tid_l)); const int tid = tid_l, wid = __builtin_amdgcn_readfirstlane(tid >> 6), lane = tid & 63, wr = wid >> 2, wc = wid & 3, fr = lane & 15, fq = lane >> 4;
    const int K = g.K, nt = K / BK;
    unsigned voffA[2], voffB[2];
    const int lda = S.lda(K);
#pragma unroll
    for (int i = 0; i < 2; ++i) { int R, C; stage_rc(tid * 16 + i * 8192, R, C); const int Rb = Epi::PERM ? ((R & ~31) + perm32(R & 31)) : R;
        voffA[i] = (unsigned)(R * lda + C) * 2u; voffB[i] = (unsigned)(Rb * K + C) * 2u; }
    const size_t kstep = (size_t)(BK * 2);
    const size_t hstep = (size_t)HALF * K * 2;
    const size_t tstep = 2 * hstep;
    const size_t kstepA = S.kstep_a(), hstepA = (size_t)HALF * lda * 2, tstepA = 2 * hstepA;
    const unsigned ldsw = (unsigned)wid * 1024u;
    const int aoff = lds_byte(wr * 64 + fr, fq * 8), boff = lds_byte(wc * 32 + fr, fq * 8);
#define PG8_SA(b, h) (((b) * 2 + (h)) * HTB)
#define PG8_SB(b, h) ((4 + (b) * 2 + (h)) * HTB)
#define PG8_STAGE(bufoff, gbase, voff) do { _Pragma("unroll") for (int _i = 0; _i < 2; ++_i) \
        __builtin_amdgcn_global_load_lds((const unsigned*)((const char*)(gbase) + (voff)[_i]), (PG8_LAS unsigned*)(lds + (bufoff) + ldsw + _i * 8192), 16, 0, 0); } while (0)
#define PG8_LDA(dst, b, h) do { _Pragma("unroll") for (int m = 0; m < 4; ++m) _Pragma("unroll") for (int k = 0; k < 2; ++k) dst[m][k] = *(const PG8_LAS bf16x8*)(lds + PG8_SA(b, h) + aoff + m * 2048 + k * 1024); } while (0)
#define PG8_LDB(dst, b, h) do { _Pragma("unroll") for (int n = 0; n < 2; ++n) _Pragma("unroll") for (int k = 0; k < 2; ++k) dst[n][k] = *(const PG8_LAS bf16x8*)(lds + PG8_SB(b, h) + boff + n * 2048 + k * 1024); } while (0)
#define PG8_MMA(ai, bj, At, Bt) do { __builtin_amdgcn_s_setprio(1); _Pragma("unroll") for (int m = 0; m < 4; ++m) _Pragma("unroll") for (int n = 0; n < 2; ++n) _Pragma("unroll") for (int k = 0; k < 2; ++k) \
        acc[ai][bj][m][n] = __builtin_amdgcn_mfma_f32_16x16x32_bf16(Bt[n][k], At[m][k], acc[ai][bj][m][n], 0, 0, 0); __builtin_amdgcn_s_setprio(0); } while (0)
#define PG8_WAIT_V(n) asm volatile("s_waitcnt vmcnt(" #n ")" ::: "memory")
#define PG8_WAIT_L(n) asm volatile("s_waitcnt lgkmcnt(" #n ")" ::: "memory")
#define PG8_BAR __builtin_amdgcn_s_barrier()
#define PG8_SCHED __builtin_amdgcn_sched_barrier(0)
    Unit cur, nxt; int ui = 0;
    if (!S.next(0, cur)) return;
    f32x4 acc[2][2][4][2];
#pragma unroll
    for (int a = 0; a < 2; ++a)
#pragma unroll
        for (int b = 0; b < 2; ++b)
#pragma unroll
            for (int m = 0; m < 4; ++m)
#pragma unroll
                for (int n = 0; n < 2; ++n) acc[a][b][m][n] = (f32x4){0.f, 0.f, 0.f, 0.f};
    bf16x8 At[4][2], B0[2][2], B1[2][2];
    const char* cA = (const char*)g.A + S.a_off(cur, tstepA); const char* cB = (const char*)g.Bt + (size_t)cur.pn * tstep;
    S.a_ready(cur);
    if constexpr (SP2) {
        PG8_STAGE(PG8_SB(0, 0), cB, voffB); PG8_STAGE(PG8_SB(0, 1), cB + hstep, voffB); PG8_STAGE(PG8_SA(0, 0), cA, voffA); PG8_STAGE(PG8_SA(0, 1), cA + hstepA, voffA);
        if (wr == 1) PG8_BAR;
        PG8_WAIT_V(2); PG8_BAR;
        PG8_STAGE(PG8_SB(1, 0), cB + kstep, voffB); PG8_STAGE(PG8_SA(1, 0), cA + kstepA, voffA); PG8_STAGE(PG8_SB(1, 1), cB + hstep + kstep, voffB);
        PG8_WAIT_V(6); PG8_BAR;
    } else {
        PG8_STAGE(PG8_SB(0, 0), cB, voffB); PG8_STAGE(PG8_SA(0, 0), cA, voffA); PG8_STAGE(PG8_SB(0, 1), cB + hstep, voffB); PG8_STAGE(PG8_SA(0, 1), cA + hstepA, voffA);
        if (wr == 1) PG8_BAR;
        PG8_WAIT_V(4); PG8_BAR;
        PG8_STAGE(PG8_SB(1, 0), cB + kstep, voffB); PG8_STAGE(PG8_SA(1, 0), cA + kstepA, voffA); PG8_STAGE(PG8_SB(1, 1), cB + hstep + kstep, voffB);
        PG8_WAIT_V(6); PG8_BAR;
    }
    for (;;) {
        const bool has_next = S.next(ui + 1, nxt);
        const char* nA = has_next ? (const char*)g.A + S.a_off(nxt, tstepA) : cA; const char* nB = has_next ? (const char*)g.Bt + (size_t)nxt.pn * tstep : cB;
        for (int t = 0; t < nt; t += 2) {
            const bool last = (t == nt - 2);
            const char* a1 = cA + (size_t)(t + 1) * kstepA;
            const char* a2 = last ? nA : cA + (size_t)(t + 2) * kstepA; const char* b2 = last ? nB : cB + (size_t)(t + 2) * kstep;
            const char* a3 = a2 + kstepA; const char* b3 = b2 + kstep;
            if (last && has_next) S.a_ready(nxt);
            if constexpr (SP2) {
            PG8_LDB(B0, 0, 0); PG8_LDB(B1, 0, 1); PG8_SCHED; PG8_LDA(At, 0, 0); PG8_STAGE(PG8_SA(1, 1), a1 + hstepA, voffA);
            PG8_WAIT_V(8); PG8_WAIT_L(0); PG8_BAR; PG8_MMA(0, 0, At, B0); PG8_MMA(0, 1, At, B1); PG8_BAR; PG8_SCHED;
            PG8_LDA(At, 0, 1); PG8_STAGE(PG8_SB(0, 0), b2, voffB); PG8_STAGE(PG8_SB(0, 1), b2 + hstep, voffB); PG8_STAGE(PG8_SA(0, 0), a2, voffA);
            PG8_WAIT_V(8); PG8_WAIT_L(0); PG8_BAR; PG8_MMA(1, 0, At, B0); PG8_MMA(1, 1, At, B1); PG8_BAR; PG8_SCHED;
            PG8_LDB(B0, 1, 0); PG8_LDB(B1, 1, 1); PG8_SCHED; PG8_LDA(At, 1, 0); PG8_STAGE(PG8_SA(0, 1), a2 + hstepA, voffA);
            PG8_WAIT_V(8); PG8_WAIT_L(0); PG8_BAR; PG8_MMA(0, 0, At, B0); PG8_MMA(0, 1, At, B1); PG8_BAR; PG8_SCHED;
            PG8_LDA(At, 1, 1); PG8_STAGE(PG8_SB(1, 0), b3, voffB); PG8_STAGE(PG8_SB(1, 1), b3 + hstep, voffB); PG8_STAGE(PG8_SA(1, 0), a3, voffA);
            PG8_WAIT_V(8); PG8_WAIT_L(0); PG8_BAR; PG8_MMA(1, 0, At, B0); PG8_MMA(1, 1, At, B1); PG8_BAR; PG8_SCHED;
            } else {
            PG8_LDB(B0, 0, 0); PG8_SCHED; PG8_LDA(At, 0, 0); PG8_STAGE(PG8_SA(1, 1), a1 + hstepA, voffA);
            PG8_WAIT_L(8); PG8_BAR; PG8_WAIT_L(0); PG8_MMA(0, 0, At, B0); PG8_BAR; PG8_SCHED;
            PG8_LDB(B1, 0, 1); PG8_STAGE(PG8_SB(0, 0), b2, voffB);
            PG8_BAR; PG8_WAIT_L(0); PG8_MMA(0, 1, At, B1); PG8_BAR;
            PG8_LDA(At, 0, 1); PG8_STAGE(PG8_SA(0, 0), a2, voffA);
            PG8_BAR; PG8_WAIT_L(0); PG8_MMA(1, 0, At, B0); PG8_BAR; PG8_SCHED;
            PG8_STAGE(PG8_SB(0, 1), b2 + hstep, voffB);
            PG8_WAIT_V(6); PG8_BAR; PG8_MMA(1, 1, At, B1); PG8_BAR;
            PG8_LDB(B0, 1, 0); PG8_SCHED; PG8_LDA(At, 1, 0); PG8_STAGE(PG8_SA(0, 1), a2 + hstepA, voffA);
            PG8_WAIT_L(8); PG8_BAR; PG8_WAIT_L(0); PG8_MMA(0, 0, At, B0); PG8_BAR; PG8_SCHED;
            PG8_LDB(B1, 1, 1); PG8_STAGE(PG8_SB(1, 0), b3, voffB);
            PG8_BAR; PG8_WAIT_L(0); PG8_MMA(0, 1, At, B1); PG8_BAR;
            PG8_LDA(At, 1, 1); PG8_STAGE(PG8_SA(1, 0), a3, voffA);
            PG8_BAR; PG8_WAIT_L(0); PG8_MMA(1, 0, At, B0); PG8_BAR; PG8_SCHED;
            PG8_STAGE(PG8_SB(1, 1), b3 + hstep, voffB);
            PG8_WAIT_V(6); PG8_BAR; PG8_MMA(1, 1, At, B1); PG8_BAR;
            }
        }
        if constexpr (ALIGN_EPI) { if (wr == 0) PG8_BAR; }
        if constexpr (!Epi::AFTER_DRAIN) { E(acc, cur, wr, wc, fr, fq); S.done(cur); }
        if (!has_next) break;
#pragma unroll
        for (int a = 0; a < 2; ++a)
#pragma unroll
            for (int b = 0; b < 2; ++b)
#pragma unroll
                for (int m = 0; m < 4; ++m)
#pragma unroll
                    for (int n = 0; n < 2; ++n) acc[a][b][m][n] = (f32x4){0.f, 0.f, 0.f, 0.f};
        cur = nxt; cA = nA; cB = nB; ++ui;
        if constexpr (ALIGN_EPI) { if (wr == 1) PG8_BAR; }
    }
    PG8_WAIT_V(0);
    if constexpr (!ALIGN_EPI) { if (wr == 0) PG8_BAR; }
    PG8_BAR;
    if constexpr (Epi::AFTER_DRAIN) { E.fused(acc, cur, wr, wc, fr, fq, lds, wid, lane); S.done(cur); }
#undef PG8_SA
#undef PG8_SB
#undef PG8_STAGE
#undef PG8_LDA
#undef PG8_LDB
#undef PG8_MMA
#undef PG8_WAIT_V
#undef PG8_WAIT_L
#undef PG8_BAR
#undef PG8_SCHED
}
}

using pg8::bf16_t; using pg8::bf16x8; using pg8::f32x4; using pg8::u32x4;
typedef float f32x16 __attribute__((ext_vector_type(16)));
typedef unsigned u32x2 __attribute__((ext_vector_type(2)));
typedef short bf16x4 __attribute__((ext_vector_type(4)));

constexpr int NB = 16, SEQ = 2048, DM = 1024, NT = NB * SEQ, MEMT = 256, NMT = NB * MEMT, HW = 512, INW = 3584, DFF = 2816, MIXW = 1536;
constexpr float ALPHA = 1.189207115002721f;
constexpr float LN_EPS = 1e-5f, RMS_EPS = 1e-5f;
constexpr int NTHR = 512, NWAVE = 8;
constexpr int LDS_BYTES = 151552;

constexpr size_t MiB = 1048576;
constexpr size_t WS_WALL = 0;
constexpr size_t WS_WKV  = 7 * MiB;
constexpr size_t WS_WOUT = 9 * MiB;
constexpr size_t WS_WUP  = 12 * MiB;
constexpr size_t WS_WDN  = 23 * MiB;
constexpr size_t WS_ROPE = 29 * MiB;
constexpr size_t WS_STAT = 29 * MiB + 524288;
constexpr size_t WS_XB   = 30 * MiB;
constexpr size_t WS_X1B  = 30 * MiB;
constexpr size_t WS_HTD  = 94 * MiB;
constexpr size_t WS_MEMB = 110 * MiB;
constexpr size_t WS_QKM  = 118 * MiB;
constexpr size_t WS_HT   = 214 * MiB;
constexpr size_t WS_KMEM = 342 * MiB;
constexpr size_t WS_VMT  = 346 * MiB;
constexpr size_t WS_KF   = 350 * MiB;
constexpr size_t WS_MIX  = 382 * MiB;
constexpr size_t WS_HH   = 96 * MiB;
constexpr size_t WS_ACT  = 272 * MiB;
constexpr size_t WS_BAR  = 478 * MiB;
constexpr size_t WS_CNT  = 478 * MiB + 16384;
constexpr size_t WS_XG   = 478 * MiB + 65536;
constexpr size_t WS_END  = 478 * MiB + 65536 + 2 * MiB;

__device__ __forceinline__ unsigned pk2(float lo, float hi) { unsigned r; asm volatile("v_cvt_pk_bf16_f32 %0, %1, %2" : "=v"(r) : "v"(lo), "v"(hi)); return r; }
__device__ __forceinline__ float bf2f(bf16_t v) { return __uint_as_float((unsigned)v << 16); }
__device__ __forceinline__ float lo2f(unsigned v) { return __uint_as_float(v << 16); }
__device__ __forceinline__ float hi2f(unsigned v) { return __uint_as_float(v & 0xffff0000u); }
#define LDS_WAIT() asm volatile("s_waitcnt lgkmcnt(0)" ::: "memory")

#ifndef FFT_HOST
#define FFT_FN __device__ __forceinline__
#define FFT_SYNC() __syncthreads()
typedef float cplx __attribute__((ext_vector_type(2)));
typedef LAS cplx* fftbuf_t;
FFT_FN float cos2pi(float r) { return __builtin_amdgcn_cosf(r); }
FFT_FN float sin2pi(float r) { return __builtin_amdgcn_sinf(r); }
#endif
FFT_FN cplx mk2(float x, float y) { cplx r; r.x = x; r.y = y; return r; }
FFT_FN cplx cadd(cplx a, cplx b) { return mk2(a.x + b.x, a.y + b.y); }
FFT_FN cplx csub(cplx a, cplx b) { return mk2(a.x - b.x, a.y - b.y); }
FFT_FN cplx cmul(cplx a, cplx b) { return mk2(a.x * b.x - a.y * b.y, a.x * b.y + a.y * b.x); }
template <bool INV> FFT_FN cplx muli(cplx a) { return INV ? mk2(-a.y, a.x) : mk2(a.y, -a.x); }
FFT_FN int padi(int i) { return i + (i >> 3); }

template <bool INV> FFT_FN void dft8(cplx (&v)[8]) {
    const float R = 0.70710678118654752f;
    const cplx a0 = cadd(v[0], v[4]), a1 = csub(v[0], v[4]), a2 = cadd(v[2], v[6]), a3 = muli<INV>(csub(v[2], v[6]));
    const cplx a4 = cadd(v[1], v[5]), a5 = csub(v[1], v[5]), a6 = cadd(v[3], v[7]), a7 = muli<INV>(csub(v[3], v[7]));
    const cplx b0 = cadd(a0, a2), b2 = csub(a0, a2), b1 = cadd(a1, a3), b3 = csub(a1, a3);
    const cplx b4 = cadd(a4, a6), b6 = muli<INV>(csub(a4, a6));
    const cplx t5 = cadd(a5, a7), t7 = csub(a5, a7);
    cplx b5, b7;
    if (!INV) { b5 = mk2((t5.x + t5.y) * R, (t5.y - t5.x) * R); b7 = mk2((t7.y - t7.x) * R, -(t7.x + t7.y) * R); }
    else      { b5 = mk2((t5.x - t5.y) * R, (t5.x + t5.y) * R); b7 = mk2(-(t7.x + t7.y) * R, (t7.x - t7.y) * R); }
    v[0] = cadd(b0, b4); v[4] = csub(b0, b4); v[1] = cadd(b1, b5); v[5] = csub(b1, b5);
    v[2] = cadd(b2, b6); v[6] = csub(b2, b6); v[3] = cadd(b3, b7); v[7] = csub(b3, b7);
}
template <int S, bool INV> FFT_FN void twid(cplx (&v)[8], int tid) {
    if (S > 1) {
        const int j = tid % S; const float rev = (float)j * (1.0f / (8.0f * S));
        const float c = cos2pi(rev), s = sin2pi(rev);
        const cplx w1 = mk2(c, INV ? s : -s);
        const cplx w2 = cmul(w1, w1), w3 = cmul(w2, w1), w4 = cmul(w2, w2), w5 = cmul(w4, w1), w6 = cmul(w4, w2), w7 = cmul(w4, w3);
        v[1] = cmul(v[1], w1); v[2] = cmul(v[2], w2); v[3] = cmul(v[3], w3); v[4] = cmul(v[4], w4);
        v[5] = cmul(v[5], w5); v[6] = cmul(v[6], w6); v[7] = cmul(v[7], w7);
    }
}
template <int S> FFT_FN void ld8(fftbuf_t X, int tid, cplx (&v)[8]) {
    const int base = (tid / S) * 8 * S + (tid % S);
#pragma unroll
    for (int k = 0; k < 8; ++k) v[k] = X[padi(base + S * k)];
}
template <int S> FFT_FN void st8(fftbuf_t X, int tid, const cplx (&v)[8]) {
    const int base = (tid / S) * 8 * S + (tid % S);
#pragma unroll
    for (int k = 0; k < 8; ++k) X[padi(base + S * k)] = v[k];
}
#ifndef FFT_HOST
template <int S> FFT_FN void twid_fill(fftbuf_t TW, int tid) {
    constexpr int P = (S == 512) ? 0 : (S == 64) ? 1 : 2;
    const int j = tid % S; const float rev = (float)j * (1.0f / (8.0f * S));
    const cplx w1 = mk2(cos2pi(rev), -sin2pi(rev)), w2 = cmul(w1, w1), w4 = cmul(w2, w2);
    TW[(3 * P + 0) * 512 + tid] = w1; TW[(3 * P + 1) * 512 + tid] = w2; TW[(3 * P + 2) * 512 + tid] = w4;
}
template <int S, bool INV> FFT_FN void twidL(cplx (&v)[8], fftbuf_t TW, int tid) {
    constexpr int P = (S == 512) ? 0 : (S == 64) ? 1 : 2;
    cplx w1 = TW[(3 * P + 0) * 512 + tid], w2 = TW[(3 * P + 1) * 512 + tid], w4 = TW[(3 * P + 2) * 512 + tid];
    if (INV) { w1.y = -w1.y; w2.y = -w2.y; w4.y = -w4.y; }
    const cplx w3 = cmul(w2, w1), w5 = cmul(w4, w1), w6 = cmul(w4, w2), w7 = cmul(w4, w3);
    v[1] = cmul(v[1], w1); v[2] = cmul(v[2], w2); v[3] = cmul(v[3], w3); v[4] = cmul(v[4], w4);
    v[5] = cmul(v[5], w5); v[6] = cmul(v[6], w6); v[7] = cmul(v[7], w7);
}
FFT_FN void fft_fwdL(fftbuf_t X, fftbuf_t TW, int tid, cplx (&v)[8]) {
    dft8<false>(v); twidL<512, false>(v, TW, tid); st8<512>(X, tid, v); FFT_SYNC();
    ld8<64>(X, tid, v); dft8<false>(v); twidL<64, false>(v, TW, tid); st8<64>(X, tid, v); FFT_SYNC();
    ld8<8>(X, tid, v); dft8<false>(v); twidL<8, false>(v, TW, tid); st8<8>(X, tid, v); FFT_SYNC();
    ld8<1>(X, tid, v); dft8<false>(v);
}
FFT_FN void fft_invL(fftbuf_t X, fftbuf_t TW, int tid, cplx (&v)[8]) {
    dft8<true>(v); st8<1>(X, tid, v); FFT_SYNC();
    ld8<8>(X, tid, v); twidL<8, true>(v, TW, tid); dft8<true>(v); st8<8>(X, tid, v); FFT_SYNC();
    ld8<64>(X, tid, v); twidL<64, true>(v, TW, tid); dft8<true>(v); st8<64>(X, tid, v); FFT_SYNC();
    ld8<512>(X, tid, v); twidL<512, true>(v, TW, tid); dft8<true>(v);
}
FFT_FN void fft_fwd(fftbuf_t X, int tid, cplx (&v)[8]) {
    dft8<false>(v); twid<512, false>(v, tid); st8<512>(X, tid, v); FFT_SYNC();
    ld8<64>(X, tid, v); dft8<false>(v); twid<64, false>(v, tid); st8<64>(X, tid, v); FFT_SYNC();
    ld8<8>(X, tid, v); dft8<false>(v); twid<8, false>(v, tid); st8<8>(X, tid, v); FFT_SYNC();
    ld8<1>(X, tid, v); dft8<false>(v);
}
FFT_FN void fft_inv(fftbuf_t X, int tid, cplx (&v)[8]) {
    dft8<true>(v); st8<1>(X, tid, v); FFT_SYNC();
    ld8<8>(X, tid, v); twid<8, true>(v, tid); dft8<true>(v); st8<8>(X, tid, v); FFT_SYNC();
    ld8<64>(X, tid, v); twid<64, true>(v, tid); dft8<true>(v); st8<64>(X, tid, v); FFT_SYNC();
    ld8<512>(X, tid, v); twid<512, true>(v, tid); dft8<true>(v);
}
#endif

struct OneUnit { int pm, pn; bool on;
    __device__ __forceinline__ bool next(int i, pg8::Unit& u) const { if (!on || i > 0) return false; u.pm = pm; u.pn = pn; return true; }
    __device__ __forceinline__ void a_ready(const pg8::Unit&) const {}
    __device__ __forceinline__ void done(const pg8::Unit&) const {}
    __device__ __forceinline__ long a_off(const pg8::Unit& u, size_t tstep) const { return (long)((size_t)u.pm * tstep); }
    __device__ __forceinline__ int lda(int K) const { return K; }
    __device__ __forceinline__ size_t kstep_a() const { return 128; } };

struct EpiB {
    static constexpr bool PERM = true, AFTER_DRAIN = false;
    bf16_t* O; int ldc;
    __device__ __forceinline__ void operator()(const f32x4 (&acc)[2][2][4][2], const pg8::Unit& u, int wr, int wc, int fr, int fq) const {
        const int row0 = u.pm * 256 + wr * 64 + fr, col0 = u.pn * 256 + wc * 32 + 8 * fq;
#pragma unroll
        for (int ai = 0; ai < 2; ++ai)
#pragma unroll
            for (int m = 0; m < 4; ++m) { bf16_t* rowp = O + (size_t)(row0 + ai * 128 + m * 16) * ldc + col0;
#pragma unroll
                for (int bj = 0; bj < 2; ++bj) { const f32x4 v0 = acc[ai][bj][m][0], v1 = acc[ai][bj][m][1];
                    u32x4 w; w.x = pk2(v0[0], v0[1]); w.y = pk2(v0[2], v0[3]); w.z = pk2(v1[0], v1[1]); w.w = pk2(v1[2], v1[3]);
                    *(u32x4*)(rowp + bj * 128) = w; } }
    }
};
struct EpiRope {
    static constexpr bool PERM = true, AFTER_DRAIN = false;
    bf16_t* O; const float2* rope;
    __device__ __forceinline__ void operator()(const f32x4 (&acc)[2][2][4][2], const pg8::Unit& u, int wr, int wc, int fr, int fq) const {
        const int row0 = u.pm * 256 + wr * 64 + fr, col0 = u.pn * 256 + wc * 32 + 8 * fq;
        const bool rot = u.pn < 4;
#pragma unroll
        for (int ai = 0; ai < 2; ++ai)
#pragma unroll
            for (int m = 0; m < 4; ++m) { const int row = row0 + ai * 128 + m * 16; bf16_t* rowp = O + (size_t)row * MIXW + col0;
#pragma unroll
                for (int bj = 0; bj < 2; ++bj) { f32x4 v0 = acc[ai][bj][m][0], v1 = acc[ai][bj][m][1];
                    if (rot) { const int pos = row & (SEQ - 1), i0 = ((col0 + bj * 128) & 63) >> 1;
                        const f32x4* rp = (const f32x4*)(rope + pos * 32 + i0); const f32x4 r0 = rp[0], r1 = rp[1];
                        f32x4 o0, o1;
                        o0[0] = v0[0] * r0[0] - v0[1] * r0[1]; o0[1] = v0[1] * r0[0] + v0[0] * r0[1];
                        o0[2] = v0[2] * r0[2] - v0[3] * r0[3]; o0[3] = v0[3] * r0[2] + v0[2] * r0[3];
                        o1[0] = v1[0] * r1[0] - v1[1] * r1[1]; o1[1] = v1[1] * r1[0] + v1[0] * r1[1];
                        o1[2] = v1[2] * r1[2] - v1[3] * r1[3]; o1[3] = v1[3] * r1[2] + v1[2] * r1[3];
                        v0 = o0; v1 = o1; }
                    u32x4 w; w.x = pk2(v0[0], v0[1]); w.y = pk2(v0[2], v0[3]); w.z = pk2(v1[0], v1[1]); w.w = pk2(v1[2], v1[3]);
                    *(u32x4*)(rowp + bj * 128) = w; } }
    }
};
constexpr int XCH_OFF = 131072 + 1024;
__device__ __forceinline__ void stat_put(LAS cplx* ST, int rowl, int wc, int fq, float s1, float s2, bool first) {
    s1 += __shfl_xor(s1, 16); s2 += __shfl_xor(s2, 16); s1 += __shfl_xor(s1, 32); s2 += __shfl_xor(s2, 32);
    if (fq == 0) { LAS cplx* p = ST + rowl * 4 + wc; cplx v; v.x = s1; v.y = s2; if (!first) { const cplx o = *p; v.x += o.x; v.y += o.y; } *p = v; }
}
struct EpiRes {
    static constexpr bool PERM = false, AFTER_DRAIN = false;
    const float* X; float* O; LAS unsigned char* lds; mutable int ecnt;
    __device__ __forceinline__ void operator()(const f32x4 (&acc)[2][2][4][2], const pg8::Unit& u, int wr, int wc, int fr, int fq) const {
        const int row0 = u.pm * 256 + wr * 64 + fr, col0 = u.pn * 256 + wc * 32 + 4 * fq;
        LAS cplx* ST = (LAS cplx*)(lds + XCH_OFF) + (ecnt & 1) * 1024; const bool first = true; ++ecnt;
#pragma unroll
        for (int ai = 0; ai < 2; ++ai) {
            f32x4 xv[4][2][2];
#pragma unroll
            for (int m = 0; m < 4; ++m)
#pragma unroll
                for (int bj = 0; bj < 2; ++bj)
#pragma unroll
                    for (int n = 0; n < 2; ++n) xv[m][bj][n] = *(const f32x4*)(X + (size_t)(row0 + ai * 128 + m * 16) * DM + col0 + bj * 128 + 16 * n);
            asm volatile("" ::: "memory");
#pragma unroll
            for (int m = 0; m < 4; ++m) { float s1 = 0.f, s2 = 0.f;
#pragma unroll
                for (int bj = 0; bj < 2; ++bj)
#pragma unroll
                    for (int n = 0; n < 2; ++n) { const f32x4 o = acc[ai][bj][m][n] + xv[m][bj][n] * ALPHA;
                        *(f32x4*)(O + (size_t)(row0 + ai * 128 + m * 16) * DM + col0 + bj * 128 + 16 * n) = o;
                        s1 += (o[0] + o[1]) + (o[2] + o[3]); s2 += (o[0] * o[0] + o[1] * o[1]) + (o[2] * o[2] + o[3] * o[3]); }
                stat_put(ST, ai * 128 + wr * 64 + m * 16 + fr, wc, fq, s1, s2, first); }
        }
    }
};
struct EpiRes2 {
    static constexpr bool PERM = false, AFTER_DRAIN = false;
    const float* R; float* O; const float2* stat; const float* g; const float* b; LAS unsigned char* lds; mutable int ecnt;
    __device__ __forceinline__ void operator()(const f32x4 (&acc)[2][2][4][2], const pg8::Unit& u, int wr, int wc, int fr, int fq) const {
        const int row0 = u.pm * 256 + wr * 64 + fr, col0 = u.pn * 256 + wc * 32 + 4 * fq;
        LAS cplx* ST = (LAS cplx*)(lds + XCH_OFF) + (ecnt & 1) * 1024; const bool first = true; ++ecnt;
#pragma unroll
        for (int ai = 0; ai < 2; ++ai)
#pragma unroll
            for (int bj = 0; bj < 2; ++bj) {
                f32x4 rv[4][2], gv[2], bv[2]; float2 st[4];
#pragma unroll
                for (int m = 0; m < 4; ++m) { const int row = row0 + ai * 128 + m * 16; st[m] = stat[row];
#pragma unroll
                    for (int n = 0; n < 2; ++n) rv[m][n] = *(const f32x4*)(R + (size_t)row * DM + col0 + bj * 128 + 16 * n); }
#pragma unroll
                for (int n = 0; n < 2; ++n) { gv[n] = *(const f32x4*)(g + col0 + bj * 128 + 16 * n); bv[n] = *(const f32x4*)(b + col0 + bj * 128 + 16 * n); }
                asm volatile("" ::: "memory");
#pragma unroll
                for (int m = 0; m < 4; ++m) { float s1 = 0.f, s2 = 0.f;
#pragma unroll
                    for (int n = 0; n < 2; ++n) { const f32x4 x1 = (rv[m][n] - st[m].x) * st[m].y * gv[n] + bv[n]; const f32x4 o = acc[ai][bj][m][n] + x1 * ALPHA;
                        *(f32x4*)(O + (size_t)(row0 + ai * 128 + m * 16) * DM + col0 + bj * 128 + 16 * n) = o;
                        s1 += (o[0] + o[1]) + (o[2] + o[3]); s2 += (o[0] * o[0] + o[1] * o[1]) + (o[2] * o[2] + o[3] * o[3]); }
                    stat_put(ST, ai * 128 + wr * 64 + m * 16 + fr, wc, fq, s1, s2, first && bj == 0); }
            }
    }
};
struct PairOrder : pg8::StaticOrder {
    bool pair;
    __device__ __forceinline__ static int vcu_of(int c) { return (c & 7) * 32 + (c >> 3); }
    __device__ __forceinline__ bool next(int i, pg8::Unit& u) const {
        if (!pair) return pg8::StaticOrder::next(i, u);
        if (i > 1) return false;
        const int v = vcu_of(c); u.pm = 2 * (v >> 2) + i; u.pn = v & 3; return true; }
};
struct KbOrder : pg8::StaticOrder {
    __device__ __forceinline__ int lda(int) const { return 64; }
    __device__ __forceinline__ size_t kstep_a() const { return (size_t)NT * 64 * 2; }
};
struct PairKb : PairOrder {
    __device__ __forceinline__ int lda(int) const { return 64; }
    __device__ __forceinline__ size_t kstep_a() const { return (size_t)NT * 64 * 2; }
};
struct RevOrder : pg8::StaticOrder {
    __device__ __forceinline__ bool next(int i, pg8::Unit& u) const { const int rounds = (nwg + G - 1) / G; if (i >= rounds) return false; return pg8::StaticOrder::next(rounds - 1 - i, u); }
};
constexpr int CWL_OFF = 131072 + 1024 + 8192;
struct FfnOrder : pg8::StaticOrder {
    const float* cw; const float* cb; LAS unsigned char* lds; mutable int cnt;
    __device__ __forceinline__ long a_off(const pg8::Unit& u, size_t) const { return ((long)u.pm * 254 - 1) * (long)(DM * 2); }
    __device__ __forceinline__ void a_ready(const pg8::Unit& u) const {
        const int tid = threadIdx.x, w = __builtin_amdgcn_readfirstlane(tid >> 6), lane = tid & 63, buf = cnt & 1; ++cnt;
        const float* src = (w < 3) ? cw + (size_t)w * (2 * DFF) : (w < 6) ? cw + (size_t)(w - 3) * (2 * DFF) + DFF : (w == 6) ? cb : cb + DFF;
        src += u.pn * 128 + lane * 4;
        if (lane < 32) __builtin_amdgcn_global_load_lds((const unsigned*)src, (LAS unsigned*)(lds + CWL_OFF + buf * 4096 + w * 512), 16, 0, 0);
    }
};
constexpr int FFN_MT = 130;
__device__ __forceinline__ float dpp_ror1(float v)  { return __int_as_float(__builtin_amdgcn_update_dpp(0, __float_as_int(v), 0x121, 0xF, 0xF, false)); }
__device__ __forceinline__ float dpp_ror15(float v) { return __int_as_float(__builtin_amdgcn_update_dpp(0, __float_as_int(v), 0x12F, 0xF, 0xF, false)); }
struct EpiFfn {
    static constexpr bool PERM = true, AFTER_DRAIN = false;
    bf16_t* ACT; LAS unsigned char* lds; mutable int ecnt;
    __device__ __forceinline__ void operator()(const f32x4 (&acc)[2][2][4][2], const pg8::Unit& u, int wr, int wc, int fr, int fq) const {
        LAS float* XC = (LAS float*)(lds + XCH_OFF);
        const LAS float* WL = (const LAS float*)(lds + CWL_OFF + (ecnt & 1) * 4096); ++ecnt;
        const int colw = wc * 32 + 8 * fq;
        if (fr == 0 || fr == 15) {
            const int edge = (fr == 15) ? 1 : 0, m = (fr == 15) ? 3 : 0;
#pragma unroll
            for (int ai = 0; ai < 2; ++ai)
#pragma unroll
                for (int bj = 0; bj < 2; ++bj)
#pragma unroll
                    for (int n = 0; n < 2; ++n) { const f32x4 v = (m == 0) ? acc[ai][bj][0][n] : acc[ai][bj][3][n];
                        *(LAS f32x4*)(XC + ((ai * 2 + wr) * 2 + edge) * 256 + bj * 128 + colw + 4 * n) = v; }
        }
        asm volatile("s_waitcnt lgkmcnt(0)" ::: "memory"); __builtin_amdgcn_s_barrier(); asm volatile("" ::: "memory");
        const int slot0 = wr * 64 + fr, row_base = u.pm * 254 - 1;
#pragma unroll
        for (int bj = 0; bj < 2; ++bj) {
            const int gc = (u.pn * 256 + bj * 128 + colw) >> 1;
            const LAS float* wl = WL + ((bj * 128 + colw) >> 1);
            f32x4 wg[3], wu[3];
#pragma unroll
            for (int j = 0; j < 3; ++j) { wg[j] = *(const LAS f32x4*)(wl + j * 128); wu[j] = *(const LAS f32x4*)(wl + (3 + j) * 128); }
            const f32x4 bg = *(const LAS f32x4*)(wl + 6 * 128), bu = *(const LAS f32x4*)(wl + 7 * 128);
#pragma unroll
            for (int ai = 0; ai < 2; ++ai) {
                const int gidx = ai * 2 + wr;
                f32x4 pe[2], ne[2];
#pragma unroll
                for (int n = 0; n < 2; ++n) {
                    pe[n] = (gidx > 0) ? *(const LAS f32x4*)(XC + (((gidx - 1) * 2) + 1) * 256 + bj * 128 + colw + 4 * n) : (f32x4){0.f, 0.f, 0.f, 0.f};
                    ne[n] = (gidx < 3) ? *(const LAS f32x4*)(XC + (((gidx + 1) * 2) + 0) * 256 + bj * 128 + colw + 4 * n) : (f32x4){0.f, 0.f, 0.f, 0.f}; }
#pragma unroll
                for (int m = 0; m < 4; ++m) {
                    const int slot = ai * 128 + slot0 + m * 16, row = row_base + slot, t = row & (SEQ - 1);
                    f32x4 hv[2];
#pragma unroll
                    for (int n = 0; n < 2; ++n) {
                        const f32x4 cur = acc[ai][bj][m][n], prv = acc[ai][bj][m == 0 ? 0 : m - 1][n], nxt = acc[ai][bj][m == 3 ? 3 : m + 1][n];
                        f32x4 up, dn;
#pragma unroll
                        for (int e = 0; e < 4; ++e) { up[e] = dpp_ror1(fr == 15 ? prv[e] : cur[e]); dn[e] = dpp_ror15(fr == 0 ? nxt[e] : cur[e]); }
                        if (m == 0 && fr == 0) up = pe[n];
                        if (m == 3 && fr == 15) dn = ne[n];
                        if (t == 0) up = (f32x4){0.f, 0.f, 0.f, 0.f};
                        if (t == SEQ - 1) dn = (f32x4){0.f, 0.f, 0.f, 0.f};
                        const f32x4 w0 = n ? wu[0] : wg[0], w1 = n ? wu[1] : wg[1], w2 = n ? wu[2] : wg[2], bb = n ? bu : bg;
                        hv[n] = w0 * up + w1 * cur + w2 * dn + bb; }
                    if (slot >= 1 && slot <= 254 && row < NT) {
                        float o[4];
#pragma unroll
                        for (int e = 0; e < 4; ++e) { const float g = hv[0][e]; o[e] = g * __builtin_amdgcn_rcpf(1.0f + __expf(-g)) * hv[1][e]; }
                        u32x2 w; w.x = pk2(o[0], o[1]); w.y = pk2(o[2], o[3]);
                        *(u32x2*)(ACT + ((size_t)(gc >> 6) * NT + row) * 64 + (gc & 63)) = w; }
                }
            }
        }
    }
};

__device__ __forceinline__ int win_row(int n) {
    if (n < 1536) return 1536 + n;
    if (n < 2560) { const int q = n - 1536, blk = q >> 6, d = q & 63; return blk * 64 + 2 * (d & 31) + (d >> 5); }
    if (n < 3072) return 512 + n;
    return n - 2048;
}
template <int MODE> __device__ __forceinline__ void p0_transpose_item(const float* W, int K, int N, bf16_t* WT, LAS float* scr, int item, int lane) {
    const int nblk = N / 32, kb = item / nblk, nb = item % nblk, k0 = 64 * kb, n0 = 32 * nb;
    f32x4 q[8];
#pragma unroll
    for (int i = 0; i < 8; ++i) q[i] = *(const f32x4*)(W + (size_t)(k0 + 8 * i + (lane >> 3)) * N + n0 + 4 * (lane & 7));
#pragma unroll
    for (int i = 0; i < 8; ++i) { LAS float* d = scr + (8 * i + (lane >> 3)) * 33 + 4 * (lane & 7); d[0] = q[i][0]; d[1] = q[i][1]; d[2] = q[i][2]; d[3] = q[i][3]; }
    LDS_WAIT(); asm volatile("" ::: "memory");
    const int c = lane & 7;
#pragma unroll
    for (int j = 0; j < 4; ++j) { const int n = (lane >> 3) + 8 * j; const LAS float* s = scr + (8 * c) * 33 + n;
        u32x4 o; o.x = pk2(s[0 * 33], s[1 * 33]); o.y = pk2(s[2 * 33], s[3 * 33]); o.z = pk2(s[4 * 33], s[5 * 33]); o.w = pk2(s[6 * 33], s[7 * 33]);
        const int nn = n0 + n; const int dr = (MODE == 1) ? win_row(nn) : (MODE == 2) ? ((nn < DFF) ? ((nn >> 2) * 8 + (nn & 3)) : (((nn - DFF) >> 2) * 8 + 4 + ((nn - DFF) & 3))) : nn;
        *(u32x4*)(WT + (size_t)dr * K + k0 + 8 * c) = o; }
    LDS_WAIT(); asm volatile("" ::: "memory");
}
__device__ __forceinline__ void cvt_rows(const float* src, bf16_t* dst, size_t n8, int gw, int ngw, int lane) {
    const size_t stride = (size_t)ngw * 64;
    for (size_t i = (size_t)gw * 64 + lane; i < n8; i += 4 * stride) {
        f32x4 a[4], c[4];
#pragma unroll
        for (int u = 0; u < 4; ++u) { const size_t k = i + u * stride; if (k < n8) { a[u] = ((const f32x4*)src)[2 * k]; c[u] = ((const f32x4*)src)[2 * k + 1]; } }
#pragma unroll
        for (int u = 0; u < 4; ++u) { const size_t k = i + u * stride; if (k < n8) {
            u32x4 w; w.x = pk2(a[u][0], a[u][1]); w.y = pk2(a[u][2], a[u][3]); w.z = pk2(c[u][0], c[u][1]); w.w = pk2(c[u][2], c[u][3]);
            ((u32x4*)dst)[k] = w; } }
    }
}
__device__ __forceinline__ void p0_filter_item(const LAS float* w1, const float* b1, const float* fq, const LAS float* w2, const float* b2, const float* w3, float* HTD, int item, int lane) {
    const int t0 = 2 * (item >> 2), ih = item & 3; float h2v[2], tl[2];
    const float fql = fq[lane], b1l = b1[lane], b2l = b2[lane];
#pragma unroll
    for (int tt = 0; tt < 2; ++tt) { const int t = t0 + tt; tl[tt] = (float)t * (1.0f / 2047.0f);
        const float w = 6.283185307179586f * (float)t / 2048.0f;
        float zk = 0.f;
        if (lane == 0) zk = tl[tt];
        else if (lane <= 16) { const float fr = 1e-4f + (float)(lane - 1) * ((15.0f - 1e-4f) / 15.0f); zk = cosf(fr * w); }
        else if (lane <= 32) { const float fr = 1e-4f + (float)(lane - 17) * ((15.0f - 1e-4f) / 15.0f); zk = -sinf(fr * w); }
        float a = b1l;
#pragma unroll 11
        for (int k = 0; k < 33; ++k) a += __shfl(zk, k) * w1[k * 64 + lane];
        const float h1 = sinf(fql * a);
        float a2 = b2l;
#pragma unroll 16
        for (int k = 0; k < 64; ++k) a2 += __shfl(h1, k) * w2[k * 64 + lane];
        h2v[tt] = sinf(fql * a2); }
    const float dmin = -15.350567286626973f, dmax = -3.0701134573253946f;
    float acc0[8], acc1[8];
#pragma unroll
    for (int i = 0; i < 8; ++i) { acc0[i] = 0.f; acc1[i] = 0.f; }
#pragma unroll 8
    for (int j = 0; j < 64; ++j) { const float s0 = __shfl(h2v[0], j), s1 = __shfl(h2v[1], j); const float* wr = w3 + (size_t)j * 2048 + ih * 512 + lane;
#pragma unroll
        for (int i = 0; i < 8; ++i) { const float wv = wr[64 * i]; acc0[i] += s0 * wv; acc1[i] += s1 * wv; } }
#pragma unroll
    for (int i = 0; i < 8; ++i) { const int col = ih * 512 + 64 * i + lane, c = col & 511;
        const float delta = fabsf(dmin + (float)c * ((dmax - dmin) / 511.0f));
        float2 o; o.x = acc0[i] * expf(-tl[0] * delta); o.y = acc1[i] * expf(-tl[1] * delta);
        *(float2*)(HTD + (size_t)col * 2048 + t0) = o; }
}
__device__ __forceinline__ void p0_prep(const float* const* in, unsigned char* ws, LAS unsigned char* lds, int tid) {
    const int lane = tid & 63, wave = __builtin_amdgcn_readfirstlane(tid >> 6), gw = blockIdx.x * NWAVE + wave, ngw = gridDim.x * NWAVE;
    LAS float* scr = (LAS float*)(lds + wave * 8704);
    LAS float* W1L = (LAS float*)(lds + 69632); LAS float* W2L = W1L + 33 * 64;
    for (int i = tid; i < 33 * 64; i += NTHR) W1L[i] = in[5][i];
    for (int i = tid; i < 64 * 64; i += NTHR) W2L[i] = in[8][i];
    __syncthreads();
    bf16_t* WALL = (bf16_t*)(ws + WS_WALL);
    constexpr int I_IN = 16 * (INW / 32), I_KV = 16 * 32, I_OUT = 24 * 32, I_UP = 16 * (2 * DFF / 32), I_DN = (DFF / 64) * 32, NIT = I_IN + I_KV + I_OUT + I_UP + I_DN;
    for (int it = gw; it < NIT; it += ngw) { int r = it;
        if (r < I_IN) { p0_transpose_item<1>(in[2], DM, INW, WALL, scr, r, lane); continue; } r -= I_IN;
        if (r < I_KV) { p0_transpose_item<0>(in[14], DM, 1024, (bf16_t*)(ws + WS_WKV), scr, r, lane); continue; } r -= I_KV;
        if (r < I_OUT) { p0_transpose_item<0>(in[15], MIXW, DM, (bf16_t*)(ws + WS_WOUT), scr, r, lane); continue; } r -= I_OUT;
        if (r < I_UP) { p0_transpose_item<2>(in[18], DM, 2 * DFF, (bf16_t*)(ws + WS_WUP), scr, r, lane); continue; } r -= I_UP;
        p0_transpose_item<0>(in[21], DFF, DM, (bf16_t*)(ws + WS_WDN), scr, r, lane); }
    for (int it = ngw - 1 - gw; it < 4096; it += ngw) p0_filter_item(W1L, in[6], in[7], W2L, in[9], in[10], (float*)(ws + WS_HTD), it, lane);
    cvt_rows(in[0], (bf16_t*)(ws + WS_XB), (size_t)NT * DM / 8, gw, ngw, lane);
    cvt_rows(in[1], (bf16_t*)(ws + WS_MEMB), (size_t)NMT * DM / 8, gw, ngw, lane);
    float2* rope = (float2*)(ws + WS_ROPE);
    for (int i = blockIdx.x * NTHR + tid; i < SEQ * 32; i += gridDim.x * NTHR) { const int pos = i >> 5, f = i & 31;
        const float invf = powf(10000.0f, -(float)(2 * f) / 64.0f); const float ang = (float)pos * invf;
        float2 cs; cs.x = cosf(ang); cs.y = sinf(ang); rope[i] = cs; }
}

__device__ __forceinline__ void filter_fft_item(const float* HTD, float2* KF, LAS unsigned char* lds, int item, int tid) {
    const int o = item >> 9, c = item & 511;
    const float* rf = HTD + (size_t)((o * 2 + 0) * 512 + c) * 2048; const float* rb = HTD + (size_t)((o * 2 + 1) * 512 + c) * 2048;
    cplx v[8];
#pragma unroll
    for (int k = 0; k < 4; ++k) v[k] = mk2(rf[tid + 512 * k], 0.f);
    v[4] = mk2(tid == 0 ? 0.f : rb[2048 - tid], 0.f); v[5] = mk2(rb[1536 - tid], 0.f); v[6] = mk2(rb[1024 - tid], 0.f); v[7] = mk2(rb[512 - tid], 0.f);
    fft_fwd((LAS cplx*)lds, tid, v);
    float2* dst = KF + (size_t)(o * 512 + c) * 4096 + 8 * tid;
#pragma unroll
    for (int m = 0; m < 8; m += 2) { f32x4 w; w[0] = v[m].x * (1.f / 4096.f); w[1] = v[m].y * (1.f / 4096.f); w[2] = v[m + 1].x * (1.f / 4096.f); w[3] = v[m + 1].y * (1.f / 4096.f); *(f32x4*)(dst + m) = w; }
    __syncthreads();
}

constexpr int HY_SEG = 2064, HY_STG_OFF = 36864;
__device__ __forceinline__ float conv3s(const LAS bf16_t* seg, int n, float w0, float w1, float w2, float b) {
    return w0 * bf2f(seg[7 + n]) + w1 * bf2f(seg[8 + n]) + w2 * bf2f(seg[9 + n]) + b;
}
__device__ __forceinline__ void hyena_item(const bf16_t* HT, const float2* KF, const float* cw, const float* cb, const float* hb, bf16_t* MIX, LAS unsigned char* lds, int bp, int cgp, int tid0) {
    LAS cplx* X = (LAS cplx*)lds; LAS bf16_t* STG = (LAS bf16_t*)(lds + HY_STG_OFF); LAS cplx* TW = (LAS cplx*)(lds + 65536);
    const int ba = 2 * bp;
    twid_fill<512>(TW, tid0); twid_fill<64>(TW, tid0); twid_fill<8>(TW, tid0);
    u32x4 oacc[8];
#pragma unroll
    for (int i = 0; i < 8; ++i) oacc[i] = (u32x4){0u, 0u, 0u, 0u};
    if (tid0 < 12) { const int sg = tid0 >> 1; STG[sg * HY_SEG + ((tid0 & 1) ? 2056 : 7)] = 0; }
    { const int c = cgp * 8;
#pragma unroll
      for (int i = 0; i < 3; ++i) { const int id = tid0 + 512 * i, sg = id >> 8, ch = id & 255;
          const u32x4 q = *(const u32x4*)(HT + (size_t)((sg >> 1) * 512 + c) * NT + (ba + (sg & 1)) * SEQ + ch * 8);
          *(LAS u32x4*)(STG + sg * HY_SEG + 8 + ch * 8) = q; } }
    __syncthreads();
#pragma unroll 1
    for (int cc = 0; cc < 8; ++cc) {
        const int c = cgp * 8 + cc;
        int tl_ = tid0; asm volatile("" : "+v"(tl_)); const int tid = tl_;
        u32x4 nx[3];
        if (cc < 7) {
#pragma unroll
            for (int i = 0; i < 3; ++i) { const int id = tid + 512 * i, sg = id >> 8, ch = id & 255;
                nx[i] = *(const u32x4*)(HT + (size_t)((sg >> 1) * 512 + c + 1) * NT + (ba + (sg & 1)) * SEQ + ch * 8); } }
        f32x4 kf[4];
        { const f32x4* kp = (const f32x4*)(KF + (size_t)c * 4096 + 8 * tid);
#pragma unroll
          for (int m = 0; m < 4; ++m) kf[m] = kp[m]; }
        cplx v[8]; float va[4], vb[4];
        { const float w0 = cw[c], w1 = cw[1536 + c], w2 = cw[3072 + c], b = cb[c];
#pragma unroll
          for (int k = 0; k < 4; ++k) { const int n = tid + 512 * k; va[k] = conv3s(STG, n, w0, w1, w2, b); vb[k] = conv3s(STG + HY_SEG, n, w0, w1, w2, b); v[k] = mk2(va[k], vb[k]); v[4 + k] = mk2(0.f, 0.f); } }
        fft_fwdL(X, TW, tid, v);
#pragma unroll
        for (int m = 0; m < 8; m += 2) { const f32x4 w = kf[m >> 1]; v[m] = cmul(v[m], mk2(w[0], w[1])); v[m + 1] = cmul(v[m + 1], mk2(w[2], w[3])); }
        { const f32x4* kp = (const f32x4*)(KF + (size_t)(512 + c) * 4096 + 8 * tid);
#pragma unroll
          for (int m = 0; m < 4; ++m) kf[m] = kp[m]; }
        fft_invL(X, TW, tid, v);
        { const float w0 = cw[512 + c], w1 = cw[1536 + 512 + c], w2 = cw[3072 + 512 + c], b = cb[512 + c], hb0 = hb[c];
#pragma unroll
          for (int k = 0; k < 4; ++k) { const int n = tid + 512 * k; const float xa = conv3s(STG + 2 * HY_SEG, n, w0, w1, w2, b), xb = conv3s(STG + 3 * HY_SEG, n, w0, w1, w2, b);
              va[k] = xa * (v[k].x + hb0 * va[k]); vb[k] = xb * (v[k].y + hb0 * vb[k]); v[k] = mk2(va[k], vb[k]); v[4 + k] = mk2(0.f, 0.f); } }
        fft_fwdL(X, TW, tid, v);
#pragma unroll
        for (int m = 0; m < 8; m += 2) { const f32x4 w = kf[m >> 1]; v[m] = cmul(v[m], mk2(w[0], w[1])); v[m + 1] = cmul(v[m + 1], mk2(w[2], w[3])); }
        fft_invL(X, TW, tid, v);
        { const float w0 = cw[1024 + c], w1 = cw[1536 + 1024 + c], w2 = cw[3072 + 1024 + c], b = cb[1024 + c], hb1 = hb[512 + c];
#pragma unroll
          for (int k = 0; k < 4; ++k) { const int n = tid + 512 * k; const float xa = conv3s(STG + 4 * HY_SEG, n, w0, w1, w2, b), xb = conv3s(STG + 5 * HY_SEG, n, w0, w1, w2, b);
              const float oa = xa * (v[k].x + hb1 * va[k]), ob = xb * (v[k].y + hb1 * vb[k]);
              const unsigned pw = pk2(oa, ob);
#pragma unroll
              for (int hh = 0; hh < 2; ++hh) { u32x4& o = oacc[2 * k + hh]; const unsigned nw = hh ? (pw & 0xffff0000u) : (pw << 16);
                  o.x = __builtin_amdgcn_alignbit(o.y, o.x, 16); o.y = __builtin_amdgcn_alignbit(o.z, o.y, 16); o.z = __builtin_amdgcn_alignbit(o.w, o.z, 16); o.w = (o.w >> 16) | nw; } } }
        __syncthreads();
        if (cc < 7) {
#pragma unroll
            for (int i = 0; i < 3; ++i) { const int id = tid + 512 * i, sg = id >> 8, ch = id & 255; *(LAS u32x4*)(STG + sg * HY_SEG + 8 + ch * 8) = nx[i]; } }
        __syncthreads();
    }
    int tw_ = tid0; asm volatile("" : "+v"(tw_)); const int tid = tw_;
#pragma unroll
    for (int k = 0; k < 4; ++k)
#pragma unroll
        for (int hh = 0; hh < 2; ++hh) *(u32x4*)(MIX + (size_t)((ba + hh) * SEQ + tid + 512 * k) * MIXW + cgp * 8) = oacc[2 * k + hh];
}

constexpr int ATT_KP = 272, ATT_VP = 144, ATT_KB = 64 * ATT_KP, ATT_VB = 128 * ATT_VP, ATT_VOFF = 2 * ATT_KB;
template <int NC> __device__ __forceinline__ void attn_unit(LAS unsigned char* lds, const bf16_t* Qp, int ldq, const bf16_t* Kp, int ldk, const bf16_t* Vt, int ldv, int nkeys, float sl2,
                                                            bf16_t* Op, int ldo, float lam, const float* subg, int tid) {
    constexpr int NSTEP = (NC == 2) ? 4 : 8;
    const int lane = tid & 63, wave = tid >> 6, r = lane & 31, h = lane >> 5;
    const int qb = (NC == 2) ? (wave & 3) : wave, comp = (NC == 2) ? (wave >> 2) : 0, dbase = comp * 64;
    bf16x8 qf[NSTEP];
#pragma unroll
    for (int st = 0; st < NSTEP; ++st) qf[st] = *(const bf16x8*)(Qp + (size_t)(qb * 32 + r) * ldq + dbase + 16 * st + 8 * h);
    f32x16 o[4];
#pragma unroll
    for (int et = 0; et < 4; ++et)
#pragma unroll
        for (int i = 0; i < 16; ++i) o[et][i] = 0.f;
    float mold = -INFINITY, lsum = 0.f;
    const int kr0 = tid >> 4, kc = tid & 15, vr0 = tid >> 3, vc = tid & 7;
    const bf16_t* kg = Kp + (size_t)kr0 * ldk + kc * 8; const bf16_t* vg = Vt + (size_t)vr0 * ldv + vc * 8;
    const int kl = kr0 * ATT_KP + kc * 16, vl = ATT_VOFF + vr0 * ATT_VP + vc * 16;
    const int nt = nkeys / 64;
    u32x4 pk0, pk1, pv0, pv1;
    pk0 = *(const u32x4*)(kg); pk1 = *(const u32x4*)(kg + (size_t)32 * ldk); pv0 = *(const u32x4*)(vg); pv1 = *(const u32x4*)(vg + (size_t)64 * ldv);
    *(LAS u32x4*)(lds + kl) = pk0; *(LAS u32x4*)(lds + kl + 32 * ATT_KP) = pk1; *(LAS u32x4*)(lds + vl) = pv0; *(LAS u32x4*)(lds + vl + 64 * ATT_VP) = pv1;
    __syncthreads();
    for (int it = 0; it < nt; ++it) {
        const int cur = it & 1; const bool more = (it + 1 < nt);
        if (more) { const bf16_t* kg2 = kg + (size_t)(it + 1) * 64 * ldk; const bf16_t* vg2 = vg + (it + 1) * 64;
            pk0 = *(const u32x4*)(kg2); pk1 = *(const u32x4*)(kg2 + (size_t)32 * ldk); pv0 = *(const u32x4*)(vg2); pv1 = *(const u32x4*)(vg2 + (size_t)64 * ldv); }
        LAS unsigned char* Kb = lds + cur * ATT_KB; LAS unsigned char* Vb = lds + ATT_VOFF + cur * ATT_VB;
        f32x16 s[2];
#pragma unroll
        for (int kb = 0; kb < 2; ++kb) {
#pragma unroll
            for (int i = 0; i < 16; ++i) s[kb][i] = 0.f;
#pragma unroll
            for (int st = 0; st < NSTEP; ++st) { const bf16x8 a = *(const LAS bf16x8*)(Kb + (kb * 32 + r) * ATT_KP + (dbase + 16 * st + 8 * h) * 2);
                s[kb] = __builtin_amdgcn_mfma_f32_32x32x16_bf16(a, qf[st], s[kb], 0, 0, 0); } }
        float mx = s[0][0];
#pragma unroll
        for (int i = 1; i < 16; ++i) mx = fmaxf(mx, s[0][i]);
#pragma unroll
        for (int i = 0; i < 16; ++i) mx = fmaxf(mx, s[1][i]);
        mx = fmaxf(mx, __shfl_xor(mx, 32));
        const float mnew = fmaxf(mold, mx * sl2), alpha = __builtin_amdgcn_exp2f(mold - mnew); mold = mnew;
        float ps = 0.f;
#pragma unroll
        for (int kb = 0; kb < 2; ++kb)
#pragma unroll
            for (int i = 0; i < 16; ++i) { const float p = __builtin_amdgcn_exp2f(__builtin_fmaf(s[kb][i], sl2, -mnew)); s[kb][i] = p; ps += p; }
        lsum = lsum * alpha + ps;
#pragma unroll
        for (int et = 0; et < 4; ++et)
#pragma unroll
            for (int i = 0; i < 16; ++i) o[et][i] *= alpha;
#pragma unroll
        for (int kb = 0; kb < 2; ++kb)
#pragma unroll
            for (int s2 = 0; s2 < 2; ++s2) {
                u32x4 pw; pw.x = pk2(s[kb][8 * s2 + 0], s[kb][8 * s2 + 1]); pw.y = pk2(s[kb][8 * s2 + 2], s[kb][8 * s2 + 3]); pw.z = pk2(s[kb][8 * s2 + 4], s[kb][8 * s2 + 5]); pw.w = pk2(s[kb][8 * s2 + 6], s[kb][8 * s2 + 7]);
                const bf16x8 pf = __builtin_bit_cast(bf16x8, pw);
#pragma unroll
                for (int et = 0; et < 4; ++et) { const LAS unsigned char* vp = Vb + (et * 32 + r) * ATT_VP + (kb * 32 + 16 * s2 + 4 * h) * 2;
                    const u32x2 lo = *(const LAS u32x2*)vp, hi = *(const LAS u32x2*)(vp + 16);
                    u32x4 aw; aw.x = lo.x; aw.y = lo.y; aw.z = hi.x; aw.w = hi.y;
                    o[et] = __builtin_amdgcn_mfma_f32_32x32x16_bf16(__builtin_bit_cast(bf16x8, aw), pf, o[et], 0, 0, 0); } }
        if (more) { const int nb = cur ^ 1;
            *(LAS u32x4*)(lds + nb * ATT_KB + kl) = pk0; *(LAS u32x4*)(lds + nb * ATT_KB + kl + 32 * ATT_KP) = pk1;
            *(LAS u32x4*)(lds + nb * ATT_VB + vl) = pv0; *(LAS u32x4*)(lds + nb * ATT_VB + vl + 64 * ATT_VP) = pv1; }
        __syncthreads();
    }
    lsum += __shfl_xor(lsum, 32);
    const float inv = 1.0f / lsum;
    if (NC == 1) {
        bf16_t* orow = Op + (size_t)(qb * 32 + r) * ldo;
#pragma unroll
        for (int et = 0; et < 4; ++et)
#pragma unroll
            for (int g = 0; g < 4; ++g) { u32x2 w; w.x = pk2(o[et][4 * g] * inv, o[et][4 * g + 1] * inv); w.y = pk2(o[et][4 * g + 2] * inv, o[et][4 * g + 3] * inv);
                *(u32x2*)(orow + et * 32 + 8 * g + 4 * h) = w; }
    } else {
        LAS float* XL = (LAS float*)lds;
        if (comp == 1) {
#pragma unroll
            for (int et = 0; et < 4; ++et)
#pragma unroll
                for (int i = 0; i < 16; ++i) XL[(qb * 64 + et * 16 + i) * 64 + lane] = o[et][i] * inv;
        }
        __syncthreads();
        if (comp == 0) {
            float ss = 0.f;
#pragma unroll
            for (int et = 0; et < 4; ++et)
#pragma unroll
                for (int i = 0; i < 16; ++i) { const float ov = o[et][i] * inv - lam * XL[(qb * 64 + et * 16 + i) * 64 + lane]; o[et][i] = ov; ss += ov * ov; }
            ss += __shfl_xor(ss, 32);
            const float rs = rsqrtf(ss * (1.0f / 128.0f) + RMS_EPS) * 0.8f;
            bf16_t* orow = Op + (size_t)(qb * 32 + r) * ldo;
#pragma unroll
            for (int et = 0; et < 4; ++et)
#pragma unroll
                for (int g = 0; g < 4; ++g) { const int e = et * 32 + 8 * g + 4 * h; const f32x4 gv = *(const f32x4*)(subg + e);
                    u32x2 w; w.x = pk2(o[et][4 * g] * rs * gv[0], o[et][4 * g + 1] * rs * gv[1]); w.y = pk2(o[et][4 * g + 2] * rs * gv[2], o[et][4 * g + 3] * rs * gv[3]);
                    *(u32x2*)(orow + e) = w; }
        }
        __syncthreads();
    }
}

template <bool TO_BF16> __device__ __forceinline__ void ln_rows(float* io, bf16_t* ob, float2* stat, const float* g, const float* b, int tid, float* alt = nullptr) {
    const int lane = tid & 63, gw = blockIdx.x * NWAVE + (tid >> 6), ngw = gridDim.x * NWAVE;
    f32x4 gv[4], bv[4];
#pragma unroll
    for (int j = 0; j < 4; ++j) { gv[j] = ((const f32x4*)g)[lane + 64 * j]; bv[j] = ((const f32x4*)b)[lane + 64 * j]; }
    for (int row0 = gw; row0 < NT; row0 += 2 * ngw) {
        f32x4 v[2][4];
#pragma unroll
        for (int u = 0; u < 2; ++u) { const int row = row0 + u * ngw; if (row < NT) { const f32x4* xr = (const f32x4*)(io + (size_t)row * DM) + lane;
#pragma unroll
            for (int j = 0; j < 4; ++j) v[u][j] = xr[64 * j]; } }
#pragma unroll
        for (int u = 0; u < 2; ++u) { const int row = row0 + u * ngw; if (row >= NT) continue;
            float s = 0.f;
#pragma unroll
            for (int j = 0; j < 4; ++j) s += (v[u][j][0] + v[u][j][1]) + (v[u][j][2] + v[u][j][3]);
#pragma unroll
            for (int o = 1; o < 64; o <<= 1) s += __shfl_xor(s, o);
            const float mean = s * (1.0f / DM); float s2 = 0.f;
#pragma unroll
            for (int j = 0; j < 4; ++j) { v[u][j] = v[u][j] - mean; s2 += (v[u][j][0] * v[u][j][0] + v[u][j][1] * v[u][j][1]) + (v[u][j][2] * v[u][j][2] + v[u][j][3] * v[u][j][3]); }
#pragma unroll
            for (int o = 1; o < 64; o <<= 1) s2 += __shfl_xor(s2, o);
            const float rstd = rsqrtf(s2 * (1.0f / DM) + LN_EPS);
            if (TO_BF16) {
                u32x2* o8 = (u32x2*)(ob + (size_t)row * DM) + lane;
#pragma unroll
                for (int j = 0; j < 4; ++j) { const f32x4 y = v[u][j] * rstd * gv[j] + bv[j]; u32x2 w; w.x = pk2(y[0], y[1]); w.y = pk2(y[2], y[3]); o8[64 * j] = w; }
                if (lane == 0) { float2 st; st.x = mean; st.y = rstd; stat[row] = st; }
            } else {
                f32x4* wr_ = (alt ? (f32x4*)(alt + (size_t)row * DM) : (f32x4*)(io + (size_t)row * DM)) + lane;
#pragma unroll
                for (int j = 0; j < 4; ++j) wr_[64 * j] = v[u][j] * rstd * gv[j] + bv[j];
            }
        }
    }
}

__device__ __forceinline__ void convgate_half(const bf16_t* HH, bf16_t* ACT, const float* cw, const float* cb, int half, int tid) {
    constexpr int NG = DFF / 8; const int total = (NT / 2) * NG;
    for (int idx = blockIdx.x * NTHR + tid; idx < total; idx += gridDim.x * NTHR) {
        const int rl = idx / NG, cg8 = idx - rl * NG, n0 = cg8 * 8, t = rl & (SEQ - 1);
        const bf16_t* hp = HH + (size_t)rl * (2 * DFF);
        float gsum[8], usum[8];
#pragma unroll
        for (int e = 0; e < 8; ++e) { gsum[e] = cb[n0 + e]; usum[e] = cb[DFF + n0 + e]; }
#pragma unroll
        for (int j = 0; j < 3; ++j) { const int tt = t + j - 1; if (tt < 0 || tt >= SEQ) continue;
            const u32x4 gq = *(const u32x4*)(hp + (ptrdiff_t)(j - 1) * (2 * DFF) + n0), uq = *(const u32x4*)(hp + (ptrdiff_t)(j - 1) * (2 * DFF) + DFF + n0);
            const float* wg = cw + (size_t)j * (2 * DFF) + n0; const float* wu = wg + DFF;
            const f32x4 wg0 = *(const f32x4*)wg, wg1 = *(const f32x4*)(wg + 4), wu0 = *(const f32x4*)wu, wu1 = *(const f32x4*)(wu + 4);
            gsum[0] += wg0[0] * lo2f(gq.x); gsum[1] += wg0[1] * hi2f(gq.x); gsum[2] += wg0[2] * lo2f(gq.y); gsum[3] += wg0[3] * hi2f(gq.y);
            gsum[4] += wg1[0] * lo2f(gq.z); gsum[5] += wg1[1] * hi2f(gq.z); gsum[6] += wg1[2] * lo2f(gq.w); gsum[7] += wg1[3] * hi2f(gq.w);
            usum[0] += wu0[0] * lo2f(uq.x); usum[1] += wu0[1] * hi2f(uq.x); usum[2] += wu0[2] * lo2f(uq.y); usum[3] += wu0[3] * hi2f(uq.y);
            usum[4] += wu1[0] * lo2f(uq.z); usum[5] += wu1[1] * hi2f(uq.z); usum[6] += wu1[2] * lo2f(uq.w); usum[7] += wu1[3] * hi2f(uq.w); }
        float a[8];
#pragma unroll
        for (int e = 0; e < 8; ++e) a[e] = gsum[e] / (1.0f + __expf(-gsum[e])) * usum[e];
        u32x4 w; w.x = pk2(a[0], a[1]); w.y = pk2(a[2], a[3]); w.z = pk2(a[4], a[5]); w.w = pk2(a[6], a[7]);
        *(u32x4*)(ACT + (size_t)(half * (NT / 2) + rl) * DFF + n0) = w;
    }
}

#define XB_TMO      128
#define XB_XCNT(j)  (256  + 64 * (j))
#define XB_XSUB(j)  (1280 + 64 * (j))
#define XB_XGEN(j)  (2304 + 64 * (j))
#define XB_TOP      3328
#define XB_TOPGEN   3392
#define XCD_BAR_WORDS 3456
#define XB_SPIN_CAP (1u << 18)

__device__ __forceinline__ unsigned xb_ld(unsigned* p)              { return __hip_atomic_load(p, __ATOMIC_RELAXED, __HIP_MEMORY_SCOPE_AGENT); }
__device__ __forceinline__ unsigned xb_add(unsigned* p, unsigned v) { return __hip_atomic_fetch_add(p, v, __ATOMIC_RELAXED, __HIP_MEMORY_SCOPE_AGENT); }
__device__ __forceinline__ unsigned xb_xcc_id() { return (unsigned)__builtin_amdgcn_s_getreg((3 << 11) | 20) & 0xFu; }
#define XB_SPIN(cond, bar) do { unsigned _sp = 0; while (cond) { __builtin_amdgcn_s_sleep(1); \
    if ((++_sp & 255u) == 0u) { if (xb_ld(&(bar)[XB_TMO])) break; if (_sp > XB_SPIN_CAP) { atomicAdd(&(bar)[XB_TMO], 1u); break; } } } } while (0)

struct XcdBarrier {
    unsigned* bar; unsigned x;
    volatile LAS unsigned* st;
};

__device__ __forceinline__ XcdBarrier xcd_barrier_post(unsigned* bar, volatile LAS unsigned* st) {
    XcdBarrier b; b.bar = bar; b.x = xb_xcc_id(); b.st = st;
    if (threadIdx.x == 0) (void)xb_add(&bar[XB_XCNT(b.x)], 1u);
    return b;
}
__device__ __forceinline__ void xcd_barrier_complete(unsigned* bar, unsigned x, unsigned& nloc, unsigned& nx) {
    const unsigned G = gridDim.x * gridDim.y * gridDim.z;
    unsigned sum, cnt, mine, sp = 0u;
    for (;;) {
        sum = 0u; cnt = 0u; mine = 0u;
#pragma unroll
        for (unsigned j = 0; j < 16; ++j) { const unsigned c = xb_ld(&bar[XB_XCNT(j)]); sum += c; cnt += (c > 0u) ? 1u : 0u; mine = (j == x) ? c : mine; }
        if (sum == G) break;
        __builtin_amdgcn_s_sleep(1);
        if ((++sp & 255u) == 0u) { if (xb_ld(&bar[XB_TMO])) break; if (sp > XB_SPIN_CAP) { atomicAdd(&bar[XB_TMO], 1u); break; } }
    }
    nloc = mine > 0u ? mine : 1u; nx = cnt > 0u ? cnt : 1u;
}

__device__ __forceinline__ void xcd_barrier(const XcdBarrier& b) {
    asm volatile("s_waitcnt vmcnt(0)" ::: "memory");
    __syncthreads();
    if (threadIdx.x == 0) {
        unsigned* bar = b.bar;
        __builtin_amdgcn_s_waitcnt(0);
        unsigned nloc = b.st[0], nx = b.st[1];
        if (nloc == 0u) { xcd_barrier_complete(bar, b.x, nloc, nx); b.st[0] = nloc; b.st[1] = nx; }
        const unsigned old = xb_add(&bar[XB_XSUB(b.x)], 1u);
        const unsigned gen = old / nloc;
        if (old + 1u == (gen + 1u) * nloc) {
            __builtin_amdgcn_fence(__ATOMIC_RELEASE, "agent");
            asm volatile("s_waitcnt vmcnt(0)" ::: "memory");
            const unsigned og = xb_add(&bar[XB_TOP], 1u);
            const unsigned tg = og / nx;
            if (og + 1u == (tg + 1u) * nx) xb_add(&bar[XB_TOPGEN], 1u);
            else XB_SPIN(xb_ld(&bar[XB_TOPGEN]) == tg, bar);
            __builtin_amdgcn_fence(__ATOMIC_ACQUIRE, "agent");
            xb_add(&bar[XB_XGEN(b.x)], 1u);
            asm volatile("s_waitcnt vmcnt(0)" ::: "memory");
        } else {
            XB_SPIN(xb_ld(&bar[XB_XGEN(b.x)]) == gen, bar);
            __builtin_amdgcn_fence(__ATOMIC_ACQUIRE, "agent");
            asm volatile("s_waitcnt vmcnt(0)" ::: "memory");
        }
    }
    __syncthreads();
}

template <int MODE> __device__ __forceinline__ void panel_finish(LAS unsigned char* lds, float* io, bf16_t* x1b, float2* stat, const float* g, const float* b, unsigned long long* XG, unsigned* CNT, int cu, int tid) {
    const int v = PairOrder::vcu_of(cu), q = v >> 2, j = v & 3, lane = tid & 63, wave = tid >> 6;
    LAS cplx* ST = (LAS cplx*)(lds + XCH_OFF); LAS cplx* MR = (LAS cplx*)lds;
    asm volatile("s_waitcnt lgkmcnt(0)" ::: "memory"); __syncthreads();
    const int ui = tid >> 8, rowl = tid & 255;
    float m1, m2;
    { const cplx a0 = ST[tid * 4 + 0], a1 = ST[tid * 4 + 1], a2 = ST[tid * 4 + 2], a3 = ST[tid * 4 + 3];
      m1 = (a0.x + a1.x) + (a2.x + a3.x); m2 = (a0.y + a1.y) + (a2.y + a3.y);
      __hip_atomic_store(XG + (size_t)((2 * q + ui) * 4 + j) * 256 + rowl, ((unsigned long long)__float_as_uint(m2) << 32) | __float_as_uint(m1), __ATOMIC_RELAXED, __HIP_MEMORY_SCOPE_AGENT); }
    asm volatile("s_waitcnt vmcnt(0)" ::: "memory");
    __syncthreads();
    if (tid == 0) {
        (void)__hip_atomic_fetch_add(CNT + (2 * q) * 16, 1u, __ATOMIC_RELAXED, __HIP_MEMORY_SCOPE_AGENT);
        (void)__hip_atomic_fetch_add(CNT + (2 * q + 1) * 16, 1u, __ATOMIC_RELAXED, __HIP_MEMORY_SCOPE_AGENT);
        unsigned sp = 0;
        while (__hip_atomic_load(CNT + (2 * q) * 16, __ATOMIC_RELAXED, __HIP_MEMORY_SCOPE_AGENT) < 4u || __hip_atomic_load(CNT + (2 * q + 1) * 16, __ATOMIC_RELAXED, __HIP_MEMORY_SCOPE_AGENT) < 4u) {
            __builtin_amdgcn_s_sleep(1); if (++sp > (1u << 22)) break; }
        __builtin_amdgcn_fence(__ATOMIC_ACQUIRE, "agent");
        asm volatile("s_waitcnt vmcnt(0)" ::: "memory");
    }
    __syncthreads();
    { float t1 = m1, t2 = m2;
#pragma unroll
      for (int jj = 1; jj < 4; ++jj) { const unsigned long long w = __hip_atomic_load(XG + (size_t)((2 * q + ui) * 4 + ((j + jj) & 3)) * 256 + rowl, __ATOMIC_RELAXED, __HIP_MEMORY_SCOPE_AGENT);
          t1 += __uint_as_float((unsigned)w); t2 += __uint_as_float((unsigned)(w >> 32)); }
      const float mean = t1 * (1.0f / DM), var = fmaxf(t2 * (1.0f / DM) - mean * mean, 0.f), rstd = rsqrtf(var + LN_EPS);
      cplx mr; mr.x = mean; mr.y = rstd; MR[tid] = mr;
      if (MODE == 1 && j == 0) { float2 sv; sv.x = mean; sv.y = rstd; stat[(2 * q + ui) * 256 + rowl] = sv; } }
    __syncthreads();
    const int cbase = j * 256 + lane * 4;
    const f32x4 g0 = *(const f32x4*)(g + cbase), b0 = *(const f32x4*)(b + cbase);
#pragma unroll 1
    for (int it = 0; it < 8; ++it) {
        const int u2 = it >> 2, rb = (it & 3) * 8; const size_t rbase = (size_t)((2 * q + u2) * 256 + wave * 32 + rb);
        f32x4 x0[8];
#pragma unroll
        for (int i = 0; i < 8; ++i) x0[i] = *(const f32x4*)(io + (rbase + i) * DM + cbase);
        asm volatile("" ::: "memory");
#pragma unroll
        for (int i = 0; i < 8; ++i) { const cplx mr = MR[u2 * 256 + wave * 32 + rb + i];
            const f32x4 y0 = (x0[i] - mr.x) * mr.y * g0 + b0;
            if (MODE == 1) { u32x2 w0; w0.x = pk2(y0[0], y0[1]); w0.y = pk2(y0[2], y0[3]); *(u32x2*)(x1b + (rbase + i) * DM + cbase) = w0; }
            else *(f32x4*)(io + (rbase + i) * DM + cbase) = y0; }
    }
}

#ifndef PH_MASK
#define PH_MASK 0xFFFFFF
#endif
#define PH(k) ((PH_MASK >> (k)) & 1)
#ifndef G5ORDER
#define G5ORDER KbOrder
#endif
#ifndef REP_P0
#define REP_P0 1
#endif
#ifndef REP_G1
#define REP_G1 1
#endif
#ifndef REP_DIFF
#define REP_DIFF 1
#endif
#ifndef REP_HY
#define REP_HY 1
#endif
#ifndef REP_MEM
#define REP_MEM 1
#endif
#ifndef REP_G3
#define REP_G3 1
#endif
#ifndef REP_G4
#define REP_G4 1
#endif
#ifndef REP_LN1
#define REP_LN1 1
#endif
struct Args { const float* in[24]; float* out; unsigned char* ws; };
__global__ void __launch_bounds__(NTHR, 2) hybrid_fwd(Args a) {
    extern __shared__ __attribute__((aligned(16))) unsigned char smem[];
    LAS unsigned char* lds = (LAS unsigned char*)smem;
    cg::grid_group grid = cg::this_grid();
    volatile LAS unsigned* bst = (volatile LAS unsigned*)(lds + 131072 + 64);
    if (threadIdx.x < 2) bst[threadIdx.x] = 0u;
    __syncthreads();
    const XcdBarrier bar = xcd_barrier_post((unsigned*)(a.ws + WS_BAR), bst);
    const int G = gridDim.x;
#define NEWPHASE() int tid_ = threadIdx.x, cu_ = blockIdx.x; asm volatile("" : "+v"(tid_)); asm volatile("" : "+s"(cu_)); const int tid = tid_, cu = cu_; (void)tid; (void)cu;
    unsigned char* ws = a.ws;
    bf16_t* WALL = (bf16_t*)(ws + WS_WALL); bf16_t* XB = (bf16_t*)(ws + WS_XB); bf16_t* MEMB = (bf16_t*)(ws + WS_MEMB); bf16_t* WKV = (bf16_t*)(ws + WS_WKV);
    bf16_t* QKM = (bf16_t*)(ws + WS_QKM); bf16_t* HT = (bf16_t*)(ws + WS_HT); bf16_t* KMEM = (bf16_t*)(ws + WS_KMEM); bf16_t* VMT = (bf16_t*)(ws + WS_VMT);
    float2* KF = (float2*)(ws + WS_KF); bf16_t* MIX = (bf16_t*)(ws + WS_MIX); float2* STAT = (float2*)(ws + WS_STAT);
    bf16_t* X1B = (bf16_t*)(ws + WS_X1B); bf16_t* HH = (bf16_t*)(ws + WS_HH); bf16_t* ACT = (bf16_t*)(ws + WS_ACT);

    for (int rep = 0; rep < REP_P0; ++rep) { NEWPHASE(); if (PH(0)) p0_prep(a.in, ws, lds, tid); }
    if (a.ws == nullptr) grid.sync();
    xcd_barrier(bar);

    for (int rep = 0; rep < REP_G1; ++rep) {
    if (PH(1)) { NEWPHASE(); pg8::Gemm g{XB, WALL, NT, 1536, DM}; pg8::StaticOrder S; S.init(g.M, g.N, G, cu);
      EpiRope E{QKM, (const float2*)(ws + WS_ROPE)};
      pg8::gemm_phase<EpiRope, pg8::StaticOrder, true, true>(lds, g, S, E); }
    if (PH(2)) { NEWPHASE(); pg8::Gemm g{WALL + (size_t)1536 * DM, XB, 2048, NT, DM}; pg8::StaticOrder S; S.init(g.M, g.N, G, cu);
      EpiB E{HT, NT};
      pg8::gemm_phase<EpiB, pg8::StaticOrder, true, true>(lds, g, S, E); }
    }
    if (PH(3)) { NEWPHASE(); const bool isK = cu < 32, on = cu < 64; const int c2 = cu - 32;
      pg8::Gemm g; EpiB E; OneUnit S;
      if (isK) { g = pg8::Gemm{MEMB, WKV, NMT, 512, DM}; E = EpiB{KMEM, 512}; S = OneUnit{cu >> 1, cu & 1, on}; }
      else { g = pg8::Gemm{WKV + (size_t)512 * DM, MEMB, 512, NMT, DM}; E = EpiB{VMT, NMT}; S = OneUnit{(c2 >> 4) & 1, c2 & 15, on}; }
      pg8::gemm_phase<EpiB, OneUnit, false, true>(lds, g, S, E);
      __syncthreads();
      if (!on) for (int it = cu - 64; it < 1024; it += G - 64) filter_fft_item((const float*)(ws + WS_HTD), KF, lds, it, tid); }
    xcd_barrier(bar);

    { NEWPHASE(); const int xcd = cu & 7, j = cu >> 3;
      float lam;
      { const float* lp = a.in[12]; const int l6 = tid & 63; float s01 = lp[l6] * lp[64 + l6], s23 = lp[128 + l6] * lp[192 + l6];
#pragma unroll
        for (int o = 1; o < 64; o <<= 1) { s01 += __shfl_xor(s01, o); s23 += __shfl_xor(s23, o); }
        lam = expf(s01) - expf(s23) + 0.2f; }
      if (PH(4)) for (int i = 0; i < 4 * REP_DIFF; ++i) {
          const int bh = ((i & 3) * 8 + xcd) * 2 + (j >> 4), qblk = j & 15, b = bh >> 2, hd = bh & 3;
          const size_t tok0 = (size_t)b * SEQ;
          attn_unit<2>(lds, QKM + (tok0 + qblk * 128) * MIXW + hd * 128, MIXW, QKM + tok0 * MIXW + 512 + hd * 128, MIXW,
                       HT + (size_t)(1536 + hd * 128) * NT + tok0, NT, SEQ, 0.125f * 1.4426950408889634f,
                       MIX + (tok0 + qblk * 128) * MIXW + 512 + hd * 128, MIXW, lam, a.in[13], tid); }
      if (PH(5)) for (int i = 0; i < 2 * REP_MEM; ++i) {
          const int bh = ((i & 1) * 8 + xcd) * 4 + (j >> 3), qblk = j & 7, b = bh >> 2, hd = bh & 3;
          const size_t tok0 = (size_t)b * SEQ;
          attn_unit<1>(lds, QKM + (tok0 + qblk * 256) * MIXW + 1024 + hd * 128, MIXW, KMEM + (size_t)b * MEMT * 512 + hd * 128, 512,
                       VMT + (size_t)(hd * 128) * NMT + b * MEMT, NMT, MEMT, 0.08838834764831845f * 1.4426950408889634f,
                       MIX + (tok0 + qblk * 256) * MIXW + 1024 + hd * 128, MIXW, 0.f, nullptr, tid); }
      if (PH(6)) for (int i = 0; i < 2 * REP_HY; ++i) {
          const int cgp = ((i & 1) * 8 + xcd) * 4 + (j >> 3), bp = j & 7;
          hyena_item(HT, KF, a.in[3], a.in[4], a.in[11], MIX, lds, bp, cgp, tid); } }
    xcd_barrier(bar);

#ifdef REP_SYNC
    for (int rep = 0; rep < REP_SYNC; ++rep) xcd_barrier(bar);
#endif
    const bool pair = (G == 256);
    if (PH(7)) { NEWPHASE(); pg8::Gemm g{MIX, (const bf16_t*)(ws + WS_WOUT), NT, DM, MIXW}; PairOrder S; S.init(g.M, g.N, G, cu); S.pair = pair;
      EpiRes E{a.in[0], a.out, lds, 0};
      pg8::gemm_phase<EpiRes, PairOrder, true, true>(lds, g, S, E);
      if (pair) panel_finish<1>(lds, a.out, X1B, STAT, a.in[16], a.in[17], (unsigned long long*)(ws + WS_XG), (unsigned*)(ws + WS_CNT), cu, tid); }
    xcd_barrier(bar);
    if (!pair) { { NEWPHASE(); ln_rows<true>(a.out, X1B, STAT, a.in[16], a.in[17], tid); } xcd_barrier(bar); }
    for (int rep = 0; rep < REP_G4; ++rep) if (PH(9)) { NEWPHASE(); pg8::Gemm g{X1B, (const bf16_t*)(ws + WS_WUP), FFN_MT * 256, 2 * DFF, DM}; FfnOrder S; S.init(g.M, g.N, G, cu); S.cw = a.in[19]; S.cb = a.in[20]; S.lds = lds; S.cnt = 0;
      EpiFfn E{ACT, lds, 0};
      pg8::gemm_phase<EpiFfn, FfnOrder, true, true>(lds, g, S, E); }
    xcd_barrier(bar);
    if (PH(11)) { NEWPHASE(); pg8::Gemm g{ACT, (const bf16_t*)(ws + WS_WDN), NT, DM, DFF}; PairKb S; S.init(g.M, g.N, G, cu); S.pair = pair;
      EpiRes2 E{a.out, a.out, STAT, a.in[16], a.in[17], lds, 0};
      pg8::gemm_phase<EpiRes2, PairKb, true, true>(lds, g, S, E);
      if (pair) panel_finish<2>(lds, a.out, nullptr, nullptr, a.in[22], a.in[23], (unsigned long long*)(ws + WS_XG) + 128 * 4 * 256, (unsigned*)(ws + WS_CNT) + 128 * 16, cu, tid); }
    if (!pair) { xcd_barrier(bar); { NEWPHASE(); ln_rows<false>(a.out, nullptr, nullptr, a.in[22], a.in[23], tid); } }
}

extern "C" void kernel_launch(void* const* d_in, const int* in_sizes, int n_in, void* d_out, int out_size, void* d_ws, size_t ws_size, hipStream_t stream) {
    static int grid = 0;
    if (grid == 0) {
        if (n_in != 24 || out_size != NT * DM || ws_size < WS_END) { fprintf(stderr, "kernel_launch: unexpected shapes (n_in %d, out %d, ws %zu)\n", n_in, out_size, ws_size); grid = -1; return; }
        int dev = 0, cus = 0, per_cu = 0;
        hipGetDevice(&dev); hipDeviceGetAttribute(&cus, hipDeviceAttributeMultiprocessorCount, dev);
        if (hipFuncSetAttribute((const void*)hybrid_fwd, hipFuncAttributeMaxDynamicSharedMemorySize, LDS_BYTES) != hipSuccess) { fprintf(stderr, "kernel_launch: hipFuncSetAttribute failed\n"); grid = -1; return; }
        if (hipOccupancyMaxActiveBlocksPerMultiprocessor(&per_cu, (const void*)hybrid_fwd, NTHR, LDS_BYTES) != hipSuccess || per_cu < 1) { fprintf(stderr, "kernel_launch: occupancy query says %d\n", per_cu); per_cu = 1; }
        (void)hipGetLastError();
        grid = cus * per_cu;
        fprintf(stderr, "kernel_launch: grid %d (cus %d x %d)\n", grid, cus, per_cu);
    }
    if (grid < 0) return;
    if (hipMemsetAsync((char*)d_ws + WS_BAR, 0, 32768, stream) != hipSuccess) { fprintf(stderr, "kernel_launch: memset failed\n"); return; }
    Args a{};
    for (int i = 0; i < 24; ++i) a.in[i] = (const float*)d_in[i];
    a.out = (float*)d_out; a.ws = (unsigned char*)d_ws;
    void* args[] = {&a};
    const hipError_t e = hipLaunchCooperativeKernel((const void*)hybrid_fwd, dim3(grid), dim3(NTHR), args, LDS_BYTES, stream);
    if (e != hipSuccess) fprintf(stderr, "kernel_launch: cooperative launch failed: %s (grid %d)\n", hipGetErrorString(e), grid);
}
```

```cpp
#include <hip/hip_runtime.h>
#include <hip/hip_cooperative_groups.h>
#include <cstdio>
#include <cstdint>
namespace cg = cooperative_groups;
#define LAS __attribute__((address_space(3)))
namespace pg8 {
#define PG8_LAS __attribute__((address_space(3)))
typedef unsigned short bf16_t;
typedef short bf16x8 __attribute__((ext_vector_type(8)));
typedef float f32x4 __attribute__((ext_vector_type(4)));
typedef unsigned u32x4 __attribute__((ext_vector_type(4)));
constexpr int BM = 256, BK = 64, HALF = 128, HTB = HALF * BK * 2  , STAGE_BYTES = 8 * HTB, NXCD = 8, WGM = 8;

__host__ __device__ __forceinline__ int lds_byte(int r, int c) { const int st = (r >> 4) * 2 + (c >> 5), rr = r & 15, cc = c & 31, ob = rr * 64 + cc * 2; return st * 1024 + (ob ^ (((ob >> 9) & 1) << 5)); }
__host__ __device__ __forceinline__ void stage_rc(int b, int& R, int& C) { const int st = b / 1024, sb = b % 1024, swz = sb ^ (((sb >> 9) & 1) << 5); R = (st >> 1) * 16 + swz / 64; C = (st & 1) * 32 + (swz % 64) / 2; }
__host__ __device__ __forceinline__ int perm32(int rho) { const int n = rho >> 4, i = rho & 15; return 8 * (i >> 2) + 4 * n + (i & 3); }

struct Unit { int pm, pn; };
struct Gemm { const bf16_t* A; const bf16_t* Bt; int M, N, K; };

struct StaticOrder {
    int nM, nN, nwg, G, c;
    __host__ __device__ void init(int M, int N, int G_, int c_) { nM = M / BM; nN = N / BM; nwg = nM * nN; G = G_; c = c_; }
    __host__ __device__ bool next(int i, Unit& u) const {
        const long L = (long)i * G + c; if (L >= nwg) return false;
        int wgid = (int)L; { const int q = nwg / NXCD, r = nwg % NXCD, xcd = wgid % NXCD, off = wgid / NXCD; wgid = (xcd < r ? xcd * (q + 1) : r * (q + 1) + (xcd - r) * q) + off; }
        const int nig = WGM * nN, gid = wgid / nig, fm = gid * WGM, gsz = (nM - fm) < WGM ? (nM - fm) : WGM;
        u.pm = fm + ((wgid % nig) % gsz); u.pn = (wgid % nig) / gsz; return true;
    }
    __device__ __forceinline__ void a_ready(const Unit&) const {}
    __device__ __forceinline__ void done(const Unit&) const {}
    __device__ __forceinline__ long a_off(const Unit& u, size_t tstep) const { return (long)((size_t)u.pm * tstep); }
    __device__ __forceinline__ int lda(int K) const { return K; }
    __device__ __forceinline__ size_t kstep_a() const { return (size_t)(BK * 2); }
};
template <class Epi, class Sched, bool ALIGN_EPI = false, bool SP2 = false>
__device__ __forceinline__ void gemm_phase(PG8_LAS unsigned char* lds, const Gemm g, const Sched& S, const Epi& E) {
    int tid_l = threadIdx.x; asm volatile("" : "+v"(tid_l)); const int tid = tid_l, wid = __builtin_amdgcn_readfirstlane(tid >> 6), lane = tid & 63, wr = wid >> 2, wc = wid & 3, fr = lane & 15, fq = lane >> 4;
    const int K = g.K, nt = K / BK;
    unsigned voffA[2], voffB[2];
    const int lda = S.lda(K);
#pragma unroll
    for (int i = 0; i < 2; ++i) { int R, C; stage_rc(tid * 16 + i * 8192, R, C); const int Rb = Epi::PERM ? ((R & ~31) + perm32(R & 31)) : R;
        voffA[i] = (unsigned)(R * lda + C) * 2u; voffB[i] = (unsigned)(Rb * K + C) * 2u; }
    const size_t kstep = (size_t)(BK * 2);
    const size_t hstep = (size_t)HALF * K * 2;
    const size_t tstep = 2 * hstep;
    const size_t kstepA = S.kstep_a(), hstepA = (size_t)HALF * lda * 2, tstepA = 2 * hstepA;
    const unsigned ldsw = (unsigned)wid * 1024u;
    const int aoff = lds_byte(wr * 64 + fr, fq * 8), boff = lds_byte(wc * 32 + fr, fq * 8);
#define PG8_SA(b, h) (((b) * 2 + (h)) * HTB)
#define PG8_SB(b, h) ((4 + (b) * 2 + (h)) * HTB)
#define PG8_STAGE(bufoff, gbase, voff) do { _Pragma("unroll") for (int _i = 0; _i < 2; ++_i) \
        __builtin_amdgcn_global_load_lds((const unsigned*)((const char*)(gbase) + (voff)[_i]), (PG8_LAS unsigned*)(lds + (bufoff) + ldsw + _i * 8192), 16, 0, 0); } while (0)
#define PG8_LDA(dst, b, h) do { _Pragma("unroll") for (int m = 0; m < 4; ++m) _Pragma("unroll") for (int k = 0; k < 2; ++k) dst[m][k] = *(const PG8_LAS bf16x8*)(lds + PG8_SA(b, h) + aoff + m * 2048 + k * 1024); } while (0)
#define PG8_LDB(dst, b, h) do { _Pragma("unroll") for (int n = 0; n < 2; ++n) _Pragma("unroll") for (int k = 0; k < 2; ++k) dst[n][k] = *(const PG8_LAS bf16x8*)(lds + PG8_SB(b, h) + boff + n * 2048 + k * 1024); } while (0)
#define PG8_MMA(ai, bj, At, Bt) do { __builtin_amdgcn_s_setprio(1); _Pragma("unroll") for (int m = 0; m < 4; ++m) _Pragma("unroll") for (int n = 0; n < 2; ++n) _Pragma("unroll") for (int k = 0; k < 2; ++k) \
        acc[ai][bj][m][n] = __builtin_amdgcn_mfma_f32_16x16x32_bf16(Bt[n][k], At[m][k], acc[ai][bj][m][n], 0, 0, 0); __builtin_amdgcn_s_setprio(0); } while (0)
#define PG8_WAIT_V(n) asm volatile("s_waitcnt vmcnt(" #n ")" ::: "memory")
#define PG8_WAIT_L(n) asm volatile("s_waitcnt lgkmcnt(" #n ")" ::: "memory")
#define PG8_BAR __builtin_amdgcn_s_barrier()
#define PG8_SCHED __builtin_amdgcn_sched_barrier(0)
    Unit cur, nxt; int ui = 0;
    if (!S.next(0, cur)) return;
    f32x4 acc[2][2][4][2];
#pragma unroll
    for (int a = 0; a < 2; ++a)
#pragma unroll
        for (int b = 0; b < 2; ++b)
#pragma unroll
            for (int m = 0; m < 4; ++m)
#pragma unroll
                for (int n = 0; n < 2; ++n) acc[a][b][m][n] = (f32x4){0.f, 0.f, 0.f, 0.f};
    bf16x8 At[4][2], B0[2][2], B1[2][2];
    const char* cA = (const char*)g.A + S.a_off(cur, tstepA); const char* cB = (const char*)g.Bt + (size_t)cur.pn * tstep;
    S.a_ready(cur);
    if constexpr (SP2) {
        PG8_STAGE(PG8_SB(0, 0), cB, voffB); PG8_STAGE(PG8_SB(0, 1), cB + hstep, voffB); PG8_STAGE(PG8_SA(0, 0), cA, voffA); PG8_STAGE(PG8_SA(0, 1), cA + hstepA, voffA);
        if (wr == 1) PG8_BAR;
        PG8_WAIT_V(2); PG8_BAR;
        PG8_STAGE(PG8_SB(1, 0), cB + kstep, voffB); PG8_STAGE(PG8_SA(1, 0), cA + kstepA, voffA); PG8_STAGE(PG8_SB(1, 1), cB + hstep + kstep, voffB);
        PG8_WAIT_V(6); PG8_BAR;
    } else {
        PG8_STAGE(PG8_SB(0, 0), cB, voffB); PG8_STAGE(PG8_SA(0, 0), cA, voffA); PG8_STAGE(PG8_SB(0, 1), cB + hstep, voffB); PG8_STAGE(PG8_SA(0, 1), cA + hstepA, voffA);
        if (wr == 1) PG8_BAR;
        PG8_WAIT_V(4); PG8_BAR;
        PG8_STAGE(PG8_SB(1, 0), cB + kstep, voffB); PG8_STAGE(PG8_SA(1, 0), cA + kstepA, voffA); PG8_STAGE(PG8_SB(1, 1), cB + hstep + kstep, voffB);
        PG8_WAIT_V(6); PG8_BAR;
    }
    for (;;) {
        const bool has_next = S.next(ui + 1, nxt);
        const char* nA = has_next ? (const char*)g.A + S.a_off(nxt, tstepA) : cA; const char* nB = has_next ? (const char*)g.Bt + (size_t)nxt.pn * tstep : cB;
        for (int t = 0; t < nt; t += 2) {
            const bool last = (t == nt - 2);
            const char* a1 = cA + (size_t)(t + 1) * kstepA;
            const char* a2 = last ? nA : cA + (size_t)(t + 2) * kstepA; const char* b2 = last ? nB : cB + (size_t)(t + 2) * kstep;
            const char* a3 = a2 + kstepA; const char* b3 = b2 + kstep;
            if (last && has_next) S.a_ready(nxt);
            if constexpr (SP2) {
            PG8_LDB(B0, 0, 0); PG8_LDB(B1, 0, 1); PG8_SCHED; PG8_LDA(At, 0, 0); PG8_STAGE(PG8_SA(1, 1), a1 + hstepA, voffA);
            PG8_WAIT_V(8); PG8_WAIT_L(0); PG8_BAR; PG8_MMA(0, 0, At, B0); PG8_MMA(0, 1, At, B1); PG8_BAR; PG8_SCHED;
            PG8_LDA(At, 0, 1); PG8_STAGE(PG8_SB(0, 0), b2, voffB); PG8_STAGE(PG8_SB(0, 1), b2 + hstep, voffB); PG8_STAGE(PG8_SA(0, 0), a2, voffA);
            PG8_WAIT_V(8); PG8_WAIT_L(0); PG8_BAR; PG8_MMA(1, 0, At, B0); PG8_MMA(1, 1, At, B1); PG8_BAR; PG8_SCHED;
            PG8_LDB(B0, 1, 0); PG8_LDB(B1, 1, 1); PG8_SCHED; PG8_LDA(At, 1, 0); PG8_STAGE(PG8_SA(0, 1), a2 + hstepA, voffA);
            PG8_WAIT_V(8); PG8_WAIT_L(0); PG8_BAR; PG8_MMA(0, 0, At, B0); PG8_MMA(0, 1, At, B1); PG8_BAR; PG8_SCHED;
            PG8_LDA(At, 1, 1); PG8_STAGE(PG8_SB(1, 0), b3, voffB); PG8_STAGE(PG8_SB(1, 1), b3 + hstep, voffB); PG8_STAGE(PG8_SA(1, 0), a3, voffA);
            PG8_WAIT_V(8); PG8_WAIT_L(0); PG8_BAR; PG8_MMA(1, 0, At, B0); PG8_MMA(1, 1, At, B1); PG8_BAR; PG8_SCHED;
            } else {
            PG8_LDB(B0, 0, 0); PG8_SCHED; PG8_LDA(At, 0, 0); PG8_STAGE(PG8_SA(1, 1), a1 + hstepA, voffA);
            PG8_WAIT_L(8); PG8_BAR; PG8_WAIT_L(0); PG8_MMA(0, 0, At, B0); PG8_BAR; PG8_SCHED;
            PG8_LDB(B1, 0, 1); PG8_STAGE(PG8_SB(0, 0), b2, voffB);
            PG8_BAR; PG8_WAIT_L(0); PG8_MMA(0, 1, At, B1); PG8_BAR;
            PG8_LDA(At, 0, 1); PG8_STAGE(PG8_SA(0, 0), a2, voffA);
            PG8_BAR; PG8_WAIT_L(0); PG8_MMA(1, 0, At, B0); PG8_BAR; PG8_SCHED;
            PG8_STAGE(PG8_SB(0, 1), b2 + hstep, voffB);
            PG8_WAIT_V(6); PG8_BAR; PG8_MMA(1, 1, At, B1); PG8_BAR;
            PG8_LDB(B0, 1, 0); PG8_SCHED; PG8_LDA(At, 1, 0); PG8_STAGE(PG8_SA(0, 1), a2 + hstepA, voffA);
            PG8_WAIT_L(8); PG8_BAR; PG8_WAIT_L(0); PG8_MMA(0, 0, At, B0); PG8_BAR; PG8_SCHED;
            PG8_LDB(B1, 1, 1); PG8_STAGE(PG8_SB(1, 0), b3, voffB);
            PG8_BAR; PG8_WAIT_L(0); PG8_MMA(0, 1, At, B1); PG8_BAR;
            PG8_LDA(At, 1, 1); PG8_STAGE(PG8_SA(1, 0), a3, voffA);
            PG8_BAR; PG8_WAIT_L(0); PG8_MMA(1, 0, At, B0); PG8_BAR; PG8_SCHED;
            PG8_STAGE(PG8_SB(1, 1), b3 + hstep, voffB);
            PG8_WAIT_V(6); PG8_BAR; PG8_MMA(1, 1, At, B1); PG8_BAR;
            }
        }
        if constexpr (ALIGN_EPI) { if (wr == 0) PG8_BAR; }
        if constexpr (!Epi::AFTER_DRAIN) { E(acc, cur, wr, wc, fr, fq); S.done(cur); }
        if (!has_next) break;
#pragma unroll
        for (int a = 0; a < 2; ++a)
#pragma unroll
            for (int b = 0; b < 2; ++b)
#pragma unroll
                for (int m = 0; m < 4; ++m)
#pragma unroll
                    for (int n = 0; n < 2; ++n) acc[a][b][m][n] = (f32x4){0.f, 0.f, 0.f, 0.f};
        cur = nxt; cA = nA; cB = nB; ++ui;
        if constexpr (ALIGN_EPI) { if (wr == 1) PG8_BAR; }
    }
    PG8_WAIT_V(0);
    if constexpr (!ALIGN_EPI) { if (wr == 0) PG8_BAR; }
    PG8_BAR;
    if constexpr (Epi::AFTER_DRAIN) { E.fused(acc, cur, wr, wc, fr, fq, lds, wid, lane); S.done(cur); }
#undef PG8_SA
#undef PG8_SB
#undef PG8_STAGE
#undef PG8_LDA
#undef PG8_LDB
#undef PG8_MMA
#undef PG8_WAIT_V
#undef PG8_WAIT_L
#undef PG8_BAR
#undef PG8_SCHED
}
}

using pg8::bf16_t; using pg8::bf16x8; using pg8::f32x4; using pg8::u32x4;
typedef float f32x16 __attribute__((ext_vector_type(16)));
typedef unsigned u32x2 __attribute__((ext_vector_type(2)));
typedef short bf16x4 __attribute__((ext_vector_type(4)));

constexpr int NB = 16, SEQ = 2048, DM = 1024, NT = NB * SEQ, MEMT = 256, NMT = NB * MEMT, HW = 512, INW = 3584, DFF = 2816, MIXW = 1536;
constexpr float ALPHA = 1.189207115002721f;
constexpr float LN_EPS = 1e-5f, RMS_EPS = 1e-5f;
constexpr int NTHR = 512, NWAVE = 8;
constexpr int LDS_BYTES = 151552;

constexpr size_t MiB = 1048576;
constexpr size_t WS_WALL = 0;
constexpr size_t WS_WKV  = 7 * MiB;
constexpr size_t WS_WOUT = 9 * MiB;
constexpr size_t WS_WUP  = 12 * MiB;
constexpr size_t WS_WDN  = 23 * MiB;
constexpr size_t WS_ROPE = 29 * MiB;
constexpr size_t WS_STAT = 29 * MiB + 524288;
constexpr size_t WS_XB   = 30 * MiB;
constexpr size_t WS_X1B  = 30 * MiB;
constexpr size_t WS_HTD  = 94 * MiB;
constexpr size_t WS_MEMB = 110 * MiB;
constexpr size_t WS_QKM  = 118 * MiB;
constexpr size_t WS_HT   = 214 * MiB;
constexpr size_t WS_KMEM = 342 * MiB;
constexpr size_t WS_VMT  = 346 * MiB;
constexpr size_t WS_KF   = 350 * MiB;
constexpr size_t WS_MIX  = 382 * MiB;
constexpr size_t WS_HH   = 96 * MiB;
constexpr size_t WS_ACT  = 272 * MiB;
constexpr size_t WS_BAR  = 478 * MiB;
constexpr size_t WS_CNT  = 478 * MiB + 16384;
constexpr size_t WS_XG   = 478 * MiB + 65536;
constexpr size_t WS_END  = 478 * MiB + 65536 + 2 * MiB;

__device__ __forceinline__ unsigned pk2(float lo, float hi) { unsigned r; asm volatile("v_cvt_pk_bf16_f32 %0, %1, %2" : "=v"(r) : "v"(lo), "v"(hi)); return r; }
__device__ __forceinline__ float bf2f(bf16_t v) { return __uint_as_float((unsigned)v << 16); }
__device__ __forceinline__ float lo2f(unsigned v) { return __uint_as_float(v << 16); }
__device__ __forceinline__ float hi2f(unsigned v) { return __uint_as_float(v & 0xffff0000u); }
#define LDS_WAIT() asm volatile("s_waitcnt lgkmcnt(0)" ::: "memory")

#ifndef FFT_HOST
#define FFT_FN __device__ __forceinline__
#define FFT_SYNC() __syncthreads()
typedef float cplx __attribute__((ext_vector_type(2)));
typedef LAS cplx* fftbuf_t;
FFT_FN float cos2pi(float r) { return __builtin_amdgcn_cosf(r); }
FFT_FN float sin2pi(float r) { return __builtin_amdgcn_sinf(r); }
#endif
FFT_FN cplx mk2(float x, float y) { cplx r; r.x = x; r.y = y; return r; }
FFT_FN cplx cadd(cplx a, cplx b) { return mk2(a.x + b.x, a.y + b.y); }
FFT_FN cplx csub(cplx a, cplx b) { return mk2(a.x - b.x, a.y - b.y); }
FFT_FN cplx cmul(cplx a, cplx b) { return mk2(a.x * b.x - a.y * b.y, a.x * b.y + a.y * b.x); }
template <bool INV> FFT_FN cplx muli(cplx a) { return INV ? mk2(-a.y, a.x) : mk2(a.y, -a.x); }
FFT_FN int padi(int i) { return i + (i >> 3); }

template <bool INV> FFT_FN void dft8(cplx (&v)[8]) {
    const float R = 0.70710678118654752f;
    const cplx a0 = cadd(v[0], v[4]), a1 = csub(v[0], v[4]), a2 = cadd(v[2], v[6]), a3 = muli<INV>(csub(v[2], v[6]));
    const cplx a4 = cadd(v[1], v[5]), a5 = csub(v[1], v[5]), a6 = cadd(v[3], v[7]), a7 = muli<INV>(csub(v[3], v[7]));
    const cplx b0 = cadd(a0, a2), b2 = csub(a0, a2), b1 = cadd(a1, a3), b3 = csub(a1, a3);
    const cplx b4 = cadd(a4, a6), b6 = muli<INV>(csub(a4, a6));
    const cplx t5 = cadd(a5, a7), t7 = csub(a5, a7);
    cplx b5, b7;
    if (!INV) { b5 = mk2((t5.x + t5.y) * R, (t5.y - t5.x) * R); b7 = mk2((t7.y - t7.x) * R, -(t7.x + t7.y) * R); }
    else      { b5 = mk2((t5.x - t5.y) * R, (t5.x + t5.y) * R); b7 = mk2(-(t7.x + t7.y) * R, (t7.x - t7.y) * R); }
    v[0] = cadd(b0, b4); v[4] = csub(b0, b4); v[1] = cadd(b1, b5); v[5] = csub(b1, b5);
    v[2] = cadd(b2, b6); v[6] = csub(b2, b6); v[3] = cadd(b3, b7); v[7] = csub(b3, b7);
}
template <int S, bool INV> FFT_FN void twid(cplx (&v)[8], int tid) {
    if (S > 1) {
        const int j = tid % S; const float rev = (float)j * (1.0f / (8.0f * S));
        const float c = cos2pi(rev), s = sin2pi(rev);
        const cplx w1 = mk2(c, INV ? s : -s);
        const cplx w2 = cmul(w1, w1), w3 = cmul(w2, w1), w4 = cmul(w2, w2), w5 = cmul(w4, w1), w6 = cmul(w4, w2), w7 = cmul(w4, w3);
        v[1] = cmul(v[1], w1); v[2] = cmul(v[2], w2); v[3] = cmul(v[3], w3); v[4] = cmul(v[4], w4);
        v[5] = cmul(v[5], w5); v[6] = cmul(v[6], w6); v[7] = cmul(v[7], w7);
    }
}
template <int S> FFT_FN void ld8(fftbuf_t X, int tid, cplx (&v)[8]) {
    const int base = (tid / S) * 8 * S + (tid % S);
#pragma unroll
    for (int k = 0; k < 8; ++k) v[k] = X[padi(base + S * k)];
}
template <int S> FFT_FN void st8(fftbuf_t X, int tid, const cplx (&v)[8]) {
    const int base = (tid / S) * 8 * S + (tid % S);
#pragma unroll
    for (int k = 0; k < 8; ++k) X[padi(base + S * k)] = v[k];
}
#ifndef FFT_HOST
template <int S> FFT_FN void twid_fill(fftbuf_t TW, int tid) {
    constexpr int P = (S == 512) ? 0 : (S == 64) ? 1 : 2;
    const int j = tid % S; const float rev = (float)j * (1.0f / (8.0f * S));
    const cplx w1 = mk2(cos2pi(rev), -sin2pi(rev)), w2 = cmul(w1, w1), w4 = cmul(w2, w2);
    TW[(3 * P + 0) * 512 + tid] = w1; TW[(3 * P + 1) * 512 + tid] = w2; TW[(3 * P + 2) * 512 + tid] = w4;
}
template <int S, bool INV> FFT_FN void twidL(cplx (&v)[8], fftbuf_t TW, int tid) {
    constexpr int P = (S == 512) ? 0 : (S == 64) ? 1 : 2;
    cplx w1 = TW[(3 * P + 0) * 512 + tid], w2 = TW[(3 * P + 1) * 512 + tid], w4 = TW[(3 * P + 2) * 512 + tid];
    if (INV) { w1.y = -w1.y; w2.y = -w2.y; w4.y = -w4.y; }
    const cplx w3 = cmul(w2, w1), w5 = cmul(w4, w1), w6 = cmul(w4, w2), w7 = cmul(w4, w3);
    v[1] = cmul(v[1], w1); v[2] = cmul(v[2], w2); v[3] = cmul(v[3], w3); v[4] = cmul(v[4], w4);
    v[5] = cmul(v[5], w5); v[6] = cmul(v[6], w6); v[7] = cmul(v[7], w7);
}
FFT_FN void fft_fwdL(fftbuf_t X, fftbuf_t TW, int tid, cplx (&v)[8]) {
    dft8<false>(v); twidL<512, false>(v, TW, tid); st8<512>(X, tid, v); FFT_SYNC();
    ld8<64>(X, tid, v); dft8<false>(v); twidL<64, false>(v, TW, tid); st8<64>(X, tid, v); FFT_SYNC();
    ld8<8>(X, tid, v); dft8<false>(v); twidL<8, false>(v, TW, tid); st8<8>(X, tid, v); FFT_SYNC();
    ld8<1>(X, tid, v); dft8<false>(v);
}
FFT_FN void fft_invL(fftbuf_t X, fftbuf_t TW, int tid, cplx (&v)[8]) {
    dft8<true>(v); st8<1>(X, tid, v); FFT_SYNC();
    ld8<8>(X, tid, v); twidL<8, true>(v, TW, tid); dft8<true>(v); st8<8>(X, tid, v); FFT_SYNC();
    ld8<64>(X, tid, v); twidL<64, true>(v, TW, tid); dft8<true>(v); st8<64>(X, tid, v); FFT_SYNC();
    ld8<512>(X, tid, v); twidL<512, true>(v, TW, tid); dft8<true>(v);
}
FFT_FN void fft_fwd(fftbuf_t X, int tid, cplx (&v)[8]) {
    dft8<false>(v); twid<512, false>(v, tid); st8<512>(X, tid, v); FFT_SYNC();
    ld8<64>(X, tid, v); dft8<false>(v); twid<64, false>(v, tid); st8<64>(X, tid, v); FFT_SYNC();
    ld8<8>(X, tid, v); dft8<false>(v); twid<8, false>(v, tid); st8<8>(X, tid, v); FFT_SYNC();
    ld8<1>(X, tid, v); dft8<false>(v);
}
FFT_FN void fft_inv(fftbuf_t X, int tid, cplx (&v)[8]) {
    dft8<true>(v); st8<1>(X, tid, v); FFT_SYNC();
    ld8<8>(X, tid, v); twid<8, true>(v, tid); dft8<true>(v); st8<8>(X, tid, v); FFT_SYNC();
    ld8<64>(X, tid, v); twid<64, true>(v, tid); dft8<true>(v); st8<64>(X, tid, v); FFT_SYNC();
    ld8<512>(X, tid, v); twid<512, true>(v, tid); dft8<true>(v);
}
#endif

struct OneUnit { int pm, pn; bool on;
    __device__ __forceinline__ bool next(int i, pg8::Unit& u) const { if (!on || i > 0) return false; u.pm = pm; u.pn = pn; return true; }
    __device__ __forceinline__ void a_ready(const pg8::Unit&) const {}
    __device__ __forceinline__ void done(const pg8::Unit&) const {}
    __device__ __forceinline__ long a_off(const pg8::Unit& u, size_t tstep) const { return (long)((size_t)u.pm * tstep); }
    __device__ __forceinline__ int lda(int K) const { return K; }
    __device__ __forceinline__ size_t kstep_a() const { return 128; } };

struct EpiB {
    static constexpr bool PERM = true, AFTER_DRAIN = false;
    bf16_t* O; int ldc;
    __device__ __forceinline__ void operator()(const f32x4 (&acc)[2][2][4][2], const pg8::Unit& u, int wr, int wc, int fr, int fq) const {
        const int row0 = u.pm * 256 + wr * 64 + fr, col0 = u.pn * 256 + wc * 32 + 8 * fq;
#pragma unroll
        for (int ai = 0; ai < 2; ++ai)
#pragma unroll
            for (int m = 0; m < 4; ++m) { bf16_t* rowp = O + (size_t)(row0 + ai * 128 + m * 16) * ldc + col0;
#pragma unroll
                for (int bj = 0; bj < 2; ++bj) { const f32x4 v0 = acc[ai][bj][m][0], v1 = acc[ai][bj][m][1];
                    u32x4 w; w.x = pk2(v0[0], v0[1]); w.y = pk2(v0[2], v0[3]); w.z = pk2(v1[0], v1[1]); w.w = pk2(v1[2], v1[3]);
                    *(u32x4*)(rowp + bj * 128) = w; } }
    }
};
struct EpiRope {
    static constexpr bool PERM = true, AFTER_DRAIN = false;
    bf16_t* O; const float2* rope;
    __device__ __forceinline__ void operator()(const f32x4 (&acc)[2][2][4][2], const pg8::Unit& u, int wr, int wc, int fr, int fq) const {
        const int row0 = u.pm * 256 + wr * 64 + fr, col0 = u.pn * 256 + wc * 32 + 8 * fq;
        const bool rot = u.pn < 4;
#pragma unroll
        for (int ai = 0; ai < 2; ++ai)
#pragma unroll
            for (int m = 0; m < 4; ++m) { const int row = row0 + ai * 128 + m * 16; bf16_t* rowp = O + (size_t)row * MIXW + col0;
#pragma unroll
                for (int bj = 0; bj < 2; ++bj) { f32x4 v0 = acc[ai][bj][m][0], v1 = acc[ai][bj][m][1];
                    if (rot) { const int pos = row & (SEQ - 1), i0 = ((col0 + bj * 128) & 63) >> 1;
                        const f32x4* rp = (const f32x4*)(rope + pos * 32 + i0); const f32x4 r0 = rp[0], r1 = rp[1];
                        f32x4 o0, o1;
                        o0[0] = v0[0] * r0[0] - v0[1] * r0[1]; o0[1] = v0[1] * r0[0] + v0[0] * r0[1];
                        o0[2] = v0[2] * r0[2] - v0[3] * r0[3]; o0[3] = v0[3] * r0[2] + v0[2] * r0[3];
                        o1[0] = v1[0] * r1[0] - v1[1] * r1[1]; o1[1] = v1[1] * r1[0] + v1[0] * r1[1];
                        o1[2] = v1[2] * r1[2] - v1[3] * r1[3]; o1[3] = v1[3] * r1[2] + v1[2] * r1[3];
                        v0 = o0; v1 = o1; }
                    u32x4 w; w.x = pk2(v0[0], v0[1]); w.y = pk2(v0[2], v0[3]); w.z = pk2(v1[0], v1[1]); w.w = pk2(v1[2], v1[3]);
                    *(u32x4*)(rowp + bj * 128) = w; } }
    }
};
constexpr int XCH_OFF = 131072 + 1024;
__device__ __forceinline__ void stat_put(LAS cplx* ST, int rowl, int wc, int fq, float s1, float s2, bool first) {
    s1 += __shfl_xor(s1, 16); s2 += __shfl_xor(s2, 16); s1 += __shfl_xor(s1, 32); s2 += __shfl_xor(s2, 32);
    if (fq == 0) { LAS cplx* p = ST + rowl * 4 + wc; cplx v; v.x = s1; v.y = s2; if (!first) { const cplx o = *p; v.x += o.x; v.y += o.y; } *p = v; }
}
struct EpiRes {
    static constexpr bool PERM = false, AFTER_DRAIN = false;
    const float* X; float* O; LAS unsigned char* lds; mutable int ecnt;
    __device__ __forceinline__ void operator()(const f32x4 (&acc)[2][2][4][2], const pg8::Unit& u, int wr, int wc, int fr, int fq) const {
        const int row0 = u.pm * 256 + wr * 64 + fr, col0 = u.pn * 256 + wc * 32 + 4 * fq;
        LAS cplx* ST = (LAS cplx*)(lds + XCH_OFF) + (ecnt & 1) * 1024; const bool first = true; ++ecnt;
#pragma unroll
        for (int ai = 0; ai < 2; ++ai) {
            f32x4 xv[4][2][2];
#pragma unroll
            for (int m = 0; m < 4; ++m)
#pragma unroll
                for (int bj = 0; bj < 2; ++bj)
#pragma unroll
                    for (int n = 0; n < 2; ++n) xv[m][bj][n] = *(const f32x4*)(X + (size_t)(row0 + ai * 128 + m * 16) * DM + col0 + bj * 128 + 16 * n);
            asm volatile("" ::: "memory");
#pragma unroll
            for (int m = 0; m < 4; ++m) { float s1 = 0.f, s2 = 0.f;
#pragma unroll
                for (int bj = 0; bj < 2; ++bj)
#pragma unroll
                    for (int n = 0; n < 2; ++n) { const f32x4 o = acc[ai][bj][m][n] + xv[m][bj][n] * ALPHA;
                        *(f32x4*)(O + (size_t)(row0 + ai * 128 + m * 16) * DM + col0 + bj * 128 + 16 * n) = o;
                        s1 += (o[0] + o[1]) + (o[2] + o[3]); s2 += (o[0] * o[0] + o[1] * o[1]) + (o[2] * o[2] + o[3] * o[3]); }
                stat_put(ST, ai * 128 + wr * 64 + m * 16 + fr, wc, fq, s1, s2, first); }
        }
    }
};
struct EpiRes2 {
    static constexpr bool PERM = false, AFTER_DRAIN = false;
    const float* R; float* O; const float2* stat; const float* g; const float* b; LAS unsigned char* lds; mutable int ecnt;
    __device__ __forceinline__ void operator()(const f32x4 (&acc)[2][2][4][2], const pg8::Unit& u, int wr, int wc, int fr, int fq) const {
        const int row0 = u.pm * 256 + wr * 64 + fr, col0 = u.pn * 256 + wc * 32 + 4 * fq;
        LAS cplx* ST = (LAS cplx*)(lds + XCH_OFF) + (ecnt & 1) * 1024; const bool first = true; ++ecnt;
#pragma unroll
        for (int ai = 0; ai < 2; ++ai)
#pragma unroll
            for (int bj = 0; bj < 2; ++bj) {
                f32x4 rv[4][2], gv[2], bv[2]; float2 st[4];
#pragma unroll
                for (int m = 0; m < 4; ++m) { const int row = row0 + ai * 128 + m * 16; st[m] = stat[row];
#pragma unroll
                    for (int n = 0; n < 2; ++n) rv[m][n] = *(const f32x4*)(R + (size_t)row * DM + col0 + bj * 128 + 16 * n); }
#pragma unroll
                for (int n = 0; n < 2; ++n) { gv[n] = *(const f32x4*)(g + col0 + bj * 128 + 16 * n); bv[n] = *(const f32x4*)(b + col0 + bj * 128 + 16 * n); }
                asm volatile("" ::: "memory");
#pragma unroll
                for (int m = 0; m < 4; ++m) { float s1 = 0.f, s2 = 0.f;
#pragma unroll
                    for (int n = 0; n < 2; ++n) { const f32x4 x1 = (rv[m][n] - st[m].x) * st[m].y * gv[n] + bv[n]; const f32x4 o = acc[ai][bj][m][n] + x1 * ALPHA;
                        *(f32x4*)(O + (size_t)(row0 + ai * 128 + m * 16) * DM + col0 + bj * 128 + 16 * n) = o;
                        s1 += (o[0] + o[1]) + (o[2] + o[3]); s2 += (o[0] * o[0] + o[1] * o[1]) + (o[2] * o[2] + o[3] * o[3]); }
                    stat_put(ST, ai * 128 + wr * 64 + m * 16 + fr, wc, fq, s1, s2, first && bj == 0); }
            }
    }
};
struct PairOrder : pg8::StaticOrder {
    bool pair;
    __device__ __forceinline__ static int vcu_of(int c) { return (c & 7) * 32 + (c >> 3); }
    __device__ __forceinline__ bool next(int i, pg8::Unit& u) const {
        if (!pair) return pg8::StaticOrder::next(i, u);
        if (i > 1) return false;
        const int v = vcu_of(c); u.pm = 2 * (v >> 2) + i; u.pn = v & 3; return true; }
};
struct KbOrder : pg8::StaticOrder {
    __device__ __forceinline__ int lda(int) const { return 64; }
    __device__ __forceinline__ size_t kstep_a() const { return (size_t)NT * 64 * 2; }
};
struct PairKb : PairOrder {
    __device__ __forceinline__ int lda(int) const { return 64; }
    __device__ __forceinline__ size_t kstep_a() const { return (size_t)NT * 64 * 2; }
};
struct RevOrder : pg8::StaticOrder {
    __device__ __forceinline__ bool next(int i, pg8::Unit& u) const { const int rounds = (nwg + G - 1) / G; if (i >= rounds) return false; return pg8::StaticOrder::next(rounds - 1 - i, u); }
};
constexpr int CWL_OFF = 131072 + 1024 + 8192;
struct FfnOrder : pg8::StaticOrder {
    const float* cw; const float* cb; LAS unsigned char* lds; mutable int cnt;
    __device__ __forceinline__ long a_off(const pg8::Unit& u, size_t) const { return ((long)u.pm * 254 - 1) * (long)(DM * 2); }
    __device__ __forceinline__ void a_ready(const pg8::Unit& u) const {
        const int tid = threadIdx.x, w = __builtin_amdgcn_readfirstlane(tid >> 6), lane = tid & 63, buf = cnt & 1; ++cnt;
        const float* src = (w < 3) ? cw + (size_t)w * (2 * DFF) : (w < 6) ? cw + (size_t)(w - 3) * (2 * DFF) + DFF : (w == 6) ? cb : cb + DFF;
        src += u.pn * 128 + lane * 4;
        if (lane < 32) __builtin_amdgcn_global_load_lds((const unsigned*)src, (LAS unsigned*)(lds + CWL_OFF + buf * 4096 + w * 512), 16, 0, 0);
    }
};
constexpr int FFN_MT = 130;
__device__ __forceinline__ float dpp_ror1(float v)  { return __int_as_float(__builtin_amdgcn_update_dpp(0, __float_as_int(v), 0x121, 0xF, 0xF, false)); }
__device__ __forceinline__ float dpp_ror15(float v) { return __int_as_float(__builtin_amdgcn_update_dpp(0, __float_as_int(v), 0x12F, 0xF, 0xF, false)); }
struct EpiFfn {
    static constexpr bool PERM = true, AFTER_DRAIN = false;
    bf16_t* ACT; LAS unsigned char* lds; mutable int ecnt;
    __device__ __forceinline__ void operator()(const f32x4 (&acc)[2][2][4][2], const pg8::Unit& u, int wr, int wc, int fr, int fq) const {
        LAS float* XC = (LAS float*)(lds + XCH_OFF);
        const LAS float* WL = (const LAS float*)(lds + CWL_OFF + (ecnt & 1) * 4096); ++ecnt;
        const int colw = wc * 32 + 8 * fq;
        if (fr == 0 || fr == 15) {
            const int edge = (fr == 15) ? 1 : 0, m = (fr == 15) ? 3 : 0;
#pragma unroll
            for (int ai = 0; ai < 2; ++ai)
#pragma unroll
                for (int bj = 0; bj < 2; ++bj)
#pragma unroll
                    for (int n = 0; n < 2; ++n) { const f32x4 v = (m == 0) ? acc[ai][bj][0][n] : acc[ai][bj][3][n];
                        *(LAS f32x4*)(XC + ((ai * 2 + wr) * 2 + edge) * 256 + bj * 128 + colw + 4 * n) = v; }
        }
        asm volatile("s_waitcnt lgkmcnt(0)" ::: "memory"); __builtin_amdgcn_s_barrier(); asm volatile("" ::: "memory");
        const int slot0 = wr * 64 + fr, row_base = u.pm * 254 - 1;
#pragma unroll
        for (int bj = 0; bj < 2; ++bj) {
            const int gc = (u.pn * 256 + bj * 128 + colw) >> 1;
            const LAS float* wl = WL + ((bj * 128 + colw) >> 1);
            f32x4 wg[3], wu[3];
#pragma unroll
            for (int j = 0; j < 3; ++j) { wg[j] = *(const LAS f32x4*)(wl + j * 128); wu[j] = *(const LAS f32x4*)(wl + (3 + j) * 128); }
            const f32x4 bg = *(const LAS f32x4*)(wl + 6 * 128), bu = *(const LAS f32x4*)(wl + 7 * 128);
#pragma unroll
            for (int ai = 0; ai < 2; ++ai) {
                const int gidx = ai * 2 + wr;
                f32x4 pe[2], ne[2];
#pragma unroll
                for (int n = 0; n < 2; ++n) {
                    pe[n] = (gidx > 0) ? *(const LAS f32x4*)(XC + (((gidx - 1) * 2) + 1) * 256 + bj * 128 + colw + 4 * n) : (f32x4){0.f, 0.f, 0.f, 0.f};
                    ne[n] = (gidx < 3) ? *(const LAS f32x4*)(XC + (((gidx + 1) * 2) + 0) * 256 + bj * 128 + colw + 4 * n) : (f32x4){0.f, 0.f, 0.f, 0.f}; }
#pragma unroll
                for (int m = 0; m < 4; ++m) {
                    const int slot = ai * 128 + slot0 + m * 16, row = row_base + slot, t = row & (SEQ - 1);
                    f32x4 hv[2];
#pragma unroll
                    for (int n = 0; n < 2; ++n) {
                        const f32x4 cur = acc[ai][bj][m][n], prv = acc[ai][bj][m == 0 ? 0 : m - 1][n], nxt = acc[ai][bj][m == 3 ? 3 : m + 1][n];
                        f32x4 up, dn;
#pragma unroll
                        for (int e = 0; e < 4; ++e) { up[e] = dpp_ror1(fr == 15 ? prv[e] : cur[e]); dn[e] = dpp_ror15(fr == 0 ? nxt[e] : cur[e]); }
                        if (m == 0 && fr == 0) up = pe[n];
                        if (m == 3 && fr == 15) dn = ne[n];
                        if (t == 0) up = (f32x4){0.f, 0.f, 0.f, 0.f};
                        if (t == SEQ - 1) dn = (f32x4){0.f, 0.f, 0.f, 0.f};
                        const f32x4 w0 = n ? wu[0] : wg[0], w1 = n ? wu[1] : wg[1], w2 = n ? wu[2] : wg[2], bb = n ? bu : bg;
                        hv[n] = w0 * up + w1 * cur + w2 * dn + bb; }
                    if (slot >= 1 && slot <= 254 && row < NT) {
                        float o[4];
#pragma unroll
                        for (int e = 0; e < 4; ++e) { const float g = hv[0][e]; o[e] = g * __builtin_amdgcn_rcpf(1.0f + __expf(-g)) * hv[1][e]; }
                        u32x2 w; w.x = pk2(o[0], o[1]); w.y = pk2(o[2], o[3]);
                        *(u32x2*)(ACT + ((size_t)(gc >> 6) * NT + row) * 64 + (gc & 63)) = w; }
                }
            }
        }
    }
};

__device__ __forceinline__ int win_row(int n) {
    if (n < 1536) return 1536 + n;
    if (n < 2560) { const int q = n - 1536, blk = q >> 6, d = q & 63; return blk * 64 + 2 * (d & 31) + (d >> 5); }
    if (n < 3072) return 512 + n;
    return n - 2048;
}
template <int MODE> __device__ __forceinline__ void p0_transpose_item(const float* W, int K, int N, bf16_t* WT, LAS float* scr, int item, int lane) {
    const int nblk = N / 32, kb = item / nblk, nb = item % nblk, k0 = 64 * kb, n0 = 32 * nb;
    f32x4 q[8];
#pragma unroll
    for (int i = 0; i < 8; ++i) q[i] = *(const f32x4*)(W + (size_t)(k0 + 8 * i + (lane >> 3)) * N + n0 + 4 * (lane & 7));
#pragma unroll
    for (int i = 0; i < 8; ++i) { LAS float* d = scr + (8 * i + (lane >> 3)) * 33 + 4 * (lane & 7); d[0] = q[i][0]; d[1] = q[i][1]; d[2] = q[i][2]; d[3] = q[i][3]; }
    LDS_WAIT(); asm volatile("" ::: "memory");
    const int c = lane & 7;
#pragma unroll
    for (int j = 0; j < 4; ++j) { const int n = (lane >> 3) + 8 * j; const LAS float* s = scr + (8 * c) * 33 + n;
        u32x4 o; o.x = pk2(s[0 * 33], s[1 * 33]); o.y = pk2(s[2 * 33], s[3 * 33]); o.z = pk2(s[4 * 33], s[5 * 33]); o.w = pk2(s[6 * 33], s[7 * 33]);
        const int nn = n0 + n; const int dr = (MODE == 1) ? win_row(nn) : (MODE == 2) ? ((nn < DFF) ? ((nn >> 2) * 8 + (nn & 3)) : (((nn - DFF) >> 2) * 8 + 4 + ((nn - DFF) & 3))) : nn;
        *(u32x4*)(WT + (size_t)dr * K + k0 + 8 * c) = o; }
    LDS_WAIT(); asm volatile("" ::: "memory");
}
__device__ __forceinline__ void cvt_rows(const float* src, bf16_t* dst, size_t n8, int gw, int ngw, int lane) {
    const size_t stride = (size_t)ngw * 64;
    for (size_t i = (size_t)gw * 64 + lane; i < n8; i += 4 * stride) {
        f32x4 a[4], c[4];
#pragma unroll
        for (int u = 0; u < 4; ++u) { const size_t k = i + u * stride; if (k < n8) { a[u] = ((const f32x4*)src)[2 * k]; c[u] = ((const f32x4*)src)[2 * k + 1]; } }
#pragma unroll
        for (int u = 0; u < 4; ++u) { const size_t k = i + u * stride; if (k < n8) {
            u32x4 w; w.x = pk2(a[u][0], a[u][1]); w.y = pk2(a[u][2], a[u][3]); w.z = pk2(c[u][0], c[u][1]); w.w = pk2(c[u][2], c[u][3]);
            ((u32x4*)dst)[k] = w; } }
    }
}
__device__ __forceinline__ void p0_filter_item(const LAS float* w1, const float* b1, const float* fq, const LAS float* w2, const float* b2, const float* w3, float* HTD, int item, int lane) {
    const int t0 = 2 * (item >> 2), ih = item & 3; float h2v[2], tl[2];
    const float fql = fq[lane], b1l = b1[lane], b2l = b2[lane];
#pragma unroll
    for (int tt = 0; tt < 2; ++tt) { const int t = t0 + tt; tl[tt] = (float)t * (1.0f / 2047.0f);
        const float w = 6.283185307179586f * (float)t / 2048.0f;
        float zk = 0.f;
        if (lane == 0) zk = tl[tt];
        else if (lane <= 16) { const float fr = 1e-4f + (float)(lane - 1) * ((15.0f - 1e-4f) / 15.0f); zk = cosf(fr * w); }
        else if (lane <= 32) { const float fr = 1e-4f + (float)(lane - 17) * ((15.0f - 1e-4f) / 15.0f); zk = -sinf(fr * w); }
        float a = b1l;
#pragma unroll 11
        for (int k = 0; k < 33; ++k) a += __shfl(zk, k) * w1[k * 64 + lane];
        const float h1 = sinf(fql * a);
        float a2 = b2l;
#pragma unroll 16
        for (int k = 0; k < 64; ++k) a2 += __shfl(h1, k) * w2[k * 64 + lane];
        h2v[tt] = sinf(fql * a2); }
    const float dmin = -15.350567286626973f, dmax = -3.0701134573253946f;
    float acc0[8], acc1[8];
#pragma unroll
    for (int i = 0; i < 8; ++i) { acc0[i] = 0.f; acc1[i] = 0.f; }
#pragma unroll 8
    for (int j = 0; j < 64; ++j) { const float s0 = __shfl(h2v[0], j), s1 = __shfl(h2v[1], j); const float* wr = w3 + (size_t)j * 2048 + ih * 512 + lane;
#pragma unroll
        for (int i = 0; i < 8; ++i) { const float wv = wr[64 * i]; acc0[i] += s0 * wv; acc1[i] += s1 * wv; } }
#pragma unroll
    for (int i = 0; i < 8; ++i) { const int col = ih * 512 + 64 * i + lane, c = col & 511;
        const float delta = fabsf(dmin + (float)c * ((dmax - dmin) / 511.0f));
        float2 o; o.x = acc0[i] * expf(-tl[0] * delta); o.y = acc1[i] * expf(-tl[1] * delta);
        *(float2*)(HTD + (size_t)col * 2048 + t0) = o; }
}
__device__ __forceinline__ void p0_prep(const float* const* in, unsigned char* ws, LAS unsigned char* lds, int tid) {
    const int lane = tid & 63, wave = __builtin_amdgcn_readfirstlane(tid >> 6), gw = blockIdx.x * NWAVE + wave, ngw = gridDim.x * NWAVE;
    LAS float* scr = (LAS float*)(lds + wave * 8704);
    LAS float* W1L = (LAS float*)(lds + 69632); LAS float* W2L = W1L + 33 * 64;
    for (int i = tid; i < 33 * 64; i += NTHR) W1L[i] = in[5][i];
    for (int i = tid; i < 64 * 64; i += NTHR) W2L[i] = in[8][i];
    __syncthreads();
    bf16_t* WALL = (bf16_t*)(ws + WS_WALL);
    constexpr int I_IN = 16 * (INW / 32), I_KV = 16 * 32, I_OUT = 24 * 32, I_UP = 16 * (2 * DFF / 32), I_DN = (DFF / 64) * 32, NIT = I_IN + I_KV + I_OUT + I_UP + I_DN;
    for (int it = gw; it < NIT; it += ngw) { int r = it;
        if (r < I_IN) { p0_transpose_item<1>(in[2], DM, INW, WALL, scr, r, lane); continue; } r -= I_IN;
        if (r < I_KV) { p0_transpose_item<0>(in[14], DM, 1024, (bf16_t*)(ws + WS_WKV), scr, r, lane); continue; } r -= I_KV;
        if (r < I_OUT) { p0_transpose_item<0>(in[15], MIXW, DM, (bf16_t*)(ws + WS_WOUT), scr, r, lane); continue; } r -= I_OUT;
        if (r < I_UP) { p0_transpose_item<2>(in[18], DM, 2 * DFF, (bf16_t*)(ws + WS_WUP), scr, r, lane); continue; } r -= I_UP;
        p0_transpose_item<0>(in[21], DFF, DM, (bf16_t*)(ws + WS_WDN), scr, r, lane); }
    for (int it = ngw - 1 - gw; it < 4096; it += ngw) p0_filter_item(W1L, in[6], in[7], W2L, in[9], in[10], (float*)(ws + WS_HTD), it, lane);
    cvt_rows(in[0], (bf16_t*)(ws + WS_XB), (size_t)NT * DM / 8, gw, ngw, lane);
    cvt_rows(in[1], (bf16_t*)(ws + WS_MEMB), (size_t)NMT * DM / 8, gw, ngw, lane);
    float2* rope = (float2*)(ws + WS_ROPE);
    for (int i = blockIdx.x * NTHR + tid; i < SEQ * 32; i += gridDim.x * NTHR) { const int pos = i >> 5, f = i & 31;
        const float invf = powf(10000.0f, -(float)(2 * f) / 64.0f); const float ang = (float)pos * invf;
        float2 cs; cs.x = cosf(ang); cs.y = sinf(ang); rope[i] = cs; }
}

__device__ __forceinline__ void filter_fft_item(const float* HTD, float2* KF, LAS unsigned char* lds, int item, int tid) {
    const int o = item >> 9, c = item & 511;
    const float* rf = HTD + (size_t)((o * 2 + 0) * 512 + c) * 2048; const float* rb = HTD + (size_t)((o * 2 + 1) * 512 + c) * 2048;
    cplx v[8];
#pragma unroll
    for (int k = 0; k < 4; ++k) v[k] = mk2(rf[tid + 512 * k], 0.f);
    v[4] = mk2(tid == 0 ? 0.f : rb[2048 - tid], 0.f); v[5] = mk2(rb[1536 - tid], 0.f); v[6] = mk2(rb[1024 - tid], 0.f); v[7] = mk2(rb[512 - tid], 0.f);
    fft_fwd((LAS cplx*)lds, tid, v);
    float2* dst = KF + (size_t)(o * 512 + c) * 4096 + 8 * tid;
#pragma unroll
    for (int m = 0; m < 8; m += 2) { f32x4 w; w[0] = v[m].x * (1.f / 4096.f); w[1] = v[m].y * (1.f / 4096.f); w[2] = v[m + 1].x * (1.f / 4096.f); w[3] = v[m + 1].y * (1.f / 4096.f); *(f32x4*)(dst + m) = w; }
    __syncthreads();
}

constexpr int HY_SEG = 2064, HY_STG_OFF = 36864;
__device__ __forceinline__ float conv3s(const LAS bf16_t* seg, int n, float w0, float w1, float w2, float b) {
    return w0 * bf2f(seg[7 + n]) + w1 * bf2f(seg[8 + n]) + w2 * bf2f(seg[9 + n]) + b;
}
__device__ __forceinline__ void hyena_item(const bf16_t* HT, const float2* KF, const float* cw, const float* cb, const float* hb, bf16_t* MIX, LAS unsigned char* lds, int bp, int cgp, int tid0) {
    LAS cplx* X = (LAS cplx*)lds; LAS bf16_t* STG = (LAS bf16_t*)(lds + HY_STG_OFF); LAS cplx* TW = (LAS cplx*)(lds + 65536);
    const int ba = 2 * bp;
    twid_fill<512>(TW, tid0); twid_fill<64>(TW, tid0); twid_fill<8>(TW, tid0);
    u32x4 oacc[8];
#pragma unroll
    for (int i = 0; i < 8; ++i) oacc[i] = (u32x4){0u, 0u, 0u, 0u};
    if (tid0 < 12) { const int sg = tid0 >> 1; STG[sg * HY_SEG + ((tid0 & 1) ? 2056 : 7)] = 0; }
    { const int c = cgp * 8;
#pragma unroll
      for (int i = 0; i < 3; ++i) { const int id = tid0 + 512 * i, sg = id >> 8, ch = id & 255;
          const u32x4 q = *(const u32x4*)(HT + (size_t)((sg >> 1) * 512 + c) * NT + (ba + (sg & 1)) * SEQ + ch * 8);
          *(LAS u32x4*)(STG + sg * HY_SEG + 8 + ch * 8) = q; } }
    __syncthreads();
#pragma unroll 1
    for (int cc = 0; cc < 8; ++cc) {
        const int c = cgp * 8 + cc;
        int tl_ = tid0; asm volatile("" : "+v"(tl_)); const int tid = tl_;
        u32x4 nx[3];
        if (cc < 7) {
#pragma unroll
            for (int i = 0; i < 3; ++i) { const int id = tid + 512 * i, sg = id >> 8, ch = id & 255;
                nx[i] = *(const u32x4*)(HT + (size_t)((sg >> 1) * 512 + c + 1) * NT + (ba + (sg & 1)) * SEQ + ch * 8); } }
        f32x4 kf[4];
        { const f32x4* kp = (const f32x4*)(KF + (size_t)c * 4096 + 8 * tid);
#pragma unroll
          for (int m = 0; m < 4; ++m) kf[m] = kp[m]; }
        cplx v[8]; float va[4], vb[4];
        { const float w0 = cw[c], w1 = cw[1536 + c], w2 = cw[3072 + c], b = cb[c];
#pragma unroll
          for (int k = 0; k < 4; ++k) { const int n = tid + 512 * k; va[k] = conv3s(STG, n, w0, w1, w2, b); vb[k] = conv3s(STG + HY_SEG, n, w0, w1, w2, b); v[k] = mk2(va[k], vb[k]); v[4 + k] = mk2(0.f, 0.f); } }
        fft_fwdL(X, TW, tid, v);
#pragma unroll
        for (int m = 0; m < 8; m += 2) { const f32x4 w = kf[m >> 1]; v[m] = cmul(v[m], mk2(w[0], w[1])); v[m + 1] = cmul(v[m + 1], mk2(w[2], w[3])); }
        { const f32x4* kp = (const f32x4*)(KF + (size_t)(512 + c) * 4096 + 8 * tid);
#pragma unroll
          for (int m = 0; m < 4; ++m) kf[m] = kp[m]; }
        fft_invL(X, TW, tid, v);
        { const float w0 = cw[512 + c], w1 = cw[1536 + 512 + c], w2 = cw[3072 + 512 + c], b = cb[512 + c], hb0 = hb[c];
#pragma unroll
          for (int k = 0; k < 4; ++k) { const int n = tid + 512 * k; const float xa = conv3s(STG + 2 * HY_SEG, n, w0, w1, w2, b), xb = conv3s(STG + 3 * HY_SEG, n, w0, w1, w2, b);
              va[k] = xa * (v[k].x + hb0 * va[k]); vb[k] = xb * (v[k].y + hb0 * vb[k]); v[k] = mk2(va[k], vb[k]); v[4 + k] = mk2(0.f, 0.f); } }
        fft_fwdL(X, TW, tid, v);
#pragma unroll
        for (int m = 0; m < 8; m += 2) { const f32x4 w = kf[m >> 1]; v[m] = cmul(v[m], mk2(w[0], w[1])); v[m + 1] = cmul(v[m + 1], mk2(w[2], w[3])); }
        fft_invL(X, TW, tid, v);
        { const float w0 = cw[1024 + c], w1 = cw[1536 + 1024 + c], w2 = cw[3072 + 1024 + c], b = cb[1024 + c], hb1 = hb[512 + c];
#pragma unroll
          for (int k = 0; k < 4; ++k) { const int n = tid + 512 * k; const float xa = conv3s(STG + 4 * HY_SEG, n, w0, w1, w2, b), xb = conv3s(STG + 5 * HY_SEG, n, w0, w1, w2, b);
              const float oa = xa * (v[k].x + hb1 * va[k]), ob = xb * (v[k].y + hb1 * vb[k]);
              const unsigned pw = pk2(oa, ob);
#pragma unroll
              for (int hh = 0; hh < 2; ++hh) { u32x4& o = oacc[2 * k + hh]; const unsigned nw = hh ? (pw & 0xffff0000u) : (pw << 16);
                  o.x = __builtin_amdgcn_alignbit(o.y, o.x, 16); o.y = __builtin_amdgcn_alignbit(o.z, o.y, 16); o.z = __builtin_amdgcn_alignbit(o.w, o.z, 16); o.w = (o.w >> 16) | nw; } } }
        __syncthreads();
        if (cc < 7) {
#pragma unroll
            for (int i = 0; i < 3; ++i) { const int id = tid + 512 * i, sg = id >> 8, ch = id & 255; *(LAS u32x4*)(STG + sg * HY_SEG + 8 + ch * 8) = nx[i]; } }
        __syncthreads();
    }
    int tw_ = tid0; asm volatile("" : "+v"(tw_)); const int tid = tw_;
#pragma unroll
    for (int k = 0; k < 4; ++k)
#pragma unroll
        for (int hh = 0; hh < 2; ++hh) *(u32x4*)(MIX + (size_t)((ba + hh) * SEQ + tid + 512 * k) * MIXW + cgp * 8) = oacc[2 * k + hh];
}

constexpr int ATT_KP = 272, ATT_VP = 144, ATT_KB = 64 * ATT_KP, ATT_VB = 128 * ATT_VP, ATT_VOFF = 2 * ATT_KB;
__device__ __forceinline__ void att_vput(LAS unsigned char* p, u32x4 q) { u32x2 lo, hi; lo.x = q.x; lo.y = q.y; hi.x = q.z; hi.y = q.w; *(LAS u32x2*)p = lo; *(LAS u32x2*)(p + 16) = hi; }
template <int NC> __device__ __forceinline__ void attn_unit(LAS unsigned char* lds, const bf16_t* Qp, int ldq, const bf16_t* Kp, int ldk, const bf16_t* Vt, int ldv, int nkeys, float sl2,
                                                            bf16_t* Op, int ldo, float lam, const float* subg, int tid) {
    constexpr int NSTEP = (NC == 2) ? 4 : 8;
    const int lane = tid & 63, wave = tid >> 6, r = lane & 31, h = lane >> 5;
    const int qb = (NC == 2) ? (wave & 3) : wave, comp = (NC == 2) ? (wave >> 2) : 0, dbase = comp * 64;
    bf16x8 qf[NSTEP];
#pragma unroll
    for (int st = 0; st < NSTEP; ++st) qf[st] = *(const bf16x8*)(Qp + (size_t)(qb * 32 + r) * ldq + dbase + 16 * st + 8 * h);
    f32x16 o[4];
#pragma unroll
    for (int et = 0; et < 4; ++et)
#pragma unroll
        for (int i = 0; i < 16; ++i) o[et][i] = 0.f;
    float mold = -INFINITY, lsum = 0.f;
    const int kr0 = tid >> 4, kc = tid & 15, vr0 = tid >> 3, vc = tid & 7;
    const bf16_t* kg = Kp + (size_t)kr0 * ldk + kc * 8; const bf16_t* vg = Vt + (size_t)vr0 * ldv + vc * 8;
    const int kl = kr0 * ATT_KP + kc * 16, vl = ATT_VOFF + vr0 * ATT_VP + (vc >> 1) * 32 + (vc & 1) * 8;
    const int nt = nkeys / 64;
    u32x4 pk0, pk1, pv0, pv1;
    pk0 = *(const u32x4*)(kg); pk1 = *(const u32x4*)(kg + (size_t)32 * ldk); pv0 = *(const u32x4*)(vg); pv1 = *(const u32x4*)(vg + (size_t)64 * ldv);
    *(LAS u32x4*)(lds + kl) = pk0; *(LAS u32x4*)(lds + kl + 32 * ATT_KP) = pk1; att_vput(lds + vl, pv0); att_vput(lds + vl + 64 * ATT_VP, pv1);
    __syncthreads();
    for (int it = 0; it < nt; ++it) {
        const int cur = it & 1; const bool more = (it + 1 < nt);
        if (more) { const bf16_t* kg2 = kg + (size_t)(it + 1) * 64 * ldk; const bf16_t* vg2 = vg + (it + 1) * 64;
            pk0 = *(const u32x4*)(kg2); pk1 = *(const u32x4*)(kg2 + (size_t)32 * ldk); pv0 = *(const u32x4*)(vg2); pv1 = *(const u32x4*)(vg2 + (size_t)64 * ldv); }
        LAS unsigned char* Kb = lds + cur * ATT_KB; LAS unsigned char* Vb = lds + ATT_VOFF + cur * ATT_VB;
        f32x16 s[2];
#pragma unroll
        for (int kb = 0; kb < 2; ++kb) {
#pragma unroll
            for (int i = 0; i < 16; ++i) s[kb][i] = 0.f;
#pragma unroll
            for (int st = 0; st < NSTEP; ++st) { const bf16x8 a = *(const LAS bf16x8*)(Kb + (kb * 32 + r) * ATT_KP + (dbase + 16 * st + 8 * h) * 2);
                s[kb] = __builtin_amdgcn_mfma_f32_32x32x16_bf16(a, qf[st], s[kb], 0, 0, 0); } }
        float mx = s[0][0];
#pragma unroll
        for (int i = 1; i < 16; ++i) mx = fmaxf(mx, s[0][i]);
#pragma unroll
        for (int i = 0; i < 16; ++i) mx = fmaxf(mx, s[1][i]);
        mx = fmaxf(mx, __shfl_xor(mx, 32));
        const float mnew = fmaxf(mold, mx * sl2), alpha = __builtin_amdgcn_exp2f(mold - mnew); mold = mnew;
        float ps = 0.f;
#pragma unroll
        for (int kb = 0; kb < 2; ++kb)
#pragma unroll
            for (int i = 0; i < 16; ++i) { const float p = __builtin_amdgcn_exp2f(__builtin_fmaf(s[kb][i], sl2, -mnew)); s[kb][i] = p; ps += p; }
        lsum = lsum * alpha + ps;
#pragma unroll
        for (int et = 0; et < 4; ++et)
#pragma unroll
            for (int i = 0; i < 16; ++i) o[et][i] *= alpha;
#pragma unroll
        for (int kb = 0; kb < 2; ++kb)
#pragma unroll
            for (int s2 = 0; s2 < 2; ++s2) {
                u32x4 pw; pw.x = pk2(s[kb][8 * s2 + 0], s[kb][8 * s2 + 1]); pw.y = pk2(s[kb][8 * s2 + 2], s[kb][8 * s2 + 3]); pw.z = pk2(s[kb][8 * s2 + 4], s[kb][8 * s2 + 5]); pw.w = pk2(s[kb][8 * s2 + 6], s[kb][8 * s2 + 7]);
                const bf16x8 pf = __builtin_bit_cast(bf16x8, pw);
#pragma unroll
                for (int et = 0; et < 4; ++et) { const u32x4 aw = *(const LAS u32x4*)(Vb + (et * 32 + r) * ATT_VP + (kb * 2 + s2) * 32 + h * 16);
                    o[et] = __builtin_amdgcn_mfma_f32_32x32x16_bf16(__builtin_bit_cast(bf16x8, aw), pf, o[et], 0, 0, 0); } }
        if (more) { const int nb = cur ^ 1;
            *(LAS u32x4*)(lds + nb * ATT_KB + kl) = pk0; *(LAS u32x4*)(lds + nb * ATT_KB + kl + 32 * ATT_KP) = pk1;
            att_vput(lds + nb * ATT_VB + vl, pv0); att_vput(lds + nb * ATT_VB + vl + 64 * ATT_VP, pv1); }
        __syncthreads();
    }
    lsum += __shfl_xor(lsum, 32);
    const float inv = 1.0f / lsum;
    if (NC == 1) {
        bf16_t* orow = Op + (size_t)(qb * 32 + r) * ldo;
#pragma unroll
        for (int et = 0; et < 4; ++et)
#pragma unroll
            for (int g = 0; g < 4; ++g) { u32x2 w; w.x = pk2(o[et][4 * g] * inv, o[et][4 * g + 1] * inv); w.y = pk2(o[et][4 * g + 2] * inv, o[et][4 * g + 3] * inv);
                *(u32x2*)(orow + et * 32 + 8 * g + 4 * h) = w; }
    } else {
        LAS float* XL = (LAS float*)lds;
        if (comp == 1) {
#pragma unroll
            for (int et = 0; et < 4; ++et)
#pragma unroll
                for (int i = 0; i < 16; ++i) XL[(qb * 64 + et * 16 + i) * 64 + lane] = o[et][i] * inv;
        }
        __syncthreads();
        if (comp == 0) {
            float ss = 0.f;
#pragma unroll
            for (int et = 0; et < 4; ++et)
#pragma unroll
                for (int i = 0; i < 16; ++i) { const float ov = o[et][i] * inv - lam * XL[(qb * 64 + et * 16 + i) * 64 + lane]; o[et][i] = ov; ss += ov * ov; }
            ss += __shfl_xor(ss, 32);
            const float rs = rsqrtf(ss * (1.0f / 128.0f) + RMS_EPS) * 0.8f;
            bf16_t* orow = Op + (size_t)(qb * 32 + r) * ldo;
#pragma unroll
            for (int et = 0; et < 4; ++et)
#pragma unroll
                for (int g = 0; g < 4; ++g) { const int e = et * 32 + 8 * g + 4 * h; const f32x4 gv = *(const f32x4*)(subg + e);
                    u32x2 w; w.x = pk2(o[et][4 * g] * rs * gv[0], o[et][4 * g + 1] * rs * gv[1]); w.y = pk2(o[et][4 * g + 2] * rs * gv[2], o[et][4 * g + 3] * rs * gv[3]);
                    *(u32x2*)(orow + e) = w; }
        }
        __syncthreads();
    }
}

template <bool TO_BF16> __device__ __forceinline__ void ln_rows(float* io, bf16_t* ob, float2* stat, const float* g, const float* b, int tid, float* alt = nullptr) {
    const int lane = tid & 63, gw = blockIdx.x * NWAVE + (tid >> 6), ngw = gridDim.x * NWAVE;
    f32x4 gv[4], bv[4];
#pragma unroll
    for (int j = 0; j < 4; ++j) { gv[j] = ((const f32x4*)g)[lane + 64 * j]; bv[j] = ((const f32x4*)b)[lane + 64 * j]; }
    for (int row0 = gw; row0 < NT; row0 += 2 * ngw) {
        f32x4 v[2][4];
#pragma unroll
        for (int u = 0; u < 2; ++u) { const int row = row0 + u * ngw; if (row < NT) { const f32x4* xr = (const f32x4*)(io + (size_t)row * DM) + lane;
#pragma unroll
            for (int j = 0; j < 4; ++j) v[u][j] = xr[64 * j]; } }
#pragma unroll
        for (int u = 0; u < 2; ++u) { const int row = row0 + u * ngw; if (row >= NT) continue;
            float s = 0.f;
#pragma unroll
            for (int j = 0; j < 4; ++j) s += (v[u][j][0] + v[u][j][1]) + (v[u][j][2] + v[u][j][3]);
#pragma unroll
            for (int o = 1; o < 64; o <<= 1) s += __shfl_xor(s, o);
            const float mean = s * (1.0f / DM); float s2 = 0.f;
#pragma unroll
            for (int j = 0; j < 4; ++j) { v[u][j] = v[u][j] - mean; s2 += (v[u][j][0] * v[u][j][0] + v[u][j][1] * v[u][j][1]) + (v[u][j][2] * v[u][j][2] + v[u][j][3] * v[u][j][3]); }
#pragma unroll
            for (int o = 1; o < 64; o <<= 1) s2 += __shfl_xor(s2, o);
            const float rstd = rsqrtf(s2 * (1.0f / DM) + LN_EPS);
            if (TO_BF16) {
                u32x2* o8 = (u32x2*)(ob + (size_t)row * DM) + lane;
#pragma unroll
                for (int j = 0; j < 4; ++j) { const f32x4 y = v[u][j] * rstd * gv[j] + bv[j]; u32x2 w; w.x = pk2(y[0], y[1]); w.y = pk2(y[2], y[3]); o8[64 * j] = w; }
                if (lane == 0) { float2 st; st.x = mean; st.y = rstd; stat[row] = st; }
            } else {
                f32x4* wr_ = (alt ? (f32x4*)(alt + (size_t)row * DM) : (f32x4*)(io + (size_t)row * DM)) + lane;
#pragma unroll
                for (int j = 0; j < 4; ++j) wr_[64 * j] = v[u][j] * rstd * gv[j] + bv[j];
            }
        }
    }
}

__device__ __forceinline__ void convgate_half(const bf16_t* HH, bf16_t* ACT, const float* cw, const float* cb, int half, int tid) {
    constexpr int NG = DFF / 8; const int total = (NT / 2) * NG;
    for (int idx = blockIdx.x * NTHR + tid; idx < total; idx += gridDim.x * NTHR) {
        const int rl = idx / NG, cg8 = idx - rl * NG, n0 = cg8 * 8, t = rl & (SEQ - 1);
        const bf16_t* hp = HH + (size_t)rl * (2 * DFF);
        float gsum[8], usum[8];
#pragma unroll
        for (int e = 0; e < 8; ++e) { gsum[e] = cb[n0 + e]; usum[e] = cb[DFF + n0 + e]; }
#pragma unroll
        for (int j = 0; j < 3; ++j) { const int tt = t + j - 1; if (tt < 0 || tt >= SEQ) continue;
            const u32x4 gq = *(const u32x4*)(hp + (ptrdiff_t)(j - 1) * (2 * DFF) + n0), uq = *(const u32x4*)(hp + (ptrdiff_t)(j - 1) * (2 * DFF) + DFF + n0);
            const float* wg = cw + (size_t)j * (2 * DFF) + n0; const float* wu = wg + DFF;
            const f32x4 wg0 = *(const f32x4*)wg, wg1 = *(const f32x4*)(wg + 4), wu0 = *(const f32x4*)wu, wu1 = *(const f32x4*)(wu + 4);
            gsum[0] += wg0[0] * lo2f(gq.x); gsum[1] += wg0[1] * hi2f(gq.x); gsum[2] += wg0[2] * lo2f(gq.y); gsum[3] += wg0[3] * hi2f(gq.y);
            gsum[4] += wg1[0] * lo2f(gq.z); gsum[5] += wg1[1] * hi2f(gq.z); gsum[6] += wg1[2] * lo2f(gq.w); gsum[7] += wg1[3] * hi2f(gq.w);
            usum[0] += wu0[0] * lo2f(uq.x); usum[1] += wu0[1] * hi2f(uq.x); usum[2] += wu0[2] * lo2f(uq.y); usum[3] += wu0[3] * hi2f(uq.y);
            usum[4] += wu1[0] * lo2f(uq.z); usum[5] += wu1[1] * hi2f(uq.z); usum[6] += wu1[2] * lo2f(uq.w); usum[7] += wu1[3] * hi2f(uq.w); }
        float a[8];
#pragma unroll
        for (int e = 0; e < 8; ++e) a[e] = gsum[e] / (1.0f + __expf(-gsum[e])) * usum[e];
        u32x4 w; w.x = pk2(a[0], a[1]); w.y = pk2(a[2], a[3]); w.z = pk2(a[4], a[5]); w.w = pk2(a[6], a[7]);
        *(u32x4*)(ACT + (size_t)(half * (NT / 2) + rl) * DFF + n0) = w;
    }
}

#define XB_TMO      128
#define XB_XCNT(j)  (256  + 64 * (j))
#define XB_XSUB(j)  (1280 + 64 * (j))
#define XB_XGEN(j)  (2304 + 64 * (j))
#define XB_TOP      3328
#define XB_TOPGEN   3392
#define XCD_BAR_WORDS 3456
#define XB_SPIN_CAP (1u << 18)

__device__ __forceinline__ unsigned xb_ld(unsigned* p)              { return __hip_atomic_load(p, __ATOMIC_RELAXED, __HIP_MEMORY_SCOPE_AGENT); }
__device__ __forceinline__ unsigned xb_add(unsigned* p, unsigned v) { return __hip_atomic_fetch_add(p, v, __ATOMIC_RELAXED, __HIP_MEMORY_SCOPE_AGENT); }
__device__ __forceinline__ unsigned xb_xcc_id() { return (unsigned)__builtin_amdgcn_s_getreg((3 << 11) | 20) & 0xFu; }
#define XB_SPIN(cond, bar) do { unsigned _sp = 0; while (cond) { __builtin_amdgcn_s_sleep(1); \
    if ((++_sp & 255u) == 0u) { if (xb_ld(&(bar)[XB_TMO])) break; if (_sp > XB_SPIN_CAP) { atomicAdd(&(bar)[XB_TMO], 1u); break; } } } } while (0)

struct XcdBarrier {
    unsigned* bar; unsigned x;
    volatile LAS unsigned* st;
};

__device__ __forceinline__ XcdBarrier xcd_barrier_post(unsigned* bar, volatile LAS unsigned* st) {
    XcdBarrier b; b.bar = bar; b.x = xb_xcc_id(); b.st = st;
    if (threadIdx.x == 0) (void)xb_add(&bar[XB_XCNT(b.x)], 1u);
    return b;
}
__device__ __forceinline__ void xcd_barrier_complete(unsigned* bar, unsigned x, unsigned& nloc, unsigned& nx) {
    const unsigned G = gridDim.x * gridDim.y * gridDim.z;
    unsigned sum, cnt, mine, sp = 0u;
    for (;;) {
        sum = 0u; cnt = 0u; mine = 0u;
#pragma unroll
        for (unsigned j = 0; j < 16; ++j) { const unsigned c = xb_ld(&bar[XB_XCNT(j)]); sum += c; cnt += (c > 0u) ? 1u : 0u; mine = (j == x) ? c : mine; }
        if (sum == G) break;
        __builtin_amdgcn_s_sleep(1);
        if ((++sp & 255u) == 0u) { if (xb_ld(&bar[XB_TMO])) break; if (sp > XB_SPIN_CAP) { atomicAdd(&bar[XB_TMO], 1u); break; } }
    }
    nloc = mine > 0u ? mine : 1u; nx = cnt > 0u ? cnt : 1u;
}

__device__ __forceinline__ void xcd_barrier(const XcdBarrier& b) {
    asm volatile("s_waitcnt vmcnt(0)" ::: "memory");
    __syncthreads();
    if (threadIdx.x == 0) {
        unsigned* bar = b.bar;
        __builtin_amdgcn_s_waitcnt(0);
        unsigned nloc = b.st[0], nx = b.st[1];
        if (nloc == 0u) { xcd_barrier_complete(bar, b.x, nloc, nx); b.st[0] = nloc; b.st[1] = nx; }
        const unsigned old = xb_add(&bar[XB_XSUB(b.x)], 1u);
        const unsigned gen = old / nloc;
        if (old + 1u == (gen + 1u) * nloc) {
            __builtin_amdgcn_fence(__ATOMIC_RELEASE, "agent");
            asm volatile("s_waitcnt vmcnt(0)" ::: "memory");
            const unsigned og = xb_add(&bar[XB_TOP], 1u);
            const unsigned tg = og / nx;
            if (og + 1u == (tg + 1u) * nx) xb_add(&bar[XB_TOPGEN], 1u);
            else XB_SPIN(xb_ld(&bar[XB_TOPGEN]) == tg, bar);
            __builtin_amdgcn_fence(__ATOMIC_ACQUIRE, "agent");
            xb_add(&bar[XB_XGEN(b.x)], 1u);
            asm volatile("s_waitcnt vmcnt(0)" ::: "memory");
        } else {
            XB_SPIN(xb_ld(&bar[XB_XGEN(b.x)]) == gen, bar);
            __builtin_amdgcn_fence(__ATOMIC_ACQUIRE, "agent");
            asm volatile("s_waitcnt vmcnt(0)" ::: "memory");
        }
    }
    __syncthreads();
}

template <int MODE> __device__ __forceinline__ void panel_finish(LAS unsigned char* lds, float* io, bf16_t* x1b, float2* stat, const float* g, const float* b, unsigned long long* XG, unsigned* CNT, int cu, int tid) {
    const int v = PairOrder::vcu_of(cu), q = v >> 2, j = v & 3, lane = tid & 63, wave = tid >> 6;
    LAS cplx* ST = (LAS cplx*)(lds + XCH_OFF); LAS cplx* MR = (LAS cplx*)lds;
    asm volatile("s_waitcnt lgkmcnt(0)" ::: "memory"); __syncthreads();
    const int ui = tid >> 8, rowl = tid & 255;
    float m1, m2;
    { const cplx a0 = ST[tid * 4 + 0], a1 = ST[tid * 4 + 1], a2 = ST[tid * 4 + 2], a3 = ST[tid * 4 + 3];
      m1 = (a0.x + a1.x) + (a2.x + a3.x); m2 = (a0.y + a1.y) + (a2.y + a3.y);
      __hip_atomic_store(XG + (size_t)((2 * q + ui) * 4 + j) * 256 + rowl, ((unsigned long long)__float_as_uint(m2) << 32) | __float_as_uint(m1), __ATOMIC_RELAXED, __HIP_MEMORY_SCOPE_AGENT); }
    asm volatile("s_waitcnt vmcnt(0)" ::: "memory");
    __syncthreads();
    if (tid == 0) {
        (void)__hip_atomic_fetch_add(CNT + (2 * q) * 16, 1u, __ATOMIC_RELAXED, __HIP_MEMORY_SCOPE_AGENT);
        (void)__hip_atomic_fetch_add(CNT + (2 * q + 1) * 16, 1u, __ATOMIC_RELAXED, __HIP_MEMORY_SCOPE_AGENT);
        unsigned sp = 0;
        while (__hip_atomic_load(CNT + (2 * q) * 16, __ATOMIC_RELAXED, __HIP_MEMORY_SCOPE_AGENT) < 4u || __hip_atomic_load(CNT + (2 * q + 1) * 16, __ATOMIC_RELAXED, __HIP_MEMORY_SCOPE_AGENT) < 4u) {
            __builtin_amdgcn_s_sleep(1); if (++sp > (1u << 22)) break; }
        __builtin_amdgcn_fence(__ATOMIC_ACQUIRE, "agent");
        asm volatile("s_waitcnt vmcnt(0)" ::: "memory");
    }
    __syncthreads();
    { float t1 = m1, t2 = m2;
#pragma unroll
      for (int jj = 1; jj < 4; ++jj) { const unsigned long long w = __hip_atomic_load(XG + (size_t)((2 * q + ui) * 4 + ((j + jj) & 3)) * 256 + rowl, __ATOMIC_RELAXED, __HIP_MEMORY_SCOPE_AGENT);
          t1 += __uint_as_float((unsigned)w); t2 += __uint_as_float((unsigned)(w >> 32)); }
      const float mean = t1 * (1.0f / DM), var = fmaxf(t2 * (1.0f / DM) - mean * mean, 0.f), rstd = rsqrtf(var + LN_EPS);
      cplx mr; mr.x = mean; mr.y = rstd; MR[tid] = mr;
      if (MODE == 1 && j == 0) { float2 sv; sv.x = mean; sv.y = rstd; stat[(2 * q + ui) * 256 + rowl] = sv; } }
    __syncthreads();
    const int cbase = j * 256 + lane * 4;
    const f32x4 g0 = *(const f32x4*)(g + cbase), b0 = *(const f32x4*)(b + cbase);
#pragma unroll 1
    for (int it = 0; it < 8; ++it) {
        const int u2 = it >> 2, rb = (it & 3) * 8; const size_t rbase = (size_t)((2 * q + u2) * 256 + wave * 32 + rb);
        f32x4 x0[8];
#pragma unroll
        for (int i = 0; i < 8; ++i) x0[i] = *(const f32x4*)(io + (rbase + i) * DM + cbase);
        asm volatile("" ::: "memory");
#pragma unroll
        for (int i = 0; i < 8; ++i) { const cplx mr = MR[u2 * 256 + wave * 32 + rb + i];
            const f32x4 y0 = (x0[i] - mr.x) * mr.y * g0 + b0;
            if (MODE == 1) { u32x2 w0; w0.x = pk2(y0[0], y0[1]); w0.y = pk2(y0[2], y0[3]); *(u32x2*)(x1b + (rbase + i) * DM + cbase) = w0; }
            else *(f32x4*)(io + (rbase + i) * DM + cbase) = y0; }
    }
}

#ifndef PH_MASK
#define PH_MASK 0xFFFFFF
#endif
#define PH(k) ((PH_MASK >> (k)) & 1)
#ifndef G5ORDER
#define G5ORDER KbOrder
#endif
#ifndef REP_P0
#define REP_P0 1
#endif
#ifndef REP_G1
#define REP_G1 1
#endif
#ifndef REP_DIFF
#define REP_DIFF 1
#endif
#ifndef REP_HY
#define REP_HY 1
#endif
#ifndef REP_MEM
#define REP_MEM 1
#endif
#ifndef REP_G3
#define REP_G3 1
#endif
#ifndef REP_G4
#define REP_G4 1
#endif
#ifndef REP_LN1
#define REP_LN1 1
#endif
struct Args { const float* in[24]; float* out; unsigned char* ws; };
__global__ void __launch_bounds__(NTHR, 2) hybrid_fwd(Args a) {
    extern __shared__ __attribute__((aligned(16))) unsigned char smem[];
    LAS unsigned char* lds = (LAS unsigned char*)smem;
    cg::grid_group grid = cg::this_grid();
    volatile LAS unsigned* bst = (volatile LAS unsigned*)(lds + 131072 + 64);
    if (threadIdx.x < 2) bst[threadIdx.x] = 0u;
    __syncthreads();
    const XcdBarrier bar = xcd_barrier_post((unsigned*)(a.ws + WS_BAR), bst);
    const int G = gridDim.x;
#define NEWPHASE() int tid_ = threadIdx.x, cu_ = blockIdx.x; asm volatile("" : "+v"(tid_)); asm volatile("" : "+s"(cu_)); const int tid = tid_, cu = cu_; (void)tid; (void)cu;
    unsigned char* ws = a.ws;
    bf16_t* WALL = (bf16_t*)(ws + WS_WALL); bf16_t* XB = (bf16_t*)(ws + WS_XB); bf16_t* MEMB = (bf16_t*)(ws + WS_MEMB); bf16_t* WKV = (bf16_t*)(ws + WS_WKV);
    bf16_t* QKM = (bf16_t*)(ws + WS_QKM); bf16_t* HT = (bf16_t*)(ws + WS_HT); bf16_t* KMEM = (bf16_t*)(ws + WS_KMEM); bf16_t* VMT = (bf16_t*)(ws + WS_VMT);
    float2* KF = (float2*)(ws + WS_KF); bf16_t* MIX = (bf16_t*)(ws + WS_MIX); float2* STAT = (float2*)(ws + WS_STAT);
    bf16_t* X1B = (bf16_t*)(ws + WS_X1B); bf16_t* HH = (bf16_t*)(ws + WS_HH); bf16_t* ACT = (bf16_t*)(ws + WS_ACT);

    for (int rep = 0; rep < REP_P0; ++rep) { NEWPHASE(); if (PH(0)) p0_prep(a.in, ws, lds, tid); }
    if (a.ws == nullptr) grid.sync();
    xcd_barrier(bar);

    for (int rep = 0; rep < REP_G1; ++rep) {
    if (PH(1)) { NEWPHASE(); pg8::Gemm g{XB, WALL, NT, 1536, DM}; pg8::StaticOrder S; S.init(g.M, g.N, G, cu);
      EpiRope E{QKM, (const float2*)(ws + WS_ROPE)};
      pg8::gemm_phase<EpiRope, pg8::StaticOrder, true, true>(lds, g, S, E); }
    if (PH(2)) { NEWPHASE(); pg8::Gemm g{WALL + (size_t)1536 * DM, XB, 2048, NT, DM}; pg8::StaticOrder S; S.init(g.M, g.N, G, cu);
      EpiB E{HT, NT};
      pg8::gemm_phase<EpiB, pg8::StaticOrder, true, true>(lds, g, S, E); }
    }
    if (PH(3)) { NEWPHASE(); const bool isK = cu < 32, on = cu < 64; const int c2 = cu - 32;
      pg8::Gemm g; EpiB E; OneUnit S;
      if (isK) { g = pg8::Gemm{MEMB, WKV, NMT, 512, DM}; E = EpiB{KMEM, 512}; S = OneUnit{cu >> 1, cu & 1, on}; }
      else { g = pg8::Gemm{WKV + (size_t)512 * DM, MEMB, 512, NMT, DM}; E = EpiB{VMT, NMT}; S = OneUnit{(c2 >> 4) & 1, c2 & 15, on}; }
      pg8::gemm_phase<EpiB, OneUnit, false, true>(lds, g, S, E);
      __syncthreads();
      if (!on) for (int it = cu - 64; it < 1024; it += G - 64) filter_fft_item((const float*)(ws + WS_HTD), KF, lds, it, tid); }
    xcd_barrier(bar);

    { NEWPHASE(); const int xcd = cu & 7, j = cu >> 3;
      float lam;
      { const float* lp = a.in[12]; const int l6 = tid & 63; float s01 = lp[l6] * lp[64 + l6], s23 = lp[128 + l6] * lp[192 + l6];
#pragma unroll
        for (int o = 1; o < 64; o <<= 1) { s01 += __shfl_xor(s01, o); s23 += __shfl_xor(s23, o); }
        lam = expf(s01) - expf(s23) + 0.2f; }
      if (PH(4)) for (int i = 0; i < 4 * REP_DIFF; ++i) {
          const int bh = ((i & 3) * 8 + xcd) * 2 + (j >> 4), qblk = j & 15, b = bh >> 2, hd = bh & 3;
          const size_t tok0 = (size_t)b * SEQ;
          attn_unit<2>(lds, QKM + (tok0 + qblk * 128) * MIXW + hd * 128, MIXW, QKM + tok0 * MIXW + 512 + hd * 128, MIXW,
                       HT + (size_t)(1536 + hd * 128) * NT + tok0, NT, SEQ, 0.125f * 1.4426950408889634f,
                       MIX + (tok0 + qblk * 128) * MIXW + 512 + hd * 128, MIXW, lam, a.in[13], tid); }
      if (PH(5)) for (int i = 0; i < 2 * REP_MEM; ++i) {
          const int bh = ((i & 1) * 8 + xcd) * 4 + (j >> 3), qblk = j & 7, b = bh >> 2, hd = bh & 3;
          const size_t tok0 = (size_t)b * SEQ;
          attn_unit<1>(lds, QKM + (tok0 + qblk * 256) * MIXW + 1024 + hd * 128, MIXW, KMEM + (size_t)b * MEMT * 512 + hd * 128, 512,
                       VMT + (size_t)(hd * 128) * NMT + b * MEMT, NMT, MEMT, 0.08838834764831845f * 1.4426950408889634f,
                       MIX + (tok0 + qblk * 256) * MIXW + 1024 + hd * 128, MIXW, 0.f, nullptr, tid); }
      if (PH(6)) for (int i = 0; i < 2 * REP_HY; ++i) {
          const int cgp = ((i & 1) * 8 + xcd) * 4 + (j >> 3), bp = j & 7;
          hyena_item(HT, KF, a.in[3], a.in[4], a.in[11], MIX, lds, bp, cgp, tid); } }
    xcd_barrier(bar);

#ifdef REP_SYNC
    for (int rep = 0; rep < REP_SYNC; ++rep) xcd_barrier(bar);
#endif
    const bool pair = (G == 256);
    if (PH(7)) { NEWPHASE(); pg8::Gemm g{MIX, (const bf16_t*)(ws + WS_WOUT), NT, DM, MIXW}; PairOrder S; S.init(g.M, g.N, G, cu); S.pair = pair;
      EpiRes E{a.in[0], a.out, lds, 0};
      pg8::gemm_phase<EpiRes, PairOrder, true, true>(lds, g, S, E);
      if (pair) panel_finish<1>(lds, a.out, X1B, STAT, a.in[16], a.in[17], (unsigned long long*)(ws + WS_XG), (unsigned*)(ws + WS_CNT), cu, tid); }
    xcd_barrier(bar);
    if (!pair) { { NEWPHASE(); ln_rows<true>(a.out, X1B, STAT, a.in[16], a.in[17], tid); } xcd_barrier(bar); }
    for (int rep = 0; rep < REP_G4; ++rep) if (PH(9)) { NEWPHASE(); pg8::Gemm g{X1B, (const bf16_t*)(ws + WS_WUP), FFN_MT * 256, 2 * DFF, DM}; FfnOrder S; S.init(g.M, g.N, G, cu); S.cw = a.in[19]; S.cb = a.in[20]; S.lds = lds; S.cnt = 0;
      EpiFfn E{ACT, lds, 0};
      pg8::gemm_phase<EpiFfn, FfnOrder, true, true>(lds, g, S, E); }
    xcd_barrier(bar);
    if (PH(11)) { NEWPHASE(); pg8::Gemm g{ACT, (const bf16_t*)(ws + WS_WDN), NT, DM, DFF}; PairKb S; S.init(g.M, g.N, G, cu); S.pair = pair;
      EpiRes2 E{a.out, a.out, STAT, a.in[16], a.in[17], lds, 0};
      pg8::gemm_phase<EpiRes2, PairKb, true, true>(lds, g, S, E);
      if (pair) panel_finish<2>(lds, a.out, nullptr, nullptr, a.in[22], a.in[23], (unsigned long long*)(ws + WS_XG) + 128 * 4 * 256, (unsigned*)(ws + WS_CNT) + 128 * 16, cu, tid); }
    if (!pair) { xcd_barrier(bar); { NEWPHASE(); ln_rows<false>(a.out, nullptr, nullptr, a.in[22], a.in[23], tid); } }
}

extern "C" void kernel_launch(void* const* d_in, const int* in_sizes, int n_in, void* d_out, int out_size, void* d_ws, size_t ws_size, hipStream_t stream) {
    static int grid = 0;
    if (grid == 0) {
        if (n_in != 24 || out_size != NT * DM || ws_size < WS_END) { fprintf(stderr, "kernel_launch: unexpected shapes (n_in %d, out %d, ws %zu)\n", n_in, out_size, ws_size); grid = -1; return; }
        int dev = 0, cus = 0, per_cu = 0;
        hipGetDevice(&dev); hipDeviceGetAttribute(&cus, hipDeviceAttributeMultiprocessorCount, dev);
        if (hipFuncSetAttribute((const void*)hybrid_fwd, hipFuncAttributeMaxDynamicSharedMemorySize, LDS_BYTES) != hipSuccess) { fprintf(stderr, "kernel_launch: hipFuncSetAttribute failed\n"); grid = -1; return; }
        if (hipOccupancyMaxActiveBlocksPerMultiprocessor(&per_cu, (const void*)hybrid_fwd, NTHR, LDS_BYTES) != hipSuccess || per_cu < 1) { fprintf(stderr, "kernel_launch: occupancy query says %d\n", per_cu); per_cu = 1; }
        (void)hipGetLastError();
        grid = cus * per_cu;
        fprintf(stderr, "kernel_launch: grid %d (cus %d x %d)\n", grid, cus, per_cu);
    }
    if (grid < 0) return;
    if (hipMemsetAsync((char*)d_ws + WS_BAR, 0, 32768, stream) != hipSuccess) { fprintf(stderr, "kernel_launch: memset failed\n"); return; }
    Args a{};
    for (int i = 0; i < 24; ++i) a.in[i] = (const float*)d_in[i];
    a.out = (float*)d_out; a.ws = (unsigned char*)d_ws;
    void* args[] = {&a};
    const hipError_t e = hipLaunchCooperativeKernel((const void*)hybrid_fwd, dim3(grid), dim3(NTHR), args, LDS_BYTES, stream);
    if (e != hipSuccess) fprintf(stderr, "kernel_launch: cooperative launch failed: %s (grid %d)\n", hipGetErrorString(e), grid);
}
```

```cpp
#include <hip/hip_runtime.h>
#include <hip/hip_cooperative_groups.h>
#include <cstdio>
#include <cstdint>
namespace cg = cooperative_groups;
#define LAS __attribute__((address_space(3)))
namespace pg8 {
#define PG8_LAS __attribute__((address_space(3)))
typedef unsigned short bf16_t;
typedef short bf16x8 __attribute__((ext_vector_type(8)));
typedef float f32x4 __attribute__((ext_vector_type(4)));
typedef unsigned u32x4 __attribute__((ext_vector_type(4)));
constexpr int BM = 256, BK = 64, HALF = 128, HTB = HALF * BK * 2  , STAGE_BYTES = 8 * HTB, NXCD = 8, WGM = 8;

__host__ __device__ __forceinline__ int lds_byte(int r, int c) { const int st = (r >> 4) * 2 + (c >> 5), rr = r & 15, cc = c & 31, ob = rr * 64 + cc * 2; return st * 1024 + (ob ^ (((ob >> 9) & 1) << 5)); }
__host__ __device__ __forceinline__ void stage_rc(int b, int& R, int& C) { const int st = b / 1024, sb = b % 1024, swz = sb ^ (((sb >> 9) & 1) << 5); R = (st >> 1) * 16 + swz / 64; C = (st & 1) * 32 + (swz % 64) / 2; }
__host__ __device__ __forceinline__ int perm32(int rho) { const int n = rho >> 4, i = rho & 15; return 8 * (i >> 2) + 4 * n + (i & 3); }

struct Unit { int pm, pn; };
struct Gemm { const bf16_t* A; const bf16_t* Bt; int M, N, K; };

struct StaticOrder {
    int nM, nN, nwg, G, c;
    __host__ __device__ void init(int M, int N, int G_, int c_) { nM = M / BM; nN = N / BM; nwg = nM * nN; G = G_; c = c_; }
    __host__ __device__ bool next(int i, Unit& u) const {
        const long L = (long)i * G + c; if (L >= nwg) return false;
        int wgid = (int)L; { const int q = nwg / NXCD, r = nwg % NXCD, xcd = wgid % NXCD, off = wgid / NXCD; wgid = (xcd < r ? xcd * (q + 1) : r * (q + 1) + (xcd - r) * q) + off; }
        const int nig = WGM * nN, gid = wgid / nig, fm = gid * WGM, gsz = (nM - fm) < WGM ? (nM - fm) : WGM;
        u.pm = fm + ((wgid % nig) % gsz); u.pn = (wgid % nig) / gsz; return true;
    }
    __device__ __forceinline__ void a_ready(const Unit&) const {}
    __device__ __forceinline__ void done(const Unit&) const {}
    __device__ __forceinline__ long a_off(const Unit& u, size_t tstep) const { return (long)((size_t)u.pm * tstep); }
    __device__ __forceinline__ int lda(int K) const { return K; }
    __device__ __forceinline__ size_t kstep_a() const { return (size_t)(BK * 2); }
};
template <class Epi, class Sched, bool ALIGN_EPI = false, bool SP2 = false>
__device__ __forceinline__ void gemm_phase(PG8_LAS unsigned char* lds, const Gemm g, const Sched& S, const Epi& E) {
    int tid_l = threadIdx.x; asm volatile("" : "+v"(tid_l)); const int tid = tid_l, wid = __builtin_amdgcn_readfirstlane(tid >> 6), lane = tid & 63, wr = wid >> 2, wc = wid & 3, fr = lane & 15, fq = lane >> 4;
    const int K = g.K, nt = K / BK;
    unsigned voffA[2], voffB[2];
    const int lda = S.lda(K);
#pragma unroll
    for (int i = 0; i < 2; ++i) { int R, C; stage_rc(tid * 16 + i * 8192, R, C); const int Rb = Epi::PERM ? ((R & ~31) + perm32(R & 31)) : R;
        voffA[i] = (unsigned)(R * lda + C) * 2u; voffB[i] = (unsigned)(Rb * K + C) * 2u; }
    const size_t kstep = (size_t)(BK * 2);
    const size_t hstep = (size_t)HALF * K * 2;
    const size_t tstep = 2 * hstep;
    const size_t kstepA = S.kstep_a(), hstepA = (size_t)HALF * lda * 2, tstepA = 2 * hstepA;
    const unsigned ldsw = (unsigned)wid * 1024u;
    const int aoff = lds_byte(wr * 64 + fr, fq * 8), boff = lds_byte(wc * 32 + fr, fq * 8);
#define PG8_SA(b, h) (((b) * 2 + (h)) * HTB)
#define PG8_SB(b, h) ((4 + (b) * 2 + (h)) * HTB)
#define PG8_STAGE(bufoff, gbase, voff) do { _Pragma("unroll") for (int _i = 0; _i < 2; ++_i) \
        __builtin_amdgcn_global_load_lds((const unsigned*)((const char*)(gbase) + (voff)[_i]), (PG8_LAS unsigned*)(lds + (bufoff) + ldsw + _i * 8192), 16, 0, 0); } while (0)
#define PG8_LDA(dst, b, h) do { _Pragma("unroll") for (int m = 0; m < 4; ++m) _Pragma("unroll") for (int k = 0; k < 2; ++k) dst[m][k] = *(const PG8_LAS bf16x8*)(lds + PG8_SA(b, h) + aoff + m * 2048 + k * 1024); } while (0)
#define PG8_LDB(dst, b, h) do { _Pragma("unroll") for (int n = 0; n < 2; ++n) _Pragma("unroll") for (int k = 0; k < 2; ++k) dst[n][k] = *(const PG8_LAS bf16x8*)(lds + PG8_SB(b, h) + boff + n * 2048 + k * 1024); } while (0)
#define PG8_MMA(ai, bj, At, Bt) do { __builtin_amdgcn_s_setprio(1); _Pragma("unroll") for (int m = 0; m < 4; ++m) _Pragma("unroll") for (int n = 0; n < 2; ++n) _Pragma("unroll") for (int k = 0; k < 2; ++k) \
        acc[ai][bj][m][n] = __builtin_amdgcn_mfma_f32_16x16x32_bf16(Bt[n][k], At[m][k], acc[ai][bj][m][n], 0, 0, 0); __builtin_amdgcn_s_setprio(0); } while (0)
#define PG8_WAIT_V(n) asm volatile("s_waitcnt vmcnt(" #n ")" ::: "memory")
#define PG8_WAIT_L(n) asm volatile("s_waitcnt lgkmcnt(" #n ")" ::: "memory")
#define PG8_BAR __builtin_amdgcn_s_barrier()
#define PG8_SCHED __builtin_amdgcn_sched_barrier(0)
    Unit cur, nxt; int ui = 0;
    if (!S.next(0, cur)) return;
    f32x4 acc[2][2][4][2];
#pragma unroll
    for (int a = 0; a < 2; ++a)
#pragma unroll
        for (int b = 0; b < 2; ++b)
#pragma unroll
            for (int m = 0; m < 4; ++m)
#pragma unroll
                for (int n = 0; n < 2; ++n) acc[a][b][m][n] = (f32x4){0.f, 0.f, 0.f, 0.f};
    bf16x8 At[4][2], B0[2][2], B1[2][2];
    const char* cA = (const char*)g.A + S.a_off(cur, tstepA); const char* cB = (const char*)g.Bt + (size_t)cur.pn * tstep;
    S.a_ready(cur);
    if constexpr (SP2) {
        PG8_STAGE(PG8_SB(0, 0), cB, voffB); PG8_STAGE(PG8_SB(0, 1), cB + hstep, voffB); PG8_STAGE(PG8_SA(0, 0), cA, voffA); PG8_STAGE(PG8_SA(0, 1), cA + hstepA, voffA);
        if (wr == 1) PG8_BAR;
        PG8_WAIT_V(2); PG8_BAR;
        PG8_STAGE(PG8_SB(1, 0), cB + kstep, voffB); PG8_STAGE(PG8_SA(1, 0), cA + kstepA, voffA); PG8_STAGE(PG8_SB(1, 1), cB + hstep + kstep, voffB);
        PG8_WAIT_V(6); PG8_BAR;
    } else {
        PG8_STAGE(PG8_SB(0, 0), cB, voffB); PG8_STAGE(PG8_SA(0, 0), cA, voffA); PG8_STAGE(PG8_SB(0, 1), cB + hstep, voffB); PG8_STAGE(PG8_SA(0, 1), cA + hstepA, voffA);
        if (wr == 1) PG8_BAR;
        PG8_WAIT_V(4); PG8_BAR;
        PG8_STAGE(PG8_SB(1, 0), cB + kstep, voffB); PG8_STAGE(PG8_SA(1, 0), cA + kstepA, voffA); PG8_STAGE(PG8_SB(1, 1), cB + hstep + kstep, voffB);
        PG8_WAIT_V(6); PG8_BAR;
    }
    for (;;) {
        const bool has_next = S.next(ui + 1, nxt);
        const char* nA = has_next ? (const char*)g.A + S.a_off(nxt, tstepA) : cA; const char* nB = has_next ? (const char*)g.Bt + (size_t)nxt.pn * tstep : cB;
        for (int t = 0; t < nt; t += 2) {
            const bool last = (t == nt - 2);
            const char* a1 = cA + (size_t)(t + 1) * kstepA;
            const char* a2 = last ? nA : cA + (size_t)(t + 2) * kstepA; const char* b2 = last ? nB : cB + (size_t)(t + 2) * kstep;
            const char* a3 = a2 + kstepA; const char* b3 = b2 + kstep;
            if (last && has_next) S.a_ready(nxt);
            if constexpr (SP2) {
            PG8_LDB(B0, 0, 0); PG8_LDB(B1, 0, 1); PG8_SCHED; PG8_LDA(At, 0, 0); PG8_STAGE(PG8_SA(1, 1), a1 + hstepA, voffA);
            PG8_WAIT_V(8); PG8_WAIT_L(0); PG8_BAR; PG8_MMA(0, 0, At, B0); PG8_MMA(0, 1, At, B1); PG8_BAR; PG8_SCHED;
            PG8_LDA(At, 0, 1); PG8_STAGE(PG8_SB(0, 0), b2, voffB); PG8_STAGE(PG8_SB(0, 1), b2 + hstep, voffB); PG8_STAGE(PG8_SA(0, 0), a2, voffA);
            PG8_WAIT_V(8); PG8_WAIT_L(0); PG8_BAR; PG8_MMA(1, 0, At, B0); PG8_MMA(1, 1, At, B1); PG8_BAR; PG8_SCHED;
            PG8_LDB(B0, 1, 0); PG8_LDB(B1, 1, 1); PG8_SCHED; PG8_LDA(At, 1, 0); PG8_STAGE(PG8_SA(0, 1), a2 + hstepA, voffA);
            PG8_WAIT_V(8); PG8_WAIT_L(0); PG8_BAR; PG8_MMA(0, 0, At, B0); PG8_MMA(0, 1, At, B1); PG8_BAR; PG8_SCHED;
            PG8_LDA(At, 1, 1); PG8_STAGE(PG8_SB(1, 0), b3, voffB); PG8_STAGE(PG8_SB(1, 1), b3 + hstep, voffB); PG8_STAGE(PG8_SA(1, 0), a3, voffA);
            PG8_WAIT_V(8); PG8_WAIT_L(0); PG8_BAR; PG8_MMA(1, 0, At, B0); PG8_MMA(1, 1, At, B1); PG8_BAR; PG8_SCHED;
            } else {
            PG8_LDB(B0, 0, 0); PG8_SCHED; PG8_LDA(At, 0, 0); PG8_STAGE(PG8_SA(1, 1), a1 + hstepA, voffA);
            PG8_WAIT_L(8); PG8_BAR; PG8_WAIT_L(0); PG8_MMA(0, 0, At, B0); PG8_BAR; PG8_SCHED;
            PG8_LDB(B1, 0, 1); PG8_STAGE(PG8_SB(0, 0), b2, voffB);
            PG8_BAR; PG8_WAIT_L(0); PG8_MMA(0, 1, At, B1); PG8_BAR;
            PG8_LDA(At, 0, 1); PG8_STAGE(PG8_SA(0, 0), a2, voffA);
            PG8_BAR; PG8_WAIT_L(0); PG8_MMA(1, 0, At, B0); PG8_BAR; PG8_SCHED;
            PG8_STAGE(PG8_SB(0, 1), b2 + hstep, voffB);
            PG8_WAIT_V(6); PG8_BAR; PG8_MMA(1, 1, At, B1); PG8_BAR;
            PG8_LDB(B0, 1, 0); PG8_SCHED; PG8_LDA(At, 1, 0); PG8_STAGE(PG8_SA(0, 1), a2 + hstepA, voffA);
            PG8_WAIT_L(8); PG8_BAR; PG8_WAIT_L(0); PG8_MMA(0, 0, At, B0); PG8_BAR; PG8_SCHED;
            PG8_LDB(B1, 1, 1); PG8_STAGE(PG8_SB(1, 0), b3, voffB);
            PG8_BAR; PG8_WAIT_L(0); PG8_MMA(0, 1, At, B1); PG8_BAR;
            PG8_LDA(At, 1, 1); PG8_STAGE(PG8_SA(1, 0), a3, voffA);
            PG8_BAR; PG8_WAIT_L(0); PG8_MMA(1, 0, At, B0); PG8_BAR; PG8_SCHED;
            PG8_STAGE(PG8_SB(1, 1), b3 + hstep, voffB);
            PG8_WAIT_V(6); PG8_BAR; PG8_MMA(1, 1, At, B1); PG8_BAR;
            }
        }
        if constexpr (ALIGN_EPI) { if (wr == 0) PG8_BAR; }
        if constexpr (!Epi::AFTER_DRAIN) { E(acc, cur, wr, wc, fr, fq); S.done(cur); }
        if (!has_next) break;
#pragma unroll
        for (int a = 0; a < 2; ++a)
#pragma unroll
            for (int b = 0; b < 2; ++b)
#pragma unroll
                for (int m = 0; m < 4; ++m)
#pragma unroll
                    for (int n = 0; n < 2; ++n) acc[a][b][m][n] = (f32x4){0.f, 0.f, 0.f, 0.f};
        cur = nxt; cA = nA; cB = nB; ++ui;
        if constexpr (ALIGN_EPI) { if (wr == 1) PG8_BAR; }
    }
    PG8_WAIT_V(0);
    if constexpr (!ALIGN_EPI) { if (wr == 0) PG8_BAR; }
    PG8_BAR;
    if constexpr (Epi::AFTER_DRAIN) { E.fused(acc, cur, wr, wc, fr, fq, lds, wid, lane); S.done(cur); }
#undef PG8_SA
#undef PG8_SB
#undef PG8_STAGE
#undef PG8_LDA
#undef PG8_LDB
#undef PG8_MMA
#undef PG8_WAIT_V
#undef PG8_WAIT_L
#undef PG8_BAR
#undef PG8_SCHED
}
}

using pg8::bf16_t; using pg8::bf16x8; using pg8::f32x4; using pg8::u32x4;
typedef float f32x16 __attribute__((ext_vector_type(16)));
typedef unsigned u32x2 __attribute__((ext_vector_type(2)));
typedef short bf16x4 __attribute__((ext_vector_type(4)));

constexpr int NB = 16, SEQ = 2048, DM = 1024, NT = NB * SEQ, MEMT = 256, NMT = NB * MEMT, HW = 512, INW = 3584, DFF = 2816, MIXW = 1536;
constexpr float ALPHA = 1.189207115002721f;
constexpr float LN_EPS = 1e-5f, RMS_EPS = 1e-5f;
constexpr int NTHR = 512, NWAVE = 8;
constexpr int LDS_BYTES = 151552;

constexpr size_t MiB = 1048576;
constexpr size_t WS_WALL = 0;
constexpr size_t WS_WKV  = 7 * MiB;
constexpr size_t WS_WOUT = 9 * MiB;
constexpr size_t WS_WUP  = 12 * MiB;
constexpr size_t WS_WDN  = 23 * MiB;
constexpr size_t WS_ROPE = 29 * MiB;
constexpr size_t WS_STAT = 29 * MiB + 524288;
constexpr size_t WS_XB   = 30 * MiB;
constexpr size_t WS_X1B  = 30 * MiB;
constexpr size_t WS_HTD  = 94 * MiB;
constexpr size_t WS_MEMB = 110 * MiB;
constexpr size_t WS_QKM  = 118 * MiB;
constexpr size_t WS_HT   = 214 * MiB;
constexpr size_t WS_KMEM = 342 * MiB;
constexpr size_t WS_VMT  = 346 * MiB;
constexpr size_t WS_KF   = 350 * MiB;
constexpr size_t WS_MIX  = 382 * MiB;
constexpr size_t WS_HH   = 96 * MiB;
constexpr size_t WS_ACT  = 272 * MiB;
constexpr size_t WS_BAR  = 478 * MiB;
constexpr size_t WS_CNT  = 478 * MiB + 16384;
constexpr size_t WS_XG   = 478 * MiB + 65536;
constexpr size_t WS_END  = 478 * MiB + 65536 + 2 * MiB;

__device__ __forceinline__ unsigned pk2(float lo, float hi) { unsigned r; asm volatile("v_cvt_pk_bf16_f32 %0, %1, %2" : "=v"(r) : "v"(lo), "v"(hi)); return r; }
__device__ __forceinline__ float bf2f(bf16_t v) { return __uint_as_float((unsigned)v << 16); }
__device__ __forceinline__ float lo2f(unsigned v) { return __uint_as_float(v << 16); }
__device__ __forceinline__ float hi2f(unsigned v) { return __uint_as_float(v & 0xffff0000u); }
#define LDS_WAIT() asm volatile("s_waitcnt lgkmcnt(0)" ::: "memory")

#ifndef FFT_HOST
#define FFT_FN __device__ __forceinline__
#define FFT_SYNC() __syncthreads()
typedef float cplx __attribute__((ext_vector_type(2)));
typedef LAS cplx* fftbuf_t;
FFT_FN float cos2pi(float r) { return __builtin_amdgcn_cosf(r); }
FFT_FN float sin2pi(float r) { return __builtin_amdgcn_sinf(r); }
#endif
FFT_FN cplx mk2(float x, float y) { cplx r; r.x = x; r.y = y; return r; }
FFT_FN cplx cadd(cplx a, cplx b) { return mk2(a.x + b.x, a.y + b.y); }
FFT_FN cplx csub(cplx a, cplx b) { return mk2(a.x - b.x, a.y - b.y); }
FFT_FN cplx cmul(cplx a, cplx b) { return mk2(a.x * b.x - a.y * b.y, a.x * b.y + a.y * b.x); }
template <bool INV> FFT_FN cplx muli(cplx a) { return INV ? mk2(-a.y, a.x) : mk2(a.y, -a.x); }
FFT_FN int padi(int i) { return i + (i >> 3); }

template <bool INV> FFT_FN void dft8(cplx (&v)[8]) {
    const float R = 0.70710678118654752f;
    const cplx a0 = cadd(v[0], v[4]), a1 = csub(v[0], v[4]), a2 = cadd(v[2], v[6]), a3 = muli<INV>(csub(v[2], v[6]));
    const cplx a4 = cadd(v[1], v[5]), a5 = csub(v[1], v[5]), a6 = cadd(v[3], v[7]), a7 = muli<INV>(csub(v[3], v[7]));
    const cplx b0 = cadd(a0, a2), b2 = csub(a0, a2), b1 = cadd(a1, a3), b3 = csub(a1, a3);
    const cplx b4 = cadd(a4, a6), b6 = muli<INV>(csub(a4, a6));
    const cplx t5 = cadd(a5, a7), t7 = csub(a5, a7);
    cplx b5, b7;
    if (!INV) { b5 = mk2((t5.x + t5.y) * R, (t5.y - t5.x) * R); b7 = mk2((t7.y - t7.x) * R, -(t7.x + t7.y) * R); }
    else      { b5 = mk2((t5.x - t5.y) * R, (t5.x + t5.y) * R); b7 = mk2(-(t7.x + t7.y) * R, (t7.x - t7.y) * R); }
    v[0] = cadd(b0, b4); v[4] = csub(b0, b4); v[1] = cadd(b1, b5); v[5] = csub(b1, b5);
    v[2] = cadd(b2, b6); v[6] = csub(b2, b6); v[3] = cadd(b3, b7); v[7] = csub(b3, b7);
}
template <int S, bool INV> FFT_FN void twid(cplx (&v)[8], int tid) {
    if (S > 1) {
        const int j = tid % S; const float rev = (float)j * (1.0f / (8.0f * S));
        const float c = cos2pi(rev), s = sin2pi(rev);
        const cplx w1 = mk2(c, INV ? s : -s);
        const cplx w2 = cmul(w1, w1), w3 = cmul(w2, w1), w4 = cmul(w2, w2), w5 = cmul(w4, w1), w6 = cmul(w4, w2), w7 = cmul(w4, w3);
        v[1] = cmul(v[1], w1); v[2] = cmul(v[2], w2); v[3] = cmul(v[3], w3); v[4] = cmul(v[4], w4);
        v[5] = cmul(v[5], w5); v[6] = cmul(v[6], w6); v[7] = cmul(v[7], w7);
    }
}
template <int S> FFT_FN void ld8(fftbuf_t X, int tid, cplx (&v)[8]) {
    const int base = (tid / S) * 8 * S + (tid % S);
#pragma unroll
    for (int k = 0; k < 8; ++k) v[k] = X[padi(base + S * k)];
}
template <int S> FFT_FN void st8(fftbuf_t X, int tid, const cplx (&v)[8]) {
    const int base = (tid / S) * 8 * S + (tid % S);
#pragma unroll
    for (int k = 0; k < 8; ++k) X[padi(base + S * k)] = v[k];
}
#ifndef FFT_HOST
template <int S> FFT_FN void twid_fill(fftbuf_t TW, int tid) {
    constexpr int P = (S == 512) ? 0 : (S == 64) ? 1 : 2;
    const int j = tid % S; const float rev = (float)j * (1.0f / (8.0f * S));
    const cplx w1 = mk2(cos2pi(rev), -sin2pi(rev)), w2 = cmul(w1, w1), w4 = cmul(w2, w2);
    TW[(3 * P + 0) * 512 + tid] = w1; TW[(3 * P + 1) * 512 + tid] = w2; TW[(3 * P + 2) * 512 + tid] = w4;
}
template <int S, bool INV> FFT_FN void twidL(cplx (&v)[8], fftbuf_t TW, int tid) {
    constexpr int P = (S == 512) ? 0 : (S == 64) ? 1 : 2;
    cplx w1 = TW[(3 * P + 0) * 512 + tid], w2 = TW[(3 * P + 1) * 512 + tid], w4 = TW[(3 * P + 2) * 512 + tid];
    if (INV) { w1.y = -w1.y; w2.y = -w2.y; w4.y = -w4.y; }
    const cplx w3 = cmul(w2, w1), w5 = cmul(w4, w1), w6 = cmul(w4, w2), w7 = cmul(w4, w3);
    v[1] = cmul(v[1], w1); v[2] = cmul(v[2], w2); v[3] = cmul(v[3], w3); v[4] = cmul(v[4], w4);
    v[5] = cmul(v[5], w5); v[6] = cmul(v[6], w6); v[7] = cmul(v[7], w7);
}
FFT_FN void fft_fwdL(fftbuf_t X, fftbuf_t TW, int tid, cplx (&v)[8]) {
    dft8<false>(v); twidL<512, false>(v, TW, tid); st8<512>(X, tid, v); FFT_SYNC();
    ld8<64>(X, tid, v); dft8<false>(v); twidL<64, false>(v, TW, tid); st8<64>(X, tid, v); FFT_SYNC();
    ld8<8>(X, tid, v); dft8<false>(v); twidL<8, false>(v, TW, tid); st8<8>(X, tid, v); FFT_SYNC();
    ld8<1>(X, tid, v); dft8<false>(v);
}
FFT_FN void fft_invL(fftbuf_t X, fftbuf_t TW, int tid, cplx (&v)[8]) {
    dft8<true>(v); st8<1>(X, tid, v); FFT_SYNC();
    ld8<8>(X, tid, v); twidL<8, true>(v, TW, tid); dft8<true>(v); st8<8>(X, tid, v); FFT_SYNC();
    ld8<64>(X, tid, v); twidL<64, true>(v, TW, tid); dft8<true>(v); st8<64>(X, tid, v); FFT_SYNC();
    ld8<512>(X, tid, v); twidL<512, true>(v, TW, tid); dft8<true>(v);
}
FFT_FN void fft_fwd(fftbuf_t X, int tid, cplx (&v)[8]) {
    dft8<false>(v); twid<512, false>(v, tid); st8<512>(X, tid, v); FFT_SYNC();
    ld8<64>(X, tid, v); dft8<false>(v); twid<64, false>(v, tid); st8<64>(X, tid, v); FFT_SYNC();
    ld8<8>(X, tid, v); dft8<false>(v); twid<8, false>(v, tid); st8<8>(X, tid, v); FFT_SYNC();
    ld8<1>(X, tid, v); dft8<false>(v);
}
FFT_FN void fft_inv(fftbuf_t X, int tid, cplx (&v)[8]) {
    dft8<true>(v); st8<1>(X, tid, v); FFT_SYNC();
    ld8<8>(X, tid, v); twid<8, true>(v, tid); dft8<true>(v); st8<8>(X, tid, v); FFT_SYNC();
    ld8<64>(X, tid, v); twid<64, true>(v, tid); dft8<true>(v); st8<64>(X, tid, v); FFT_SYNC();
    ld8<512>(X, tid, v); twid<512, true>(v, tid); dft8<true>(v);
}
#endif

struct OneUnit { int pm, pn; bool on;
    __device__ __forceinline__ bool next(int i, pg8::Unit& u) const { if (!on || i > 0) return false; u.pm = pm; u.pn = pn; return true; }
    __device__ __forceinline__ void a_ready(const pg8::Unit&) const {}
    __device__ __forceinline__ void done(const pg8::Unit&) const {}
    __device__ __forceinline__ long a_off(const pg8::Unit& u, size_t tstep) const { return (long)((size_t)u.pm * tstep); }
    __device__ __forceinline__ int lda(int K) const { return K; }
    __device__ __forceinline__ size_t kstep_a() const { return 128; } };

struct EpiB {
    static constexpr bool PERM = true, AFTER_DRAIN = false;
    bf16_t* O; int ldc;
    __device__ __forceinline__ void operator()(const f32x4 (&acc)[2][2][4][2], const pg8::Unit& u, int wr, int wc, int fr, int fq) const {
        const int row0 = u.pm * 256 + wr * 64 + fr, col0 = u.pn * 256 + wc * 32 + 8 * fq;
#pragma unroll
        for (int ai = 0; ai < 2; ++ai)
#pragma unroll
            for (int m = 0; m < 4; ++m) { bf16_t* rowp = O + (size_t)(row0 + ai * 128 + m * 16) * ldc + col0;
#pragma unroll
                for (int bj = 0; bj < 2; ++bj) { const f32x4 v0 = acc[ai][bj][m][0], v1 = acc[ai][bj][m][1];
                    u32x4 w; w.x = pk2(v0[0], v0[1]); w.y = pk2(v0[2], v0[3]); w.z = pk2(v1[0], v1[1]); w.w = pk2(v1[2], v1[3]);
                    *(u32x4*)(rowp + bj * 128) = w; } }
    }
};
struct EpiRope {
    static constexpr bool PERM = true, AFTER_DRAIN = false;
    bf16_t* O; const float2* rope;
    __device__ __forceinline__ void operator()(const f32x4 (&acc)[2][2][4][2], const pg8::Unit& u, int wr, int wc, int fr, int fq) const {
        const int row0 = u.pm * 256 + wr * 64 + fr, col0 = u.pn * 256 + wc * 32 + 8 * fq;
        const bool rot = u.pn < 4;
#pragma unroll
        for (int ai = 0; ai < 2; ++ai)
#pragma unroll
            for (int m = 0; m < 4; ++m) { const int row = row0 + ai * 128 + m * 16; bf16_t* rowp = O + (size_t)row * MIXW + col0;
#pragma unroll
                for (int bj = 0; bj < 2; ++bj) { f32x4 v0 = acc[ai][bj][m][0], v1 = acc[ai][bj][m][1];
                    if (rot) { const int pos = row & (SEQ - 1), i0 = ((col0 + bj * 128) & 63) >> 1;
                        const f32x4* rp = (const f32x4*)(rope + pos * 32 + i0); const f32x4 r0 = rp[0], r1 = rp[1];
                        f32x4 o0, o1;
                        o0[0] = v0[0] * r0[0] - v0[1] * r0[1]; o0[1] = v0[1] * r0[0] + v0[0] * r0[1];
                        o0[2] = v0[2] * r0[2] - v0[3] * r0[3]; o0[3] = v0[3] * r0[2] + v0[2] * r0[3];
                        o1[0] = v1[0] * r1[0] - v1[1] * r1[1]; o1[1] = v1[1] * r1[0] + v1[0] * r1[1];
                        o1[2] = v1[2] * r1[2] - v1[3] * r1[3]; o1[3] = v1[3] * r1[2] + v1[2] * r1[3];
                        v0 = o0; v1 = o1; }
                    u32x4 w; w.x = pk2(v0[0], v0[1]); w.y = pk2(v0[2], v0[3]); w.z = pk2(v1[0], v1[1]); w.w = pk2(v1[2], v1[3]);
                    *(u32x4*)(rowp + bj * 128) = w; } }
    }
};
constexpr int XCH_OFF = 131072 + 1024;
__device__ __forceinline__ void stat_put(LAS cplx* ST, int rowl, int wc, int fq, float s1, float s2, bool first) {
    s1 += __shfl_xor(s1, 16); s2 += __shfl_xor(s2, 16); s1 += __shfl_xor(s1, 32); s2 += __shfl_xor(s2, 32);
    if (fq == 0) { LAS cplx* p = ST + rowl * 4 + wc; cplx v; v.x = s1; v.y = s2; if (!first) { const cplx o = *p; v.x += o.x; v.y += o.y; } *p = v; }
}
struct EpiRes {
    static constexpr bool PERM = false, AFTER_DRAIN = false;
    const float* X; float* O; LAS unsigned char* lds; mutable int ecnt;
    __device__ __forceinline__ void operator()(const f32x4 (&acc)[2][2][4][2], const pg8::Unit& u, int wr, int wc, int fr, int fq) const {
        const int row0 = u.pm * 256 + wr * 64 + fr, col0 = u.pn * 256 + wc * 32 + 4 * fq;
        LAS cplx* ST = (LAS cplx*)(lds + XCH_OFF) + (ecnt & 1) * 1024; const bool first = true; ++ecnt;
#pragma unroll
        for (int ai = 0; ai < 2; ++ai) {
            f32x4 xv[4][2][2];
#pragma unroll
            for (int m = 0; m < 4; ++m)
#pragma unroll
                for (int bj = 0; bj < 2; ++bj)
#pragma unroll
                    for (int n = 0; n < 2; ++n) xv[m][bj][n] = *(const f32x4*)(X + (size_t)(row0 + ai * 128 + m * 16) * DM + col0 + bj * 128 + 16 * n);
            asm volatile("" ::: "memory");
#pragma unroll
            for (int m = 0; m < 4; ++m) { float s1 = 0.f, s2 = 0.f;
#pragma unroll
                for (int bj = 0; bj < 2; ++bj)
#pragma unroll
                    for (int n = 0; n < 2; ++n) { const f32x4 o = acc[ai][bj][m][n] + xv[m][bj][n] * ALPHA;
                        *(f32x4*)(O + (size_t)(row0 + ai * 128 + m * 16) * DM + col0 + bj * 128 + 16 * n) = o;
                        s1 += (o[0] + o[1]) + (o[2] + o[3]); s2 += (o[0] * o[0] + o[1] * o[1]) + (o[2] * o[2] + o[3] * o[3]); }
                stat_put(ST, ai * 128 + wr * 64 + m * 16 + fr, wc, fq, s1, s2, first); }
        }
    }
};
struct EpiRes2 {
    static constexpr bool PERM = false, AFTER_DRAIN = false;
    const float* R; float* O; const float2* stat; const float* g; const float* b; LAS unsigned char* lds; mutable int ecnt;
    __device__ __forceinline__ void operator()(const f32x4 (&acc)[2][2][4][2], const pg8::Unit& u, int wr, int wc, int fr, int fq) const {
        const int row0 = u.pm * 256 + wr * 64 + fr, col0 = u.pn * 256 + wc * 32 + 4 * fq;
        LAS cplx* ST = (LAS cplx*)(lds + XCH_OFF) + (ecnt & 1) * 1024; const bool first = true; ++ecnt;
#pragma unroll
        for (int ai = 0; ai < 2; ++ai)
#pragma unroll
            for (int bj = 0; bj < 2; ++bj) {
                f32x4 rv[4][2], gv[2], bv[2]; float2 st[4];
#pragma unroll
                for (int m = 0; m < 4; ++m) { const int row = row0 + ai * 128 + m * 16; st[m] = stat[row];
#pragma unroll
                    for (int n = 0; n < 2; ++n) rv[m][n] = *(const f32x4*)(R + (size_t)row * DM + col0 + bj * 128 + 16 * n); }
#pragma unroll
                for (int n = 0; n < 2; ++n) { gv[n] = *(const f32x4*)(g + col0 + bj * 128 + 16 * n); bv[n] = *(const f32x4*)(b + col0 + bj * 128 + 16 * n); }
                asm volatile("" ::: "memory");
#pragma unroll
                for (int m = 0; m < 4; ++m) { float s1 = 0.f, s2 = 0.f;
#pragma unroll
                    for (int n = 0; n < 2; ++n) { const f32x4 x1 = (rv[m][n] - st[m].x) * st[m].y * gv[n] + bv[n]; const f32x4 o = acc[ai][bj][m][n] + x1 * ALPHA;
                        *(f32x4*)(O + (size_t)(row0 + ai * 128 + m * 16) * DM + col0 + bj * 128 + 16 * n) = o;
                        s1 += (o[0] + o[1]) + (o[2] + o[3]); s2 += (o[0] * o[0] + o[1] * o[1]) + (o[2] * o[2] + o[3] * o[3]); }
                    stat_put(ST, ai * 128 + wr * 64 + m * 16 + fr, wc, fq, s1, s2, first && bj == 0); }
            }
    }
};
template <int MODE> struct EpiLn {
    static constexpr bool PERM = false, AFTER_DRAIN = true;
    const float* RES; float* OF; bf16_t* OB; const float* g; const float* b; unsigned long long* XG; unsigned* CNT;
    __device__ __forceinline__ void operator()(const f32x4 (&)[2][2][4][2], const pg8::Unit&, int, int, int, int) const {}
    __device__ __forceinline__ void fused(f32x4 (&acc)[2][2][4][2], const pg8::Unit& u, int wr, int wc, int fr, int fq, LAS unsigned char* lds, int wid, int lane) const {
        const int tid = wid * 64 + lane, row0 = u.pm * 256 + wr * 64 + fr, col0 = u.pn * 256 + wc * 32 + 4 * fq;
        LAS cplx* ST = (LAS cplx*)(lds + XCH_OFF); LAS cplx* MR = (LAS cplx*)(lds + XCH_OFF + 8192);
#pragma unroll
        for (int ai = 0; ai < 2; ++ai) {
            f32x4 xv[4][2][2];
#pragma unroll
            for (int m = 0; m < 4; ++m)
#pragma unroll
                for (int bj = 0; bj < 2; ++bj)
#pragma unroll
                    for (int n = 0; n < 2; ++n) xv[m][bj][n] = *(const f32x4*)(RES + (size_t)(row0 + ai * 128 + m * 16) * DM + col0 + bj * 128 + 16 * n);
#pragma unroll
            for (int m = 0; m < 4; ++m) { float s1 = 0.f, s2 = 0.f;
#pragma unroll
                for (int bj = 0; bj < 2; ++bj)
#pragma unroll
                    for (int n = 0; n < 2; ++n) { const f32x4 o = acc[ai][bj][m][n] + xv[m][bj][n] * ALPHA; acc[ai][bj][m][n] = o;
                        s1 += (o[0] + o[1]) + (o[2] + o[3]); s2 += (o[0] * o[0] + o[1] * o[1]) + (o[2] * o[2] + o[3] * o[3]); }
                stat_put(ST, ai * 128 + wr * 64 + m * 16 + fr, wc, fq, s1, s2, true); }
        }
        asm volatile("s_waitcnt lgkmcnt(0)" ::: "memory"); __syncthreads();
        float m1 = 0.f, m2 = 0.f;
        if (tid < 256) { const cplx a0 = ST[tid * 4 + 0], a1 = ST[tid * 4 + 1], a2 = ST[tid * 4 + 2], a3 = ST[tid * 4 + 3];
            m1 = (a0.x + a1.x) + (a2.x + a3.x); m2 = (a0.y + a1.y) + (a2.y + a3.y);
            __hip_atomic_store(XG + (size_t)(u.pm * 4 + u.pn) * 256 + tid, ((unsigned long long)__float_as_uint(m2) << 32) | __float_as_uint(m1), __ATOMIC_RELAXED, __HIP_MEMORY_SCOPE_AGENT); }
        asm volatile("s_waitcnt vmcnt(0)" ::: "memory");
        __syncthreads();
        if (tid == 0) {
            (void)__hip_atomic_fetch_add(CNT + u.pm * 16, 1u, __ATOMIC_RELAXED, __HIP_MEMORY_SCOPE_AGENT);
            unsigned sp = 0;
            while (__hip_atomic_load(CNT + u.pm * 16, __ATOMIC_RELAXED, __HIP_MEMORY_SCOPE_AGENT) < 4u) { __builtin_amdgcn_s_sleep(1); if (++sp > (1u << 22)) break; }
            __builtin_amdgcn_fence(__ATOMIC_ACQUIRE, "agent");
            asm volatile("s_waitcnt vmcnt(0)" ::: "memory");
        }
        __syncthreads();
        if (tid < 256) { float t1 = m1, t2 = m2;
#pragma unroll
            for (int jj = 1; jj < 4; ++jj) { const unsigned long long w = __hip_atomic_load(XG + (size_t)(u.pm * 4 + ((u.pn + jj) & 3)) * 256 + tid, __ATOMIC_RELAXED, __HIP_MEMORY_SCOPE_AGENT);
                t1 += __uint_as_float((unsigned)w); t2 += __uint_as_float((unsigned)(w >> 32)); }
            const float mean = t1 * (1.0f / DM), var = fmaxf(t2 * (1.0f / DM) - mean * mean, 0.f);
            cplx mr; mr.x = mean; mr.y = rsqrtf(var + LN_EPS); MR[tid] = mr; }
        __syncthreads();
#pragma unroll
        for (int bj = 0; bj < 2; ++bj)
#pragma unroll
            for (int n = 0; n < 2; ++n) { const int c = col0 + bj * 128 + 16 * n; const f32x4 gv = *(const f32x4*)(g + c), bv = *(const f32x4*)(b + c);
#pragma unroll
                for (int ai = 0; ai < 2; ++ai)
#pragma unroll
                    for (int m = 0; m < 4; ++m) { const int rl = ai * 128 + wr * 64 + m * 16 + fr; const cplx mr = MR[rl];
                        const f32x4 y = (acc[ai][bj][m][n] - mr.x) * mr.y * gv + bv; const size_t off = (size_t)(u.pm * 256 + rl) * DM + c;
                        *(f32x4*)(OF + off) = y;
                        if (MODE == 1) { u32x2 w; w.x = pk2(y[0], y[1]); w.y = pk2(y[2], y[3]); *(u32x2*)(OB + off) = w; } } }
    }
};
struct OneUnitKb : OneUnit {
    __device__ __forceinline__ int lda(int) const { return 64; }
    __device__ __forceinline__ size_t kstep_a() const { return (size_t)NT * 64 * 2; }
};
struct PairOrder : pg8::StaticOrder {
    bool pair;
    __device__ __forceinline__ static int vcu_of(int c) { return (c & 7) * 32 + (c >> 3); }
    __device__ __forceinline__ bool next(int i, pg8::Unit& u) const {
        if (!pair) return pg8::StaticOrder::next(i, u);
        if (i > 1) return false;
        const int v = vcu_of(c); u.pm = 2 * (v >> 2) + i; u.pn = v & 3; return true; }
};
struct KbOrder : pg8::StaticOrder {
    __device__ __forceinline__ int lda(int) const { return 64; }
    __device__ __forceinline__ size_t kstep_a() const { return (size_t)NT * 64 * 2; }
};
struct PairKb : PairOrder {
    __device__ __forceinline__ int lda(int) const { return 64; }
    __device__ __forceinline__ size_t kstep_a() const { return (size_t)NT * 64 * 2; }
};
struct RevOrder : pg8::StaticOrder {
    __device__ __forceinline__ bool next(int i, pg8::Unit& u) const { const int rounds = (nwg + G - 1) / G; if (i >= rounds) return false; return pg8::StaticOrder::next(rounds - 1 - i, u); }
};
constexpr int CWL_OFF = 131072 + 1024 + 8192;
struct FfnOrder : pg8::StaticOrder {
    const float* cw; const float* cb; LAS unsigned char* lds; mutable int cnt;
    __device__ __forceinline__ long a_off(const pg8::Unit& u, size_t) const { return ((long)u.pm * 254 - 1) * (long)(DM * 2); }
    __device__ __forceinline__ void a_ready(const pg8::Unit& u) const {
        const int tid = threadIdx.x, w = __builtin_amdgcn_readfirstlane(tid >> 6), lane = tid & 63, buf = cnt & 1; ++cnt;
        const float* src = (w < 3) ? cw + (size_t)w * (2 * DFF) : (w < 6) ? cw + (size_t)(w - 3) * (2 * DFF) + DFF : (w == 6) ? cb : cb + DFF;
        src += u.pn * 128 + lane * 4;
        if (lane < 32) __builtin_amdgcn_global_load_lds((const unsigned*)src, (LAS unsigned*)(lds + CWL_OFF + buf * 4096 + w * 512), 16, 0, 0);
    }
};
constexpr int FFN_MT = 130;
__device__ __forceinline__ float dpp_ror1(float v)  { return __int_as_float(__builtin_amdgcn_update_dpp(0, __float_as_int(v), 0x121, 0xF, 0xF, false)); }
__device__ __forceinline__ float dpp_ror15(float v) { return __int_as_float(__builtin_amdgcn_update_dpp(0, __float_as_int(v), 0x12F, 0xF, 0xF, false)); }
struct EpiFfn {
    static constexpr bool PERM = true, AFTER_DRAIN = false;
    bf16_t* ACT; LAS unsigned char* lds; mutable int ecnt;
    __device__ __forceinline__ void operator()(const f32x4 (&acc)[2][2][4][2], const pg8::Unit& u, int wr, int wc, int fr, int fq) const {
        LAS float* XC = (LAS float*)(lds + XCH_OFF);
        const LAS float* WL = (const LAS float*)(lds + CWL_OFF + (ecnt & 1) * 4096); ++ecnt;
        const int colw = wc * 32 + 8 * fq;
        if (fr == 0 || fr == 15) {
            const int edge = (fr == 15) ? 1 : 0, m = (fr == 15) ? 3 : 0;
#pragma unroll
            for (int ai = 0; ai < 2; ++ai)
#pragma unroll
                for (int bj = 0; bj < 2; ++bj)
#pragma unroll
                    for (int n = 0; n < 2; ++n) { const f32x4 v = (m == 0) ? acc[ai][bj][0][n] : acc[ai][bj][3][n];
                        *(LAS f32x4*)(XC + ((ai * 2 + wr) * 2 + edge) * 256 + bj * 128 + colw + 4 * n) = v; }
        }
        asm volatile("s_waitcnt lgkmcnt(0)" ::: "memory"); __builtin_amdgcn_s_barrier(); asm volatile("" ::: "memory");
        const int slot0 = wr * 64 + fr, row_base = u.pm * 254 - 1;
#pragma unroll
        for (int bj = 0; bj < 2; ++bj) {
            const int gc = (u.pn * 256 + bj * 128 + colw) >> 1;
            const LAS float* wl = WL + ((bj * 128 + colw) >> 1);
            f32x4 wg[3], wu[3];
#pragma unroll
            for (int j = 0; j < 3; ++j) { wg[j] = *(const LAS f32x4*)(wl + j * 128); wu[j] = *(const LAS f32x4*)(wl + (3 + j) * 128); }
            const f32x4 bg = *(const LAS f32x4*)(wl + 6 * 128), bu = *(const LAS f32x4*)(wl + 7 * 128);
#pragma unroll
            for (int ai = 0; ai < 2; ++ai) {
                const int gidx = ai * 2 + wr;
                f32x4 pe[2], ne[2];
#pragma unroll
                for (int n = 0; n < 2; ++n) {
                    pe[n] = (gidx > 0) ? *(const LAS f32x4*)(XC + (((gidx - 1) * 2) + 1) * 256 + bj * 128 + colw + 4 * n) : (f32x4){0.f, 0.f, 0.f, 0.f};
                    ne[n] = (gidx < 3) ? *(const LAS f32x4*)(XC + (((gidx + 1) * 2) + 0) * 256 + bj * 128 + colw + 4 * n) : (f32x4){0.f, 0.f, 0.f, 0.f}; }
#pragma unroll
                for (int m = 0; m < 4; ++m) {
                    const int slot = ai * 128 + slot0 + m * 16, row = row_base + slot, t = row & (SEQ - 1);
                    f32x4 hv[2];
#pragma unroll
                    for (int n = 0; n < 2; ++n) {
                        const f32x4 cur = acc[ai][bj][m][n], prv = acc[ai][bj][m == 0 ? 0 : m - 1][n], nxt = acc[ai][bj][m == 3 ? 3 : m + 1][n];
                        f32x4 up, dn;
#pragma unroll
                        for (int e = 0; e < 4; ++e) { up[e] = dpp_ror1(fr == 15 ? prv[e] : cur[e]); dn[e] = dpp_ror15(fr == 0 ? nxt[e] : cur[e]); }
                        if (m == 0 && fr == 0) up = pe[n];
                        if (m == 3 && fr == 15) dn = ne[n];
                        if (t == 0) up = (f32x4){0.f, 0.f, 0.f, 0.f};
                        if (t == SEQ - 1) dn = (f32x4){0.f, 0.f, 0.f, 0.f};
                        const f32x4 w0 = n ? wu[0] : wg[0], w1 = n ? wu[1] : wg[1], w2 = n ? wu[2] : wg[2], bb = n ? bu : bg;
                        hv[n] = w0 * up + w1 * cur + w2 * dn + bb; }
                    if (slot >= 1 && slot <= 254 && row < NT) {
                        float o[4];
#pragma unroll
                        for (int e = 0; e < 4; ++e) { const float g = hv[0][e]; o[e] = g * __builtin_amdgcn_rcpf(1.0f + __expf(-g)) * hv[1][e]; }
                        u32x2 w; w.x = pk2(o[0], o[1]); w.y = pk2(o[2], o[3]);
                        *(u32x2*)(ACT + ((size_t)(gc >> 6) * NT + row) * 64 + (gc & 63)) = w; }
                }
            }
        }
    }
};

__device__ __forceinline__ int win_row(int n) {
    if (n < 1536) return 1536 + n;
    if (n < 2560) { const int q = n - 1536, blk = q >> 6, d = q & 63; return blk * 64 + 2 * (d & 31) + (d >> 5); }
    if (n < 3072) return 512 + n;
    return n - 2048;
}
template <int MODE> __device__ __forceinline__ void p0_transpose_item(const float* W, int K, int N, bf16_t* WT, LAS float* scr, int item, int lane) {
    const int nblk = N / 32, kb = item / nblk, nb = item % nblk, k0 = 64 * kb, n0 = 32 * nb;
    f32x4 q[8];
#pragma unroll
    for (int i = 0; i < 8; ++i) q[i] = *(const f32x4*)(W + (size_t)(k0 + 8 * i + (lane >> 3)) * N + n0 + 4 * (lane & 7));
#pragma unroll
    for (int i = 0; i < 8; ++i) { LAS float* d = scr + (8 * i + (lane >> 3)) * 33 + 4 * (lane & 7); d[0] = q[i][0]; d[1] = q[i][1]; d[2] = q[i][2]; d[3] = q[i][3]; }
    LDS_WAIT(); asm volatile("" ::: "memory");
    const int c = lane & 7;
#pragma unroll
    for (int j = 0; j < 4; ++j) { const int n = (lane >> 3) + 8 * j; const LAS float* s = scr + (8 * c) * 33 + n;
        u32x4 o; o.x = pk2(s[0 * 33], s[1 * 33]); o.y = pk2(s[2 * 33], s[3 * 33]); o.z = pk2(s[4 * 33], s[5 * 33]); o.w = pk2(s[6 * 33], s[7 * 33]);
        const int nn = n0 + n; const int dr = (MODE == 1) ? win_row(nn) : (MODE == 2) ? ((nn < DFF) ? ((nn >> 2) * 8 + (nn & 3)) : (((nn - DFF) >> 2) * 8 + 4 + ((nn - DFF) & 3))) : nn;
        *(u32x4*)(WT + (size_t)dr * K + k0 + 8 * c) = o; }
    LDS_WAIT(); asm volatile("" ::: "memory");
}
__device__ __forceinline__ void cvt_rows(const float* src, bf16_t* dst, size_t n8, int gw, int ngw, int lane) {
    const size_t stride = (size_t)ngw * 64;
    for (size_t i = (size_t)gw * 64 + lane; i < n8; i += 4 * stride) {
        f32x4 a[4], c[4];
#pragma unroll
        for (int u = 0; u < 4; ++u) { const size_t k = i + u * stride; if (k < n8) { a[u] = ((const f32x4*)src)[2 * k]; c[u] = ((const f32x4*)src)[2 * k + 1]; } }
#pragma unroll
        for (int u = 0; u < 4; ++u) { const size_t k = i + u * stride; if (k < n8) {
            u32x4 w; w.x = pk2(a[u][0], a[u][1]); w.y = pk2(a[u][2], a[u][3]); w.z = pk2(c[u][0], c[u][1]); w.w = pk2(c[u][2], c[u][3]);
            ((u32x4*)dst)[k] = w; } }
    }
}
__device__ __forceinline__ void p0_filter_item(const LAS float* w1, const float* b1, const float* fq, const LAS float* w2, const float* b2, const float* w3, float* HTD, int item, int lane) {
    const int t0 = 2 * (item >> 2), ih = item & 3; float h2v[2], tl[2];
    const float fql = fq[lane], b1l = b1[lane], b2l = b2[lane];
#pragma unroll
    for (int tt = 0; tt < 2; ++tt) { const int t = t0 + tt; tl[tt] = (float)t * (1.0f / 2047.0f);
        const float w = 6.283185307179586f * (float)t / 2048.0f;
        float zk = 0.f;
        if (lane == 0) zk = tl[tt];
        else if (lane <= 16) { const float fr = 1e-4f + (float)(lane - 1) * ((15.0f - 1e-4f) / 15.0f); zk = cosf(fr * w); }
        else if (lane <= 32) { const float fr = 1e-4f + (float)(lane - 17) * ((15.0f - 1e-4f) / 15.0f); zk = -sinf(fr * w); }
        float a = b1l;
#pragma unroll 11
        for (int k = 0; k < 33; ++k) a += __shfl(zk, k) * w1[k * 64 + lane];
        const float h1 = sinf(fql * a);
        float a2 = b2l;
#pragma unroll 16
        for (int k = 0; k < 64; ++k) a2 += __shfl(h1, k) * w2[k * 64 + lane];
        h2v[tt] = sinf(fql * a2); }
    const float dmin = -15.350567286626973f, dmax = -3.0701134573253946f;
    float acc0[8], acc1[8];
#pragma unroll
    for (int i = 0; i < 8; ++i) { acc0[i] = 0.f; acc1[i] = 0.f; }
#pragma unroll 8
    for (int j = 0; j < 64; ++j) { const float s0 = __shfl(h2v[0], j), s1 = __shfl(h2v[1], j); const float* wr = w3 + (size_t)j * 2048 + ih * 512 + lane;
#pragma unroll
        for (int i = 0; i < 8; ++i) { const float wv = wr[64 * i]; acc0[i] += s0 * wv; acc1[i] += s1 * wv; } }
#pragma unroll
    for (int i = 0; i < 8; ++i) { const int col = ih * 512 + 64 * i + lane, c = col & 511;
        const float delta = fabsf(dmin + (float)c * ((dmax - dmin) / 511.0f));
        float2 o; o.x = acc0[i] * expf(-tl[0] * delta); o.y = acc1[i] * expf(-tl[1] * delta);
        *(float2*)(HTD + (size_t)col * 2048 + t0) = o; }
}
__device__ __forceinline__ void p0_prep(const float* const* in, unsigned char* ws, LAS unsigned char* lds, int tid) {
    const int lane = tid & 63, wave = __builtin_amdgcn_readfirstlane(tid >> 6), gw = blockIdx.x * NWAVE + wave, ngw = gridDim.x * NWAVE;
    LAS float* scr = (LAS float*)(lds + wave * 8704);
    LAS float* W1L = (LAS float*)(lds + 69632); LAS float* W2L = W1L + 33 * 64;
    for (int i = tid; i < 33 * 64; i += NTHR) W1L[i] = in[5][i];
    for (int i = tid; i < 64 * 64; i += NTHR) W2L[i] = in[8][i];
    __syncthreads();
    bf16_t* WALL = (bf16_t*)(ws + WS_WALL);
    constexpr int I_IN = 16 * (INW / 32), I_KV = 16 * 32, I_OUT = 24 * 32, I_UP = 16 * (2 * DFF / 32), I_DN = (DFF / 64) * 32, NIT = I_IN + I_KV + I_OUT + I_UP + I_DN;
    for (int it = gw; it < NIT; it += ngw) { int r = it;
        if (r < I_IN) { p0_transpose_item<1>(in[2], DM, INW, WALL, scr, r, lane); continue; } r -= I_IN;
        if (r < I_KV) { p0_transpose_item<0>(in[14], DM, 1024, (bf16_t*)(ws + WS_WKV), scr, r, lane); continue; } r -= I_KV;
        if (r < I_OUT) { p0_transpose_item<0>(in[15], MIXW, DM, (bf16_t*)(ws + WS_WOUT), scr, r, lane); continue; } r -= I_OUT;
        if (r < I_UP) { p0_transpose_item<2>(in[18], DM, 2 * DFF, (bf16_t*)(ws + WS_WUP), scr, r, lane); continue; } r -= I_UP;
        p0_transpose_item<0>(in[21], DFF, DM, (bf16_t*)(ws + WS_WDN), scr, r, lane); }
    for (int it = ngw - 1 - gw; it < 4096; it += ngw) p0_filter_item(W1L, in[6], in[7], W2L, in[9], in[10], (float*)(ws + WS_HTD), it, lane);
    cvt_rows(in[0], (bf16_t*)(ws + WS_XB), (size_t)NT * DM / 8, gw, ngw, lane);
    cvt_rows(in[1], (bf16_t*)(ws + WS_MEMB), (size_t)NMT * DM / 8, gw, ngw, lane);
    float2* rope = (float2*)(ws + WS_ROPE);
    for (int i = blockIdx.x * NTHR + tid; i < SEQ * 32; i += gridDim.x * NTHR) { const int pos = i >> 5, f = i & 31;
        const float invf = powf(10000.0f, -(float)(2 * f) / 64.0f); const float ang = (float)pos * invf;
        float2 cs; cs.x = cosf(ang); cs.y = sinf(ang); rope[i] = cs; }
}

__device__ __forceinline__ void filter_fft_item(const float* HTD, float2* KF, LAS unsigned char* lds, int item, int tid) {
    const int o = item >> 9, c = item & 511;
    const float* rf = HTD + (size_t)((o * 2 + 0) * 512 + c) * 2048; const float* rb = HTD + (size_t)((o * 2 + 1) * 512 + c) * 2048;
    cplx v[8];
#pragma unroll
    for (int k = 0; k < 4; ++k) v[k] = mk2(rf[tid + 512 * k], 0.f);
    v[4] = mk2(tid == 0 ? 0.f : rb[2048 - tid], 0.f); v[5] = mk2(rb[1536 - tid], 0.f); v[6] = mk2(rb[1024 - tid], 0.f); v[7] = mk2(rb[512 - tid], 0.f);
    fft_fwd((LAS cplx*)lds, tid, v);
    float2* dst = KF + (size_t)(o * 512 + c) * 4096 + 8 * tid;
#pragma unroll
    for (int m = 0; m < 8; m += 2) { f32x4 w; w[0] = v[m].x * (1.f / 4096.f); w[1] = v[m].y * (1.f / 4096.f); w[2] = v[m + 1].x * (1.f / 4096.f); w[3] = v[m + 1].y * (1.f / 4096.f); *(f32x4*)(dst + m) = w; }
    __syncthreads();
}

constexpr int HY_SEG = 2064, HY_STG_OFF = 36864;
__device__ __forceinline__ float conv3s(const LAS bf16_t* seg, int n, float w0, float w1, float w2, float b) {
    return w0 * bf2f(seg[7 + n]) + w1 * bf2f(seg[8 + n]) + w2 * bf2f(seg[9 + n]) + b;
}
__device__ __forceinline__ void hyena_item(const bf16_t* HT, const float2* KF, const float* cw, const float* cb, const float* hb, bf16_t* MIX, LAS unsigned char* lds, int bp, int cgp, int tid0) {
    LAS cplx* X = (LAS cplx*)lds; LAS bf16_t* STG = (LAS bf16_t*)(lds + HY_STG_OFF); LAS cplx* TW = (LAS cplx*)(lds + 65536);
    const int ba = 2 * bp;
    twid_fill<512>(TW, tid0); twid_fill<64>(TW, tid0); twid_fill<8>(TW, tid0);
    u32x4 oacc[8];
#pragma unroll
    for (int i = 0; i < 8; ++i) oacc[i] = (u32x4){0u, 0u, 0u, 0u};
    if (tid0 < 12) { const int sg = tid0 >> 1; STG[sg * HY_SEG + ((tid0 & 1) ? 2056 : 7)] = 0; }
    { const int c = cgp * 8;
#pragma unroll
      for (int i = 0; i < 3; ++i) { const int id = tid0 + 512 * i, sg = id >> 8, ch = id & 255;
          const u32x4 q = *(const u32x4*)(HT + (size_t)((sg >> 1) * 512 + c) * NT + (ba + (sg & 1)) * SEQ + ch * 8);
          *(LAS u32x4*)(STG + sg * HY_SEG + 8 + ch * 8) = q; } }
    __syncthreads();
#pragma unroll 1
    for (int cc = 0; cc < 8; ++cc) {
        const int c = cgp * 8 + cc;
        int tl_ = tid0; asm volatile("" : "+v"(tl_)); const int tid = tl_;
        u32x4 nx[3];
        if (cc < 7) {
#pragma unroll
            for (int i = 0; i < 3; ++i) { const int id = tid + 512 * i, sg = id >> 8, ch = id & 255;
                nx[i] = *(const u32x4*)(HT + (size_t)((sg >> 1) * 512 + c + 1) * NT + (ba + (sg & 1)) * SEQ + ch * 8); } }
        f32x4 kf[4];
        { const f32x4* kp = (const f32x4*)(KF + (size_t)c * 4096 + 8 * tid);
#pragma unroll
          for (int m = 0; m < 4; ++m) kf[m] = kp[m]; }
        cplx v[8]; float va[4], vb[4];
        { const float w0 = cw[c], w1 = cw[1536 + c], w2 = cw[3072 + c], b = cb[c];
#pragma unroll
          for (int k = 0; k < 4; ++k) { const int n = tid + 512 * k; va[k] = conv3s(STG, n, w0, w1, w2, b); vb[k] = conv3s(STG + HY_SEG, n, w0, w1, w2, b); v[k] = mk2(va[k], vb[k]); v[4 + k] = mk2(0.f, 0.f); } }
        fft_fwdL(X, TW, tid, v);
#pragma unroll
        for (int m = 0; m < 8; m += 2) { const f32x4 w = kf[m >> 1]; v[m] = cmul(v[m], mk2(w[0], w[1])); v[m + 1] = cmul(v[m + 1], mk2(w[2], w[3])); }
        { const f32x4* kp = (const f32x4*)(KF + (size_t)(512 + c) * 4096 + 8 * tid);
#pragma unroll
          for (int m = 0; m < 4; ++m) kf[m] = kp[m]; }
        fft_invL(X, TW, tid, v);
        { const float w0 = cw[512 + c], w1 = cw[1536 + 512 + c], w2 = cw[3072 + 512 + c], b = cb[512 + c], hb0 = hb[c];
#pragma unroll
          for (int k = 0; k < 4; ++k) { const int n = tid + 512 * k; const float xa = conv3s(STG + 2 * HY_SEG, n, w0, w1, w2, b), xb = conv3s(STG + 3 * HY_SEG, n, w0, w1, w2, b);
              va[k] = xa * (v[k].x + hb0 * va[k]); vb[k] = xb * (v[k].y + hb0 * vb[k]); v[k] = mk2(va[k], vb[k]); v[4 + k] = mk2(0.f, 0.f); } }
        fft_fwdL(X, TW, tid, v);
#pragma unroll
        for (int m = 0; m < 8; m += 2) { const f32x4 w = kf[m >> 1]; v[m] = cmul(v[m], mk2(w[0], w[1])); v[m + 1] = cmul(v[m + 1], mk2(w[2], w[3])); }
        fft_invL(X, TW, tid, v);
        { const float w0 = cw[1024 + c], w1 = cw[1536 + 1024 + c], w2 = cw[3072 + 1024 + c], b = cb[1024 + c], hb1 = hb[512 + c];
#pragma unroll
          for (int k = 0; k < 4; ++k) { const int n = tid + 512 * k; const float xa = conv3s(STG + 4 * HY_SEG, n, w0, w1, w2, b), xb = conv3s(STG + 5 * HY_SEG, n, w0, w1, w2, b);
              const float oa = xa * (v[k].x + hb1 * va[k]), ob = xb * (v[k].y + hb1 * vb[k]);
              const unsigned pw = pk2(oa, ob);
#pragma unroll
              for (int hh = 0; hh < 2; ++hh) { u32x4& o = oacc[2 * k + hh]; const unsigned nw = hh ? (pw & 0xffff0000u) : (pw << 16);
                  o.x = __builtin_amdgcn_alignbit(o.y, o.x, 16); o.y = __builtin_amdgcn_alignbit(o.z, o.y, 16); o.z = __builtin_amdgcn_alignbit(o.w, o.z, 16); o.w = (o.w >> 16) | nw; } } }
        __syncthreads();
        if (cc < 7) {
#pragma unroll
            for (int i = 0; i < 3; ++i) { const int id = tid + 512 * i, sg = id >> 8, ch = id & 255; *(LAS u32x4*)(STG + sg * HY_SEG + 8 + ch * 8) = nx[i]; } }
        __syncthreads();
    }
    int tw_ = tid0; asm volatile("" : "+v"(tw_)); const int tid = tw_;
#pragma unroll
    for (int k = 0; k < 4; ++k)
#pragma unroll
        for (int hh = 0; hh < 2; ++hh) *(u32x4*)(MIX + (size_t)((ba + hh) * SEQ + tid + 512 * k) * MIXW + cgp * 8) = oacc[2 * k + hh];
}

constexpr int ATT_KP = 272, ATT_VP = 144, ATT_KB = 64 * ATT_KP, ATT_VB = 128 * ATT_VP, ATT_VOFF = 2 * ATT_KB;
__device__ __forceinline__ void att_vput(LAS unsigned char* p, u32x4 q) { u32x2 lo, hi; lo.x = q.x; lo.y = q.y; hi.x = q.z; hi.y = q.w; *(LAS u32x2*)p = lo; *(LAS u32x2*)(p + 16) = hi; }
template <int NC> __device__ __forceinline__ void attn_unit(LAS unsigned char* lds, const bf16_t* Qp, int ldq, const bf16_t* Kp, int ldk, const bf16_t* Vt, int ldv, int nkeys, float sl2,
                                                            bf16_t* Op, int ldo, float lam, const float* subg, int tid) {
    constexpr int NSTEP = (NC == 2) ? 4 : 8;
    const int lane = tid & 63, wave = tid >> 6, r = lane & 31, h = lane >> 5;
    const int qb = (NC == 2) ? (wave & 3) : wave, comp = (NC == 2) ? (wave >> 2) : 0, dbase = comp * 64;
    bf16x8 qf[NSTEP];
#pragma unroll
    for (int st = 0; st < NSTEP; ++st) qf[st] = *(const bf16x8*)(Qp + (size_t)(qb * 32 + r) * ldq + dbase + 16 * st + 8 * h);
    f32x16 o[4];
#pragma unroll
    for (int et = 0; et < 4; ++et)
#pragma unroll
        for (int i = 0; i < 16; ++i) o[et][i] = 0.f;
    float mold = -INFINITY, lsum = 0.f;
    const int kr0 = tid >> 4, kc = tid & 15, vr0 = tid >> 3, vc = tid & 7;
    const bf16_t* kg = Kp + (size_t)kr0 * ldk + kc * 8; const bf16_t* vg = Vt + (size_t)vr0 * ldv + vc * 8;
    const int kl = kr0 * ATT_KP + kc * 16, vl = ATT_VOFF + vr0 * ATT_VP + (vc >> 1) * 32 + (vc & 1) * 8;
    const int nt = nkeys / 64;
    u32x4 pk0, pk1, pv0, pv1;
    pk0 = *(const u32x4*)(kg); pk1 = *(const u32x4*)(kg + (size_t)32 * ldk); pv0 = *(const u32x4*)(vg); pv1 = *(const u32x4*)(vg + (size_t)64 * ldv);
    *(LAS u32x4*)(lds + kl) = pk0; *(LAS u32x4*)(lds + kl + 32 * ATT_KP) = pk1; att_vput(lds + vl, pv0); att_vput(lds + vl + 64 * ATT_VP, pv1);
    __syncthreads();
    for (int it = 0; it < nt; ++it) {
        const int cur = it & 1; const bool more = (it + 1 < nt);
        if (more) { const bf16_t* kg2 = kg + (size_t)(it + 1) * 64 * ldk; const bf16_t* vg2 = vg + (it + 1) * 64;
            pk0 = *(const u32x4*)(kg2); pk1 = *(const u32x4*)(kg2 + (size_t)32 * ldk); pv0 = *(const u32x4*)(vg2); pv1 = *(const u32x4*)(vg2 + (size_t)64 * ldv); }
        LAS unsigned char* Kb = lds + cur * ATT_KB; LAS unsigned char* Vb = lds + ATT_VOFF + cur * ATT_VB;
        f32x16 s[2];
#pragma unroll
        for (int kb = 0; kb < 2; ++kb) {
#pragma unroll
            for (int i = 0; i < 16; ++i) s[kb][i] = 0.f;
#pragma unroll
            for (int st = 0; st < NSTEP; ++st) { const bf16x8 a = *(const LAS bf16x8*)(Kb + (kb * 32 + r) * ATT_KP + (dbase + 16 * st + 8 * h) * 2);
                s[kb] = __builtin_amdgcn_mfma_f32_32x32x16_bf16(a, qf[st], s[kb], 0, 0, 0); } }
        float mx = s[0][0];
#pragma unroll
        for (int i = 1; i < 16; ++i) mx = fmaxf(mx, s[0][i]);
#pragma unroll
        for (int i = 0; i < 16; ++i) mx = fmaxf(mx, s[1][i]);
        mx = fmaxf(mx, __shfl_xor(mx, 32));
        const float mnew = fmaxf(mold, mx * sl2), alpha = __builtin_amdgcn_exp2f(mold - mnew); mold = mnew;
        float ps = 0.f;
#pragma unroll
        for (int kb = 0; kb < 2; ++kb)
#pragma unroll
            for (int i = 0; i < 16; ++i) { const float p = __builtin_amdgcn_exp2f(__builtin_fmaf(s[kb][i], sl2, -mnew)); s[kb][i] = p; ps += p; }
        lsum = lsum * alpha + ps;
#pragma unroll
        for (int et = 0; et < 4; ++et)
#pragma unroll
            for (int i = 0; i < 16; ++i) o[et][i] *= alpha;
#pragma unroll
        for (int kb = 0; kb < 2; ++kb)
#pragma unroll
            for (int s2 = 0; s2 < 2; ++s2) {
                u32x4 pw; pw.x = pk2(s[kb][8 * s2 + 0], s[kb][8 * s2 + 1]); pw.y = pk2(s[kb][8 * s2 + 2], s[kb][8 * s2 + 3]); pw.z = pk2(s[kb][8 * s2 + 4], s[kb][8 * s2 + 5]); pw.w = pk2(s[kb][8 * s2 + 6], s[kb][8 * s2 + 7]);
                const bf16x8 pf = __builtin_bit_cast(bf16x8, pw);
#pragma unroll
                for (int et = 0; et < 4; ++et) { const u32x4 aw = *(const LAS u32x4*)(Vb + (et * 32 + r) * ATT_VP + (kb * 2 + s2) * 32 + h * 16);
                    o[et] = __builtin_amdgcn_mfma_f32_32x32x16_bf16(__builtin_bit_cast(bf16x8, aw), pf, o[et], 0, 0, 0); } }
        if (more) { const int nb = cur ^ 1;
            *(LAS u32x4*)(lds + nb * ATT_KB + kl) = pk0; *(LAS u32x4*)(lds + nb * ATT_KB + kl + 32 * ATT_KP) = pk1;
            att_vput(lds + nb * ATT_VB + vl, pv0); att_vput(lds + nb * ATT_VB + vl + 64 * ATT_VP, pv1); }
        __syncthreads();
    }
    lsum += __shfl_xor(lsum, 32);
    const float inv = 1.0f / lsum;
    if (NC == 1) {
        bf16_t* orow = Op + (size_t)(qb * 32 + r) * ldo;
#pragma unroll
        for (int et = 0; et < 4; ++et)
#pragma unroll
            for (int g = 0; g < 4; ++g) { u32x2 w; w.x = pk2(o[et][4 * g] * inv, o[et][4 * g + 1] * inv); w.y = pk2(o[et][4 * g + 2] * inv, o[et][4 * g + 3] * inv);
                *(u32x2*)(orow + et * 32 + 8 * g + 4 * h) = w; }
    } else {
        LAS float* XL = (LAS float*)lds;
        if (comp == 1) {
#pragma unroll
            for (int et = 0; et < 4; ++et)
#pragma unroll
                for (int i = 0; i < 16; ++i) XL[(qb * 64 + et * 16 + i) * 64 + lane] = o[et][i] * inv;
        }
        __syncthreads();
        if (comp == 0) {
            float ss = 0.f;
#pragma unroll
            for (int et = 0; et < 4; ++et)
#pragma unroll
                for (int i = 0; i < 16; ++i) { const float ov = o[et][i] * inv - lam * XL[(qb * 64 + et * 16 + i) * 64 + lane]; o[et][i] = ov; ss += ov * ov; }
            ss += __shfl_xor(ss, 32);
            const float rs = rsqrtf(ss * (1.0f / 128.0f) + RMS_EPS) * 0.8f;
            bf16_t* orow = Op + (size_t)(qb * 32 + r) * ldo;
#pragma unroll
            for (int et = 0; et < 4; ++et)
#pragma unroll
                for (int g = 0; g < 4; ++g) { const int e = et * 32 + 8 * g + 4 * h; const f32x4 gv = *(const f32x4*)(subg + e);
                    u32x2 w; w.x = pk2(o[et][4 * g] * rs * gv[0], o[et][4 * g + 1] * rs * gv[1]); w.y = pk2(o[et][4 * g + 2] * rs * gv[2], o[et][4 * g + 3] * rs * gv[3]);
                    *(u32x2*)(orow + e) = w; }
        }
        __syncthreads();
    }
}

template <bool TO_BF16> __device__ __forceinline__ void ln_rows(float* io, bf16_t* ob, float2* stat, const float* g, const float* b, int tid, float* alt = nullptr) {
    const int lane = tid & 63, gw = blockIdx.x * NWAVE + (tid >> 6), ngw = gridDim.x * NWAVE;
    f32x4 gv[4], bv[4];
#pragma unroll
    for (int j = 0; j < 4; ++j) { gv[j] = ((const f32x4*)g)[lane + 64 * j]; bv[j] = ((const f32x4*)b)[lane + 64 * j]; }
    for (int row0 = gw; row0 < NT; row0 += 2 * ngw) {
        f32x4 v[2][4];
#pragma unroll
        for (int u = 0; u < 2; ++u) { const int row = row0 + u * ngw; if (row < NT) { const f32x4* xr = (const f32x4*)(io + (size_t)row * DM) + lane;
#pragma unroll
            for (int j = 0; j < 4; ++j) v[u][j] = xr[64 * j]; } }
#pragma unroll
        for (int u = 0; u < 2; ++u) { const int row = row0 + u * ngw; if (row >= NT) continue;
            float s = 0.f;
#pragma unroll
            for (int j = 0; j < 4; ++j) s += (v[u][j][0] + v[u][j][1]) + (v[u][j][2] + v[u][j][3]);
#pragma unroll
            for (int o = 1; o < 64; o <<= 1) s += __shfl_xor(s, o);
            const float mean = s * (1.0f / DM); float s2 = 0.f;
#pragma unroll
            for (int j = 0; j < 4; ++j) { v[u][j] = v[u][j] - mean; s2 += (v[u][j][0] * v[u][j][0] + v[u][j][1] * v[u][j][1]) + (v[u][j][2] * v[u][j][2] + v[u][j][3] * v[u][j][3]); }
#pragma unroll
            for (int o = 1; o < 64; o <<= 1) s2 += __shfl_xor(s2, o);
            const float rstd = rsqrtf(s2 * (1.0f / DM) + LN_EPS);
            if (TO_BF16) {
                u32x2* o8 = (u32x2*)(ob + (size_t)row * DM) + lane;
#pragma unroll
                for (int j = 0; j < 4; ++j) { const f32x4 y = v[u][j] * rstd * gv[j] + bv[j]; u32x2 w; w.x = pk2(y[0], y[1]); w.y = pk2(y[2], y[3]); o8[64 * j] = w; }
                if (lane == 0) { float2 st; st.x = mean; st.y = rstd; stat[row] = st; }
            } else {
                f32x4* wr_ = (alt ? (f32x4*)(alt + (size_t)row * DM) : (f32x4*)(io + (size_t)row * DM)) + lane;
#pragma unroll
                for (int j = 0; j < 4; ++j) wr_[64 * j] = v[u][j] * rstd * gv[j] + bv[j];
            }
        }
    }
}

__device__ __forceinline__ void convgate_half(const bf16_t* HH, bf16_t* ACT, const float* cw, const float* cb, int half, int tid) {
    constexpr int NG = DFF / 8; const int total = (NT / 2) * NG;
    for (int idx = blockIdx.x * NTHR + tid; idx < total; idx += gridDim.x * NTHR) {
        const int rl = idx / NG, cg8 = idx - rl * NG, n0 = cg8 * 8, t = rl & (SEQ - 1);
        const bf16_t* hp = HH + (size_t)rl * (2 * DFF);
        float gsum[8], usum[8];
#pragma unroll
        for (int e = 0; e < 8; ++e) { gsum[e] = cb[n0 + e]; usum[e] = cb[DFF + n0 + e]; }
#pragma unroll
        for (int j = 0; j < 3; ++j) { const int tt = t + j - 1; if (tt < 0 || tt >= SEQ) continue;
            const u32x4 gq = *(const u32x4*)(hp + (ptrdiff_t)(j - 1) * (2 * DFF) + n0), uq = *(const u32x4*)(hp + (ptrdiff_t)(j - 1) * (2 * DFF) + DFF + n0);
            const float* wg = cw + (size_t)j * (2 * DFF) + n0; const float* wu = wg + DFF;
            const f32x4 wg0 = *(const f32x4*)wg, wg1 = *(const f32x4*)(wg + 4), wu0 = *(const f32x4*)wu, wu1 = *(const f32x4*)(wu + 4);
            gsum[0] += wg0[0] * lo2f(gq.x); gsum[1] += wg0[1] * hi2f(gq.x); gsum[2] += wg0[2] * lo2f(gq.y); gsum[3] += wg0[3] * hi2f(gq.y);
            gsum[4] += wg1[0] * lo2f(gq.z); gsum[5] += wg1[1] * hi2f(gq.z); gsum[6] += wg1[2] * lo2f(gq.w); gsum[7] += wg1[3] * hi2f(gq.w);
            usum[0] += wu0[0] * lo2f(uq.x); usum[1] += wu0[1] * hi2f(uq.x); usum[2] += wu0[2] * lo2f(uq.y); usum[3] += wu0[3] * hi2f(uq.y);
            usum[4] += wu1[0] * lo2f(uq.z); usum[5] += wu1[1] * hi2f(uq.z); usum[6] += wu1[2] * lo2f(uq.w); usum[7] += wu1[3] * hi2f(uq.w); }
        float a[8];
#pragma unroll
        for (int e = 0; e < 8; ++e) a[e] = gsum[e] / (1.0f + __expf(-gsum[e])) * usum[e];
        u32x4 w; w.x = pk2(a[0], a[1]); w.y = pk2(a[2], a[3]); w.z = pk2(a[4], a[5]); w.w = pk2(a[6], a[7]);
        *(u32x4*)(ACT + (size_t)(half * (NT / 2) + rl) * DFF + n0) = w;
    }
}

#define XB_TMO      128
#define XB_XCNT(j)  (256  + 64 * (j))
#define XB_XSUB(j)  (1280 + 64 * (j))
#define XB_XGEN(j)  (2304 + 64 * (j))
#define XB_TOP      3328
#define XB_TOPGEN   3392
#define XCD_BAR_WORDS 3456
#define XB_SPIN_CAP (1u << 18)

__device__ __forceinline__ unsigned xb_ld(unsigned* p)              { return __hip_atomic_load(p, __ATOMIC_RELAXED, __HIP_MEMORY_SCOPE_AGENT); }
__device__ __forceinline__ unsigned xb_add(unsigned* p, unsigned v) { return __hip_atomic_fetch_add(p, v, __ATOMIC_RELAXED, __HIP_MEMORY_SCOPE_AGENT); }
__device__ __forceinline__ unsigned xb_xcc_id() { return (unsigned)__builtin_amdgcn_s_getreg((3 << 11) | 20) & 0xFu; }
#define XB_SPIN(cond, bar) do { unsigned _sp = 0; while (cond) { __builtin_amdgcn_s_sleep(1); \
    if ((++_sp & 255u) == 0u) { if (xb_ld(&(bar)[XB_TMO])) break; if (_sp > XB_SPIN_CAP) { atomicAdd(&(bar)[XB_TMO], 1u); break; } } } } while (0)

struct XcdBarrier {
    unsigned* bar; unsigned x;
    volatile LAS unsigned* st;
};

__device__ __forceinline__ XcdBarrier xcd_barrier_post(unsigned* bar, volatile LAS unsigned* st) {
    XcdBarrier b; b.bar = bar; b.x = xb_xcc_id(); b.st = st;
    if (threadIdx.x == 0) (void)xb_add(&bar[XB_XCNT(b.x)], 1u);
    return b;
}
__device__ __forceinline__ void xcd_barrier_complete(unsigned* bar, unsigned x, unsigned& nloc, unsigned& nx) {
    const unsigned G = gridDim.x * gridDim.y * gridDim.z;
    unsigned sum, cnt, mine, sp = 0u;
    for (;;) {
        sum = 0u; cnt = 0u; mine = 0u;
#pragma unroll
        for (unsigned j = 0; j < 16; ++j) { const unsigned c = xb_ld(&bar[XB_XCNT(j)]); sum += c; cnt += (c > 0u) ? 1u : 0u; mine = (j == x) ? c : mine; }
        if (sum == G) break;
        __builtin_amdgcn_s_sleep(1);
        if ((++sp & 255u) == 0u) { if (xb_ld(&bar[XB_TMO])) break; if (sp > XB_SPIN_CAP) { atomicAdd(&bar[XB_TMO], 1u); break; } }
    }
    nloc = mine > 0u ? mine : 1u; nx = cnt > 0u ? cnt : 1u;
}

__device__ __forceinline__ void xcd_barrier(const XcdBarrier& b) {
    asm volatile("s_waitcnt vmcnt(0)" ::: "memory");
    __syncthreads();
    if (threadIdx.x == 0) {
        unsigned* bar = b.bar;
        __builtin_amdgcn_s_waitcnt(0);
        unsigned nloc = b.st[0], nx = b.st[1];
        if (nloc == 0u) { xcd_barrier_complete(bar, b.x, nloc, nx); b.st[0] = nloc; b.st[1] = nx; }
        const unsigned old = xb_add(&bar[XB_XSUB(b.x)], 1u);
        const unsigned gen = old / nloc;
        if (old + 1u == (gen + 1u) * nloc) {
            __builtin_amdgcn_fence(__ATOMIC_RELEASE, "agent");
            asm volatile("s_waitcnt vmcnt(0)" ::: "memory");
            const unsigned og = xb_add(&bar[XB_TOP], 1u);
            const unsigned tg = og / nx;
            if (og + 1u == (tg + 1u) * nx) xb_add(&bar[XB_TOPGEN], 1u);
            else XB_SPIN(xb_ld(&bar[XB_TOPGEN]) == tg, bar);
            __builtin_amdgcn_fence(__ATOMIC_ACQUIRE, "agent");
            xb_add(&bar[XB_XGEN(b.x)], 1u);
            asm volatile("s_waitcnt vmcnt(0)" ::: "memory");
        } else {
            XB_SPIN(xb_ld(&bar[XB_XGEN(b.x)]) == gen, bar);
            __builtin_amdgcn_fence(__ATOMIC_ACQUIRE, "agent");
            asm volatile("s_waitcnt vmcnt(0)" ::: "memory");
        }
    }
    __syncthreads();
}

template <int MODE> __device__ __forceinline__ void panel_finish(LAS unsigned char* lds, float* io, bf16_t* x1b, float2* stat, const float* g, const float* b, unsigned long long* XG, unsigned* CNT, int cu, int tid) {
    const int v = PairOrder::vcu_of(cu), q = v >> 2, j = v & 3, lane = tid & 63, wave = tid >> 6;
    LAS cplx* ST = (LAS cplx*)(lds + XCH_OFF); LAS cplx* MR = (LAS cplx*)lds;
    asm volatile("s_waitcnt lgkmcnt(0)" ::: "memory"); __syncthreads();
    const int ui = tid >> 8, rowl = tid & 255;
    float m1, m2;
    { const cplx a0 = ST[tid * 4 + 0], a1 = ST[tid * 4 + 1], a2 = ST[tid * 4 + 2], a3 = ST[tid * 4 + 3];
      m1 = (a0.x + a1.x) + (a2.x + a3.x); m2 = (a0.y + a1.y) + (a2.y + a3.y);
      __hip_atomic_store(XG + (size_t)((2 * q + ui) * 4 + j) * 256 + rowl, ((unsigned long long)__float_as_uint(m2) << 32) | __float_as_uint(m1), __ATOMIC_RELAXED, __HIP_MEMORY_SCOPE_AGENT); }
    asm volatile("s_waitcnt vmcnt(0)" ::: "memory");
    __syncthreads();
    if (tid == 0) {
        (void)__hip_atomic_fetch_add(CNT + (2 * q) * 16, 1u, __ATOMIC_RELAXED, __HIP_MEMORY_SCOPE_AGENT);
        (void)__hip_atomic_fetch_add(CNT + (2 * q + 1) * 16, 1u, __ATOMIC_RELAXED, __HIP_MEMORY_SCOPE_AGENT);
        unsigned sp = 0;
        while (__hip_atomic_load(CNT + (2 * q) * 16, __ATOMIC_RELAXED, __HIP_MEMORY_SCOPE_AGENT) < 4u || __hip_atomic_load(CNT + (2 * q + 1) * 16, __ATOMIC_RELAXED, __HIP_MEMORY_SCOPE_AGENT) < 4u) {
            __builtin_amdgcn_s_sleep(1); if (++sp > (1u << 22)) break; }
        __builtin_amdgcn_fence(__ATOMIC_ACQUIRE, "agent");
        asm volatile("s_waitcnt vmcnt(0)" ::: "memory");
    }
    __syncthreads();
    { float t1 = m1, t2 = m2;
#pragma unroll
      for (int jj = 1; jj < 4; ++jj) { const unsigned long long w = __hip_atomic_load(XG + (size_t)((2 * q + ui) * 4 + ((j + jj) & 3)) * 256 + rowl, __ATOMIC_RELAXED, __HIP_MEMORY_SCOPE_AGENT);
          t1 += __uint_as_float((unsigned)w); t2 += __uint_as_float((unsigned)(w >> 32)); }
      const float mean = t1 * (1.0f / DM), var = fmaxf(t2 * (1.0f / DM) - mean * mean, 0.f), rstd = rsqrtf(var + LN_EPS);
      cplx mr; mr.x = mean; mr.y = rstd; MR[tid] = mr;
      if (MODE == 1 && j == 0) { float2 sv; sv.x = mean; sv.y = rstd; stat[(2 * q + ui) * 256 + rowl] = sv; } }
    __syncthreads();
    const int cbase = j * 256 + lane * 4;
    const f32x4 g0 = *(const f32x4*)(g + cbase), b0 = *(const f32x4*)(b + cbase);
#pragma unroll 1
    for (int it = 0; it < 8; ++it) {
        const int u2 = it >> 2, rb = (it & 3) * 8; const size_t rbase = (size_t)((2 * q + u2) * 256 + wave * 32 + rb);
        f32x4 x0[8];
#pragma unroll
        for (int i = 0; i < 8; ++i) x0[i] = *(const f32x4*)(io + (rbase + i) * DM + cbase);
        asm volatile("" ::: "memory");
#pragma unroll
        for (int i = 0; i < 8; ++i) { const cplx mr = MR[u2 * 256 + wave * 32 + rb + i];
            const f32x4 y0 = (x0[i] - mr.x) * mr.y * g0 + b0;
            if (MODE == 1) { u32x2 w0; w0.x = pk2(y0[0], y0[1]); w0.y = pk2(y0[2], y0[3]); *(u32x2*)(x1b + (rbase + i) * DM + cbase) = w0; }
            else *(f32x4*)(io + (rbase + i) * DM + cbase) = y0; }
    }
}

#ifndef PH_MASK
#define PH_MASK 0xFFFFFF
#endif
#define PH(k) ((PH_MASK >> (k)) & 1)
#ifndef G5ORDER
#define G5ORDER KbOrder
#endif
#ifndef REP_P0
#define REP_P0 1
#endif
#ifndef REP_G1
#define REP_G1 1
#endif
#ifndef REP_DIFF
#define REP_DIFF 1
#endif
#ifndef REP_HY
#define REP_HY 1
#endif
#ifndef REP_MEM
#define REP_MEM 1
#endif
#ifndef REP_G3
#define REP_G3 1
#endif
#ifndef REP_G4
#define REP_G4 1
#endif
#ifndef REP_LN1
#define REP_LN1 1
#endif
struct Args { const float* in[24]; float* out; unsigned char* ws; };
__global__ void __launch_bounds__(NTHR, 2) hybrid_fwd(Args a) {
    extern __shared__ __attribute__((aligned(16))) unsigned char smem[];
    LAS unsigned char* lds = (LAS unsigned char*)smem;
    cg::grid_group grid = cg::this_grid();
    volatile LAS unsigned* bst = (volatile LAS unsigned*)(lds + LDS_BYTES - 64);
    if (threadIdx.x < 2) bst[threadIdx.x] = 0u;
    __syncthreads();
    const XcdBarrier bar = xcd_barrier_post((unsigned*)(a.ws + WS_BAR), bst);
    const int G = gridDim.x;
#define NEWPHASE() int tid_ = threadIdx.x, cu_ = blockIdx.x; asm volatile("" : "+v"(tid_)); asm volatile("" : "+s"(cu_)); const int tid = tid_, cu = cu_; (void)tid; (void)cu;
    unsigned char* ws = a.ws;
    bf16_t* WALL = (bf16_t*)(ws + WS_WALL); bf16_t* XB = (bf16_t*)(ws + WS_XB); bf16_t* MEMB = (bf16_t*)(ws + WS_MEMB); bf16_t* WKV = (bf16_t*)(ws + WS_WKV);
    bf16_t* QKM = (bf16_t*)(ws + WS_QKM); bf16_t* HT = (bf16_t*)(ws + WS_HT); bf16_t* KMEM = (bf16_t*)(ws + WS_KMEM); bf16_t* VMT = (bf16_t*)(ws + WS_VMT);
    float2* KF = (float2*)(ws + WS_KF); bf16_t* MIX = (bf16_t*)(ws + WS_MIX); float2* STAT = (float2*)(ws + WS_STAT);
    bf16_t* X1B = (bf16_t*)(ws + WS_X1B); bf16_t* HH = (bf16_t*)(ws + WS_HH); bf16_t* ACT = (bf16_t*)(ws + WS_ACT);

    for (int rep = 0; rep < REP_P0; ++rep) { NEWPHASE(); if (PH(0)) p0_prep(a.in, ws, lds, tid); }
    if (a.ws == nullptr) grid.sync();
    xcd_barrier(bar);

    for (int rep = 0; rep < REP_G1; ++rep) {
    if (PH(1)) { NEWPHASE(); pg8::Gemm g{XB, WALL, NT, 1536, DM}; pg8::StaticOrder S; S.init(g.M, g.N, G, cu);
      EpiRope E{QKM, (const float2*)(ws + WS_ROPE)};
      pg8::gemm_phase<EpiRope, pg8::StaticOrder, true, true>(lds, g, S, E); }
    if (PH(2)) { NEWPHASE(); pg8::Gemm g{WALL + (size_t)1536 * DM, XB, 2048, NT, DM}; pg8::StaticOrder S; S.init(g.M, g.N, G, cu);
      EpiB E{HT, NT};
      pg8::gemm_phase<EpiB, pg8::StaticOrder, true, true>(lds, g, S, E); }
    }
    if (PH(3)) { NEWPHASE(); const bool isK = cu < 32, on = cu < 64; const int c2 = cu - 32;
      pg8::Gemm g; EpiB E; OneUnit S;
      if (isK) { g = pg8::Gemm{MEMB, WKV, NMT, 512, DM}; E = EpiB{KMEM, 512}; S = OneUnit{cu >> 1, cu & 1, on}; }
      else { g = pg8::Gemm{WKV + (size_t)512 * DM, MEMB, 512, NMT, DM}; E = EpiB{VMT, NMT}; S = OneUnit{(c2 >> 4) & 1, c2 & 15, on}; }
      pg8::gemm_phase<EpiB, OneUnit, false, true>(lds, g, S, E);
      __syncthreads();
      if (!on) for (int it = cu - 64; it < 1024; it += G - 64) filter_fft_item((const float*)(ws + WS_HTD), KF, lds, it, tid); }
    xcd_barrier(bar);

    { NEWPHASE(); const int xcd = cu & 7, j = cu >> 3;
      float lam;
      { const float* lp = a.in[12]; const int l6 = tid & 63; float s01 = lp[l6] * lp[64 + l6], s23 = lp[128 + l6] * lp[192 + l6];
#pragma unroll
        for (int o = 1; o < 64; o <<= 1) { s01 += __shfl_xor(s01, o); s23 += __shfl_xor(s23, o); }
        lam = expf(s01) - expf(s23) + 0.2f; }
      if (PH(4)) for (int i = 0; i < 4 * REP_DIFF; ++i) {
          const int bh = ((i & 3) * 8 + xcd) * 2 + (j >> 4), qblk = j & 15, b = bh >> 2, hd = bh & 3;
          const size_t tok0 = (size_t)b * SEQ;
          attn_unit<2>(lds, QKM + (tok0 + qblk * 128) * MIXW + hd * 128, MIXW, QKM + tok0 * MIXW + 512 + hd * 128, MIXW,
                       HT + (size_t)(1536 + hd * 128) * NT + tok0, NT, SEQ, 0.125f * 1.4426950408889634f,
                       MIX + (tok0 + qblk * 128) * MIXW + 512 + hd * 128, MIXW, lam, a.in[13], tid); }
      if (PH(5)) for (int i = 0; i < 2 * REP_MEM; ++i) {
          const int bh = ((i & 1) * 8 + xcd) * 4 + (j >> 3), qblk = j & 7, b = bh >> 2, hd = bh & 3;
          const size_t tok0 = (size_t)b * SEQ;
          attn_unit<1>(lds, QKM + (tok0 + qblk * 256) * MIXW + 1024 + hd * 128, MIXW, KMEM + (size_t)b * MEMT * 512 + hd * 128, 512,
                       VMT + (size_t)(hd * 128) * NMT + b * MEMT, NMT, MEMT, 0.08838834764831845f * 1.4426950408889634f,
                       MIX + (tok0 + qblk * 256) * MIXW + 1024 + hd * 128, MIXW, 0.f, nullptr, tid); }
      if (PH(6)) for (int i = 0; i < 2 * REP_HY; ++i) {
          const int cgp = ((i & 1) * 8 + xcd) * 4 + (j >> 3), bp = j & 7;
          hyena_item(HT, KF, a.in[3], a.in[4], a.in[11], MIX, lds, bp, cgp, tid); } }
    xcd_barrier(bar);

#ifdef REP_SYNC
    for (int rep = 0; rep < REP_SYNC; ++rep) xcd_barrier(bar);
#endif
    const bool pair = (G == 256);
    if (pair) {
        if (PH(7)) for (int pass = 0; pass < 2; ++pass) { NEWPHASE(); const int v = PairOrder::vcu_of(cu);
            pg8::Gemm g{MIX, (const bf16_t*)(ws + WS_WOUT), NT, DM, MIXW}; OneUnit S{2 * (v >> 2) + pass, v & 3, true};
            EpiLn<1> E{a.in[0], a.out, X1B, a.in[16], a.in[17], (unsigned long long*)(ws + WS_XG), (unsigned*)(ws + WS_CNT)};
            pg8::gemm_phase<EpiLn<1>, OneUnit, false, true>(lds, g, S, E); }
        xcd_barrier(bar);
    } else {
        { NEWPHASE(); pg8::Gemm g{MIX, (const bf16_t*)(ws + WS_WOUT), NT, DM, MIXW}; pg8::StaticOrder S; S.init(g.M, g.N, G, cu);
          EpiRes E{a.in[0], a.out, lds, 0};
          pg8::gemm_phase<EpiRes, pg8::StaticOrder, true, true>(lds, g, S, E); }
        xcd_barrier(bar);
        { NEWPHASE(); ln_rows<true>(a.out, X1B, STAT, a.in[16], a.in[17], tid); }
        xcd_barrier(bar);
    }
    for (int rep = 0; rep < REP_G4; ++rep) if (PH(9)) { NEWPHASE(); pg8::Gemm g{X1B, (const bf16_t*)(ws + WS_WUP), FFN_MT * 256, 2 * DFF, DM}; FfnOrder S; S.init(g.M, g.N, G, cu); S.cw = a.in[19]; S.cb = a.in[20]; S.lds = lds; S.cnt = 0;
      EpiFfn E{ACT, lds, 0};
      pg8::gemm_phase<EpiFfn, FfnOrder, true, true>(lds, g, S, E); }
    xcd_barrier(bar);
    if (pair) {
        if (PH(11)) for (int pass = 0; pass < 2; ++pass) { NEWPHASE(); const int v = PairOrder::vcu_of(cu);
            pg8::Gemm g{ACT, (const bf16_t*)(ws + WS_WDN), NT, DM, DFF}; OneUnitKb S; S.pm = 2 * (v >> 2) + pass; S.pn = v & 3; S.on = true;
            EpiLn<2> E{a.out, a.out, nullptr, a.in[22], a.in[23], (unsigned long long*)(ws + WS_XG) + 128 * 4 * 256, (unsigned*)(ws + WS_CNT) + 128 * 16};
            pg8::gemm_phase<EpiLn<2>, OneUnitKb, false, true>(lds, g, S, E); }
    } else {
        { NEWPHASE(); pg8::Gemm g{ACT, (const bf16_t*)(ws + WS_WDN), NT, DM, DFF}; KbOrder S; S.init(g.M, g.N, G, cu);
          EpiRes2 E{a.out, a.out, STAT, a.in[16], a.in[17], lds, 0};
          pg8::gemm_phase<EpiRes2, KbOrder, true, true>(lds, g, S, E); }
        xcd_barrier(bar);
        { NEWPHASE(); ln_rows<false>(a.out, nullptr, nullptr, a.in[22], a.in[23], tid); }
    }
}

extern "C" void kernel_launch(void* const* d_in, const int* in_sizes, int n_in, void* d_out, int out_size, void* d_ws, size_t ws_size, hipStream_t stream) {
    static int grid = 0;
    if (grid == 0) {
        if (n_in != 24 || out_size != NT * DM || ws_size < WS_END) { fprintf(stderr, "kernel_launch: unexpected shapes (n_in %d, out %d, ws %zu)\n", n_in, out_size, ws_size); grid = -1; return; }
        int dev = 0, cus = 0, per_cu = 0;
        hipGetDevice(&dev); hipDeviceGetAttribute(&cus, hipDeviceAttributeMultiprocessorCount, dev);
        if (hipFuncSetAttribute((const void*)hybrid_fwd, hipFuncAttributeMaxDynamicSharedMemorySize, LDS_BYTES) != hipSuccess) { fprintf(stderr, "kernel_launch: hipFuncSetAttribute failed\n"); grid = -1; return; }
        if (hipOccupancyMaxActiveBlocksPerMultiprocessor(&per_cu, (const void*)hybrid_fwd, NTHR, LDS_BYTES) != hipSuccess || per_cu < 1) { fprintf(stderr, "kernel_launch: occupancy query says %d\n", per_cu); per_cu = 1; }
        (void)hipGetLastError();
        grid = cus * per_cu;
        fprintf(stderr, "kernel_launch: grid %d (cus %d x %d)\n", grid, cus, per_cu);
    }
    if (grid < 0) return;
    if (hipMemsetAsync((char*)d_ws + WS_BAR, 0, 32768, stream) != hipSuccess) { fprintf(stderr, "kernel_launch: memset failed\n"); return; }
    Args a{};
    for (int i = 0; i < 24; ++i) a.in[i] = (const float*)d_in[i];
    a.out = (float*)d_out; a.ws = (unsigned char*)d_ws;
    void* args[] = {&a};
    const hipError_t e = hipLaunchCooperativeKernel((const void*)hybrid_fwd, dim3(grid), dim3(NTHR), args, LDS_BYTES, stream);
    if (e != hipSuccess) fprintf(stderr, "kernel_launch: cooperative launch failed: %s (grid %d)\n", hipGetErrorString(e), grid);
}
```

```cpp
#include <hip/hip_runtime.h>
#include <hip/hip_cooperative_groups.h>
#include <cstdio>
#include <cstdint>
namespace cg = cooperative_groups;
#define LAS __attribute__((address_space(3)))
namespace pg8 {
#define PG8_LAS __attribute__((address_space(3)))
typedef unsigned short bf16_t;
typedef short bf16x8 __attribute__((ext_vector_type(8)));
typedef float f32x4 __attribute__((ext_vector_type(4)));
typedef unsigned u32x4 __attribute__((ext_vector_type(4)));
constexpr int BM = 256, BK = 64, HALF = 128, HTB = HALF * BK * 2  , STAGE_BYTES = 8 * HTB, NXCD = 8, WGM = 8;

__host__ __device__ __forceinline__ int lds_byte(int r, int c) { const int st = (r >> 4) * 2 + (c >> 5), rr = r & 15, cc = c & 31, ob = rr * 64 + cc * 2; return st * 1024 + (ob ^ (((ob >> 9) & 1) << 5)); }
__host__ __device__ __forceinline__ void stage_rc(int b, int& R, int& C) { const int st = b / 1024, sb = b % 1024, swz = sb ^ (((sb >> 9) & 1) << 5); R = (st >> 1) * 16 + swz / 64; C = (st & 1) * 32 + (swz % 64) / 2; }
__host__ __device__ __forceinline__ int perm32(int rho) { const int n = rho >> 4, i = rho & 15; return 8 * (i >> 2) + 4 * n + (i & 3); }

struct Unit { int pm, pn; };
struct Gemm { const bf16_t* A; const bf16_t* Bt; int M, N, K; };

struct StaticOrder {
    int nM, nN, nwg, G, c;
    __host__ __device__ void init(int M, int N, int G_, int c_) { nM = M / BM; nN = N / BM; nwg = nM * nN; G = G_; c = c_; }
    __host__ __device__ bool next(int i, Unit& u) const {
        const long L = (long)i * G + c; if (L >= nwg) return false;
        int wgid = (int)L; { const int q = nwg / NXCD, r = nwg % NXCD, xcd = wgid % NXCD, off = wgid / NXCD; wgid = (xcd < r ? xcd * (q + 1) : r * (q + 1) + (xcd - r) * q) + off; }
        const int nig = WGM * nN, gid = wgid / nig, fm = gid * WGM, gsz = (nM - fm) < WGM ? (nM - fm) : WGM;
        u.pm = fm + ((wgid % nig) % gsz); u.pn = (wgid % nig) / gsz; return true;
    }
    __device__ __forceinline__ void a_ready(const Unit&) const {}
    __device__ __forceinline__ void done(const Unit&) const {}
    __device__ __forceinline__ long a_off(const Unit& u, size_t tstep) const { return (long)((size_t)u.pm * tstep); }
    __device__ __forceinline__ int lda(int K) const { return K; }
    __device__ __forceinline__ size_t kstep_a() const { return (size_t)(BK * 2); }
};
template <class Epi, class Sched, bool ALIGN_EPI = false, bool SP2 = false>
__device__ __forceinline__ void gemm_phase(PG8_LAS unsigned char* lds, const Gemm g, const Sched& S, const Epi& E) {
    int tid_l = threadIdx.x; asm volatile("" : "+v"(tid_l)); const int tid = tid_l, wid = __builtin_amdgcn_readfirstlane(tid >> 6), lane = tid & 63, wr = wid >> 2, wc = wid & 3, fr = lane & 15, fq = lane >> 4;
    const int K = g.K, nt = K / BK;
    unsigned voffA[2], voffB[2];
    const int lda = S.lda(K);
#pragma unroll
    for (int i = 0; i < 2; ++i) { int R, C; stage_rc(tid * 16 + i * 8192, R, C); const int Rb = Epi::PERM ? ((R & ~31) + perm32(R & 31)) : R;
        voffA[i] = (unsigned)(R * lda + C) * 2u; voffB[i] = (unsigned)(Rb * K + C) * 2u; }
    const size_t kstep = (size_t)(BK * 2);
    const size_t hstep = (size_t)HALF * K * 2;
    const size_t tstep = 2 * hstep;
    const size_t kstepA = S.kstep_a(), hstepA = (size_t)HALF * lda * 2, tstepA = 2 * hstepA;
    const unsigned ldsw = (unsigned)wid * 1024u;
    const int aoff = lds_byte(wr * 64 + fr, fq * 8), boff = lds_byte(wc * 32 + fr, fq * 8);
#define PG8_SA(b, h) (((b) * 2 + (h)) * HTB)
#define PG8_SB(b, h) ((4 + (b) * 2 + (h)) * HTB)
#define PG8_STAGE(bufoff, gbase, voff) do { _Pragma("unroll") for (int _i = 0; _i < 2; ++_i) \
        __builtin_amdgcn_global_load_lds((const unsigned*)((const char*)(gbase) + (voff)[_i]), (PG8_LAS unsigned*)(lds + (bufoff) + ldsw + _i * 8192), 16, 0, 0); } while (0)
#define PG8_LDA(dst, b, h) do { _Pragma("unroll") for (int m = 0; m < 4; ++m) _Pragma("unroll") for (int k = 0; k < 2; ++k) dst[m][k] = *(const PG8_LAS bf16x8*)(lds + PG8_SA(b, h) + aoff + m * 2048 + k * 1024); } while (0)
#define PG8_LDB(dst, b, h) do { _Pragma("unroll") for (int n = 0; n < 2; ++n) _Pragma("unroll") for (int k = 0; k < 2; ++k) dst[n][k] = *(const PG8_LAS bf16x8*)(lds + PG8_SB(b, h) + boff + n * 2048 + k * 1024); } while (0)
#define PG8_MMA(ai, bj, At, Bt) do { __builtin_amdgcn_s_setprio(1); _Pragma("unroll") for (int m = 0; m < 4; ++m) _Pragma("unroll") for (int n = 0; n < 2; ++n) _Pragma("unroll") for (int k = 0; k < 2; ++k) \
        acc[ai][bj][m][n] = __builtin_amdgcn_mfma_f32_16x16x32_bf16(Bt[n][k], At[m][k], acc[ai][bj][m][n], 0, 0, 0); __builtin_amdgcn_s_setprio(0); } while (0)
#define PG8_WAIT_V(n) asm volatile("s_waitcnt vmcnt(" #n ")" ::: "memory")
#define PG8_WAIT_L(n) asm volatile("s_waitcnt lgkmcnt(" #n ")" ::: "memory")
#define PG8_BAR __builtin_amdgcn_s_barrier()
#define PG8_SCHED __builtin_amdgcn_sched_barrier(0)
    Unit cur, nxt; int ui = 0;
    if (!S.next(0, cur)) return;
    f32x4 acc[2][2][4][2];
#pragma unroll
    for (int a = 0; a < 2; ++a)
#pragma unroll
        for (int b = 0; b < 2; ++b)
#pragma unroll
            for (int m = 0; m < 4; ++m)
#pragma unroll
                for (int n = 0; n < 2; ++n) acc[a][b][m][n] = (f32x4){0.f, 0.f, 0.f, 0.f};
    bf16x8 At[4][2], B0[2][2], B1[2][2];
    const char* cA = (const char*)g.A + S.a_off(cur, tstepA); const char* cB = (const char*)g.Bt + (size_t)cur.pn * tstep;
    S.a_ready(cur);
    if constexpr (SP2) {
        PG8_STAGE(PG8_SB(0, 0), cB, voffB); PG8_STAGE(PG8_SB(0, 1), cB + hstep, voffB); PG8_STAGE(PG8_SA(0, 0), cA, voffA); PG8_STAGE(PG8_SA(0, 1), cA + hstepA, voffA);
        if (wr == 1) PG8_BAR;
        PG8_WAIT_V(2); PG8_BAR;
        PG8_STAGE(PG8_SB(1, 0), cB + kstep, voffB); PG8_STAGE(PG8_SA(1, 0), cA + kstepA, voffA); PG8_STAGE(PG8_SB(1, 1), cB + hstep + kstep, voffB);
        PG8_WAIT_V(6); PG8_BAR;
    } else {
        PG8_STAGE(PG8_SB(0, 0), cB, voffB); PG8_STAGE(PG8_SA(0, 0), cA, voffA); PG8_STAGE(PG8_SB(0, 1), cB + hstep, voffB); PG8_STAGE(PG8_SA(0, 1), cA + hstepA, voffA);
        if (wr == 1) PG8_BAR;
        PG8_WAIT_V(4); PG8_BAR;
        PG8_STAGE(PG8_SB(1, 0), cB + kstep, voffB); PG8_STAGE(PG8_SA(1, 0), cA + kstepA, voffA); PG8_STAGE(PG8_SB(1, 1), cB + hstep + kstep, voffB);
        PG8_WAIT_V(6); PG8_BAR;
    }
    for (;;) {
        const bool has_next = S.next(ui + 1, nxt);
        const char* nA = has_next ? (const char*)g.A + S.a_off(nxt, tstepA) : cA; const char* nB = has_next ? (const char*)g.Bt + (size_t)nxt.pn * tstep : cB;
        for (int t = 0; t < nt; t += 2) {
            const bool last = (t == nt - 2);
            const char* a1 = cA + (size_t)(t + 1) * kstepA;
            const char* a2 = last ? nA : cA + (size_t)(t + 2) * kstepA; const char* b2 = last ? nB : cB + (size_t)(t + 2) * kstep;
            const char* a3 = a2 + kstepA; const char* b3 = b2 + kstep;
            if (last && has_next) S.a_ready(nxt);
            if constexpr (SP2) {
            PG8_LDB(B0, 0, 0); PG8_LDB(B1, 0, 1); PG8_SCHED; PG8_LDA(At, 0, 0); PG8_STAGE(PG8_SA(1, 1), a1 + hstepA, voffA);
            PG8_WAIT_V(8); PG8_WAIT_L(0); PG8_BAR; PG8_MMA(0, 0, At, B0); PG8_MMA(0, 1, At, B1); PG8_BAR; PG8_SCHED;
            PG8_LDA(At, 0, 1); PG8_STAGE(PG8_SB(0, 0), b2, voffB); PG8_STAGE(PG8_SB(0, 1), b2 + hstep, voffB); PG8_STAGE(PG8_SA(0, 0), a2, voffA);
            PG8_WAIT_V(8); PG8_WAIT_L(0); PG8_BAR; PG8_MMA(1, 0, At, B0); PG8_MMA(1, 1, At, B1); PG8_BAR; PG8_SCHED;
            PG8_LDB(B0, 1, 0); PG8_LDB(B1, 1, 1); PG8_SCHED; PG8_LDA(At, 1, 0); PG8_STAGE(PG8_SA(0, 1), a2 + hstepA, voffA);
            PG8_WAIT_V(8); PG8_WAIT_L(0); PG8_BAR; PG8_MMA(0, 0, At, B0); PG8_MMA(0, 1, At, B1); PG8_BAR; PG8_SCHED;
            PG8_LDA(At, 1, 1); PG8_STAGE(PG8_SB(1, 0), b3, voffB); PG8_STAGE(PG8_SB(1, 1), b3 + hstep, voffB); PG8_STAGE(PG8_SA(1, 0), a3, voffA);
            PG8_WAIT_V(8); PG8_WAIT_L(0); PG8_BAR; PG8_MMA(1, 0, At, B0); PG8_MMA(1, 1, At, B1); PG8_BAR; PG8_SCHED;
            } else {
            PG8_LDB(B0, 0, 0); PG8_SCHED; PG8_LDA(At, 0, 0); PG8_STAGE(PG8_SA(1, 1), a1 + hstepA, voffA);
            PG8_WAIT_L(8); PG8_BAR; PG8_WAIT_L(0); PG8_MMA(0, 0, At, B0); PG8_BAR; PG8_SCHED;
            PG8_LDB(B1, 0, 1); PG8_STAGE(PG8_SB(0, 0), b2, voffB);
            PG8_BAR; PG8_WAIT_L(0); PG8_MMA(0, 1, At, B1); PG8_BAR;
            PG8_LDA(At, 0, 1); PG8_STAGE(PG8_SA(0, 0), a2, voffA);
            PG8_BAR; PG8_WAIT_L(0); PG8_MMA(1, 0, At, B0); PG8_BAR; PG8_SCHED;
            PG8_STAGE(PG8_SB(0, 1), b2 + hstep, voffB);
            PG8_WAIT_V(6); PG8_BAR; PG8_MMA(1, 1, At, B1); PG8_BAR;
            PG8_LDB(B0, 1, 0); PG8_SCHED; PG8_LDA(At, 1, 0); PG8_STAGE(PG8_SA(0, 1), a2 + hstepA, voffA);
            PG8_WAIT_L(8); PG8_BAR; PG8_WAIT_L(0); PG8_MMA(0, 0, At, B0); PG8_BAR; PG8_SCHED;
            PG8_LDB(B1, 1, 1); PG8_STAGE(PG8_SB(1, 0), b3, voffB);
            PG8_BAR; PG8_WAIT_L(0); PG8_MMA(0, 1, At, B1); PG8_BAR;
            PG8_LDA(At, 1, 1); PG8_STAGE(PG8_SA(1, 0), a3, voffA);
            PG8_BAR; PG8_WAIT_L(0); PG8_MMA(1, 0, At, B0); PG8_BAR; PG8_SCHED;
            PG8_STAGE(PG8_SB(1, 1), b3 + hstep, voffB);
            PG8_WAIT_V(6); PG8_BAR; PG8_MMA(1, 1, At, B1); PG8_BAR;
            }
        }
        if constexpr (ALIGN_EPI) { if (wr == 0) PG8_BAR; }
        if constexpr (!Epi::AFTER_DRAIN) { E(acc, cur, wr, wc, fr, fq); S.done(cur); }
        if (!has_next) break;
#pragma unroll
        for (int a = 0; a < 2; ++a)
#pragma unroll
            for (int b = 0; b < 2; ++b)
#pragma unroll
                for (int m = 0; m < 4; ++m)
#pragma unroll
                    for (int n = 0; n < 2; ++n) acc[a][b][m][n] = (f32x4){0.f, 0.f, 0.f, 0.f};
        cur = nxt; cA = nA; cB = nB; ++ui;
        if constexpr (ALIGN_EPI) { if (wr == 1) PG8_BAR; }
    }
    PG8_WAIT_V(0);
    if constexpr (!ALIGN_EPI) { if (wr == 0) PG8_BAR; }
    PG8_BAR;
    if constexpr (Epi::AFTER_DRAIN) { E.fused(acc, cur, wr, wc, fr, fq, lds, wid, lane); S.done(cur); }
#undef PG8_SA
#undef PG8_SB
#undef PG8_STAGE
#undef PG8_LDA
#undef PG8_LDB
#undef PG8_MMA
#undef PG8_WAIT_V
#undef PG8_WAIT_L
#undef PG8_BAR
#undef PG8_SCHED
}
}

using pg8::bf16_t; using pg8::bf16x8; using pg8::f32x4; using pg8::u32x4;
typedef float f32x16 __attribute__((ext_vector_type(16)));
typedef unsigned u32x2 __attribute__((ext_vector_type(2)));
typedef short bf16x4 __attribute__((ext_vector_type(4)));

constexpr int NB = 16, SEQ = 2048, DM = 1024, NT = NB * SEQ, MEMT = 256, NMT = NB * MEMT, HW = 512, INW = 3584, DFF = 2816, MIXW = 1536;
constexpr float ALPHA = 1.189207115002721f;
constexpr float LN_EPS = 1e-5f, RMS_EPS = 1e-5f;
constexpr int NTHR = 512, NWAVE = 8;
constexpr int LDS_BYTES = 151552;

constexpr size_t MiB = 1048576;
constexpr size_t WS_WALL = 0;
constexpr size_t WS_WKV  = 7 * MiB;
constexpr size_t WS_WOUT = 9 * MiB;
constexpr size_t WS_WUP  = 12 * MiB;
constexpr size_t WS_WDN  = 23 * MiB;
constexpr size_t WS_ROPE = 29 * MiB;
constexpr size_t WS_STAT = 29 * MiB + 524288;
constexpr size_t WS_XB   = 30 * MiB;
constexpr size_t WS_X1B  = 30 * MiB;
constexpr size_t WS_HTD  = 94 * MiB;
constexpr size_t WS_MEMB = 110 * MiB;
constexpr size_t WS_QKM  = 118 * MiB;
constexpr size_t WS_HT   = 214 * MiB;
constexpr size_t WS_KMEM = 342 * MiB;
constexpr size_t WS_VMT  = 346 * MiB;
constexpr size_t WS_KF   = 350 * MiB;
constexpr size_t WS_MIX  = 382 * MiB;
constexpr size_t WS_HH   = 96 * MiB;
constexpr size_t WS_ACT  = 272 * MiB;
constexpr size_t WS_BAR  = 478 * MiB;
constexpr size_t WS_CNT  = 478 * MiB + 16384;
constexpr size_t WS_XG   = 478 * MiB + 65536;
constexpr size_t WS_END  = 478 * MiB + 65536 + 2 * MiB;

__device__ __forceinline__ unsigned pk2(float lo, float hi) { unsigned r; asm volatile("v_cvt_pk_bf16_f32 %0, %1, %2" : "=v"(r) : "v"(lo), "v"(hi)); return r; }
__device__ __forceinline__ float bf2f(bf16_t v) { return __uint_as_float((unsigned)v << 16); }
__device__ __forceinline__ float lo2f(unsigned v) { return __uint_as_float(v << 16); }
__device__ __forceinline__ float hi2f(unsigned v) { return __uint_as_float(v & 0xffff0000u); }
#define LDS_WAIT() asm volatile("s_waitcnt lgkmcnt(0)" ::: "memory")
__device__ __forceinline__ float xsum16(float v) { const auto r_ = __builtin_amdgcn_permlane16_swap(__float_as_uint(v), __float_as_uint(v), false, false); return __uint_as_float(r_[0]) + __uint_as_float(r_[1]); }
__device__ __forceinline__ float xsum32(float v) { const auto r_ = __builtin_amdgcn_permlane32_swap(__float_as_uint(v), __float_as_uint(v), false, false); return __uint_as_float(r_[0]) + __uint_as_float(r_[1]); }
__device__ __forceinline__ float wave_allsum(float v, int lane) {
#pragma unroll
    for (int o = 1; o < 16; o <<= 1) v += __int_as_float(__builtin_amdgcn_ds_bpermute((lane ^ o) << 2, __float_as_int(v)));
    return xsum32(xsum16(v));
}

#ifndef FFT_HOST
#define FFT_FN __device__ __forceinline__
#define FFT_SYNC() __syncthreads()
typedef float cplx __attribute__((ext_vector_type(2)));
typedef LAS cplx* fftbuf_t;
FFT_FN float cos2pi(float r) { return __builtin_amdgcn_cosf(r); }
FFT_FN float sin2pi(float r) { return __builtin_amdgcn_sinf(r); }
#endif
FFT_FN cplx mk2(float x, float y) { cplx r; r.x = x; r.y = y; return r; }
FFT_FN cplx cadd(cplx a, cplx b) { return mk2(a.x + b.x, a.y + b.y); }
FFT_FN cplx csub(cplx a, cplx b) { return mk2(a.x - b.x, a.y - b.y); }
FFT_FN cplx cmul(cplx a, cplx b) { return mk2(a.x * b.x - a.y * b.y, a.x * b.y + a.y * b.x); }
template <bool INV> FFT_FN cplx muli(cplx a) { return INV ? mk2(-a.y, a.x) : mk2(a.y, -a.x); }
FFT_FN int padi(int i) { return i + (i >> 3); }

template <bool INV> FFT_FN void dft8(cplx (&v)[8]) {
    const float R = 0.70710678118654752f;
    const cplx a0 = cadd(v[0], v[4]), a1 = csub(v[0], v[4]), a2 = cadd(v[2], v[6]), a3 = muli<INV>(csub(v[2], v[6]));
    const cplx a4 = cadd(v[1], v[5]), a5 = csub(v[1], v[5]), a6 = cadd(v[3], v[7]), a7 = muli<INV>(csub(v[3], v[7]));
    const cplx b0 = cadd(a0, a2), b2 = csub(a0, a2), b1 = cadd(a1, a3), b3 = csub(a1, a3);
    const cplx b4 = cadd(a4, a6), b6 = muli<INV>(csub(a4, a6));
    const cplx t5 = cadd(a5, a7), t7 = csub(a5, a7);
    cplx b5, b7;
    if (!INV) { b5 = mk2((t5.x + t5.y) * R, (t5.y - t5.x) * R); b7 = mk2((t7.y - t7.x) * R, -(t7.x + t7.y) * R); }
    else      { b5 = mk2((t5.x - t5.y) * R, (t5.x + t5.y) * R); b7 = mk2(-(t7.x + t7.y) * R, (t7.x - t7.y) * R); }
    v[0] = cadd(b0, b4); v[4] = csub(b0, b4); v[1] = cadd(b1, b5); v[5] = csub(b1, b5);
    v[2] = cadd(b2, b6); v[6] = csub(b2, b6); v[3] = cadd(b3, b7); v[7] = csub(b3, b7);
}
template <int S, bool INV> FFT_FN void twid(cplx (&v)[8], int tid) {
    if (S > 1) {
        const int j = tid % S; const float rev = (float)j * (1.0f / (8.0f * S));
        const float c = cos2pi(rev), s = sin2pi(rev);
        const cplx w1 = mk2(c, INV ? s : -s);
        const cplx w2 = cmul(w1, w1), w3 = cmul(w2, w1), w4 = cmul(w2, w2), w5 = cmul(w4, w1), w6 = cmul(w4, w2), w7 = cmul(w4, w3);
        v[1] = cmul(v[1], w1); v[2] = cmul(v[2], w2); v[3] = cmul(v[3], w3); v[4] = cmul(v[4], w4);
        v[5] = cmul(v[5], w5); v[6] = cmul(v[6], w6); v[7] = cmul(v[7], w7);
    }
}
template <int S> FFT_FN void ld8(fftbuf_t X, int tid, cplx (&v)[8]) {
    const int base = (tid / S) * 8 * S + (tid % S);
#pragma unroll
    for (int k = 0; k < 8; ++k) v[k] = X[padi(base + S * k)];
}
template <int S> FFT_FN void st8(fftbuf_t X, int tid, const cplx (&v)[8]) {
    const int base = (tid / S) * 8 * S + (tid % S);
#pragma unroll
    for (int k = 0; k < 8; ++k) X[padi(base + S * k)] = v[k];
}
#ifndef FFT_HOST
template <int S> FFT_FN void twid_fill(fftbuf_t TW, int tid) {
    constexpr int P = (S == 512) ? 0 : (S == 64) ? 1 : 2;
    const int j = tid % S; const float rev = (float)j * (1.0f / (8.0f * S));
    const cplx w1 = mk2(cos2pi(rev), -sin2pi(rev)), w2 = cmul(w1, w1), w4 = cmul(w2, w2);
    TW[(3 * P + 0) * 512 + tid] = w1; TW[(3 * P + 1) * 512 + tid] = w2; TW[(3 * P + 2) * 512 + tid] = w4;
}
template <int S, bool INV> FFT_FN void twidL(cplx (&v)[8], fftbuf_t TW, int tid) {
    constexpr int P = (S == 512) ? 0 : (S == 64) ? 1 : 2;
    cplx w1 = TW[(3 * P + 0) * 512 + tid], w2 = TW[(3 * P + 1) * 512 + tid], w4 = TW[(3 * P + 2) * 512 + tid];
    if (INV) { w1.y = -w1.y; w2.y = -w2.y; w4.y = -w4.y; }
    const cplx w3 = cmul(w2, w1), w5 = cmul(w4, w1), w6 = cmul(w4, w2), w7 = cmul(w4, w3);
    v[1] = cmul(v[1], w1); v[2] = cmul(v[2], w2); v[3] = cmul(v[3], w3); v[4] = cmul(v[4], w4);
    v[5] = cmul(v[5], w5); v[6] = cmul(v[6], w6); v[7] = cmul(v[7], w7);
}
FFT_FN void fft_fwdL(fftbuf_t X, fftbuf_t TW, int tid, cplx (&v)[8]) {
    dft8<false>(v); twidL<512, false>(v, TW, tid); st8<512>(X, tid, v); FFT_SYNC();
    ld8<64>(X, tid, v); dft8<false>(v); twidL<64, false>(v, TW, tid); st8<64>(X, tid, v); FFT_SYNC();
    ld8<8>(X, tid, v); dft8<false>(v); twidL<8, false>(v, TW, tid); st8<8>(X, tid, v); FFT_SYNC();
    ld8<1>(X, tid, v); dft8<false>(v);
}
FFT_FN void fft_invL(fftbuf_t X, fftbuf_t TW, int tid, cplx (&v)[8]) {
    dft8<true>(v); st8<1>(X, tid, v); FFT_SYNC();
    ld8<8>(X, tid, v); twidL<8, true>(v, TW, tid); dft8<true>(v); st8<8>(X, tid, v); FFT_SYNC();
    ld8<64>(X, tid, v); twidL<64, true>(v, TW, tid); dft8<true>(v); st8<64>(X, tid, v); FFT_SYNC();
    ld8<512>(X, tid, v); twidL<512, true>(v, TW, tid); dft8<true>(v);
}
FFT_FN void fft_fwd(fftbuf_t X, int tid, cplx (&v)[8]) {
    dft8<false>(v); twid<512, false>(v, tid); st8<512>(X, tid, v); FFT_SYNC();
    ld8<64>(X, tid, v); dft8<false>(v); twid<64, false>(v, tid); st8<64>(X, tid, v); FFT_SYNC();
    ld8<8>(X, tid, v); dft8<false>(v); twid<8, false>(v, tid); st8<8>(X, tid, v); FFT_SYNC();
    ld8<1>(X, tid, v); dft8<false>(v);
}
FFT_FN void fft_inv(fftbuf_t X, int tid, cplx (&v)[8]) {
    dft8<true>(v); st8<1>(X, tid, v); FFT_SYNC();
    ld8<8>(X, tid, v); twid<8, true>(v, tid); dft8<true>(v); st8<8>(X, tid, v); FFT_SYNC();
    ld8<64>(X, tid, v); twid<64, true>(v, tid); dft8<true>(v); st8<64>(X, tid, v); FFT_SYNC();
    ld8<512>(X, tid, v); twid<512, true>(v, tid); dft8<true>(v);
}
#endif

struct OneUnit { int pm, pn; bool on;
    __device__ __forceinline__ bool next(int i, pg8::Unit& u) const { if (!on || i > 0) return false; u.pm = pm; u.pn = pn; return true; }
    __device__ __forceinline__ void a_ready(const pg8::Unit&) const {}
    __device__ __forceinline__ void done(const pg8::Unit&) const {}
    __device__ __forceinline__ long a_off(const pg8::Unit& u, size_t tstep) const { return (long)((size_t)u.pm * tstep); }
    __device__ __forceinline__ int lda(int K) const { return K; }
    __device__ __forceinline__ size_t kstep_a() const { return 128; } };

struct EpiB {
    static constexpr bool PERM = true, AFTER_DRAIN = false;
    bf16_t* O; int ldc;
    __device__ __forceinline__ void operator()(const f32x4 (&acc)[2][2][4][2], const pg8::Unit& u, int wr, int wc, int fr, int fq) const {
        const int row0 = u.pm * 256 + wr * 64 + fr, col0 = u.pn * 256 + wc * 32 + 8 * fq;
#pragma unroll
        for (int ai = 0; ai < 2; ++ai)
#pragma unroll
            for (int m = 0; m < 4; ++m) { bf16_t* rowp = O + (size_t)(row0 + ai * 128 + m * 16) * ldc + col0;
#pragma unroll
                for (int bj = 0; bj < 2; ++bj) { const f32x4 v0 = acc[ai][bj][m][0], v1 = acc[ai][bj][m][1];
                    u32x4 w; w.x = pk2(v0[0], v0[1]); w.y = pk2(v0[2], v0[3]); w.z = pk2(v1[0], v1[1]); w.w = pk2(v1[2], v1[3]);
                    *(u32x4*)(rowp + bj * 128) = w; } }
    }
};
struct EpiRope {
    static constexpr bool PERM = true, AFTER_DRAIN = false;
    bf16_t* O; const float2* rope;
    __device__ __forceinline__ void operator()(const f32x4 (&acc)[2][2][4][2], const pg8::Unit& u, int wr, int wc, int fr, int fq) const {
        const int row0 = u.pm * 256 + wr * 64 + fr, col0 = u.pn * 256 + wc * 32 + 8 * fq;
        const bool rot = u.pn < 4;
#pragma unroll
        for (int ai = 0; ai < 2; ++ai)
#pragma unroll
            for (int m = 0; m < 4; ++m) { const int row = row0 + ai * 128 + m * 16; bf16_t* rowp = O + (size_t)row * MIXW + col0;
#pragma unroll
                for (int bj = 0; bj < 2; ++bj) { f32x4 v0 = acc[ai][bj][m][0], v1 = acc[ai][bj][m][1];
                    if (rot) { const int pos = row & (SEQ - 1), i0 = ((col0 + bj * 128) & 63) >> 1;
                        const f32x4* rp = (const f32x4*)(rope + pos * 32 + i0); const f32x4 r0 = rp[0], r1 = rp[1];
                        f32x4 o0, o1;
                        o0[0] = v0[0] * r0[0] - v0[1] * r0[1]; o0[1] = v0[1] * r0[0] + v0[0] * r0[1];
                        o0[2] = v0[2] * r0[2] - v0[3] * r0[3]; o0[3] = v0[3] * r0[2] + v0[2] * r0[3];
                        o1[0] = v1[0] * r1[0] - v1[1] * r1[1]; o1[1] = v1[1] * r1[0] + v1[0] * r1[1];
                        o1[2] = v1[2] * r1[2] - v1[3] * r1[3]; o1[3] = v1[3] * r1[2] + v1[2] * r1[3];
                        v0 = o0; v1 = o1; }
                    u32x4 w; w.x = pk2(v0[0], v0[1]); w.y = pk2(v0[2], v0[3]); w.z = pk2(v1[0], v1[1]); w.w = pk2(v1[2], v1[3]);
                    *(u32x4*)(rowp + bj * 128) = w; } }
    }
};
constexpr int XCH_OFF = 131072 + 1024;
__device__ __forceinline__ void stat_put(LAS cplx* ST, int rowl, int wc, int fq, float s1, float s2, bool first) {
    s1 = xsum32(xsum16(s1)); s2 = xsum32(xsum16(s2));
    if (fq == 0) { LAS cplx* p = ST + rowl * 4 + wc; cplx v; v.x = s1; v.y = s2; if (!first) { const cplx o = *p; v.x += o.x; v.y += o.y; } *p = v; }
}
struct EpiRes {
    static constexpr bool PERM = false, AFTER_DRAIN = false;
    const float* X; float* O; LAS unsigned char* lds; mutable int ecnt;
    __device__ __forceinline__ void operator()(const f32x4 (&acc)[2][2][4][2], const pg8::Unit& u, int wr, int wc, int fr, int fq) const {
        const int row0 = u.pm * 256 + wr * 64 + fr, col0 = u.pn * 256 + wc * 32 + 4 * fq;
        LAS cplx* ST = (LAS cplx*)(lds + XCH_OFF) + (ecnt & 1) * 1024; const bool first = true; ++ecnt;
#pragma unroll
        for (int ai = 0; ai < 2; ++ai) {
            f32x4 xv[4][2][2];
#pragma unroll
            for (int m = 0; m < 4; ++m)
#pragma unroll
                for (int bj = 0; bj < 2; ++bj)
#pragma unroll
                    for (int n = 0; n < 2; ++n) xv[m][bj][n] = *(const f32x4*)(X + (size_t)(row0 + ai * 128 + m * 16) * DM + col0 + bj * 128 + 16 * n);
            asm volatile("" ::: "memory");
#pragma unroll
            for (int m = 0; m < 4; ++m) { float s1 = 0.f, s2 = 0.f;
#pragma unroll
                for (int bj = 0; bj < 2; ++bj)
#pragma unroll
                    for (int n = 0; n < 2; ++n) { const f32x4 o = acc[ai][bj][m][n] + xv[m][bj][n] * ALPHA;
                        *(f32x4*)(O + (size_t)(row0 + ai * 128 + m * 16) * DM + col0 + bj * 128 + 16 * n) = o;
                        s1 += (o[0] + o[1]) + (o[2] + o[3]); s2 += (o[0] * o[0] + o[1] * o[1]) + (o[2] * o[2] + o[3] * o[3]); }
                stat_put(ST, ai * 128 + wr * 64 + m * 16 + fr, wc, fq, s1, s2, first); }
        }
    }
};
struct EpiRes2 {
    static constexpr bool PERM = false, AFTER_DRAIN = false;
    const float* R; float* O; const float2* stat; const float* g; const float* b; LAS unsigned char* lds; mutable int ecnt;
    __device__ __forceinline__ void operator()(const f32x4 (&acc)[2][2][4][2], const pg8::Unit& u, int wr, int wc, int fr, int fq) const {
        const int row0 = u.pm * 256 + wr * 64 + fr, col0 = u.pn * 256 + wc * 32 + 4 * fq;
        LAS cplx* ST = (LAS cplx*)(lds + XCH_OFF) + (ecnt & 1) * 1024; const bool first = true; ++ecnt;
#pragma unroll
        for (int ai = 0; ai < 2; ++ai)
#pragma unroll
            for (int bj = 0; bj < 2; ++bj) {
                f32x4 rv[4][2], gv[2], bv[2]; float2 st[4];
#pragma unroll
                for (int m = 0; m < 4; ++m) { const int row = row0 + ai * 128 + m * 16; st[m] = stat[row];
#pragma unroll
                    for (int n = 0; n < 2; ++n) rv[m][n] = *(const f32x4*)(R + (size_t)row * DM + col0 + bj * 128 + 16 * n); }
#pragma unroll
                for (int n = 0; n < 2; ++n) { gv[n] = *(const f32x4*)(g + col0 + bj * 128 + 16 * n); bv[n] = *(const f32x4*)(b + col0 + bj * 128 + 16 * n); }
                asm volatile("" ::: "memory");
#pragma unroll
                for (int m = 0; m < 4; ++m) { float s1 = 0.f, s2 = 0.f;
#pragma unroll
                    for (int n = 0; n < 2; ++n) { const f32x4 x1 = (rv[m][n] - st[m].x) * st[m].y * gv[n] + bv[n]; const f32x4 o = acc[ai][bj][m][n] + x1 * ALPHA;
                        *(f32x4*)(O + (size_t)(row0 + ai * 128 + m * 16) * DM + col0 + bj * 128 + 16 * n) = o;
                        s1 += (o[0] + o[1]) + (o[2] + o[3]); s2 += (o[0] * o[0] + o[1] * o[1]) + (o[2] * o[2] + o[3] * o[3]); }
                    stat_put(ST, ai * 128 + wr * 64 + m * 16 + fr, wc, fq, s1, s2, first && bj == 0); }
            }
    }
};
template <int MODE> struct EpiLn {
    static constexpr bool PERM = false, AFTER_DRAIN = false;
    const float* RES; float* OF; bf16_t* OB; const float* g; const float* b; unsigned long long* XG; unsigned* CNT; LAS unsigned char* ldsp;
    __device__ __forceinline__ void operator()(const f32x4 (&acc)[2][2][4][2], const pg8::Unit& u, int wr, int wc, int fr, int fq) const {
        const int t_ = threadIdx.x; fused(const_cast<f32x4 (&)[2][2][4][2]>(acc), u, wr, wc, fr, fq, ldsp, __builtin_amdgcn_readfirstlane(t_ >> 6), t_ & 63); }
    __device__ __forceinline__ void fused(f32x4 (&acc)[2][2][4][2], const pg8::Unit& u, int wr, int wc, int fr, int fq, LAS unsigned char* lds, int wid, int lane) const {
        const int tid = wid * 64 + lane, row0 = u.pm * 256 + wr * 64 + fr, col0 = u.pn * 256 + wc * 32 + 4 * fq;
        LAS cplx* ST = (LAS cplx*)(lds + XCH_OFF); LAS cplx* MR = (LAS cplx*)(lds + XCH_OFF + 8192);
#pragma unroll
        for (int ai = 0; ai < 2; ++ai) {
            float s1[4], s2[4];
#pragma unroll
            for (int m = 0; m < 4; ++m) { s1[m] = 0.f; s2[m] = 0.f; }
#pragma unroll
            for (int bj = 0; bj < 2; ++bj)
#pragma unroll
                for (int n = 0; n < 2; ++n) {
                    f32x4 xv[4];
#pragma unroll
                    for (int m = 0; m < 4; ++m) xv[m] = *(const f32x4*)(RES + (size_t)(row0 + ai * 128 + m * 16) * DM + col0 + bj * 128 + 16 * n);
                    asm volatile("" ::: "memory");
#pragma unroll
                    for (int m = 0; m < 4; ++m) { const f32x4 o = acc[ai][bj][m][n] + xv[m] * ALPHA; acc[ai][bj][m][n] = o;
                        s1[m] += (o[0] + o[1]) + (o[2] + o[3]); s2[m] += (o[0] * o[0] + o[1] * o[1]) + (o[2] * o[2] + o[3] * o[3]); }
                }
#pragma unroll
            for (int m = 0; m < 4; ++m) stat_put(ST, ai * 128 + wr * 64 + m * 16 + fr, wc, fq, s1[m], s2[m], true);
        }
        asm volatile("s_waitcnt lgkmcnt(0)" ::: "memory"); __syncthreads();
        float m1 = 0.f, m2 = 0.f;
        if (tid < 256) { const cplx a0 = ST[tid * 4 + 0], a1 = ST[tid * 4 + 1], a2 = ST[tid * 4 + 2], a3 = ST[tid * 4 + 3];
            m1 = (a0.x + a1.x) + (a2.x + a3.x); m2 = (a0.y + a1.y) + (a2.y + a3.y);
            __hip_atomic_store(XG + (size_t)(u.pm * 4 + u.pn) * 256 + tid, ((unsigned long long)__float_as_uint(m2) << 32) | __float_as_uint(m1), __ATOMIC_RELAXED, __HIP_MEMORY_SCOPE_AGENT); }
        asm volatile("s_waitcnt vmcnt(0)" ::: "memory");
        __syncthreads();
        if (tid == 0) {
            (void)__hip_atomic_fetch_add(CNT + u.pm * 16, 1u, __ATOMIC_RELAXED, __HIP_MEMORY_SCOPE_AGENT);
            unsigned sp = 0;
            while (__hip_atomic_load(CNT + u.pm * 16, __ATOMIC_RELAXED, __HIP_MEMORY_SCOPE_AGENT) < 4u) { __builtin_amdgcn_s_sleep(1); if (++sp > (1u << 22)) break; }
            __builtin_amdgcn_fence(__ATOMIC_ACQUIRE, "agent");
            asm volatile("s_waitcnt vmcnt(0)" ::: "memory");
        }
        __syncthreads();
        if (tid < 256) { float t1 = m1, t2 = m2;
#pragma unroll
            for (int jj = 1; jj < 4; ++jj) { const unsigned long long w = __hip_atomic_load(XG + (size_t)(u.pm * 4 + ((u.pn + jj) & 3)) * 256 + tid, __ATOMIC_RELAXED, __HIP_MEMORY_SCOPE_AGENT);
                t1 += __uint_as_float((unsigned)w); t2 += __uint_as_float((unsigned)(w >> 32)); }
            const float mean = t1 * (1.0f / DM), var = fmaxf(t2 * (1.0f / DM) - mean * mean, 0.f);
            cplx mr; mr.x = mean; mr.y = rsqrtf(var + LN_EPS); MR[tid] = mr; }
        __syncthreads();
#pragma unroll
        for (int bj = 0; bj < 2; ++bj)
#pragma unroll
            for (int n = 0; n < 2; ++n) { const int c = col0 + bj * 128 + 16 * n; const f32x4 gv = *(const f32x4*)(g + c), bv = *(const f32x4*)(b + c);
#pragma unroll
                for (int ai = 0; ai < 2; ++ai)
#pragma unroll
                    for (int m = 0; m < 4; ++m) { const int rl = ai * 128 + wr * 64 + m * 16 + fr; const cplx mr = MR[rl];
                        const f32x4 y = (acc[ai][bj][m][n] - mr.x) * mr.y * gv + bv; const size_t off = (size_t)(u.pm * 256 + rl) * DM + c;
                        *(f32x4*)(OF + off) = y;
                        if (MODE == 1) { u32x2 w; w.x = pk2(y[0], y[1]); w.y = pk2(y[2], y[3]); *(u32x2*)(OB + off) = w; } } }
    }
};
struct QuadTwo { int q, j;
    __device__ __forceinline__ bool next(int i, pg8::Unit& u) const { if (i > 1) return false; u.pm = 2 * q + i; u.pn = j; return true; }
    __device__ __forceinline__ void a_ready(const pg8::Unit&) const {}
    __device__ __forceinline__ void done(const pg8::Unit&) const {}
    __device__ __forceinline__ long a_off(const pg8::Unit& u, size_t tstep) const { return (long)((size_t)u.pm * tstep); }
    __device__ __forceinline__ int lda(int K) const { return K; }
    __device__ __forceinline__ size_t kstep_a() const { return 128; } };
struct QuadTwoKb : QuadTwo {
    __device__ __forceinline__ int lda(int) const { return 64; }
    __device__ __forceinline__ size_t kstep_a() const { return (size_t)NT * 64 * 2; } };
struct OneUnitKb : OneUnit {
    __device__ __forceinline__ int lda(int) const { return 64; }
    __device__ __forceinline__ size_t kstep_a() const { return (size_t)NT * 64 * 2; }
};
struct PairOrder : pg8::StaticOrder {
    bool pair;
    __device__ __forceinline__ static int vcu_of(int c) { return (c & 7) * 32 + (c >> 3); }
    __device__ __forceinline__ bool next(int i, pg8::Unit& u) const {
        if (!pair) return pg8::StaticOrder::next(i, u);
        if (i > 1) return false;
        const int v = vcu_of(c); u.pm = 2 * (v >> 2) + i; u.pn = v & 3; return true; }
};
struct KbOrder : pg8::StaticOrder {
    __device__ __forceinline__ int lda(int) const { return 64; }
    __device__ __forceinline__ size_t kstep_a() const { return (size_t)NT * 64 * 2; }
};
struct PairKb : PairOrder {
    __device__ __forceinline__ int lda(int) const { return 64; }
    __device__ __forceinline__ size_t kstep_a() const { return (size_t)NT * 64 * 2; }
};
struct RevOrder : pg8::StaticOrder {
    __device__ __forceinline__ bool next(int i, pg8::Unit& u) const { const int rounds = (nwg + G - 1) / G; if (i >= rounds) return false; return pg8::StaticOrder::next(rounds - 1 - i, u); }
};
constexpr int CWL_OFF = 131072 + 1024 + 8192;
struct FfnOrder : pg8::StaticOrder {
    const float* cw; const float* cb; LAS unsigned char* lds; mutable int cnt;
    __device__ __forceinline__ long a_off(const pg8::Unit& u, size_t) const { return ((long)u.pm * 254 - 1) * (long)(DM * 2); }
    __device__ __forceinline__ void a_ready(const pg8::Unit& u) const {
        const int tid = threadIdx.x, w = __builtin_amdgcn_readfirstlane(tid >> 6), lane = tid & 63, buf = cnt & 1; ++cnt;
        const float* src = (w < 3) ? cw + (size_t)w * (2 * DFF) : (w < 6) ? cw + (size_t)(w - 3) * (2 * DFF) + DFF : (w == 6) ? cb : cb + DFF;
        src += u.pn * 128 + lane * 4;
        if (lane < 32) __builtin_amdgcn_global_load_lds((const unsigned*)src, (LAS unsigned*)(lds + CWL_OFF + buf * 4096 + w * 512), 16, 0, 0);
    }
};
constexpr int FFN_MT = 130;
__device__ __forceinline__ float dpp_ror1(float v)  { return __int_as_float(__builtin_amdgcn_update_dpp(0, __float_as_int(v), 0x121, 0xF, 0xF, false)); }
__device__ __forceinline__ float dpp_ror15(float v) { return __int_as_float(__builtin_amdgcn_update_dpp(0, __float_as_int(v), 0x12F, 0xF, 0xF, false)); }
struct EpiFfn {
    static constexpr bool PERM = true, AFTER_DRAIN = false;
    bf16_t* ACT; LAS unsigned char* lds; mutable int ecnt;
    __device__ __forceinline__ void operator()(const f32x4 (&acc)[2][2][4][2], const pg8::Unit& u, int wr, int wc, int fr, int fq) const {
        LAS float* XC = (LAS float*)(lds + XCH_OFF);
        const LAS float* WL = (const LAS float*)(lds + CWL_OFF + (ecnt & 1) * 4096); ++ecnt;
        const int colw = wc * 32 + 8 * fq;
        if (fr == 0 || fr == 15) {
            const int edge = (fr == 15) ? 1 : 0, m = (fr == 15) ? 3 : 0;
#pragma unroll
            for (int ai = 0; ai < 2; ++ai)
#pragma unroll
                for (int bj = 0; bj < 2; ++bj)
#pragma unroll
                    for (int n = 0; n < 2; ++n) { const f32x4 v = (m == 0) ? acc[ai][bj][0][n] : acc[ai][bj][3][n];
                        *(LAS f32x4*)(XC + ((ai * 2 + wr) * 2 + edge) * 256 + bj * 128 + colw + 4 * n) = v; }
        }
        asm volatile("s_waitcnt lgkmcnt(0)" ::: "memory"); __builtin_amdgcn_s_barrier(); asm volatile("" ::: "memory");
        const int slot0 = wr * 64 + fr, row_base = u.pm * 254 - 1;
#pragma unroll
        for (int bj = 0; bj < 2; ++bj) {
            const int gc = (u.pn * 256 + bj * 128 + colw) >> 1;
            const LAS float* wl = WL + ((bj * 128 + colw) >> 1);
            f32x4 wg[3], wu[3];
#pragma unroll
            for (int j = 0; j < 3; ++j) { wg[j] = *(const LAS f32x4*)(wl + j * 128); wu[j] = *(const LAS f32x4*)(wl + (3 + j) * 128); }
            const f32x4 bg = *(const LAS f32x4*)(wl + 6 * 128), bu = *(const LAS f32x4*)(wl + 7 * 128);
#pragma unroll
            for (int ai = 0; ai < 2; ++ai) {
                const int gidx = ai * 2 + wr;
                f32x4 pe[2], ne[2];
#pragma unroll
                for (int n = 0; n < 2; ++n) {
                    pe[n] = (gidx > 0) ? *(const LAS f32x4*)(XC + (((gidx - 1) * 2) + 1) * 256 + bj * 128 + colw + 4 * n) : (f32x4){0.f, 0.f, 0.f, 0.f};
                    ne[n] = (gidx < 3) ? *(const LAS f32x4*)(XC + (((gidx + 1) * 2) + 0) * 256 + bj * 128 + colw + 4 * n) : (f32x4){0.f, 0.f, 0.f, 0.f}; }
#pragma unroll
                for (int m = 0; m < 4; ++m) {
                    const int slot = ai * 128 + slot0 + m * 16, row = row_base + slot, t = row & (SEQ - 1);
                    f32x4 hv[2];
#pragma unroll
                    for (int n = 0; n < 2; ++n) {
                        const f32x4 cur = acc[ai][bj][m][n], prv = acc[ai][bj][m == 0 ? 0 : m - 1][n], nxt = acc[ai][bj][m == 3 ? 3 : m + 1][n];
                        f32x4 up, dn;
#pragma unroll
                        for (int e = 0; e < 4; ++e) { up[e] = dpp_ror1(fr == 15 ? prv[e] : cur[e]); dn[e] = dpp_ror15(fr == 0 ? nxt[e] : cur[e]); }
                        if (m == 0 && fr == 0) up = pe[n];
                        if (m == 3 && fr == 15) dn = ne[n];
                        if (t == 0) up = (f32x4){0.f, 0.f, 0.f, 0.f};
                        if (t == SEQ - 1) dn = (f32x4){0.f, 0.f, 0.f, 0.f};
                        const f32x4 w0 = n ? wu[0] : wg[0], w1 = n ? wu[1] : wg[1], w2 = n ? wu[2] : wg[2], bb = n ? bu : bg;
                        hv[n] = w0 * up + w1 * cur + w2 * dn + bb; }
                    if (slot >= 1 && slot <= 254 && row < NT) {
                        float o[4];
#pragma unroll
                        for (int e = 0; e < 4; ++e) { const float g = hv[0][e]; o[e] = g * __builtin_amdgcn_rcpf(1.0f + __expf(-g)) * hv[1][e]; }
                        u32x2 w; w.x = pk2(o[0], o[1]); w.y = pk2(o[2], o[3]);
                        *(u32x2*)(ACT + ((size_t)(gc >> 6) * NT + row) * 64 + (gc & 63)) = w; }
                }
            }
        }
    }
};

__device__ __forceinline__ int win_row(int n) {
    if (n < 1536) return 1536 + n;
    if (n < 2560) { const int q = n - 1536, blk = q >> 6, d = q & 63; return blk * 64 + 2 * (d & 31) + (d >> 5); }
    if (n < 3072) return 512 + n;
    return n - 2048;
}
template <int MODE> __device__ __forceinline__ void p0_transpose_item(const float* W, int K, int N, bf16_t* WT, LAS float* scr, int item, int lane) {
    const int nblk = N / 32, kb = item / nblk, nb = item % nblk, k0 = 64 * kb, n0 = 32 * nb;
    f32x4 q[8];
#pragma unroll
    for (int i = 0; i < 8; ++i) q[i] = *(const f32x4*)(W + (size_t)(k0 + 8 * i + (lane >> 3)) * N + n0 + 4 * (lane & 7));
#pragma unroll
    for (int i = 0; i < 8; ++i) { LAS float* d = scr + (8 * i + (lane >> 3)) * 33 + 4 * (lane & 7); d[0] = q[i][0]; d[1] = q[i][1]; d[2] = q[i][2]; d[3] = q[i][3]; }
    LDS_WAIT(); asm volatile("" ::: "memory");
    const int c = lane & 7;
#pragma unroll
    for (int j = 0; j < 4; ++j) { const int n = (lane >> 3) + 8 * j; const LAS float* s = scr + (8 * c) * 33 + n;
        u32x4 o; o.x = pk2(s[0 * 33], s[1 * 33]); o.y = pk2(s[2 * 33], s[3 * 33]); o.z = pk2(s[4 * 33], s[5 * 33]); o.w = pk2(s[6 * 33], s[7 * 33]);
        const int nn = n0 + n; const int dr = (MODE == 1) ? win_row(nn) : (MODE == 2) ? ((nn < DFF) ? ((nn >> 2) * 8 + (nn & 3)) : (((nn - DFF) >> 2) * 8 + 4 + ((nn - DFF) & 3))) : nn;
        *(u32x4*)(WT + (size_t)dr * K + k0 + 8 * c) = o; }
    LDS_WAIT(); asm volatile("" ::: "memory");
}
__device__ __forceinline__ void cvt_rows(const float* src, bf16_t* dst, size_t n8, int gw, int ngw, int lane) {
    const size_t stride = (size_t)ngw * 64;
    for (size_t i = (size_t)gw * 64 + lane; i < n8; i += 4 * stride) {
        f32x4 a[4], c[4];
#pragma unroll
        for (int u = 0; u < 4; ++u) { const size_t k = i + u * stride; if (k < n8) { a[u] = ((const f32x4*)src)[2 * k]; c[u] = ((const f32x4*)src)[2 * k + 1]; } }
#pragma unroll
        for (int u = 0; u < 4; ++u) { const size_t k = i + u * stride; if (k < n8) {
            u32x4 w; w.x = pk2(a[u][0], a[u][1]); w.y = pk2(a[u][2], a[u][3]); w.z = pk2(c[u][0], c[u][1]); w.w = pk2(c[u][2], c[u][3]);
            ((u32x4*)dst)[k] = w; } }
    }
}
__device__ __forceinline__ void p0_filter_item(const LAS float* w1, const float* b1, const float* fq, const LAS float* w2, const float* b2, const float* w3, float* HTD, int item, int lane) {
    const int t0 = 2 * (item >> 2), ih = item & 3; float h2v[2], tl[2];
    const float fql = fq[lane], b1l = b1[lane], b2l = b2[lane];
#pragma unroll
    for (int tt = 0; tt < 2; ++tt) { const int t = t0 + tt; tl[tt] = (float)t * (1.0f / 2047.0f);
        const float w = 6.283185307179586f * (float)t / 2048.0f;
        float zk = 0.f;
        if (lane == 0) zk = tl[tt];
        else if (lane <= 16) { const float fr = 1e-4f + (float)(lane - 1) * ((15.0f - 1e-4f) / 15.0f); zk = cosf(fr * w); }
        else if (lane <= 32) { const float fr = 1e-4f + (float)(lane - 17) * ((15.0f - 1e-4f) / 15.0f); zk = -sinf(fr * w); }
        float a = b1l;
#pragma unroll 11
        for (int k = 0; k < 33; ++k) a += __shfl(zk, k) * w1[k * 64 + lane];
        const float h1 = sinf(fql * a);
        float a2 = b2l;
#pragma unroll 16
        for (int k = 0; k < 64; ++k) a2 += __shfl(h1, k) * w2[k * 64 + lane];
        h2v[tt] = sinf(fql * a2); }
    const float dmin = -15.350567286626973f, dmax = -3.0701134573253946f;
    float acc0[8], acc1[8];
#pragma unroll
    for (int i = 0; i < 8; ++i) { acc0[i] = 0.f; acc1[i] = 0.f; }
#pragma unroll 8
    for (int j = 0; j < 64; ++j) { const float s0 = __shfl(h2v[0], j), s1 = __shfl(h2v[1], j); const float* wr = w3 + (size_t)j * 2048 + ih * 512 + lane;
#pragma unroll
        for (int i = 0; i < 8; ++i) { const float wv = wr[64 * i]; acc0[i] += s0 * wv; acc1[i] += s1 * wv; } }
#pragma unroll
    for (int i = 0; i < 8; ++i) { const int col = ih * 512 + 64 * i + lane, c = col & 511;
        const float delta = fabsf(dmin + (float)c * ((dmax - dmin) / 511.0f));
        float2 o; o.x = acc0[i] * expf(-tl[0] * delta); o.y = acc1[i] * expf(-tl[1] * delta);
        *(float2*)(HTD + (size_t)col * 2048 + t0) = o; }
}
__device__ __forceinline__ void p0_prep(const float* const* in, unsigned char* ws, LAS unsigned char* lds, int tid) {
    const int lane = tid & 63, wave = __builtin_amdgcn_readfirstlane(tid >> 6), gw = blockIdx.x * NWAVE + wave, ngw = gridDim.x * NWAVE;
    LAS float* scr = (LAS float*)(lds + wave * 8704);
    LAS float* W1L = (LAS float*)(lds + 69632); LAS float* W2L = W1L + 33 * 64;
    for (int i = tid; i < 33 * 64; i += NTHR) W1L[i] = in[5][i];
    for (int i = tid; i < 64 * 64; i += NTHR) W2L[i] = in[8][i];
    __syncthreads();
    bf16_t* WALL = (bf16_t*)(ws + WS_WALL);
    constexpr int I_IN = 16 * (INW / 32), I_KV = 16 * 32, I_OUT = 24 * 32, I_UP = 16 * (2 * DFF / 32), I_DN = (DFF / 64) * 32, NIT = I_IN + I_KV + I_OUT + I_UP + I_DN;
    for (int it = gw; it < NIT; it += ngw) { int r = it;
        if (r < I_IN) { p0_transpose_item<1>(in[2], DM, INW, WALL, scr, r, lane); continue; } r -= I_IN;
        if (r < I_KV) { p0_transpose_item<0>(in[14], DM, 1024, (bf16_t*)(ws + WS_WKV), scr, r, lane); continue; } r -= I_KV;
        if (r < I_OUT) { p0_transpose_item<0>(in[15], MIXW, DM, (bf16_t*)(ws + WS_WOUT), scr, r, lane); continue; } r -= I_OUT;
        if (r < I_UP) { p0_transpose_item<2>(in[18], DM, 2 * DFF, (bf16_t*)(ws + WS_WUP), scr, r, lane); continue; } r -= I_UP;
        p0_transpose_item<0>(in[21], DFF, DM, (bf16_t*)(ws + WS_WDN), scr, r, lane); }
    for (int it = ngw - 1 - gw; it < 4096; it += ngw) p0_filter_item(W1L, in[6], in[7], W2L, in[9], in[10], (float*)(ws + WS_HTD), it, lane);
    cvt_rows(in[0], (bf16_t*)(ws + WS_XB), (size_t)NT * DM / 8, gw, ngw, lane);
    cvt_rows(in[1], (bf16_t*)(ws + WS_MEMB), (size_t)NMT * DM / 8, gw, ngw, lane);
    float2* rope = (float2*)(ws + WS_ROPE);
    for (int i = blockIdx.x * NTHR + tid; i < SEQ * 32; i += gridDim.x * NTHR) { const int pos = i >> 5, f = i & 31;
        const float invf = powf(10000.0f, -(float)(2 * f) / 64.0f); const float ang = (float)pos * invf;
        float2 cs; cs.x = cosf(ang); cs.y = sinf(ang); rope[i] = cs; }
}

__device__ __forceinline__ void filter_fft_item(const float* HTD, float2* KF, LAS unsigned char* lds, int item, int tid) {
    const int o = item >> 9, c = item & 511;
    const float* rf = HTD + (size_t)((o * 2 + 0) * 512 + c) * 2048; const float* rb = HTD + (size_t)((o * 2 + 1) * 512 + c) * 2048;
    cplx v[8];
#pragma unroll
    for (int k = 0; k < 4; ++k) v[k] = mk2(rf[tid + 512 * k], 0.f);
    v[4] = mk2(tid == 0 ? 0.f : rb[2048 - tid], 0.f); v[5] = mk2(rb[1536 - tid], 0.f); v[6] = mk2(rb[1024 - tid], 0.f); v[7] = mk2(rb[512 - tid], 0.f);
    fft_fwd((LAS cplx*)lds, tid, v);
    float2* dst = KF + (size_t)(o * 512 + c) * 4096 + 8 * tid;
#pragma unroll
    for (int m = 0; m < 8; m += 2) { f32x4 w; w[0] = v[m].x * (1.f / 4096.f); w[1] = v[m].y * (1.f / 4096.f); w[2] = v[m + 1].x * (1.f / 4096.f); w[3] = v[m + 1].y * (1.f / 4096.f); *(f32x4*)(dst + m) = w; }
    __syncthreads();
}

constexpr int HY_SEG = 2064, HY_STG_OFF = 36864;
__device__ __forceinline__ float conv3s(const LAS bf16_t* seg, int n, float w0, float w1, float w2, float b) {
    return w0 * bf2f(seg[7 + n]) + w1 * bf2f(seg[8 + n]) + w2 * bf2f(seg[9 + n]) + b;
}
__device__ __forceinline__ void hyena_item(const bf16_t* HT, const float2* KF, const float* cw, const float* cb, const float* hb, bf16_t* MIX, LAS unsigned char* lds, int bp, int cgp, int tid0) {
    LAS cplx* X = (LAS cplx*)lds; LAS bf16_t* STG = (LAS bf16_t*)(lds + HY_STG_OFF); LAS cplx* TW = (LAS cplx*)(lds + 65536);
    const int ba = 2 * bp;
    twid_fill<512>(TW, tid0); twid_fill<64>(TW, tid0); twid_fill<8>(TW, tid0);
    u32x4 oacc[8];
#pragma unroll
    for (int i = 0; i < 8; ++i) oacc[i] = (u32x4){0u, 0u, 0u, 0u};
    if (tid0 < 12) { const int sg = tid0 >> 1; STG[sg * HY_SEG + ((tid0 & 1) ? 2056 : 7)] = 0; }
    { const int c = cgp * 8;
#pragma unroll
      for (int i = 0; i < 3; ++i) { const int id = tid0 + 512 * i, sg = id >> 8, ch = id & 255;
          const u32x4 q = *(const u32x4*)(HT + (size_t)((sg >> 1) * 512 + c) * NT + (ba + (sg & 1)) * SEQ + ch * 8);
          *(LAS u32x4*)(STG + sg * HY_SEG + 8 + ch * 8) = q; } }
    __syncthreads();
#pragma unroll 1
    for (int cc = 0; cc < 8; ++cc) {
        const int c = cgp * 8 + cc;
        int tl_ = tid0; asm volatile("" : "+v"(tl_)); const int tid = tl_;
        u32x4 nx[3];
        if (cc < 7) {
#pragma unroll
            for (int i = 0; i < 3; ++i) { const int id = tid + 512 * i, sg = id >> 8, ch = id & 255;
                nx[i] = *(const u32x4*)(HT + (size_t)((sg >> 1) * 512 + c + 1) * NT + (ba + (sg & 1)) * SEQ + ch * 8); } }
        f32x4 kf[4];
        { const f32x4* kp = (const f32x4*)(KF + (size_t)c * 4096 + 8 * tid);
#pragma unroll
          for (int m = 0; m < 4; ++m) kf[m] = kp[m]; }
        cplx v[8]; float va[4], vb[4];
        { const float w0 = cw[c], w1 = cw[1536 + c], w2 = cw[3072 + c], b = cb[c];
#pragma unroll
          for (int k = 0; k < 4; ++k) { const int n = tid + 512 * k; va[k] = conv3s(STG, n, w0, w1, w2, b); vb[k] = conv3s(STG + HY_SEG, n, w0, w1, w2, b); v[k] = mk2(va[k], vb[k]); v[4 + k] = mk2(0.f, 0.f); } }
        fft_fwdL(X, TW, tid, v);
#pragma unroll
        for (int m = 0; m < 8; m += 2) { const f32x4 w = kf[m >> 1]; v[m] = cmul(v[m], mk2(w[0], w[1])); v[m + 1] = cmul(v[m + 1], mk2(w[2], w[3])); }
        { const f32x4* kp = (const f32x4*)(KF + (size_t)(512 + c) * 4096 + 8 * tid);
#pragma unroll
          for (int m = 0; m < 4; ++m) kf[m] = kp[m]; }
        fft_invL(X, TW, tid, v);
        { const float w0 = cw[512 + c], w1 = cw[1536 + 512 + c], w2 = cw[3072 + 512 + c], b = cb[512 + c], hb0 = hb[c];
#pragma unroll
          for (int k = 0; k < 4; ++k) { const int n = tid + 512 * k; const float xa = conv3s(STG + 2 * HY_SEG, n, w0, w1, w2, b), xb = conv3s(STG + 3 * HY_SEG, n, w0, w1, w2, b);
              va[k] = xa * (v[k].x + hb0 * va[k]); vb[k] = xb * (v[k].y + hb0 * vb[k]); v[k] = mk2(va[k], vb[k]); v[4 + k] = mk2(0.f, 0.f); } }
        fft_fwdL(X, TW, tid, v);
#pragma unroll
        for (int m = 0; m < 8; m += 2) { const f32x4 w = kf[m >> 1]; v[m] = cmul(v[m], mk2(w[0], w[1])); v[m + 1] = cmul(v[m + 1], mk2(w[2], w[3])); }
        fft_invL(X, TW, tid, v);
        { const float w0 = cw[1024 + c], w1 = cw[1536 + 1024 + c], w2 = cw[3072 + 1024 + c], b = cb[1024 + c], hb1 = hb[512 + c];
#pragma unroll
          for (int k = 0; k < 4; ++k) { const int n = tid + 512 * k; const float xa = conv3s(STG + 4 * HY_SEG, n, w0, w1, w2, b), xb = conv3s(STG + 5 * HY_SEG, n, w0, w1, w2, b);
              const float oa = xa * (v[k].x + hb1 * va[k]), ob = xb * (v[k].y + hb1 * vb[k]);
              const unsigned pw = pk2(oa, ob);
#pragma unroll
              for (int hh = 0; hh < 2; ++hh) { u32x4& o = oacc[2 * k + hh]; const unsigned nw = hh ? (pw & 0xffff0000u) : (pw << 16);
                  o.x = __builtin_amdgcn_alignbit(o.y, o.x, 16); o.y = __builtin_amdgcn_alignbit(o.z, o.y, 16); o.z = __builtin_amdgcn_alignbit(o.w, o.z, 16); o.w = (o.w >> 16) | nw; } } }
        __syncthreads();
        if (cc < 7) {
#pragma unroll
            for (int i = 0; i < 3; ++i) { const int id = tid + 512 * i, sg = id >> 8, ch = id & 255; *(LAS u32x4*)(STG + sg * HY_SEG + 8 + ch * 8) = nx[i]; } }
        __syncthreads();
    }
    int tw_ = tid0; asm volatile("" : "+v"(tw_)); const int tid = tw_;
#pragma unroll
    for (int k = 0; k < 4; ++k)
#pragma unroll
        for (int hh = 0; hh < 2; ++hh) *(u32x4*)(MIX + (size_t)((ba + hh) * SEQ + tid + 512 * k) * MIXW + cgp * 8) = oacc[2 * k + hh];
}

constexpr int ATT_KP = 272, ATT_VP = 144, ATT_KB = 64 * ATT_KP, ATT_VB = 128 * ATT_VP, ATT_VOFF = 2 * ATT_KB;
__device__ __forceinline__ float half_swap_max(float v) { const auto r_ = __builtin_amdgcn_permlane32_swap(__float_as_uint(v), __float_as_uint(v), false, false); return fmaxf(__uint_as_float(r_[0]), __uint_as_float(r_[1])); }
__device__ __forceinline__ float half_swap_sum(float v) { const auto r_ = __builtin_amdgcn_permlane32_swap(__float_as_uint(v), __float_as_uint(v), false, false); return __uint_as_float(r_[0]) + __uint_as_float(r_[1]); }
__device__ __forceinline__ void att_vput(LAS unsigned char* p, u32x4 q) { u32x2 lo, hi; lo.x = q.x; lo.y = q.y; hi.x = q.z; hi.y = q.w; *(LAS u32x2*)p = lo; *(LAS u32x2*)(p + 16) = hi; }
template <int NC> __device__ __forceinline__ void attn_unit(LAS unsigned char* lds, const bf16_t* Qp, int ldq, const bf16_t* Kp, int ldk, const bf16_t* Vt, int ldv, int nkeys, float sl2,
                                                            bf16_t* Op, int ldo, float lam, const float* subg, int tid) {
    constexpr int NSTEP = (NC == 2) ? 4 : 8;
    const int lane = tid & 63, wave = tid >> 6, r = lane & 31, h = lane >> 5;
    const int qb = (NC == 2) ? (wave & 3) : wave, comp = (NC == 2) ? (wave >> 2) : 0, dbase = comp * 64;
    bf16x8 qf[NSTEP];
#pragma unroll
    for (int st = 0; st < NSTEP; ++st) qf[st] = *(const bf16x8*)(Qp + (size_t)(qb * 32 + r) * ldq + dbase + 16 * st + 8 * h);
    f32x16 o[4];
#pragma unroll
    for (int et = 0; et < 4; ++et)
#pragma unroll
        for (int i = 0; i < 16; ++i) o[et][i] = 0.f;
    float mold = -INFINITY, lsum = 0.f;
    const int kr0 = tid >> 4, kc = tid & 15, vr0 = tid >> 3, vc = tid & 7;
    const bf16_t* kg = Kp + (size_t)kr0 * ldk + kc * 8; const bf16_t* vg = Vt + (size_t)vr0 * ldv + vc * 8;
    const int kl = kr0 * ATT_KP + kc * 16, vl = ATT_VOFF + vr0 * ATT_VP + (vc >> 1) * 32 + (vc & 1) * 8;
    const int nt = nkeys / 64;
    u32x4 pk0, pk1, pv0, pv1;
    pk0 = *(const u32x4*)(kg); pk1 = *(const u32x4*)(kg + (size_t)32 * ldk); pv0 = *(const u32x4*)(vg); pv1 = *(const u32x4*)(vg + (size_t)64 * ldv);
    *(LAS u32x4*)(lds + kl) = pk0; *(LAS u32x4*)(lds + kl + 32 * ATT_KP) = pk1; att_vput(lds + vl, pv0); att_vput(lds + vl + 64 * ATT_VP, pv1);
    __syncthreads();
    for (int it = 0; it < nt; ++it) {
        const int cur = it & 1; const bool more = (it + 1 < nt);
        if (more) { const bf16_t* kg2 = kg + (size_t)(it + 1) * 64 * ldk; const bf16_t* vg2 = vg + (it + 1) * 64;
            pk0 = *(const u32x4*)(kg2); pk1 = *(const u32x4*)(kg2 + (size_t)32 * ldk); pv0 = *(const u32x4*)(vg2); pv1 = *(const u32x4*)(vg2 + (size_t)64 * ldv); }
        LAS unsigned char* Kb = lds + cur * ATT_KB; LAS unsigned char* Vb = lds + ATT_VOFF + cur * ATT_VB;
        f32x16 s[2];
#pragma unroll
        for (int kb = 0; kb < 2; ++kb) {
#pragma unroll
            for (int i = 0; i < 16; ++i) s[kb][i] = 0.f;
#pragma unroll
            for (int st = 0; st < NSTEP; ++st) { const bf16x8 a = *(const LAS bf16x8*)(Kb + (kb * 32 + r) * ATT_KP + (dbase + 16 * st + 8 * h) * 2);
                s[kb] = __builtin_amdgcn_mfma_f32_32x32x16_bf16(a, qf[st], s[kb], 0, 0, 0); } }
        float mx = s[0][0];
#pragma unroll
        for (int i = 1; i < 16; ++i) mx = fmaxf(mx, s[0][i]);
#pragma unroll
        for (int i = 0; i < 16; ++i) mx = fmaxf(mx, s[1][i]);
        mx = half_swap_max(mx);
        const float mnew = fmaxf(mold, mx * sl2), alpha = __builtin_amdgcn_exp2f(mold - mnew); mold = mnew;
        float ps = 0.f;
#pragma unroll
        for (int kb = 0; kb < 2; ++kb)
#pragma unroll
            for (int i = 0; i < 16; ++i) { const float p = __builtin_amdgcn_exp2f(__builtin_fmaf(s[kb][i], sl2, -mnew)); s[kb][i] = p; ps += p; }
        lsum = lsum * alpha + ps;
#pragma unroll
        for (int et = 0; et < 4; ++et)
#pragma unroll
            for (int i = 0; i < 16; ++i) o[et][i] *= alpha;
#pragma unroll
        for (int kb = 0; kb < 2; ++kb)
#pragma unroll
            for (int s2 = 0; s2 < 2; ++s2) {
                u32x4 pw; pw.x = pk2(s[kb][8 * s2 + 0], s[kb][8 * s2 + 1]); pw.y = pk2(s[kb][8 * s2 + 2], s[kb][8 * s2 + 3]); pw.z = pk2(s[kb][8 * s2 + 4], s[kb][8 * s2 + 5]); pw.w = pk2(s[kb][8 * s2 + 6], s[kb][8 * s2 + 7]);
                const bf16x8 pf = __builtin_bit_cast(bf16x8, pw);
#pragma unroll
                for (int et = 0; et < 4; ++et) { const u32x4 aw = *(const LAS u32x4*)(Vb + (et * 32 + r) * ATT_VP + (kb * 2 + s2) * 32 + h * 16);
                    o[et] = __builtin_amdgcn_mfma_f32_32x32x16_bf16(__builtin_bit_cast(bf16x8, aw), pf, o[et], 0, 0, 0); } }
        if (more) { const int nb = cur ^ 1;
            *(LAS u32x4*)(lds + nb * ATT_KB + kl) = pk0; *(LAS u32x4*)(lds + nb * ATT_KB + kl + 32 * ATT_KP) = pk1;
            att_vput(lds + nb * ATT_VB + vl, pv0); att_vput(lds + nb * ATT_VB + vl + 64 * ATT_VP, pv1); }
        __syncthreads();
    }
    lsum = half_swap_sum(lsum);
    const float inv = 1.0f / lsum;
    if (NC == 1) {
        bf16_t* orow = Op + (size_t)(qb * 32 + r) * ldo;
#pragma unroll
        for (int et = 0; et < 4; ++et)
#pragma unroll
            for (int g = 0; g < 4; ++g) { u32x2 w; w.x = pk2(o[et][4 * g] * inv, o[et][4 * g + 1] * inv); w.y = pk2(o[et][4 * g + 2] * inv, o[et][4 * g + 3] * inv);
                *(u32x2*)(orow + et * 32 + 8 * g + 4 * h) = w; }
    } else {
        LAS float* XL = (LAS float*)lds;
        if (comp == 1) {
#pragma unroll
            for (int et = 0; et < 4; ++et)
#pragma unroll
                for (int i = 0; i < 16; ++i) XL[(qb * 64 + et * 16 + i) * 64 + lane] = o[et][i] * inv;
        }
        __syncthreads();
        if (comp == 0) {
            float ss = 0.f;
#pragma unroll
            for (int et = 0; et < 4; ++et)
#pragma unroll
                for (int i = 0; i < 16; ++i) { const float ov = o[et][i] * inv - lam * XL[(qb * 64 + et * 16 + i) * 64 + lane]; o[et][i] = ov; ss += ov * ov; }
            ss = half_swap_sum(ss);
            const float rs = rsqrtf(ss * (1.0f / 128.0f) + RMS_EPS) * 0.8f;
            bf16_t* orow = Op + (size_t)(qb * 32 + r) * ldo;
#pragma unroll
            for (int et = 0; et < 4; ++et)
#pragma unroll
                for (int g = 0; g < 4; ++g) { const int e = et * 32 + 8 * g + 4 * h; const f32x4 gv = *(const f32x4*)(subg + e);
                    u32x2 w; w.x = pk2(o[et][4 * g] * rs * gv[0], o[et][4 * g + 1] * rs * gv[1]); w.y = pk2(o[et][4 * g + 2] * rs * gv[2], o[et][4 * g + 3] * rs * gv[3]);
                    *(u32x2*)(orow + e) = w; }
        }
        __syncthreads();
    }
}

template <bool TO_BF16> __device__ __forceinline__ void ln_rows(float* io, bf16_t* ob, float2* stat, const float* g, const float* b, int tid, float* alt = nullptr) {
    const int lane = tid & 63, gw = blockIdx.x * NWAVE + (tid >> 6), ngw = gridDim.x * NWAVE;
    f32x4 gv[4], bv[4];
#pragma unroll
    for (int j = 0; j < 4; ++j) { gv[j] = ((const f32x4*)g)[lane + 64 * j]; bv[j] = ((const f32x4*)b)[lane + 64 * j]; }
    for (int row0 = gw; row0 < NT; row0 += 2 * ngw) {
        f32x4 v[2][4];
#pragma unroll
        for (int u = 0; u < 2; ++u) { const int row = row0 + u * ngw; if (row < NT) { const f32x4* xr = (const f32x4*)(io + (size_t)row * DM) + lane;
#pragma unroll
            for (int j = 0; j < 4; ++j) v[u][j] = xr[64 * j]; } }
#pragma unroll
        for (int u = 0; u < 2; ++u) { const int row = row0 + u * ngw; if (row >= NT) continue;
            float s = 0.f;
#pragma unroll
            for (int j = 0; j < 4; ++j) s += (v[u][j][0] + v[u][j][1]) + (v[u][j][2] + v[u][j][3]);
            s = wave_allsum(s, lane);
            const float mean = s * (1.0f / DM); float s2 = 0.f;
#pragma unroll
            for (int j = 0; j < 4; ++j) { v[u][j] = v[u][j] - mean; s2 += (v[u][j][0] * v[u][j][0] + v[u][j][1] * v[u][j][1]) + (v[u][j][2] * v[u][j][2] + v[u][j][3] * v[u][j][3]); }
            s2 = wave_allsum(s2, lane);
            const float rstd = rsqrtf(s2 * (1.0f / DM) + LN_EPS);
            if (TO_BF16) {
                u32x2* o8 = (u32x2*)(ob + (size_t)row * DM) + lane;
#pragma unroll
                for (int j = 0; j < 4; ++j) { const f32x4 y = v[u][j] * rstd * gv[j] + bv[j]; u32x2 w; w.x = pk2(y[0], y[1]); w.y = pk2(y[2], y[3]); o8[64 * j] = w; }
                if (lane == 0) { float2 st; st.x = mean; st.y = rstd; stat[row] = st; }
            } else {
                f32x4* wr_ = (alt ? (f32x4*)(alt + (size_t)row * DM) : (f32x4*)(io + (size_t)row * DM)) + lane;
#pragma unroll
                for (int j = 0; j < 4; ++j) wr_[64 * j] = v[u][j] * rstd * gv[j] + bv[j];
            }
        }
    }
}

__device__ __forceinline__ void convgate_half(const bf16_t* HH, bf16_t* ACT, const float* cw, const float* cb, int half, int tid) {
    constexpr int NG = DFF / 8; const int total = (NT / 2) * NG;
    for (int idx = blockIdx.x * NTHR + tid; idx < total; idx += gridDim.x * NTHR) {
        const int rl = idx / NG, cg8 = idx - rl * NG, n0 = cg8 * 8, t = rl & (SEQ - 1);
        const bf16_t* hp = HH + (size_t)rl * (2 * DFF);
        float gsum[8], usum[8];
#pragma unroll
        for (int e = 0; e < 8; ++e) { gsum[e] = cb[n0 + e]; usum[e] = cb[DFF + n0 + e]; }
#pragma unroll
        for (int j = 0; j < 3; ++j) { const int tt = t + j - 1; if (tt < 0 || tt >= SEQ) continue;
            const u32x4 gq = *(const u32x4*)(hp + (ptrdiff_t)(j - 1) * (2 * DFF) + n0), uq = *(const u32x4*)(hp + (ptrdiff_t)(j - 1) * (2 * DFF) + DFF + n0);
            const float* wg = cw + (size_t)j * (2 * DFF) + n0; const float* wu = wg + DFF;
            const f32x4 wg0 = *(const f32x4*)wg, wg1 = *(const f32x4*)(wg + 4), wu0 = *(const f32x4*)wu, wu1 = *(const f32x4*)(wu + 4);
            gsum[0] += wg0[0] * lo2f(gq.x); gsum[1] += wg0[1] * hi2f(gq.x); gsum[2] += wg0[2] * lo2f(gq.y); gsum[3] += wg0[3] * hi2f(gq.y);
            gsum[4] += wg1[0] * lo2f(gq.z); gsum[5] += wg1[1] * hi2f(gq.z); gsum[6] += wg1[2] * lo2f(gq.w); gsum[7] += wg1[3] * hi2f(gq.w);
            usum[0] += wu0[0] * lo2f(uq.x); usum[1] += wu0[1] * hi2f(uq.x); usum[2] += wu0[2] * lo2f(uq.y); usum[3] += wu0[3] * hi2f(uq.y);
            usum[4] += wu1[0] * lo2f(uq.z); usum[5] += wu1[1] * hi2f(uq.z); usum[6] += wu1[2] * lo2f(uq.w); usum[7] += wu1[3] * hi2f(uq.w); }
        float a[8];
#pragma unroll
        for (int e = 0; e < 8; ++e) a[e] = gsum[e] / (1.0f + __expf(-gsum[e])) * usum[e];
        u32x4 w; w.x = pk2(a[0], a[1]); w.y = pk2(a[2], a[3]); w.z = pk2(a[4], a[5]); w.w = pk2(a[6], a[7]);
        *(u32x4*)(ACT + (size_t)(half * (NT / 2) + rl) * DFF + n0) = w;
    }
}

#define XB_TMO      128
#define XB_XCNT(j)  (256  + 64 * (j))
#define XB_XSUB(j)  (1280 + 64 * (j))
#define XB_XGEN(j)  (2304 + 64 * (j))
#define XB_TOP      3328
#define XB_TOPGEN   3392
#define XCD_BAR_WORDS 3456
#define XB_SPIN_CAP (1u << 18)

__device__ __forceinline__ unsigned xb_ld(unsigned* p)              { return __hip_atomic_load(p, __ATOMIC_RELAXED, __HIP_MEMORY_SCOPE_AGENT); }
__device__ __forceinline__ unsigned xb_add(unsigned* p, unsigned v) { return __hip_atomic_fetch_add(p, v, __ATOMIC_RELAXED, __HIP_MEMORY_SCOPE_AGENT); }
__device__ __forceinline__ unsigned xb_xcc_id() { return (unsigned)__builtin_amdgcn_s_getreg((3 << 11) | 20) & 0xFu; }
#define XB_SPIN(cond, bar) do { unsigned _sp = 0; while (cond) { __builtin_amdgcn_s_sleep(1); \
    if ((++_sp & 255u) == 0u) { if (xb_ld(&(bar)[XB_TMO])) break; if (_sp > XB_SPIN_CAP) { atomicAdd(&(bar)[XB_TMO], 1u); break; } } } } while (0)

struct XcdBarrier {
    unsigned* bar; unsigned x;
    volatile LAS unsigned* st;
};

__device__ __forceinline__ XcdBarrier xcd_barrier_post(unsigned* bar, volatile LAS unsigned* st) {
    XcdBarrier b; b.bar = bar; b.x = xb_xcc_id(); b.st = st;
    if (threadIdx.x == 0) (void)xb_add(&bar[XB_XCNT(b.x)], 1u);
    return b;
}
__device__ __forceinline__ void xcd_barrier_complete(unsigned* bar, unsigned x, unsigned& nloc, unsigned& nx) {
    const unsigned G = gridDim.x * gridDim.y * gridDim.z;
    unsigned sum, cnt, mine, sp = 0u;
    for (;;) {
        sum = 0u; cnt = 0u; mine = 0u;
#pragma unroll
        for (unsigned j = 0; j < 16; ++j) { const unsigned c = xb_ld(&bar[XB_XCNT(j)]); sum += c; cnt += (c > 0u) ? 1u : 0u; mine = (j == x) ? c : mine; }
        if (sum == G) break;
        __builtin_amdgcn_s_sleep(1);
        if ((++sp & 255u) == 0u) { if (xb_ld(&bar[XB_TMO])) break; if (sp > XB_SPIN_CAP) { atomicAdd(&bar[XB_TMO], 1u); break; } }
    }
    nloc = mine > 0u ? mine : 1u; nx = cnt > 0u ? cnt : 1u;
}

__device__ __forceinline__ void xcd_barrier(const XcdBarrier& b) {
    asm volatile("s_waitcnt vmcnt(0)" ::: "memory");
    __syncthreads();
    if (threadIdx.x == 0) {
        unsigned* bar = b.bar;
        __builtin_amdgcn_s_waitcnt(0);
        unsigned nloc = b.st[0], nx = b.st[1];
        if (nloc == 0u) { xcd_barrier_complete(bar, b.x, nloc, nx); b.st[0] = nloc; b.st[1] = nx; }
        const unsigned old = xb_add(&bar[XB_XSUB(b.x)], 1u);
        const unsigned gen = old / nloc;
        if (old + 1u == (gen + 1u) * nloc) {
            __builtin_amdgcn_fence(__ATOMIC_RELEASE, "agent");
            asm volatile("s_waitcnt vmcnt(0)" ::: "memory");
            const unsigned og = xb_add(&bar[XB_TOP], 1u);
            const unsigned tg = og / nx;
            if (og + 1u == (tg + 1u) * nx) xb_add(&bar[XB_TOPGEN], 1u);
            else XB_SPIN(xb_ld(&bar[XB_TOPGEN]) == tg, bar);
            __builtin_amdgcn_fence(__ATOMIC_ACQUIRE, "agent");
            xb_add(&bar[XB_XGEN(b.x)], 1u);
            asm volatile("s_waitcnt vmcnt(0)" ::: "memory");
        } else {
            XB_SPIN(xb_ld(&bar[XB_XGEN(b.x)]) == gen, bar);
            __builtin_amdgcn_fence(__ATOMIC_ACQUIRE, "agent");
            asm volatile("s_waitcnt vmcnt(0)" ::: "memory");
        }
    }
    __syncthreads();
}

template <int MODE> __device__ __forceinline__ void panel_finish(LAS unsigned char* lds, float* io, bf16_t* x1b, float2* stat, const float* g, const float* b, unsigned long long* XG, unsigned* CNT, int cu, int tid) {
    const int v = PairOrder::vcu_of(cu), q = v >> 2, j = v & 3, lane = tid & 63, wave = tid >> 6;
    LAS cplx* ST = (LAS cplx*)(lds + XCH_OFF); LAS cplx* MR = (LAS cplx*)lds;
    asm volatile("s_waitcnt lgkmcnt(0)" ::: "memory"); __syncthreads();
    const int ui = tid >> 8, rowl = tid & 255;
    float m1, m2;
    { const cplx a0 = ST[tid * 4 + 0], a1 = ST[tid * 4 + 1], a2 = ST[tid * 4 + 2], a3 = ST[tid * 4 + 3];
      m1 = (a0.x + a1.x) + (a2.x + a3.x); m2 = (a0.y + a1.y) + (a2.y + a3.y);
      __hip_atomic_store(XG + (size_t)((2 * q + ui) * 4 + j) * 256 + rowl, ((unsigned long long)__float_as_uint(m2) << 32) | __float_as_uint(m1), __ATOMIC_RELAXED, __HIP_MEMORY_SCOPE_AGENT); }
    asm volatile("s_waitcnt vmcnt(0)" ::: "memory");
    __syncthreads();
    if (tid == 0) {
        (void)__hip_atomic_fetch_add(CNT + (2 * q) * 16, 1u, __ATOMIC_RELAXED, __HIP_MEMORY_SCOPE_AGENT);
        (void)__hip_atomic_fetch_add(CNT + (2 * q + 1) * 16, 1u, __ATOMIC_RELAXED, __HIP_MEMORY_SCOPE_AGENT);
        unsigned sp = 0;
        while (__hip_atomic_load(CNT + (2 * q) * 16, __ATOMIC_RELAXED, __HIP_MEMORY_SCOPE_AGENT) < 4u || __hip_atomic_load(CNT + (2 * q + 1) * 16, __ATOMIC_RELAXED, __HIP_MEMORY_SCOPE_AGENT) < 4u) {
            __builtin_amdgcn_s_sleep(1); if (++sp > (1u << 22)) break; }
        __builtin_amdgcn_fence(__ATOMIC_ACQUIRE, "agent");
        asm volatile("s_waitcnt vmcnt(0)" ::: "memory");
    }
    __syncthreads();
    { float t1 = m1, t2 = m2;
#pragma unroll
      for (int jj = 1; jj < 4; ++jj) { const unsigned long long w = __hip_atomic_load(XG + (size_t)((2 * q + ui) * 4 + ((j + jj) & 3)) * 256 + rowl, __ATOMIC_RELAXED, __HIP_MEMORY_SCOPE_AGENT);
          t1 += __uint_as_float((unsigned)w); t2 += __uint_as_float((unsigned)(w >> 32)); }
      const float mean = t1 * (1.0f / DM), var = fmaxf(t2 * (1.0f / DM) - mean * mean, 0.f), rstd = rsqrtf(var + LN_EPS);
      cplx mr; mr.x = mean; mr.y = rstd; MR[tid] = mr;
      if (MODE == 1 && j == 0) { float2 sv; sv.x = mean; sv.y = rstd; stat[(2 * q + ui) * 256 + rowl] = sv; } }
    __syncthreads();
    const int cbase = j * 256 + lane * 4;
    const f32x4 g0 = *(const f32x4*)(g + cbase), b0 = *(const f32x4*)(b + cbase);
#pragma unroll 1
    for (int it = 0; it < 8; ++it) {
        const int u2 = it >> 2, rb = (it & 3) * 8; const size_t rbase = (size_t)((2 * q + u2) * 256 + wave * 32 + rb);
        f32x4 x0[8];
#pragma unroll
        for (int i = 0; i < 8; ++i) x0[i] = *(const f32x4*)(io + (rbase + i) * DM + cbase);
        asm volatile("" ::: "memory");
#pragma unroll
        for (int i = 0; i < 8; ++i) { const cplx mr = MR[u2 * 256 + wave * 32 + rb + i];
            const f32x4 y0 = (x0[i] - mr.x) * mr.y * g0 + b0;
            if (MODE == 1) { u32x2 w0; w0.x = pk2(y0[0], y0[1]); w0.y = pk2(y0[2], y0[3]); *(u32x2*)(x1b + (rbase + i) * DM + cbase) = w0; }
            else *(f32x4*)(io + (rbase + i) * DM + cbase) = y0; }
    }
}

#ifndef PH_MASK
#define PH_MASK 0xFFFFFF
#endif
#define PH(k) ((PH_MASK >> (k)) & 1)
#ifndef G5ORDER
#define G5ORDER KbOrder
#endif
#ifndef REP_P0
#define REP_P0 1
#endif
#ifndef REP_G1
#define REP_G1 1
#endif
#ifndef REP_DIFF
#define REP_DIFF 1
#endif
#ifndef REP_HY
#define REP_HY 1
#endif
#ifndef REP_MEM
#define REP_MEM 1
#endif
#ifndef REP_G3
#define REP_G3 1
#endif
#ifndef REP_G4
#define REP_G4 1
#endif
#ifndef REP_LN1
#define REP_LN1 1
#endif
struct Args { const float* in[24]; float* out; unsigned char* ws; };
__global__ void __launch_bounds__(NTHR, 2) hybrid_fwd(Args a) {
    extern __shared__ __attribute__((aligned(16))) unsigned char smem[];
    LAS unsigned char* lds = (LAS unsigned char*)smem;
    cg::grid_group grid = cg::this_grid();
    volatile LAS unsigned* bst = (volatile LAS unsigned*)(lds + LDS_BYTES - 64);
    if (threadIdx.x < 2) bst[threadIdx.x] = 0u;
    __syncthreads();
    const XcdBarrier bar = xcd_barrier_post((unsigned*)(a.ws + WS_BAR), bst);
    const int G = gridDim.x;
#define NEWPHASE() int tid_ = threadIdx.x, cu_ = blockIdx.x; asm volatile("" : "+v"(tid_)); asm volatile("" : "+s"(cu_)); const int tid = tid_, cu = cu_; (void)tid; (void)cu;
    unsigned char* ws = a.ws;
    bf16_t* WALL = (bf16_t*)(ws + WS_WALL); bf16_t* XB = (bf16_t*)(ws + WS_XB); bf16_t* MEMB = (bf16_t*)(ws + WS_MEMB); bf16_t* WKV = (bf16_t*)(ws + WS_WKV);
    bf16_t* QKM = (bf16_t*)(ws + WS_QKM); bf16_t* HT = (bf16_t*)(ws + WS_HT); bf16_t* KMEM = (bf16_t*)(ws + WS_KMEM); bf16_t* VMT = (bf16_t*)(ws + WS_VMT);
    float2* KF = (float2*)(ws + WS_KF); bf16_t* MIX = (bf16_t*)(ws + WS_MIX); float2* STAT = (float2*)(ws + WS_STAT);
    bf16_t* X1B = (bf16_t*)(ws + WS_X1B); bf16_t* HH = (bf16_t*)(ws + WS_HH); bf16_t* ACT = (bf16_t*)(ws + WS_ACT);

    for (int rep = 0; rep < REP_P0; ++rep) { NEWPHASE(); if (PH(0)) p0_prep(a.in, ws, lds, tid); }
    if (a.ws == nullptr) grid.sync();
    xcd_barrier(bar);

    for (int rep = 0; rep < REP_G1; ++rep) {
    if (PH(1)) { NEWPHASE(); pg8::Gemm g{XB, WALL, NT, 1536, DM}; pg8::StaticOrder S; S.init(g.M, g.N, G, cu);
      EpiRope E{QKM, (const float2*)(ws + WS_ROPE)};
      pg8::gemm_phase<EpiRope, pg8::StaticOrder, true, true>(lds, g, S, E); }
    if (PH(2)) { NEWPHASE(); pg8::Gemm g{WALL + (size_t)1536 * DM, XB, 2048, NT, DM}; pg8::StaticOrder S; S.init(g.M, g.N, G, cu);
      EpiB E{HT, NT};
      pg8::gemm_phase<EpiB, pg8::StaticOrder, true, true>(lds, g, S, E); }
    }
    if (PH(3)) { NEWPHASE(); const bool isK = cu < 32, on = cu < 64; const int c2 = cu - 32;
      pg8::Gemm g; EpiB E; OneUnit S;
      if (isK) { g = pg8::Gemm{MEMB, WKV, NMT, 512, DM}; E = EpiB{KMEM, 512}; S = OneUnit{cu >> 1, cu & 1, on}; }
      else { g = pg8::Gemm{WKV + (size_t)512 * DM, MEMB, 512, NMT, DM}; E = EpiB{VMT, NMT}; S = OneUnit{(c2 >> 4) & 1, c2 & 15, on}; }
      pg8::gemm_phase<EpiB, OneUnit, false, true>(lds, g, S, E);
      __syncthreads();
      if (!on) for (int it = cu - 64; it < 1024; it += G - 64) filter_fft_item((const float*)(ws + WS_HTD), KF, lds, it, tid); }
    xcd_barrier(bar);

    { NEWPHASE(); const int xcd = cu & 7, j = cu >> 3;
      float lam;
      { const float* lp = a.in[12]; const int l6 = tid & 63; float s01 = lp[l6] * lp[64 + l6], s23 = lp[128 + l6] * lp[192 + l6];
        s01 = wave_allsum(s01, l6); s23 = wave_allsum(s23, l6);
        lam = expf(s01) - expf(s23) + 0.2f; }
      if (PH(4)) for (int i = 0; i < 4 * REP_DIFF; ++i) {
          const int bh = ((i & 3) * 8 + xcd) * 2 + (j >> 4), qblk = j & 15, b = bh >> 2, hd = bh & 3;
          const size_t tok0 = (size_t)b * SEQ;
          attn_unit<2>(lds, QKM + (tok0 + qblk * 128) * MIXW + hd * 128, MIXW, QKM + tok0 * MIXW + 512 + hd * 128, MIXW,
                       HT + (size_t)(1536 + hd * 128) * NT + tok0, NT, SEQ, 0.125f * 1.4426950408889634f,
                       MIX + (tok0 + qblk * 128) * MIXW + 512 + hd * 128, MIXW, lam, a.in[13], tid); }
      if (PH(5)) for (int i = 0; i < 2 * REP_MEM; ++i) {
          const int bh = ((i & 1) * 8 + xcd) * 4 + (j >> 3), qblk = j & 7, b = bh >> 2, hd = bh & 3;
          const size_t tok0 = (size_t)b * SEQ;
          attn_unit<1>(lds, QKM + (tok0 + qblk * 256) * MIXW + 1024 + hd * 128, MIXW, KMEM + (size_t)b * MEMT * 512 + hd * 128, 512,
                       VMT + (size_t)(hd * 128) * NMT + b * MEMT, NMT, MEMT, 0.08838834764831845f * 1.4426950408889634f,
                       MIX + (tok0 + qblk * 256) * MIXW + 1024 + hd * 128, MIXW, 0.f, nullptr, tid); }
      if (PH(6)) for (int i = 0; i < 2 * REP_HY; ++i) {
          const int cgp = ((i & 1) * 8 + xcd) * 4 + (j >> 3), bp = j & 7;
          hyena_item(HT, KF, a.in[3], a.in[4], a.in[11], MIX, lds, bp, cgp, tid); } }
    xcd_barrier(bar);

#ifdef REP_SYNC
    for (int rep = 0; rep < REP_SYNC; ++rep) xcd_barrier(bar);
#endif
    const bool pair = (G == 256);
    if (pair) {
        if (PH(7)) { NEWPHASE(); const int v = PairOrder::vcu_of(cu);
            pg8::Gemm g{MIX, (const bf16_t*)(ws + WS_WOUT), NT, DM, MIXW}; QuadTwo S{v >> 2, v & 3};
            EpiLn<1> E{a.in[0], a.out, X1B, a.in[16], a.in[17], (unsigned long long*)(ws + WS_XG), (unsigned*)(ws + WS_CNT), lds};
            pg8::gemm_phase<EpiLn<1>, QuadTwo, true, true>(lds, g, S, E); }
        xcd_barrier(bar);
    } else {
        { NEWPHASE(); pg8::Gemm g{MIX, (const bf16_t*)(ws + WS_WOUT), NT, DM, MIXW}; pg8::StaticOrder S; S.init(g.M, g.N, G, cu);
          EpiRes E{a.in[0], a.out, lds, 0};
          pg8::gemm_phase<EpiRes, pg8::StaticOrder, true, true>(lds, g, S, E); }
        xcd_barrier(bar);
        { NEWPHASE(); ln_rows<true>(a.out, X1B, STAT, a.in[16], a.in[17], tid); }
        xcd_barrier(bar);
    }
    for (int rep = 0; rep < REP_G4; ++rep) if (PH(9)) { NEWPHASE(); pg8::Gemm g{X1B, (const bf16_t*)(ws + WS_WUP), FFN_MT * 256, 2 * DFF, DM}; FfnOrder S; S.init(g.M, g.N, G, cu); S.cw = a.in[19]; S.cb = a.in[20]; S.lds = lds; S.cnt = 0;
      EpiFfn E{ACT, lds, 0};
      pg8::gemm_phase<EpiFfn, FfnOrder, true, true>(lds, g, S, E); }
    xcd_barrier(bar);
    if (pair) {
        if (PH(11)) { NEWPHASE(); const int v = PairOrder::vcu_of(cu);
            pg8::Gemm g{ACT, (const bf16_t*)(ws + WS_WDN), NT, DM, DFF}; QuadTwoKb S; S.q = v >> 2; S.j = v & 3;
            EpiLn<2> E{a.out, a.out, nullptr, a.in[22], a.in[23], (unsigned long long*)(ws + WS_XG) + 128 * 4 * 256, (unsigned*)(ws + WS_CNT) + 128 * 16, lds};
            pg8::gemm_phase<EpiLn<2>, QuadTwoKb, true, true>(lds, g, S, E); }
    } else {
        { NEWPHASE(); pg8::Gemm g{ACT, (const bf16_t*)(ws + WS_WDN), NT, DM, DFF}; KbOrder S; S.init(g.M, g.N, G, cu);
          EpiRes2 E{a.out, a.out, STAT, a.in[16], a.in[17], lds, 0};
          pg8::gemm_phase<EpiRes2, KbOrder, true, true>(lds, g, S, E); }
        xcd_barrier(bar);
        { NEWPHASE(); ln_rows<false>(a.out, nullptr, nullptr, a.in[22], a.in[23], tid); }
    }
}

extern "C" void kernel_launch(void* const* d_in, const int* in_sizes, int n_in, void* d_out, int out_size, void* d_ws, size_t ws_size, hipStream_t stream) {
    static int grid = 0;
    if (grid == 0) {
        if (n_in != 24 || out_size != NT * DM || ws_size < WS_END) { fprintf(stderr, "kernel_launch: unexpected shapes (n_in %d, out %d, ws %zu)\n", n_in, out_size, ws_size); grid = -1; return; }
        int dev = 0, cus = 0, per_cu = 0;
        hipGetDevice(&dev); hipDeviceGetAttribute(&cus, hipDeviceAttributeMultiprocessorCount, dev);
        if (hipFuncSetAttribute((const void*)hybrid_fwd, hipFuncAttributeMaxDynamicSharedMemorySize, LDS_BYTES) != hipSuccess) { fprintf(stderr, "kernel_launch: hipFuncSetAttribute failed\n"); grid = -1; return; }
        if (hipOccupancyMaxActiveBlocksPerMultiprocessor(&per_cu, (const void*)hybrid_fwd, NTHR, LDS_BYTES) != hipSuccess || per_cu < 1) { fprintf(stderr, "kernel_launch: occupancy query says %d\n", per_cu); per_cu = 1; }
        (void)hipGetLastError();
        grid = cus * per_cu;
        fprintf(stderr, "kernel_launch: grid %d (cus %d x %d)\n", grid, cus, per_cu);
    }
    if (grid < 0) return;
    if (hipMemsetAsync((char*)d_ws + WS_BAR, 0, 32768, stream) != hipSuccess) { fprintf(stderr, "kernel_launch: memset failed\n"); return; }
    Args a{};
    for (int i = 0; i < 24; ++i) a.in[i] = (const float*)d_in[i];
    a.out = (float*)d_out; a.ws = (unsigned char*)d_ws;
    void* args[] = {&a};
    const hipError_t e = hipLaunchCooperativeKernel((const void*)hybrid_fwd, dim3(grid), dim3(NTHR), args, LDS_BYTES, stream);
    if (e != hipSuccess) fprintf(stderr, "kernel_launch: cooperative launch failed: %s (grid %d)\n", hipGetErrorString(e), grid);
}
```

```cpp
#include <hip/hip_runtime.h>
#include <hip/hip_cooperative_groups.h>
#include <cstdio>
#include <cstdint>
namespace cg = cooperative_groups;
#define LAS __attribute__((address_space(3)))
namespace pg8 {
#define PG8_LAS __attribute__((address_space(3)))
typedef unsigned short bf16_t;
typedef short bf16x8 __attribute__((ext_vector_type(8)));
typedef float f32x4 __attribute__((ext_vector_type(4)));
typedef unsigned u32x4 __attribute__((ext_vector_type(4)));
constexpr int BM = 256, BK = 64, HALF = 128, HTB = HALF * BK * 2  , STAGE_BYTES = 8 * HTB, NXCD = 8, WGM = 8;

__host__ __device__ __forceinline__ int lds_byte(int r, int c) { const int st = (r >> 4) * 2 + (c >> 5), rr = r & 15, cc = c & 31, ob = rr * 64 + cc * 2; return st * 1024 + (ob ^ (((ob >> 9) & 1) << 5)); }
__host__ __device__ __forceinline__ void stage_rc(int b, int& R, int& C) { const int st = b / 1024, sb = b % 1024, swz = sb ^ (((sb >> 9) & 1) << 5); R = (st >> 1) * 16 + swz / 64; C = (st & 1) * 32 + (swz % 64) / 2; }
__host__ __device__ __forceinline__ int perm32(int rho) { const int n = rho >> 4, i = rho & 15; return 8 * (i >> 2) + 4 * n + (i & 3); }

struct Unit { int pm, pn; };
struct Gemm { const bf16_t* A; const bf16_t* Bt; int M, N, K; };

struct StaticOrder {
    int nM, nN, nwg, G, c;
    __host__ __device__ void init(int M, int N, int G_, int c_) { nM = M / BM; nN = N / BM; nwg = nM * nN; G = G_; c = c_; }
    __host__ __device__ bool next(int i, Unit& u) const {
        const long L = (long)i * G + c; if (L >= nwg) return false;
        int wgid = (int)L; { const int q = nwg / NXCD, r = nwg % NXCD, xcd = wgid % NXCD, off = wgid / NXCD; wgid = (xcd < r ? xcd * (q + 1) : r * (q + 1) + (xcd - r) * q) + off; }
        const int nig = WGM * nN, gid = wgid / nig, fm = gid * WGM, gsz = (nM - fm) < WGM ? (nM - fm) : WGM;
        u.pm = fm + ((wgid % nig) % gsz); u.pn = (wgid % nig) / gsz; return true;
    }
    __device__ __forceinline__ void a_ready(const Unit&) const {}
    __device__ __forceinline__ void done(const Unit&) const {}
    __device__ __forceinline__ long a_off(const Unit& u, size_t tstep) const { return (long)((size_t)u.pm * tstep); }
    __device__ __forceinline__ int lda(int K) const { return K; }
    __device__ __forceinline__ size_t kstep_a() const { return (size_t)(BK * 2); }
};
template <class Epi, class Sched, bool ALIGN_EPI = false, bool SP2 = false>
__device__ __forceinline__ void gemm_phase(PG8_LAS unsigned char* lds, const Gemm g, const Sched& S, const Epi& E) {
    int tid_l = threadIdx.x; asm volatile("" : "+v"(tid_l)); const int tid = tid_l, wid = __builtin_amdgcn_readfirstlane(tid >> 6), lane = tid & 63, wr = wid >> 2, wc = wid & 3, fr = lane & 15, fq = lane >> 4;
    const int K = g.K, nt = K / BK;
    unsigned voffA[2], voffB[2];
    const int lda = S.lda(K);
#pragma unroll
    for (int i = 0; i < 2; ++i) { int R, C; stage_rc(tid * 16 + i * 8192, R, C); const int Rb = Epi::PERM ? ((R & ~31) + perm32(R & 31)) : R;
        voffA[i] = (unsigned)(R * lda + C) * 2u; voffB[i] = (unsigned)(Rb * K + C) * 2u; }
    const size_t kstep = (size_t)(BK * 2);
    const size_t hstep = (size_t)HALF * K * 2;
    const size_t tstep = 2 * hstep;
    const size_t kstepA = S.kstep_a(), hstepA = (size_t)HALF * lda * 2, tstepA = 2 * hstepA;
    const unsigned ldsw = (unsigned)wid * 1024u;
    const int aoff = lds_byte(wr * 64 + fr, fq * 8), boff = lds_byte(wc * 32 + fr, fq * 8);
#define PG8_SA(b, h) (((b) * 2 + (h)) * HTB)
#define PG8_SB(b, h) ((4 + (b) * 2 + (h)) * HTB)
#define PG8_STAGE(bufoff, gbase, voff) do { _Pragma("unroll") for (int _i = 0; _i < 2; ++_i) \
        __builtin_amdgcn_global_load_lds((const unsigned*)((const char*)(gbase) + (voff)[_i]), (PG8_LAS unsigned*)(lds + (bufoff) + ldsw + _i * 8192), 16, 0, 0); } while (0)
#define PG8_LDA(dst, b, h) do { _Pragma("unroll") for (int m = 0; m < 4; ++m) _Pragma("unroll") for (int k = 0; k < 2; ++k) dst[m][k] = *(const PG8_LAS bf16x8*)(lds + PG8_SA(b, h) + aoff + m * 2048 + k * 1024); } while (0)
#define PG8_LDB(dst, b, h) do { _Pragma("unroll") for (int n = 0; n < 2; ++n) _Pragma("unroll") for (int k = 0; k < 2; ++k) dst[n][k] = *(const PG8_LAS bf16x8*)(lds + PG8_SB(b, h) + boff + n * 2048 + k * 1024); } while (0)
#define PG8_MMA(ai, bj, At, Bt) do { __builtin_amdgcn_s_setprio(1); _Pragma("unroll") for (int m = 0; m < 4; ++m) _Pragma("unroll") for (int n = 0; n < 2; ++n) _Pragma("unroll") for (int k = 0; k < 2; ++k) \
        acc[ai][bj][m][n] = __builtin_amdgcn_mfma_f32_16x16x32_bf16(Bt[n][k], At[m][k], acc[ai][bj][m][n], 0, 0, 0); __builtin_amdgcn_s_setprio(0); } while (0)
#define PG8_WAIT_V(n) asm volatile("s_waitcnt vmcnt(" #n ")" ::: "memory")
#define PG8_WAIT_L(n) asm volatile("s_waitcnt lgkmcnt(" #n ")" ::: "memory")
#define PG8_BAR __builtin_amdgcn_s_barrier()
#define PG8_SCHED __builtin_amdgcn_sched_barrier(0)
    Unit cur, nxt; int ui = 0;
    if (!S.next(0, cur)) return;
    f32x4 acc[2][2][4][2];
#pragma unroll
    for (int a = 0; a < 2; ++a)
#pragma unroll
        for (int b = 0; b < 2; ++b)
#pragma unroll
            for (int m = 0; m < 4; ++m)
#pragma unroll
                for (int n = 0; n < 2; ++n) acc[a][b][m][n] = (f32x4){0.f, 0.f, 0.f, 0.f};
    bf16x8 At[4][2], B0[2][2], B1[2][2];
    const char* cA = (const char*)g.A + S.a_off(cur, tstepA); const char* cB = (const char*)g.Bt + (size_t)cur.pn * tstep;
    S.a_ready(cur);
    if constexpr (SP2) {
        PG8_STAGE(PG8_SB(0, 0), cB, voffB); PG8_STAGE(PG8_SB(0, 1), cB + hstep, voffB); PG8_STAGE(PG8_SA(0, 0), cA, voffA); PG8_STAGE(PG8_SA(0, 1), cA + hstepA, voffA);
        if (wr == 1) PG8_BAR;
        PG8_WAIT_V(2); PG8_BAR;
        PG8_STAGE(PG8_SB(1, 0), cB + kstep, voffB); PG8_STAGE(PG8_SA(1, 0), cA + kstepA, voffA); PG8_STAGE(PG8_SB(1, 1), cB + hstep + kstep, voffB);
        PG8_WAIT_V(6); PG8_BAR;
    } else {
        PG8_STAGE(PG8_SB(0, 0), cB, voffB); PG8_STAGE(PG8_SA(0, 0), cA, voffA); PG8_STAGE(PG8_SB(0, 1), cB + hstep, voffB); PG8_STAGE(PG8_SA(0, 1), cA + hstepA, voffA);
        if (wr == 1) PG8_BAR;
        PG8_WAIT_V(4); PG8_BAR;
        PG8_STAGE(PG8_SB(1, 0), cB + kstep, voffB); PG8_STAGE(PG8_SA(1, 0), cA + kstepA, voffA); PG8_STAGE(PG8_SB(1, 1), cB + hstep + kstep, voffB);
        PG8_WAIT_V(6); PG8_BAR;
    }
    for (;;) {
        const bool has_next = S.next(ui + 1, nxt);
        const char* nA = has_next ? (const char*)g.A + S.a_off(nxt, tstepA) : cA; const char* nB = has_next ? (const char*)g.Bt + (size_t)nxt.pn * tstep : cB;
        for (int t = 0; t < nt; t += 2) {
            const bool last = (t == nt - 2);
            const char* a1 = cA + (size_t)(t + 1) * kstepA;
            const char* a2 = last ? nA : cA + (size_t)(t + 2) * kstepA; const char* b2 = last ? nB : cB + (size_t)(t + 2) * kstep;
            const char* a3 = a2 + kstepA; const char* b3 = b2 + kstep;
            if (last && has_next) S.a_ready(nxt);
            if constexpr (SP2) {
            PG8_LDB(B0, 0, 0); PG8_LDB(B1, 0, 1); PG8_SCHED; PG8_LDA(At, 0, 0); PG8_STAGE(PG8_SA(1, 1), a1 + hstepA, voffA);
            PG8_WAIT_V(8); PG8_WAIT_L(0); PG8_BAR; PG8_MMA(0, 0, At, B0); PG8_MMA(0, 1, At, B1); PG8_BAR; PG8_SCHED;
            PG8_LDA(At, 0, 1); PG8_STAGE(PG8_SB(0, 0), b2, voffB); PG8_STAGE(PG8_SB(0, 1), b2 + hstep, voffB); PG8_STAGE(PG8_SA(0, 0), a2, voffA);
            PG8_WAIT_V(8); PG8_WAIT_L(0); PG8_BAR; PG8_MMA(1, 0, At, B0); PG8_MMA(1, 1, At, B1); PG8_BAR; PG8_SCHED;
            PG8_LDB(B0, 1, 0); PG8_LDB(B1, 1, 1); PG8_SCHED; PG8_LDA(At, 1, 0); PG8_STAGE(PG8_SA(0, 1), a2 + hstepA, voffA);
            PG8_WAIT_V(8); PG8_WAIT_L(0); PG8_BAR; PG8_MMA(0, 0, At, B0); PG8_MMA(0, 1, At, B1); PG8_BAR; PG8_SCHED;
            PG8_LDA(At, 1, 1); PG8_STAGE(PG8_SB(1, 0), b3, voffB); PG8_STAGE(PG8_SB(1, 1), b3 + hstep, voffB); PG8_STAGE(PG8_SA(1, 0), a3, voffA);
            PG8_WAIT_V(8); PG8_WAIT_L(0); PG8_BAR; PG8_MMA(1, 0, At, B0); PG8_MMA(1, 1, At, B1); PG8_BAR; PG8_SCHED;
            } else {
            PG8_LDB(B0, 0, 0); PG8_SCHED; PG8_LDA(At, 0, 0); PG8_STAGE(PG8_SA(1, 1), a1 + hstepA, voffA);
            PG8_WAIT_L(8); PG8_BAR; PG8_WAIT_L(0); PG8_MMA(0, 0, At, B0); PG8_BAR; PG8_SCHED;
            PG8_LDB(B1, 0, 1); PG8_STAGE(PG8_SB(0, 0), b2, voffB);
            PG8_BAR; PG8_WAIT_L(0); PG8_MMA(0, 1, At, B1); PG8_BAR;
            PG8_LDA(At, 0, 1); PG8_STAGE(PG8_SA(0, 0), a2, voffA);
            PG8_BAR; PG8_WAIT_L(0); PG8_MMA(1, 0, At, B0); PG8_BAR; PG8_SCHED;
            PG8_STAGE(PG8_SB(0, 1), b2 + hstep, voffB);
            PG8_WAIT_V(6); PG8_BAR; PG8_MMA(1, 1, At, B1); PG8_BAR;
            PG8_LDB(B0, 1, 0); PG8_SCHED; PG8_LDA(At, 1, 0); PG8_STAGE(PG8_SA(0, 1), a2 + hstepA, voffA);
            PG8_WAIT_L(8); PG8_BAR; PG8_WAIT_L(0); PG8_MMA(0, 0, At, B0); PG8_BAR; PG8_SCHED;
            PG8_LDB(B1, 1, 1); PG8_STAGE(PG8_SB(1, 0), b3, voffB);
            PG8_BAR; PG8_WAIT_L(0); PG8_MMA(0, 1, At, B1); PG8_BAR;
            PG8_LDA(At, 1, 1); PG8_STAGE(PG8_SA(1, 0), a3, voffA);
            PG8_BAR; PG8_WAIT_L(0); PG8_MMA(1, 0, At, B0); PG8_BAR; PG8_SCHED;
            PG8_STAGE(PG8_SB(1, 1), b3 + hstep, voffB);
            PG8_WAIT_V(6); PG8_BAR; PG8_MMA(1, 1, At, B1); PG8_BAR;
            }
        }
        if constexpr (ALIGN_EPI) { if (wr == 0) PG8_BAR; }
        if constexpr (!Epi::AFTER_DRAIN) { E(acc, cur, wr, wc, fr, fq); S.done(cur); }
        if (!has_next) break;
#pragma unroll
        for (int a = 0; a < 2; ++a)
#pragma unroll
            for (int b = 0; b < 2; ++b)
#pragma unroll
                for (int m = 0; m < 4; ++m)
#pragma unroll
                    for (int n = 0; n < 2; ++n) acc[a][b][m][n] = (f32x4){0.f, 0.f, 0.f, 0.f};
        cur = nxt; cA = nA; cB = nB; ++ui;
        if constexpr (ALIGN_EPI) { if (wr == 1) PG8_BAR; }
    }
    PG8_WAIT_V(0);
    if constexpr (!ALIGN_EPI) { if (wr == 0) PG8_BAR; }
    PG8_BAR;
    if constexpr (Epi::AFTER_DRAIN) { E.fused(acc, cur, wr, wc, fr, fq, lds, wid, lane); S.done(cur); }
#undef PG8_SA
#undef PG8_SB
#undef PG8_STAGE
#undef PG8_LDA
#undef PG8_LDB
#undef PG8_MMA
#undef PG8_WAIT_V
#undef PG8_WAIT_L
#undef PG8_BAR
#undef PG8_SCHED
}
}

using pg8::bf16_t; using pg8::bf16x8; using pg8::f32x4; using pg8::u32x4;
typedef float f32x16 __attribute__((ext_vector_type(16)));
typedef unsigned u32x2 __attribute__((ext_vector_type(2)));
typedef short bf16x4 __attribute__((ext_vector_type(4)));

constexpr int NB = 16, SEQ = 2048, DM = 1024, NT = NB * SEQ, MEMT = 256, NMT = NB * MEMT, HW = 512, INW = 3584, DFF = 2816, MIXW = 1536;
constexpr float ALPHA = 1.189207115002721f;
constexpr float LN_EPS = 1e-5f, RMS_EPS = 1e-5f;
constexpr int NTHR = 512, NWAVE = 8;
constexpr int LDS_BYTES = 151552;

constexpr size_t MiB = 1048576;
constexpr size_t WS_WALL = 0;
constexpr size_t WS_WKV  = 7 * MiB;
constexpr size_t WS_WOUT = 9 * MiB;
constexpr size_t WS_WUP  = 12 * MiB;
constexpr size_t WS_WDN  = 23 * MiB;
constexpr size_t WS_ROPE = 29 * MiB;
constexpr size_t WS_STAT = 29 * MiB + 524288;
constexpr size_t WS_XB   = 30 * MiB;
constexpr size_t WS_X1B  = 30 * MiB;
constexpr size_t WS_HTD  = 94 * MiB;
constexpr size_t WS_MEMB = 110 * MiB;
constexpr size_t WS_QKM  = 118 * MiB;
constexpr size_t WS_HT   = 214 * MiB;
constexpr size_t WS_KMEM = 342 * MiB;
constexpr size_t WS_VMT  = 346 * MiB;
constexpr size_t WS_KF   = 350 * MiB;
constexpr size_t WS_MIX  = 382 * MiB;
constexpr size_t WS_HH   = 96 * MiB;
constexpr size_t WS_ACT  = 272 * MiB;
constexpr size_t WS_BAR  = 478 * MiB;
constexpr size_t WS_CNT  = 478 * MiB + 16384;
constexpr size_t WS_XG   = 478 * MiB + 65536;
constexpr size_t WS_END  = 478 * MiB + 65536 + 2 * MiB;

__device__ __forceinline__ unsigned pk2(float lo, float hi) { unsigned r; asm volatile("v_cvt_pk_bf16_f32 %0, %1, %2" : "=v"(r) : "v"(lo), "v"(hi)); return r; }
__device__ __forceinline__ float bf2f(bf16_t v) { return __uint_as_float((unsigned)v << 16); }
__device__ __forceinline__ float lo2f(unsigned v) { return __uint_as_float(v << 16); }
__device__ __forceinline__ float hi2f(unsigned v) { return __uint_as_float(v & 0xffff0000u); }
#define LDS_WAIT() asm volatile("s_waitcnt lgkmcnt(0)" ::: "memory")
__device__ __forceinline__ float xsum16(float v) { const auto r_ = __builtin_amdgcn_permlane16_swap(__float_as_uint(v), __float_as_uint(v), false, false); return __uint_as_float(r_[0]) + __uint_as_float(r_[1]); }
__device__ __forceinline__ float xsum32(float v) { const auto r_ = __builtin_amdgcn_permlane32_swap(__float_as_uint(v), __float_as_uint(v), false, false); return __uint_as_float(r_[0]) + __uint_as_float(r_[1]); }
__device__ __forceinline__ float wave_allsum(float v, int lane) {
#pragma unroll
    for (int o = 1; o < 16; o <<= 1) v += __int_as_float(__builtin_amdgcn_ds_bpermute((lane ^ o) << 2, __float_as_int(v)));
    return xsum32(xsum16(v));
}

#ifndef FFT_HOST
#define FFT_FN __device__ __forceinline__
#define FFT_SYNC() __syncthreads()
typedef float cplx __attribute__((ext_vector_type(2)));
typedef LAS cplx* fftbuf_t;
FFT_FN float cos2pi(float r) { return __builtin_amdgcn_cosf(r); }
FFT_FN float sin2pi(float r) { return __builtin_amdgcn_sinf(r); }
#endif
FFT_FN cplx mk2(float x, float y) { cplx r; r.x = x; r.y = y; return r; }
FFT_FN cplx cadd(cplx a, cplx b) { return mk2(a.x + b.x, a.y + b.y); }
FFT_FN cplx csub(cplx a, cplx b) { return mk2(a.x - b.x, a.y - b.y); }
FFT_FN cplx cmul(cplx a, cplx b) { return mk2(a.x * b.x - a.y * b.y, a.x * b.y + a.y * b.x); }
template <bool INV> FFT_FN cplx muli(cplx a) { return INV ? mk2(-a.y, a.x) : mk2(a.y, -a.x); }
FFT_FN int padi(int i) { return i + (i >> 3); }

template <bool INV> FFT_FN void dft8(cplx (&v)[8]) {
    const float R = 0.70710678118654752f;
    const cplx a0 = cadd(v[0], v[4]), a1 = csub(v[0], v[4]), a2 = cadd(v[2], v[6]), a3 = muli<INV>(csub(v[2], v[6]));
    const cplx a4 = cadd(v[1], v[5]), a5 = csub(v[1], v[5]), a6 = cadd(v[3], v[7]), a7 = muli<INV>(csub(v[3], v[7]));
    const cplx b0 = cadd(a0, a2), b2 = csub(a0, a2), b1 = cadd(a1, a3), b3 = csub(a1, a3);
    const cplx b4 = cadd(a4, a6), b6 = muli<INV>(csub(a4, a6));
    const cplx t5 = cadd(a5, a7), t7 = csub(a5, a7);
    cplx b5, b7;
    if (!INV) { b5 = mk2((t5.x + t5.y) * R, (t5.y - t5.x) * R); b7 = mk2((t7.y - t7.x) * R, -(t7.x + t7.y) * R); }
    else      { b5 = mk2((t5.x - t5.y) * R, (t5.x + t5.y) * R); b7 = mk2(-(t7.x + t7.y) * R, (t7.x - t7.y) * R); }
    v[0] = cadd(b0, b4); v[4] = csub(b0, b4); v[1] = cadd(b1, b5); v[5] = csub(b1, b5);
    v[2] = cadd(b2, b6); v[6] = csub(b2, b6); v[3] = cadd(b3, b7); v[7] = csub(b3, b7);
}
template <int S, bool INV> FFT_FN void twid(cplx (&v)[8], int tid) {
    if (S > 1) {
        const int j = tid % S; const float rev = (float)j * (1.0f / (8.0f * S));
        const float c = cos2pi(rev), s = sin2pi(rev);
        const cplx w1 = mk2(c, INV ? s : -s);
        const cplx w2 = cmul(w1, w1), w3 = cmul(w2, w1), w4 = cmul(w2, w2), w5 = cmul(w4, w1), w6 = cmul(w4, w2), w7 = cmul(w4, w3);
        v[1] = cmul(v[1], w1); v[2] = cmul(v[2], w2); v[3] = cmul(v[3], w3); v[4] = cmul(v[4], w4);
        v[5] = cmul(v[5], w5); v[6] = cmul(v[6], w6); v[7] = cmul(v[7], w7);
    }
}
template <int S> FFT_FN void ld8(fftbuf_t X, int tid, cplx (&v)[8]) {
    const int base = (tid / S) * 8 * S + (tid % S);
#pragma unroll
    for (int k = 0; k < 8; ++k) v[k] = X[padi(base + S * k)];
}
template <int S> FFT_FN void st8(fftbuf_t X, int tid, const cplx (&v)[8]) {
    const int base = (tid / S) * 8 * S + (tid % S);
#pragma unroll
    for (int k = 0; k < 8; ++k) X[padi(base + S * k)] = v[k];
}
#ifndef FFT_HOST
template <int S> FFT_FN void twid_fill(fftbuf_t TW, int tid) {
    constexpr int P = (S == 512) ? 0 : (S == 64) ? 1 : 2;
    const int j = tid % S; const float rev = (float)j * (1.0f / (8.0f * S));
    const cplx w1 = mk2(cos2pi(rev), -sin2pi(rev)), w2 = cmul(w1, w1), w4 = cmul(w2, w2);
    TW[(3 * P + 0) * 512 + tid] = w1; TW[(3 * P + 1) * 512 + tid] = w2; TW[(3 * P + 2) * 512 + tid] = w4;
}
template <int S, bool INV> FFT_FN void twidL(cplx (&v)[8], fftbuf_t TW, int tid) {
    constexpr int P = (S == 512) ? 0 : (S == 64) ? 1 : 2;
    cplx w1 = TW[(3 * P + 0) * 512 + tid], w2 = TW[(3 * P + 1) * 512 + tid], w4 = TW[(3 * P + 2) * 512 + tid];
    if (INV) { w1.y = -w1.y; w2.y = -w2.y; w4.y = -w4.y; }
    const cplx w3 = cmul(w2, w1), w5 = cmul(w4, w1), w6 = cmul(w4, w2), w7 = cmul(w4, w3);
    v[1] = cmul(v[1], w1); v[2] = cmul(v[2], w2); v[3] = cmul(v[3], w3); v[4] = cmul(v[4], w4);
    v[5] = cmul(v[5], w5); v[6] = cmul(v[6], w6); v[7] = cmul(v[7], w7);
}
FFT_FN void fft_fwdL(fftbuf_t X, fftbuf_t TW, int tid, cplx (&v)[8]) {
    dft8<false>(v); twidL<512, false>(v, TW, tid); st8<512>(X, tid, v); FFT_SYNC();
    ld8<64>(X, tid, v); dft8<false>(v); twidL<64, false>(v, TW, tid); st8<64>(X, tid, v); FFT_SYNC();
    ld8<8>(X, tid, v); dft8<false>(v); twidL<8, false>(v, TW, tid); st8<8>(X, tid, v); FFT_SYNC();
    ld8<1>(X, tid, v); dft8<false>(v);
}
FFT_FN void fft_invL(fftbuf_t X, fftbuf_t TW, int tid, cplx (&v)[8]) {
    dft8<true>(v); st8<1>(X, tid, v); FFT_SYNC();
    ld8<8>(X, tid, v); twidL<8, true>(v, TW, tid); dft8<true>(v); st8<8>(X, tid, v); FFT_SYNC();
    ld8<64>(X, tid, v); twidL<64, true>(v, TW, tid); dft8<true>(v); st8<64>(X, tid, v); FFT_SYNC();
    ld8<512>(X, tid, v); twidL<512, true>(v, TW, tid); dft8<true>(v);
}
FFT_FN void fft_fwd(fftbuf_t X, int tid, cplx (&v)[8]) {
    dft8<false>(v); twid<512, false>(v, tid); st8<512>(X, tid, v); FFT_SYNC();
    ld8<64>(X, tid, v); dft8<false>(v); twid<64, false>(v, tid); st8<64>(X, tid, v); FFT_SYNC();
    ld8<8>(X, tid, v); dft8<false>(v); twid<8, false>(v, tid); st8<8>(X, tid, v); FFT_SYNC();
    ld8<1>(X, tid, v); dft8<false>(v);
}
FFT_FN void fft_inv(fftbuf_t X, int tid, cplx (&v)[8]) {
    dft8<true>(v); st8<1>(X, tid, v); FFT_SYNC();
    ld8<8>(X, tid, v); twid<8, true>(v, tid); dft8<true>(v); st8<8>(X, tid, v); FFT_SYNC();
    ld8<64>(X, tid, v); twid<64, true>(v, tid); dft8<true>(v); st8<64>(X, tid, v); FFT_SYNC();
    ld8<512>(X, tid, v); twid<512, true>(v, tid); dft8<true>(v);
}
#endif

struct OneUnit { int pm, pn; bool on;
    __device__ __forceinline__ bool next(int i, pg8::Unit& u) const { if (!on || i > 0) return false; u.pm = pm; u.pn = pn; return true; }
    __device__ __forceinline__ void a_ready(const pg8::Unit&) const {}
    __device__ __forceinline__ void done(const pg8::Unit&) const {}
    __device__ __forceinline__ long a_off(const pg8::Unit& u, size_t tstep) const { return (long)((size_t)u.pm * tstep); }
    __device__ __forceinline__ int lda(int K) const { return K; }
    __device__ __forceinline__ size_t kstep_a() const { return 128; } };

struct EpiB {
    static constexpr bool PERM = true, AFTER_DRAIN = false;
    bf16_t* O; int ldc;
    __device__ __forceinline__ void operator()(const f32x4 (&acc)[2][2][4][2], const pg8::Unit& u, int wr, int wc, int fr, int fq) const {
        const int row0 = u.pm * 256 + wr * 64 + fr, col0 = u.pn * 256 + wc * 32 + 8 * fq;
#pragma unroll
        for (int ai = 0; ai < 2; ++ai)
#pragma unroll
            for (int m = 0; m < 4; ++m) { bf16_t* rowp = O + (size_t)(row0 + ai * 128 + m * 16) * ldc + col0;
#pragma unroll
                for (int bj = 0; bj < 2; ++bj) { const f32x4 v0 = acc[ai][bj][m][0], v1 = acc[ai][bj][m][1];
                    u32x4 w; w.x = pk2(v0[0], v0[1]); w.y = pk2(v0[2], v0[3]); w.z = pk2(v1[0], v1[1]); w.w = pk2(v1[2], v1[3]);
                    *(u32x4*)(rowp + bj * 128) = w; } }
    }
};
struct EpiRope {
    static constexpr bool PERM = true, AFTER_DRAIN = false;
    bf16_t* O; const float2* rope;
    __device__ __forceinline__ void operator()(const f32x4 (&acc)[2][2][4][2], const pg8::Unit& u, int wr, int wc, int fr, int fq) const {
        const int row0 = u.pm * 256 + wr * 64 + fr, col0 = u.pn * 256 + wc * 32 + 8 * fq;
        const bool rot = u.pn < 4;
#pragma unroll
        for (int ai = 0; ai < 2; ++ai)
#pragma unroll
            for (int m = 0; m < 4; ++m) { const int row = row0 + ai * 128 + m * 16; bf16_t* rowp = O + (size_t)row * MIXW + col0;
#pragma unroll
                for (int bj = 0; bj < 2; ++bj) { f32x4 v0 = acc[ai][bj][m][0], v1 = acc[ai][bj][m][1];
                    if (rot) { const int pos = row & (SEQ - 1), i0 = ((col0 + bj * 128) & 63) >> 1;
                        const f32x4* rp = (const f32x4*)(rope + pos * 32 + i0); const f32x4 r0 = rp[0], r1 = rp[1];
                        f32x4 o0, o1;
                        o0[0] = v0[0] * r0[0] - v0[1] * r0[1]; o0[1] = v0[1] * r0[0] + v0[0] * r0[1];
                        o0[2] = v0[2] * r0[2] - v0[3] * r0[3]; o0[3] = v0[3] * r0[2] + v0[2] * r0[3];
                        o1[0] = v1[0] * r1[0] - v1[1] * r1[1]; o1[1] = v1[1] * r1[0] + v1[0] * r1[1];
                        o1[2] = v1[2] * r1[2] - v1[3] * r1[3]; o1[3] = v1[3] * r1[2] + v1[2] * r1[3];
                        v0 = o0; v1 = o1; }
                    u32x4 w; w.x = pk2(v0[0], v0[1]); w.y = pk2(v0[2], v0[3]); w.z = pk2(v1[0], v1[1]); w.w = pk2(v1[2], v1[3]);
                    *(u32x4*)(rowp + bj * 128) = w; } }
    }
};
constexpr int XCH_OFF = 131072 + 1024;
__device__ __forceinline__ void stat_put(LAS cplx* ST, int rowl, int wc, int fq, float s1, float s2, bool first) {
    s1 = xsum32(xsum16(s1)); s2 = xsum32(xsum16(s2));
    if (fq == 0) { LAS cplx* p = ST + rowl * 4 + wc; cplx v; v.x = s1; v.y = s2; if (!first) { const cplx o = *p; v.x += o.x; v.y += o.y; } *p = v; }
}
struct EpiRes {
    static constexpr bool PERM = false, AFTER_DRAIN = false;
    const float* X; float* O; LAS unsigned char* lds; mutable int ecnt;
    __device__ __forceinline__ void operator()(const f32x4 (&acc)[2][2][4][2], const pg8::Unit& u, int wr, int wc, int fr, int fq) const {
        const int row0 = u.pm * 256 + wr * 64 + fr, col0 = u.pn * 256 + wc * 32 + 4 * fq;
        LAS cplx* ST = (LAS cplx*)(lds + XCH_OFF) + (ecnt & 1) * 1024; const bool first = true; ++ecnt;
#pragma unroll
        for (int ai = 0; ai < 2; ++ai) {
            f32x4 xv[4][2][2];
#pragma unroll
            for (int m = 0; m < 4; ++m)
#pragma unroll
                for (int bj = 0; bj < 2; ++bj)
#pragma unroll
                    for (int n = 0; n < 2; ++n) xv[m][bj][n] = *(const f32x4*)(X + (size_t)(row0 + ai * 128 + m * 16) * DM + col0 + bj * 128 + 16 * n);
            asm volatile("" ::: "memory");
#pragma unroll
            for (int m = 0; m < 4; ++m) { float s1 = 0.f, s2 = 0.f;
#pragma unroll
                for (int bj = 0; bj < 2; ++bj)
#pragma unroll
                    for (int n = 0; n < 2; ++n) { const f32x4 o = acc[ai][bj][m][n] + xv[m][bj][n] * ALPHA;
                        *(f32x4*)(O + (size_t)(row0 + ai * 128 + m * 16) * DM + col0 + bj * 128 + 16 * n) = o;
                        s1 += (o[0] + o[1]) + (o[2] + o[3]); s2 += (o[0] * o[0] + o[1] * o[1]) + (o[2] * o[2] + o[3] * o[3]); }
                stat_put(ST, ai * 128 + wr * 64 + m * 16 + fr, wc, fq, s1, s2, first); }
        }
    }
};
struct EpiRes2 {
    static constexpr bool PERM = false, AFTER_DRAIN = false;
    const float* R; float* O; const float2* stat; const float* g; const float* b; LAS unsigned char* lds; mutable int ecnt;
    __device__ __forceinline__ void operator()(const f32x4 (&acc)[2][2][4][2], const pg8::Unit& u, int wr, int wc, int fr, int fq) const {
        const int row0 = u.pm * 256 + wr * 64 + fr, col0 = u.pn * 256 + wc * 32 + 4 * fq;
        LAS cplx* ST = (LAS cplx*)(lds + XCH_OFF) + (ecnt & 1) * 1024; const bool first = true; ++ecnt;
#pragma unroll
        for (int ai = 0; ai < 2; ++ai)
#pragma unroll
            for (int bj = 0; bj < 2; ++bj) {
                f32x4 rv[4][2], gv[2], bv[2]; float2 st[4];
#pragma unroll
                for (int m = 0; m < 4; ++m) { const int row = row0 + ai * 128 + m * 16; st[m] = stat[row];
#pragma unroll
                    for (int n = 0; n < 2; ++n) rv[m][n] = *(const f32x4*)(R + (size_t)row * DM + col0 + bj * 128 + 16 * n); }
#pragma unroll
                for (int n = 0; n < 2; ++n) { gv[n] = *(const f32x4*)(g + col0 + bj * 128 + 16 * n); bv[n] = *(const f32x4*)(b + col0 + bj * 128 + 16 * n); }
                asm volatile("" ::: "memory");
#pragma unroll
                for (int m = 0; m < 4; ++m) { float s1 = 0.f, s2 = 0.f;
#pragma unroll
                    for (int n = 0; n < 2; ++n) { const f32x4 x1 = (rv[m][n] - st[m].x) * st[m].y * gv[n] + bv[n]; const f32x4 o = acc[ai][bj][m][n] + x1 * ALPHA;
                        *(f32x4*)(O + (size_t)(row0 + ai * 128 + m * 16) * DM + col0 + bj * 128 + 16 * n) = o;
                        s1 += (o[0] + o[1]) + (o[2] + o[3]); s2 += (o[0] * o[0] + o[1] * o[1]) + (o[2] * o[2] + o[3] * o[3]); }
                    stat_put(ST, ai * 128 + wr * 64 + m * 16 + fr, wc, fq, s1, s2, first && bj == 0); }
            }
    }
};
template <int MODE> struct EpiLn {
    static constexpr bool PERM = false, AFTER_DRAIN = false;
    const float* RES; float* OF; bf16_t* OB; const float* g; const float* b; unsigned long long* XG; unsigned* CNT; LAS unsigned char* ldsp;
    __device__ __forceinline__ void operator()(const f32x4 (&acc)[2][2][4][2], const pg8::Unit& u, int wr, int wc, int fr, int fq) const {
        const int t_ = threadIdx.x; fused(const_cast<f32x4 (&)[2][2][4][2]>(acc), u, wr, wc, fr, fq, ldsp, __builtin_amdgcn_readfirstlane(t_ >> 6), t_ & 63); }
    __device__ __forceinline__ void fused(f32x4 (&acc)[2][2][4][2], const pg8::Unit& u, int wr, int wc, int fr, int fq, LAS unsigned char* lds, int wid, int lane) const {
        const int tid = wid * 64 + lane, row0 = u.pm * 256 + wr * 64 + fr, col0 = u.pn * 256 + wc * 32 + 4 * fq;
        LAS cplx* ST = (LAS cplx*)(lds + XCH_OFF); LAS cplx* MR = (LAS cplx*)(lds + XCH_OFF + 8192);
#pragma unroll
        for (int ai = 0; ai < 2; ++ai) {
            float s1[4], s2[4];
#pragma unroll
            for (int m = 0; m < 4; ++m) { s1[m] = 0.f; s2[m] = 0.f; }
#pragma unroll
            for (int bj = 0; bj < 2; ++bj) {
                f32x4 xv[4][2];
#pragma unroll
                for (int m = 0; m < 4; ++m)
#pragma unroll
                    for (int n = 0; n < 2; ++n) xv[m][n] = *(const f32x4*)(RES + (size_t)(row0 + ai * 128 + m * 16) * DM + col0 + bj * 128 + 16 * n);
                asm volatile("" ::: "memory");
#pragma unroll
                for (int m = 0; m < 4; ++m)
#pragma unroll
                    for (int n = 0; n < 2; ++n) { const f32x4 o = acc[ai][bj][m][n] + xv[m][n] * ALPHA; acc[ai][bj][m][n] = o;
                        s1[m] += (o[0] + o[1]) + (o[2] + o[3]); s2[m] += (o[0] * o[0] + o[1] * o[1]) + (o[2] * o[2] + o[3] * o[3]); }
            }
#pragma unroll
            for (int m = 0; m < 4; ++m) stat_put(ST, ai * 128 + wr * 64 + m * 16 + fr, wc, fq, s1[m], s2[m], true);
        }
        asm volatile("s_waitcnt lgkmcnt(0)" ::: "memory"); __syncthreads();
        float m1 = 0.f, m2 = 0.f;
        if (tid < 256) { const cplx a0 = ST[tid * 4 + 0], a1 = ST[tid * 4 + 1], a2 = ST[tid * 4 + 2], a3 = ST[tid * 4 + 3];
            m1 = (a0.x + a1.x) + (a2.x + a3.x); m2 = (a0.y + a1.y) + (a2.y + a3.y);
            __hip_atomic_store(XG + (size_t)(u.pm * 4 + u.pn) * 256 + tid, ((unsigned long long)__float_as_uint(m2) << 32) | __float_as_uint(m1), __ATOMIC_RELAXED, __HIP_MEMORY_SCOPE_AGENT); }
        asm volatile("s_waitcnt vmcnt(0)" ::: "memory");
        __syncthreads();
        if (tid == 0) {
            (void)__hip_atomic_fetch_add(CNT + u.pm * 16, 1u, __ATOMIC_RELAXED, __HIP_MEMORY_SCOPE_AGENT);
            unsigned sp = 0;
            while (__hip_atomic_load(CNT + u.pm * 16, __ATOMIC_RELAXED, __HIP_MEMORY_SCOPE_AGENT) < 4u) { __builtin_amdgcn_s_sleep(1); if (++sp > (1u << 22)) break; }
            __builtin_amdgcn_fence(__ATOMIC_ACQUIRE, "agent");
            asm volatile("s_waitcnt vmcnt(0)" ::: "memory");
        }
        __syncthreads();
        if (tid < 256) { float t1 = m1, t2 = m2;
#pragma unroll
            for (int jj = 1; jj < 4; ++jj) { const unsigned long long w = __hip_atomic_load(XG + (size_t)(u.pm * 4 + ((u.pn + jj) & 3)) * 256 + tid, __ATOMIC_RELAXED, __HIP_MEMORY_SCOPE_AGENT);
                t1 += __uint_as_float((unsigned)w); t2 += __uint_as_float((unsigned)(w >> 32)); }
            const float mean = t1 * (1.0f / DM), var = fmaxf(t2 * (1.0f / DM) - mean * mean, 0.f);
            cplx mr; mr.x = mean; mr.y = rsqrtf(var + LN_EPS); MR[tid] = mr; }
        __syncthreads();
#pragma unroll
        for (int bj = 0; bj < 2; ++bj)
#pragma unroll
            for (int n = 0; n < 2; ++n) { const int c = col0 + bj * 128 + 16 * n; const f32x4 gv = *(const f32x4*)(g + c), bv = *(const f32x4*)(b + c);
#pragma unroll
                for (int ai = 0; ai < 2; ++ai)
#pragma unroll
                    for (int m = 0; m < 4; ++m) { const int rl = ai * 128 + wr * 64 + m * 16 + fr; const cplx mr = MR[rl];
                        const f32x4 y = (acc[ai][bj][m][n] - mr.x) * mr.y * gv + bv; const size_t off = (size_t)(u.pm * 256 + rl) * DM + c;
                        *(f32x4*)(OF + off) = y;
                        if (MODE == 1) { u32x2 w; w.x = pk2(y[0], y[1]); w.y = pk2(y[2], y[3]); *(u32x2*)(OB + off) = w; } } }
    }
};
struct QuadTwo { int q, j;
    __device__ __forceinline__ bool next(int i, pg8::Unit& u) const { if (i > 1) return false; u.pm = 2 * q + i; u.pn = j; return true; }
    __device__ __forceinline__ void a_ready(const pg8::Unit&) const {}
    __device__ __forceinline__ void done(const pg8::Unit&) const {}
    __device__ __forceinline__ long a_off(const pg8::Unit& u, size_t tstep) const { return (long)((size_t)u.pm * tstep); }
    __device__ __forceinline__ int lda(int K) const { return K; }
    __device__ __forceinline__ size_t kstep_a() const { return 128; } };
struct QuadTwoKb : QuadTwo {
    __device__ __forceinline__ int lda(int) const { return 64; }
    __device__ __forceinline__ size_t kstep_a() const { return (size_t)NT * 64 * 2; } };
struct OneUnitKb : OneUnit {
    __device__ __forceinline__ int lda(int) const { return 64; }
    __device__ __forceinline__ size_t kstep_a() const { return (size_t)NT * 64 * 2; }
};
struct PairOrder : pg8::StaticOrder {
    bool pair;
    __device__ __forceinline__ static int vcu_of(int c) { return (c & 7) * 32 + (c >> 3); }
    __device__ __forceinline__ bool next(int i, pg8::Unit& u) const {
        if (!pair) return pg8::StaticOrder::next(i, u);
        if (i > 1) return false;
        const int v = vcu_of(c); u.pm = 2 * (v >> 2) + i; u.pn = v & 3; return true; }
};
struct KbOrder : pg8::StaticOrder {
    __device__ __forceinline__ int lda(int) const { return 64; }
    __device__ __forceinline__ size_t kstep_a() const { return (size_t)NT * 64 * 2; }
};
struct PairKb : PairOrder {
    __device__ __forceinline__ int lda(int) const { return 64; }
    __device__ __forceinline__ size_t kstep_a() const { return (size_t)NT * 64 * 2; }
};
struct RevOrder : pg8::StaticOrder {
    __device__ __forceinline__ bool next(int i, pg8::Unit& u) const { const int rounds = (nwg + G - 1) / G; if (i >= rounds) return false; return pg8::StaticOrder::next(rounds - 1 - i, u); }
};
constexpr int CWL_OFF = 131072 + 1024 + 8192;
struct FfnOrder : pg8::StaticOrder {
    const float* cw; const float* cb; LAS unsigned char* lds; mutable int cnt;
    __device__ __forceinline__ long a_off(const pg8::Unit& u, size_t) const { return ((long)u.pm * 254 - 1) * (long)(DM * 2); }
    __device__ __forceinline__ void a_ready(const pg8::Unit& u) const {
        const int tid = threadIdx.x, w = __builtin_amdgcn_readfirstlane(tid >> 6), lane = tid & 63, buf = cnt & 1; ++cnt;
        const float* src = (w < 3) ? cw + (size_t)w * (2 * DFF) : (w < 6) ? cw + (size_t)(w - 3) * (2 * DFF) + DFF : (w == 6) ? cb : cb + DFF;
        src += u.pn * 128 + lane * 4;
        if (lane < 32) __builtin_amdgcn_global_load_lds((const unsigned*)src, (LAS unsigned*)(lds + CWL_OFF + buf * 4096 + w * 512), 16, 0, 0);
    }
};
constexpr int FFN_MT = 130;
__device__ __forceinline__ float dpp_ror1(float v)  { return __int_as_float(__builtin_amdgcn_update_dpp(0, __float_as_int(v), 0x121, 0xF, 0xF, false)); }
__device__ __forceinline__ float dpp_ror15(float v) { return __int_as_float(__builtin_amdgcn_update_dpp(0, __float_as_int(v), 0x12F, 0xF, 0xF, false)); }
struct EpiFfn {
    static constexpr bool PERM = true, AFTER_DRAIN = false;
    bf16_t* ACT; LAS unsigned char* lds; mutable int ecnt;
    __device__ __forceinline__ void operator()(const f32x4 (&acc)[2][2][4][2], const pg8::Unit& u, int wr, int wc, int fr, int fq) const {
        LAS float* XC = (LAS float*)(lds + XCH_OFF);
        const LAS float* WL = (const LAS float*)(lds + CWL_OFF + (ecnt & 1) * 4096); ++ecnt;
        const int colw = wc * 32 + 8 * fq;
        if (fr == 0 || fr == 15) {
            const int edge = (fr == 15) ? 1 : 0, m = (fr == 15) ? 3 : 0;
#pragma unroll
            for (int ai = 0; ai < 2; ++ai)
#pragma unroll
                for (int bj = 0; bj < 2; ++bj)
#pragma unroll
                    for (int n = 0; n < 2; ++n) { const f32x4 v = (m == 0) ? acc[ai][bj][0][n] : acc[ai][bj][3][n];
                        *(LAS f32x4*)(XC + ((ai * 2 + wr) * 2 + edge) * 256 + bj * 128 + colw + 4 * n) = v; }
        }
        asm volatile("s_waitcnt lgkmcnt(0)" ::: "memory"); __builtin_amdgcn_s_barrier(); asm volatile("" ::: "memory");
        const int slot0 = wr * 64 + fr, row_base = u.pm * 254 - 1;
#pragma unroll
        for (int bj = 0; bj < 2; ++bj) {
            const int gc = (u.pn * 256 + bj * 128 + colw) >> 1;
            const LAS float* wl = WL + ((bj * 128 + colw) >> 1);
            f32x4 wg[3], wu[3];
#pragma unroll
            for (int j = 0; j < 3; ++j) { wg[j] = *(const LAS f32x4*)(wl + j * 128); wu[j] = *(const LAS f32x4*)(wl + (3 + j) * 128); }
            const f32x4 bg = *(const LAS f32x4*)(wl + 6 * 128), bu = *(const LAS f32x4*)(wl + 7 * 128);
#pragma unroll
            for (int ai = 0; ai < 2; ++ai) {
                const int gidx = ai * 2 + wr;
                f32x4 pe[2], ne[2];
#pragma unroll
                for (int n = 0; n < 2; ++n) {
                    pe[n] = (gidx > 0) ? *(const LAS f32x4*)(XC + (((gidx - 1) * 2) + 1) * 256 + bj * 128 + colw + 4 * n) : (f32x4){0.f, 0.f, 0.f, 0.f};
                    ne[n] = (gidx < 3) ? *(const LAS f32x4*)(XC + (((gidx + 1) * 2) + 0) * 256 + bj * 128 + colw + 4 * n) : (f32x4){0.f, 0.f, 0.f, 0.f}; }
#pragma unroll
                for (int m = 0; m < 4; ++m) {
                    const int slot = ai * 128 + slot0 + m * 16, row = row_base + slot, t = row & (SEQ - 1);
                    f32x4 hv[2];
#pragma unroll
                    for (int n = 0; n < 2; ++n) {
                        const f32x4 cur = acc[ai][bj][m][n], prv = acc[ai][bj][m == 0 ? 0 : m - 1][n], nxt = acc[ai][bj][m == 3 ? 3 : m + 1][n];
                        f32x4 up, dn;
#pragma unroll
                        for (int e = 0; e < 4; ++e) { up[e] = dpp_ror1(fr == 15 ? prv[e] : cur[e]); dn[e] = dpp_ror15(fr == 0 ? nxt[e] : cur[e]); }
                        if (m == 0 && fr == 0) up = pe[n];
                        if (m == 3 && fr == 15) dn = ne[n];
                        if (t == 0) up = (f32x4){0.f, 0.f, 0.f, 0.f};
                        if (t == SEQ - 1) dn = (f32x4){0.f, 0.f, 0.f, 0.f};
                        const f32x4 w0 = n ? wu[0] : wg[0], w1 = n ? wu[1] : wg[1], w2 = n ? wu[2] : wg[2], bb = n ? bu : bg;
                        hv[n] = w0 * up + w1 * cur + w2 * dn + bb; }
                    if (slot >= 1 && slot <= 254 && row < NT) {
                        float o[4];
#pragma unroll
                        for (int e = 0; e < 4; ++e) { const float g = hv[0][e]; o[e] = g * __builtin_amdgcn_rcpf(1.0f + __expf(-g)) * hv[1][e]; }
                        u32x2 w; w.x = pk2(o[0], o[1]); w.y = pk2(o[2], o[3]);
                        *(u32x2*)(ACT + ((size_t)(gc >> 6) * NT + row) * 64 + (gc & 63)) = w; }
                }
            }
        }
    }
};

__device__ __forceinline__ int win_row(int n) {
    if (n < 1536) return 1536 + n;
    if (n < 2560) { const int q = n - 1536, blk = q >> 6, d = q & 63; return blk * 64 + 2 * (d & 31) + (d >> 5); }
    if (n < 3072) return 512 + n;
    return n - 2048;
}
template <int MODE> __device__ __forceinline__ void p0_transpose_item(const float* W, int K, int N, bf16_t* WT, LAS float* scr, int item, int lane) {
    const int nblk = N / 32, kb = item / nblk, nb = item % nblk, k0 = 64 * kb, n0 = 32 * nb;
    f32x4 q[8];
#pragma unroll
    for (int i = 0; i < 8; ++i) q[i] = *(const f32x4*)(W + (size_t)(k0 + 8 * i + (lane >> 3)) * N + n0 + 4 * (lane & 7));
#pragma unroll
    for (int i = 0; i < 8; ++i) { LAS float* d = scr + (8 * i + (lane >> 3)) * 33 + 4 * (lane & 7); d[0] = q[i][0]; d[1] = q[i][1]; d[2] = q[i][2]; d[3] = q[i][3]; }
    LDS_WAIT(); asm volatile("" ::: "memory");
    const int c = lane & 7;
#pragma unroll
    for (int j = 0; j < 4; ++j) { const int n = (lane >> 3) + 8 * j; const LAS float* s = scr + (8 * c) * 33 + n;
        u32x4 o; o.x = pk2(s[0 * 33], s[1 * 33]); o.y = pk2(s[2 * 33], s[3 * 33]); o.z = pk2(s[4 * 33], s[5 * 33]); o.w = pk2(s[6 * 33], s[7 * 33]);
        const int nn = n0 + n; const int dr = (MODE == 1) ? win_row(nn) : (MODE == 2) ? ((nn < DFF) ? ((nn >> 2) * 8 + (nn & 3)) : (((nn - DFF) >> 2) * 8 + 4 + ((nn - DFF) & 3))) : nn;
        *(u32x4*)(WT + (size_t)dr * K + k0 + 8 * c) = o; }
    LDS_WAIT(); asm volatile("" ::: "memory");
}
__device__ __forceinline__ void cvt_rows(const float* src, bf16_t* dst, size_t n8, int gw, int ngw, int lane) {
    const size_t stride = (size_t)ngw * 64;
    for (size_t i = (size_t)gw * 64 + lane; i < n8; i += 4 * stride) {
        f32x4 a[4], c[4];
#pragma unroll
        for (int u = 0; u < 4; ++u) { const size_t k = i + u * stride; if (k < n8) { a[u] = ((const f32x4*)src)[2 * k]; c[u] = ((const f32x4*)src)[2 * k + 1]; } }
#pragma unroll
        for (int u = 0; u < 4; ++u) { const size_t k = i + u * stride; if (k < n8) {
            u32x4 w; w.x = pk2(a[u][0], a[u][1]); w.y = pk2(a[u][2], a[u][3]); w.z = pk2(c[u][0], c[u][1]); w.w = pk2(c[u][2], c[u][3]);
            ((u32x4*)dst)[k] = w; } }
    }
}
__device__ __forceinline__ void p0_filter_item(const LAS float* w1, const float* b1, const float* fq, const LAS float* w2, const float* b2, const float* w3, float* HTD, int item, int lane) {
    const int t0 = 2 * (item >> 2), ih = item & 3; float h2v[2], tl[2];
    const float fql = fq[lane], b1l = b1[lane], b2l = b2[lane];
#pragma unroll
    for (int tt = 0; tt < 2; ++tt) { const int t = t0 + tt; tl[tt] = (float)t * (1.0f / 2047.0f);
        const float w = 6.283185307179586f * (float)t / 2048.0f;
        float zk = 0.f;
        if (lane == 0) zk = tl[tt];
        else if (lane <= 16) { const float fr = 1e-4f + (float)(lane - 1) * ((15.0f - 1e-4f) / 15.0f); zk = cosf(fr * w); }
        else if (lane <= 32) { const float fr = 1e-4f + (float)(lane - 17) * ((15.0f - 1e-4f) / 15.0f); zk = -sinf(fr * w); }
        float a = b1l;
#pragma unroll 11
        for (int k = 0; k < 33; ++k) a += __shfl(zk, k) * w1[k * 64 + lane];
        const float h1 = sinf(fql * a);
        float a2 = b2l;
#pragma unroll 16
        for (int k = 0; k < 64; ++k) a2 += __shfl(h1, k) * w2[k * 64 + lane];
        h2v[tt] = sinf(fql * a2); }
    const float dmin = -15.350567286626973f, dmax = -3.0701134573253946f;
    float acc0[8], acc1[8];
#pragma unroll
    for (int i = 0; i < 8; ++i) { acc0[i] = 0.f; acc1[i] = 0.f; }
#pragma unroll 8
    for (int j = 0; j < 64; ++j) { const float s0 = __shfl(h2v[0], j), s1 = __shfl(h2v[1], j); const float* wr = w3 + (size_t)j * 2048 + ih * 512 + lane;
#pragma unroll
        for (int i = 0; i < 8; ++i) { const float wv = wr[64 * i]; acc0[i] += s0 * wv; acc1[i] += s1 * wv; } }
#pragma unroll
    for (int i = 0; i < 8; ++i) { const int col = ih * 512 + 64 * i + lane, c = col & 511;
        const float delta = fabsf(dmin + (float)c * ((dmax - dmin) / 511.0f));
        float2 o; o.x = acc0[i] * expf(-tl[0] * delta); o.y = acc1[i] * expf(-tl[1] * delta);
        *(float2*)(HTD + (size_t)col * 2048 + t0) = o; }
}
__device__ __forceinline__ void p0_prep(const float* const* in, unsigned char* ws, LAS unsigned char* lds, int tid) {
    const int lane = tid & 63, wave = __builtin_amdgcn_readfirstlane(tid >> 6), gw = blockIdx.x * NWAVE + wave, ngw = gridDim.x * NWAVE;
    LAS float* scr = (LAS float*)(lds + wave * 8704);
    LAS float* W1L = (LAS float*)(lds + 69632); LAS float* W2L = W1L + 33 * 64;
    for (int i = tid; i < 33 * 64; i += NTHR) W1L[i] = in[5][i];
    for (int i = tid; i < 64 * 64; i += NTHR) W2L[i] = in[8][i];
    __syncthreads();
    bf16_t* WALL = (bf16_t*)(ws + WS_WALL);
    constexpr int I_IN = 16 * (INW / 32), I_KV = 16 * 32, I_OUT = 24 * 32, I_UP = 16 * (2 * DFF / 32), I_DN = (DFF / 64) * 32, NIT = I_IN + I_KV + I_OUT + I_UP + I_DN;
    for (int it = gw; it < NIT; it += ngw) { int r = it;
        if (r < I_IN) { p0_transpose_item<1>(in[2], DM, INW, WALL, scr, r, lane); continue; } r -= I_IN;
        if (r < I_KV) { p0_transpose_item<0>(in[14], DM, 1024, (bf16_t*)(ws + WS_WKV), scr, r, lane); continue; } r -= I_KV;
        if (r < I_OUT) { p0_transpose_item<0>(in[15], MIXW, DM, (bf16_t*)(ws + WS_WOUT), scr, r, lane); continue; } r -= I_OUT;
        if (r < I_UP) { p0_transpose_item<2>(in[18], DM, 2 * DFF, (bf16_t*)(ws + WS_WUP), scr, r, lane); continue; } r -= I_UP;
        p0_transpose_item<0>(in[21], DFF, DM, (bf16_t*)(ws + WS_WDN), scr, r, lane); }
    for (int it = ngw - 1 - gw; it < 4096; it += ngw) p0_filter_item(W1L, in[6], in[7], W2L, in[9], in[10], (float*)(ws + WS_HTD), it, lane);
    cvt_rows(in[0], (bf16_t*)(ws + WS_XB), (size_t)NT * DM / 8, gw, ngw, lane);
    cvt_rows(in[1], (bf16_t*)(ws + WS_MEMB), (size_t)NMT * DM / 8, gw, ngw, lane);
    float2* rope = (float2*)(ws + WS_ROPE);
    for (int i = blockIdx.x * NTHR + tid; i < SEQ * 32; i += gridDim.x * NTHR) { const int pos = i >> 5, f = i & 31;
        const float invf = powf(10000.0f, -(float)(2 * f) / 64.0f); const float ang = (float)pos * invf;
        float2 cs; cs.x = cosf(ang); cs.y = sinf(ang); rope[i] = cs; }
}

__device__ __forceinline__ void filter_fft_item(const float* HTD, float2* KF, LAS unsigned char* lds, int item, int tid) {
    const int o = item >> 9, c = item & 511;
    const float* rf = HTD + (size_t)((o * 2 + 0) * 512 + c) * 2048; const float* rb = HTD + (size_t)((o * 2 + 1) * 512 + c) * 2048;
    cplx v[8];
#pragma unroll
    for (int k = 0; k < 4; ++k) v[k] = mk2(rf[tid + 512 * k], 0.f);
    v[4] = mk2(tid == 0 ? 0.f : rb[2048 - tid], 0.f); v[5] = mk2(rb[1536 - tid], 0.f); v[6] = mk2(rb[1024 - tid], 0.f); v[7] = mk2(rb[512 - tid], 0.f);
    fft_fwd((LAS cplx*)lds, tid, v);
    float2* dst = KF + (size_t)(o * 512 + c) * 4096 + 8 * tid;
#pragma unroll
    for (int m = 0; m < 8; m += 2) { f32x4 w; w[0] = v[m].x * (1.f / 4096.f); w[1] = v[m].y * (1.f / 4096.f); w[2] = v[m + 1].x * (1.f / 4096.f); w[3] = v[m + 1].y * (1.f / 4096.f); *(f32x4*)(dst + m) = w; }
    __syncthreads();
}

constexpr int HY_SEG = 2064, HY_STG_OFF = 36864;
__device__ __forceinline__ float conv3s(const LAS bf16_t* seg, int n, float w0, float w1, float w2, float b) {
    return w0 * bf2f(seg[7 + n]) + w1 * bf2f(seg[8 + n]) + w2 * bf2f(seg[9 + n]) + b;
}
__device__ __forceinline__ void hyena_item(const bf16_t* HT, const float2* KF, const float* cw, const float* cb, const float* hb, bf16_t* MIX, LAS unsigned char* lds, int bp, int cgp, int tid0) {
    LAS cplx* X = (LAS cplx*)lds; LAS bf16_t* STG = (LAS bf16_t*)(lds + HY_STG_OFF); LAS cplx* TW = (LAS cplx*)(lds + 65536);
    const int ba = 2 * bp;
    twid_fill<512>(TW, tid0); twid_fill<64>(TW, tid0); twid_fill<8>(TW, tid0);
    u32x4 oacc[8];
#pragma unroll
    for (int i = 0; i < 8; ++i) oacc[i] = (u32x4){0u, 0u, 0u, 0u};
    if (tid0 < 12) { const int sg = tid0 >> 1; STG[sg * HY_SEG + ((tid0 & 1) ? 2056 : 7)] = 0; }
    { const int c = cgp * 8;
#pragma unroll
      for (int i = 0; i < 3; ++i) { const int id = tid0 + 512 * i, sg = id >> 8, ch = id & 255;
          const u32x4 q = *(const u32x4*)(HT + (size_t)((sg >> 1) * 512 + c) * NT + (ba + (sg & 1)) * SEQ + ch * 8);
          *(LAS u32x4*)(STG + sg * HY_SEG + 8 + ch * 8) = q; } }
    __syncthreads();
#pragma unroll 1
    for (int cc = 0; cc < 8; ++cc) {
        const int c = cgp * 8 + cc;
        int tl_ = tid0; asm volatile("" : "+v"(tl_)); const int tid = tl_;
        u32x4 nx[3];
        if (cc < 7) {
#pragma unroll
            for (int i = 0; i < 3; ++i) { const int id = tid + 512 * i, sg = id >> 8, ch = id & 255;
                nx[i] = *(const u32x4*)(HT + (size_t)((sg >> 1) * 512 + c + 1) * NT + (ba + (sg & 1)) * SEQ + ch * 8); } }
        f32x4 kf[4];
        { const f32x4* kp = (const f32x4*)(KF + (size_t)c * 4096 + 8 * tid);
#pragma unroll
          for (int m = 0; m < 4; ++m) kf[m] = kp[m]; }
        cplx v[8]; float va[4], vb[4];
        { const float w0 = cw[c], w1 = cw[1536 + c], w2 = cw[3072 + c], b = cb[c];
#pragma unroll
          for (int k = 0; k < 4; ++k) { const int n = tid + 512 * k; va[k] = conv3s(STG, n, w0, w1, w2, b); vb[k] = conv3s(STG + HY_SEG, n, w0, w1, w2, b); v[k] = mk2(va[k], vb[k]); v[4 + k] = mk2(0.f, 0.f); } }
        fft_fwdL(X, TW, tid, v);
#pragma unroll
        for (int m = 0; m < 8; m += 2) { const f32x4 w = kf[m >> 1]; v[m] = cmul(v[m], mk2(w[0], w[1])); v[m + 1] = cmul(v[m + 1], mk2(w[2], w[3])); }
        { const f32x4* kp = (const f32x4*)(KF + (size_t)(512 + c) * 4096 + 8 * tid);
#pragma unroll
          for (int m = 0; m < 4; ++m) kf[m] = kp[m]; }
        fft_invL(X, TW, tid, v);
        { const float w0 = cw[512 + c], w1 = cw[1536 + 512 + c], w2 = cw[3072 + 512 + c], b = cb[512 + c], hb0 = hb[c];
#pragma unroll
          for (int k = 0; k < 4; ++k) { const int n = tid + 512 * k; const float xa = conv3s(STG + 2 * HY_SEG, n, w0, w1, w2, b), xb = conv3s(STG + 3 * HY_SEG, n, w0, w1, w2, b);
              va[k] = xa * (v[k].x + hb0 * va[k]); vb[k] = xb * (v[k].y + hb0 * vb[k]); v[k] = mk2(va[k], vb[k]); v[4 + k] = mk2(0.f, 0.f); } }
        fft_fwdL(X, TW, tid, v);
#pragma unroll
        for (int m = 0; m < 8; m += 2) { const f32x4 w = kf[m >> 1]; v[m] = cmul(v[m], mk2(w[0], w[1])); v[m + 1] = cmul(v[m + 1], mk2(w[2], w[3])); }
        fft_invL(X, TW, tid, v);
        { const float w0 = cw[1024 + c], w1 = cw[1536 + 1024 + c], w2 = cw[3072 + 1024 + c], b = cb[1024 + c], hb1 = hb[512 + c];
#pragma unroll
          for (int k = 0; k < 4; ++k) { const int n = tid + 512 * k; const float xa = conv3s(STG + 4 * HY_SEG, n, w0, w1, w2, b), xb = conv3s(STG + 5 * HY_SEG, n, w0, w1, w2, b);
              const float oa = xa * (v[k].x + hb1 * va[k]), ob = xb * (v[k].y + hb1 * vb[k]);
              const unsigned pw = pk2(oa, ob);
#pragma unroll
              for (int hh = 0; hh < 2; ++hh) { u32x4& o = oacc[2 * k + hh]; const unsigned nw = hh ? (pw & 0xffff0000u) : (pw << 16);
                  o.x = __builtin_amdgcn_alignbit(o.y, o.x, 16); o.y = __builtin_amdgcn_alignbit(o.z, o.y, 16); o.z = __builtin_amdgcn_alignbit(o.w, o.z, 16); o.w = (o.w >> 16) | nw; } } }
        __syncthreads();
        if (cc < 7) {
#pragma unroll
            for (int i = 0; i < 3; ++i) { const int id = tid + 512 * i, sg = id >> 8, ch = id & 255; *(LAS u32x4*)(STG + sg * HY_SEG + 8 + ch * 8) = nx[i]; } }
        __syncthreads();
    }
    int tw_ = tid0; asm volatile("" : "+v"(tw_)); const int tid = tw_;
#pragma unroll
    for (int k = 0; k < 4; ++k)
#pragma unroll
        for (int hh = 0; hh < 2; ++hh) *(u32x4*)(MIX + (size_t)((ba + hh) * SEQ + tid + 512 * k) * MIXW + cgp * 8) = oacc[2 * k + hh];
}

constexpr int ATT_KP = 272, ATT_VP = 144, ATT_KB = 64 * ATT_KP, ATT_VB = 128 * ATT_VP, ATT_VOFF = 2 * ATT_KB;
__device__ __forceinline__ float half_swap_max(float v) { const auto r_ = __builtin_amdgcn_permlane32_swap(__float_as_uint(v), __float_as_uint(v), false, false); return fmaxf(__uint_as_float(r_[0]), __uint_as_float(r_[1])); }
__device__ __forceinline__ float half_swap_sum(float v) { const auto r_ = __builtin_amdgcn_permlane32_swap(__float_as_uint(v), __float_as_uint(v), false, false); return __uint_as_float(r_[0]) + __uint_as_float(r_[1]); }
__device__ __forceinline__ void att_vput(LAS unsigned char* p, u32x4 q) { u32x2 lo, hi; lo.x = q.x; lo.y = q.y; hi.x = q.z; hi.y = q.w; *(LAS u32x2*)p = lo; *(LAS u32x2*)(p + 16) = hi; }
template <int NC> __device__ __forceinline__ void attn_unit(LAS unsigned char* lds, const bf16_t* Qp, int ldq, const bf16_t* Kp, int ldk, const bf16_t* Vt, int ldv, int nkeys, float sl2,
                                                            bf16_t* Op, int ldo, float lam, const float* subg, int tid) {
    constexpr int NSTEP = (NC == 2) ? 4 : 8;
    const int lane = tid & 63, wave = tid >> 6, r = lane & 31, h = lane >> 5;
    const int qb = (NC == 2) ? (wave & 3) : wave, comp = (NC == 2) ? (wave >> 2) : 0, dbase = comp * 64;
    bf16x8 qf[NSTEP];
#pragma unroll
    for (int st = 0; st < NSTEP; ++st) qf[st] = *(const bf16x8*)(Qp + (size_t)(qb * 32 + r) * ldq + dbase + 16 * st + 8 * h);
    f32x16 o[4];
#pragma unroll
    for (int et = 0; et < 4; ++et)
#pragma unroll
        for (int i = 0; i < 16; ++i) o[et][i] = 0.f;
    float mold = -INFINITY, lsum = 0.f;
    const int kr0 = tid >> 4, kc = tid & 15, vr0 = tid >> 3, vc = tid & 7;
    const bf16_t* kg = Kp + (size_t)kr0 * ldk + kc * 8; const bf16_t* vg = Vt + (size_t)vr0 * ldv + vc * 8;
    const int kl = kr0 * ATT_KP + kc * 16, vl = ATT_VOFF + vr0 * ATT_VP + (vc >> 1) * 32 + (vc & 1) * 8;
    const int nt = nkeys / 64;
    u32x4 pk0, pk1, pv0, pv1;
    pk0 = *(const u32x4*)(kg); pk1 = *(const u32x4*)(kg + (size_t)32 * ldk); pv0 = *(const u32x4*)(vg); pv1 = *(const u32x4*)(vg + (size_t)64 * ldv);
    *(LAS u32x4*)(lds + kl) = pk0; *(LAS u32x4*)(lds + kl + 32 * ATT_KP) = pk1; att_vput(lds + vl, pv0); att_vput(lds + vl + 64 * ATT_VP, pv1);
    __syncthreads();
    for (int it = 0; it < nt; ++it) {
        const int cur = it & 1; const bool more = (it + 1 < nt);
        if (more) { const bf16_t* kg2 = kg + (size_t)(it + 1) * 64 * ldk; const bf16_t* vg2 = vg + (it + 1) * 64;
            pk0 = *(const u32x4*)(kg2); pk1 = *(const u32x4*)(kg2 + (size_t)32 * ldk); pv0 = *(const u32x4*)(vg2); pv1 = *(const u32x4*)(vg2 + (size_t)64 * ldv); }
        LAS unsigned char* Kb = lds + cur * ATT_KB; LAS unsigned char* Vb = lds + ATT_VOFF + cur * ATT_VB;
        f32x16 s[2];
#pragma unroll
        for (int kb = 0; kb < 2; ++kb) {
#pragma unroll
            for (int i = 0; i < 16; ++i) s[kb][i] = 0.f;
#pragma unroll
            for (int st = 0; st < NSTEP; ++st) { const bf16x8 a = *(const LAS bf16x8*)(Kb + (kb * 32 + r) * ATT_KP + (dbase + 16 * st + 8 * h) * 2);
                s[kb] = __builtin_amdgcn_mfma_f32_32x32x16_bf16(a, qf[st], s[kb], 0, 0, 0); } }
        float mx = s[0][0];
#pragma unroll
        for (int i = 1; i < 16; ++i) mx = fmaxf(mx, s[0][i]);
#pragma unroll
        for (int i = 0; i < 16; ++i) mx = fmaxf(mx, s[1][i]);
        mx = half_swap_max(mx);
        const float mnew = fmaxf(mold, mx * sl2), alpha = __builtin_amdgcn_exp2f(mold - mnew); mold = mnew;
        float ps = 0.f;
#pragma unroll
        for (int kb = 0; kb < 2; ++kb)
#pragma unroll
            for (int i = 0; i < 16; ++i) { const float p = __builtin_amdgcn_exp2f(__builtin_fmaf(s[kb][i], sl2, -mnew)); s[kb][i] = p; ps += p; }
        lsum = lsum * alpha + ps;
#pragma unroll
        for (int et = 0; et < 4; ++et)
#pragma unroll
            for (int i = 0; i < 16; ++i) o[et][i] *= alpha;
#pragma unroll
        for (int kb = 0; kb < 2; ++kb)
#pragma unroll
            for (int s2 = 0; s2 < 2; ++s2) {
                u32x4 pw; pw.x = pk2(s[kb][8 * s2 + 0], s[kb][8 * s2 + 1]); pw.y = pk2(s[kb][8 * s2 + 2], s[kb][8 * s2 + 3]); pw.z = pk2(s[kb][8 * s2 + 4], s[kb][8 * s2 + 5]); pw.w = pk2(s[kb][8 * s2 + 6], s[kb][8 * s2 + 7]);
                const bf16x8 pf = __builtin_bit_cast(bf16x8, pw);
#pragma unroll
                for (int et = 0; et < 4; ++et) { const u32x4 aw = *(const LAS u32x4*)(Vb + (et * 32 + r) * ATT_VP + (kb * 2 + s2) * 32 + h * 16);
                    o[et] = __builtin_amdgcn_mfma_f32_32x32x16_bf16(__builtin_bit_cast(bf16x8, aw), pf, o[et], 0, 0, 0); } }
        if (more) { const int nb = cur ^ 1;
            *(LAS u32x4*)(lds + nb * ATT_KB + kl) = pk0; *(LAS u32x4*)(lds + nb * ATT_KB + kl + 32 * ATT_KP) = pk1;
            att_vput(lds + nb * ATT_VB + vl, pv0); att_vput(lds + nb * ATT_VB + vl + 64 * ATT_VP, pv1); }
        __syncthreads();
    }
    lsum = half_swap_sum(lsum);
    const float inv = 1.0f / lsum;
    if (NC == 1) {
        bf16_t* orow = Op + (size_t)(qb * 32 + r) * ldo;
#pragma unroll
        for (int et = 0; et < 4; ++et)
#pragma unroll
            for (int g = 0; g < 4; ++g) { u32x2 w; w.x = pk2(o[et][4 * g] * inv, o[et][4 * g + 1] * inv); w.y = pk2(o[et][4 * g + 2] * inv, o[et][4 * g + 3] * inv);
                *(u32x2*)(orow + et * 32 + 8 * g + 4 * h) = w; }
    } else {
        LAS float* XL = (LAS float*)lds;
        if (comp == 1) {
#pragma unroll
            for (int et = 0; et < 4; ++et)
#pragma unroll
                for (int i = 0; i < 16; ++i) XL[(qb * 64 + et * 16 + i) * 64 + lane] = o[et][i] * inv;
        }
        __syncthreads();
        if (comp == 0) {
            float ss = 0.f;
#pragma unroll
            for (int et = 0; et < 4; ++et)
#pragma unroll
                for (int i = 0; i < 16; ++i) { const float ov = o[et][i] * inv - lam * XL[(qb * 64 + et * 16 + i) * 64 + lane]; o[et][i] = ov; ss += ov * ov; }
            ss = half_swap_sum(ss);
            const float rs = rsqrtf(ss * (1.0f / 128.0f) + RMS_EPS) * 0.8f;
            bf16_t* orow = Op + (size_t)(qb * 32 + r) * ldo;
#pragma unroll
            for (int et = 0; et < 4; ++et)
#pragma unroll
                for (int g = 0; g < 4; ++g) { const int e = et * 32 + 8 * g + 4 * h; const f32x4 gv = *(const f32x4*)(subg + e);
                    u32x2 w; w.x = pk2(o[et][4 * g] * rs * gv[0], o[et][4 * g + 1] * rs * gv[1]); w.y = pk2(o[et][4 * g + 2] * rs * gv[2], o[et][4 * g + 3] * rs * gv[3]);
                    *(u32x2*)(orow + e) = w; }
        }
        __syncthreads();
    }
}

template <bool TO_BF16> __device__ __forceinline__ void ln_rows(float* io, bf16_t* ob, float2* stat, const float* g, const float* b, int tid, float* alt = nullptr) {
    const int lane = tid & 63, gw = blockIdx.x * NWAVE + (tid >> 6), ngw = gridDim.x * NWAVE;
    f32x4 gv[4], bv[4];
#pragma unroll
    for (int j = 0; j < 4; ++j) { gv[j] = ((const f32x4*)g)[lane + 64 * j]; bv[j] = ((const f32x4*)b)[lane + 64 * j]; }
    for (int row0 = gw; row0 < NT; row0 += 2 * ngw) {
        f32x4 v[2][4];
#pragma unroll
        for (int u = 0; u < 2; ++u) { const int row = row0 + u * ngw; if (row < NT) { const f32x4* xr = (const f32x4*)(io + (size_t)row * DM) + lane;
#pragma unroll
            for (int j = 0; j < 4; ++j) v[u][j] = xr[64 * j]; } }
#pragma unroll
        for (int u = 0; u < 2; ++u) { const int row = row0 + u * ngw; if (row >= NT) continue;
            float s = 0.f;
#pragma unroll
            for (int j = 0; j < 4; ++j) s += (v[u][j][0] + v[u][j][1]) + (v[u][j][2] + v[u][j][3]);
            s = wave_allsum(s, lane);
            const float mean = s * (1.0f / DM); float s2 = 0.f;
#pragma unroll
            for (int j = 0; j < 4; ++j) { v[u][j] = v[u][j] - mean; s2 += (v[u][j][0] * v[u][j][0] + v[u][j][1] * v[u][j][1]) + (v[u][j][2] * v[u][j][2] + v[u][j][3] * v[u][j][3]); }
            s2 = wave_allsum(s2, lane);
            const float rstd = rsqrtf(s2 * (1.0f / DM) + LN_EPS);
            if (TO_BF16) {
                u32x2* o8 = (u32x2*)(ob + (size_t)row * DM) + lane;
#pragma unroll
                for (int j = 0; j < 4; ++j) { const f32x4 y = v[u][j] * rstd * gv[j] + bv[j]; u32x2 w; w.x = pk2(y[0], y[1]); w.y = pk2(y[2], y[3]); o8[64 * j] = w; }
                if (lane == 0) { float2 st; st.x = mean; st.y = rstd; stat[row] = st; }
            } else {
                f32x4* wr_ = (alt ? (f32x4*)(alt + (size_t)row * DM) : (f32x4*)(io + (size_t)row * DM)) + lane;
#pragma unroll
                for (int j = 0; j < 4; ++j) wr_[64 * j] = v[u][j] * rstd * gv[j] + bv[j];
            }
        }
    }
}

__device__ __forceinline__ void convgate_half(const bf16_t* HH, bf16_t* ACT, const float* cw, const float* cb, int half, int tid) {
    constexpr int NG = DFF / 8; const int total = (NT / 2) * NG;
    for (int idx = blockIdx.x * NTHR + tid; idx < total; idx += gridDim.x * NTHR) {
        const int rl = idx / NG, cg8 = idx - rl * NG, n0 = cg8 * 8, t = rl & (SEQ - 1);
        const bf16_t* hp = HH + (size_t)rl * (2 * DFF);
        float gsum[8], usum[8];
#pragma unroll
        for (int e = 0; e < 8; ++e) { gsum[e] = cb[n0 + e]; usum[e] = cb[DFF + n0 + e]; }
#pragma unroll
        for (int j = 0; j < 3; ++j) { const int tt = t + j - 1; if (tt < 0 || tt >= SEQ) continue;
            const u32x4 gq = *(const u32x4*)(hp + (ptrdiff_t)(j - 1) * (2 * DFF) + n0), uq = *(const u32x4*)(hp + (ptrdiff_t)(j - 1) * (2 * DFF) + DFF + n0);
            const float* wg = cw + (size_t)j * (2 * DFF) + n0; const float* wu = wg + DFF;
            const f32x4 wg0 = *(const f32x4*)wg, wg1 = *(const f32x4*)(wg + 4), wu0 = *(const f32x4*)wu, wu1 = *(const f32x4*)(wu + 4);
            gsum[0] += wg0[0] * lo2f(gq.x); gsum[1] += wg0[1] * hi2f(gq.x); gsum[2] += wg0[2] * lo2f(gq.y); gsum[3] += wg0[3] * hi2f(gq.y);
            gsum[4] += wg1[0] * lo2f(gq.z); gsum[5] += wg1[1] * hi2f(gq.z); gsum[6] += wg1[2] * lo2f(gq.w); gsum[7] += wg1[3] * hi2f(gq.w);
            usum[0] += wu0[0] * lo2f(uq.x); usum[1] += wu0[1] * hi2f(uq.x); usum[2] += wu0[2] * lo2f(uq.y); usum[3] += wu0[3] * hi2f(uq.y);
            usum[4] += wu1[0] * lo2f(uq.z); usum[5] += wu1[1] * hi2f(uq.z); usum[6] += wu1[2] * lo2f(uq.w); usum[7] += wu1[3] * hi2f(uq.w); }
        float a[8];
#pragma unroll
        for (int e = 0; e < 8; ++e) a[e] = gsum[e] / (1.0f + __expf(-gsum[e])) * usum[e];
        u32x4 w; w.x = pk2(a[0], a[1]); w.y = pk2(a[2], a[3]); w.z = pk2(a[4], a[5]); w.w = pk2(a[6], a[7]);
        *(u32x4*)(ACT + (size_t)(half * (NT / 2) + rl) * DFF + n0) = w;
    }
}

#define XB_TMO      128
#define XB_XCNT(j)  (256  + 64 * (j))
#define XB_XSUB(j)  (1280 + 64 * (j))
#define XB_XGEN(j)  (2304 + 64 * (j))
#define XB_TOP      3328
#define XB_TOPGEN   3392
#define XCD_BAR_WORDS 3456
#define XB_SPIN_CAP (1u << 18)

__device__ __forceinline__ unsigned xb_ld(unsigned* p)              { return __hip_atomic_load(p, __ATOMIC_RELAXED, __HIP_MEMORY_SCOPE_AGENT); }
__device__ __forceinline__ unsigned xb_add(unsigned* p, unsigned v) { return __hip_atomic_fetch_add(p, v, __ATOMIC_RELAXED, __HIP_MEMORY_SCOPE_AGENT); }
__device__ __forceinline__ unsigned xb_xcc_id() { return (unsigned)__builtin_amdgcn_s_getreg((3 << 11) | 20) & 0xFu; }
#define XB_SPIN(cond, bar) do { unsigned _sp = 0; while (cond) { __builtin_amdgcn_s_sleep(1); \
    if ((++_sp & 255u) == 0u) { if (xb_ld(&(bar)[XB_TMO])) break; if (_sp > XB_SPIN_CAP) { atomicAdd(&(bar)[XB_TMO], 1u); break; } } } } while (0)

struct XcdBarrier {
    unsigned* bar; unsigned x;
    volatile LAS unsigned* st;
};

__device__ __forceinline__ XcdBarrier xcd_barrier_post(unsigned* bar, volatile LAS unsigned* st) {
    XcdBarrier b; b.bar = bar; b.x = xb_xcc_id(); b.st = st;
    if (threadIdx.x == 0) (void)xb_add(&bar[XB_XCNT(b.x)], 1u);
    return b;
}
__device__ __forceinline__ void xcd_barrier_complete(unsigned* bar, unsigned x, unsigned& nloc, unsigned& nx) {
    const unsigned G = gridDim.x * gridDim.y * gridDim.z;
    unsigned sum, cnt, mine, sp = 0u;
    for (;;) {
        sum = 0u; cnt = 0u; mine = 0u;
#pragma unroll
        for (unsigned j = 0; j < 16; ++j) { const unsigned c = xb_ld(&bar[XB_XCNT(j)]); sum += c; cnt += (c > 0u) ? 1u : 0u; mine = (j == x) ? c : mine; }
        if (sum == G) break;
        __builtin_amdgcn_s_sleep(1);
        if ((++sp & 255u) == 0u) { if (xb_ld(&bar[XB_TMO])) break; if (sp > XB_SPIN_CAP) { atomicAdd(&bar[XB_TMO], 1u); break; } }
    }
    nloc = mine > 0u ? mine : 1u; nx = cnt > 0u ? cnt : 1u;
}

__device__ __forceinline__ void xcd_barrier(const XcdBarrier& b) {
    asm volatile("s_waitcnt vmcnt(0)" ::: "memory");
    __syncthreads();
    if (threadIdx.x == 0) {
        unsigned* bar = b.bar;
        __builtin_amdgcn_s_waitcnt(0);
        unsigned nloc = b.st[0], nx = b.st[1];
        if (nloc == 0u) { xcd_barrier_complete(bar, b.x, nloc, nx); b.st[0] = nloc; b.st[1] = nx; }
        const unsigned old = xb_add(&bar[XB_XSUB(b.x)], 1u);
        const unsigned gen = old / nloc;
        if (old + 1u == (gen + 1u) * nloc) {
            __builtin_amdgcn_fence(__ATOMIC_RELEASE, "agent");
            asm volatile("s_waitcnt vmcnt(0)" ::: "memory");
            const unsigned og = xb_add(&bar[XB_TOP], 1u);
            const unsigned tg = og / nx;
            if (og + 1u == (tg + 1u) * nx) xb_add(&bar[XB_TOPGEN], 1u);
            else XB_SPIN(xb_ld(&bar[XB_TOPGEN]) == tg, bar);
            __builtin_amdgcn_fence(__ATOMIC_ACQUIRE, "agent");
            xb_add(&bar[XB_XGEN(b.x)], 1u);
            asm volatile("s_waitcnt vmcnt(0)" ::: "memory");
        } else {
            XB_SPIN(xb_ld(&bar[XB_XGEN(b.x)]) == gen, bar);
            __builtin_amdgcn_fence(__ATOMIC_ACQUIRE, "agent");
            asm volatile("s_waitcnt vmcnt(0)" ::: "memory");
        }
    }
    __syncthreads();
}

template <int MODE> __device__ __forceinline__ void panel_finish(LAS unsigned char* lds, float* io, bf16_t* x1b, float2* stat, const float* g, const float* b, unsigned long long* XG, unsigned* CNT, int cu, int tid) {
    const int v = PairOrder::vcu_of(cu), q = v >> 2, j = v & 3, lane = tid & 63, wave = tid >> 6;
    LAS cplx* ST = (LAS cplx*)(lds + XCH_OFF); LAS cplx* MR = (LAS cplx*)lds;
    asm volatile("s_waitcnt lgkmcnt(0)" ::: "memory"); __syncthreads();
    const int ui = tid >> 8, rowl = tid & 255;
    float m1, m2;
    { const cplx a0 = ST[tid * 4 + 0], a1 = ST[tid * 4 + 1], a2 = ST[tid * 4 + 2], a3 = ST[tid * 4 + 3];
      m1 = (a0.x + a1.x) + (a2.x + a3.x); m2 = (a0.y + a1.y) + (a2.y + a3.y);
      __hip_atomic_store(XG + (size_t)((2 * q + ui) * 4 + j) * 256 + rowl, ((unsigned long long)__float_as_uint(m2) << 32) | __float_as_uint(m1), __ATOMIC_RELAXED, __HIP_MEMORY_SCOPE_AGENT); }
    asm volatile("s_waitcnt vmcnt(0)" ::: "memory");
    __syncthreads();
    if (tid == 0) {
        (void)__hip_atomic_fetch_add(CNT + (2 * q) * 16, 1u, __ATOMIC_RELAXED, __HIP_MEMORY_SCOPE_AGENT);
        (void)__hip_atomic_fetch_add(CNT + (2 * q + 1) * 16, 1u, __ATOMIC_RELAXED, __HIP_MEMORY_SCOPE_AGENT);
        unsigned sp = 0;
        while (__hip_atomic_load(CNT + (2 * q) * 16, __ATOMIC_RELAXED, __HIP_MEMORY_SCOPE_AGENT) < 4u || __hip_atomic_load(CNT + (2 * q + 1) * 16, __ATOMIC_RELAXED, __HIP_MEMORY_SCOPE_AGENT) < 4u) {
            __builtin_amdgcn_s_sleep(1); if (++sp > (1u << 22)) break; }
        __builtin_amdgcn_fence(__ATOMIC_ACQUIRE, "agent");
        asm volatile("s_waitcnt vmcnt(0)" ::: "memory");
    }
    __syncthreads();
    { float t1 = m1, t2 = m2;
#pragma unroll
      for (int jj = 1; jj < 4; ++jj) { const unsigned long long w = __hip_atomic_load(XG + (size_t)((2 * q + ui) * 4 + ((j + jj) & 3)) * 256 + rowl, __ATOMIC_RELAXED, __HIP_MEMORY_SCOPE_AGENT);
          t1 += __uint_as_float((unsigned)w); t2 += __uint_as_float((unsigned)(w >> 32)); }
      const float mean = t1 * (1.0f / DM), var = fmaxf(t2 * (1.0f / DM) - mean * mean, 0.f), rstd = rsqrtf(var + LN_EPS);
      cplx mr; mr.x = mean; mr.y = rstd; MR[tid] = mr;
      if (MODE == 1 && j == 0) { float2 sv; sv.x = mean; sv.y = rstd; stat[(2 * q + ui) * 256 + rowl] = sv; } }
    __syncthreads();
    const int cbase = j * 256 + lane * 4;
    const f32x4 g0 = *(const f32x4*)(g + cbase), b0 = *(const f32x4*)(b + cbase);
#pragma unroll 1
    for (int it = 0; it < 8; ++it) {
        const int u2 = it >> 2, rb = (it & 3) * 8; const size_t rbase = (size_t)((2 * q + u2) * 256 + wave * 32 + rb);
        f32x4 x0[8];
#pragma unroll
        for (int i = 0; i < 8; ++i) x0[i] = *(const f32x4*)(io + (rbase + i) * DM + cbase);
        asm volatile("" ::: "memory");
#pragma unroll
        for (int i = 0; i < 8; ++i) { const cplx mr = MR[u2 * 256 + wave * 32 + rb + i];
            const f32x4 y0 = (x0[i] - mr.x) * mr.y * g0 + b0;
            if (MODE == 1) { u32x2 w0; w0.x = pk2(y0[0], y0[1]); w0.y = pk2(y0[2], y0[3]); *(u32x2*)(x1b + (rbase + i) * DM + cbase) = w0; }
            else *(f32x4*)(io + (rbase + i) * DM + cbase) = y0; }
    }
}

#ifndef PH_MASK
#define PH_MASK 0xFFFFFF
#endif
#define PH(k) ((PH_MASK >> (k)) & 1)
#ifndef G5ORDER
#define G5ORDER KbOrder
#endif
#ifndef REP_P0
#define REP_P0 1
#endif
#ifndef REP_G1
#define REP_G1 1
#endif
#ifndef REP_DIFF
#define REP_DIFF 1
#endif
#ifndef REP_HY
#define REP_HY 1
#endif
#ifndef REP_MEM
#define REP_MEM 1
#endif
#ifndef REP_G3
#define REP_G3 1
#endif
#ifndef REP_G4
#define REP_G4 1
#endif
#ifndef REP_LN1
#define REP_LN1 1
#endif
struct Args { const float* in[24]; float* out; unsigned char* ws; };
__global__ void __launch_bounds__(NTHR, 2) hybrid_fwd(Args a) {
    extern __shared__ __attribute__((aligned(16))) unsigned char smem[];
    LAS unsigned char* lds = (LAS unsigned char*)smem;
    cg::grid_group grid = cg::this_grid();
    volatile LAS unsigned* bst = (volatile LAS unsigned*)(lds + LDS_BYTES - 64);
    if (threadIdx.x < 2) bst[threadIdx.x] = 0u;
    __syncthreads();
    const XcdBarrier bar = xcd_barrier_post((unsigned*)(a.ws + WS_BAR), bst);
    const int G = gridDim.x;
#define NEWPHASE() int tid_ = threadIdx.x, cu_ = blockIdx.x; asm volatile("" : "+v"(tid_)); asm volatile("" : "+s"(cu_)); const int tid = tid_, cu = cu_; (void)tid; (void)cu;
    unsigned char* ws = a.ws;
    bf16_t* WALL = (bf16_t*)(ws + WS_WALL); bf16_t* XB = (bf16_t*)(ws + WS_XB); bf16_t* MEMB = (bf16_t*)(ws + WS_MEMB); bf16_t* WKV = (bf16_t*)(ws + WS_WKV);
    bf16_t* QKM = (bf16_t*)(ws + WS_QKM); bf16_t* HT = (bf16_t*)(ws + WS_HT); bf16_t* KMEM = (bf16_t*)(ws + WS_KMEM); bf16_t* VMT = (bf16_t*)(ws + WS_VMT);
    float2* KF = (float2*)(ws + WS_KF); bf16_t* MIX = (bf16_t*)(ws + WS_MIX); float2* STAT = (float2*)(ws + WS_STAT);
    bf16_t* X1B = (bf16_t*)(ws + WS_X1B); bf16_t* HH = (bf16_t*)(ws + WS_HH); bf16_t* ACT = (bf16_t*)(ws + WS_ACT);

    for (int rep = 0; rep < REP_P0; ++rep) { NEWPHASE(); if (PH(0)) p0_prep(a.in, ws, lds, tid); }
    if (a.ws == nullptr) grid.sync();
    xcd_barrier(bar);

    for (int rep = 0; rep < REP_G1; ++rep) {
    if (PH(1)) { NEWPHASE(); pg8::Gemm g{XB, WALL, NT, 1536, DM}; pg8::StaticOrder S; S.init(g.M, g.N, G, cu);
      EpiRope E{QKM, (const float2*)(ws + WS_ROPE)};
      pg8::gemm_phase<EpiRope, pg8::StaticOrder, true, true>(lds, g, S, E); }
    if (PH(2)) { NEWPHASE(); pg8::Gemm g{WALL + (size_t)1536 * DM, XB, 2048, NT, DM}; pg8::StaticOrder S; S.init(g.M, g.N, G, cu);
      EpiB E{HT, NT};
      pg8::gemm_phase<EpiB, pg8::StaticOrder, true, true>(lds, g, S, E); }
    }
    if (PH(3)) { NEWPHASE(); const bool isK = cu < 32, on = cu < 64; const int c2 = cu - 32;
      pg8::Gemm g; EpiB E; OneUnit S;
      if (isK) { g = pg8::Gemm{MEMB, WKV, NMT, 512, DM}; E = EpiB{KMEM, 512}; S = OneUnit{cu >> 1, cu & 1, on}; }
      else { g = pg8::Gemm{WKV + (size_t)512 * DM, MEMB, 512, NMT, DM}; E = EpiB{VMT, NMT}; S = OneUnit{(c2 >> 4) & 1, c2 & 15, on}; }
      pg8::gemm_phase<EpiB, OneUnit, false, true>(lds, g, S, E);
      __syncthreads();
      if (!on) for (int it = cu - 64; it < 1024; it += G - 64) filter_fft_item((const float*)(ws + WS_HTD), KF, lds, it, tid); }
    xcd_barrier(bar);

    { NEWPHASE(); const int xcd = cu & 7, j = cu >> 3;
      float lam;
      { const float* lp = a.in[12]; const int l6 = tid & 63; float s01 = lp[l6] * lp[64 + l6], s23 = lp[128 + l6] * lp[192 + l6];
        s01 = wave_allsum(s01, l6); s23 = wave_allsum(s23, l6);
        lam = expf(s01) - expf(s23) + 0.2f; }
      if (PH(4)) for (int i = 0; i < 4 * REP_DIFF; ++i) {
          const int bh = ((i & 3) * 8 + xcd) * 2 + (j >> 4), qblk = j & 15, b = bh >> 2, hd = bh & 3;
          const size_t tok0 = (size_t)b * SEQ;
          attn_unit<2>(lds, QKM + (tok0 + qblk * 128) * MIXW + hd * 128, MIXW, QKM + tok0 * MIXW + 512 + hd * 128, MIXW,
                       HT + (size_t)(1536 + hd * 128) * NT + tok0, NT, SEQ, 0.125f * 1.4426950408889634f,
                       MIX + (tok0 + qblk * 128) * MIXW + 512 + hd * 128, MIXW, lam, a.in[13], tid); }
      if (PH(5)) for (int i = 0; i < 2 * REP_MEM; ++i) {
          const int bh = ((i & 1) * 8 + xcd) * 4 + (j >> 3), qblk = j & 7, b = bh >> 2, hd = bh & 3;
          const size_t tok0 = (size_t)b * SEQ;
          attn_unit<1>(lds, QKM + (tok0 + qblk * 256) * MIXW + 1024 + hd * 128, MIXW, KMEM + (size_t)b * MEMT * 512 + hd * 128, 512,
                       VMT + (size_t)(hd * 128) * NMT + b * MEMT, NMT, MEMT, 0.08838834764831845f * 1.4426950408889634f,
                       MIX + (tok0 + qblk * 256) * MIXW + 1024 + hd * 128, MIXW, 0.f, nullptr, tid); }
      if (PH(6)) for (int i = 0; i < 2 * REP_HY; ++i) {
          const int cgp = ((i & 1) * 8 + xcd) * 4 + (j >> 3), bp = j & 7;
          hyena_item(HT, KF, a.in[3], a.in[4], a.in[11], MIX, lds, bp, cgp, tid); } }
    xcd_barrier(bar);

#ifdef REP_SYNC
    for (int rep = 0; rep < REP_SYNC; ++rep) xcd_barrier(bar);
#endif
    const bool pair = (G == 256);
    if (pair) {
        if (PH(7)) { NEWPHASE(); const int v = PairOrder::vcu_of(cu);
            pg8::Gemm g{MIX, (const bf16_t*)(ws + WS_WOUT), NT, DM, MIXW}; QuadTwo S{v >> 2, v & 3};
            EpiLn<1> E{a.in[0], a.out, X1B, a.in[16], a.in[17], (unsigned long long*)(ws + WS_XG), (unsigned*)(ws + WS_CNT), lds};
            pg8::gemm_phase<EpiLn<1>, QuadTwo, true, true>(lds, g, S, E); }
        xcd_barrier(bar);
    } else {
        { NEWPHASE(); pg8::Gemm g{MIX, (const bf16_t*)(ws + WS_WOUT), NT, DM, MIXW}; pg8::StaticOrder S; S.init(g.M, g.N, G, cu);
          EpiRes E{a.in[0], a.out, lds, 0};
          pg8::gemm_phase<EpiRes, pg8::StaticOrder, true, true>(lds, g, S, E); }
        xcd_barrier(bar);
        { NEWPHASE(); ln_rows<true>(a.out, X1B, STAT, a.in[16], a.in[17], tid); }
        xcd_barrier(bar);
    }
    for (int rep = 0; rep < REP_G4; ++rep) if (PH(9)) { NEWPHASE(); pg8::Gemm g{X1B, (const bf16_t*)(ws + WS_WUP), FFN_MT * 256, 2 * DFF, DM}; FfnOrder S; S.init(g.M, g.N, G, cu); S.cw = a.in[19]; S.cb = a.in[20]; S.lds = lds; S.cnt = 0;
      EpiFfn E{ACT, lds, 0};
      pg8::gemm_phase<EpiFfn, FfnOrder, true, true>(lds, g, S, E); }
    xcd_barrier(bar);
    if (pair) {
        if (PH(11)) { NEWPHASE(); const int v = PairOrder::vcu_of(cu);
            pg8::Gemm g{ACT, (const bf16_t*)(ws + WS_WDN), NT, DM, DFF}; QuadTwoKb S; S.q = v >> 2; S.j = v & 3;
            EpiLn<2> E{a.out, a.out, nullptr, a.in[22], a.in[23], (unsigned long long*)(ws + WS_XG) + 128 * 4 * 256, (unsigned*)(ws + WS_CNT) + 128 * 16, lds};
            pg8::gemm_phase<EpiLn<2>, QuadTwoKb, true, true>(lds, g, S, E); }
    } else {
        { NEWPHASE(); pg8::Gemm g{ACT, (const bf16_t*)(ws + WS_WDN), NT, DM, DFF}; KbOrder S; S.init(g.M, g.N, G, cu);
          EpiRes2 E{a.out, a.out, STAT, a.in[16], a.in[17], lds, 0};
          pg8::gemm_phase<EpiRes2, KbOrder, true, true>(lds, g, S, E); }
        xcd_barrier(bar);
        { NEWPHASE(); ln_rows<false>(a.out, nullptr, nullptr, a.in[22], a.in[23], tid); }
    }
}

extern "C" void kernel_launch(void* const* d_in, const int* in_sizes, int n_in, void* d_out, int out_size, void* d_ws, size_t ws_size, hipStream_t stream) {
    static int grid = 0;
    if (grid == 0) {
        if (n_in != 24 || out_size != NT * DM || ws_size < WS_END) { fprintf(stderr, "kernel_launch: unexpected shapes (n_in %d, out %d, ws %zu)\n", n_in, out_size, ws_size); grid = -1; return; }
        int dev = 0, cus = 0, per_cu = 0;
        hipGetDevice(&dev); hipDeviceGetAttribute(&cus, hipDeviceAttributeMultiprocessorCount, dev);
        if (hipFuncSetAttribute((const void*)hybrid_fwd, hipFuncAttributeMaxDynamicSharedMemorySize, LDS_BYTES) != hipSuccess) { fprintf(stderr, "kernel_launch: hipFuncSetAttribute failed\n"); grid = -1; return; }
        if (hipOccupancyMaxActiveBlocksPerMultiprocessor(&per_cu, (const void*)hybrid_fwd, NTHR, LDS_BYTES) != hipSuccess || per_cu < 1) { fprintf(stderr, "kernel_launch: occupancy query says %d\n", per_cu); per_cu = 1; }
        (void)hipGetLastError();
        grid = cus * per_cu;
        fprintf(stderr, "kernel_launch: grid %d (cus %d x %d)\n", grid, cus, per_cu);
    }
    if (grid < 0) return;
    if (hipMemsetAsync((char*)d_ws + WS_BAR, 0, 32768, stream) != hipSuccess) { fprintf(stderr, "kernel_launch: memset failed\n"); return; }
    Args a{};
    for (int i = 0; i < 24; ++i) a.in[i] = (const float*)d_in[i];
    a.out = (float*)d_out; a.ws = (unsigned char*)d_ws;
    void* args[] = {&a};
    const hipError_t e = hipLaunchCooperativeKernel((const void*)hybrid_fwd, dim3(grid), dim3(NTHR), args, LDS_BYTES, stream);
    if (e != hipSuccess) fprintf(stderr, "kernel_launch: cooperative launch failed: %s (grid %d)\n", hipGetErrorString(e), grid);
}
```

```cpp
#include <hip/hip_runtime.h>
#include <hip/hip_cooperative_groups.h>
#include <cstdio>
#include <cstdint>
namespace cg = cooperative_groups;
#define LAS __attribute__((address_space(3)))
namespace pg8 {
#define PG8_LAS __attribute__((address_space(3)))
typedef unsigned short bf16_t;
typedef short bf16x8 __attribute__((ext_vector_type(8)));
typedef float f32x4 __attribute__((ext_vector_type(4)));
typedef unsigned u32x4 __attribute__((ext_vector_type(4)));
constexpr int BM = 256, BK = 64, HALF = 128, HTB = HALF * BK * 2  , STAGE_BYTES = 8 * HTB, NXCD = 8, WGM = 8;

__host__ __device__ __forceinline__ int lds_byte(int r, int c) { const int st = (r >> 4) * 2 + (c >> 5), rr = r & 15, cc = c & 31, ob = rr * 64 + cc * 2; return st * 1024 + (ob ^ (((ob >> 9) & 1) << 5)); }
__host__ __device__ __forceinline__ void stage_rc(int b, int& R, int& C) { const int st = b / 1024, sb = b % 1024, swz = sb ^ (((sb >> 9) & 1) << 5); R = (st >> 1) * 16 + swz / 64; C = (st & 1) * 32 + (swz % 64) / 2; }
__host__ __device__ __forceinline__ int perm32(int rho) { const int n = rho >> 4, i = rho & 15; return 8 * (i >> 2) + 4 * n + (i & 3); }

struct Unit { int pm, pn; };
struct Gemm { const bf16_t* A; const bf16_t* Bt; int M, N, K; };

struct StaticOrder {
    int nM, nN, nwg, G, c;
    __host__ __device__ void init(int M, int N, int G_, int c_) { nM = M / BM; nN = N / BM; nwg = nM * nN; G = G_; c = c_; }
    __host__ __device__ bool next(int i, Unit& u) const {
        const long L = (long)i * G + c; if (L >= nwg) return false;
        int wgid = (int)L; { const int q = nwg / NXCD, r = nwg % NXCD, xcd = wgid % NXCD, off = wgid / NXCD; wgid = (xcd < r ? xcd * (q + 1) : r * (q + 1) + (xcd - r) * q) + off; }
        const int nig = WGM * nN, gid = wgid / nig, fm = gid * WGM, gsz = (nM - fm) < WGM ? (nM - fm) : WGM;
        u.pm = fm + ((wgid % nig) % gsz); u.pn = (wgid % nig) / gsz; return true;
    }
    __device__ __forceinline__ void a_ready(const Unit&) const {}
    __device__ __forceinline__ void done(const Unit&) const {}
    __device__ __forceinline__ long a_off(const Unit& u, size_t tstep) const { return (long)((size_t)u.pm * tstep); }
    __device__ __forceinline__ int lda(int K) const { return K; }
    __device__ __forceinline__ size_t kstep_a() const { return (size_t)(BK * 2); }
};
template <class Epi, class Sched, bool ALIGN_EPI = false, bool SP2 = false>
__device__ __forceinline__ void gemm_phase(PG8_LAS unsigned char* lds, const Gemm g, const Sched& S, const Epi& E) {
    int tid_l = threadIdx.x; asm volatile("" : "+v"(tid_l)); const int tid = tid_l, wid = __builtin_amdgcn_readfirstlane(tid >> 6), lane = tid & 63, wr = wid >> 2, wc = wid & 3, fr = lane & 15, fq = lane >> 4;
    const int K = g.K, nt = K / BK;
    unsigned voffA[2], voffB[2];
    const int lda = S.lda(K);
#pragma unroll
    for (int i = 0; i < 2; ++i) { int R, C; stage_rc(tid * 16 + i * 8192, R, C); const int Rb = Epi::PERM ? ((R & ~31) + perm32(R & 31)) : R;
        voffA[i] = (unsigned)(R * lda + C) * 2u; voffB[i] = (unsigned)(Rb * K + C) * 2u; }
    const size_t kstep = (size_t)(BK * 2);
    const size_t hstep = (size_t)HALF * K * 2;
    const size_t tstep = 2 * hstep;
    const size_t kstepA = S.kstep_a(), hstepA = (size_t)HALF * lda * 2, tstepA = 2 * hstepA;
    const unsigned ldsw = (unsigned)wid * 1024u;
    const int aoff = lds_byte(wr * 64 + fr, fq * 8), boff = lds_byte(wc * 32 + fr, fq * 8);
#define PG8_SA(b, h) (((b) * 2 + (h)) * HTB)
#define PG8_SB(b, h) ((4 + (b) * 2 + (h)) * HTB)
#define PG8_STAGE(bufoff, gbase, voff) do { _Pragma("unroll") for (int _i = 0; _i < 2; ++_i) \
        __builtin_amdgcn_global_load_lds((const unsigned*)((const char*)(gbase) + (voff)[_i]), (PG8_LAS unsigned*)(lds + (bufoff) + ldsw + _i * 8192), 16, 0, 0); } while (0)
#define PG8_LDA(dst, b, h) do { _Pragma("unroll") for (int m = 0; m < 4; ++m) _Pragma("unroll") for (int k = 0; k < 2; ++k) dst[m][k] = *(const PG8_LAS bf16x8*)(lds + PG8_SA(b, h) + aoff + m * 2048 + k * 1024); } while (0)
#define PG8_LDB(dst, b, h) do { _Pragma("unroll") for (int n = 0; n < 2; ++n) _Pragma("unroll") for (int k = 0; k < 2; ++k) dst[n][k] = *(const PG8_LAS bf16x8*)(lds + PG8_SB(b, h) + boff + n * 2048 + k * 1024); } while (0)
#define PG8_MMA(ai, bj, At, Bt) do { __builtin_amdgcn_s_setprio(1); _Pragma("unroll") for (int m = 0; m < 4; ++m) _Pragma("unroll") for (int n = 0; n < 2; ++n) _Pragma("unroll") for (int k = 0; k < 2; ++k) \
        acc[ai][bj][m][n] = __builtin_amdgcn_mfma_f32_16x16x32_bf16(Bt[n][k], At[m][k], acc[ai][bj][m][n], 0, 0, 0); __builtin_amdgcn_s_setprio(0); } while (0)
#define PG8_WAIT_V(n) asm volatile("s_waitcnt vmcnt(" #n ")" ::: "memory")
#define PG8_WAIT_L(n) asm volatile("s_waitcnt lgkmcnt(" #n ")" ::: "memory")
#define PG8_BAR __builtin_amdgcn_s_barrier()
#define PG8_SCHED __builtin_amdgcn_sched_barrier(0)
    Unit cur, nxt; int ui = 0;
    if (!S.next(0, cur)) return;
    f32x4 acc[2][2][4][2];
#pragma unroll
    for (int a = 0; a < 2; ++a)
#pragma unroll
        for (int b = 0; b < 2; ++b)
#pragma unroll
            for (int m = 0; m < 4; ++m)
#pragma unroll
                for (int n = 0; n < 2; ++n) acc[a][b][m][n] = (f32x4){0.f, 0.f, 0.f, 0.f};
    bf16x8 At[4][2], B0[2][2], B1[2][2];
    const char* cA = (const char*)g.A + S.a_off(cur, tstepA); const char* cB = (const char*)g.Bt + (size_t)cur.pn * tstep;
    S.a_ready(cur);
    if constexpr (SP2) {
        PG8_STAGE(PG8_SB(0, 0), cB, voffB); PG8_STAGE(PG8_SB(0, 1), cB + hstep, voffB); PG8_STAGE(PG8_SA(0, 0), cA, voffA); PG8_STAGE(PG8_SA(0, 1), cA + hstepA, voffA);
        if (wr == 1) PG8_BAR;
        PG8_WAIT_V(2); PG8_BAR;
        PG8_STAGE(PG8_SB(1, 0), cB + kstep, voffB); PG8_STAGE(PG8_SA(1, 0), cA + kstepA, voffA); PG8_STAGE(PG8_SB(1, 1), cB + hstep + kstep, voffB);
        PG8_WAIT_V(6); PG8_BAR;
    } else {
        PG8_STAGE(PG8_SB(0, 0), cB, voffB); PG8_STAGE(PG8_SA(0, 0), cA, voffA); PG8_STAGE(PG8_SB(0, 1), cB + hstep, voffB); PG8_STAGE(PG8_SA(0, 1), cA + hstepA, voffA);
        if (wr == 1) PG8_BAR;
        PG8_WAIT_V(4); PG8_BAR;
        PG8_STAGE(PG8_SB(1, 0), cB + kstep, voffB); PG8_STAGE(PG8_SA(1, 0), cA + kstepA, voffA); PG8_STAGE(PG8_SB(1, 1), cB + hstep + kstep, voffB);
        PG8_WAIT_V(6); PG8_BAR;
    }
    for (;;) {
        const bool has_next = S.next(ui + 1, nxt);
        const char* nA = has_next ? (const char*)g.A + S.a_off(nxt, tstepA) : cA; const char* nB = has_next ? (const char*)g.Bt + (size_t)nxt.pn * tstep : cB;
        for (int t = 0; t < nt; t += 2) {
            const bool last = (t == nt - 2);
            const char* a1 = cA + (size_t)(t + 1) * kstepA;
            const char* a2 = last ? nA : cA + (size_t)(t + 2) * kstepA; const char* b2 = last ? nB : cB + (size_t)(t + 2) * kstep;
            const char* a3 = a2 + kstepA; const char* b3 = b2 + kstep;
            if (last && has_next) S.a_ready(nxt);
            if constexpr (SP2) {
            PG8_LDB(B0, 0, 0); PG8_LDB(B1, 0, 1); PG8_SCHED; PG8_LDA(At, 0, 0); PG8_STAGE(PG8_SA(1, 1), a1 + hstepA, voffA);
            PG8_WAIT_V(8); PG8_WAIT_L(0); PG8_BAR; PG8_MMA(0, 0, At, B0); PG8_MMA(0, 1, At, B1); PG8_BAR; PG8_SCHED;
            PG8_LDA(At, 0, 1); PG8_STAGE(PG8_SB(0, 0), b2, voffB); PG8_STAGE(PG8_SB(0, 1), b2 + hstep, voffB); PG8_STAGE(PG8_SA(0, 0), a2, voffA);
            PG8_WAIT_V(8); PG8_WAIT_L(0); PG8_BAR; PG8_MMA(1, 0, At, B0); PG8_MMA(1, 1, At, B1); PG8_BAR; PG8_SCHED;
            PG8_LDB(B0, 1, 0); PG8_LDB(B1, 1, 1); PG8_SCHED; PG8_LDA(At, 1, 0); PG8_STAGE(PG8_SA(0, 1), a2 + hstepA, voffA);
            PG8_WAIT_V(8); PG8_WAIT_L(0); PG8_BAR; PG8_MMA(0, 0, At, B0); PG8_MMA(0, 1, At, B1); PG8_BAR; PG8_SCHED;
            PG8_LDA(At, 1, 1); PG8_STAGE(PG8_SB(1, 0), b3, voffB); PG8_STAGE(PG8_SB(1, 1), b3 + hstep, voffB); PG8_STAGE(PG8_SA(1, 0), a3, voffA);
            PG8_WAIT_V(8); PG8_WAIT_L(0); PG8_BAR; PG8_MMA(1, 0, At, B0); PG8_MMA(1, 1, At, B1); PG8_BAR; PG8_SCHED;
            } else {
            PG8_LDB(B0, 0, 0); PG8_SCHED; PG8_LDA(At, 0, 0); PG8_STAGE(PG8_SA(1, 1), a1 + hstepA, voffA);
            PG8_WAIT_L(8); PG8_BAR; PG8_WAIT_L(0); PG8_MMA(0, 0, At, B0); PG8_BAR; PG8_SCHED;
            PG8_LDB(B1, 0, 1); PG8_STAGE(PG8_SB(0, 0), b2, voffB);
            PG8_BAR; PG8_WAIT_L(0); PG8_MMA(0, 1, At, B1); PG8_BAR;
            PG8_LDA(At, 0, 1); PG8_STAGE(PG8_SA(0, 0), a2, voffA);
            PG8_BAR; PG8_WAIT_L(0); PG8_MMA(1, 0, At, B0); PG8_BAR; PG8_SCHED;
            PG8_STAGE(PG8_SB(0, 1), b2 + hstep, voffB);
            PG8_WAIT_V(6); PG8_BAR; PG8_MMA(1, 1, At, B1); PG8_BAR;
            PG8_LDB(B0, 1, 0); PG8_SCHED; PG8_LDA(At, 1, 0); PG8_STAGE(PG8_SA(0, 1), a2 + hstepA, voffA);
            PG8_WAIT_L(8); PG8_BAR; PG8_WAIT_L(0); PG8_MMA(0, 0, At, B0); PG8_BAR; PG8_SCHED;
            PG8_LDB(B1, 1, 1); PG8_STAGE(PG8_SB(1, 0), b3, voffB);
            PG8_BAR; PG8_WAIT_L(0); PG8_MMA(0, 1, At, B1); PG8_BAR;
            PG8_LDA(At, 1, 1); PG8_STAGE(PG8_SA(1, 0), a3, voffA);
            PG8_BAR; PG8_WAIT_L(0); PG8_MMA(1, 0, At, B0); PG8_BAR; PG8_SCHED;
            PG8_STAGE(PG8_SB(1, 1), b3 + hstep, voffB);
            PG8_WAIT_V(6); PG8_BAR; PG8_MMA(1, 1, At, B1); PG8_BAR;
            }
        }
        if constexpr (ALIGN_EPI) { if (wr == 0) PG8_BAR; }
        if constexpr (!Epi::AFTER_DRAIN) { E(acc, cur, wr, wc, fr, fq); S.done(cur); }
        if (!has_next) break;
#pragma unroll
        for (int a = 0; a < 2; ++a)
#pragma unroll
            for (int b = 0; b < 2; ++b)
#pragma unroll
                for (int m = 0; m < 4; ++m)
#pragma unroll
                    for (int n = 0; n < 2; ++n) acc[a][b][m][n] = (f32x4){0.f, 0.f, 0.f, 0.f};
        cur = nxt; cA = nA; cB = nB; ++ui;
        if constexpr (ALIGN_EPI) { if (wr == 1) PG8_BAR; }
    }
    PG8_WAIT_V(0);
    if constexpr (!ALIGN_EPI) { if (wr == 0) PG8_BAR; }
    PG8_BAR;
    if constexpr (Epi::AFTER_DRAIN) { E.fused(acc, cur, wr, wc, fr, fq, lds, wid, lane); S.done(cur); }
#undef PG8_SA
#undef PG8_SB
#undef PG8_STAGE
#undef PG8_LDA
#undef PG8_LDB
#undef PG8_MMA
#undef PG8_WAIT_V
#undef PG8_WAIT_L
#undef PG8_BAR
#undef PG8_SCHED
}
}

using pg8::bf16_t; using pg8::bf16x8; using pg8::f32x4; using pg8::u32x4;
typedef float f32x16 __attribute__((ext_vector_type(16)));
typedef unsigned u32x2 __attribute__((ext_vector_type(2)));
typedef short bf16x4 __attribute__((ext_vector_type(4)));

constexpr int NB = 16, SEQ = 2048, DM = 1024, NT = NB * SEQ, MEMT = 256, NMT = NB * MEMT, HW = 512, INW = 3584, DFF = 2816, MIXW = 1536;
constexpr float ALPHA = 1.189207115002721f;
constexpr float LN_EPS = 1e-5f, RMS_EPS = 1e-5f;
constexpr int NTHR = 512, NWAVE = 8;
constexpr int LDS_BYTES = 155648;

constexpr size_t MiB = 1048576;
constexpr size_t WS_WALL = 0;
constexpr size_t WS_WKV  = 7 * MiB;
constexpr size_t WS_WOUT = 9 * MiB;
constexpr size_t WS_WUP  = 12 * MiB;
constexpr size_t WS_WDN  = 23 * MiB;
constexpr size_t WS_ROPE = 29 * MiB;
constexpr size_t WS_STAT = 29 * MiB + 524288;
constexpr size_t WS_XB   = 30 * MiB;
constexpr size_t WS_X1B  = 30 * MiB;
constexpr size_t WS_HTD  = 94 * MiB;
constexpr size_t WS_MEMB = 110 * MiB;
constexpr size_t WS_QKM  = 118 * MiB;
constexpr size_t WS_HT   = 214 * MiB;
constexpr size_t WS_KMEM = 342 * MiB;
constexpr size_t WS_VMT  = 346 * MiB;
constexpr size_t WS_KF   = 350 * MiB;
constexpr size_t WS_MIX  = 382 * MiB;
constexpr size_t WS_HH   = 96 * MiB;
constexpr size_t WS_ACT  = 272 * MiB;
constexpr size_t WS_BAR  = 478 * MiB;
constexpr size_t WS_CNT  = 478 * MiB + 16384;
constexpr size_t WS_XG   = 478 * MiB + 65536;
constexpr size_t WS_END  = 478 * MiB + 65536 + 2 * MiB;

__device__ __forceinline__ unsigned pk2(float lo, float hi) { unsigned r; asm volatile("v_cvt_pk_bf16_f32 %0, %1, %2" : "=v"(r) : "v"(lo), "v"(hi)); return r; }
__device__ __forceinline__ float bf2f(bf16_t v) { return __uint_as_float((unsigned)v << 16); }
__device__ __forceinline__ float lo2f(unsigned v) { return __uint_as_float(v << 16); }
__device__ __forceinline__ float hi2f(unsigned v) { return __uint_as_float(v & 0xffff0000u); }
#define LDS_WAIT() asm volatile("s_waitcnt lgkmcnt(0)" ::: "memory")
__device__ __forceinline__ float xsum16(float v) { const auto r_ = __builtin_amdgcn_permlane16_swap(__float_as_uint(v), __float_as_uint(v), false, false); return __uint_as_float(r_[0]) + __uint_as_float(r_[1]); }
__device__ __forceinline__ float xsum32(float v) { const auto r_ = __builtin_amdgcn_permlane32_swap(__float_as_uint(v), __float_as_uint(v), false, false); return __uint_as_float(r_[0]) + __uint_as_float(r_[1]); }
__device__ __forceinline__ float wave_allsum(float v, int lane) {
#pragma unroll
    for (int o = 1; o < 16; o <<= 1) v += __int_as_float(__builtin_amdgcn_ds_bpermute((lane ^ o) << 2, __float_as_int(v)));
    return xsum32(xsum16(v));
}

#ifndef FFT_HOST
#define FFT_FN __device__ __forceinline__
#define FFT_SYNC() do { asm volatile("s_waitcnt lgkmcnt(0)" ::: "memory"); __builtin_amdgcn_s_barrier(); asm volatile("" ::: "memory"); } while (0)
typedef float cplx __attribute__((ext_vector_type(2)));
typedef LAS cplx* fftbuf_t;
FFT_FN float cos2pi(float r) { return __builtin_amdgcn_cosf(r); }
FFT_FN float sin2pi(float r) { return __builtin_amdgcn_sinf(r); }
#endif
FFT_FN cplx mk2(float x, float y) { cplx r; r.x = x; r.y = y; return r; }
FFT_FN cplx cadd(cplx a, cplx b) { return mk2(a.x + b.x, a.y + b.y); }
FFT_FN cplx csub(cplx a, cplx b) { return mk2(a.x - b.x, a.y - b.y); }
FFT_FN cplx cmul(cplx a, cplx b) { return mk2(a.x * b.x - a.y * b.y, a.x * b.y + a.y * b.x); }
template <bool INV> FFT_FN cplx muli(cplx a) { return INV ? mk2(-a.y, a.x) : mk2(a.y, -a.x); }
FFT_FN int padi(int i) { return i + (i >> 3); }

template <bool INV> FFT_FN void dft8(cplx (&v)[8]) {
    const float R = 0.70710678118654752f;
    const cplx a0 = cadd(v[0], v[4]), a1 = csub(v[0], v[4]), a2 = cadd(v[2], v[6]), a3 = muli<INV>(csub(v[2], v[6]));
    const cplx a4 = cadd(v[1], v[5]), a5 = csub(v[1], v[5]), a6 = cadd(v[3], v[7]), a7 = muli<INV>(csub(v[3], v[7]));
    const cplx b0 = cadd(a0, a2), b2 = csub(a0, a2), b1 = cadd(a1, a3), b3 = csub(a1, a3);
    const cplx b4 = cadd(a4, a6), b6 = muli<INV>(csub(a4, a6));
    const cplx t5 = cadd(a5, a7), t7 = csub(a5, a7);
    cplx b5, b7;
    if (!INV) { b5 = mk2((t5.x + t5.y) * R, (t5.y - t5.x) * R); b7 = mk2((t7.y - t7.x) * R, -(t7.x + t7.y) * R); }
    else      { b5 = mk2((t5.x - t5.y) * R, (t5.x + t5.y) * R); b7 = mk2(-(t7.x + t7.y) * R, (t7.x - t7.y) * R); }
    v[0] = cadd(b0, b4); v[4] = csub(b0, b4); v[1] = cadd(b1, b5); v[5] = csub(b1, b5);
    v[2] = cadd(b2, b6); v[6] = csub(b2, b6); v[3] = cadd(b3, b7); v[7] = csub(b3, b7);
}
template <int S, bool INV> FFT_FN void twid(cplx (&v)[8], int tid) {
    if (S > 1) {
        const int j = tid % S; const float rev = (float)j * (1.0f / (8.0f * S));
        const float c = cos2pi(rev), s = sin2pi(rev);
        const cplx w1 = mk2(c, INV ? s : -s);
        const cplx w2 = cmul(w1, w1), w3 = cmul(w2, w1), w4 = cmul(w2, w2), w5 = cmul(w4, w1), w6 = cmul(w4, w2), w7 = cmul(w4, w3);
        v[1] = cmul(v[1], w1); v[2] = cmul(v[2], w2); v[3] = cmul(v[3], w3); v[4] = cmul(v[4], w4);
        v[5] = cmul(v[5], w5); v[6] = cmul(v[6], w6); v[7] = cmul(v[7], w7);
    }
}
template <int S> FFT_FN void ld8(fftbuf_t X, int tid, cplx (&v)[8]) {
    const int base = (tid / S) * 8 * S + (tid % S);
#pragma unroll
    for (int k = 0; k < 8; ++k) v[k] = X[padi(base + S * k)];
}
template <int S> FFT_FN void st8(fftbuf_t X, int tid, const cplx (&v)[8]) {
    const int base = (tid / S) * 8 * S + (tid % S);
#pragma unroll
    for (int k = 0; k < 8; ++k) X[padi(base + S * k)] = v[k];
}
#ifndef FFT_HOST
template <int S> FFT_FN void twid_fill(fftbuf_t TW, int tid) {
    constexpr int P = (S == 512) ? 0 : (S == 64) ? 1 : 2;
    const int j = tid % S; const float rev = (float)j * (1.0f / (8.0f * S));
    const cplx w1 = mk2(cos2pi(rev), -sin2pi(rev)), w2 = cmul(w1, w1), w3 = cmul(w2, w1), w4 = cmul(w2, w2), w5 = cmul(w4, w1), w6 = cmul(w4, w2), w7 = cmul(w4, w3);
    TW[(7 * P + 0) * 512 + tid] = w1; TW[(7 * P + 1) * 512 + tid] = w2; TW[(7 * P + 2) * 512 + tid] = w3; TW[(7 * P + 3) * 512 + tid] = w4;
    TW[(7 * P + 4) * 512 + tid] = w5; TW[(7 * P + 5) * 512 + tid] = w6; TW[(7 * P + 6) * 512 + tid] = w7;
}
template <int S, bool INV> FFT_FN void twidL(cplx (&v)[8], fftbuf_t TW, int tid) {
    constexpr int P = (S == 512) ? 0 : (S == 64) ? 1 : 2;
#pragma unroll
    for (int q = 1; q < 8; ++q) { cplx w = TW[(7 * P + q - 1) * 512 + tid]; if (INV) w.y = -w.y; v[q] = cmul(v[q], w); }
}
FFT_FN void fft_fwdL(fftbuf_t X, fftbuf_t TW, int tid, cplx (&v)[8]) {
    dft8<false>(v); twidL<512, false>(v, TW, tid); st8<512>(X, tid, v); FFT_SYNC();
    ld8<64>(X, tid, v); dft8<false>(v); twidL<64, false>(v, TW, tid); st8<64>(X, tid, v); FFT_SYNC();
    ld8<8>(X, tid, v); dft8<false>(v); twidL<8, false>(v, TW, tid); st8<8>(X, tid, v); FFT_SYNC();
    ld8<1>(X, tid, v); dft8<false>(v);
}
FFT_FN void fft_invL(fftbuf_t X, fftbuf_t TW, int tid, cplx (&v)[8]) {
    dft8<true>(v); st8<1>(X, tid, v); FFT_SYNC();
    ld8<8>(X, tid, v); twidL<8, true>(v, TW, tid); dft8<true>(v); st8<8>(X, tid, v); FFT_SYNC();
    ld8<64>(X, tid, v); twidL<64, true>(v, TW, tid); dft8<true>(v); st8<64>(X, tid, v); FFT_SYNC();
    ld8<512>(X, tid, v); twidL<512, true>(v, TW, tid); dft8<true>(v);
}
FFT_FN void fft_fwd(fftbuf_t X, int tid, cplx (&v)[8]) {
    dft8<false>(v); twid<512, false>(v, tid); st8<512>(X, tid, v); FFT_SYNC();
    ld8<64>(X, tid, v); dft8<false>(v); twid<64, false>(v, tid); st8<64>(X, tid, v); FFT_SYNC();
    ld8<8>(X, tid, v); dft8<false>(v); twid<8, false>(v, tid); st8<8>(X, tid, v); FFT_SYNC();
    ld8<1>(X, tid, v); dft8<false>(v);
}
FFT_FN void fft_inv(fftbuf_t X, int tid, cplx (&v)[8]) {
    dft8<true>(v); st8<1>(X, tid, v); FFT_SYNC();
    ld8<8>(X, tid, v); twid<8, true>(v, tid); dft8<true>(v); st8<8>(X, tid, v); FFT_SYNC();
    ld8<64>(X, tid, v); twid<64, true>(v, tid); dft8<true>(v); st8<64>(X, tid, v); FFT_SYNC();
    ld8<512>(X, tid, v); twid<512, true>(v, tid); dft8<true>(v);
}
#endif

struct OneUnit { int pm, pn; bool on;
    __device__ __forceinline__ bool next(int i, pg8::Unit& u) const { if (!on || i > 0) return false; u.pm = pm; u.pn = pn; return true; }
    __device__ __forceinline__ void a_ready(const pg8::Unit&) const {}
    __device__ __forceinline__ void done(const pg8::Unit&) const {}
    __device__ __forceinline__ long a_off(const pg8::Unit& u, size_t tstep) const { return (long)((size_t)u.pm * tstep); }
    __device__ __forceinline__ int lda(int K) const { return K; }
    __device__ __forceinline__ size_t kstep_a() const { return 128; } };

struct EpiB {
    static constexpr bool PERM = true, AFTER_DRAIN = false;
    bf16_t* O; int ldc;
    __device__ __forceinline__ void operator()(const f32x4 (&acc)[2][2][4][2], const pg8::Unit& u, int wr, int wc, int fr, int fq) const {
        const int row0 = u.pm * 256 + wr * 64 + fr, col0 = u.pn * 256 + wc * 32 + 8 * fq;
#pragma unroll
        for (int ai = 0; ai < 2; ++ai)
#pragma unroll
            for (int m = 0; m < 4; ++m) { bf16_t* rowp = O + (size_t)(row0 + ai * 128 + m * 16) * ldc + col0;
#pragma unroll
                for (int bj = 0; bj < 2; ++bj) { const f32x4 v0 = acc[ai][bj][m][0], v1 = acc[ai][bj][m][1];
                    u32x4 w; w.x = pk2(v0[0], v0[1]); w.y = pk2(v0[2], v0[3]); w.z = pk2(v1[0], v1[1]); w.w = pk2(v1[2], v1[3]);
                    *(u32x4*)(rowp + bj * 128) = w; } }
    }
};
struct EpiRope {
    static constexpr bool PERM = true, AFTER_DRAIN = false;
    bf16_t* O; const float2* rope;
    __device__ __forceinline__ void operator()(const f32x4 (&acc)[2][2][4][2], const pg8::Unit& u, int wr, int wc, int fr, int fq) const {
        const int row0 = u.pm * 256 + wr * 64 + fr, col0 = u.pn * 256 + wc * 32 + 8 * fq;
        const bool rot = u.pn < 4;
#pragma unroll
        for (int ai = 0; ai < 2; ++ai)
#pragma unroll
            for (int m = 0; m < 4; ++m) { const int row = row0 + ai * 128 + m * 16; bf16_t* rowp = O + (size_t)row * MIXW + col0;
#pragma unroll
                for (int bj = 0; bj < 2; ++bj) { f32x4 v0 = acc[ai][bj][m][0], v1 = acc[ai][bj][m][1];
                    if (rot) { const int pos = row & (SEQ - 1), i0 = ((col0 + bj * 128) & 63) >> 1;
                        const f32x4* rp = (const f32x4*)(rope + pos * 32 + i0); const f32x4 r0 = rp[0], r1 = rp[1];
                        f32x4 o0, o1;
                        o0[0] = v0[0] * r0[0] - v0[1] * r0[1]; o0[1] = v0[1] * r0[0] + v0[0] * r0[1];
                        o0[2] = v0[2] * r0[2] - v0[3] * r0[3]; o0[3] = v0[3] * r0[2] + v0[2] * r0[3];
                        o1[0] = v1[0] * r1[0] - v1[1] * r1[1]; o1[1] = v1[1] * r1[0] + v1[0] * r1[1];
                        o1[2] = v1[2] * r1[2] - v1[3] * r1[3]; o1[3] = v1[3] * r1[2] + v1[2] * r1[3];
                        v0 = o0; v1 = o1; }
                    u32x4 w; w.x = pk2(v0[0], v0[1]); w.y = pk2(v0[2], v0[3]); w.z = pk2(v1[0], v1[1]); w.w = pk2(v1[2], v1[3]);
                    *(u32x4*)(rowp + bj * 128) = w; } }
    }
};
constexpr int XCH_OFF = 131072 + 1024;
__device__ __forceinline__ void stat_put(LAS cplx* ST, int rowl, int wc, int fq, float s1, float s2, bool first) {
    s1 = xsum32(xsum16(s1)); s2 = xsum32(xsum16(s2));
    if (fq == 0) { LAS cplx* p = ST + rowl * 4 + wc; cplx v; v.x = s1; v.y = s2; if (!first) { const cplx o = *p; v.x += o.x; v.y += o.y; } *p = v; }
}
struct EpiRes {
    static constexpr bool PERM = false, AFTER_DRAIN = false;
    const float* X; float* O; LAS unsigned char* lds; mutable int ecnt;
    __device__ __forceinline__ void operator()(const f32x4 (&acc)[2][2][4][2], const pg8::Unit& u, int wr, int wc, int fr, int fq) const {
        const int row0 = u.pm * 256 + wr * 64 + fr, col0 = u.pn * 256 + wc * 32 + 4 * fq;
        LAS cplx* ST = (LAS cplx*)(lds + XCH_OFF) + (ecnt & 1) * 1024; const bool first = true; ++ecnt;
#pragma unroll
        for (int ai = 0; ai < 2; ++ai) {
            f32x4 xv[4][2][2];
#pragma unroll
            for (int m = 0; m < 4; ++m)
#pragma unroll
                for (int bj = 0; bj < 2; ++bj)
#pragma unroll
                    for (int n = 0; n < 2; ++n) xv[m][bj][n] = *(const f32x4*)(X + (size_t)(row0 + ai * 128 + m * 16) * DM + col0 + bj * 128 + 16 * n);
            asm volatile("" ::: "memory");
#pragma unroll
            for (int m = 0; m < 4; ++m) { float s1 = 0.f, s2 = 0.f;
#pragma unroll
                for (int bj = 0; bj < 2; ++bj)
#pragma unroll
                    for (int n = 0; n < 2; ++n) { const f32x4 o = acc[ai][bj][m][n] + xv[m][bj][n] * ALPHA;
                        *(f32x4*)(O + (size_t)(row0 + ai * 128 + m * 16) * DM + col0 + bj * 128 + 16 * n) = o;
                        s1 += (o[0] + o[1]) + (o[2] + o[3]); s2 += (o[0] * o[0] + o[1] * o[1]) + (o[2] * o[2] + o[3] * o[3]); }
                stat_put(ST, ai * 128 + wr * 64 + m * 16 + fr, wc, fq, s1, s2, first); }
        }
    }
};
struct EpiRes2 {
    static constexpr bool PERM = false, AFTER_DRAIN = false;
    const float* R; float* O; const float2* stat; const float* g; const float* b; LAS unsigned char* lds; mutable int ecnt;
    __device__ __forceinline__ void operator()(const f32x4 (&acc)[2][2][4][2], const pg8::Unit& u, int wr, int wc, int fr, int fq) const {
        const int row0 = u.pm * 256 + wr * 64 + fr, col0 = u.pn * 256 + wc * 32 + 4 * fq;
        LAS cplx* ST = (LAS cplx*)(lds + XCH_OFF) + (ecnt & 1) * 1024; const bool first = true; ++ecnt;
#pragma unroll
        for (int ai = 0; ai < 2; ++ai)
#pragma unroll
            for (int bj = 0; bj < 2; ++bj) {
                f32x4 rv[4][2], gv[2], bv[2]; float2 st[4];
#pragma unroll
                for (int m = 0; m < 4; ++m) { const int row = row0 + ai * 128 + m * 16; st[m] = stat[row];
#pragma unroll
                    for (int n = 0; n < 2; ++n) rv[m][n] = *(const f32x4*)(R + (size_t)row * DM + col0 + bj * 128 + 16 * n); }
#pragma unroll
                for (int n = 0; n < 2; ++n) { gv[n] = *(const f32x4*)(g + col0 + bj * 128 + 16 * n); bv[n] = *(const f32x4*)(b + col0 + bj * 128 + 16 * n); }
                asm volatile("" ::: "memory");
#pragma unroll
                for (int m = 0; m < 4; ++m) { float s1 = 0.f, s2 = 0.f;
#pragma unroll
                    for (int n = 0; n < 2; ++n) { const f32x4 x1 = (rv[m][n] - st[m].x) * st[m].y * gv[n] + bv[n]; const f32x4 o = acc[ai][bj][m][n] + x1 * ALPHA;
                        *(f32x4*)(O + (size_t)(row0 + ai * 128 + m * 16) * DM + col0 + bj * 128 + 16 * n) = o;
                        s1 += (o[0] + o[1]) + (o[2] + o[3]); s2 += (o[0] * o[0] + o[1] * o[1]) + (o[2] * o[2] + o[3] * o[3]); }
                    stat_put(ST, ai * 128 + wr * 64 + m * 16 + fr, wc, fq, s1, s2, first && bj == 0); }
            }
    }
};
template <int MODE> struct EpiLn {
    static constexpr bool PERM = false, AFTER_DRAIN = false;
    const float* RES; float* OF; bf16_t* OB; const float* g; const float* b; unsigned long long* XG; unsigned* CNT; LAS unsigned char* ldsp;
    __device__ __forceinline__ void operator()(const f32x4 (&acc)[2][2][4][2], const pg8::Unit& u, int wr, int wc, int fr, int fq) const {
        const int t_ = threadIdx.x; fused(const_cast<f32x4 (&)[2][2][4][2]>(acc), u, wr, wc, fr, fq, ldsp, __builtin_amdgcn_readfirstlane(t_ >> 6), t_ & 63); }
    __device__ __forceinline__ void fused(f32x4 (&acc)[2][2][4][2], const pg8::Unit& u, int wr, int wc, int fr, int fq, LAS unsigned char* lds, int wid, int lane) const {
        const int tid = wid * 64 + lane, row0 = u.pm * 256 + wr * 64 + fr, col0 = u.pn * 256 + wc * 32 + 4 * fq;
        LAS cplx* ST = (LAS cplx*)(lds + XCH_OFF); LAS cplx* MR = (LAS cplx*)(lds + XCH_OFF + 8192);
#pragma unroll
        for (int ai = 0; ai < 2; ++ai) {
            float s1[4], s2[4];
#pragma unroll
            for (int m = 0; m < 4; ++m) { s1[m] = 0.f; s2[m] = 0.f; }
#pragma unroll
            for (int bj = 0; bj < 2; ++bj) {
                f32x4 xv[4][2];
#pragma unroll
                for (int m = 0; m < 4; ++m)
#pragma unroll
                    for (int n = 0; n < 2; ++n) xv[m][n] = *(const f32x4*)(RES + (size_t)(row0 + ai * 128 + m * 16) * DM + col0 + bj * 128 + 16 * n);
                asm volatile("" ::: "memory");
#pragma unroll
                for (int m = 0; m < 4; ++m)
#pragma unroll
                    for (int n = 0; n < 2; ++n) { const f32x4 o = acc[ai][bj][m][n] + xv[m][n] * ALPHA; acc[ai][bj][m][n] = o;
                        s1[m] += (o[0] + o[1]) + (o[2] + o[3]); s2[m] += (o[0] * o[0] + o[1] * o[1]) + (o[2] * o[2] + o[3] * o[3]); }
            }
#pragma unroll
            for (int m = 0; m < 4; ++m) stat_put(ST, ai * 128 + wr * 64 + m * 16 + fr, wc, fq, s1[m], s2[m], true);
        }
        asm volatile("s_waitcnt lgkmcnt(0)" ::: "memory"); __syncthreads();
        float m1 = 0.f, m2 = 0.f;
        if (tid < 256) { const cplx a0 = ST[tid * 4 + 0], a1 = ST[tid * 4 + 1], a2 = ST[tid * 4 + 2], a3 = ST[tid * 4 + 3];
            m1 = (a0.x + a1.x) + (a2.x + a3.x); m2 = (a0.y + a1.y) + (a2.y + a3.y);
            __hip_atomic_store(XG + (size_t)(u.pm * 4 + u.pn) * 256 + tid, ((unsigned long long)__float_as_uint(m2) << 32) | __float_as_uint(m1), __ATOMIC_RELAXED, __HIP_MEMORY_SCOPE_AGENT); }
        asm volatile("s_waitcnt vmcnt(0)" ::: "memory");
        __syncthreads();
        if (tid == 0) {
            (void)__hip_atomic_fetch_add(CNT + u.pm * 16, 1u, __ATOMIC_RELAXED, __HIP_MEMORY_SCOPE_AGENT);
            unsigned sp = 0;
            while (__hip_atomic_load(CNT + u.pm * 16, __ATOMIC_RELAXED, __HIP_MEMORY_SCOPE_AGENT) < 4u) { __builtin_amdgcn_s_sleep(1); if (++sp > (1u << 22)) break; }
            __builtin_amdgcn_fence(__ATOMIC_ACQUIRE, "agent");
            asm volatile("s_waitcnt vmcnt(0)" ::: "memory");
        }
        __syncthreads();
        if (tid < 256) { float t1 = m1, t2 = m2;
#pragma unroll
            for (int jj = 1; jj < 4; ++jj) { const unsigned long long w = __hip_atomic_load(XG + (size_t)(u.pm * 4 + ((u.pn + jj) & 3)) * 256 + tid, __ATOMIC_RELAXED, __HIP_MEMORY_SCOPE_AGENT);
                t1 += __uint_as_float((unsigned)w); t2 += __uint_as_float((unsigned)(w >> 32)); }
            const float mean = t1 * (1.0f / DM), var = fmaxf(t2 * (1.0f / DM) - mean * mean, 0.f);
            cplx mr; mr.x = mean; mr.y = rsqrtf(var + LN_EPS); MR[tid] = mr; }
        __syncthreads();
#pragma unroll
        for (int bj = 0; bj < 2; ++bj)
#pragma unroll
            for (int n = 0; n < 2; ++n) { const int c = col0 + bj * 128 + 16 * n; const f32x4 gv = *(const f32x4*)(g + c), bv = *(const f32x4*)(b + c);
#pragma unroll
                for (int ai = 0; ai < 2; ++ai)
#pragma unroll
                    for (int m = 0; m < 4; ++m) { const int rl = ai * 128 + wr * 64 + m * 16 + fr; const cplx mr = MR[rl];
                        const f32x4 y = (acc[ai][bj][m][n] - mr.x) * mr.y * gv + bv; const size_t off = (size_t)(u.pm * 256 + rl) * DM + c;
                        *(f32x4*)(OF + off) = y;
                        if (MODE == 1) { u32x2 w; w.x = pk2(y[0], y[1]); w.y = pk2(y[2], y[3]); *(u32x2*)(OB + off) = w; } } }
    }
};
struct QuadTwo { int q, j;
    __device__ __forceinline__ bool next(int i, pg8::Unit& u) const { if (i > 1) return false; u.pm = 2 * q + i; u.pn = j; return true; }
    __device__ __forceinline__ void a_ready(const pg8::Unit&) const {}
    __device__ __forceinline__ void done(const pg8::Unit&) const {}
    __device__ __forceinline__ long a_off(const pg8::Unit& u, size_t tstep) const { return (long)((size_t)u.pm * tstep); }
    __device__ __forceinline__ int lda(int K) const { return K; }
    __device__ __forceinline__ size_t kstep_a() const { return 128; } };
struct QuadTwoKb : QuadTwo {
    __device__ __forceinline__ int lda(int) const { return 64; }
    __device__ __forceinline__ size_t kstep_a() const { return (size_t)NT * 64 * 2; } };
struct OneUnitKb : OneUnit {
    __device__ __forceinline__ int lda(int) const { return 64; }
    __device__ __forceinline__ size_t kstep_a() const { return (size_t)NT * 64 * 2; }
};
struct PairOrder : pg8::StaticOrder {
    bool pair;
    __device__ __forceinline__ static int vcu_of(int c) { return (c & 7) * 32 + (c >> 3); }
    __device__ __forceinline__ bool next(int i, pg8::Unit& u) const {
        if (!pair) return pg8::StaticOrder::next(i, u);
        if (i > 1) return false;
        const int v = vcu_of(c); u.pm = 2 * (v >> 2) + i; u.pn = v & 3; return true; }
};
struct KbOrder : pg8::StaticOrder {
    __device__ __forceinline__ int lda(int) const { return 64; }
    __device__ __forceinline__ size_t kstep_a() const { return (size_t)NT * 64 * 2; }
};
struct PairKb : PairOrder {
    __device__ __forceinline__ int lda(int) const { return 64; }
    __device__ __forceinline__ size_t kstep_a() const { return (size_t)NT * 64 * 2; }
};
struct RevOrder : pg8::StaticOrder {
    __device__ __forceinline__ bool next(int i, pg8::Unit& u) const { const int rounds = (nwg + G - 1) / G; if (i >= rounds) return false; return pg8::StaticOrder::next(rounds - 1 - i, u); }
};
constexpr int CWL_OFF = 131072 + 1024 + 8192;
struct FfnOrder : pg8::StaticOrder {
    const float* cw; const float* cb; LAS unsigned char* lds; mutable int cnt;
    __device__ __forceinline__ long a_off(const pg8::Unit& u, size_t) const { return ((long)u.pm * 254 - 1) * (long)(DM * 2); }
    __device__ __forceinline__ void a_ready(const pg8::Unit& u) const {
        const int tid = threadIdx.x, w = __builtin_amdgcn_readfirstlane(tid >> 6), lane = tid & 63, buf = cnt & 1; ++cnt;
        const float* src = (w < 3) ? cw + (size_t)w * (2 * DFF) : (w < 6) ? cw + (size_t)(w - 3) * (2 * DFF) + DFF : (w == 6) ? cb : cb + DFF;
        src += u.pn * 128 + lane * 4;
        if (lane < 32) __builtin_amdgcn_global_load_lds((const unsigned*)src, (LAS unsigned*)(lds + CWL_OFF + buf * 4096 + w * 512), 16, 0, 0);
    }
};
constexpr int FFN_MT = 130;
__device__ __forceinline__ float dpp_ror1(float v)  { return __int_as_float(__builtin_amdgcn_update_dpp(0, __float_as_int(v), 0x121, 0xF, 0xF, false)); }
__device__ __forceinline__ float dpp_ror15(float v) { return __int_as_float(__builtin_amdgcn_update_dpp(0, __float_as_int(v), 0x12F, 0xF, 0xF, false)); }
struct EpiFfn {
    static constexpr bool PERM = true, AFTER_DRAIN = false;
    bf16_t* ACT; LAS unsigned char* lds; mutable int ecnt;
    __device__ __forceinline__ void operator()(const f32x4 (&acc)[2][2][4][2], const pg8::Unit& u, int wr, int wc, int fr, int fq) const {
        LAS float* XC = (LAS float*)(lds + XCH_OFF);
        const LAS float* WL = (const LAS float*)(lds + CWL_OFF + (ecnt & 1) * 4096); ++ecnt;
        const int colw = wc * 32 + 8 * fq;
        if (fr == 0 || fr == 15) {
            const int edge = (fr == 15) ? 1 : 0, m = (fr == 15) ? 3 : 0;
#pragma unroll
            for (int ai = 0; ai < 2; ++ai)
#pragma unroll
                for (int bj = 0; bj < 2; ++bj)
#pragma unroll
                    for (int n = 0; n < 2; ++n) { const f32x4 v = (m == 0) ? acc[ai][bj][0][n] : acc[ai][bj][3][n];
                        *(LAS f32x4*)(XC + ((ai * 2 + wr) * 2 + edge) * 256 + bj * 128 + colw + 4 * n) = v; }
        }
        asm volatile("s_waitcnt lgkmcnt(0)" ::: "memory"); __builtin_amdgcn_s_barrier(); asm volatile("" ::: "memory");
        const int slot0 = wr * 64 + fr, row_base = u.pm * 254 - 1;
#pragma unroll
        for (int bj = 0; bj < 2; ++bj) {
            const int gc = (u.pn * 256 + bj * 128 + colw) >> 1;
            const LAS float* wl = WL + ((bj * 128 + colw) >> 1);
            f32x4 wg[3], wu[3];
#pragma unroll
            for (int j = 0; j < 3; ++j) { wg[j] = *(const LAS f32x4*)(wl + j * 128); wu[j] = *(const LAS f32x4*)(wl + (3 + j) * 128); }
            const f32x4 bg = *(const LAS f32x4*)(wl + 6 * 128), bu = *(const LAS f32x4*)(wl + 7 * 128);
#pragma unroll
            for (int ai = 0; ai < 2; ++ai) {
                const int gidx = ai * 2 + wr;
                f32x4 pe[2], ne[2];
#pragma unroll
                for (int n = 0; n < 2; ++n) {
                    pe[n] = (gidx > 0) ? *(const LAS f32x4*)(XC + (((gidx - 1) * 2) + 1) * 256 + bj * 128 + colw + 4 * n) : (f32x4){0.f, 0.f, 0.f, 0.f};
                    ne[n] = (gidx < 3) ? *(const LAS f32x4*)(XC + (((gidx + 1) * 2) + 0) * 256 + bj * 128 + colw + 4 * n) : (f32x4){0.f, 0.f, 0.f, 0.f}; }
#pragma unroll
                for (int m = 0; m < 4; ++m) {
                    const int slot = ai * 128 + slot0 + m * 16, row = row_base + slot, t = row & (SEQ - 1);
                    f32x4 hv[2];
#pragma unroll
                    for (int n = 0; n < 2; ++n) {
                        const f32x4 cur = acc[ai][bj][m][n], prv = acc[ai][bj][m == 0 ? 0 : m - 1][n], nxt = acc[ai][bj][m == 3 ? 3 : m + 1][n];
                        f32x4 up, dn;
#pragma unroll
                        for (int e = 0; e < 4; ++e) { up[e] = dpp_ror1(fr == 15 ? prv[e] : cur[e]); dn[e] = dpp_ror15(fr == 0 ? nxt[e] : cur[e]); }
                        if (m == 0 && fr == 0) up = pe[n];
                        if (m == 3 && fr == 15) dn = ne[n];
                        if (t == 0) up = (f32x4){0.f, 0.f, 0.f, 0.f};
                        if (t == SEQ - 1) dn = (f32x4){0.f, 0.f, 0.f, 0.f};
                        const f32x4 w0 = n ? wu[0] : wg[0], w1 = n ? wu[1] : wg[1], w2 = n ? wu[2] : wg[2], bb = n ? bu : bg;
                        hv[n] = w0 * up + w1 * cur + w2 * dn + bb; }
                    if (slot >= 1 && slot <= 254 && row < NT) {
                        float o[4];
#pragma unroll
                        for (int e = 0; e < 4; ++e) { const float g = hv[0][e]; o[e] = g * __builtin_amdgcn_rcpf(1.0f + __expf(-g)) * hv[1][e]; }
                        u32x2 w; w.x = pk2(o[0], o[1]); w.y = pk2(o[2], o[3]);
                        *(u32x2*)(ACT + ((size_t)(gc >> 6) * NT + row) * 64 + (gc & 63)) = w; }
                }
            }
        }
    }
};

__device__ __forceinline__ int win_row(int n) {
    if (n < 1536) return 1536 + n;
    if (n < 2560) { const int q = n - 1536, blk = q >> 6, d = q & 63; return blk * 64 + 2 * (d & 31) + (d >> 5); }
    if (n < 3072) return 512 + n;
    return n - 2048;
}
template <int MODE> __device__ __forceinline__ void p0_transpose_item(const float* W, int K, int N, bf16_t* WT, LAS float* scr, int item, int lane) {
    const int nblk = N / 32, kb = item / nblk, nb = item % nblk, k0 = 64 * kb, n0 = 32 * nb;
    f32x4 q[8];
#pragma unroll
    for (int i = 0; i < 8; ++i) q[i] = *(const f32x4*)(W + (size_t)(k0 + 8 * i + (lane >> 3)) * N + n0 + 4 * (lane & 7));
#pragma unroll
    for (int i = 0; i < 8; ++i) { LAS float* d = scr + (8 * i + (lane >> 3)) * 33 + 4 * (lane & 7); d[0] = q[i][0]; d[1] = q[i][1]; d[2] = q[i][2]; d[3] = q[i][3]; }
    LDS_WAIT(); asm volatile("" ::: "memory");
    const int c = lane & 7;
#pragma unroll
    for (int j = 0; j < 4; ++j) { const int n = (lane >> 3) + 8 * j; const LAS float* s = scr + (8 * c) * 33 + n;
        u32x4 o; o.x = pk2(s[0 * 33], s[1 * 33]); o.y = pk2(s[2 * 33], s[3 * 33]); o.z = pk2(s[4 * 33], s[5 * 33]); o.w = pk2(s[6 * 33], s[7 * 33]);
        const int nn = n0 + n; const int dr = (MODE == 1) ? win_row(nn) : (MODE == 2) ? ((nn < DFF) ? ((nn >> 2) * 8 + (nn & 3)) : (((nn - DFF) >> 2) * 8 + 4 + ((nn - DFF) & 3))) : nn;
        *(u32x4*)(WT + (size_t)dr * K + k0 + 8 * c) = o; }
    LDS_WAIT(); asm volatile("" ::: "memory");
}
__device__ __forceinline__ void cvt_rows(const float* src, bf16_t* dst, size_t n8, int gw, int ngw, int lane) {
    const size_t stride = (size_t)ngw * 64;
    for (size_t i = (size_t)gw * 64 + lane; i < n8; i += 4 * stride) {
        f32x4 a[4], c[4];
#pragma unroll
        for (int u = 0; u < 4; ++u) { const size_t k = i + u * stride; if (k < n8) { a[u] = ((const f32x4*)src)[2 * k]; c[u] = ((const f32x4*)src)[2 * k + 1]; } }
#pragma unroll
        for (int u = 0; u < 4; ++u) { const size_t k = i + u * stride; if (k < n8) {
            u32x4 w; w.x = pk2(a[u][0], a[u][1]); w.y = pk2(a[u][2], a[u][3]); w.z = pk2(c[u][0], c[u][1]); w.w = pk2(c[u][2], c[u][3]);
            ((u32x4*)dst)[k] = w; } }
    }
}
__device__ __forceinline__ void p0_filter_item(const LAS float* w1, const float* b1, const float* fq, const LAS float* w2, const float* b2, const float* w3, float* HTD, int item, int lane) {
    const int t0 = 2 * (item >> 2), ih = item & 3; float h2v[2], tl[2];
    const float fql = fq[lane], b1l = b1[lane], b2l = b2[lane];
#pragma unroll
    for (int tt = 0; tt < 2; ++tt) { const int t = t0 + tt; tl[tt] = (float)t * (1.0f / 2047.0f);
        const float w = 6.283185307179586f * (float)t / 2048.0f;
        float zk = 0.f;
        if (lane == 0) zk = tl[tt];
        else if (lane <= 16) { const float fr = 1e-4f + (float)(lane - 1) * ((15.0f - 1e-4f) / 15.0f); zk = cosf(fr * w); }
        else if (lane <= 32) { const float fr = 1e-4f + (float)(lane - 17) * ((15.0f - 1e-4f) / 15.0f); zk = -sinf(fr * w); }
        float a = b1l;
#pragma unroll 11
        for (int k = 0; k < 33; ++k) a += __shfl(zk, k) * w1[k * 64 + lane];
        const float h1 = sinf(fql * a);
        float a2 = b2l;
#pragma unroll 16
        for (int k = 0; k < 64; ++k) a2 += __shfl(h1, k) * w2[k * 64 + lane];
        h2v[tt] = sinf(fql * a2); }
    const float dmin = -15.350567286626973f, dmax = -3.0701134573253946f;
    float acc0[8], acc1[8];
#pragma unroll
    for (int i = 0; i < 8; ++i) { acc0[i] = 0.f; acc1[i] = 0.f; }
#pragma unroll 8
    for (int j = 0; j < 64; ++j) { const float s0 = __shfl(h2v[0], j), s1 = __shfl(h2v[1], j); const float* wr = w3 + (size_t)j * 2048 + ih * 512 + lane;
#pragma unroll
        for (int i = 0; i < 8; ++i) { const float wv = wr[64 * i]; acc0[i] += s0 * wv; acc1[i] += s1 * wv; } }
#pragma unroll
    for (int i = 0; i < 8; ++i) { const int col = ih * 512 + 64 * i + lane, c = col & 511;
        const float delta = fabsf(dmin + (float)c * ((dmax - dmin) / 511.0f));
        float2 o; o.x = acc0[i] * expf(-tl[0] * delta); o.y = acc1[i] * expf(-tl[1] * delta);
        *(float2*)(HTD + (size_t)col * 2048 + t0) = o; }
}
__device__ __forceinline__ void p0_prep(const float* const* in, unsigned char* ws, LAS unsigned char* lds, int tid) {
    const int lane = tid & 63, wave = __builtin_amdgcn_readfirstlane(tid >> 6), gw = blockIdx.x * NWAVE + wave, ngw = gridDim.x * NWAVE;
    LAS float* scr = (LAS float*)(lds + wave * 8704);
    LAS float* W1L = (LAS float*)(lds + 69632); LAS float* W2L = W1L + 33 * 64;
    for (int i = tid; i < 33 * 64; i += NTHR) W1L[i] = in[5][i];
    for (int i = tid; i < 64 * 64; i += NTHR) W2L[i] = in[8][i];
    __syncthreads();
    bf16_t* WALL = (bf16_t*)(ws + WS_WALL);
    constexpr int I_IN = 16 * (INW / 32), I_KV = 16 * 32, I_OUT = 24 * 32, I_UP = 16 * (2 * DFF / 32), I_DN = (DFF / 64) * 32, NIT = I_IN + I_KV + I_OUT + I_UP + I_DN;
    for (int it = gw; it < NIT; it += ngw) { int r = it;
        if (r < I_IN) { p0_transpose_item<1>(in[2], DM, INW, WALL, scr, r, lane); continue; } r -= I_IN;
        if (r < I_KV) { p0_transpose_item<0>(in[14], DM, 1024, (bf16_t*)(ws + WS_WKV), scr, r, lane); continue; } r -= I_KV;
        if (r < I_OUT) { p0_transpose_item<0>(in[15], MIXW, DM, (bf16_t*)(ws + WS_WOUT), scr, r, lane); continue; } r -= I_OUT;
        if (r < I_UP) { p0_transpose_item<2>(in[18], DM, 2 * DFF, (bf16_t*)(ws + WS_WUP), scr, r, lane); continue; } r -= I_UP;
        p0_transpose_item<0>(in[21], DFF, DM, (bf16_t*)(ws + WS_WDN), scr, r, lane); }
    for (int it = ngw - 1 - gw; it < 4096; it += ngw) p0_filter_item(W1L, in[6], in[7], W2L, in[9], in[10], (float*)(ws + WS_HTD), it, lane);
    cvt_rows(in[0], (bf16_t*)(ws + WS_XB), (size_t)NT * DM / 8, gw, ngw, lane);
    cvt_rows(in[1], (bf16_t*)(ws + WS_MEMB), (size_t)NMT * DM / 8, gw, ngw, lane);
    float2* rope = (float2*)(ws + WS_ROPE);
    for (int i = blockIdx.x * NTHR + tid; i < SEQ * 32; i += gridDim.x * NTHR) { const int pos = i >> 5, f = i & 31;
        const float invf = powf(10000.0f, -(float)(2 * f) / 64.0f); const float ang = (float)pos * invf;
        float2 cs; cs.x = cosf(ang); cs.y = sinf(ang); rope[i] = cs; }
}

__device__ __forceinline__ void filter_fft_item(const float* HTD, float2* KF, LAS unsigned char* lds, int item, int tid) {
    const int o = item >> 9, c = item & 511;
    const float* rf = HTD + (size_t)((o * 2 + 0) * 512 + c) * 2048; const float* rb = HTD + (size_t)((o * 2 + 1) * 512 + c) * 2048;
    cplx v[8];
#pragma unroll
    for (int k = 0; k < 4; ++k) v[k] = mk2(rf[tid + 512 * k], 0.f);
    v[4] = mk2(tid == 0 ? 0.f : rb[2048 - tid], 0.f); v[5] = mk2(rb[1536 - tid], 0.f); v[6] = mk2(rb[1024 - tid], 0.f); v[7] = mk2(rb[512 - tid], 0.f);
    fft_fwd((LAS cplx*)lds, tid, v);
    float2* dst = KF + (size_t)(o * 512 + c) * 4096 + 8 * tid;
#pragma unroll
    for (int m = 0; m < 8; m += 2) { f32x4 w; w[0] = v[m].x * (1.f / 4096.f); w[1] = v[m].y * (1.f / 4096.f); w[2] = v[m + 1].x * (1.f / 4096.f); w[3] = v[m + 1].y * (1.f / 4096.f); *(f32x4*)(dst + m) = w; }
    __syncthreads();
}

constexpr int HY_SEG = 2064, HY_STG_OFF = 36864;
__device__ __forceinline__ float conv3s(const LAS bf16_t* seg, int n, float w0, float w1, float w2, float b) {
    return w0 * bf2f(seg[7 + n]) + w1 * bf2f(seg[8 + n]) + w2 * bf2f(seg[9 + n]) + b;
}
__device__ __forceinline__ void hyena_item(const bf16_t* HT, const float2* KF, const float* cw, const float* cb, const float* hb, bf16_t* MIX, LAS unsigned char* lds, int bp, int cgp, int tid0) {
    LAS cplx* X = (LAS cplx*)lds; LAS bf16_t* STG = (LAS bf16_t*)(lds + HY_STG_OFF); LAS cplx* TW = (LAS cplx*)(lds + 65536);
    const int ba = 2 * bp;
    twid_fill<512>(TW, tid0); twid_fill<64>(TW, tid0); twid_fill<8>(TW, tid0);
    u32x4 oacc[8];
#pragma unroll
    for (int i = 0; i < 8; ++i) oacc[i] = (u32x4){0u, 0u, 0u, 0u};
    if (tid0 < 12) { const int sg = tid0 >> 1; STG[sg * HY_SEG + ((tid0 & 1) ? 2056 : 7)] = 0; }
    { const int c = cgp * 8;
#pragma unroll
      for (int i = 0; i < 3; ++i) { const int id = tid0 + 512 * i, sg = id >> 8, ch = id & 255;
          const u32x4 q = *(const u32x4*)(HT + (size_t)((sg >> 1) * 512 + c) * NT + (ba + (sg & 1)) * SEQ + ch * 8);
          *(LAS u32x4*)(STG + sg * HY_SEG + 8 + ch * 8) = q; } }
    __syncthreads();
#pragma unroll 1
    for (int cc = 0; cc < 8; ++cc) {
        const int c = cgp * 8 + cc;
        int tl_ = tid0; asm volatile("" : "+v"(tl_)); const int tid = tl_;
        const float cwv0 = cw[c], cwv1 = cw[1536 + c], cwv2 = cw[3072 + c], cbv = cb[c], cw10 = cw[512 + c], cw11 = cw[1536 + 512 + c], cw12 = cw[3072 + 512 + c], cb1 = cb[512 + c],
                    cw20 = cw[1024 + c], cw21 = cw[1536 + 1024 + c], cw22 = cw[3072 + 1024 + c], cb2 = cb[1024 + c], hbv0 = hb[c], hbv1 = hb[512 + c];
        u32x4 nx[3];
        if (cc < 7) {
#pragma unroll
            for (int i = 0; i < 3; ++i) { const int id = tid + 512 * i, sg = id >> 8, ch = id & 255;
                nx[i] = *(const u32x4*)(HT + (size_t)((sg >> 1) * 512 + c + 1) * NT + (ba + (sg & 1)) * SEQ + ch * 8); } }
        f32x4 kf[4];
        { const f32x4* kp = (const f32x4*)(KF + (size_t)c * 4096 + 8 * tid);
#pragma unroll
          for (int m = 0; m < 4; ++m) kf[m] = kp[m]; }
        cplx v[8]; float va[4], vb[4];
        { const float w0 = cwv0, w1 = cwv1, w2 = cwv2, b = cbv;
#pragma unroll
          for (int k = 0; k < 4; ++k) { const int n = tid + 512 * k; va[k] = conv3s(STG, n, w0, w1, w2, b); vb[k] = conv3s(STG + HY_SEG, n, w0, w1, w2, b); v[k] = mk2(va[k], vb[k]); v[4 + k] = mk2(0.f, 0.f); } }
        fft_fwdL(X, TW, tid, v);
#pragma unroll
        for (int m = 0; m < 8; m += 2) { const f32x4 w = kf[m >> 1]; v[m] = cmul(v[m], mk2(w[0], w[1])); v[m + 1] = cmul(v[m + 1], mk2(w[2], w[3])); }
        { const f32x4* kp = (const f32x4*)(KF + (size_t)(512 + c) * 4096 + 8 * tid);
#pragma unroll
          for (int m = 0; m < 4; ++m) kf[m] = kp[m]; }
        fft_invL(X, TW, tid, v);
        { const float w0 = cw10, w1 = cw11, w2 = cw12, b = cb1, hb0 = hbv0;
#pragma unroll
          for (int k = 0; k < 4; ++k) { const int n = tid + 512 * k; const float xa = conv3s(STG + 2 * HY_SEG, n, w0, w1, w2, b), xb = conv3s(STG + 3 * HY_SEG, n, w0, w1, w2, b);
              va[k] = xa * (v[k].x + hb0 * va[k]); vb[k] = xb * (v[k].y + hb0 * vb[k]); v[k] = mk2(va[k], vb[k]); v[4 + k] = mk2(0.f, 0.f); } }
        fft_fwdL(X, TW, tid, v);
#pragma unroll
        for (int m = 0; m < 8; m += 2) { const f32x4 w = kf[m >> 1]; v[m] = cmul(v[m], mk2(w[0], w[1])); v[m + 1] = cmul(v[m + 1], mk2(w[2], w[3])); }
        fft_invL(X, TW, tid, v);
        { const float w0 = cw20, w1 = cw21, w2 = cw22, b = cb2, hb1 = hbv1;
#pragma unroll
          for (int k = 0; k < 4; ++k) { const int n = tid + 512 * k; const float xa = conv3s(STG + 4 * HY_SEG, n, w0, w1, w2, b), xb = conv3s(STG + 5 * HY_SEG, n, w0, w1, w2, b);
              const float oa = xa * (v[k].x + hb1 * va[k]), ob = xb * (v[k].y + hb1 * vb[k]);
              const unsigned pw = pk2(oa, ob);
#pragma unroll
              for (int hh = 0; hh < 2; ++hh) { u32x4& o = oacc[2 * k + hh]; const unsigned nw = hh ? (pw & 0xffff0000u) : (pw << 16);
                  o.x = __builtin_amdgcn_alignbit(o.y, o.x, 16); o.y = __builtin_amdgcn_alignbit(o.z, o.y, 16); o.z = __builtin_amdgcn_alignbit(o.w, o.z, 16); o.w = (o.w >> 16) | nw; } } }
        __syncthreads();
        if (cc < 7) {
#pragma unroll
            for (int i = 0; i < 3; ++i) { const int id = tid + 512 * i, sg = id >> 8, ch = id & 255; *(LAS u32x4*)(STG + sg * HY_SEG + 8 + ch * 8) = nx[i]; } }
        __syncthreads();
    }
    int tw_ = tid0; asm volatile("" : "+v"(tw_)); const int tid = tw_;
#pragma unroll
    for (int k = 0; k < 4; ++k)
#pragma unroll
        for (int hh = 0; hh < 2; ++hh) *(u32x4*)(MIX + (size_t)((ba + hh) * SEQ + tid + 512 * k) * MIXW + cgp * 8) = oacc[2 * k + hh];
}

constexpr int ATT_KP = 272, ATT_VP = 144, ATT_KB = 64 * ATT_KP, ATT_VB = 128 * ATT_VP, ATT_VOFF = 2 * ATT_KB;
__device__ __forceinline__ float half_swap_max(float v) { const auto r_ = __builtin_amdgcn_permlane32_swap(__float_as_uint(v), __float_as_uint(v), false, false); return fmaxf(__uint_as_float(r_[0]), __uint_as_float(r_[1])); }
__device__ __forceinline__ float half_swap_sum(float v) { const auto r_ = __builtin_amdgcn_permlane32_swap(__float_as_uint(v), __float_as_uint(v), false, false); return __uint_as_float(r_[0]) + __uint_as_float(r_[1]); }
__device__ __forceinline__ void att_vput(LAS unsigned char* p, u32x4 q) { u32x2 lo, hi; lo.x = q.x; lo.y = q.y; hi.x = q.z; hi.y = q.w; *(LAS u32x2*)p = lo; *(LAS u32x2*)(p + 16) = hi; }
template <int NC> __device__ __forceinline__ void attn_unit(LAS unsigned char* lds, const bf16_t* Qp, int ldq, const bf16_t* Kp, int ldk, const bf16_t* Vt, int ldv, int nkeys, float sl2,
                                                            bf16_t* Op, int ldo, float lam, const float* subg, int tid) {
    constexpr int NSTEP = (NC == 2) ? 4 : 8;
    const int lane = tid & 63, wave = tid >> 6, r = lane & 31, h = lane >> 5;
    const int qb = (NC == 2) ? (wave & 3) : wave, comp = (NC == 2) ? (wave >> 2) : 0, dbase = comp * 64;
    bf16x8 qf[NSTEP];
#pragma unroll
    for (int st = 0; st < NSTEP; ++st) qf[st] = *(const bf16x8*)(Qp + (size_t)(qb * 32 + r) * ldq + dbase + 16 * st + 8 * h);
    f32x16 o[4];
#pragma unroll
    for (int et = 0; et < 4; ++et)
#pragma unroll
        for (int i = 0; i < 16; ++i) o[et][i] = 0.f;
    float mold = -INFINITY, lsum = 0.f;
    const int kr0 = tid >> 4, kc = tid & 15, vr0 = tid >> 3, vc = tid & 7;
    const bf16_t* kg = Kp + (size_t)kr0 * ldk + kc * 8; const bf16_t* vg = Vt + (size_t)vr0 * ldv + vc * 8;
    const int kl = kr0 * ATT_KP + kc * 16, vl = ATT_VOFF + vr0 * ATT_VP + (vc >> 1) * 32 + (vc & 1) * 8;
    const int nt = nkeys / 64;
    u32x4 pk0, pk1, pv0, pv1;
    pk0 = *(const u32x4*)(kg); pk1 = *(const u32x4*)(kg + (size_t)32 * ldk); pv0 = *(const u32x4*)(vg); pv1 = *(const u32x4*)(vg + (size_t)64 * ldv);
    *(LAS u32x4*)(lds + kl) = pk0; *(LAS u32x4*)(lds + kl + 32 * ATT_KP) = pk1; att_vput(lds + vl, pv0); att_vput(lds + vl + 64 * ATT_VP, pv1);
    __syncthreads();
    for (int it = 0; it < nt; ++it) {
        const int cur = it & 1; const bool more = (it + 1 < nt);
        if (more) { const bf16_t* kg2 = kg + (size_t)(it + 1) * 64 * ldk; const bf16_t* vg2 = vg + (it + 1) * 64;
            pk0 = *(const u32x4*)(kg2); pk1 = *(const u32x4*)(kg2 + (size_t)32 * ldk); pv0 = *(const u32x4*)(vg2); pv1 = *(const u32x4*)(vg2 + (size_t)64 * ldv); }
        LAS unsigned char* Kb = lds + cur * ATT_KB; LAS unsigned char* Vb = lds + ATT_VOFF + cur * ATT_VB;
        f32x16 s[2];
#pragma unroll
        for (int kb = 0; kb < 2; ++kb) {
#pragma unroll
            for (int i = 0; i < 16; ++i) s[kb][i] = 0.f;
#pragma unroll
            for (int st = 0; st < NSTEP; ++st) { const bf16x8 a = *(const LAS bf16x8*)(Kb + (kb * 32 + r) * ATT_KP + (dbase + 16 * st + 8 * h) * 2);
                s[kb] = __builtin_amdgcn_mfma_f32_32x32x16_bf16(a, qf[st], s[kb], 0, 0, 0); } }
        float mx = s[0][0];
#pragma unroll
        for (int i = 1; i < 16; ++i) mx = fmaxf(mx, s[0][i]);
#pragma unroll
        for (int i = 0; i < 16; ++i) mx = fmaxf(mx, s[1][i]);
        mx = half_swap_max(mx);
        const float mnew = fmaxf(mold, mx * sl2), alpha = __builtin_amdgcn_exp2f(mold - mnew); mold = mnew;
        float ps = 0.f;
#pragma unroll
        for (int kb = 0; kb < 2; ++kb)
#pragma unroll
            for (int i = 0; i < 16; ++i) { const float p = __builtin_amdgcn_exp2f(__builtin_fmaf(s[kb][i], sl2, -mnew)); s[kb][i] = p; ps += p; }
        lsum = lsum * alpha + ps;
#pragma unroll
        for (int et = 0; et < 4; ++et)
#pragma unroll
            for (int i = 0; i < 16; ++i) o[et][i] *= alpha;
#pragma unroll
        for (int kb = 0; kb < 2; ++kb)
#pragma unroll
            for (int s2 = 0; s2 < 2; ++s2) {
                u32x4 pw; pw.x = pk2(s[kb][8 * s2 + 0], s[kb][8 * s2 + 1]); pw.y = pk2(s[kb][8 * s2 + 2], s[kb][8 * s2 + 3]); pw.z = pk2(s[kb][8 * s2 + 4], s[kb][8 * s2 + 5]); pw.w = pk2(s[kb][8 * s2 + 6], s[kb][8 * s2 + 7]);
                const bf16x8 pf = __builtin_bit_cast(bf16x8, pw);
#pragma unroll
                for (int et = 0; et < 4; ++et) { const u32x4 aw = *(const LAS u32x4*)(Vb + (et * 32 + r) * ATT_VP + (kb * 2 + s2) * 32 + h * 16);
                    o[et] = __builtin_amdgcn_mfma_f32_32x32x16_bf16(__builtin_bit_cast(bf16x8, aw), pf, o[et], 0, 0, 0); } }
        if (more) { const int nb = cur ^ 1;
            *(LAS u32x4*)(lds + nb * ATT_KB + kl) = pk0; *(LAS u32x4*)(lds + nb * ATT_KB + kl + 32 * ATT_KP) = pk1;
            att_vput(lds + nb * ATT_VB + vl, pv0); att_vput(lds + nb * ATT_VB + vl + 64 * ATT_VP, pv1); }
        __syncthreads();
    }
    lsum = half_swap_sum(lsum);
    const float inv = 1.0f / lsum;
    if (NC == 1) {
        bf16_t* orow = Op + (size_t)(qb * 32 + r) * ldo;
#pragma unroll
        for (int et = 0; et < 4; ++et)
#pragma unroll
            for (int g = 0; g < 4; ++g) { u32x2 w; w.x = pk2(o[et][4 * g] * inv, o[et][4 * g + 1] * inv); w.y = pk2(o[et][4 * g + 2] * inv, o[et][4 * g + 3] * inv);
                *(u32x2*)(orow + et * 32 + 8 * g + 4 * h) = w; }
    } else {
        LAS float* XL = (LAS float*)lds;
        if (comp == 1) {
#pragma unroll
            for (int et = 0; et < 4; ++et)
#pragma unroll
                for (int i = 0; i < 16; ++i) XL[(qb * 64 + et * 16 + i) * 64 + lane] = o[et][i] * inv;
        }
        __syncthreads();
        if (comp == 0) {
            float ss = 0.f;
#pragma unroll
            for (int et = 0; et < 4; ++et)
#pragma unroll
                for (int i = 0; i < 16; ++i) { const float ov = o[et][i] * inv - lam * XL[(qb * 64 + et * 16 + i) * 64 + lane]; o[et][i] = ov; ss += ov * ov; }
            ss = half_swap_sum(ss);
            const float rs = rsqrtf(ss * (1.0f / 128.0f) + RMS_EPS) * 0.8f;
            bf16_t* orow = Op + (size_t)(qb * 32 + r) * ldo;
#pragma unroll
            for (int et = 0; et < 4; ++et)
#pragma unroll
                for (int g = 0; g < 4; ++g) { const int e = et * 32 + 8 * g + 4 * h; const f32x4 gv = *(const f32x4*)(subg + e);
                    u32x2 w; w.x = pk2(o[et][4 * g] * rs * gv[0], o[et][4 * g + 1] * rs * gv[1]); w.y = pk2(o[et][4 * g + 2] * rs * gv[2], o[et][4 * g + 3] * rs * gv[3]);
                    *(u32x2*)(orow + e) = w; }
        }
        __syncthreads();
    }
}

template <bool TO_BF16> __device__ __forceinline__ void ln_rows(float* io, bf16_t* ob, float2* stat, const float* g, const float* b, int tid, float* alt = nullptr) {
    const int lane = tid & 63, gw = blockIdx.x * NWAVE + (tid >> 6), ngw = gridDim.x * NWAVE;
    f32x4 gv[4], bv[4];
#pragma unroll
    for (int j = 0; j < 4; ++j) { gv[j] = ((const f32x4*)g)[lane + 64 * j]; bv[j] = ((const f32x4*)b)[lane + 64 * j]; }
    for (int row0 = gw; row0 < NT; row0 += 2 * ngw) {
        f32x4 v[2][4];
#pragma unroll
        for (int u = 0; u < 2; ++u) { const int row = row0 + u * ngw; if (row < NT) { const f32x4* xr = (const f32x4*)(io + (size_t)row * DM) + lane;
#pragma unroll
            for (int j = 0; j < 4; ++j) v[u][j] = xr[64 * j]; } }
#pragma unroll
        for (int u = 0; u < 2; ++u) { const int row = row0 + u * ngw; if (row >= NT) continue;
            float s = 0.f;
#pragma unroll
            for (int j = 0; j < 4; ++j) s += (v[u][j][0] + v[u][j][1]) + (v[u][j][2] + v[u][j][3]);
            s = wave_allsum(s, lane);
            const float mean = s * (1.0f / DM); float s2 = 0.f;
#pragma unroll
            for (int j = 0; j < 4; ++j) { v[u][j] = v[u][j] - mean; s2 += (v[u][j][0] * v[u][j][0] + v[u][j][1] * v[u][j][1]) + (v[u][j][2] * v[u][j][2] + v[u][j][3] * v[u][j][3]); }
            s2 = wave_allsum(s2, lane);
            const float rstd = rsqrtf(s2 * (1.0f / DM) + LN_EPS);
            if (TO_BF16) {
                u32x2* o8 = (u32x2*)(ob + (size_t)row * DM) + lane;
#pragma unroll
                for (int j = 0; j < 4; ++j) { const f32x4 y = v[u][j] * rstd * gv[j] + bv[j]; u32x2 w; w.x = pk2(y[0], y[1]); w.y = pk2(y[2], y[3]); o8[64 * j] = w; }
                if (lane == 0) { float2 st; st.x = mean; st.y = rstd; stat[row] = st; }
            } else {
                f32x4* wr_ = (alt ? (f32x4*)(alt + (size_t)row * DM) : (f32x4*)(io + (size_t)row * DM)) + lane;
#pragma unroll
                for (int j = 0; j < 4; ++j) wr_[64 * j] = v[u][j] * rstd * gv[j] + bv[j];
            }
        }
    }
}

__device__ __forceinline__ void convgate_half(const bf16_t* HH, bf16_t* ACT, const float* cw, const float* cb, int half, int tid) {
    constexpr int NG = DFF / 8; const int total = (NT / 2) * NG;
    for (int idx = blockIdx.x * NTHR + tid; idx < total; idx += gridDim.x * NTHR) {
        const int rl = idx / NG, cg8 = idx - rl * NG, n0 = cg8 * 8, t = rl & (SEQ - 1);
        const bf16_t* hp = HH + (size_t)rl * (2 * DFF);
        float gsum[8], usum[8];
#pragma unroll
        for (int e = 0; e < 8; ++e) { gsum[e] = cb[n0 + e]; usum[e] = cb[DFF + n0 + e]; }
#pragma unroll
        for (int j = 0; j < 3; ++j) { const int tt = t + j - 1; if (tt < 0 || tt >= SEQ) continue;
            const u32x4 gq = *(const u32x4*)(hp + (ptrdiff_t)(j - 1) * (2 * DFF) + n0), uq = *(const u32x4*)(hp + (ptrdiff_t)(j - 1) * (2 * DFF) + DFF + n0);
            const float* wg = cw + (size_t)j * (2 * DFF) + n0; const float* wu = wg + DFF;
            const f32x4 wg0 = *(const f32x4*)wg, wg1 = *(const f32x4*)(wg + 4), wu0 = *(const f32x4*)wu, wu1 = *(const f32x4*)(wu + 4);
            gsum[0] += wg0[0] * lo2f(gq.x); gsum[1] += wg0[1] * hi2f(gq.x); gsum[2] += wg0[2] * lo2f(gq.y); gsum[3] += wg0[3] * hi2f(gq.y);
            gsum[4] += wg1[0] * lo2f(gq.z); gsum[5] += wg1[1] * hi2f(gq.z); gsum[6] += wg1[2] * lo2f(gq.w); gsum[7] += wg1[3] * hi2f(gq.w);
            usum[0] += wu0[0] * lo2f(uq.x); usum[1] += wu0[1] * hi2f(uq.x); usum[2] += wu0[2] * lo2f(uq.y); usum[3] += wu0[3] * hi2f(uq.y);
            usum[4] += wu1[0] * lo2f(uq.z); usum[5] += wu1[1] * hi2f(uq.z); usum[6] += wu1[2] * lo2f(uq.w); usum[7] += wu1[3] * hi2f(uq.w); }
        float a[8];
#pragma unroll
        for (int e = 0; e < 8; ++e) a[e] = gsum[e] / (1.0f + __expf(-gsum[e])) * usum[e];
        u32x4 w; w.x = pk2(a[0], a[1]); w.y = pk2(a[2], a[3]); w.z = pk2(a[4], a[5]); w.w = pk2(a[6], a[7]);
        *(u32x4*)(ACT + (size_t)(half * (NT / 2) + rl) * DFF + n0) = w;
    }
}

#define XB_TMO      128
#define XB_XCNT(j)  (256  + 64 * (j))
#define XB_XSUB(j)  (1280 + 64 * (j))
#define XB_XGEN(j)  (2304 + 64 * (j))
#define XB_TOP      3328
#define XB_TOPGEN   3392
#define XCD_BAR_WORDS 3456
#define XB_SPIN_CAP (1u << 18)

__device__ __forceinline__ unsigned xb_ld(unsigned* p)              { return __hip_atomic_load(p, __ATOMIC_RELAXED, __HIP_MEMORY_SCOPE_AGENT); }
__device__ __forceinline__ unsigned xb_add(unsigned* p, unsigned v) { return __hip_atomic_fetch_add(p, v, __ATOMIC_RELAXED, __HIP_MEMORY_SCOPE_AGENT); }
__device__ __forceinline__ unsigned xb_xcc_id() { return (unsigned)__builtin_amdgcn_s_getreg((3 << 11) | 20) & 0xFu; }
#define XB_SPIN(cond, bar) do { unsigned _sp = 0; while (cond) { __builtin_amdgcn_s_sleep(1); \
    if ((++_sp & 255u) == 0u) { if (xb_ld(&(bar)[XB_TMO])) break; if (_sp > XB_SPIN_CAP) { atomicAdd(&(bar)[XB_TMO], 1u); break; } } } } while (0)

struct XcdBarrier {
    unsigned* bar; unsigned x;
    volatile LAS unsigned* st;
};

__device__ __forceinline__ XcdBarrier xcd_barrier_post(unsigned* bar, volatile LAS unsigned* st) {
    XcdBarrier b; b.bar = bar; b.x = xb_xcc_id(); b.st = st;
    if (threadIdx.x == 0) (void)xb_add(&bar[XB_XCNT(b.x)], 1u);
    return b;
}
__device__ __forceinline__ void xcd_barrier_complete(unsigned* bar, unsigned x, unsigned& nloc, unsigned& nx) {
    const unsigned G = gridDim.x * gridDim.y * gridDim.z;
    unsigned sum, cnt, mine, sp = 0u;
    for (;;) {
        sum = 0u; cnt = 0u; mine = 0u;
#pragma unroll
        for (unsigned j = 0; j < 16; ++j) { const unsigned c = xb_ld(&bar[XB_XCNT(j)]); sum += c; cnt += (c > 0u) ? 1u : 0u; mine = (j == x) ? c : mine; }
        if (sum == G) break;
        __builtin_amdgcn_s_sleep(1);
        if ((++sp & 255u) == 0u) { if (xb_ld(&bar[XB_TMO])) break; if (sp > XB_SPIN_CAP) { atomicAdd(&bar[XB_TMO], 1u); break; } }
    }
    nloc = mine > 0u ? mine : 1u; nx = cnt > 0u ? cnt : 1u;
}

__device__ __forceinline__ void xcd_barrier(const XcdBarrier& b) {
    asm volatile("s_waitcnt vmcnt(0)" ::: "memory");
    __syncthreads();
    if (threadIdx.x == 0) {
        unsigned* bar = b.bar;
        __builtin_amdgcn_s_waitcnt(0);
        unsigned nloc = b.st[0], nx = b.st[1];
        if (nloc == 0u) { xcd_barrier_complete(bar, b.x, nloc, nx); b.st[0] = nloc; b.st[1] = nx; }
        const unsigned old = xb_add(&bar[XB_XSUB(b.x)], 1u);
        const unsigned gen = old / nloc;
        if (old + 1u == (gen + 1u) * nloc) {
            __builtin_amdgcn_fence(__ATOMIC_RELEASE, "agent");
            asm volatile("s_waitcnt vmcnt(0)" ::: "memory");
            const unsigned og = xb_add(&bar[XB_TOP], 1u);
            const unsigned tg = og / nx;
            if (og + 1u == (tg + 1u) * nx) xb_add(&bar[XB_TOPGEN], 1u);
            else XB_SPIN(xb_ld(&bar[XB_TOPGEN]) == tg, bar);
            __builtin_amdgcn_fence(__ATOMIC_ACQUIRE, "agent");
            xb_add(&bar[XB_XGEN(b.x)], 1u);
            asm volatile("s_waitcnt vmcnt(0)" ::: "memory");
        } else {
            XB_SPIN(xb_ld(&bar[XB_XGEN(b.x)]) == gen, bar);
            __builtin_amdgcn_fence(__ATOMIC_ACQUIRE, "agent");
            asm volatile("s_waitcnt vmcnt(0)" ::: "memory");
        }
    }
    __syncthreads();
}

template <int MODE> __device__ __forceinline__ void panel_finish(LAS unsigned char* lds, float* io, bf16_t* x1b, float2* stat, const float* g, const float* b, unsigned long long* XG, unsigned* CNT, int cu, int tid) {
    const int v = PairOrder::vcu_of(cu), q = v >> 2, j = v & 3, lane = tid & 63, wave = tid >> 6;
    LAS cplx* ST = (LAS cplx*)(lds + XCH_OFF); LAS cplx* MR = (LAS cplx*)lds;
    asm volatile("s_waitcnt lgkmcnt(0)" ::: "memory"); __syncthreads();
    const int ui = tid >> 8, rowl = tid & 255;
    float m1, m2;
    { const cplx a0 = ST[tid * 4 + 0], a1 = ST[tid * 4 + 1], a2 = ST[tid * 4 + 2], a3 = ST[tid * 4 + 3];
      m1 = (a0.x + a1.x) + (a2.x + a3.x); m2 = (a0.y + a1.y) + (a2.y + a3.y);
      __hip_atomic_store(XG + (size_t)((2 * q + ui) * 4 + j) * 256 + rowl, ((unsigned long long)__float_as_uint(m2) << 32) | __float_as_uint(m1), __ATOMIC_RELAXED, __HIP_MEMORY_SCOPE_AGENT); }
    asm volatile("s_waitcnt vmcnt(0)" ::: "memory");
    __syncthreads();
    if (tid == 0) {
        (void)__hip_atomic_fetch_add(CNT + (2 * q) * 16, 1u, __ATOMIC_RELAXED, __HIP_MEMORY_SCOPE_AGENT);
        (void)__hip_atomic_fetch_add(CNT + (2 * q + 1) * 16, 1u, __ATOMIC_RELAXED, __HIP_MEMORY_SCOPE_AGENT);
        unsigned sp = 0;
        while (__hip_atomic_load(CNT + (2 * q) * 16, __ATOMIC_RELAXED, __HIP_MEMORY_SCOPE_AGENT) < 4u || __hip_atomic_load(CNT + (2 * q + 1) * 16, __ATOMIC_RELAXED, __HIP_MEMORY_SCOPE_AGENT) < 4u) {
            __builtin_amdgcn_s_sleep(1); if (++sp > (1u << 22)) break; }
        __builtin_amdgcn_fence(__ATOMIC_ACQUIRE, "agent");
        asm volatile("s_waitcnt vmcnt(0)" ::: "memory");
    }
    __syncthreads();
    { float t1 = m1, t2 = m2;
#pragma unroll
      for (int jj = 1; jj < 4; ++jj) { const unsigned long long w = __hip_atomic_load(XG + (size_t)((2 * q + ui) * 4 + ((j + jj) & 3)) * 256 + rowl, __ATOMIC_RELAXED, __HIP_MEMORY_SCOPE_AGENT);
          t1 += __uint_as_float((unsigned)w); t2 += __uint_as_float((unsigned)(w >> 32)); }
      const float mean = t1 * (1.0f / DM), var = fmaxf(t2 * (1.0f / DM) - mean * mean, 0.f), rstd = rsqrtf(var + LN_EPS);
      cplx mr; mr.x = mean; mr.y = rstd; MR[tid] = mr;
      if (MODE == 1 && j == 0) { float2 sv; sv.x = mean; sv.y = rstd; stat[(2 * q + ui) * 256 + rowl] = sv; } }
    __syncthreads();
    const int cbase = j * 256 + lane * 4;
    const f32x4 g0 = *(const f32x4*)(g + cbase), b0 = *(const f32x4*)(b + cbase);
#pragma unroll 1
    for (int it = 0; it < 8; ++it) {
        const int u2 = it >> 2, rb = (it & 3) * 8; const size_t rbase = (size_t)((2 * q + u2) * 256 + wave * 32 + rb);
        f32x4 x0[8];
#pragma unroll
        for (int i = 0; i < 8; ++i) x0[i] = *(const f32x4*)(io + (rbase + i) * DM + cbase);
        asm volatile("" ::: "memory");
#pragma unroll
        for (int i = 0; i < 8; ++i) { const cplx mr = MR[u2 * 256 + wave * 32 + rb + i];
            const f32x4 y0 = (x0[i] - mr.x) * mr.y * g0 + b0;
            if (MODE == 1) { u32x2 w0; w0.x = pk2(y0[0], y0[1]); w0.y = pk2(y0[2], y0[3]); *(u32x2*)(x1b + (rbase + i) * DM + cbase) = w0; }
            else *(f32x4*)(io + (rbase + i) * DM + cbase) = y0; }
    }
}

#ifndef PH_MASK
#define PH_MASK 0xFFFFFF
#endif
#define PH(k) ((PH_MASK >> (k)) & 1)
#ifndef G5ORDER
#define G5ORDER KbOrder
#endif
#ifndef REP_P0
#define REP_P0 1
#endif
#ifndef REP_G1
#define REP_G1 1
#endif
#ifndef REP_DIFF
#define REP_DIFF 1
#endif
#ifndef REP_HY
#define REP_HY 1
#endif
#ifndef REP_MEM
#define REP_MEM 1
#endif
#ifndef REP_G3
#define REP_G3 1
#endif
#ifndef REP_G4
#define REP_G4 1
#endif
#ifndef REP_LN1
#define REP_LN1 1
#endif
struct Args { const float* in[24]; float* out; unsigned char* ws; };
__global__ void __launch_bounds__(NTHR, 2) hybrid_fwd(Args a) {
    extern __shared__ __attribute__((aligned(16))) unsigned char smem[];
    LAS unsigned char* lds = (LAS unsigned char*)smem;
    cg::grid_group grid = cg::this_grid();
    volatile LAS unsigned* bst = (volatile LAS unsigned*)(lds + LDS_BYTES - 64);
    if (threadIdx.x < 2) bst[threadIdx.x] = 0u;
    __syncthreads();
    const XcdBarrier bar = xcd_barrier_post((unsigned*)(a.ws + WS_BAR), bst);
    const int G = gridDim.x;
#define NEWPHASE() int tid_ = threadIdx.x, cu_ = blockIdx.x; asm volatile("" : "+v"(tid_)); asm volatile("" : "+s"(cu_)); const int tid = tid_, cu = cu_; (void)tid; (void)cu;
    unsigned char* ws = a.ws;
    bf16_t* WALL = (bf16_t*)(ws + WS_WALL); bf16_t* XB = (bf16_t*)(ws + WS_XB); bf16_t* MEMB = (bf16_t*)(ws + WS_MEMB); bf16_t* WKV = (bf16_t*)(ws + WS_WKV);
    bf16_t* QKM = (bf16_t*)(ws + WS_QKM); bf16_t* HT = (bf16_t*)(ws + WS_HT); bf16_t* KMEM = (bf16_t*)(ws + WS_KMEM); bf16_t* VMT = (bf16_t*)(ws + WS_VMT);
    float2* KF = (float2*)(ws + WS_KF); bf16_t* MIX = (bf16_t*)(ws + WS_MIX); float2* STAT = (float2*)(ws + WS_STAT);
    bf16_t* X1B = (bf16_t*)(ws + WS_X1B); bf16_t* HH = (bf16_t*)(ws + WS_HH); bf16_t* ACT = (bf16_t*)(ws + WS_ACT);

    for (int rep = 0; rep < REP_P0; ++rep) { NEWPHASE(); if (PH(0)) p0_prep(a.in, ws, lds, tid); }
    if (a.ws == nullptr) grid.sync();
    xcd_barrier(bar);

    for (int rep = 0; rep < REP_G1; ++rep) {
    if (PH(1)) { NEWPHASE(); pg8::Gemm g{XB, WALL, NT, 1536, DM}; pg8::StaticOrder S; S.init(g.M, g.N, G, cu);
      EpiRope E{QKM, (const float2*)(ws + WS_ROPE)};
      pg8::gemm_phase<EpiRope, pg8::StaticOrder, true, true>(lds, g, S, E); }
    if (PH(2)) { NEWPHASE(); pg8::Gemm g{WALL + (size_t)1536 * DM, XB, 2048, NT, DM}; pg8::StaticOrder S; S.init(g.M, g.N, G, cu);
      EpiB E{HT, NT};
      pg8::gemm_phase<EpiB, pg8::StaticOrder, true, true>(lds, g, S, E); }
    }
    if (PH(3)) { NEWPHASE(); const bool isK = cu < 32, on = cu < 64; const int c2 = cu - 32;
      pg8::Gemm g; EpiB E; OneUnit S;
      if (isK) { g = pg8::Gemm{MEMB, WKV, NMT, 512, DM}; E = EpiB{KMEM, 512}; S = OneUnit{cu >> 1, cu & 1, on}; }
      else { g = pg8::Gemm{WKV + (size_t)512 * DM, MEMB, 512, NMT, DM}; E = EpiB{VMT, NMT}; S = OneUnit{(c2 >> 4) & 1, c2 & 15, on}; }
      pg8::gemm_phase<EpiB, OneUnit, false, true>(lds, g, S, E);
      __syncthreads();
      if (!on) for (int it = cu - 64; it < 1024; it += G - 64) filter_fft_item((const float*)(ws + WS_HTD), KF, lds, it, tid); }
    xcd_barrier(bar);

    { NEWPHASE(); const int xcd = cu & 7, j = cu >> 3;
      float lam;
      { const float* lp = a.in[12]; const int l6 = tid & 63; float s01 = lp[l6] * lp[64 + l6], s23 = lp[128 + l6] * lp[192 + l6];
        s01 = wave_allsum(s01, l6); s23 = wave_allsum(s23, l6);
        lam = expf(s01) - expf(s23) + 0.2f; }
      if (PH(4)) for (int i = 0; i < 4 * REP_DIFF; ++i) {
          const int bh = ((i & 3) * 8 + xcd) * 2 + (j >> 4), qblk = j & 15, b = bh >> 2, hd = bh & 3;
          const size_t tok0 = (size_t)b * SEQ;
          attn_unit<2>(lds, QKM + (tok0 + qblk * 128) * MIXW + hd * 128, MIXW, QKM + tok0 * MIXW + 512 + hd * 128, MIXW,
                       HT + (size_t)(1536 + hd * 128) * NT + tok0, NT, SEQ, 0.125f * 1.4426950408889634f,
                       MIX + (tok0 + qblk * 128) * MIXW + 512 + hd * 128, MIXW, lam, a.in[13], tid); }
      if (PH(5)) for (int i = 0; i < 2 * REP_MEM; ++i) {
          const int bh = ((i & 1) * 8 + xcd) * 4 + (j >> 3), qblk = j & 7, b = bh >> 2, hd = bh & 3;
          const size_t tok0 = (size_t)b * SEQ;
          attn_unit<1>(lds, QKM + (tok0 + qblk * 256) * MIXW + 1024 + hd * 128, MIXW, KMEM + (size_t)b * MEMT * 512 + hd * 128, 512,
                       VMT + (size_t)(hd * 128) * NMT + b * MEMT, NMT, MEMT, 0.08838834764831845f * 1.4426950408889634f,
                       MIX + (tok0 + qblk * 256) * MIXW + 1024 + hd * 128, MIXW, 0.f, nullptr, tid); }
      if (PH(6)) for (int i = 0; i < 2 * REP_HY; ++i) {
          const int cgp = ((i & 1) * 8 + xcd) * 4 + (j >> 3), bp = j & 7;
          hyena_item(HT, KF, a.in[3], a.in[4], a.in[11], MIX, lds, bp, cgp, tid); } }
    xcd_barrier(bar);

#ifdef REP_SYNC
    for (int rep = 0; rep < REP_SYNC; ++rep) xcd_barrier(bar);
#endif
    const bool pair = (G == 256);
    if (pair) {
        if (PH(7)) { NEWPHASE(); const int v = PairOrder::vcu_of(cu);
            pg8::Gemm g{MIX, (const bf16_t*)(ws + WS_WOUT), NT, DM, MIXW}; QuadTwo S{v >> 2, v & 3};
            EpiLn<1> E{a.in[0], a.out, X1B, a.in[16], a.in[17], (unsigned long long*)(ws + WS_XG), (unsigned*)(ws + WS_CNT), lds};
            pg8::gemm_phase<EpiLn<1>, QuadTwo, true, true>(lds, g, S, E); }
        xcd_barrier(bar);
    } else {
        { NEWPHASE(); pg8::Gemm g{MIX, (const bf16_t*)(ws + WS_WOUT), NT, DM, MIXW}; pg8::StaticOrder S; S.init(g.M, g.N, G, cu);
          EpiRes E{a.in[0], a.out, lds, 0};
          pg8::gemm_phase<EpiRes, pg8::StaticOrder, true, true>(lds, g, S, E); }
        xcd_barrier(bar);
        { NEWPHASE(); ln_rows<true>(a.out, X1B, STAT, a.in[16], a.in[17], tid); }
        xcd_barrier(bar);
    }
    for (int rep = 0; rep < REP_G4; ++rep) if (PH(9)) { NEWPHASE(); pg8::Gemm g{X1B, (const bf16_t*)(ws + WS_WUP), FFN_MT * 256, 2 * DFF, DM}; FfnOrder S; S.init(g.M, g.N, G, cu); S.cw = a.in[19]; S.cb = a.in[20]; S.lds = lds; S.cnt = 0;
      EpiFfn E{ACT, lds, 0};
      pg8::gemm_phase<EpiFfn, FfnOrder, true, true>(lds, g, S, E); }
    xcd_barrier(bar);
    if (pair) {
        if (PH(11)) { NEWPHASE(); const int v = PairOrder::vcu_of(cu);
            pg8::Gemm g{ACT, (const bf16_t*)(ws + WS_WDN), NT, DM, DFF}; QuadTwoKb S; S.q = v >> 2; S.j = v & 3;
            EpiLn<2> E{a.out, a.out, nullptr, a.in[22], a.in[23], (unsigned long long*)(ws + WS_XG) + 128 * 4 * 256, (unsigned*)(ws + WS_CNT) + 128 * 16, lds};
            pg8::gemm_phase<EpiLn<2>, QuadTwoKb, true, true>(lds, g, S, E); }
    } else {
        { NEWPHASE(); pg8::Gemm g{ACT, (const bf16_t*)(ws + WS_WDN), NT, DM, DFF}; KbOrder S; S.init(g.M, g.N, G, cu);
          EpiRes2 E{a.out, a.out, STAT, a.in[16], a.in[17], lds, 0};
          pg8::gemm_phase<EpiRes2, KbOrder, true, true>(lds, g, S, E); }
        xcd_barrier(bar);
        { NEWPHASE(); ln_rows<false>(a.out, nullptr, nullptr, a.in[22], a.in[23], tid); }
    }
}

extern "C" void kernel_launch(void* const* d_in, const int* in_sizes, int n_in, void* d_out, int out_size, void* d_ws, size_t ws_size, hipStream_t stream) {
    static int grid = 0;
    if (grid == 0) {
        if (n_in != 24 || out_size != NT * DM || ws_size < WS_END) { fprintf(stderr, "kernel_launch: unexpected shapes (n_in %d, out %d, ws %zu)\n", n_in, out_size, ws_size); grid = -1; return; }
        int dev = 0, cus = 0, per_cu = 0;
        hipGetDevice(&dev); hipDeviceGetAttribute(&cus, hipDeviceAttributeMultiprocessorCount, dev);
        if (hipFuncSetAttribute((const void*)hybrid_fwd, hipFuncAttributeMaxDynamicSharedMemorySize, LDS_BYTES) != hipSuccess) { fprintf(stderr, "kernel_launch: hipFuncSetAttribute failed\n"); grid = -1; return; }
        if (hipOccupancyMaxActiveBlocksPerMultiprocessor(&per_cu, (const void*)hybrid_fwd, NTHR, LDS_BYTES) != hipSuccess || per_cu < 1) { fprintf(stderr, "kernel_launch: occupancy query says %d\n", per_cu); per_cu = 1; }
        (void)hipGetLastError();
        grid = cus * per_cu;
        fprintf(stderr, "kernel_launch: grid %d (cus %d x %d)\n", grid, cus, per_cu);
    }
    if (grid < 0) return;
    if (hipMemsetAsync((char*)d_ws + WS_BAR, 0, 32768, stream) != hipSuccess) { fprintf(stderr, "kernel_launch: memset failed\n"); return; }
    Args a{};
    for (int i = 0; i < 24; ++i) a.in[i] = (const float*)d_in[i];
    a.out = (float*)d_out; a.ws = (unsigned char*)d_ws;
    void* args[] = {&a};
    const hipError_t e = hipLaunchCooperativeKernel((const void*)hybrid_fwd, dim3(grid), dim3(NTHR), args, LDS_BYTES, stream);
    if (e != hipSuccess) fprintf(stderr, "kernel_launch: cooperative launch failed: %s (grid %d)\n", hipGetErrorString(e), grid);
}
```

```cpp
#include <hip/hip_runtime.h>
#include <hip/hip_cooperative_groups.h>
#include <cstdio>
#include <cstdint>
namespace cg = cooperative_groups;
#define LAS __attribute__((address_space(3)))
namespace pg8 {
#define PG8_LAS __attribute__((address_space(3)))
typedef unsigned short bf16_t;
typedef short bf16x8 __attribute__((ext_vector_type(8)));
typedef float f32x4 __attribute__((ext_vector_type(4)));
typedef unsigned u32x4 __attribute__((ext_vector_type(4)));
constexpr int BM = 256, BK = 64, HALF = 128, HTB = HALF * BK * 2  , STAGE_BYTES = 8 * HTB, NXCD = 8, WGM = 8;

__host__ __device__ __forceinline__ int lds_byte(int r, int c) { const int st = (r >> 4) * 2 + (c >> 5), rr = r & 15, cc = c & 31, ob = rr * 64 + cc * 2; return st * 1024 + (ob ^ (((ob >> 9) & 1) << 5)); }
__host__ __device__ __forceinline__ void stage_rc(int b, int& R, int& C) { const int st = b / 1024, sb = b % 1024, swz = sb ^ (((sb >> 9) & 1) << 5); R = (st >> 1) * 16 + swz / 64; C = (st & 1) * 32 + (swz % 64) / 2; }
__host__ __device__ __forceinline__ int perm32(int rho) { const int n = rho >> 4, i = rho & 15; return 8 * (i >> 2) + 4 * n + (i & 3); }

struct Unit { int pm, pn; };
struct Gemm { const bf16_t* A; const bf16_t* Bt; int M, N, K; };

struct StaticOrder {
    int nM, nN, nwg, G, c;
    __host__ __device__ void init(int M, int N, int G_, int c_) { nM = M / BM; nN = N / BM; nwg = nM * nN; G = G_; c = c_; }
    __host__ __device__ bool next(int i, Unit& u) const {
        const long L = (long)i * G + c; if (L >= nwg) return false;
        int wgid = (int)L; { const int q = nwg / NXCD, r = nwg % NXCD, xcd = wgid % NXCD, off = wgid / NXCD; wgid = (xcd < r ? xcd * (q + 1) : r * (q + 1) + (xcd - r) * q) + off; }
        const int nig = WGM * nN, gid = wgid / nig, fm = gid * WGM, gsz = (nM - fm) < WGM ? (nM - fm) : WGM;
        u.pm = fm + ((wgid % nig) % gsz); u.pn = (wgid % nig) / gsz; return true;
    }
    __device__ __forceinline__ void a_ready(const Unit&) const {}
    __device__ __forceinline__ void done(const Unit&) const {}
    __device__ __forceinline__ long a_off(const Unit& u, size_t tstep) const { return (long)((size_t)u.pm * tstep); }
    __device__ __forceinline__ int lda(int K) const { return K; }
    __device__ __forceinline__ size_t kstep_a() const { return (size_t)(BK * 2); }
};
template <class Epi, class Sched, bool ALIGN_EPI = false, bool SP2 = false>
__device__ __forceinline__ void gemm_phase(PG8_LAS unsigned char* lds, const Gemm g, const Sched& S, const Epi& E) {
    int tid_l = threadIdx.x; asm volatile("" : "+v"(tid_l)); const int tid = tid_l, wid = __builtin_amdgcn_readfirstlane(tid >> 6), lane = tid & 63, wr = wid >> 2, wc = wid & 3, fr = lane & 15, fq = lane >> 4;
    const int K = g.K, nt = K / BK;
    unsigned voffA[2], voffB[2];
    const int lda = S.lda(K);
#pragma unroll
    for (int i = 0; i < 2; ++i) { int R, C; stage_rc(tid * 16 + i * 8192, R, C); const int Rb = Epi::PERM ? ((R & ~31) + perm32(R & 31)) : R;
        voffA[i] = (unsigned)(R * lda + C) * 2u; voffB[i] = (unsigned)(Rb * K + C) * 2u; }
    const size_t kstep = (size_t)(BK * 2);
    const size_t hstep = (size_t)HALF * K * 2;
    const size_t tstep = 2 * hstep;
    const size_t kstepA = S.kstep_a(), hstepA = (size_t)HALF * lda * 2, tstepA = 2 * hstepA;
    const unsigned ldsw = (unsigned)wid * 1024u;
    const int aoff = lds_byte(wr * 64 + fr, fq * 8), boff = lds_byte(wc * 32 + fr, fq * 8);
#define PG8_SA(b, h) (((b) * 2 + (h)) * HTB)
#define PG8_SB(b, h) ((4 + (b) * 2 + (h)) * HTB)
#define PG8_STAGE(bufoff, gbase, voff) do { _Pragma("unroll") for (int _i = 0; _i < 2; ++_i) \
        __builtin_amdgcn_global_load_lds((const unsigned*)((const char*)(gbase) + (voff)[_i]), (PG8_LAS unsigned*)(lds + (bufoff) + ldsw + _i * 8192), 16, 0, 0); } while (0)
#define PG8_LDA(dst, b, h) do { _Pragma("unroll") for (int m = 0; m < 4; ++m) _Pragma("unroll") for (int k = 0; k < 2; ++k) dst[m][k] = *(const PG8_LAS bf16x8*)(lds + PG8_SA(b, h) + aoff + m * 2048 + k * 1024); } while (0)
#define PG8_LDB(dst, b, h) do { _Pragma("unroll") for (int n = 0; n < 2; ++n) _Pragma("unroll") for (int k = 0; k < 2; ++k) dst[n][k] = *(const PG8_LAS bf16x8*)(lds + PG8_SB(b, h) + boff + n * 2048 + k * 1024); } while (0)
#define PG8_MMA(ai, bj, At, Bt) do { __builtin_amdgcn_s_setprio(1); _Pragma("unroll") for (int m = 0; m < 4; ++m) _Pragma("unroll") for (int n = 0; n < 2; ++n) _Pragma("unroll") for (int k = 0; k < 2; ++k) \
        acc[ai][bj][m][n] = __builtin_amdgcn_mfma_f32_16x16x32_bf16(Bt[n][k], At[m][k], acc[ai][bj][m][n], 0, 0, 0); __builtin_amdgcn_s_setprio(0); } while (0)
#define PG8_WAIT_V(n) asm volatile("s_waitcnt vmcnt(" #n ")" ::: "memory")
#define PG8_WAIT_L(n) asm volatile("s_waitcnt lgkmcnt(" #n ")" ::: "memory")
#define PG8_BAR __builtin_amdgcn_s_barrier()
#define PG8_SCHED __builtin_amdgcn_sched_barrier(0)
    Unit cur, nxt; int ui = 0;
    if (!S.next(0, cur)) return;
    f32x4 acc[2][2][4][2];
#pragma unroll
    for (int a = 0; a < 2; ++a)
#pragma unroll
        for (int b = 0; b < 2; ++b)
#pragma unroll
            for (int m = 0; m < 4; ++m)
#pragma unroll
                for (int n = 0; n < 2; ++n) acc[a][b][m][n] = (f32x4){0.f, 0.f, 0.f, 0.f};
    bf16x8 At[4][2], B0[2][2], B1[2][2];
    const char* cA = (const char*)g.A + S.a_off(cur, tstepA); const char* cB = (const char*)g.Bt + (size_t)cur.pn * tstep;
    S.a_ready(cur);
    if constexpr (SP2) {
        PG8_STAGE(PG8_SB(0, 0), cB, voffB); PG8_STAGE(PG8_SB(0, 1), cB + hstep, voffB); PG8_STAGE(PG8_SA(0, 0), cA, voffA); PG8_STAGE(PG8_SA(0, 1), cA + hstepA, voffA);
        if (wr == 1) PG8_BAR;
        PG8_WAIT_V(2); PG8_BAR;
        PG8_STAGE(PG8_SB(1, 0), cB + kstep, voffB); PG8_STAGE(PG8_SA(1, 0), cA + kstepA, voffA); PG8_STAGE(PG8_SB(1, 1), cB + hstep + kstep, voffB);
        PG8_WAIT_V(6); PG8_BAR;
    } else {
        PG8_STAGE(PG8_SB(0, 0), cB, voffB); PG8_STAGE(PG8_SA(0, 0), cA, voffA); PG8_STAGE(PG8_SB(0, 1), cB + hstep, voffB); PG8_STAGE(PG8_SA(0, 1), cA + hstepA, voffA);
        if (wr == 1) PG8_BAR;
        PG8_WAIT_V(4); PG8_BAR;
        PG8_STAGE(PG8_SB(1, 0), cB + kstep, voffB); PG8_STAGE(PG8_SA(1, 0), cA + kstepA, voffA); PG8_STAGE(PG8_SB(1, 1), cB + hstep + kstep, voffB);
        PG8_WAIT_V(6); PG8_BAR;
    }
    for (;;) {
        const bool has_next = S.next(ui + 1, nxt);
        const char* nA = has_next ? (const char*)g.A + S.a_off(nxt, tstepA) : cA; const char* nB = has_next ? (const char*)g.Bt + (size_t)nxt.pn * tstep : cB;
        for (int t = 0; t < nt; t += 2) {
            const bool last = (t == nt - 2);
            const char* a1 = cA + (size_t)(t + 1) * kstepA;
            const char* a2 = last ? nA : cA + (size_t)(t + 2) * kstepA; const char* b2 = last ? nB : cB + (size_t)(t + 2) * kstep;
            const char* a3 = a2 + kstepA; const char* b3 = b2 + kstep;
            if (last && has_next) S.a_ready(nxt);
            if constexpr (SP2) {
            PG8_LDB(B0, 0, 0); PG8_LDB(B1, 0, 1); PG8_SCHED; PG8_LDA(At, 0, 0); PG8_STAGE(PG8_SA(1, 1), a1 + hstepA, voffA);
            PG8_WAIT_V(8); PG8_WAIT_L(0); PG8_BAR; PG8_MMA(0, 0, At, B0); PG8_MMA(0, 1, At, B1); PG8_BAR; PG8_SCHED;
            PG8_LDA(At, 0, 1); PG8_STAGE(PG8_SB(0, 0), b2, voffB); PG8_STAGE(PG8_SB(0, 1), b2 + hstep, voffB); PG8_STAGE(PG8_SA(0, 0), a2, voffA);
            PG8_WAIT_V(8); PG8_WAIT_L(0); PG8_BAR; PG8_MMA(1, 0, At, B0); PG8_MMA(1, 1, At, B1); PG8_BAR; PG8_SCHED;
            PG8_LDB(B0, 1, 0); PG8_LDB(B1, 1, 1); PG8_SCHED; PG8_LDA(At, 1, 0); PG8_STAGE(PG8_SA(0, 1), a2 + hstepA, voffA);
            PG8_WAIT_V(8); PG8_WAIT_L(0); PG8_BAR; PG8_MMA(0, 0, At, B0); PG8_MMA(0, 1, At, B1); PG8_BAR; PG8_SCHED;
            PG8_LDA(At, 1, 1); PG8_STAGE(PG8_SB(1, 0), b3, voffB); PG8_STAGE(PG8_SB(1, 1), b3 + hstep, voffB); PG8_STAGE(PG8_SA(1, 0), a3, voffA);
            PG8_WAIT_V(8); PG8_WAIT_L(0); PG8_BAR; PG8_MMA(1, 0, At, B0); PG8_MMA(1, 1, At, B1); PG8_BAR; PG8_SCHED;
            } else {
            PG8_LDB(B0, 0, 0); PG8_SCHED; PG8_LDA(At, 0, 0); PG8_STAGE(PG8_SA(1, 1), a1 + hstepA, voffA);
            PG8_WAIT_L(8); PG8_BAR; PG8_WAIT_L(0); PG8_MMA(0, 0, At, B0); PG8_BAR; PG8_SCHED;
            PG8_LDB(B1, 0, 1); PG8_STAGE(PG8_SB(0, 0), b2, voffB);
            PG8_BAR; PG8_WAIT_L(0); PG8_MMA(0, 1, At, B1); PG8_BAR;
            PG8_LDA(At, 0, 1); PG8_STAGE(PG8_SA(0, 0), a2, voffA);
            PG8_BAR; PG8_WAIT_L(0); PG8_MMA(1, 0, At, B0); PG8_BAR; PG8_SCHED;
            PG8_STAGE(PG8_SB(0, 1), b2 + hstep, voffB);
            PG8_WAIT_V(6); PG8_BAR; PG8_MMA(1, 1, At, B1); PG8_BAR;
            PG8_LDB(B0, 1, 0); PG8_SCHED; PG8_LDA(At, 1, 0); PG8_STAGE(PG8_SA(0, 1), a2 + hstepA, voffA);
            PG8_WAIT_L(8); PG8_BAR; PG8_WAIT_L(0); PG8_MMA(0, 0, At, B0); PG8_BAR; PG8_SCHED;
            PG8_LDB(B1, 1, 1); PG8_STAGE(PG8_SB(1, 0), b3, voffB);
            PG8_BAR; PG8_WAIT_L(0); PG8_MMA(0, 1, At, B1); PG8_BAR;
            PG8_LDA(At, 1, 1); PG8_STAGE(PG8_SA(1, 0), a3, voffA);
            PG8_BAR; PG8_WAIT_L(0); PG8_MMA(1, 0, At, B0); PG8_BAR; PG8_SCHED;
            PG8_STAGE(PG8_SB(1, 1), b3 + hstep, voffB);
            PG8_WAIT_V(6); PG8_BAR; PG8_MMA(1, 1, At, B1); PG8_BAR;
            }
        }
        if constexpr (ALIGN_EPI) { if (wr == 0) PG8_BAR; }
        if constexpr (!Epi::AFTER_DRAIN) { E(acc, cur, wr, wc, fr, fq); S.done(cur); }
        if (!has_next) break;
#pragma unroll
        for (int a = 0; a < 2; ++a)
#pragma unroll
            for (int b = 0; b < 2; ++b)
#pragma unroll
                for (int m = 0; m < 4; ++m)
#pragma unroll
                    for (int n = 0; n < 2; ++n) acc[a][b][m][n] = (f32x4){0.f, 0.f, 0.f, 0.f};
        cur = nxt; cA = nA; cB = nB; ++ui;
        if constexpr (ALIGN_EPI) { if (wr == 1) PG8_BAR; }
    }
    PG8_WAIT_V(0);
    if constexpr (!ALIGN_EPI) { if (wr == 0) PG8_BAR; }
    PG8_BAR;
    if constexpr (Epi::AFTER_DRAIN) { E.fused(acc, cur, wr, wc, fr, fq, lds, wid, lane); S.done(cur); }
#undef PG8_SA
#undef PG8_SB
#undef PG8_STAGE
#undef PG8_LDA
#undef PG8_LDB
#undef PG8_MMA
#undef PG8_WAIT_V
#undef PG8_WAIT_L
#undef PG8_BAR
#undef PG8_SCHED
}
}

using pg8::bf16_t; using pg8::bf16x8; using pg8::f32x4; using pg8::u32x4;
typedef float f32x16 __attribute__((ext_vector_type(16)));
typedef unsigned u32x2 __attribute__((ext_vector_type(2)));
typedef short bf16x4 __attribute__((ext_vector_type(4)));

constexpr int NB = 16, SEQ = 2048, DM = 1024, NT = NB * SEQ, MEMT = 256, NMT = NB * MEMT, HW = 512, INW = 3584, DFF = 2816, MIXW = 1536;
constexpr float ALPHA = 1.189207115002721f;
constexpr float LN_EPS = 1e-5f, RMS_EPS = 1e-5f;
constexpr int NTHR = 512, NWAVE = 8;
constexpr int LDS_BYTES = 155648;

constexpr size_t MiB = 1048576;
constexpr size_t WS_WALL = 0;
constexpr size_t WS_WKV  = 7 * MiB;
constexpr size_t WS_WOUT = 9 * MiB;
constexpr size_t WS_WUP  = 12 * MiB;
constexpr size_t WS_WDN  = 23 * MiB;
constexpr size_t WS_ROPE = 29 * MiB;
constexpr size_t WS_STAT = 29 * MiB + 524288;
constexpr size_t WS_XB   = 30 * MiB;
constexpr size_t WS_X1B  = 30 * MiB;
constexpr size_t WS_HTD  = 94 * MiB;
constexpr size_t WS_MEMB = 110 * MiB;
constexpr size_t WS_QKM  = 118 * MiB;
constexpr size_t WS_HT   = 214 * MiB;
constexpr size_t WS_KMEM = 342 * MiB;
constexpr size_t WS_VMT  = 346 * MiB;
constexpr size_t WS_KF   = 350 * MiB;
constexpr size_t WS_MIX  = 382 * MiB;
constexpr size_t WS_HH   = 96 * MiB;
constexpr size_t WS_ACT  = 272 * MiB;
constexpr size_t WS_BAR  = 478 * MiB;
constexpr size_t WS_CNT  = 478 * MiB + 16384;
constexpr size_t WS_XG   = 478 * MiB + 65536;
constexpr size_t WS_END  = 478 * MiB + 65536 + 2 * MiB;

__device__ __forceinline__ unsigned pk2(float lo, float hi) { unsigned r; asm volatile("v_cvt_pk_bf16_f32 %0, %1, %2" : "=v"(r) : "v"(lo), "v"(hi)); return r; }
__device__ __forceinline__ float bf2f(bf16_t v) { return __uint_as_float((unsigned)v << 16); }
__device__ __forceinline__ float lo2f(unsigned v) { return __uint_as_float(v << 16); }
__device__ __forceinline__ float hi2f(unsigned v) { return __uint_as_float(v & 0xffff0000u); }
#define LDS_WAIT() asm volatile("s_waitcnt lgkmcnt(0)" ::: "memory")
__device__ __forceinline__ float xsum16(float v) { const auto r_ = __builtin_amdgcn_permlane16_swap(__float_as_uint(v), __float_as_uint(v), false, false); return __uint_as_float(r_[0]) + __uint_as_float(r_[1]); }
__device__ __forceinline__ float xsum32(float v) { const auto r_ = __builtin_amdgcn_permlane32_swap(__float_as_uint(v), __float_as_uint(v), false, false); return __uint_as_float(r_[0]) + __uint_as_float(r_[1]); }
__device__ __forceinline__ float wave_allsum(float v, int lane) {
#pragma unroll
    for (int o = 1; o < 16; o <<= 1) v += __int_as_float(__builtin_amdgcn_ds_bpermute((lane ^ o) << 2, __float_as_int(v)));
    return xsum32(xsum16(v));
}

#ifndef FFT_HOST
#define FFT_FN __device__ __forceinline__
#define FFT_SYNC() do { asm volatile("s_waitcnt lgkmcnt(0)" ::: "memory"); __builtin_amdgcn_s_barrier(); asm volatile("" ::: "memory"); } while (0)
typedef float cplx __attribute__((ext_vector_type(2)));
typedef LAS cplx* fftbuf_t;
FFT_FN float cos2pi(float r) { return __builtin_amdgcn_cosf(r); }
FFT_FN float sin2pi(float r) { return __builtin_amdgcn_sinf(r); }
#endif
FFT_FN cplx mk2(float x, float y) { cplx r; r.x = x; r.y = y; return r; }
FFT_FN cplx cadd(cplx a, cplx b) { return mk2(a.x + b.x, a.y + b.y); }
FFT_FN cplx csub(cplx a, cplx b) { return mk2(a.x - b.x, a.y - b.y); }
FFT_FN cplx cmul(cplx a, cplx b) { return mk2(a.x * b.x - a.y * b.y, a.x * b.y + a.y * b.x); }
template <bool INV> FFT_FN cplx muli(cplx a) { return INV ? mk2(-a.y, a.x) : mk2(a.y, -a.x); }
FFT_FN int padi(int i) { return i + (i >> 3); }

template <bool INV> FFT_FN void dft8(cplx (&v)[8]) {
    const float R = 0.70710678118654752f;
    const cplx a0 = cadd(v[0], v[4]), a1 = csub(v[0], v[4]), a2 = cadd(v[2], v[6]), a3 = muli<INV>(csub(v[2], v[6]));
    const cplx a4 = cadd(v[1], v[5]), a5 = csub(v[1], v[5]), a6 = cadd(v[3], v[7]), a7 = muli<INV>(csub(v[3], v[7]));
    const cplx b0 = cadd(a0, a2), b2 = csub(a0, a2), b1 = cadd(a1, a3), b3 = csub(a1, a3);
    const cplx b4 = cadd(a4, a6), b6 = muli<INV>(csub(a4, a6));
    const cplx t5 = cadd(a5, a7), t7 = csub(a5, a7);
    cplx b5, b7;
    if (!INV) { b5 = mk2((t5.x + t5.y) * R, (t5.y - t5.x) * R); b7 = mk2((t7.y - t7.x) * R, -(t7.x + t7.y) * R); }
    else      { b5 = mk2((t5.x - t5.y) * R, (t5.x + t5.y) * R); b7 = mk2(-(t7.x + t7.y) * R, (t7.x - t7.y) * R); }
    v[0] = cadd(b0, b4); v[4] = csub(b0, b4); v[1] = cadd(b1, b5); v[5] = csub(b1, b5);
    v[2] = cadd(b2, b6); v[6] = csub(b2, b6); v[3] = cadd(b3, b7); v[7] = csub(b3, b7);
}
template <int S, bool INV> FFT_FN void twid(cplx (&v)[8], int tid) {
    if (S > 1) {
        const int j = tid % S; const float rev = (float)j * (1.0f / (8.0f * S));
        const float c = cos2pi(rev), s = sin2pi(rev);
        const cplx w1 = mk2(c, INV ? s : -s);
        const cplx w2 = cmul(w1, w1), w3 = cmul(w2, w1), w4 = cmul(w2, w2), w5 = cmul(w4, w1), w6 = cmul(w4, w2), w7 = cmul(w4, w3);
        v[1] = cmul(v[1], w1); v[2] = cmul(v[2], w2); v[3] = cmul(v[3], w3); v[4] = cmul(v[4], w4);
        v[5] = cmul(v[5], w5); v[6] = cmul(v[6], w6); v[7] = cmul(v[7], w7);
    }
}
template <int S> FFT_FN void ld8(fftbuf_t X, int tid, cplx (&v)[8]) {
    const int base = (tid / S) * 8 * S + (tid % S);
#pragma unroll
    for (int k = 0; k < 8; ++k) v[k] = X[padi(base + S * k)];
}
template <int S> FFT_FN void st8(fftbuf_t X, int tid, const cplx (&v)[8]) {
    const int base = (tid / S) * 8 * S + (tid % S);
#pragma unroll
    for (int k = 0; k < 8; ++k) X[padi(base + S * k)] = v[k];
}
#ifndef FFT_HOST
template <int S> FFT_FN void twid_fill(fftbuf_t TW, int tid) {
    constexpr int P = (S == 512) ? 0 : (S == 64) ? 1 : 2;
    const int j = tid % S; const float rev = (float)j * (1.0f / (8.0f * S));
    const cplx w1 = mk2(cos2pi(rev), -sin2pi(rev)), w2 = cmul(w1, w1), w3 = cmul(w2, w1), w4 = cmul(w2, w2), w5 = cmul(w4, w1), w6 = cmul(w4, w2), w7 = cmul(w4, w3);
    TW[(7 * P + 0) * 512 + tid] = w1; TW[(7 * P + 1) * 512 + tid] = w2; TW[(7 * P + 2) * 512 + tid] = w3; TW[(7 * P + 3) * 512 + tid] = w4;
    TW[(7 * P + 4) * 512 + tid] = w5; TW[(7 * P + 5) * 512 + tid] = w6; TW[(7 * P + 6) * 512 + tid] = w7;
}
template <int S, bool INV> FFT_FN void twidL(cplx (&v)[8], fftbuf_t TW, int tid) {
    constexpr int P = (S == 512) ? 0 : (S == 64) ? 1 : 2;
#pragma unroll
    for (int q = 1; q < 8; ++q) { cplx w = TW[(7 * P + q - 1) * 512 + tid]; if (INV) w.y = -w.y; v[q] = cmul(v[q], w); }
}
FFT_FN void fft_fwdL(fftbuf_t X, fftbuf_t TW, int tid, cplx (&v)[8]) {
    dft8<false>(v); twidL<512, false>(v, TW, tid); st8<512>(X, tid, v); FFT_SYNC();
    ld8<64>(X, tid, v); dft8<false>(v); twidL<64, false>(v, TW, tid); st8<64>(X, tid, v); FFT_SYNC();
    ld8<8>(X, tid, v); dft8<false>(v); twidL<8, false>(v, TW, tid); st8<8>(X, tid, v); FFT_SYNC();
    ld8<1>(X, tid, v); dft8<false>(v);
}
FFT_FN void fft_invL(fftbuf_t X, fftbuf_t TW, int tid, cplx (&v)[8]) {
    dft8<true>(v); st8<1>(X, tid, v); FFT_SYNC();
    ld8<8>(X, tid, v); twidL<8, true>(v, TW, tid); dft8<true>(v); st8<8>(X, tid, v); FFT_SYNC();
    ld8<64>(X, tid, v); twidL<64, true>(v, TW, tid); dft8<true>(v); st8<64>(X, tid, v); FFT_SYNC();
    ld8<512>(X, tid, v); twidL<512, true>(v, TW, tid); dft8<true>(v);
}
FFT_FN void fft_fwd(fftbuf_t X, int tid, cplx (&v)[8]) {
    dft8<false>(v); twid<512, false>(v, tid); st8<512>(X, tid, v); FFT_SYNC();
    ld8<64>(X, tid, v); dft8<false>(v); twid<64, false>(v, tid); st8<64>(X, tid, v); FFT_SYNC();
    ld8<8>(X, tid, v); dft8<false>(v); twid<8, false>(v, tid); st8<8>(X, tid, v); FFT_SYNC();
    ld8<1>(X, tid, v); dft8<false>(v);
}
FFT_FN void fft_inv(fftbuf_t X, int tid, cplx (&v)[8]) {
    dft8<true>(v); st8<1>(X, tid, v); FFT_SYNC();
    ld8<8>(X, tid, v); twid<8, true>(v, tid); dft8<true>(v); st8<8>(X, tid, v); FFT_SYNC();
    ld8<64>(X, tid, v); twid<64, true>(v, tid); dft8<true>(v); st8<64>(X, tid, v); FFT_SYNC();
    ld8<512>(X, tid, v); twid<512, true>(v, tid); dft8<true>(v);
}
#endif

struct OneUnit { int pm, pn; bool on;
    __device__ __forceinline__ bool next(int i, pg8::Unit& u) const { if (!on || i > 0) return false; u.pm = pm; u.pn = pn; return true; }
    __device__ __forceinline__ void a_ready(const pg8::Unit&) const {}
    __device__ __forceinline__ void done(const pg8::Unit&) const {}
    __device__ __forceinline__ long a_off(const pg8::Unit& u, size_t tstep) const { return (long)((size_t)u.pm * tstep); }
    __device__ __forceinline__ int lda(int K) const { return K; }
    __device__ __forceinline__ size_t kstep_a() const { return 128; } };

struct EpiB {
    static constexpr bool PERM = true, AFTER_DRAIN = false;
    bf16_t* O; int ldc;
    __device__ __forceinline__ void operator()(const f32x4 (&acc)[2][2][4][2], const pg8::Unit& u, int wr, int wc, int fr, int fq) const {
        const int row0 = u.pm * 256 + wr * 64 + fr, col0 = u.pn * 256 + wc * 32 + 8 * fq;
#pragma unroll
        for (int ai = 0; ai < 2; ++ai)
#pragma unroll
            for (int m = 0; m < 4; ++m) { bf16_t* rowp = O + (size_t)(row0 + ai * 128 + m * 16) * ldc + col0;
#pragma unroll
                for (int bj = 0; bj < 2; ++bj) { const f32x4 v0 = acc[ai][bj][m][0], v1 = acc[ai][bj][m][1];
                    u32x4 w; w.x = pk2(v0[0], v0[1]); w.y = pk2(v0[2], v0[3]); w.z = pk2(v1[0], v1[1]); w.w = pk2(v1[2], v1[3]);
                    *(u32x4*)(rowp + bj * 128) = w; } }
    }
};
struct EpiRope {
    static constexpr bool PERM = true, AFTER_DRAIN = false;
    bf16_t* O; const float2* rope;
    __device__ __forceinline__ void operator()(const f32x4 (&acc)[2][2][4][2], const pg8::Unit& u, int wr, int wc, int fr, int fq) const {
        const int row0 = u.pm * 256 + wr * 64 + fr, col0 = u.pn * 256 + wc * 32 + 8 * fq;
        const bool rot = u.pn < 4;
#pragma unroll
        for (int ai = 0; ai < 2; ++ai)
#pragma unroll
            for (int m = 0; m < 4; ++m) { const int row = row0 + ai * 128 + m * 16; bf16_t* rowp = O + (size_t)row * MIXW + col0;
#pragma unroll
                for (int bj = 0; bj < 2; ++bj) { f32x4 v0 = acc[ai][bj][m][0], v1 = acc[ai][bj][m][1];
                    if (rot) { const int pos = row & (SEQ - 1), i0 = ((col0 + bj * 128) & 63) >> 1;
                        const f32x4* rp = (const f32x4*)(rope + pos * 32 + i0); const f32x4 r0 = rp[0], r1 = rp[1];
                        f32x4 o0, o1;
                        o0[0] = v0[0] * r0[0] - v0[1] * r0[1]; o0[1] = v0[1] * r0[0] + v0[0] * r0[1];
                        o0[2] = v0[2] * r0[2] - v0[3] * r0[3]; o0[3] = v0[3] * r0[2] + v0[2] * r0[3];
                        o1[0] = v1[0] * r1[0] - v1[1] * r1[1]; o1[1] = v1[1] * r1[0] + v1[0] * r1[1];
                        o1[2] = v1[2] * r1[2] - v1[3] * r1[3]; o1[3] = v1[3] * r1[2] + v1[2] * r1[3];
                        v0 = o0; v1 = o1; }
                    u32x4 w; w.x = pk2(v0[0], v0[1]); w.y = pk2(v0[2], v0[3]); w.z = pk2(v1[0], v1[1]); w.w = pk2(v1[2], v1[3]);
                    *(u32x4*)(rowp + bj * 128) = w; } }
    }
};
constexpr int XCH_OFF = 131072 + 1024;
__device__ __forceinline__ void stat_put(LAS cplx* ST, int rowl, int wc, int fq, float s1, float s2, bool first) {
    s1 = xsum32(xsum16(s1)); s2 = xsum32(xsum16(s2));
    if (fq == 0) { LAS cplx* p = ST + rowl * 4 + wc; cplx v; v.x = s1; v.y = s2; if (!first) { const cplx o = *p; v.x += o.x; v.y += o.y; } *p = v; }
}
struct EpiRes {
    static constexpr bool PERM = false, AFTER_DRAIN = false;
    const float* X; float* O; LAS unsigned char* lds; mutable int ecnt;
    __device__ __forceinline__ void operator()(const f32x4 (&acc)[2][2][4][2], const pg8::Unit& u, int wr, int wc, int fr, int fq) const {
        const int row0 = u.pm * 256 + wr * 64 + fr, col0 = u.pn * 256 + wc * 32 + 4 * fq;
        LAS cplx* ST = (LAS cplx*)(lds + XCH_OFF) + (ecnt & 1) * 1024; const bool first = true; ++ecnt;
#pragma unroll
        for (int ai = 0; ai < 2; ++ai) {
            f32x4 xv[4][2][2];
#pragma unroll
            for (int m = 0; m < 4; ++m)
#pragma unroll
                for (int bj = 0; bj < 2; ++bj)
#pragma unroll
                    for (int n = 0; n < 2; ++n) xv[m][bj][n] = *(const f32x4*)(X + (size_t)(row0 + ai * 128 + m * 16) * DM + col0 + bj * 128 + 16 * n);
            asm volatile("" ::: "memory");
#pragma unroll
            for (int m = 0; m < 4; ++m) { float s1 = 0.f, s2 = 0.f;
#pragma unroll
                for (int bj = 0; bj < 2; ++bj)
#pragma unroll
                    for (int n = 0; n < 2; ++n) { const f32x4 o = acc[ai][bj][m][n] + xv[m][bj][n] * ALPHA;
                        *(f32x4*)(O + (size_t)(row0 + ai * 128 + m * 16) * DM + col0 + bj * 128 + 16 * n) = o;
                        s1 += (o[0] + o[1]) + (o[2] + o[3]); s2 += (o[0] * o[0] + o[1] * o[1]) + (o[2] * o[2] + o[3] * o[3]); }
                stat_put(ST, ai * 128 + wr * 64 + m * 16 + fr, wc, fq, s1, s2, first); }
        }
    }
};
struct EpiRes2 {
    static constexpr bool PERM = false, AFTER_DRAIN = false;
    const float* R; float* O; const float2* stat; const float* g; const float* b; LAS unsigned char* lds; mutable int ecnt;
    __device__ __forceinline__ void operator()(const f32x4 (&acc)[2][2][4][2], const pg8::Unit& u, int wr, int wc, int fr, int fq) const {
        const int row0 = u.pm * 256 + wr * 64 + fr, col0 = u.pn * 256 + wc * 32 + 4 * fq;
        LAS cplx* ST = (LAS cplx*)(lds + XCH_OFF) + (ecnt & 1) * 1024; const bool first = true; ++ecnt;
#pragma unroll
        for (int ai = 0; ai < 2; ++ai)
#pragma unroll
            for (int bj = 0; bj < 2; ++bj) {
                f32x4 rv[4][2], gv[2], bv[2]; float2 st[4];
#pragma unroll
                for (int m = 0; m < 4; ++m) { const int row = row0 + ai * 128 + m * 16; st[m] = stat[row];
#pragma unroll
                    for (int n = 0; n < 2; ++n) rv[m][n] = *(const f32x4*)(R + (size_t)row * DM + col0 + bj * 128 + 16 * n); }
#pragma unroll
                for (int n = 0; n < 2; ++n) { gv[n] = *(const f32x4*)(g + col0 + bj * 128 + 16 * n); bv[n] = *(const f32x4*)(b + col0 + bj * 128 + 16 * n); }
                asm volatile("" ::: "memory");
#pragma unroll
                for (int m = 0; m < 4; ++m) { float s1 = 0.f, s2 = 0.f;
#pragma unroll
                    for (int n = 0; n < 2; ++n) { const f32x4 x1 = (rv[m][n] - st[m].x) * st[m].y * gv[n] + bv[n]; const f32x4 o = acc[ai][bj][m][n] + x1 * ALPHA;
                        *(f32x4*)(O + (size_t)(row0 + ai * 128 + m * 16) * DM + col0 + bj * 128 + 16 * n) = o;
                        s1 += (o[0] + o[1]) + (o[2] + o[3]); s2 += (o[0] * o[0] + o[1] * o[1]) + (o[2] * o[2] + o[3] * o[3]); }
                    stat_put(ST, ai * 128 + wr * 64 + m * 16 + fr, wc, fq, s1, s2, first && bj == 0); }
            }
    }
};
template <int MODE> struct EpiLn {
    static constexpr bool PERM = false, AFTER_DRAIN = false;
    const float* RES; const bf16_t* RESB; float* OF; bf16_t* OB; const float* g; const float* b; unsigned long long* XG; unsigned* CNT; LAS unsigned char* ldsp;
    __device__ __forceinline__ void operator()(const f32x4 (&acc)[2][2][4][2], const pg8::Unit& u, int wr, int wc, int fr, int fq) const {
        const int t_ = threadIdx.x; fused(const_cast<f32x4 (&)[2][2][4][2]>(acc), u, wr, wc, fr, fq, ldsp, __builtin_amdgcn_readfirstlane(t_ >> 6), t_ & 63); }
    __device__ __forceinline__ void fused(f32x4 (&acc)[2][2][4][2], const pg8::Unit& u, int wr, int wc, int fr, int fq, LAS unsigned char* lds, int wid, int lane) const {
        const int tid = wid * 64 + lane, row0 = u.pm * 256 + wr * 64 + fr, col0 = u.pn * 256 + wc * 32 + 4 * fq;
        LAS cplx* ST = (LAS cplx*)(lds + XCH_OFF); LAS cplx* MR = (LAS cplx*)(lds + XCH_OFF + 8192);
#pragma unroll
        for (int ai = 0; ai < 2; ++ai) {
            float s1[4], s2[4];
#pragma unroll
            for (int m = 0; m < 4; ++m) { s1[m] = 0.f; s2[m] = 0.f; }
#pragma unroll
            for (int bj = 0; bj < 2; ++bj) {
                f32x4 xv[4][2];
                if (MODE == 1) {
#pragma unroll
                    for (int m = 0; m < 4; ++m)
#pragma unroll
                        for (int n = 0; n < 2; ++n) xv[m][n] = *(const f32x4*)(RES + (size_t)(row0 + ai * 128 + m * 16) * DM + col0 + bj * 128 + 16 * n);
                } else {
                    u32x2 xb[4][2];
#pragma unroll
                    for (int m = 0; m < 4; ++m)
#pragma unroll
                        for (int n = 0; n < 2; ++n) xb[m][n] = *(const u32x2*)(RESB + (size_t)(row0 + ai * 128 + m * 16) * DM + col0 + bj * 128 + 16 * n);
#pragma unroll
                    for (int m = 0; m < 4; ++m)
#pragma unroll
                        for (int n = 0; n < 2; ++n) { xv[m][n][0] = lo2f(xb[m][n].x); xv[m][n][1] = hi2f(xb[m][n].x); xv[m][n][2] = lo2f(xb[m][n].y); xv[m][n][3] = hi2f(xb[m][n].y); }
                }
                asm volatile("" ::: "memory");
#pragma unroll
                for (int m = 0; m < 4; ++m)
#pragma unroll
                    for (int n = 0; n < 2; ++n) { const f32x4 o = acc[ai][bj][m][n] + xv[m][n] * ALPHA; acc[ai][bj][m][n] = o;
                        s1[m] += (o[0] + o[1]) + (o[2] + o[3]); s2[m] += (o[0] * o[0] + o[1] * o[1]) + (o[2] * o[2] + o[3] * o[3]); }
            }
#pragma unroll
            for (int m = 0; m < 4; ++m) stat_put(ST, ai * 128 + wr * 64 + m * 16 + fr, wc, fq, s1[m], s2[m], true);
        }
        asm volatile("s_waitcnt lgkmcnt(0)" ::: "memory"); __syncthreads();
        float m1 = 0.f, m2 = 0.f;
        if (tid < 256) { const cplx a0 = ST[tid * 4 + 0], a1 = ST[tid * 4 + 1], a2 = ST[tid * 4 + 2], a3 = ST[tid * 4 + 3];
            m1 = (a0.x + a1.x) + (a2.x + a3.x); m2 = (a0.y + a1.y) + (a2.y + a3.y);
            __hip_atomic_store(XG + (size_t)(u.pm * 4 + u.pn) * 256 + tid, ((unsigned long long)__float_as_uint(m2) << 32) | __float_as_uint(m1), __ATOMIC_RELAXED, __HIP_MEMORY_SCOPE_AGENT); }
        asm volatile("s_waitcnt vmcnt(0)" ::: "memory");
        __syncthreads();
        if (tid == 0) {
            (void)__hip_atomic_fetch_add(CNT + u.pm * 16, 1u, __ATOMIC_RELAXED, __HIP_MEMORY_SCOPE_AGENT);
            unsigned sp = 0;
            while (__hip_atomic_load(CNT + u.pm * 16, __ATOMIC_RELAXED, __HIP_MEMORY_SCOPE_AGENT) < 4u) { __builtin_amdgcn_s_sleep(1); if (++sp > (1u << 22)) break; }
            __builtin_amdgcn_fence(__ATOMIC_ACQUIRE, "agent");
            asm volatile("s_waitcnt vmcnt(0)" ::: "memory");
        }
        __syncthreads();
        if (tid < 256) { float t1 = m1, t2 = m2;
#pragma unroll
            for (int jj = 1; jj < 4; ++jj) { const unsigned long long w = __hip_atomic_load(XG + (size_t)(u.pm * 4 + ((u.pn + jj) & 3)) * 256 + tid, __ATOMIC_RELAXED, __HIP_MEMORY_SCOPE_AGENT);
                t1 += __uint_as_float((unsigned)w); t2 += __uint_as_float((unsigned)(w >> 32)); }
            const float mean = t1 * (1.0f / DM), var = fmaxf(t2 * (1.0f / DM) - mean * mean, 0.f);
            cplx mr; mr.x = mean; mr.y = rsqrtf(var + LN_EPS); MR[tid] = mr; }
        __syncthreads();
#pragma unroll
        for (int bj = 0; bj < 2; ++bj)
#pragma unroll
            for (int n = 0; n < 2; ++n) { const int c = col0 + bj * 128 + 16 * n; const f32x4 gv = *(const f32x4*)(g + c), bv = *(const f32x4*)(b + c);
#pragma unroll
                for (int ai = 0; ai < 2; ++ai)
#pragma unroll
                    for (int m = 0; m < 4; ++m) { const int rl = ai * 128 + wr * 64 + m * 16 + fr; const cplx mr = MR[rl];
                        const f32x4 y = (acc[ai][bj][m][n] - mr.x) * mr.y * gv + bv; const size_t off = (size_t)(u.pm * 256 + rl) * DM + c;
                        if (MODE == 1) { u32x2 w; w.x = pk2(y[0], y[1]); w.y = pk2(y[2], y[3]); *(u32x2*)(OB + off) = w; }
                        else *(f32x4*)(OF + off) = y; } }
    }
};
struct QuadTwo { int q, j;
    __device__ __forceinline__ bool next(int i, pg8::Unit& u) const { if (i > 1) return false; u.pm = 2 * q + i; u.pn = j; return true; }
    __device__ __forceinline__ void a_ready(const pg8::Unit&) const {}
    __device__ __forceinline__ void done(const pg8::Unit&) const {}
    __device__ __forceinline__ long a_off(const pg8::Unit& u, size_t tstep) const { return (long)((size_t)u.pm * tstep); }
    __device__ __forceinline__ int lda(int K) const { return K; }
    __device__ __forceinline__ size_t kstep_a() const { return 128; } };
struct QuadTwoKb : QuadTwo {
    __device__ __forceinline__ int lda(int) const { return 64; }
    __device__ __forceinline__ size_t kstep_a() const { return (size_t)NT * 64 * 2; } };
struct OneUnitKb : OneUnit {
    __device__ __forceinline__ int lda(int) const { return 64; }
    __device__ __forceinline__ size_t kstep_a() const { return (size_t)NT * 64 * 2; }
};
struct PairOrder : pg8::StaticOrder {
    bool pair;
    __device__ __forceinline__ static int vcu_of(int c) { return (c & 7) * 32 + (c >> 3); }
    __device__ __forceinline__ bool next(int i, pg8::Unit& u) const {
        if (!pair) return pg8::StaticOrder::next(i, u);
        if (i > 1) return false;
        const int v = vcu_of(c); u.pm = 2 * (v >> 2) + i; u.pn = v & 3; return true; }
};
struct KbOrder : pg8::StaticOrder {
    __device__ __forceinline__ int lda(int) const { return 64; }
    __device__ __forceinline__ size_t kstep_a() const { return (size_t)NT * 64 * 2; }
};
struct PairKb : PairOrder {
    __device__ __forceinline__ int lda(int) const { return 64; }
    __device__ __forceinline__ size_t kstep_a() const { return (size_t)NT * 64 * 2; }
};
struct RevOrder : pg8::StaticOrder {
    __device__ __forceinline__ bool next(int i, pg8::Unit& u) const { const int rounds = (nwg + G - 1) / G; if (i >= rounds) return false; return pg8::StaticOrder::next(rounds - 1 - i, u); }
};
constexpr int CWL_OFF = 131072 + 1024 + 8192;
struct FfnOrder : pg8::StaticOrder {
    const float* cw; const float* cb; LAS unsigned char* lds; mutable int cnt;
    __device__ __forceinline__ long a_off(const pg8::Unit& u, size_t) const { return ((long)u.pm * 254 - 1) * (long)(DM * 2); }
    __device__ __forceinline__ void a_ready(const pg8::Unit& u) const {
        const int tid = threadIdx.x, w = __builtin_amdgcn_readfirstlane(tid >> 6), lane = tid & 63, buf = cnt & 1; ++cnt;
        const float* src = (w < 3) ? cw + (size_t)w * (2 * DFF) : (w < 6) ? cw + (size_t)(w - 3) * (2 * DFF) + DFF : (w == 6) ? cb : cb + DFF;
        src += u.pn * 128 + lane * 4;
        if (lane < 32) __builtin_amdgcn_global_load_lds((const unsigned*)src, (LAS unsigned*)(lds + CWL_OFF + buf * 4096 + w * 512), 16, 0, 0);
    }
};
constexpr int FFN_MT = 130;
__device__ __forceinline__ float dpp_ror1(float v)  { return __int_as_float(__builtin_amdgcn_update_dpp(0, __float_as_int(v), 0x121, 0xF, 0xF, false)); }
__device__ __forceinline__ float dpp_ror15(float v) { return __int_as_float(__builtin_amdgcn_update_dpp(0, __float_as_int(v), 0x12F, 0xF, 0xF, false)); }
struct EpiFfn {
    static constexpr bool PERM = true, AFTER_DRAIN = false;
    bf16_t* ACT; LAS unsigned char* lds; mutable int ecnt;
    __device__ __forceinline__ void operator()(const f32x4 (&acc)[2][2][4][2], const pg8::Unit& u, int wr, int wc, int fr, int fq) const {
        LAS float* XC = (LAS float*)(lds + XCH_OFF);
        const LAS float* WL = (const LAS float*)(lds + CWL_OFF + (ecnt & 1) * 4096); ++ecnt;
        const int colw = wc * 32 + 8 * fq;
        if (fr == 0 || fr == 15) {
            const int edge = (fr == 15) ? 1 : 0, m = (fr == 15) ? 3 : 0;
#pragma unroll
            for (int ai = 0; ai < 2; ++ai)
#pragma unroll
                for (int bj = 0; bj < 2; ++bj)
#pragma unroll
                    for (int n = 0; n < 2; ++n) { const f32x4 v = (m == 0) ? acc[ai][bj][0][n] : acc[ai][bj][3][n];
                        *(LAS f32x4*)(XC + ((ai * 2 + wr) * 2 + edge) * 256 + bj * 128 + colw + 4 * n) = v; }
        }
        asm volatile("s_waitcnt lgkmcnt(0)" ::: "memory"); __builtin_amdgcn_s_barrier(); asm volatile("" ::: "memory");
        const int slot0 = wr * 64 + fr, row_base = u.pm * 254 - 1;
#pragma unroll
        for (int bj = 0; bj < 2; ++bj) {
            const int gc = (u.pn * 256 + bj * 128 + colw) >> 1;
            const LAS float* wl = WL + ((bj * 128 + colw) >> 1);
            f32x4 wg[3], wu[3];
#pragma unroll
            for (int j = 0; j < 3; ++j) { wg[j] = *(const LAS f32x4*)(wl + j * 128); wu[j] = *(const LAS f32x4*)(wl + (3 + j) * 128); }
            const f32x4 bg = *(const LAS f32x4*)(wl + 6 * 128), bu = *(const LAS f32x4*)(wl + 7 * 128);
#pragma unroll
            for (int ai = 0; ai < 2; ++ai) {
                const int gidx = ai * 2 + wr;
                f32x4 pe[2], ne[2];
#pragma unroll
                for (int n = 0; n < 2; ++n) {
                    pe[n] = (gidx > 0) ? *(const LAS f32x4*)(XC + (((gidx - 1) * 2) + 1) * 256 + bj * 128 + colw + 4 * n) : (f32x4){0.f, 0.f, 0.f, 0.f};
                    ne[n] = (gidx < 3) ? *(const LAS f32x4*)(XC + (((gidx + 1) * 2) + 0) * 256 + bj * 128 + colw + 4 * n) : (f32x4){0.f, 0.f, 0.f, 0.f}; }
#pragma unroll
                for (int m = 0; m < 4; ++m) {
                    const int slot = ai * 128 + slot0 + m * 16, row = row_base + slot, t = row & (SEQ - 1);
                    f32x4 hv[2];
#pragma unroll
                    for (int n = 0; n < 2; ++n) {
                        const f32x4 cur = acc[ai][bj][m][n], prv = acc[ai][bj][m == 0 ? 0 : m - 1][n], nxt = acc[ai][bj][m == 3 ? 3 : m + 1][n];
                        f32x4 up, dn;
#pragma unroll
                        for (int e = 0; e < 4; ++e) { up[e] = dpp_ror1(fr == 15 ? prv[e] : cur[e]); dn[e] = dpp_ror15(fr == 0 ? nxt[e] : cur[e]); }
                        if (m == 0 && fr == 0) up = pe[n];
                        if (m == 3 && fr == 15) dn = ne[n];
                        if (t == 0) up = (f32x4){0.f, 0.f, 0.f, 0.f};
                        if (t == SEQ - 1) dn = (f32x4){0.f, 0.f, 0.f, 0.f};
                        const f32x4 w0 = n ? wu[0] : wg[0], w1 = n ? wu[1] : wg[1], w2 = n ? wu[2] : wg[2], bb = n ? bu : bg;
                        hv[n] = w0 * up + w1 * cur + w2 * dn + bb; }
                    if (slot >= 1 && slot <= 254 && row < NT) {
                        float o[4];
#pragma unroll
                        for (int e = 0; e < 4; ++e) { const float g = hv[0][e]; o[e] = g * __builtin_amdgcn_rcpf(1.0f + __expf(-g)) * hv[1][e]; }
                        u32x2 w; w.x = pk2(o[0], o[1]); w.y = pk2(o[2], o[3]);
                        *(u32x2*)(ACT + ((size_t)(gc >> 6) * NT + row) * 64 + (gc & 63)) = w; }
                }
            }
        }
    }
};

__device__ __forceinline__ int win_row(int n) {
    if (n < 1536) return 1536 + n;
    if (n < 2560) { const int q = n - 1536, blk = q >> 6, d = q & 63; return blk * 64 + 2 * (d & 31) + (d >> 5); }
    if (n < 3072) return 512 + n;
    return n - 2048;
}
template <int MODE> __device__ __forceinline__ void p0_transpose_item(const float* W, int K, int N, bf16_t* WT, LAS float* scr, int item, int lane) {
    const int nblk = N / 32, kb = item / nblk, nb = item % nblk, k0 = 64 * kb, n0 = 32 * nb;
    f32x4 q[8];
#pragma unroll
    for (int i = 0; i < 8; ++i) q[i] = *(const f32x4*)(W + (size_t)(k0 + 8 * i + (lane >> 3)) * N + n0 + 4 * (lane & 7));
#pragma unroll
    for (int i = 0; i < 8; ++i) { LAS float* d = scr + (8 * i + (lane >> 3)) * 33 + 4 * (lane & 7); d[0] = q[i][0]; d[1] = q[i][1]; d[2] = q[i][2]; d[3] = q[i][3]; }
    LDS_WAIT(); asm volatile("" ::: "memory");
    const int c = lane & 7;
#pragma unroll
    for (int j = 0; j < 4; ++j) { const int n = (lane >> 3) + 8 * j; const LAS float* s = scr + (8 * c) * 33 + n;
        u32x4 o; o.x = pk2(s[0 * 33], s[1 * 33]); o.y = pk2(s[2 * 33], s[3 * 33]); o.z = pk2(s[4 * 33], s[5 * 33]); o.w = pk2(s[6 * 33], s[7 * 33]);
        const int nn = n0 + n; const int dr = (MODE == 1) ? win_row(nn) : (MODE == 2) ? ((nn < DFF) ? ((nn >> 2) * 8 + (nn & 3)) : (((nn - DFF) >> 2) * 8 + 4 + ((nn - DFF) & 3))) : nn;
        *(u32x4*)(WT + (size_t)dr * K + k0 + 8 * c) = o; }
    LDS_WAIT(); asm volatile("" ::: "memory");
}
__device__ __forceinline__ void cvt_rows(const float* src, bf16_t* dst, size_t n8, int gw, int ngw, int lane) {
    const size_t stride = (size_t)ngw * 64;
    for (size_t i = (size_t)gw * 64 + lane; i < n8; i += 4 * stride) {
        f32x4 a[4], c[4];
#pragma unroll
        for (int u = 0; u < 4; ++u) { const size_t k = i + u * stride; if (k < n8) { a[u] = ((const f32x4*)src)[2 * k]; c[u] = ((const f32x4*)src)[2 * k + 1]; } }
#pragma unroll
        for (int u = 0; u < 4; ++u) { const size_t k = i + u * stride; if (k < n8) {
            u32x4 w; w.x = pk2(a[u][0], a[u][1]); w.y = pk2(a[u][2], a[u][3]); w.z = pk2(c[u][0], c[u][1]); w.w = pk2(c[u][2], c[u][3]);
            ((u32x4*)dst)[k] = w; } }
    }
}
__device__ __forceinline__ void p0_filter_item(const LAS float* w1, const float* b1, const float* fq, const LAS float* w2, const float* b2, const float* w3, float* HTD, int item, int lane) {
    const int t0 = 2 * (item >> 2), ih = item & 3; float h2v[2], tl[2];
    const float fql = fq[lane], b1l = b1[lane], b2l = b2[lane];
#pragma unroll
    for (int tt = 0; tt < 2; ++tt) { const int t = t0 + tt; tl[tt] = (float)t * (1.0f / 2047.0f);
        const float w = 6.283185307179586f * (float)t / 2048.0f;
        float zk = 0.f;
        if (lane == 0) zk = tl[tt];
        else if (lane <= 16) { const float fr = 1e-4f + (float)(lane - 1) * ((15.0f - 1e-4f) / 15.0f); zk = cosf(fr * w); }
        else if (lane <= 32) { const float fr = 1e-4f + (float)(lane - 17) * ((15.0f - 1e-4f) / 15.0f); zk = -sinf(fr * w); }
        float a = b1l;
#pragma unroll 11
        for (int k = 0; k < 33; ++k) a += __shfl(zk, k) * w1[k * 64 + lane];
        const float h1 = sinf(fql * a);
        float a2 = b2l;
#pragma unroll 16
        for (int k = 0; k < 64; ++k) a2 += __shfl(h1, k) * w2[k * 64 + lane];
        h2v[tt] = sinf(fql * a2); }
    const float dmin = -15.350567286626973f, dmax = -3.0701134573253946f;
    float acc0[8], acc1[8];
#pragma unroll
    for (int i = 0; i < 8; ++i) { acc0[i] = 0.f; acc1[i] = 0.f; }
#pragma unroll 8
    for (int j = 0; j < 64; ++j) { const float s0 = __shfl(h2v[0], j), s1 = __shfl(h2v[1], j); const float* wr = w3 + (size_t)j * 2048 + ih * 512 + lane;
#pragma unroll
        for (int i = 0; i < 8; ++i) { const float wv = wr[64 * i]; acc0[i] += s0 * wv; acc1[i] += s1 * wv; } }
#pragma unroll
    for (int i = 0; i < 8; ++i) { const int col = ih * 512 + 64 * i + lane, c = col & 511;
        const float delta = fabsf(dmin + (float)c * ((dmax - dmin) / 511.0f));
        float2 o; o.x = acc0[i] * expf(-tl[0] * delta); o.y = acc1[i] * expf(-tl[1] * delta);
        *(float2*)(HTD + (size_t)col * 2048 + t0) = o; }
}
__device__ __forceinline__ void p0_prep(const float* const* in, unsigned char* ws, LAS unsigned char* lds, int tid) {
    const int lane = tid & 63, wave = __builtin_amdgcn_readfirstlane(tid >> 6), gw = blockIdx.x * NWAVE + wave, ngw = gridDim.x * NWAVE;
    LAS float* scr = (LAS float*)(lds + wave * 8704);
    LAS float* W1L = (LAS float*)(lds + 69632); LAS float* W2L = W1L + 33 * 64;
    for (int i = tid; i < 33 * 64; i += NTHR) W1L[i] = in[5][i];
    for (int i = tid; i < 64 * 64; i += NTHR) W2L[i] = in[8][i];
    __syncthreads();
    bf16_t* WALL = (bf16_t*)(ws + WS_WALL);
    constexpr int I_IN = 16 * (INW / 32), I_KV = 16 * 32, I_OUT = 24 * 32, I_UP = 16 * (2 * DFF / 32), I_DN = (DFF / 64) * 32, NIT = I_IN + I_KV + I_OUT + I_UP + I_DN;
    for (int it = gw; it < NIT; it += ngw) { int r = it;
        if (r < I_IN) { p0_transpose_item<1>(in[2], DM, INW, WALL, scr, r, lane); continue; } r -= I_IN;
        if (r < I_KV) { p0_transpose_item<0>(in[14], DM, 1024, (bf16_t*)(ws + WS_WKV), scr, r, lane); continue; } r -= I_KV;
        if (r < I_OUT) { p0_transpose_item<0>(in[15], MIXW, DM, (bf16_t*)(ws + WS_WOUT), scr, r, lane); continue; } r -= I_OUT;
        if (r < I_UP) { p0_transpose_item<2>(in[18], DM, 2 * DFF, (bf16_t*)(ws + WS_WUP), scr, r, lane); continue; } r -= I_UP;
        p0_transpose_item<0>(in[21], DFF, DM, (bf16_t*)(ws + WS_WDN), scr, r, lane); }
    for (int it = ngw - 1 - gw; it < 4096; it += ngw) p0_filter_item(W1L, in[6], in[7], W2L, in[9], in[10], (float*)(ws + WS_HTD), it, lane);
    cvt_rows(in[0], (bf16_t*)(ws + WS_XB), (size_t)NT * DM / 8, gw, ngw, lane);
    cvt_rows(in[1], (bf16_t*)(ws + WS_MEMB), (size_t)NMT * DM / 8, gw, ngw, lane);
    float2* rope = (float2*)(ws + WS_ROPE);
    for (int i = blockIdx.x * NTHR + tid; i < SEQ * 32; i += gridDim.x * NTHR) { const int pos = i >> 5, f = i & 31;
        const float invf = powf(10000.0f, -(float)(2 * f) / 64.0f); const float ang = (float)pos * invf;
        float2 cs; cs.x = cosf(ang); cs.y = sinf(ang); rope[i] = cs; }
}

__device__ __forceinline__ void filter_fft_item(const float* HTD, float2* KF, LAS unsigned char* lds, int item, int tid) {
    const int o = item >> 9, c = item & 511;
    const float* rf = HTD + (size_t)((o * 2 + 0) * 512 + c) * 2048; const float* rb = HTD + (size_t)((o * 2 + 1) * 512 + c) * 2048;
    cplx v[8];
#pragma unroll
    for (int k = 0; k < 4; ++k) v[k] = mk2(rf[tid + 512 * k], 0.f);
    v[4] = mk2(tid == 0 ? 0.f : rb[2048 - tid], 0.f); v[5] = mk2(rb[1536 - tid], 0.f); v[6] = mk2(rb[1024 - tid], 0.f); v[7] = mk2(rb[512 - tid], 0.f);
    fft_fwd((LAS cplx*)lds, tid, v);
    float2* dst = KF + (size_t)(o * 512 + c) * 4096 + 8 * tid;
#pragma unroll
    for (int m = 0; m < 8; m += 2) { f32x4 w; w[0] = v[m].x * (1.f / 4096.f); w[1] = v[m].y * (1.f / 4096.f); w[2] = v[m + 1].x * (1.f / 4096.f); w[3] = v[m + 1].y * (1.f / 4096.f); *(f32x4*)(dst + m) = w; }
    __syncthreads();
}

constexpr int HY_SEG = 2064, HY_STG_OFF = 36864;
__device__ __forceinline__ float conv3s(const LAS bf16_t* seg, int n, float w0, float w1, float w2, float b) {
    return w0 * bf2f(seg[7 + n]) + w1 * bf2f(seg[8 + n]) + w2 * bf2f(seg[9 + n]) + b;
}
__device__ __forceinline__ void hyena_item(const bf16_t* HT, const float2* KF, const float* cw, const float* cb, const float* hb, bf16_t* MIX, LAS unsigned char* lds, int bp, int cgp, int tid0) {
    LAS cplx* X = (LAS cplx*)lds; LAS bf16_t* STG = (LAS bf16_t*)(lds + HY_STG_OFF); LAS cplx* TW = (LAS cplx*)(lds + 65536);
    const int ba = 2 * bp;
    twid_fill<512>(TW, tid0); twid_fill<64>(TW, tid0); twid_fill<8>(TW, tid0);
    u32x4 oacc[8];
#pragma unroll
    for (int i = 0; i < 8; ++i) oacc[i] = (u32x4){0u, 0u, 0u, 0u};
    if (tid0 < 12) { const int sg = tid0 >> 1; STG[sg * HY_SEG + ((tid0 & 1) ? 2056 : 7)] = 0; }
    { const int c = cgp * 8;
#pragma unroll
      for (int i = 0; i < 3; ++i) { const int id = tid0 + 512 * i, sg = id >> 8, ch = id & 255;
          const u32x4 q = *(const u32x4*)(HT + (size_t)((sg >> 1) * 512 + c) * NT + (ba + (sg & 1)) * SEQ + ch * 8);
          *(LAS u32x4*)(STG + sg * HY_SEG + 8 + ch * 8) = q; } }
    __syncthreads();
#pragma unroll 1
    for (int cc = 0; cc < 8; ++cc) {
        const int c = cgp * 8 + cc;
        int tl_ = tid0; asm volatile("" : "+v"(tl_)); const int tid = tl_;
        const float cwv0 = cw[c], cwv1 = cw[1536 + c], cwv2 = cw[3072 + c], cbv = cb[c], cw10 = cw[512 + c], cw11 = cw[1536 + 512 + c], cw12 = cw[3072 + 512 + c], cb1 = cb[512 + c],
                    cw20 = cw[1024 + c], cw21 = cw[1536 + 1024 + c], cw22 = cw[3072 + 1024 + c], cb2 = cb[1024 + c], hbv0 = hb[c], hbv1 = hb[512 + c];
        u32x4 nx[3];
        if (cc < 7) {
#pragma unroll
            for (int i = 0; i < 3; ++i) { const int id = tid + 512 * i, sg = id >> 8, ch = id & 255;
                nx[i] = *(const u32x4*)(HT + (size_t)((sg >> 1) * 512 + c + 1) * NT + (ba + (sg & 1)) * SEQ + ch * 8); } }
        f32x4 kf[4];
        { const f32x4* kp = (const f32x4*)(KF + (size_t)c * 4096 + 8 * tid);
#pragma unroll
          for (int m = 0; m < 4; ++m) kf[m] = kp[m]; }
        cplx v[8]; float va[4], vb[4];
        { const float w0 = cwv0, w1 = cwv1, w2 = cwv2, b = cbv;
#pragma unroll
          for (int k = 0; k < 4; ++k) { const int n = tid + 512 * k; va[k] = conv3s(STG, n, w0, w1, w2, b); vb[k] = conv3s(STG + HY_SEG, n, w0, w1, w2, b); v[k] = mk2(va[k], vb[k]); v[4 + k] = mk2(0.f, 0.f); } }
        fft_fwdL(X, TW, tid, v);
#pragma unroll
        for (int m = 0; m < 8; m += 2) { const f32x4 w = kf[m >> 1]; v[m] = cmul(v[m], mk2(w[0], w[1])); v[m + 1] = cmul(v[m + 1], mk2(w[2], w[3])); }
        { const f32x4* kp = (const f32x4*)(KF + (size_t)(512 + c) * 4096 + 8 * tid);
#pragma unroll
          for (int m = 0; m < 4; ++m) kf[m] = kp[m]; }
        fft_invL(X, TW, tid, v);
        { const float w0 = cw10, w1 = cw11, w2 = cw12, b = cb1, hb0 = hbv0;
#pragma unroll
          for (int k = 0; k < 4; ++k) { const int n = tid + 512 * k; const float xa = conv3s(STG + 2 * HY_SEG, n, w0, w1, w2, b), xb = conv3s(STG + 3 * HY_SEG, n, w0, w1, w2, b);
              va[k] = xa * (v[k].x + hb0 * va[k]); vb[k] = xb * (v[k].y + hb0 * vb[k]); v[k] = mk2(va[k], vb[k]); v[4 + k] = mk2(0.f, 0.f); } }
        fft_fwdL(X, TW, tid, v);
#pragma unroll
        for (int m = 0; m < 8; m += 2) { const f32x4 w = kf[m >> 1]; v[m] = cmul(v[m], mk2(w[0], w[1])); v[m + 1] = cmul(v[m + 1], mk2(w[2], w[3])); }
        fft_invL(X, TW, tid, v);
        { const float w0 = cw20, w1 = cw21, w2 = cw22, b = cb2, hb1 = hbv1;
#pragma unroll
          for (int k = 0; k < 4; ++k) { const int n = tid + 512 * k; const float xa = conv3s(STG + 4 * HY_SEG, n, w0, w1, w2, b), xb = conv3s(STG + 5 * HY_SEG, n, w0, w1, w2, b);
              const float oa = xa * (v[k].x + hb1 * va[k]), ob = xb * (v[k].y + hb1 * vb[k]);
              const unsigned pw = pk2(oa, ob);
#pragma unroll
              for (int hh = 0; hh < 2; ++hh) { u32x4& o = oacc[2 * k + hh]; const unsigned nw = hh ? (pw & 0xffff0000u) : (pw << 16);
                  o.x = __builtin_amdgcn_alignbit(o.y, o.x, 16); o.y = __builtin_amdgcn_alignbit(o.z, o.y, 16); o.z = __builtin_amdgcn_alignbit(o.w, o.z, 16); o.w = (o.w >> 16) | nw; } } }
        __syncthreads();
        if (cc < 7) {
#pragma unroll
            for (int i = 0; i < 3; ++i) { const int id = tid + 512 * i, sg = id >> 8, ch = id & 255; *(LAS u32x4*)(STG + sg * HY_SEG + 8 + ch * 8) = nx[i]; } }
        __syncthreads();
    }
    int tw_ = tid0; asm volatile("" : "+v"(tw_)); const int tid = tw_;
#pragma unroll
    for (int k = 0; k < 4; ++k)
#pragma unroll
        for (int hh = 0; hh < 2; ++hh) *(u32x4*)(MIX + (size_t)((ba + hh) * SEQ + tid + 512 * k) * MIXW + cgp * 8) = oacc[2 * k + hh];
}

constexpr int ATT_KP = 272, ATT_VP = 144, ATT_KB = 64 * ATT_KP, ATT_VB = 128 * ATT_VP, ATT_VOFF = 2 * ATT_KB;
__device__ __forceinline__ float half_swap_max(float v) { const auto r_ = __builtin_amdgcn_permlane32_swap(__float_as_uint(v), __float_as_uint(v), false, false); return fmaxf(__uint_as_float(r_[0]), __uint_as_float(r_[1])); }
__device__ __forceinline__ float half_swap_sum(float v) { const auto r_ = __builtin_amdgcn_permlane32_swap(__float_as_uint(v), __float_as_uint(v), false, false); return __uint_as_float(r_[0]) + __uint_as_float(r_[1]); }
__device__ __forceinline__ void att_vput(LAS unsigned char* p, u32x4 q) { u32x2 lo, hi; lo.x = q.x; lo.y = q.y; hi.x = q.z; hi.y = q.w; *(LAS u32x2*)p = lo; *(LAS u32x2*)(p + 16) = hi; }
template <int NC> __device__ __forceinline__ void attn_unit(LAS unsigned char* lds, const bf16_t* Qp, int ldq, const bf16_t* Kp, int ldk, const bf16_t* Vt, int ldv, int nkeys, float sl2,
                                                            bf16_t* Op, int ldo, float lam, const float* subg, int tid) {
    constexpr int NSTEP = (NC == 2) ? 4 : 8;
    const int lane = tid & 63, wave = tid >> 6, r = lane & 31, h = lane >> 5;
    const int qb = (NC == 2) ? (wave & 3) : wave, comp = (NC == 2) ? (wave >> 2) : 0, dbase = comp * 64;
    bf16x8 qf[NSTEP];
#pragma unroll
    for (int st = 0; st < NSTEP; ++st) qf[st] = *(const bf16x8*)(Qp + (size_t)(qb * 32 + r) * ldq + dbase + 16 * st + 8 * h);
    f32x16 o[4];
#pragma unroll
    for (int et = 0; et < 4; ++et)
#pragma unroll
        for (int i = 0; i < 16; ++i) o[et][i] = 0.f;
    float mold = -INFINITY, lsum = 0.f;
    const int kr0 = tid >> 4, kc = tid & 15, vr0 = tid >> 3, vc = tid & 7;
    const bf16_t* kg = Kp + (size_t)kr0 * ldk + kc * 8; const bf16_t* vg = Vt + (size_t)vr0 * ldv + vc * 8;
    const int kl = kr0 * ATT_KP + kc * 16, vl = ATT_VOFF + vr0 * ATT_VP + (vc >> 1) * 32 + (vc & 1) * 8;
    const int nt = nkeys / 64;
    u32x4 pk0, pk1, pv0, pv1;
    pk0 = *(const u32x4*)(kg); pk1 = *(const u32x4*)(kg + (size_t)32 * ldk); pv0 = *(const u32x4*)(vg); pv1 = *(const u32x4*)(vg + (size_t)64 * ldv);
    *(LAS u32x4*)(lds + kl) = pk0; *(LAS u32x4*)(lds + kl + 32 * ATT_KP) = pk1; att_vput(lds + vl, pv0); att_vput(lds + vl + 64 * ATT_VP, pv1);
    __syncthreads();
    for (int it = 0; it < nt; ++it) {
        const int cur = it & 1; const bool more = (it + 1 < nt);
        if (more) { const bf16_t* kg2 = kg + (size_t)(it + 1) * 64 * ldk; const bf16_t* vg2 = vg + (it + 1) * 64;
            pk0 = *(const u32x4*)(kg2); pk1 = *(const u32x4*)(kg2 + (size_t)32 * ldk); pv0 = *(const u32x4*)(vg2); pv1 = *(const u32x4*)(vg2 + (size_t)64 * ldv); }
        LAS unsigned char* Kb = lds + cur * ATT_KB; LAS unsigned char* Vb = lds + ATT_VOFF + cur * ATT_VB;
        f32x16 s[2];
#pragma unroll
        for (int kb = 0; kb < 2; ++kb) {
#pragma unroll
            for (int i = 0; i < 16; ++i) s[kb][i] = 0.f;
#pragma unroll
            for (int st = 0; st < NSTEP; ++st) { const bf16x8 a = *(const LAS bf16x8*)(Kb + (kb * 32 + r) * ATT_KP + (dbase + 16 * st + 8 * h) * 2);
                s[kb] = __builtin_amdgcn_mfma_f32_32x32x16_bf16(a, qf[st], s[kb], 0, 0, 0); } }
        float mx = s[0][0];
#pragma unroll
        for (int i = 1; i < 16; ++i) mx = fmaxf(mx, s[0][i]);
#pragma unroll
        for (int i = 0; i < 16; ++i) mx = fmaxf(mx, s[1][i]);
        mx = half_swap_max(mx);
        const float mnew = fmaxf(mold, mx * sl2), alpha = __builtin_amdgcn_exp2f(mold - mnew); mold = mnew;
        float ps = 0.f;
#pragma unroll
        for (int kb = 0; kb < 2; ++kb)
#pragma unroll
            for (int i = 0; i < 16; ++i) { const float p = __builtin_amdgcn_exp2f(__builtin_fmaf(s[kb][i], sl2, -mnew)); s[kb][i] = p; ps += p; }
        lsum = lsum * alpha + ps;
#pragma unroll
        for (int et = 0; et < 4; ++et)
#pragma unroll
            for (int i = 0; i < 16; ++i) o[et][i] *= alpha;
#pragma unroll
        for (int kb = 0; kb < 2; ++kb)
#pragma unroll
            for (int s2 = 0; s2 < 2; ++s2) {
                u32x4 pw; pw.x = pk2(s[kb][8 * s2 + 0], s[kb][8 * s2 + 1]); pw.y = pk2(s[kb][8 * s2 + 2], s[kb][8 * s2 + 3]); pw.z = pk2(s[kb][8 * s2 + 4], s[kb][8 * s2 + 5]); pw.w = pk2(s[kb][8 * s2 + 6], s[kb][8 * s2 + 7]);
                const bf16x8 pf = __builtin_bit_cast(bf16x8, pw);
#pragma unroll
                for (int et = 0; et < 4; ++et) { const u32x4 aw = *(const LAS u32x4*)(Vb + (et * 32 + r) * ATT_VP + (kb * 2 + s2) * 32 + h * 16);
                    o[et] = __builtin_amdgcn_mfma_f32_32x32x16_bf16(__builtin_bit_cast(bf16x8, aw), pf, o[et], 0, 0, 0); } }
        if (more) { const int nb = cur ^ 1;
            *(LAS u32x4*)(lds + nb * ATT_KB + kl) = pk0; *(LAS u32x4*)(lds + nb * ATT_KB + kl + 32 * ATT_KP) = pk1;
            att_vput(lds + nb * ATT_VB + vl, pv0); att_vput(lds + nb * ATT_VB + vl + 64 * ATT_VP, pv1); }
        __syncthreads();
    }
    lsum = half_swap_sum(lsum);
    const float inv = 1.0f / lsum;
    if (NC == 1) {
        bf16_t* orow = Op + (size_t)(qb * 32 + r) * ldo;
#pragma unroll
        for (int et = 0; et < 4; ++et)
#pragma unroll
            for (int g = 0; g < 4; ++g) { u32x2 w; w.x = pk2(o[et][4 * g] * inv, o[et][4 * g + 1] * inv); w.y = pk2(o[et][4 * g + 2] * inv, o[et][4 * g + 3] * inv);
                *(u32x2*)(orow + et * 32 + 8 * g + 4 * h) = w; }
    } else {
        LAS float* XL = (LAS float*)lds;
        if (comp == 1) {
#pragma unroll
            for (int et = 0; et < 4; ++et)
#pragma unroll
                for (int i = 0; i < 16; ++i) XL[(qb * 64 + et * 16 + i) * 64 + lane] = o[et][i] * inv;
        }
        __syncthreads();
        if (comp == 0) {
            float ss = 0.f;
#pragma unroll
            for (int et = 0; et < 4; ++et)
#pragma unroll
                for (int i = 0; i < 16; ++i) { const float ov = o[et][i] * inv - lam * XL[(qb * 64 + et * 16 + i) * 64 + lane]; o[et][i] = ov; ss += ov * ov; }
            ss = half_swap_sum(ss);
            const float rs = rsqrtf(ss * (1.0f / 128.0f) + RMS_EPS) * 0.8f;
            bf16_t* orow = Op + (size_t)(qb * 32 + r) * ldo;
#pragma unroll
            for (int et = 0; et < 4; ++et)
#pragma unroll
                for (int g = 0; g < 4; ++g) { const int e = et * 32 + 8 * g + 4 * h; const f32x4 gv = *(const f32x4*)(subg + e);
                    u32x2 w; w.x = pk2(o[et][4 * g] * rs * gv[0], o[et][4 * g + 1] * rs * gv[1]); w.y = pk2(o[et][4 * g + 2] * rs * gv[2], o[et][4 * g + 3] * rs * gv[3]);
                    *(u32x2*)(orow + e) = w; }
        }
        __syncthreads();
    }
}

template <bool TO_BF16> __device__ __forceinline__ void ln_rows(float* io, bf16_t* ob, float2* stat, const float* g, const float* b, int tid, float* alt = nullptr) {
    const int lane = tid & 63, gw = blockIdx.x * NWAVE + (tid >> 6), ngw = gridDim.x * NWAVE;
    f32x4 gv[4], bv[4];
#pragma unroll
    for (int j = 0; j < 4; ++j) { gv[j] = ((const f32x4*)g)[lane + 64 * j]; bv[j] = ((const f32x4*)b)[lane + 64 * j]; }
    for (int row0 = gw; row0 < NT; row0 += 2 * ngw) {
        f32x4 v[2][4];
#pragma unroll
        for (int u = 0; u < 2; ++u) { const int row = row0 + u * ngw; if (row < NT) { const f32x4* xr = (const f32x4*)(io + (size_t)row * DM) + lane;
#pragma unroll
            for (int j = 0; j < 4; ++j) v[u][j] = xr[64 * j]; } }
#pragma unroll
        for (int u = 0; u < 2; ++u) { const int row = row0 + u * ngw; if (row >= NT) continue;
            float s = 0.f;
#pragma unroll
            for (int j = 0; j < 4; ++j) s += (v[u][j][0] + v[u][j][1]) + (v[u][j][2] + v[u][j][3]);
            s = wave_allsum(s, lane);
            const float mean = s * (1.0f / DM); float s2 = 0.f;
#pragma unroll
            for (int j = 0; j < 4; ++j) { v[u][j] = v[u][j] - mean; s2 += (v[u][j][0] * v[u][j][0] + v[u][j][1] * v[u][j][1]) + (v[u][j][2] * v[u][j][2] + v[u][j][3] * v[u][j][3]); }
            s2 = wave_allsum(s2, lane);
            const float rstd = rsqrtf(s2 * (1.0f / DM) + LN_EPS);
            if (TO_BF16) {
                u32x2* o8 = (u32x2*)(ob + (size_t)row * DM) + lane;
#pragma unroll
                for (int j = 0; j < 4; ++j) { const f32x4 y = v[u][j] * rstd * gv[j] + bv[j]; u32x2 w; w.x = pk2(y[0], y[1]); w.y = pk2(y[2], y[3]); o8[64 * j] = w; }
                if (lane == 0) { float2 st; st.x = mean; st.y = rstd; stat[row] = st; }
            } else {
                f32x4* wr_ = (alt ? (f32x4*)(alt + (size_t)row * DM) : (f32x4*)(io + (size_t)row * DM)) + lane;
#pragma unroll
                for (int j = 0; j < 4; ++j) wr_[64 * j] = v[u][j] * rstd * gv[j] + bv[j];
            }
        }
    }
}

__device__ __forceinline__ void convgate_half(const bf16_t* HH, bf16_t* ACT, const float* cw, const float* cb, int half, int tid) {
    constexpr int NG = DFF / 8; const int total = (NT / 2) * NG;
    for (int idx = blockIdx.x * NTHR + tid; idx < total; idx += gridDim.x * NTHR) {
        const int rl = idx / NG, cg8 = idx - rl * NG, n0 = cg8 * 8, t = rl & (SEQ - 1);
        const bf16_t* hp = HH + (size_t)rl * (2 * DFF);
        float gsum[8], usum[8];
#pragma unroll
        for (int e = 0; e < 8; ++e) { gsum[e] = cb[n0 + e]; usum[e] = cb[DFF + n0 + e]; }
#pragma unroll
        for (int j = 0; j < 3; ++j) { const int tt = t + j - 1; if (tt < 0 || tt >= SEQ) continue;
            const u32x4 gq = *(const u32x4*)(hp + (ptrdiff_t)(j - 1) * (2 * DFF) + n0), uq = *(const u32x4*)(hp + (ptrdiff_t)(j - 1) * (2 * DFF) + DFF + n0);
            const float* wg = cw + (size_t)j * (2 * DFF) + n0; const float* wu = wg + DFF;
            const f32x4 wg0 = *(const f32x4*)wg, wg1 = *(const f32x4*)(wg + 4), wu0 = *(const f32x4*)wu, wu1 = *(const f32x4*)(wu + 4);
            gsum[0] += wg0[0] * lo2f(gq.x); gsum[1] += wg0[1] * hi2f(gq.x); gsum[2] += wg0[2] * lo2f(gq.y); gsum[3] += wg0[3] * hi2f(gq.y);
            gsum[4] += wg1[0] * lo2f(gq.z); gsum[5] += wg1[1] * hi2f(gq.z); gsum[6] += wg1[2] * lo2f(gq.w); gsum[7] += wg1[3] * hi2f(gq.w);
            usum[0] += wu0[0] * lo2f(uq.x); usum[1] += wu0[1] * hi2f(uq.x); usum[2] += wu0[2] * lo2f(uq.y); usum[3] += wu0[3] * hi2f(uq.y);
            usum[4] += wu1[0] * lo2f(uq.z); usum[5] += wu1[1] * hi2f(uq.z); usum[6] += wu1[2] * lo2f(uq.w); usum[7] += wu1[3] * hi2f(uq.w); }
        float a[8];
#pragma unroll
        for (int e = 0; e < 8; ++e) a[e] = gsum[e] / (1.0f + __expf(-gsum[e])) * usum[e];
        u32x4 w; w.x = pk2(a[0], a[1]); w.y = pk2(a[2], a[3]); w.z = pk2(a[4], a[5]); w.w = pk2(a[6], a[7]);
        *(u32x4*)(ACT + (size_t)(half * (NT / 2) + rl) * DFF + n0) = w;
    }
}

#define XB_TMO      128
#define XB_XCNT(j)  (256  + 64 * (j))
#define XB_XSUB(j)  (1280 + 64 * (j))
#define XB_XGEN(j)  (2304 + 64 * (j))
#define XB_TOP      3328
#define XB_TOPGEN   3392
#define XCD_BAR_WORDS 3456
#define XB_SPIN_CAP (1u << 18)

__device__ __forceinline__ unsigned xb_ld(unsigned* p)              { return __hip_atomic_load(p, __ATOMIC_RELAXED, __HIP_MEMORY_SCOPE_AGENT); }
__device__ __forceinline__ unsigned xb_add(unsigned* p, unsigned v) { return __hip_atomic_fetch_add(p, v, __ATOMIC_RELAXED, __HIP_MEMORY_SCOPE_AGENT); }
__device__ __forceinline__ unsigned xb_xcc_id() { return (unsigned)__builtin_amdgcn_s_getreg((3 << 11) | 20) & 0xFu; }
#define XB_SPIN(cond, bar) do { unsigned _sp = 0; while (cond) { __builtin_amdgcn_s_sleep(1); \
    if ((++_sp & 255u) == 0u) { if (xb_ld(&(bar)[XB_TMO])) break; if (_sp > XB_SPIN_CAP) { atomicAdd(&(bar)[XB_TMO], 1u); break; } } } } while (0)

struct XcdBarrier {
    unsigned* bar; unsigned x;
    volatile LAS unsigned* st;
};

__device__ __forceinline__ XcdBarrier xcd_barrier_post(unsigned* bar, volatile LAS unsigned* st) {
    XcdBarrier b; b.bar = bar; b.x = xb_xcc_id(); b.st = st;
    if (threadIdx.x == 0) (void)xb_add(&bar[XB_XCNT(b.x)], 1u);
    return b;
}
__device__ __forceinline__ void xcd_barrier_complete(unsigned* bar, unsigned x, unsigned& nloc, unsigned& nx) {
    const unsigned G = gridDim.x * gridDim.y * gridDim.z;
    unsigned sum, cnt, mine, sp = 0u;
    for (;;) {
        sum = 0u; cnt = 0u; mine = 0u;
#pragma unroll
        for (unsigned j = 0; j < 16; ++j) { const unsigned c = xb_ld(&bar[XB_XCNT(j)]); sum += c; cnt += (c > 0u) ? 1u : 0u; mine = (j == x) ? c : mine; }
        if (sum == G) break;
        __builtin_amdgcn_s_sleep(1);
        if ((++sp & 255u) == 0u) { if (xb_ld(&bar[XB_TMO])) break; if (sp > XB_SPIN_CAP) { atomicAdd(&bar[XB_TMO], 1u); break; } }
    }
    nloc = mine > 0u ? mine : 1u; nx = cnt > 0u ? cnt : 1u;
}

__device__ __forceinline__ void xcd_barrier(const XcdBarrier& b) {
    asm volatile("s_waitcnt vmcnt(0)" ::: "memory");
    __syncthreads();
    if (threadIdx.x == 0) {
        unsigned* bar = b.bar;
        __builtin_amdgcn_s_waitcnt(0);
        unsigned nloc = b.st[0], nx = b.st[1];
        if (nloc == 0u) { xcd_barrier_complete(bar, b.x, nloc, nx); b.st[0] = nloc; b.st[1] = nx; }
        const unsigned old = xb_add(&bar[XB_XSUB(b.x)], 1u);
        const unsigned gen = old / nloc;
        if (old + 1u == (gen + 1u) * nloc) {
            __builtin_amdgcn_fence(__ATOMIC_RELEASE, "agent");
            asm volatile("s_waitcnt vmcnt(0)" ::: "memory");
            const unsigned og = xb_add(&bar[XB_TOP], 1u);
            const unsigned tg = og / nx;
            if (og + 1u == (tg + 1u) * nx) xb_add(&bar[XB_TOPGEN], 1u);
            else XB_SPIN(xb_ld(&bar[XB_TOPGEN]) == tg, bar);
            __builtin_amdgcn_fence(__ATOMIC_ACQUIRE, "agent");
            xb_add(&bar[XB_XGEN(b.x)], 1u);
            asm volatile("s_waitcnt vmcnt(0)" ::: "memory");
        } else {
            XB_SPIN(xb_ld(&bar[XB_XGEN(b.x)]) == gen, bar);
            __builtin_amdgcn_fence(__ATOMIC_ACQUIRE, "agent");
            asm volatile("s_waitcnt vmcnt(0)" ::: "memory");
        }
    }
    __syncthreads();
}

template <int MODE> __device__ __forceinline__ void panel_finish(LAS unsigned char* lds, float* io, bf16_t* x1b, float2* stat, const float* g, const float* b, unsigned long long* XG, unsigned* CNT, int cu, int tid) {
    const int v = PairOrder::vcu_of(cu), q = v >> 2, j = v & 3, lane = tid & 63, wave = tid >> 6;
    LAS cplx* ST = (LAS cplx*)(lds + XCH_OFF); LAS cplx* MR = (LAS cplx*)lds;
    asm volatile("s_waitcnt lgkmcnt(0)" ::: "memory"); __syncthreads();
    const int ui = tid >> 8, rowl = tid & 255;
    float m1, m2;
    { const cplx a0 = ST[tid * 4 + 0], a1 = ST[tid * 4 + 1], a2 = ST[tid * 4 + 2], a3 = ST[tid * 4 + 3];
      m1 = (a0.x + a1.x) + (a2.x + a3.x); m2 = (a0.y + a1.y) + (a2.y + a3.y);
      __hip_atomic_store(XG + (size_t)((2 * q + ui) * 4 + j) * 256 + rowl, ((unsigned long long)__float_as_uint(m2) << 32) | __float_as_uint(m1), __ATOMIC_RELAXED, __HIP_MEMORY_SCOPE_AGENT); }
    asm volatile("s_waitcnt vmcnt(0)" ::: "memory");
    __syncthreads();
    if (tid == 0) {
        (void)__hip_atomic_fetch_add(CNT + (2 * q) * 16, 1u, __ATOMIC_RELAXED, __HIP_MEMORY_SCOPE_AGENT);
        (void)__hip_atomic_fetch_add(CNT + (2 * q + 1) * 16, 1u, __ATOMIC_RELAXED, __HIP_MEMORY_SCOPE_AGENT);
        unsigned sp = 0;
        while (__hip_atomic_load(CNT + (2 * q) * 16, __ATOMIC_RELAXED, __HIP_MEMORY_SCOPE_AGENT) < 4u || __hip_atomic_load(CNT + (2 * q + 1) * 16, __ATOMIC_RELAXED, __HIP_MEMORY_SCOPE_AGENT) < 4u) {
            __builtin_amdgcn_s_sleep(1); if (++sp > (1u << 22)) break; }
        __builtin_amdgcn_fence(__ATOMIC_ACQUIRE, "agent");
        asm volatile("s_waitcnt vmcnt(0)" ::: "memory");
    }
    __syncthreads();
    { float t1 = m1, t2 = m2;
#pragma unroll
      for (int jj = 1; jj < 4; ++jj) { const unsigned long long w = __hip_atomic_load(XG + (size_t)((2 * q + ui) * 4 + ((j + jj) & 3)) * 256 + rowl, __ATOMIC_RELAXED, __HIP_MEMORY_SCOPE_AGENT);
          t1 += __uint_as_float((unsigned)w); t2 += __uint_as_float((unsigned)(w >> 32)); }
      const float mean = t1 * (1.0f / DM), var = fmaxf(t2 * (1.0f / DM) - mean * mean, 0.f), rstd = rsqrtf(var + LN_EPS);
      cplx mr; mr.x = mean; mr.y = rstd; MR[tid] = mr;
      if (MODE == 1 && j == 0) { float2 sv; sv.x = mean; sv.y = rstd; stat[(2 * q + ui) * 256 + rowl] = sv; } }
    __syncthreads();
    const int cbase = j * 256 + lane * 4;
    const f32x4 g0 = *(const f32x4*)(g + cbase), b0 = *(const f32x4*)(b + cbase);
#pragma unroll 1
    for (int it = 0; it < 8; ++it) {
        const int u2 = it >> 2, rb = (it & 3) * 8; const size_t rbase = (size_t)((2 * q + u2) * 256 + wave * 32 + rb);
        f32x4 x0[8];
#pragma unroll
        for (int i = 0; i < 8; ++i) x0[i] = *(const f32x4*)(io + (rbase + i) * DM + cbase);
        asm volatile("" ::: "memory");
#pragma unroll
        for (int i = 0; i < 8; ++i) { const cplx mr = MR[u2 * 256 + wave * 32 + rb + i];
            const f32x4 y0 = (x0[i] - mr.x) * mr.y * g0 + b0;
            if (MODE == 1) { u32x2 w0; w0.x = pk2(y0[0], y0[1]); w0.y = pk2(y0[2], y0[3]); *(u32x2*)(x1b + (rbase + i) * DM + cbase) = w0; }
            else *(f32x4*)(io + (rbase + i) * DM + cbase) = y0; }
    }
}

#ifndef PH_MASK
#define PH_MASK 0xFFFFFF
#endif
#define PH(k) ((PH_MASK >> (k)) & 1)
#ifndef G5ORDER
#define G5ORDER KbOrder
#endif
#ifndef REP_P0
#define REP_P0 1
#endif
#ifndef REP_G1
#define REP_G1 1
#endif
#ifndef REP_DIFF
#define REP_DIFF 1
#endif
#ifndef REP_HY
#define REP_HY 1
#endif
#ifndef REP_MEM
#define REP_MEM 1
#endif
#ifndef REP_G3
#define REP_G3 1
#endif
#ifndef REP_G4
#define REP_G4 1
#endif
#ifndef REP_LN1
#define REP_LN1 1
#endif
struct Args { const float* in[24]; float* out; unsigned char* ws; };
__global__ void __launch_bounds__(NTHR, 2) hybrid_fwd(Args a) {
    extern __shared__ __attribute__((aligned(16))) unsigned char smem[];
    LAS unsigned char* lds = (LAS unsigned char*)smem;
    cg::grid_group grid = cg::this_grid();
    volatile LAS unsigned* bst = (volatile LAS unsigned*)(lds + LDS_BYTES - 64);
    if (threadIdx.x < 2) bst[threadIdx.x] = 0u;
    __syncthreads();
    const XcdBarrier bar = xcd_barrier_post((unsigned*)(a.ws + WS_BAR), bst);
    const int G = gridDim.x;
#define NEWPHASE() int tid_ = threadIdx.x, cu_ = blockIdx.x; asm volatile("" : "+v"(tid_)); asm volatile("" : "+s"(cu_)); const int tid = tid_, cu = cu_; (void)tid; (void)cu;
    unsigned char* ws = a.ws;
    bf16_t* WALL = (bf16_t*)(ws + WS_WALL); bf16_t* XB = (bf16_t*)(ws + WS_XB); bf16_t* MEMB = (bf16_t*)(ws + WS_MEMB); bf16_t* WKV = (bf16_t*)(ws + WS_WKV);
    bf16_t* QKM = (bf16_t*)(ws + WS_QKM); bf16_t* HT = (bf16_t*)(ws + WS_HT); bf16_t* KMEM = (bf16_t*)(ws + WS_KMEM); bf16_t* VMT = (bf16_t*)(ws + WS_VMT);
    float2* KF = (float2*)(ws + WS_KF); bf16_t* MIX = (bf16_t*)(ws + WS_MIX); float2* STAT = (float2*)(ws + WS_STAT);
    bf16_t* X1B = (bf16_t*)(ws + WS_X1B); bf16_t* HH = (bf16_t*)(ws + WS_HH); bf16_t* ACT = (bf16_t*)(ws + WS_ACT);

    for (int rep = 0; rep < REP_P0; ++rep) { NEWPHASE(); if (PH(0)) p0_prep(a.in, ws, lds, tid); }
    if (a.ws == nullptr) grid.sync();
    xcd_barrier(bar);

    for (int rep = 0; rep < REP_G1; ++rep) {
    if (PH(1)) { NEWPHASE(); pg8::Gemm g{XB, WALL, NT, 1536, DM}; pg8::StaticOrder S; S.init(g.M, g.N, G, cu);
      EpiRope E{QKM, (const float2*)(ws + WS_ROPE)};
      pg8::gemm_phase<EpiRope, pg8::StaticOrder, true, true>(lds, g, S, E); }
    if (PH(2)) { NEWPHASE(); pg8::Gemm g{WALL + (size_t)1536 * DM, XB, 2048, NT, DM}; pg8::StaticOrder S; S.init(g.M, g.N, G, cu);
      EpiB E{HT, NT};
      pg8::gemm_phase<EpiB, pg8::StaticOrder, true, true>(lds, g, S, E); }
    }
    if (PH(3)) { NEWPHASE(); const bool isK = cu < 32, on = cu < 64; const int c2 = cu - 32;
      pg8::Gemm g; EpiB E; OneUnit S;
      if (isK) { g = pg8::Gemm{MEMB, WKV, NMT, 512, DM}; E = EpiB{KMEM, 512}; S = OneUnit{cu >> 1, cu & 1, on}; }
      else { g = pg8::Gemm{WKV + (size_t)512 * DM, MEMB, 512, NMT, DM}; E = EpiB{VMT, NMT}; S = OneUnit{(c2 >> 4) & 1, c2 & 15, on}; }
      pg8::gemm_phase<EpiB, OneUnit, false, true>(lds, g, S, E);
      __syncthreads();
      if (!on) for (int it = cu - 64; it < 1024; it += G - 64) filter_fft_item((const float*)(ws + WS_HTD), KF, lds, it, tid); }
    xcd_barrier(bar);

    { NEWPHASE(); const int xcd = cu & 7, j = cu >> 3;
      float lam;
      { const float* lp = a.in[12]; const int l6 = tid & 63; float s01 = lp[l6] * lp[64 + l6], s23 = lp[128 + l6] * lp[192 + l6];
        s01 = wave_allsum(s01, l6); s23 = wave_allsum(s23, l6);
        lam = expf(s01) - expf(s23) + 0.2f; }
      if (PH(4)) for (int i = 0; i < 4 * REP_DIFF; ++i) {
          const int bh = ((i & 3) * 8 + xcd) * 2 + (j >> 4), qblk = j & 15, b = bh >> 2, hd = bh & 3;
          const size_t tok0 = (size_t)b * SEQ;
          attn_unit<2>(lds, QKM + (tok0 + qblk * 128) * MIXW + hd * 128, MIXW, QKM + tok0 * MIXW + 512 + hd * 128, MIXW,
                       HT + (size_t)(1536 + hd * 128) * NT + tok0, NT, SEQ, 0.125f * 1.4426950408889634f,
                       MIX + (tok0 + qblk * 128) * MIXW + 512 + hd * 128, MIXW, lam, a.in[13], tid); }
      if (PH(5)) for (int i = 0; i < 2 * REP_MEM; ++i) {
          const int bh = ((i & 1) * 8 + xcd) * 4 + (j >> 3), qblk = j & 7, b = bh >> 2, hd = bh & 3;
          const size_t tok0 = (size_t)b * SEQ;
          attn_unit<1>(lds, QKM + (tok0 + qblk * 256) * MIXW + 1024 + hd * 128, MIXW, KMEM + (size_t)b * MEMT * 512 + hd * 128, 512,
                       VMT + (size_t)(hd * 128) * NMT + b * MEMT, NMT, MEMT, 0.08838834764831845f * 1.4426950408889634f,
                       MIX + (tok0 + qblk * 256) * MIXW + 1024 + hd * 128, MIXW, 0.f, nullptr, tid); }
      if (PH(6)) for (int i = 0; i < 2 * REP_HY; ++i) {
          const int cgp = ((i & 1) * 8 + xcd) * 4 + (j >> 3), bp = j & 7;
          hyena_item(HT, KF, a.in[3], a.in[4], a.in[11], MIX, lds, bp, cgp, tid); } }
    xcd_barrier(bar);

#ifdef REP_SYNC
    for (int rep = 0; rep < REP_SYNC; ++rep) xcd_barrier(bar);
#endif
    const bool pair = (G == 256);
    if (pair) {
        if (PH(7)) { NEWPHASE(); const int v = PairOrder::vcu_of(cu);
            pg8::Gemm g{MIX, (const bf16_t*)(ws + WS_WOUT), NT, DM, MIXW}; QuadTwo S{v >> 2, v & 3};
            EpiLn<1> E{a.in[0], nullptr, nullptr, X1B, a.in[16], a.in[17], (unsigned long long*)(ws + WS_XG), (unsigned*)(ws + WS_CNT), lds};
            pg8::gemm_phase<EpiLn<1>, QuadTwo, true, true>(lds, g, S, E); }
        xcd_barrier(bar);
    } else {
        { NEWPHASE(); pg8::Gemm g{MIX, (const bf16_t*)(ws + WS_WOUT), NT, DM, MIXW}; pg8::StaticOrder S; S.init(g.M, g.N, G, cu);
          EpiRes E{a.in[0], a.out, lds, 0};
          pg8::gemm_phase<EpiRes, pg8::StaticOrder, true, true>(lds, g, S, E); }
        xcd_barrier(bar);
        { NEWPHASE(); ln_rows<true>(a.out, X1B, STAT, a.in[16], a.in[17], tid); }
        xcd_barrier(bar);
    }
    for (int rep = 0; rep < REP_G4; ++rep) if (PH(9)) { NEWPHASE(); pg8::Gemm g{X1B, (const bf16_t*)(ws + WS_WUP), FFN_MT * 256, 2 * DFF, DM}; FfnOrder S; S.init(g.M, g.N, G, cu); S.cw = a.in[19]; S.cb = a.in[20]; S.lds = lds; S.cnt = 0;
      EpiFfn E{ACT, lds, 0};
      pg8::gemm_phase<EpiFfn, FfnOrder, true, true>(lds, g, S, E); }
    xcd_barrier(bar);
    if (pair) {
        if (PH(11)) { NEWPHASE(); const int v = PairOrder::vcu_of(cu);
            pg8::Gemm g{ACT, (const bf16_t*)(ws + WS_WDN), NT, DM, DFF}; QuadTwoKb S; S.q = v >> 2; S.j = v & 3;
            EpiLn<2> E{nullptr, X1B, a.out, nullptr, a.in[22], a.in[23], (unsigned long long*)(ws + WS_XG) + 128 * 4 * 256, (unsigned*)(ws + WS_CNT) + 128 * 16, lds};
            pg8::gemm_phase<EpiLn<2>, QuadTwoKb, true, true>(lds, g, S, E); }
    } else {
        { NEWPHASE(); pg8::Gemm g{ACT, (const bf16_t*)(ws + WS_WDN), NT, DM, DFF}; KbOrder S; S.init(g.M, g.N, G, cu);
          EpiRes2 E{a.out, a.out, STAT, a.in[16], a.in[17], lds, 0};
          pg8::gemm_phase<EpiRes2, KbOrder, true, true>(lds, g, S, E); }
        xcd_barrier(bar);
        { NEWPHASE(); ln_rows<false>(a.out, nullptr, nullptr, a.in[22], a.in[23], tid); }
    }
}

extern "C" void kernel_launch(void* const* d_in, const int* in_sizes, int n_in, void* d_out, int out_size, void* d_ws, size_t ws_size, hipStream_t stream) {
    static int grid = 0;
    if (grid == 0) {
        if (n_in != 24 || out_size != NT * DM || ws_size < WS_END) { fprintf(stderr, "kernel_launch: unexpected shapes (n_in %d, out %d, ws %zu)\n", n_in, out_size, ws_size); grid = -1; return; }
        int dev = 0, cus = 0, per_cu = 0;
        hipGetDevice(&dev); hipDeviceGetAttribute(&cus, hipDeviceAttributeMultiprocessorCount, dev);
        if (hipFuncSetAttribute((const void*)hybrid_fwd, hipFuncAttributeMaxDynamicSharedMemorySize, LDS_BYTES) != hipSuccess) { fprintf(stderr, "kernel_launch: hipFuncSetAttribute failed\n"); grid = -1; return; }
        if (hipOccupancyMaxActiveBlocksPerMultiprocessor(&per_cu, (const void*)hybrid_fwd, NTHR, LDS_BYTES) != hipSuccess || per_cu < 1) { fprintf(stderr, "kernel_launch: occupancy query says %d\n", per_cu); per_cu = 1; }
        (void)hipGetLastError();
        grid = cus * per_cu;
        fprintf(stderr, "kernel_launch: grid %d (cus %d x %d)\n", grid, cus, per_cu);
    }
    if (grid < 0) return;
    if (hipMemsetAsync((char*)d_ws + WS_BAR, 0, 32768, stream) != hipSuccess) { fprintf(stderr, "kernel_launch: memset failed\n"); return; }
    Args a{};
    for (int i = 0; i < 24; ++i) a.in[i] = (const float*)d_in[i];
    a.out = (float*)d_out; a.ws = (unsigned char*)d_ws;
    void* args[] = {&a};
    const hipError_t e = hipLaunchCooperativeKernel((const void*)hybrid_fwd, dim3(grid), dim3(NTHR), args, LDS_BYTES, stream);
    if (e != hipSuccess) fprintf(stderr, "kernel_launch: cooperative launch failed: %s (grid %d)\n", hipGetErrorString(e), grid);
}
```

```cpp
#include <hip/hip_runtime.h>
#include <hip/hip_cooperative_groups.h>
#include <cstdio>
#include <cstdint>
namespace cg = cooperative_groups;
#define LAS __attribute__((address_space(3)))
namespace pg8 {
#define PG8_LAS __attribute__((address_space(3)))
typedef unsigned short bf16_t;
typedef short bf16x8 __attribute__((ext_vector_type(8)));
typedef float f32x4 __attribute__((ext_vector_type(4)));
typedef unsigned u32x4 __attribute__((ext_vector_type(4)));
constexpr int BM = 256, BK = 64, HALF = 128, HTB = HALF * BK * 2  , STAGE_BYTES = 8 * HTB, NXCD = 8, WGM = 8;

__host__ __device__ __forceinline__ int lds_byte(int r, int c) { const int st = (r >> 4) * 2 + (c >> 5), rr = r & 15, cc = c & 31, ob = rr * 64 + cc * 2; return st * 1024 + (ob ^ (((ob >> 9) & 1) << 5)); }
__host__ __device__ __forceinline__ void stage_rc(int b, int& R, int& C) { const int st = b / 1024, sb = b % 1024, swz = sb ^ (((sb >> 9) & 1) << 5); R = (st >> 1) * 16 + swz / 64; C = (st & 1) * 32 + (swz % 64) / 2; }
__host__ __device__ __forceinline__ int perm32(int rho) { const int n = rho >> 4, i = rho & 15; return 8 * (i >> 2) + 4 * n + (i & 3); }

struct Unit { int pm, pn; };
struct Gemm { const bf16_t* A; const bf16_t* Bt; int M, N, K; };

struct StaticOrder {
    int nM, nN, nwg, G, c;
    __host__ __device__ void init(int M, int N, int G_, int c_) { nM = M / BM; nN = N / BM; nwg = nM * nN; G = G_; c = c_; }
    __host__ __device__ bool next(int i, Unit& u) const {
        const long L = (long)i * G + c; if (L >= nwg) return false;
        int wgid = (int)L; { const int q = nwg / NXCD, r = nwg % NXCD, xcd = wgid % NXCD, off = wgid / NXCD; wgid = (xcd < r ? xcd * (q + 1) : r * (q + 1) + (xcd - r) * q) + off; }
        const int nig = WGM * nN, gid = wgid / nig, fm = gid * WGM, gsz = (nM - fm) < WGM ? (nM - fm) : WGM;
        u.pm = fm + ((wgid % nig) % gsz); u.pn = (wgid % nig) / gsz; return true;
    }
    __device__ __forceinline__ void a_ready(const Unit&) const {}
    __device__ __forceinline__ void done(const Unit&) const {}
    __device__ __forceinline__ long a_off(const Unit& u, size_t tstep) const { return (long)((size_t)u.pm * tstep); }
    __device__ __forceinline__ int lda(int K) const { return K; }
    __device__ __forceinline__ size_t kstep_a() const { return (size_t)(BK * 2); }
};
template <class Epi, class Sched, bool ALIGN_EPI = false, bool SP2 = false>
__device__ __forceinline__ void gemm_phase(PG8_LAS unsigned char* lds, const Gemm g, const Sched& S, const Epi& E) {
    int tid_l = threadIdx.x; asm volatile("" : "+v"(tid_l)); const int tid = tid_l, wid = __builtin_amdgcn_readfirstlane(tid >> 6), lane = tid & 63, wr = wid >> 2, wc = wid & 3, fr = lane & 15, fq = lane >> 4;
    const int K = g.K, nt = K / BK;
    unsigned voffA[2], voffB[2];
    const int lda = S.lda(K);
#pragma unroll
    for (int i = 0; i < 2; ++i) { int R, C; stage_rc(tid * 16 + i * 8192, R, C); const int Rb = Epi::PERM ? ((R & ~31) + perm32(R & 31)) : R;
        voffA[i] = (unsigned)(R * lda + C) * 2u; voffB[i] = (unsigned)(Rb * K + C) * 2u; }
    const size_t kstep = (size_t)(BK * 2);
    const size_t hstep = (size_t)HALF * K * 2;
    const size_t tstep = 2 * hstep;
    const size_t kstepA = S.kstep_a(), hstepA = (size_t)HALF * lda * 2, tstepA = 2 * hstepA;
    const unsigned ldsw = (unsigned)wid * 1024u;
    const int aoff = lds_byte(wr * 64 + fr, fq * 8), boff = lds_byte(wc * 32 + fr, fq * 8);
#define PG8_SA(b, h) (((b) * 2 + (h)) * HTB)
#define PG8_SB(b, h) ((4 + (b) * 2 + (h)) * HTB)
#define PG8_STAGE(bufoff, gbase, voff) do { _Pragma("unroll") for (int _i = 0; _i < 2; ++_i) \
        __builtin_amdgcn_global_load_lds((const unsigned*)((const char*)(gbase) + (voff)[_i]), (PG8_LAS unsigned*)(lds + (bufoff) + ldsw + _i * 8192), 16, 0, 0); } while (0)
#define PG8_LDA(dst, b, h) do { _Pragma("unroll") for (int m = 0; m < 4; ++m) _Pragma("unroll") for (int k = 0; k < 2; ++k) dst[m][k] = *(const PG8_LAS bf16x8*)(lds + PG8_SA(b, h) + aoff + m * 2048 + k * 1024); } while (0)
#define PG8_LDB(dst, b, h) do { _Pragma("unroll") for (int n = 0; n < 2; ++n) _Pragma("unroll") for (int k = 0; k < 2; ++k) dst[n][k] = *(const PG8_LAS bf16x8*)(lds + PG8_SB(b, h) + boff + n * 2048 + k * 1024); } while (0)
#define PG8_MMA(ai, bj, At, Bt) do { __builtin_amdgcn_s_setprio(1); _Pragma("unroll") for (int m = 0; m < 4; ++m) _Pragma("unroll") for (int n = 0; n < 2; ++n) _Pragma("unroll") for (int k = 0; k < 2; ++k) \
        acc[ai][bj][m][n] = __builtin_amdgcn_mfma_f32_16x16x32_bf16(Bt[n][k], At[m][k], acc[ai][bj][m][n], 0, 0, 0); __builtin_amdgcn_s_setprio(0); } while (0)
#define PG8_WAIT_V(n) asm volatile("s_waitcnt vmcnt(" #n ")" ::: "memory")
#define PG8_WAIT_L(n) asm volatile("s_waitcnt lgkmcnt(" #n ")" ::: "memory")
#define PG8_BAR __builtin_amdgcn_s_barrier()
#define PG8_SCHED __builtin_amdgcn_sched_barrier(0)
    Unit cur, nxt; int ui = 0;
    if (!S.next(0, cur)) return;
    f32x4 acc[2][2][4][2];
#pragma unroll
    for (int a = 0; a < 2; ++a)
#pragma unroll
        for (int b = 0; b < 2; ++b)
#pragma unroll
            for (int m = 0; m < 4; ++m)
#pragma unroll
                for (int n = 0; n < 2; ++n) acc[a][b][m][n] = (f32x4){0.f, 0.f, 0.f, 0.f};
    bf16x8 At[4][2], B0[2][2], B1[2][2];
    const char* cA = (const char*)g.A + S.a_off(cur, tstepA); const char* cB = (const char*)g.Bt + (size_t)cur.pn * tstep;
    S.a_ready(cur);
    if constexpr (SP2) {
        PG8_STAGE(PG8_SB(0, 0), cB, voffB); PG8_STAGE(PG8_SB(0, 1), cB + hstep, voffB); PG8_STAGE(PG8_SA(0, 0), cA, voffA); PG8_STAGE(PG8_SA(0, 1), cA + hstepA, voffA);
        if (wr == 1) PG8_BAR;
        PG8_WAIT_V(2); PG8_BAR;
        PG8_STAGE(PG8_SB(1, 0), cB + kstep, voffB); PG8_STAGE(PG8_SA(1, 0), cA + kstepA, voffA); PG8_STAGE(PG8_SB(1, 1), cB + hstep + kstep, voffB);
        PG8_WAIT_V(6); PG8_BAR;
    } else {
        PG8_STAGE(PG8_SB(0, 0), cB, voffB); PG8_STAGE(PG8_SA(0, 0), cA, voffA); PG8_STAGE(PG8_SB(0, 1), cB + hstep, voffB); PG8_STAGE(PG8_SA(0, 1), cA + hstepA, voffA);
        if (wr == 1) PG8_BAR;
        PG8_WAIT_V(4); PG8_BAR;
        PG8_STAGE(PG8_SB(1, 0), cB + kstep, voffB); PG8_STAGE(PG8_SA(1, 0), cA + kstepA, voffA); PG8_STAGE(PG8_SB(1, 1), cB + hstep + kstep, voffB);
        PG8_WAIT_V(6); PG8_BAR;
    }
    for (;;) {
        const bool has_next = S.next(ui + 1, nxt);
        const char* nA = has_next ? (const char*)g.A + S.a_off(nxt, tstepA) : cA; const char* nB = has_next ? (const char*)g.Bt + (size_t)nxt.pn * tstep : cB;
        for (int t = 0; t < nt; t += 2) {
            const bool last = (t == nt - 2);
            const char* a1 = cA + (size_t)(t + 1) * kstepA;
            const char* a2 = last ? nA : cA + (size_t)(t + 2) * kstepA; const char* b2 = last ? nB : cB + (size_t)(t + 2) * kstep;
            const char* a3 = a2 + kstepA; const char* b3 = b2 + kstep;
            if (last && has_next) S.a_ready(nxt);
            if constexpr (SP2) {
            PG8_LDB(B0, 0, 0); PG8_LDB(B1, 0, 1); PG8_SCHED; PG8_LDA(At, 0, 0); PG8_STAGE(PG8_SA(1, 1), a1 + hstepA, voffA);
            PG8_WAIT_V(8); PG8_WAIT_L(0); PG8_BAR; PG8_MMA(0, 0, At, B0); PG8_MMA(0, 1, At, B1); PG8_BAR; PG8_SCHED;
            PG8_LDA(At, 0, 1); PG8_STAGE(PG8_SB(0, 0), b2, voffB); PG8_STAGE(PG8_SB(0, 1), b2 + hstep, voffB); PG8_STAGE(PG8_SA(0, 0), a2, voffA);
            PG8_WAIT_V(8); PG8_WAIT_L(0); PG8_BAR; PG8_MMA(1, 0, At, B0); PG8_MMA(1, 1, At, B1); PG8_BAR; PG8_SCHED;
            PG8_LDB(B0, 1, 0); PG8_LDB(B1, 1, 1); PG8_SCHED; PG8_LDA(At, 1, 0); PG8_STAGE(PG8_SA(0, 1), a2 + hstepA, voffA);
            PG8_WAIT_V(8); PG8_WAIT_L(0); PG8_BAR; PG8_MMA(0, 0, At, B0); PG8_MMA(0, 1, At, B1); PG8_BAR; PG8_SCHED;
            PG8_LDA(At, 1, 1); PG8_STAGE(PG8_SB(1, 0), b3, voffB); PG8_STAGE(PG8_SB(1, 1), b3 + hstep, voffB); PG8_STAGE(PG8_SA(1, 0), a3, voffA);
            PG8_WAIT_V(8); PG8_WAIT_L(0); PG8_BAR; PG8_MMA(1, 0, At, B0); PG8_MMA(1, 1, At, B1); PG8_BAR; PG8_SCHED;
            } else {
            PG8_LDB(B0, 0, 0); PG8_SCHED; PG8_LDA(At, 0, 0); PG8_STAGE(PG8_SA(1, 1), a1 + hstepA, voffA);
            PG8_WAIT_L(8); PG8_BAR; PG8_WAIT_L(0); PG8_MMA(0, 0, At, B0); PG8_BAR; PG8_SCHED;
            PG8_LDB(B1, 0, 1); PG8_STAGE(PG8_SB(0, 0), b2, voffB);
            PG8_BAR; PG8_WAIT_L(0); PG8_MMA(0, 1, At, B1); PG8_BAR;
            PG8_LDA(At, 0, 1); PG8_STAGE(PG8_SA(0, 0), a2, voffA);
            PG8_BAR; PG8_WAIT_L(0); PG8_MMA(1, 0, At, B0); PG8_BAR; PG8_SCHED;
            PG8_STAGE(PG8_SB(0, 1), b2 + hstep, voffB);
            PG8_WAIT_V(6); PG8_BAR; PG8_MMA(1, 1, At, B1); PG8_BAR;
            PG8_LDB(B0, 1, 0); PG8_SCHED; PG8_LDA(At, 1, 0); PG8_STAGE(PG8_SA(0, 1), a2 + hstepA, voffA);
            PG8_WAIT_L(8); PG8_BAR; PG8_WAIT_L(0); PG8_MMA(0, 0, At, B0); PG8_BAR; PG8_SCHED;
            PG8_LDB(B1, 1, 1); PG8_STAGE(PG8_SB(1, 0), b3, voffB);
            PG8_BAR; PG8_WAIT_L(0); PG8_MMA(0, 1, At, B1); PG8_BAR;
            PG8_LDA(At, 1, 1); PG8_STAGE(PG8_SA(1, 0), a3, voffA);
            PG8_BAR; PG8_WAIT_L(0); PG8_MMA(1, 0, At, B0); PG8_BAR; PG8_SCHED;
            PG8_STAGE(PG8_SB(1, 1), b3 + hstep, voffB);
            PG8_WAIT_V(6); PG8_BAR; PG8_MMA(1, 1, At, B1); PG8_BAR;
            }
        }
        if constexpr (ALIGN_EPI) { if (wr == 0) PG8_BAR; }
        if constexpr (!Epi::AFTER_DRAIN) { E(acc, cur, wr, wc, fr, fq); S.done(cur); }
        if (!has_next) break;
#pragma unroll
        for (int a = 0; a < 2; ++a)
#pragma unroll
            for (int b = 0; b < 2; ++b)
#pragma unroll
                for (int m = 0; m < 4; ++m)
#pragma unroll
                    for (int n = 0; n < 2; ++n) acc[a][b][m][n] = (f32x4){0.f, 0.f, 0.f, 0.f};
        cur = nxt; cA = nA; cB = nB; ++ui;
        if constexpr (ALIGN_EPI) { if (wr == 1) PG8_BAR; }
    }
    PG8_WAIT_V(0);
    if constexpr (!ALIGN_EPI) { if (wr == 0) PG8_BAR; }
    PG8_BAR;
    if constexpr (Epi::AFTER_DRAIN) { E.fused(acc, cur, wr, wc, fr, fq, lds, wid, lane); S.done(cur); }
#undef PG8_SA
#undef PG8_SB
#undef PG8_STAGE
#undef PG8_LDA
#undef PG8_LDB
#undef PG8_MMA
#undef PG8_WAIT_V
#undef PG8_WAIT_L
#undef PG8_BAR
#undef PG8_SCHED
}
}

using pg8::bf16_t; using pg8::bf16x8; using pg8::f32x4; using pg8::u32x4;
typedef float f32x16 __attribute__((ext_vector_type(16)));
typedef unsigned u32x2 __attribute__((ext_vector_type(2)));
typedef short bf16x4 __attribute__((ext_vector_type(4)));

constexpr int NB = 16, SEQ = 2048, DM = 1024, NT = NB * SEQ, MEMT = 256, NMT = NB * MEMT, HW = 512, INW = 3584, DFF = 2816, MIXW = 1536;
constexpr float ALPHA = 1.189207115002721f;
constexpr float LN_EPS = 1e-5f, RMS_EPS = 1e-5f;
constexpr int NTHR = 512, NWAVE = 8;
constexpr int LDS_BYTES = 155648;

constexpr size_t MiB = 1048576;
constexpr size_t WS_WALL = 0;
constexpr size_t WS_WKV  = 7 * MiB;
constexpr size_t WS_WOUT = 9 * MiB;
constexpr size_t WS_WUP  = 12 * MiB;
constexpr size_t WS_WDN  = 23 * MiB;
constexpr size_t WS_ROPE = 29 * MiB;
constexpr size_t WS_STAT = 29 * MiB + 524288;
constexpr size_t WS_XB   = 30 * MiB;
constexpr size_t WS_X1B  = 30 * MiB;
constexpr size_t WS_HTD  = 94 * MiB;
constexpr size_t WS_MEMB = 110 * MiB;
constexpr size_t WS_QKM  = 118 * MiB;
constexpr size_t WS_HT   = 214 * MiB;
constexpr size_t WS_KMEM = 342 * MiB;
constexpr size_t WS_VMT  = 346 * MiB;
constexpr size_t WS_KF   = 350 * MiB;
constexpr size_t WS_MIX  = 382 * MiB;
constexpr size_t WS_HH   = 96 * MiB;
constexpr size_t WS_ACT  = 272 * MiB;
constexpr size_t WS_BAR  = 478 * MiB;
constexpr size_t WS_CNT  = 478 * MiB + 16384;
constexpr size_t WS_XG   = 478 * MiB + 65536;
constexpr size_t WS_END  = 478 * MiB + 65536 + 2 * MiB;

__device__ __forceinline__ unsigned pk2(float lo, float hi) { unsigned r; asm volatile("v_cvt_pk_bf16_f32 %0, %1, %2" : "=v"(r) : "v"(lo), "v"(hi)); return r; }
__device__ __forceinline__ float bf2f(bf16_t v) { return __uint_as_float((unsigned)v << 16); }
__device__ __forceinline__ float lo2f(unsigned v) { return __uint_as_float(v << 16); }
__device__ __forceinline__ float hi2f(unsigned v) { return __uint_as_float(v & 0xffff0000u); }
#define LDS_WAIT() asm volatile("s_waitcnt lgkmcnt(0)" ::: "memory")
__device__ __forceinline__ float xsum16(float v) { const auto r_ = __builtin_amdgcn_permlane16_swap(__float_as_uint(v), __float_as_uint(v), false, false); return __uint_as_float(r_[0]) + __uint_as_float(r_[1]); }
__device__ __forceinline__ float xsum32(float v) { const auto r_ = __builtin_amdgcn_permlane32_swap(__float_as_uint(v), __float_as_uint(v), false, false); return __uint_as_float(r_[0]) + __uint_as_float(r_[1]); }
__device__ __forceinline__ float wave_allsum(float v, int lane) {
#pragma unroll
    for (int o = 1; o < 16; o <<= 1) v += __int_as_float(__builtin_amdgcn_ds_bpermute((lane ^ o) << 2, __float_as_int(v)));
    return xsum32(xsum16(v));
}

#ifndef FFT_HOST
#define FFT_FN __device__ __forceinline__
#define FFT_SYNC() do { asm volatile("s_waitcnt lgkmcnt(0)" ::: "memory"); __builtin_amdgcn_s_barrier(); asm volatile("" ::: "memory"); } while (0)
typedef float cplx __attribute__((ext_vector_type(2)));
typedef LAS cplx* fftbuf_t;
FFT_FN float cos2pi(float r) { return __builtin_amdgcn_cosf(r); }
FFT_FN float sin2pi(float r) { return __builtin_amdgcn_sinf(r); }
#endif
FFT_FN cplx mk2(float x, float y) { cplx r; r.x = x; r.y = y; return r; }
FFT_FN cplx cadd(cplx a, cplx b) { return mk2(a.x + b.x, a.y + b.y); }
FFT_FN cplx csub(cplx a, cplx b) { return mk2(a.x - b.x, a.y - b.y); }
#ifdef FFT_HOST
FFT_FN cplx cmul(cplx a, cplx b) { return mk2(a.x * b.x - a.y * b.y, a.x * b.y + a.y * b.x); }
FFT_FN cplx cmulc(cplx a, cplx b) { return mk2(a.x * b.x + a.y * b.y, a.y * b.x - a.x * b.y); }
#else
FFT_FN cplx cmul(cplx a, cplx b) { cplx t, r;
    asm("v_pk_mul_f32 %0, %1, %2 op_sel_hi:[1,0]" : "=v"(t) : "v"(a), "v"(b));
    asm("v_pk_fma_f32 %0, %1, %2, %3 op_sel:[1,1,0] op_sel_hi:[0,1,1] neg_lo:[1,0,0]" : "=v"(r) : "v"(a), "v"(b), "v"(t)); return r; }
FFT_FN cplx cmulc(cplx a, cplx b) { cplx t, r;
    asm("v_pk_mul_f32 %0, %1, %2 op_sel_hi:[1,0]" : "=v"(t) : "v"(a), "v"(b));
    asm("v_pk_fma_f32 %0, %1, %2, %3 op_sel:[1,1,0] op_sel_hi:[0,1,1] neg_hi:[1,0,0]" : "=v"(r) : "v"(a), "v"(b), "v"(t)); return r; }
#endif
template <bool INV> FFT_FN cplx muli(cplx a) { return INV ? mk2(-a.y, a.x) : mk2(a.y, -a.x); }
FFT_FN int padi(int i) { return i + (i >> 3); }

template <bool INV> FFT_FN void dft8(cplx (&v)[8]) {
    const float R = 0.70710678118654752f;
    const cplx a0 = cadd(v[0], v[4]), a1 = csub(v[0], v[4]), a2 = cadd(v[2], v[6]), a3 = muli<INV>(csub(v[2], v[6]));
    const cplx a4 = cadd(v[1], v[5]), a5 = csub(v[1], v[5]), a6 = cadd(v[3], v[7]), a7 = muli<INV>(csub(v[3], v[7]));
    const cplx b0 = cadd(a0, a2), b2 = csub(a0, a2), b1 = cadd(a1, a3), b3 = csub(a1, a3);
    const cplx b4 = cadd(a4, a6), b6 = muli<INV>(csub(a4, a6));
    const cplx t5 = cadd(a5, a7), t7 = csub(a5, a7);
    cplx b5, b7;
    if (!INV) { b5 = mk2((t5.x + t5.y) * R, (t5.y - t5.x) * R); b7 = mk2((t7.y - t7.x) * R, -(t7.x + t7.y) * R); }
    else      { b5 = mk2((t5.x - t5.y) * R, (t5.x + t5.y) * R); b7 = mk2(-(t7.x + t7.y) * R, (t7.x - t7.y) * R); }
    v[0] = cadd(b0, b4); v[4] = csub(b0, b4); v[1] = cadd(b1, b5); v[5] = csub(b1, b5);
    v[2] = cadd(b2, b6); v[6] = csub(b2, b6); v[3] = cadd(b3, b7); v[7] = csub(b3, b7);
}
FFT_FN void dft8_fwd_half(cplx (&v)[8]) {
    const float R = 0.70710678118654752f;
    const cplx m2 = muli<false>(v[2]), m3 = muli<false>(v[3]);
    const cplx b0 = cadd(v[0], v[2]), b2 = csub(v[0], v[2]), b1 = cadd(v[0], m2), b3 = csub(v[0], m2);
    const cplx b4 = cadd(v[1], v[3]), b6 = muli<false>(csub(v[1], v[3]));
    const cplx t5 = cadd(v[1], m3), t7 = csub(v[1], m3);
    const cplx b5 = mk2((t5.x + t5.y) * R, (t5.y - t5.x) * R), b7 = mk2((t7.y - t7.x) * R, -(t7.x + t7.y) * R);
    v[0] = cadd(b0, b4); v[4] = csub(b0, b4); v[1] = cadd(b1, b5); v[5] = csub(b1, b5);
    v[2] = cadd(b2, b6); v[6] = csub(b2, b6); v[3] = cadd(b3, b7); v[7] = csub(b3, b7);
}
template <int S, bool INV> FFT_FN void twid(cplx (&v)[8], int tid) {
    if (S > 1) {
        const int j = tid % S; const float rev = (float)j * (1.0f / (8.0f * S));
        const float c = cos2pi(rev), s = sin2pi(rev);
        const cplx w1 = mk2(c, INV ? s : -s);
        const cplx w2 = cmul(w1, w1), w3 = cmul(w2, w1), w4 = cmul(w2, w2), w5 = cmul(w4, w1), w6 = cmul(w4, w2), w7 = cmul(w4, w3);
        v[1] = cmul(v[1], w1); v[2] = cmul(v[2], w2); v[3] = cmul(v[3], w3); v[4] = cmul(v[4], w4);
        v[5] = cmul(v[5], w5); v[6] = cmul(v[6], w6); v[7] = cmul(v[7], w7);
    }
}
template <int S> FFT_FN void ld8(fftbuf_t X, int tid, cplx (&v)[8]) {
    const int base = (tid / S) * 8 * S + (tid % S);
#pragma unroll
    for (int k = 0; k < 8; ++k) v[k] = X[padi(base + S * k)];
}
template <int S> FFT_FN void st8(fftbuf_t X, int tid, const cplx (&v)[8]) {
    const int base = (tid / S) * 8 * S + (tid % S);
#pragma unroll
    for (int k = 0; k < 8; ++k) X[padi(base + S * k)] = v[k];
}
#ifndef FFT_HOST
template <int S> FFT_FN void twid_fill(fftbuf_t TW, int tid) {
    constexpr int P = (S == 512) ? 0 : (S == 64) ? 1 : 2;
    const int j = tid % S; const float rev = (float)j * (1.0f / (8.0f * S));
    const cplx w1 = mk2(cos2pi(rev), -sin2pi(rev)), w2 = cmul(w1, w1), w3 = cmul(w2, w1), w4 = cmul(w2, w2), w5 = cmul(w4, w1), w6 = cmul(w4, w2), w7 = cmul(w4, w3);
    TW[(7 * P + 0) * 512 + tid] = w1; TW[(7 * P + 1) * 512 + tid] = w2; TW[(7 * P + 2) * 512 + tid] = w3; TW[(7 * P + 3) * 512 + tid] = w4;
    TW[(7 * P + 4) * 512 + tid] = w5; TW[(7 * P + 5) * 512 + tid] = w6; TW[(7 * P + 6) * 512 + tid] = w7;
}
template <int S, bool INV> FFT_FN void twidL(cplx (&v)[8], fftbuf_t TW, int tid) {
    constexpr int P = (S == 512) ? 0 : (S == 64) ? 1 : 2;
#pragma unroll
    for (int q = 1; q < 8; ++q) { const cplx w = TW[(7 * P + q - 1) * 512 + tid]; v[q] = INV ? cmulc(v[q], w) : cmul(v[q], w); }
}
FFT_FN void fft_fwdL(fftbuf_t X, fftbuf_t TW, int tid, cplx (&v)[8]) {
    dft8_fwd_half(v); twidL<512, false>(v, TW, tid); st8<512>(X, tid, v); FFT_SYNC();
    ld8<64>(X, tid, v); dft8<false>(v); twidL<64, false>(v, TW, tid); st8<64>(X, tid, v); FFT_SYNC();
    ld8<8>(X, tid, v); dft8<false>(v); twidL<8, false>(v, TW, tid); st8<8>(X, tid, v); FFT_SYNC();
    ld8<1>(X, tid, v); dft8<false>(v);
}
FFT_FN void fft_invL(fftbuf_t X, fftbuf_t TW, int tid, cplx (&v)[8]) {
    dft8<true>(v); st8<1>(X, tid, v); FFT_SYNC();
    ld8<8>(X, tid, v); twidL<8, true>(v, TW, tid); dft8<true>(v); st8<8>(X, tid, v); FFT_SYNC();
    ld8<64>(X, tid, v); twidL<64, true>(v, TW, tid); dft8<true>(v); st8<64>(X, tid, v); FFT_SYNC();
    ld8<512>(X, tid, v); twidL<512, true>(v, TW, tid); dft8<true>(v);
}
FFT_FN void fft_fwd(fftbuf_t X, int tid, cplx (&v)[8]) {
    dft8<false>(v); twid<512, false>(v, tid); st8<512>(X, tid, v); FFT_SYNC();
    ld8<64>(X, tid, v); dft8<false>(v); twid<64, false>(v, tid); st8<64>(X, tid, v); FFT_SYNC();
    ld8<8>(X, tid, v); dft8<false>(v); twid<8, false>(v, tid); st8<8>(X, tid, v); FFT_SYNC();
    ld8<1>(X, tid, v); dft8<false>(v);
}
FFT_FN void fft_inv(fftbuf_t X, int tid, cplx (&v)[8]) {
    dft8<true>(v); st8<1>(X, tid, v); FFT_SYNC();
    ld8<8>(X, tid, v); twid<8, true>(v, tid); dft8<true>(v); st8<8>(X, tid, v); FFT_SYNC();
    ld8<64>(X, tid, v); twid<64, true>(v, tid); dft8<true>(v); st8<64>(X, tid, v); FFT_SYNC();
    ld8<512>(X, tid, v); twid<512, true>(v, tid); dft8<true>(v);
}
#endif

struct OneUnit { int pm, pn; bool on;
    __device__ __forceinline__ bool next(int i, pg8::Unit& u) const { if (!on || i > 0) return false; u.pm = pm; u.pn = pn; return true; }
    __device__ __forceinline__ void a_ready(const pg8::Unit&) const {}
    __device__ __forceinline__ void done(const pg8::Unit&) const {}
    __device__ __forceinline__ long a_off(const pg8::Unit& u, size_t tstep) const { return (long)((size_t)u.pm * tstep); }
    __device__ __forceinline__ int lda(int K) const { return K; }
    __device__ __forceinline__ size_t kstep_a() const { return 128; } };

struct EpiB {
    static constexpr bool PERM = true, AFTER_DRAIN = false;
    bf16_t* O; int ldc;
    __device__ __forceinline__ void operator()(const f32x4 (&acc)[2][2][4][2], const pg8::Unit& u, int wr, int wc, int fr, int fq) const {
        const int row0 = u.pm * 256 + wr * 64 + fr, col0 = u.pn * 256 + wc * 32 + 8 * fq;
#pragma unroll
        for (int ai = 0; ai < 2; ++ai)
#pragma unroll
            for (int m = 0; m < 4; ++m) { bf16_t* rowp = O + (size_t)(row0 + ai * 128 + m * 16) * ldc + col0;
#pragma unroll
                for (int bj = 0; bj < 2; ++bj) { const f32x4 v0 = acc[ai][bj][m][0], v1 = acc[ai][bj][m][1];
                    u32x4 w; w.x = pk2(v0[0], v0[1]); w.y = pk2(v0[2], v0[3]); w.z = pk2(v1[0], v1[1]); w.w = pk2(v1[2], v1[3]);
                    *(u32x4*)(rowp + bj * 128) = w; } }
    }
};
struct EpiRope {
    static constexpr bool PERM = true, AFTER_DRAIN = false;
    bf16_t* O; const float2* rope;
    __device__ __forceinline__ void operator()(const f32x4 (&acc)[2][2][4][2], const pg8::Unit& u, int wr, int wc, int fr, int fq) const {
        const int row0 = u.pm * 256 + wr * 64 + fr, col0 = u.pn * 256 + wc * 32 + 8 * fq;
        const bool rot = u.pn < 4;
#pragma unroll
        for (int ai = 0; ai < 2; ++ai)
#pragma unroll
            for (int m = 0; m < 4; ++m) { const int row = row0 + ai * 128 + m * 16; bf16_t* rowp = O + (size_t)row * MIXW + col0;
#pragma unroll
                for (int bj = 0; bj < 2; ++bj) { f32x4 v0 = acc[ai][bj][m][0], v1 = acc[ai][bj][m][1];
                    if (rot) { const int pos = row & (SEQ - 1), i0 = ((col0 + bj * 128) & 63) >> 1;
                        const f32x4* rp = (const f32x4*)(rope + pos * 32 + i0); const f32x4 r0 = rp[0], r1 = rp[1];
                        f32x4 o0, o1;
                        o0[0] = v0[0] * r0[0] - v0[1] * r0[1]; o0[1] = v0[1] * r0[0] + v0[0] * r0[1];
                        o0[2] = v0[2] * r0[2] - v0[3] * r0[3]; o0[3] = v0[3] * r0[2] + v0[2] * r0[3];
                        o1[0] = v1[0] * r1[0] - v1[1] * r1[1]; o1[1] = v1[1] * r1[0] + v1[0] * r1[1];
                        o1[2] = v1[2] * r1[2] - v1[3] * r1[3]; o1[3] = v1[3] * r1[2] + v1[2] * r1[3];
                        v0 = o0; v1 = o1; }
                    u32x4 w; w.x = pk2(v0[0], v0[1]); w.y = pk2(v0[2], v0[3]); w.z = pk2(v1[0], v1[1]); w.w = pk2(v1[2], v1[3]);
                    *(u32x4*)(rowp + bj * 128) = w; } }
    }
};
constexpr int XCH_OFF = 131072 + 1024;
__device__ __forceinline__ void stat_put(LAS cplx* ST, int rowl, int wc, int fq, float s1, float s2, bool first) {
    s1 = xsum32(xsum16(s1)); s2 = xsum32(xsum16(s2));
    if (fq == 0) { LAS cplx* p = ST + rowl * 4 + wc; cplx v; v.x = s1; v.y = s2; if (!first) { const cplx o = *p; v.x += o.x; v.y += o.y; } *p = v; }
}
struct EpiRes {
    static constexpr bool PERM = false, AFTER_DRAIN = false;
    const float* X; float* O; LAS unsigned char* lds; mutable int ecnt;
    __device__ __forceinline__ void operator()(const f32x4 (&acc)[2][2][4][2], const pg8::Unit& u, int wr, int wc, int fr, int fq) const {
        const int row0 = u.pm * 256 + wr * 64 + fr, col0 = u.pn * 256 + wc * 32 + 4 * fq;
        LAS cplx* ST = (LAS cplx*)(lds + XCH_OFF) + (ecnt & 1) * 1024; const bool first = true; ++ecnt;
#pragma unroll
        for (int ai = 0; ai < 2; ++ai) {
            f32x4 xv[4][2][2];
#pragma unroll
            for (int m = 0; m < 4; ++m)
#pragma unroll
                for (int bj = 0; bj < 2; ++bj)
#pragma unroll
                    for (int n = 0; n < 2; ++n) xv[m][bj][n] = *(const f32x4*)(X + (size_t)(row0 + ai * 128 + m * 16) * DM + col0 + bj * 128 + 16 * n);
            asm volatile("" ::: "memory");
#pragma unroll
            for (int m = 0; m < 4; ++m) { float s1 = 0.f, s2 = 0.f;
#pragma unroll
                for (int bj = 0; bj < 2; ++bj)
#pragma unroll
                    for (int n = 0; n < 2; ++n) { const f32x4 o = acc[ai][bj][m][n] + xv[m][bj][n] * ALPHA;
                        *(f32x4*)(O + (size_t)(row0 + ai * 128 + m * 16) * DM + col0 + bj * 128 + 16 * n) = o;
                        s1 += (o[0] + o[1]) + (o[2] + o[3]); s2 += (o[0] * o[0] + o[1] * o[1]) + (o[2] * o[2] + o[3] * o[3]); }
                stat_put(ST, ai * 128 + wr * 64 + m * 16 + fr, wc, fq, s1, s2, first); }
        }
    }
};
struct EpiRes2 {
    static constexpr bool PERM = false, AFTER_DRAIN = false;
    const float* R; float* O; const float2* stat; const float* g; const float* b; LAS unsigned char* lds; mutable int ecnt;
    __device__ __forceinline__ void operator()(const f32x4 (&acc)[2][2][4][2], const pg8::Unit& u, int wr, int wc, int fr, int fq) const {
        const int row0 = u.pm * 256 + wr * 64 + fr, col0 = u.pn * 256 + wc * 32 + 4 * fq;
        LAS cplx* ST = (LAS cplx*)(lds + XCH_OFF) + (ecnt & 1) * 1024; const bool first = true; ++ecnt;
#pragma unroll
        for (int ai = 0; ai < 2; ++ai)
#pragma unroll
            for (int bj = 0; bj < 2; ++bj) {
                f32x4 rv[4][2], gv[2], bv[2]; float2 st[4];
#pragma unroll
                for (int m = 0; m < 4; ++m) { const int row = row0 + ai * 128 + m * 16; st[m] = stat[row];
#pragma unroll
                    for (int n = 0; n < 2; ++n) rv[m][n] = *(const f32x4*)(R + (size_t)row * DM + col0 + bj * 128 + 16 * n); }
#pragma unroll
                for (int n = 0; n < 2; ++n) { gv[n] = *(const f32x4*)(g + col0 + bj * 128 + 16 * n); bv[n] = *(const f32x4*)(b + col0 + bj * 128 + 16 * n); }
                asm volatile("" ::: "memory");
#pragma unroll
                for (int m = 0; m < 4; ++m) { float s1 = 0.f, s2 = 0.f;
#pragma unroll
                    for (int n = 0; n < 2; ++n) { const f32x4 x1 = (rv[m][n] - st[m].x) * st[m].y * gv[n] + bv[n]; const f32x4 o = acc[ai][bj][m][n] + x1 * ALPHA;
                        *(f32x4*)(O + (size_t)(row0 + ai * 128 + m * 16) * DM + col0 + bj * 128 + 16 * n) = o;
                        s1 += (o[0] + o[1]) + (o[2] + o[3]); s2 += (o[0] * o[0] + o[1] * o[1]) + (o[2] * o[2] + o[3] * o[3]); }
                    stat_put(ST, ai * 128 + wr * 64 + m * 16 + fr, wc, fq, s1, s2, first && bj == 0); }
            }
    }
};
template <int MODE, bool RB> struct EpiLn {
    static constexpr bool PERM = false, AFTER_DRAIN = false;
    const float* RES; const bf16_t* RESB; float* OF; bf16_t* OB; const float* g; const float* b; unsigned long long* XG; unsigned* CNT; LAS unsigned char* ldsp;
    __device__ __forceinline__ void operator()(const f32x4 (&acc)[2][2][4][2], const pg8::Unit& u, int wr, int wc, int fr, int fq) const {
        const int t_ = threadIdx.x; fused(const_cast<f32x4 (&)[2][2][4][2]>(acc), u, wr, wc, fr, fq, ldsp, __builtin_amdgcn_readfirstlane(t_ >> 6), t_ & 63); }
    __device__ __forceinline__ void fused(f32x4 (&acc)[2][2][4][2], const pg8::Unit& u, int wr, int wc, int fr, int fq, LAS unsigned char* lds, int wid, int lane) const {
        const int tid = wid * 64 + lane, row0 = u.pm * 256 + wr * 64 + fr, col0 = u.pn * 256 + wc * 32 + 4 * fq;
        LAS cplx* ST = (LAS cplx*)(lds + XCH_OFF); LAS cplx* MR = (LAS cplx*)(lds + XCH_OFF + 8192);
#pragma unroll
        for (int ai = 0; ai < 2; ++ai) {
            float s1[4], s2[4];
#pragma unroll
            for (int m = 0; m < 4; ++m) { s1[m] = 0.f; s2[m] = 0.f; }
#pragma unroll
            for (int bj = 0; bj < 2; ++bj) {
                f32x4 xv[4][2];
                if (!RB) {
#pragma unroll
                    for (int m = 0; m < 4; ++m)
#pragma unroll
                        for (int n = 0; n < 2; ++n) xv[m][n] = __builtin_nontemporal_load((const f32x4*)(RES + (size_t)(row0 + ai * 128 + m * 16) * DM + col0 + bj * 128 + 16 * n));
                } else {
                    u32x2 xb[4][2];
#pragma unroll
                    for (int m = 0; m < 4; ++m)
#pragma unroll
                        for (int n = 0; n < 2; ++n) xb[m][n] = *(const u32x2*)(RESB + (size_t)(row0 + ai * 128 + m * 16) * DM + col0 + bj * 128 + 16 * n);
#pragma unroll
                    for (int m = 0; m < 4; ++m)
#pragma unroll
                        for (int n = 0; n < 2; ++n) { xv[m][n][0] = lo2f(xb[m][n].x); xv[m][n][1] = hi2f(xb[m][n].x); xv[m][n][2] = lo2f(xb[m][n].y); xv[m][n][3] = hi2f(xb[m][n].y); }
                }
                asm volatile("" ::: "memory");
#pragma unroll
                for (int m = 0; m < 4; ++m)
#pragma unroll
                    for (int n = 0; n < 2; ++n) { const f32x4 o = acc[ai][bj][m][n] + xv[m][n] * ALPHA; acc[ai][bj][m][n] = o;
                        s1[m] += (o[0] + o[1]) + (o[2] + o[3]); s2[m] += (o[0] * o[0] + o[1] * o[1]) + (o[2] * o[2] + o[3] * o[3]); }
            }
#pragma unroll
            for (int m = 0; m < 4; ++m) stat_put(ST, ai * 128 + wr * 64 + m * 16 + fr, wc, fq, s1[m], s2[m], true);
        }
        asm volatile("s_waitcnt lgkmcnt(0)" ::: "memory"); __syncthreads();
        float m1 = 0.f, m2 = 0.f;
        if (tid < 256) { const cplx a0 = ST[tid * 4 + 0], a1 = ST[tid * 4 + 1], a2 = ST[tid * 4 + 2], a3 = ST[tid * 4 + 3];
            m1 = (a0.x + a1.x) + (a2.x + a3.x); m2 = (a0.y + a1.y) + (a2.y + a3.y);
            __hip_atomic_store(XG + (size_t)(u.pm * 4 + u.pn) * 256 + tid, ((unsigned long long)__float_as_uint(m2) << 32) | __float_as_uint(m1), __ATOMIC_RELAXED, __HIP_MEMORY_SCOPE_AGENT); }
        asm volatile("s_waitcnt vmcnt(0)" ::: "memory");
        __syncthreads();
        if (tid == 0) {
            (void)__hip_atomic_fetch_add(CNT + u.pm * 16, 1u, __ATOMIC_RELAXED, __HIP_MEMORY_SCOPE_AGENT);
            unsigned sp = 0;
            while (__hip_atomic_load(CNT + u.pm * 16, __ATOMIC_RELAXED, __HIP_MEMORY_SCOPE_AGENT) < 4u) { __builtin_amdgcn_s_sleep(1); if (++sp > (1u << 22)) break; }
            __builtin_amdgcn_fence(__ATOMIC_ACQUIRE, "agent");
            asm volatile("s_waitcnt vmcnt(0)" ::: "memory");
        }
        __syncthreads();
        if (tid < 256) { float t1 = m1, t2 = m2;
#pragma unroll
            for (int jj = 1; jj < 4; ++jj) { const unsigned long long w = __hip_atomic_load(XG + (size_t)(u.pm * 4 + ((u.pn + jj) & 3)) * 256 + tid, __ATOMIC_RELAXED, __HIP_MEMORY_SCOPE_AGENT);
                t1 += __uint_as_float((unsigned)w); t2 += __uint_as_float((unsigned)(w >> 32)); }
            const float mean = t1 * (1.0f / DM), var = fmaxf(t2 * (1.0f / DM) - mean * mean, 0.f);
            cplx mr; mr.x = mean; mr.y = rsqrtf(var + LN_EPS); MR[tid] = mr; }
        __syncthreads();
#pragma unroll
        for (int bj = 0; bj < 2; ++bj)
#pragma unroll
            for (int n = 0; n < 2; ++n) { const int c = col0 + bj * 128 + 16 * n; const f32x4 gv = *(const f32x4*)(g + c), bv = *(const f32x4*)(b + c);
#pragma unroll
                for (int ai = 0; ai < 2; ++ai)
#pragma unroll
                    for (int m = 0; m < 4; ++m) { const int rl = ai * 128 + wr * 64 + m * 16 + fr; const cplx mr = MR[rl];
                        const f32x4 y = (acc[ai][bj][m][n] - mr.x) * mr.y * gv + bv; const size_t off = (size_t)(u.pm * 256 + rl) * DM + c;
                        if (MODE == 1) { u32x2 w; w.x = pk2(y[0], y[1]); w.y = pk2(y[2], y[3]); *(u32x2*)(OB + off) = w; }
                        else __builtin_nontemporal_store(y, (f32x4*)(OF + off)); } }
    }
};
struct QuadTwo { int q, j;
    __device__ __forceinline__ bool next(int i, pg8::Unit& u) const { if (i > 1) return false; u.pm = 2 * q + i; u.pn = j; return true; }
    __device__ __forceinline__ void a_ready(const pg8::Unit&) const {}
    __device__ __forceinline__ void done(const pg8::Unit&) const {}
    __device__ __forceinline__ long a_off(const pg8::Unit& u, size_t tstep) const { return (long)((size_t)u.pm * tstep); }
    __device__ __forceinline__ int lda(int K) const { return K; }
    __device__ __forceinline__ size_t kstep_a() const { return 128; } };
struct QuadTwoKb : QuadTwo {
    __device__ __forceinline__ int lda(int) const { return 64; }
    __device__ __forceinline__ size_t kstep_a() const { return (size_t)NT * 64 * 2; } };
struct OneUnitKb : OneUnit {
    __device__ __forceinline__ int lda(int) const { return 64; }
    __device__ __forceinline__ size_t kstep_a() const { return (size_t)NT * 64 * 2; }
};
struct PairOrder : pg8::StaticOrder {
    bool pair;
    __device__ __forceinline__ static int vcu_of(int c) { return (c & 7) * 32 + (c >> 3); }
    __device__ __forceinline__ bool next(int i, pg8::Unit& u) const {
        if (!pair) return pg8::StaticOrder::next(i, u);
        if (i > 1) return false;
        const int v = vcu_of(c); u.pm = 2 * (v >> 2) + i; u.pn = v & 3; return true; }
};
struct KbOrder : pg8::StaticOrder {
    __device__ __forceinline__ int lda(int) const { return 64; }
    __device__ __forceinline__ size_t kstep_a() const { return (size_t)NT * 64 * 2; }
};
struct PairKb : PairOrder {
    __device__ __forceinline__ int lda(int) const { return 64; }
    __device__ __forceinline__ size_t kstep_a() const { return (size_t)NT * 64 * 2; }
};
struct RevOrder : pg8::StaticOrder {
    __device__ __forceinline__ bool next(int i, pg8::Unit& u) const { const int rounds = (nwg + G - 1) / G; if (i >= rounds) return false; return pg8::StaticOrder::next(rounds - 1 - i, u); }
};
constexpr int CWL_OFF = 131072 + 1024 + 8192;
struct FfnOrder : pg8::StaticOrder {
    const float* cw; const float* cb; LAS unsigned char* lds; mutable int cnt;
    __device__ __forceinline__ long a_off(const pg8::Unit& u, size_t) const { return ((long)u.pm * 254 - 1) * (long)(DM * 2); }
    __device__ __forceinline__ void a_ready(const pg8::Unit& u) const {
        const int tid = threadIdx.x, w = __builtin_amdgcn_readfirstlane(tid >> 6), lane = tid & 63, buf = cnt & 1; ++cnt;
        const float* src = (w < 3) ? cw + (size_t)w * (2 * DFF) : (w < 6) ? cw + (size_t)(w - 3) * (2 * DFF) + DFF : (w == 6) ? cb : cb + DFF;
        src += u.pn * 128 + lane * 4;
        if (lane < 32) __builtin_amdgcn_global_load_lds((const unsigned*)src, (LAS unsigned*)(lds + CWL_OFF + buf * 4096 + w * 512), 16, 0, 0);
    }
};
constexpr int FFN_MT = 130;
__device__ __forceinline__ float dpp_ror1(float v)  { return __int_as_float(__builtin_amdgcn_update_dpp(0, __float_as_int(v), 0x121, 0xF, 0xF, false)); }
__device__ __forceinline__ float dpp_ror15(float v) { return __int_as_float(__builtin_amdgcn_update_dpp(0, __float_as_int(v), 0x12F, 0xF, 0xF, false)); }
struct EpiFfn {
    static constexpr bool PERM = true, AFTER_DRAIN = false;
    bf16_t* ACT; LAS unsigned char* lds; mutable int ecnt;
    __device__ __forceinline__ void operator()(const f32x4 (&acc)[2][2][4][2], const pg8::Unit& u, int wr, int wc, int fr, int fq) const {
        LAS float* XC = (LAS float*)(lds + XCH_OFF);
        const LAS float* WL = (const LAS float*)(lds + CWL_OFF + (ecnt & 1) * 4096); ++ecnt;
        const int colw = wc * 32 + 8 * fq;
        if (fr == 0 || fr == 15) {
            const int edge = (fr == 15) ? 1 : 0, m = (fr == 15) ? 3 : 0;
#pragma unroll
            for (int ai = 0; ai < 2; ++ai)
#pragma unroll
                for (int bj = 0; bj < 2; ++bj)
#pragma unroll
                    for (int n = 0; n < 2; ++n) { const f32x4 v = (m == 0) ? acc[ai][bj][0][n] : acc[ai][bj][3][n];
                        *(LAS f32x4*)(XC + ((ai * 2 + wr) * 2 + edge) * 256 + bj * 128 + colw + 4 * n) = v; }
        }
        asm volatile("s_waitcnt lgkmcnt(0)" ::: "memory"); __builtin_amdgcn_s_barrier(); asm volatile("" ::: "memory");
        const int slot0 = wr * 64 + fr, row_base = u.pm * 254 - 1;
#pragma unroll
        for (int bj = 0; bj < 2; ++bj) {
            const int gc = (u.pn * 256 + bj * 128 + colw) >> 1;
            const LAS float* wl = WL + ((bj * 128 + colw) >> 1);
            f32x4 wg[3], wu[3];
#pragma unroll
            for (int j = 0; j < 3; ++j) { wg[j] = *(const LAS f32x4*)(wl + j * 128); wu[j] = *(const LAS f32x4*)(wl + (3 + j) * 128); }
            const f32x4 bg = *(const LAS f32x4*)(wl + 6 * 128), bu = *(const LAS f32x4*)(wl + 7 * 128);
#pragma unroll
            for (int ai = 0; ai < 2; ++ai) {
                const int gidx = ai * 2 + wr;
                f32x4 pe[2], ne[2];
#pragma unroll
                for (int n = 0; n < 2; ++n) {
                    pe[n] = (gidx > 0) ? *(const LAS f32x4*)(XC + (((gidx - 1) * 2) + 1) * 256 + bj * 128 + colw + 4 * n) : (f32x4){0.f, 0.f, 0.f, 0.f};
                    ne[n] = (gidx < 3) ? *(const LAS f32x4*)(XC + (((gidx + 1) * 2) + 0) * 256 + bj * 128 + colw + 4 * n) : (f32x4){0.f, 0.f, 0.f, 0.f}; }
                u32x2 wq[2];
#pragma unroll
                for (int m = 0; m < 4; ++m) {
                    const int slot = ai * 128 + slot0 + m * 16, row = row_base + slot, t = row & (SEQ - 1);
                    const bool padrow = __any(t == 0 || t == SEQ - 1) != 0;
                    f32x4 hv[2];
#pragma unroll
                    for (int n = 0; n < 2; ++n) {
                        const f32x4 cur = acc[ai][bj][m][n], prv = acc[ai][bj][m == 0 ? 0 : m - 1][n], nxt = acc[ai][bj][m == 3 ? 3 : m + 1][n];
                        f32x4 up, dn;
#pragma unroll
                        for (int e = 0; e < 4; ++e) { up[e] = dpp_ror1(fr == 15 ? prv[e] : cur[e]); dn[e] = dpp_ror15(fr == 0 ? nxt[e] : cur[e]); }
                        if (m == 0 && fr == 0) up = pe[n];
                        if (m == 3 && fr == 15) dn = ne[n];
                        if (padrow) {
                            if (t == 0) up = (f32x4){0.f, 0.f, 0.f, 0.f};
                            if (t == SEQ - 1) dn = (f32x4){0.f, 0.f, 0.f, 0.f}; }
                        const f32x4 w0 = n ? wu[0] : wg[0], w1 = n ? wu[1] : wg[1], w2 = n ? wu[2] : wg[2], bb = n ? bu : bg;
                        hv[n] = w0 * up + w1 * cur + w2 * dn + bb; }
                    { float o[4];
#pragma unroll
                      for (int e = 0; e < 4; ++e) { const float g = hv[0][e]; o[e] = g * __builtin_amdgcn_rcpf(1.0f + __expf(-g)) * hv[1][e]; }
                      wq[m & 1].x = pk2(o[0], o[1]); wq[m & 1].y = pk2(o[2], o[3]); }
                    if (m & 1) {
                        const auto r0 = __builtin_amdgcn_permlane16_swap(wq[0].x, wq[1].x, false, false); const auto r1 = __builtin_amdgcn_permlane16_swap(wq[0].y, wq[1].y, false, false);
                        u32x4 w; w.x = r0[0]; w.y = r1[0]; w.z = r0[1]; w.w = r1[1];
                        const int ms = (fq & 1) ? m : m - 1, slot_s = ai * 128 + slot0 + ms * 16, row_s = row_base + slot_s, gcs = gc - ((fq & 1) ? 4 : 0);
                        if (slot_s >= 1 && slot_s <= 254 && row_s < NT) *(u32x4*)(ACT + ((size_t)(gcs >> 6) * NT + row_s) * 64 + (gcs & 63)) = w; }
                }
            }
        }
    }
};

struct P1Order {
    pg8::StaticOrder sa, sb; int c;
    __device__ __forceinline__ void init(int G, int c_) { sa.init(NT, 1536, G, c_); sb.init(2048, NT, G, c_); c = c_; }
    __device__ __forceinline__ bool next(int i, pg8::Unit& u) const {
        if (i < 3) { if (!sa.next(i, u)) return false; u.pm += 60; return true; }
        if (i < 7) { if (!sb.next(i - 3, u)) return false; u.pm += 6; u.pn += 60; return true; }
        if (i == 7 && c < 64) { if (c < 32) { u.pm = 220 + (c >> 1); u.pn = 14 + (c & 1); } else { const int c2 = c - 32; u.pm = 16 + ((c2 >> 4) & 1); u.pn = 220 + (c2 & 15); } return true; }
        return false; }
    __device__ __forceinline__ void a_ready(const pg8::Unit&) const {}
    __device__ __forceinline__ void done(const pg8::Unit&) const {}
    __device__ __forceinline__ long a_off(const pg8::Unit& u, size_t tstep) const { return (long)((size_t)u.pm * tstep); }
    __device__ __forceinline__ int lda(int K) const { return K; }
    __device__ __forceinline__ size_t kstep_a() const { return 128; }
};
struct EpiP1 {
    static constexpr bool PERM = true, AFTER_DRAIN = false;
    EpiRope ea; EpiB eb, ec, ed;
    __device__ __forceinline__ void operator()(const f32x4 (&acc)[2][2][4][2], const pg8::Unit& u, int wr, int wc, int fr, int fq) const {
        pg8::Unit v;
        if (u.pm >= 220) { v.pm = u.pm - 220; v.pn = u.pn - 14; ec(acc, v, wr, wc, fr, fq); }
        else if (u.pm >= 60) { v.pm = u.pm - 60; v.pn = u.pn; ea(acc, v, wr, wc, fr, fq); }
        else if (u.pm >= 16) { v.pm = u.pm - 16; v.pn = u.pn - 220; ed(acc, v, wr, wc, fr, fq); }
        else { v.pm = u.pm - 6; v.pn = u.pn - 60; eb(acc, v, wr, wc, fr, fq); }
    }
};

__device__ __forceinline__ int win_row(int n) {
    if (n < 1536) return 1536 + n;
    if (n < 2560) { const int q = n - 1536, blk = q >> 6, d = q & 63; return blk * 64 + 2 * (d & 31) + (d >> 5); }
    if (n < 3072) return 512 + n;
    return n - 2048;
}
template <int MODE> __device__ __forceinline__ void p0_transpose_item(const float* W, int K, int N, bf16_t* WT, LAS float* scr, int item, int lane) {
    const int nblk = N / 32, kb = item / nblk, nb = item % nblk, k0 = 64 * kb, n0 = 32 * nb;
    f32x4 q[8];
#pragma unroll
    for (int i = 0; i < 8; ++i) q[i] = __builtin_nontemporal_load((const f32x4*)(W + (size_t)(k0 + 8 * i + (lane >> 3)) * N + n0 + 4 * (lane & 7)));
#pragma unroll
    for (int i = 0; i < 8; ++i) { LAS float* d = scr + (8 * i + (lane >> 3)) * 33 + 4 * (lane & 7); d[0] = q[i][0]; d[1] = q[i][1]; d[2] = q[i][2]; d[3] = q[i][3]; }
    LDS_WAIT(); asm volatile("" ::: "memory");
    const int c = lane & 7;
#pragma unroll
    for (int j = 0; j < 4; ++j) { const int n = (lane >> 3) + 8 * j; const LAS float* s = scr + (8 * c) * 33 + n;
        u32x4 o; o.x = pk2(s[0 * 33], s[1 * 33]); o.y = pk2(s[2 * 33], s[3 * 33]); o.z = pk2(s[4 * 33], s[5 * 33]); o.w = pk2(s[6 * 33], s[7 * 33]);
        const int nn = n0 + n; const int dr = (MODE == 1) ? win_row(nn) : (MODE == 2) ? ((nn < DFF) ? ((nn >> 2) * 8 + (nn & 3)) : (((nn - DFF) >> 2) * 8 + 4 + ((nn - DFF) & 3))) : nn;
        *(u32x4*)(WT + (size_t)dr * K + k0 + 8 * c) = o; }
    LDS_WAIT(); asm volatile("" ::: "memory");
}
__device__ __forceinline__ void cvt_rows(const float* src, bf16_t* dst, size_t n8, int gw, int ngw, int lane) {
    const size_t n4 = 2 * n8, stride = (size_t)ngw * 64;
    for (size_t i = (size_t)gw * 64 + lane; i < n4; i += 8 * stride) {
        f32x4 a[8];
#pragma unroll
        for (int u = 0; u < 8; ++u) { const size_t k = i + u * stride; if (k < n4) a[u] = __builtin_nontemporal_load((const f32x4*)src + k); }
#pragma unroll
        for (int u = 0; u < 8; ++u) { const size_t k = i + u * stride; if (k < n4) { u32x2 w; w.x = pk2(a[u][0], a[u][1]); w.y = pk2(a[u][2], a[u][3]); ((u32x2*)dst)[k] = w; } }
    }
}
__device__ __forceinline__ void p0_filter_item(const LAS float* w1, const float* b1, const float* fq, const LAS float* w2, const float* b2, const float* w3, float* HTD, int item, int lane) {
    const int t0 = 2 * (item >> 2), ih = item & 3; float h2v[2], tl[2];
    const float fql = fq[lane], b1l = b1[lane], b2l = b2[lane];
#pragma unroll
    for (int tt = 0; tt < 2; ++tt) { const int t = t0 + tt; tl[tt] = (float)t * (1.0f / 2047.0f);
        const float w = 6.283185307179586f * (float)t / 2048.0f;
        float zk = 0.f;
        if (lane == 0) zk = tl[tt];
        else if (lane <= 16) { const float fr = 1e-4f + (float)(lane - 1) * ((15.0f - 1e-4f) / 15.0f); zk = cosf(fr * w); }
        else if (lane <= 32) { const float fr = 1e-4f + (float)(lane - 17) * ((15.0f - 1e-4f) / 15.0f); zk = -sinf(fr * w); }
        float a = b1l;
#pragma unroll 11
        for (int k = 0; k < 33; ++k) a += __shfl(zk, k) * w1[k * 64 + lane];
        const float h1 = sinf(fql * a);
        float a2 = b2l;
#pragma unroll 16
        for (int k = 0; k < 64; ++k) a2 += __shfl(h1, k) * w2[k * 64 + lane];
        h2v[tt] = sinf(fql * a2); }
    const float dmin = -15.350567286626973f, dmax = -3.0701134573253946f;
    float acc0[8], acc1[8];
#pragma unroll
    for (int i = 0; i < 8; ++i) { acc0[i] = 0.f; acc1[i] = 0.f; }
#pragma unroll 8
    for (int j = 0; j < 64; ++j) { const float s0 = __shfl(h2v[0], j), s1 = __shfl(h2v[1], j); const float* wr = w3 + (size_t)j * 2048 + ih * 512 + lane;
#pragma unroll
        for (int i = 0; i < 8; ++i) { const float wv = wr[64 * i]; acc0[i] += s0 * wv; acc1[i] += s1 * wv; } }
#pragma unroll
    for (int i = 0; i < 8; ++i) { const int col = ih * 512 + 64 * i + lane, c = col & 511;
        const float delta = fabsf(dmin + (float)c * ((dmax - dmin) / 511.0f));
        float2 o; o.x = acc0[i] * expf(-tl[0] * delta); o.y = acc1[i] * expf(-tl[1] * delta);
        *(float2*)(HTD + (size_t)col * 2048 + t0) = o; }
}
__device__ __forceinline__ void p0_prep(const float* const* in, unsigned char* ws, LAS unsigned char* lds, int tid, unsigned long long t_start) {
#ifdef PROBE_AT
#define PROBE0(k) do { if ((k) == PROBE_AT) { const unsigned long long t_now = __builtin_amdgcn_s_memrealtime(), dt_ = t_now - t_start; while (__builtin_amdgcn_s_memrealtime() - t_now < dt_) __builtin_amdgcn_s_sleep(8); } } while (0)
#else
#define PROBE0(k) do {} while (0)
#endif
    const int lane = tid & 63, wave = __builtin_amdgcn_readfirstlane(tid >> 6), gw = blockIdx.x * NWAVE + wave, ngw = gridDim.x * NWAVE;
    LAS float* scr = (LAS float*)(lds + wave * 8704);
    LAS float* W1L = (LAS float*)(lds + 69632); LAS float* W2L = W1L + 33 * 64;
    for (int i = tid; i < 33 * 64; i += NTHR) W1L[i] = in[5][i];
    for (int i = tid; i < 64 * 64; i += NTHR) W2L[i] = in[8][i];
    __syncthreads();
    bf16_t* WALL = (bf16_t*)(ws + WS_WALL);
    constexpr int I_IN = 16 * (INW / 32), I_KV = 16 * 32, I_OUT = 24 * 32, I_UP = 16 * (2 * DFF / 32), I_DN = (DFF / 64) * 32, NIT = I_IN + I_KV + I_OUT + I_UP + I_DN;
    for (int it = gw; it < NIT; it += ngw) { int r = it;
        if (r < I_IN) { p0_transpose_item<1>(in[2], DM, INW, WALL, scr, r, lane); continue; } r -= I_IN;
        if (r < I_KV) { p0_transpose_item<0>(in[14], DM, 1024, (bf16_t*)(ws + WS_WKV), scr, r, lane); continue; } r -= I_KV;
        if (r < I_OUT) { p0_transpose_item<0>(in[15], MIXW, DM, (bf16_t*)(ws + WS_WOUT), scr, r, lane); continue; } r -= I_OUT;
        if (r < I_UP) { p0_transpose_item<2>(in[18], DM, 2 * DFF, (bf16_t*)(ws + WS_WUP), scr, r, lane); continue; } r -= I_UP;
        p0_transpose_item<0>(in[21], DFF, DM, (bf16_t*)(ws + WS_WDN), scr, r, lane); }
    PROBE0(11);
    for (int it = ngw - 1 - gw; it < 4096; it += ngw) p0_filter_item(W1L, in[6], in[7], W2L, in[9], in[10], (float*)(ws + WS_HTD), it, lane);
    PROBE0(12);
    cvt_rows(in[0], (bf16_t*)(ws + WS_XB), (size_t)NT * DM / 8, gw, ngw, lane);
    cvt_rows(in[1], (bf16_t*)(ws + WS_MEMB), (size_t)NMT * DM / 8, gw, ngw, lane);
    float2* rope = (float2*)(ws + WS_ROPE);
    for (int i = blockIdx.x * NTHR + tid; i < SEQ * 32; i += gridDim.x * NTHR) { const int pos = i >> 5, f = i & 31;
        const float invf = powf(10000.0f, -(float)(2 * f) / 64.0f); const float ang = (float)pos * invf;
        float2 cs; cs.x = cosf(ang); cs.y = sinf(ang); rope[i] = cs; }
}

__device__ __forceinline__ void filter_fft_item(const float* HTD, float2* KF, LAS unsigned char* lds, int item, int tid) {
    const int o = item >> 9, c = item & 511;
    const float* rf = HTD + (size_t)((o * 2 + 0) * 512 + c) * 2048; const float* rb = HTD + (size_t)((o * 2 + 1) * 512 + c) * 2048;
    cplx v[8];
#pragma unroll
    for (int k = 0; k < 4; ++k) v[k] = mk2(rf[tid + 512 * k], 0.f);
    v[4] = mk2(tid == 0 ? 0.f : rb[2048 - tid], 0.f); v[5] = mk2(rb[1536 - tid], 0.f); v[6] = mk2(rb[1024 - tid], 0.f); v[7] = mk2(rb[512 - tid], 0.f);
    fft_fwd((LAS cplx*)lds, tid, v);
    float2* dst = KF + (size_t)(o * 512 + c) * 4096 + 8 * tid;
#pragma unroll
    for (int m = 0; m < 8; m += 2) { f32x4 w; w[0] = v[m].x * (1.f / 4096.f); w[1] = v[m].y * (1.f / 4096.f); w[2] = v[m + 1].x * (1.f / 4096.f); w[3] = v[m + 1].y * (1.f / 4096.f); *(f32x4*)(dst + m) = w; }
    __syncthreads();
}

constexpr int HY_SEG = 2064, HY_STG_OFF = 36864;
__device__ __forceinline__ u32x4 hy_fetch_conv(const bf16_t* HT, const float* cw, const float* cb, int c, int ba, int id) {
    const int sg = id >> 8, ch = id & 255, col = (sg >> 1) * 512 + c;
    const bf16_t* p = HT + (size_t)col * NT + (ba + (sg & 1)) * SEQ + ch * 8;
    const u32x4 q = __builtin_nontemporal_load((const u32x4*)p);
    const float lf = (ch > 0) ? bf2f(p[-1]) : 0.f, rt = (ch < 255) ? bf2f(p[8]) : 0.f;
    const float w0 = cw[col], w1 = cw[1536 + col], w2 = cw[3072 + col], bb = cb[col];
    float e[10]; e[0] = lf; e[1] = lo2f(q.x); e[2] = hi2f(q.x); e[3] = lo2f(q.y); e[4] = hi2f(q.y); e[5] = lo2f(q.z); e[6] = hi2f(q.z); e[7] = lo2f(q.w); e[8] = hi2f(q.w); e[9] = rt;
    float o[8];
#pragma unroll
    for (int j = 0; j < 8; ++j) o[j] = w0 * e[j] + w1 * e[j + 1] + w2 * e[j + 2] + bb;
    u32x4 r; r.x = pk2(o[0], o[1]); r.y = pk2(o[2], o[3]); r.z = pk2(o[4], o[5]); r.w = pk2(o[6], o[7]); return r;
}
__device__ __forceinline__ void hyena_item(const bf16_t* HT, const float2* KF, const float* cw, const float* cb, const float* hb, bf16_t* MIX, LAS unsigned char* lds, int bp, int cgp, int tid0) {
    LAS cplx* X = (LAS cplx*)lds; LAS bf16_t* STG = (LAS bf16_t*)(lds + HY_STG_OFF); LAS cplx* TW = (LAS cplx*)(lds + 65536);
    const int ba = 2 * bp;
    twid_fill<512>(TW, tid0); twid_fill<64>(TW, tid0); twid_fill<8>(TW, tid0);
    u32x4 oacc[8];
#pragma unroll
    for (int i = 0; i < 8; ++i) oacc[i] = (u32x4){0u, 0u, 0u, 0u};
    {
#pragma unroll
      for (int i = 0; i < 3; ++i) { const int id = tid0 + 512 * i, sg = id >> 8, ch = id & 255;
          *(LAS u32x4*)(STG + sg * HY_SEG + 8 + ch * 8) = hy_fetch_conv(HT, cw, cb, cgp * 8, ba, id); } }
    __syncthreads();
#pragma unroll 1
    for (int cc = 0; cc < 8; ++cc) {
        const int c = cgp * 8 + cc;
        int tl_ = tid0; asm volatile("" : "+v"(tl_)); const int tid = tl_;
        const float hbv0 = hb[c], hbv1 = hb[512 + c];
        u32x4 nx[3];
        if (cc < 7) {
#pragma unroll
            for (int i = 0; i < 3; ++i) nx[i] = hy_fetch_conv(HT, cw, cb, c + 1, ba, tid + 512 * i); }
        f32x4 kf[4];
        { const f32x4* kp = (const f32x4*)(KF + (size_t)c * 4096 + 8 * tid);
#pragma unroll
          for (int m = 0; m < 4; ++m) kf[m] = kp[m]; }
        cplx v[8]; float va[4], vb[4];
        {
#pragma unroll
          for (int k = 0; k < 4; ++k) { const int n = tid + 512 * k; va[k] = bf2f(STG[8 + n]); vb[k] = bf2f(STG[HY_SEG + 8 + n]); v[k] = mk2(va[k], vb[k]); v[4 + k] = mk2(0.f, 0.f); } }
        fft_fwdL(X, TW, tid, v);
#pragma unroll
        for (int m = 0; m < 8; m += 2) { const f32x4 w = kf[m >> 1]; v[m] = cmul(v[m], mk2(w[0], w[1])); v[m + 1] = cmul(v[m + 1], mk2(w[2], w[3])); }
        { const f32x4* kp = (const f32x4*)(KF + (size_t)(512 + c) * 4096 + 8 * tid);
#pragma unroll
          for (int m = 0; m < 4; ++m) kf[m] = kp[m]; }
        fft_invL(X, TW, tid, v);
        { const float hb0 = hbv0;
#pragma unroll
          for (int k = 0; k < 4; ++k) { const int n = tid + 512 * k; const float xa = bf2f(STG[2 * HY_SEG + 8 + n]), xb = bf2f(STG[3 * HY_SEG + 8 + n]);
              va[k] = xa * (v[k].x + hb0 * va[k]); vb[k] = xb * (v[k].y + hb0 * vb[k]); v[k] = mk2(va[k], vb[k]); v[4 + k] = mk2(0.f, 0.f); } }
        fft_fwdL(X, TW, tid, v);
#pragma unroll
        for (int m = 0; m < 8; m += 2) { const f32x4 w = kf[m >> 1]; v[m] = cmul(v[m], mk2(w[0], w[1])); v[m + 1] = cmul(v[m + 1], mk2(w[2], w[3])); }
        fft_invL(X, TW, tid, v);
        { const float hb1 = hbv1;
#pragma unroll
          for (int k = 0; k < 4; ++k) { const int n = tid + 512 * k; const float xa = bf2f(STG[4 * HY_SEG + 8 + n]), xb = bf2f(STG[5 * HY_SEG + 8 + n]);
              const float oa = xa * (v[k].x + hb1 * va[k]), ob = xb * (v[k].y + hb1 * vb[k]);
              const unsigned pw = pk2(oa, ob);
#pragma unroll
              for (int hh = 0; hh < 2; ++hh) { u32x4& o = oacc[2 * k + hh]; const unsigned nw = hh ? (pw & 0xffff0000u) : (pw << 16);
                  o.x = __builtin_amdgcn_alignbit(o.y, o.x, 16); o.y = __builtin_amdgcn_alignbit(o.z, o.y, 16); o.z = __builtin_amdgcn_alignbit(o.w, o.z, 16); o.w = (o.w >> 16) | nw; } } }
        __syncthreads();
        if (cc < 7) {
#pragma unroll
            for (int i = 0; i < 3; ++i) { const int id = tid + 512 * i, sg = id >> 8, ch = id & 255; *(LAS u32x4*)(STG + sg * HY_SEG + 8 + ch * 8) = nx[i]; } }
        __syncthreads();
    }
    int tw_ = tid0; asm volatile("" : "+v"(tw_)); const int tid = tw_;
#pragma unroll
    for (int k = 0; k < 4; ++k)
#pragma unroll
        for (int hh = 0; hh < 2; ++hh) *(u32x4*)(MIX + (size_t)((ba + hh) * SEQ + tid + 512 * k) * MIXW + cgp * 8) = oacc[2 * k + hh];
}

constexpr int ATT_KP = 272, ATT_VP = 144, ATT_KB = 64 * ATT_KP, ATT_VB = 128 * ATT_VP, ATT_VOFF = 2 * ATT_KB;
__device__ __forceinline__ float half_swap_max(float v) { const auto r_ = __builtin_amdgcn_permlane32_swap(__float_as_uint(v), __float_as_uint(v), false, false); return fmaxf(__uint_as_float(r_[0]), __uint_as_float(r_[1])); }
__device__ __forceinline__ float half_swap_sum(float v) { const auto r_ = __builtin_amdgcn_permlane32_swap(__float_as_uint(v), __float_as_uint(v), false, false); return __uint_as_float(r_[0]) + __uint_as_float(r_[1]); }
__device__ __forceinline__ void att_vput(LAS unsigned char* p, u32x4 q) { u32x2 lo, hi; lo.x = q.x; lo.y = q.y; hi.x = q.z; hi.y = q.w; *(LAS u32x2*)p = lo; *(LAS u32x2*)(p + 16) = hi; }
template <int NC> __device__ __forceinline__ void attn_unit(LAS unsigned char* lds, const bf16_t* Qp, int ldq, const bf16_t* Kp, int ldk, const bf16_t* Vt, int ldv, int nkeys, float sl2,
                                                            bf16_t* Op, int ldo, float lam, const float* subg, int tid) {
    constexpr int NSTEP = (NC == 2) ? 4 : 8;
    const int lane = tid & 63, wave = tid >> 6, r = lane & 31, h = lane >> 5;
    const int qb = (NC == 2) ? (wave & 3) : wave, comp = (NC == 2) ? (wave >> 2) : 0, dbase = comp * 64;
    bf16x8 qf[NSTEP];
#pragma unroll
    for (int st = 0; st < NSTEP; ++st) qf[st] = *(const bf16x8*)(Qp + (size_t)(qb * 32 + r) * ldq + dbase + 16 * st + 8 * h);
    f32x16 o[4];
#pragma unroll
    for (int et = 0; et < 4; ++et)
#pragma unroll
        for (int i = 0; i < 16; ++i) o[et][i] = 0.f;
    float mold = -INFINITY, lsum = 0.f;
    const int kr0 = tid >> 4, kc = tid & 15, vr0 = tid >> 3, vc = tid & 7;
    const bf16_t* kg = Kp + (size_t)kr0 * ldk + kc * 8; const bf16_t* vg = Vt + (size_t)vr0 * ldv + vc * 8;
    const int kl = kr0 * ATT_KP + kc * 16, vl = ATT_VOFF + vr0 * ATT_VP + (vc >> 1) * 32 + (vc & 1) * 8;
    const int nt = nkeys / 64;
    u32x4 pk0, pk1, pv0, pv1;
    pk0 = *(const u32x4*)(kg); pk1 = *(const u32x4*)(kg + (size_t)32 * ldk); pv0 = *(const u32x4*)(vg); pv1 = *(const u32x4*)(vg + (size_t)64 * ldv);
    *(LAS u32x4*)(lds + kl) = pk0; *(LAS u32x4*)(lds + kl + 32 * ATT_KP) = pk1; att_vput(lds + vl, pv0); att_vput(lds + vl + 64 * ATT_VP, pv1);
    __syncthreads();
    for (int it = 0; it < nt; ++it) {
        const int cur = it & 1; const bool more = (it + 1 < nt);
        if (more) { const bf16_t* kg2 = kg + (size_t)(it + 1) * 64 * ldk; const bf16_t* vg2 = vg + (it + 1) * 64;
            pk0 = *(const u32x4*)(kg2); pk1 = *(const u32x4*)(kg2 + (size_t)32 * ldk); pv0 = *(const u32x4*)(vg2); pv1 = *(const u32x4*)(vg2 + (size_t)64 * ldv); }
        LAS unsigned char* Kb = lds + cur * ATT_KB; LAS unsigned char* Vb = lds + ATT_VOFF + cur * ATT_VB;
        f32x16 s[2];
#pragma unroll
        for (int kb = 0; kb < 2; ++kb) {
#pragma unroll
            for (int i = 0; i < 16; ++i) s[kb][i] = 0.f;
#pragma unroll
            for (int st = 0; st < NSTEP; ++st) { const bf16x8 a = *(const LAS bf16x8*)(Kb + (kb * 32 + r) * ATT_KP + (dbase + 16 * st + 8 * h) * 2);
                s[kb] = __builtin_amdgcn_mfma_f32_32x32x16_bf16(a, qf[st], s[kb], 0, 0, 0); } }
        float mx = s[0][0];
#pragma unroll
        for (int i = 1; i < 16; ++i) mx = fmaxf(mx, s[0][i]);
#pragma unroll
        for (int i = 0; i < 16; ++i) mx = fmaxf(mx, s[1][i]);
        mx = half_swap_max(mx);
        const float mnew = fmaxf(mold, mx * sl2), alpha = __builtin_amdgcn_exp2f(mold - mnew); mold = mnew;
        float ps = 0.f;
#pragma unroll
        for (int kb = 0; kb < 2; ++kb)
#pragma unroll
            for (int i = 0; i < 16; ++i) { const float p = __builtin_amdgcn_exp2f(__builtin_fmaf(s[kb][i], sl2, -mnew)); s[kb][i] = p; ps += p; }
        lsum = lsum * alpha + ps;
#pragma unroll
        for (int et = 0; et < 4; ++et)
#pragma unroll
            for (int i = 0; i < 16; ++i) o[et][i] *= alpha;
#pragma unroll
        for (int kb = 0; kb < 2; ++kb)
#pragma unroll
            for (int s2 = 0; s2 < 2; ++s2) {
                u32x4 pw; pw.x = pk2(s[kb][8 * s2 + 0], s[kb][8 * s2 + 1]); pw.y = pk2(s[kb][8 * s2 + 2], s[kb][8 * s2 + 3]); pw.z = pk2(s[kb][8 * s2 + 4], s[kb][8 * s2 + 5]); pw.w = pk2(s[kb][8 * s2 + 6], s[kb][8 * s2 + 7]);
                const bf16x8 pf = __builtin_bit_cast(bf16x8, pw);
#pragma unroll
                for (int et = 0; et < 4; ++et) { const u32x4 aw = *(const LAS u32x4*)(Vb + (et * 32 + r) * ATT_VP + (kb * 2 + s2) * 32 + h * 16);
                    o[et] = __builtin_amdgcn_mfma_f32_32x32x16_bf16(__builtin_bit_cast(bf16x8, aw), pf, o[et], 0, 0, 0); } }
        if (more) { const int nb = cur ^ 1;
            *(LAS u32x4*)(lds + nb * ATT_KB + kl) = pk0; *(LAS u32x4*)(lds + nb * ATT_KB + kl + 32 * ATT_KP) = pk1;
            att_vput(lds + nb * ATT_VB + vl, pv0); att_vput(lds + nb * ATT_VB + vl + 64 * ATT_VP, pv1); }
        __syncthreads();
    }
    lsum = half_swap_sum(lsum);
    const float inv = 1.0f / lsum;
    if (NC == 1) {
        bf16_t* orow = Op + (size_t)(qb * 32 + r) * ldo;
#pragma unroll
        for (int et = 0; et < 4; ++et)
#pragma unroll
            for (int g = 0; g < 4; ++g) { u32x2 w; w.x = pk2(o[et][4 * g] * inv, o[et][4 * g + 1] * inv); w.y = pk2(o[et][4 * g + 2] * inv, o[et][4 * g + 3] * inv);
                *(u32x2*)(orow + et * 32 + 8 * g + 4 * h) = w; }
    } else {
        LAS float* XL = (LAS float*)lds;
        if (comp == 1) {
#pragma unroll
            for (int et = 0; et < 4; ++et)
#pragma unroll
                for (int g = 0; g < 4; ++g) { f32x4 t; t[0] = o[et][4 * g] * inv; t[1] = o[et][4 * g + 1] * inv; t[2] = o[et][4 * g + 2] * inv; t[3] = o[et][4 * g + 3] * inv;
                    *(LAS f32x4*)(XL + ((qb * 16 + et * 4 + g) * 64 + lane) * 4) = t; }
        }
        __syncthreads();
        if (comp == 0) {
            float ss = 0.f;
#pragma unroll
            for (int et = 0; et < 4; ++et)
#pragma unroll
                for (int g = 0; g < 4; ++g) { const f32x4 t = *(const LAS f32x4*)(XL + ((qb * 16 + et * 4 + g) * 64 + lane) * 4);
#pragma unroll
                    for (int i2 = 0; i2 < 4; ++i2) { const float ov = o[et][4 * g + i2] * inv - lam * t[i2]; o[et][4 * g + i2] = ov; ss += ov * ov; } }
            ss = half_swap_sum(ss);
            const float rs = rsqrtf(ss * (1.0f / 128.0f) + RMS_EPS) * 0.8f;
            bf16_t* orow = Op + (size_t)(qb * 32 + r) * ldo;
#pragma unroll
            for (int et = 0; et < 4; ++et)
#pragma unroll
                for (int g = 0; g < 4; ++g) { const int e = et * 32 + 8 * g + 4 * h; const f32x4 gv = *(const f32x4*)(subg + e);
                    u32x2 w; w.x = pk2(o[et][4 * g] * rs * gv[0], o[et][4 * g + 1] * rs * gv[1]); w.y = pk2(o[et][4 * g + 2] * rs * gv[2], o[et][4 * g + 3] * rs * gv[3]);
                    *(u32x2*)(orow + e) = w; }
        }
        __syncthreads();
    }
}

template <bool TO_BF16> __device__ __forceinline__ void ln_rows(float* io, bf16_t* ob, float2* stat, const float* g, const float* b, int tid, float* alt = nullptr) {
    const int lane = tid & 63, gw = blockIdx.x * NWAVE + (tid >> 6), ngw = gridDim.x * NWAVE;
    f32x4 gv[4], bv[4];
#pragma unroll
    for (int j = 0; j < 4; ++j) { gv[j] = ((const f32x4*)g)[lane + 64 * j]; bv[j] = ((const f32x4*)b)[lane + 64 * j]; }
    for (int row0 = gw; row0 < NT; row0 += 2 * ngw) {
        f32x4 v[2][4];
#pragma unroll
        for (int u = 0; u < 2; ++u) { const int row = row0 + u * ngw; if (row < NT) { const f32x4* xr = (const f32x4*)(io + (size_t)row * DM) + lane;
#pragma unroll
            for (int j = 0; j < 4; ++j) v[u][j] = xr[64 * j]; } }
#pragma unroll
        for (int u = 0; u < 2; ++u) { const int row = row0 + u * ngw; if (row >= NT) continue;
            float s = 0.f;
#pragma unroll
            for (int j = 0; j < 4; ++j) s += (v[u][j][0] + v[u][j][1]) + (v[u][j][2] + v[u][j][3]);
            s = wave_allsum(s, lane);
            const float mean = s * (1.0f / DM); float s2 = 0.f;
#pragma unroll
            for (int j = 0; j < 4; ++j) { v[u][j] = v[u][j] - mean; s2 += (v[u][j][0] * v[u][j][0] + v[u][j][1] * v[u][j][1]) + (v[u][j][2] * v[u][j][2] + v[u][j][3] * v[u][j][3]); }
            s2 = wave_allsum(s2, lane);
            const float rstd = rsqrtf(s2 * (1.0f / DM) + LN_EPS);
            if (TO_BF16) {
                u32x2* o8 = (u32x2*)(ob + (size_t)row * DM) + lane;
#pragma unroll
                for (int j = 0; j < 4; ++j) { const f32x4 y = v[u][j] * rstd * gv[j] + bv[j]; u32x2 w; w.x = pk2(y[0], y[1]); w.y = pk2(y[2], y[3]); o8[64 * j] = w; }
                if (lane == 0) { float2 st; st.x = mean; st.y = rstd; stat[row] = st; }
            } else {
                f32x4* wr_ = (alt ? (f32x4*)(alt + (size_t)row * DM) : (f32x4*)(io + (size_t)row * DM)) + lane;
#pragma unroll
                for (int j = 0; j < 4; ++j) wr_[64 * j] = v[u][j] * rstd * gv[j] + bv[j];
            }
        }
    }
}

__device__ __forceinline__ void convgate_half(const bf16_t* HH, bf16_t* ACT, const float* cw, const float* cb, int half, int tid) {
    constexpr int NG = DFF / 8; const int total = (NT / 2) * NG;
    for (int idx = blockIdx.x * NTHR + tid; idx < total; idx += gridDim.x * NTHR) {
        const int rl = idx / NG, cg8 = idx - rl * NG, n0 = cg8 * 8, t = rl & (SEQ - 1);
        const bf16_t* hp = HH + (size_t)rl * (2 * DFF);
        float gsum[8], usum[8];
#pragma unroll
        for (int e = 0; e < 8; ++e) { gsum[e] = cb[n0 + e]; usum[e] = cb[DFF + n0 + e]; }
#pragma unroll
        for (int j = 0; j < 3; ++j) { const int tt = t + j - 1; if (tt < 0 || tt >= SEQ) continue;
            const u32x4 gq = *(const u32x4*)(hp + (ptrdiff_t)(j - 1) * (2 * DFF) + n0), uq = *(const u32x4*)(hp + (ptrdiff_t)(j - 1) * (2 * DFF) + DFF + n0);
            const float* wg = cw + (size_t)j * (2 * DFF) + n0; const float* wu = wg + DFF;
            const f32x4 wg0 = *(const f32x4*)wg, wg1 = *(const f32x4*)(wg + 4), wu0 = *(const f32x4*)wu, wu1 = *(const f32x4*)(wu + 4);
            gsum[0] += wg0[0] * lo2f(gq.x); gsum[1] += wg0[1] * hi2f(gq.x); gsum[2] += wg0[2] * lo2f(gq.y); gsum[3] += wg0[3] * hi2f(gq.y);
            gsum[4] += wg1[0] * lo2f(gq.z); gsum[5] += wg1[1] * hi2f(gq.z); gsum[6] += wg1[2] * lo2f(gq.w); gsum[7] += wg1[3] * hi2f(gq.w);
            usum[0] += wu0[0] * lo2f(uq.x); usum[1] += wu0[1] * hi2f(uq.x); usum[2] += wu0[2] * lo2f(uq.y); usum[3] += wu0[3] * hi2f(uq.y);
            usum[4] += wu1[0] * lo2f(uq.z); usum[5] += wu1[1] * hi2f(uq.z); usum[6] += wu1[2] * lo2f(uq.w); usum[7] += wu1[3] * hi2f(uq.w); }
        float a[8];
#pragma unroll
        for (int e = 0; e < 8; ++e) a[e] = gsum[e] / (1.0f + __expf(-gsum[e])) * usum[e];
        u32x4 w; w.x = pk2(a[0], a[1]); w.y = pk2(a[2], a[3]); w.z = pk2(a[4], a[5]); w.w = pk2(a[6], a[7]);
        *(u32x4*)(ACT + (size_t)(half * (NT / 2) + rl) * DFF + n0) = w;
    }
}

#define XB_TMO      128
#define XB_XCNT(j)  (256  + 64 * (j))
#define XB_XSUB(j)  (1280 + 64 * (j))
#define XB_XGEN(j)  (2304 + 64 * (j))
#define XB_TOP      3328
#define XB_TOPGEN   3392
#define XCD_BAR_WORDS 3456
#define XB_SPIN_CAP (1u << 18)

__device__ __forceinline__ unsigned xb_ld(unsigned* p)              { return __hip_atomic_load(p, __ATOMIC_RELAXED, __HIP_MEMORY_SCOPE_AGENT); }
__device__ __forceinline__ unsigned xb_add(unsigned* p, unsigned v) { return __hip_atomic_fetch_add(p, v, __ATOMIC_RELAXED, __HIP_MEMORY_SCOPE_AGENT); }
__device__ __forceinline__ unsigned xb_xcc_id() { return (unsigned)__builtin_amdgcn_s_getreg((3 << 11) | 20) & 0xFu; }
#define XB_SPIN(cond, bar) do { unsigned _sp = 0; while (cond) { __builtin_amdgcn_s_sleep(1); \
    if ((++_sp & 255u) == 0u) { if (xb_ld(&(bar)[XB_TMO])) break; if (_sp > XB_SPIN_CAP) { atomicAdd(&(bar)[XB_TMO], 1u); break; } } } } while (0)

struct XcdBarrier {
    unsigned* bar; unsigned x;
    volatile LAS unsigned* st;
};

__device__ __forceinline__ XcdBarrier xcd_barrier_post(unsigned* bar, volatile LAS unsigned* st) {
    XcdBarrier b; b.bar = bar; b.x = xb_xcc_id(); b.st = st;
    if (threadIdx.x == 0) (void)xb_add(&bar[XB_XCNT(b.x)], 1u);
    return b;
}
__device__ __forceinline__ void xcd_barrier_complete(unsigned* bar, unsigned x, unsigned& nloc, unsigned& nx) {
    const unsigned G = gridDim.x * gridDim.y * gridDim.z;
    unsigned sum, cnt, mine, sp = 0u;
    for (;;) {
        sum = 0u; cnt = 0u; mine = 0u;
#pragma unroll
        for (unsigned j = 0; j < 16; ++j) { const unsigned c = xb_ld(&bar[XB_XCNT(j)]); sum += c; cnt += (c > 0u) ? 1u : 0u; mine = (j == x) ? c : mine; }
        if (sum == G) break;
        __builtin_amdgcn_s_sleep(1);
        if ((++sp & 255u) == 0u) { if (xb_ld(&bar[XB_TMO])) break; if (sp > XB_SPIN_CAP) { atomicAdd(&bar[XB_TMO], 1u); break; } }
    }
    nloc = mine > 0u ? mine : 1u; nx = cnt > 0u ? cnt : 1u;
}

__device__ __forceinline__ void xcd_barrier(const XcdBarrier& b) {
    asm volatile("s_waitcnt vmcnt(0)" ::: "memory");
    __syncthreads();
    if (threadIdx.x == 0) {
        unsigned* bar = b.bar;
        __builtin_amdgcn_s_waitcnt(0);
        unsigned nloc = b.st[0], nx = b.st[1];
        if (nloc == 0u) { xcd_barrier_complete(bar, b.x, nloc, nx); b.st[0] = nloc; b.st[1] = nx; }
        const unsigned old = xb_add(&bar[XB_XSUB(b.x)], 1u);
        const unsigned gen = old / nloc;
        if (old + 1u == (gen + 1u) * nloc) {
            __builtin_amdgcn_fence(__ATOMIC_RELEASE, "agent");
            asm volatile("s_waitcnt vmcnt(0)" ::: "memory");
            const unsigned og = xb_add(&bar[XB_TOP], 1u);
            const unsigned tg = og / nx;
            if (og + 1u == (tg + 1u) * nx) xb_add(&bar[XB_TOPGEN], 1u);
            else XB_SPIN(xb_ld(&bar[XB_TOPGEN]) == tg, bar);
            __builtin_amdgcn_fence(__ATOMIC_ACQUIRE, "agent");
            xb_add(&bar[XB_XGEN(b.x)], 1u);
            asm volatile("s_waitcnt vmcnt(0)" ::: "memory");
        } else {
            XB_SPIN(xb_ld(&bar[XB_XGEN(b.x)]) == gen, bar);
            __builtin_amdgcn_fence(__ATOMIC_ACQUIRE, "agent");
            asm volatile("s_waitcnt vmcnt(0)" ::: "memory");
        }
    }
    __syncthreads();
}

template <int MODE> __device__ __forceinline__ void panel_finish(LAS unsigned char* lds, float* io, bf16_t* x1b, float2* stat, const float* g, const float* b, unsigned long long* XG, unsigned* CNT, int cu, int tid) {
    const int v = PairOrder::vcu_of(cu), q = v >> 2, j = v & 3, lane = tid & 63, wave = tid >> 6;
    LAS cplx* ST = (LAS cplx*)(lds + XCH_OFF); LAS cplx* MR = (LAS cplx*)lds;
    asm volatile("s_waitcnt lgkmcnt(0)" ::: "memory"); __syncthreads();
    const int ui = tid >> 8, rowl = tid & 255;
    float m1, m2;
    { const cplx a0 = ST[tid * 4 + 0], a1 = ST[tid * 4 + 1], a2 = ST[tid * 4 + 2], a3 = ST[tid * 4 + 3];
      m1 = (a0.x + a1.x) + (a2.x + a3.x); m2 = (a0.y + a1.y) + (a2.y + a3.y);
      __hip_atomic_store(XG + (size_t)((2 * q + ui) * 4 + j) * 256 + rowl, ((unsigned long long)__float_as_uint(m2) << 32) | __float_as_uint(m1), __ATOMIC_RELAXED, __HIP_MEMORY_SCOPE_AGENT); }
    asm volatile("s_waitcnt vmcnt(0)" ::: "memory");
    __syncthreads();
    if (tid == 0) {
        (void)__hip_atomic_fetch_add(CNT + (2 * q) * 16, 1u, __ATOMIC_RELAXED, __HIP_MEMORY_SCOPE_AGENT);
        (void)__hip_atomic_fetch_add(CNT + (2 * q + 1) * 16, 1u, __ATOMIC_RELAXED, __HIP_MEMORY_SCOPE_AGENT);
        unsigned sp = 0;
        while (__hip_atomic_load(CNT + (2 * q) * 16, __ATOMIC_RELAXED, __HIP_MEMORY_SCOPE_AGENT) < 4u || __hip_atomic_load(CNT + (2 * q + 1) * 16, __ATOMIC_RELAXED, __HIP_MEMORY_SCOPE_AGENT) < 4u) {
            __builtin_amdgcn_s_sleep(1); if (++sp > (1u << 22)) break; }
        __builtin_amdgcn_fence(__ATOMIC_ACQUIRE, "agent");
        asm volatile("s_waitcnt vmcnt(0)" ::: "memory");
    }
    __syncthreads();
    { float t1 = m1, t2 = m2;
#pragma unroll
      for (int jj = 1; jj < 4; ++jj) { const unsigned long long w = __hip_atomic_load(XG + (size_t)((2 * q + ui) * 4 + ((j + jj) & 3)) * 256 + rowl, __ATOMIC_RELAXED, __HIP_MEMORY_SCOPE_AGENT);
          t1 += __uint_as_float((unsigned)w); t2 += __uint_as_float((unsigned)(w >> 32)); }
      const float mean = t1 * (1.0f / DM), var = fmaxf(t2 * (1.0f / DM) - mean * mean, 0.f), rstd = rsqrtf(var + LN_EPS);
      cplx mr; mr.x = mean; mr.y = rstd; MR[tid] = mr;
      if (MODE == 1 && j == 0) { float2 sv; sv.x = mean; sv.y = rstd; stat[(2 * q + ui) * 256 + rowl] = sv; } }
    __syncthreads();
    const int cbase = j * 256 + lane * 4;
    const f32x4 g0 = *(const f32x4*)(g + cbase), b0 = *(const f32x4*)(b + cbase);
#pragma unroll 1
    for (int it = 0; it < 8; ++it) {
        const int u2 = it >> 2, rb = (it & 3) * 8; const size_t rbase = (size_t)((2 * q + u2) * 256 + wave * 32 + rb);
        f32x4 x0[8];
#pragma unroll
        for (int i = 0; i < 8; ++i) x0[i] = *(const f32x4*)(io + (rbase + i) * DM + cbase);
        asm volatile("" ::: "memory");
#pragma unroll
        for (int i = 0; i < 8; ++i) { const cplx mr = MR[u2 * 256 + wave * 32 + rb + i];
            const f32x4 y0 = (x0[i] - mr.x) * mr.y * g0 + b0;
            if (MODE == 1) { u32x2 w0; w0.x = pk2(y0[0], y0[1]); w0.y = pk2(y0[2], y0[3]); *(u32x2*)(x1b + (rbase + i) * DM + cbase) = w0; }
            else *(f32x4*)(io + (rbase + i) * DM + cbase) = y0; }
    }
}

#ifndef PH_MASK
#define PH_MASK 0xFFFFFF
#endif
#define PH(k) ((PH_MASK >> (k)) & 1)
#ifndef G3_RB
#define G3_RB false
#endif
#ifndef G5ORDER
#define G5ORDER KbOrder
#endif
#ifndef REP_P0
#define REP_P0 1
#endif
#ifndef REP_G1
#define REP_G1 1
#endif
#ifndef REP_DIFF
#define REP_DIFF 1
#endif
#ifndef REP_HY
#define REP_HY 1
#endif
#ifndef REP_MEM
#define REP_MEM 1
#endif
#ifndef REP_G3
#define REP_G3 1
#endif
#ifndef REP_G4
#define REP_G4 1
#endif
#ifndef REP_LN1
#define REP_LN1 1
#endif
struct Args { const float* in[24]; float* out; unsigned char* ws; };
__global__ void __launch_bounds__(NTHR, 2) hybrid_fwd(Args a) {
    extern __shared__ __attribute__((aligned(16))) unsigned char smem[];
    LAS unsigned char* lds = (LAS unsigned char*)smem;
    cg::grid_group grid = cg::this_grid();
    volatile LAS unsigned* bst = (volatile LAS unsigned*)(lds + LDS_BYTES - 64);
    if (threadIdx.x < 2) bst[threadIdx.x] = 0u;
    __syncthreads();
#ifdef PROBE_AT
    const unsigned long long t_start = __builtin_amdgcn_s_memrealtime();
#define PROBE(k) do { if ((k) == PROBE_AT) { const unsigned long long t_now = __builtin_amdgcn_s_memrealtime(), dt_ = t_now - t_start; while (__builtin_amdgcn_s_memrealtime() - t_now < dt_) __builtin_amdgcn_s_sleep(8); __syncthreads(); } } while (0)
#else
    const unsigned long long t_start = 0;
#define PROBE(k) do {} while (0)
#endif
    const XcdBarrier bar = xcd_barrier_post((unsigned*)(a.ws + WS_BAR), bst);
    const int G = gridDim.x;
#define NEWPHASE() int tid_ = threadIdx.x, cu_ = blockIdx.x; asm volatile("" : "+v"(tid_)); asm volatile("" : "+s"(cu_)); const int tid = tid_, cu = cu_; (void)tid; (void)cu;
    unsigned char* ws = a.ws;
    bf16_t* WALL = (bf16_t*)(ws + WS_WALL); bf16_t* XB = (bf16_t*)(ws + WS_XB); bf16_t* MEMB = (bf16_t*)(ws + WS_MEMB); bf16_t* WKV = (bf16_t*)(ws + WS_WKV);
    bf16_t* QKM = (bf16_t*)(ws + WS_QKM); bf16_t* HT = (bf16_t*)(ws + WS_HT); bf16_t* KMEM = (bf16_t*)(ws + WS_KMEM); bf16_t* VMT = (bf16_t*)(ws + WS_VMT);
    float2* KF = (float2*)(ws + WS_KF); bf16_t* MIX = (bf16_t*)(ws + WS_MIX); float2* STAT = (float2*)(ws + WS_STAT);
    bf16_t* X1B = (bf16_t*)(ws + WS_X1B); bf16_t* HH = (bf16_t*)(ws + WS_HH); bf16_t* ACT = (bf16_t*)(ws + WS_ACT);

    for (int rep = 0; rep < REP_P0; ++rep) { NEWPHASE(); if (PH(0)) p0_prep(a.in, ws, lds, tid, t_start); }
    if (a.ws == nullptr) grid.sync();
    xcd_barrier(bar);

    for (int rep = 0; rep < REP_G1; ++rep) if (PH(1)) { NEWPHASE(); pg8::Gemm g{(const bf16_t*)ws, (const bf16_t*)ws, 0, 0, DM}; P1Order S; S.init(G, cu);
      EpiP1 E{EpiRope{QKM, (const float2*)(ws + WS_ROPE)}, EpiB{HT, NT}, EpiB{KMEM, 512}, EpiB{VMT, NMT}};
      pg8::gemm_phase<EpiP1, P1Order, false, true>(lds, g, S, E); }
    if (PH(3)) { NEWPHASE(); __syncthreads();
      if (cu >= 64) for (int it = cu - 64; it < 1024; it += G - 64) filter_fft_item((const float*)(ws + WS_HTD), KF, lds, it, tid); }
    xcd_barrier(bar);

    { NEWPHASE(); const int xcd = cu & 7, j = cu >> 3;
      float lam;
      { const float* lp = a.in[12]; const int l6 = tid & 63; float s01 = lp[l6] * lp[64 + l6], s23 = lp[128 + l6] * lp[192 + l6];
        s01 = wave_allsum(s01, l6); s23 = wave_allsum(s23, l6);
        lam = expf(s01) - expf(s23) + 0.2f; }
      if (PH(6)) for (int i = 0; i < 2 * REP_HY; ++i) {
          const int cgp = ((i & 1) * 8 + xcd) * 4 + (j >> 3), bp = j & 7;
          hyena_item(HT, KF, a.in[3], a.in[4], a.in[11], MIX, lds, bp, cgp, tid); }
      if (PH(4)) for (int i = 0; i < 4 * REP_DIFF; ++i) {
          const int bh = ((i & 3) * 8 + xcd) * 2 + (j >> 4), qblk = j & 15, b = bh >> 2, hd = bh & 3;
          const size_t tok0 = (size_t)b * SEQ;
          attn_unit<2>(lds, QKM + (tok0 + qblk * 128) * MIXW + hd * 128, MIXW, QKM + tok0 * MIXW + 512 + hd * 128, MIXW,
                       HT + (size_t)(1536 + hd * 128) * NT + tok0, NT, SEQ, 0.125f * 1.4426950408889634f,
                       MIX + (tok0 + qblk * 128) * MIXW + 512 + hd * 128, MIXW, lam, a.in[13], tid); }
      if (PH(5)) for (int i = 0; i < 2 * REP_MEM; ++i) {
          const int bh = ((i & 1) * 8 + xcd) * 4 + (j >> 3), qblk = j & 7, b = bh >> 2, hd = bh & 3;
          const size_t tok0 = (size_t)b * SEQ;
          attn_unit<1>(lds, QKM + (tok0 + qblk * 256) * MIXW + 1024 + hd * 128, MIXW, KMEM + (size_t)b * MEMT * 512 + hd * 128, 512,
                       VMT + (size_t)(hd * 128) * NMT + b * MEMT, NMT, MEMT, 0.08838834764831845f * 1.4426950408889634f,
                       MIX + (tok0 + qblk * 256) * MIXW + 1024 + hd * 128, MIXW, 0.f, nullptr, tid); } }
    xcd_barrier(bar);

#ifdef REP_SYNC
    for (int rep = 0; rep < REP_SYNC; ++rep) xcd_barrier(bar);
#endif
    const bool pair = (G == 256);
    if (pair) {
        if (PH(7)) { NEWPHASE(); const int v = PairOrder::vcu_of(cu);
            pg8::Gemm g{MIX, (const bf16_t*)(ws + WS_WOUT), NT, DM, MIXW}; QuadTwo S{v >> 2, v & 3};
            EpiLn<1, G3_RB> E{a.in[0], XB, nullptr, X1B, a.in[16], a.in[17], (unsigned long long*)(ws + WS_XG), (unsigned*)(ws + WS_CNT), lds};
            pg8::gemm_phase<EpiLn<1, G3_RB>, QuadTwo, true, true>(lds, g, S, E); }
        xcd_barrier(bar);
    } else {
        { NEWPHASE(); pg8::Gemm g{MIX, (const bf16_t*)(ws + WS_WOUT), NT, DM, MIXW}; pg8::StaticOrder S; S.init(g.M, g.N, G, cu);
          EpiRes E{a.in[0], a.out, lds, 0};
          pg8::gemm_phase<EpiRes, pg8::StaticOrder, true, true>(lds, g, S, E); }
        xcd_barrier(bar);
        { NEWPHASE(); ln_rows<true>(a.out, X1B, STAT, a.in[16], a.in[17], tid); }
        xcd_barrier(bar);
    }
    for (int rep = 0; rep < REP_G4; ++rep) if (PH(9)) { NEWPHASE(); pg8::Gemm g{X1B, (const bf16_t*)(ws + WS_WUP), FFN_MT * 256, 2 * DFF, DM}; FfnOrder S; S.init(g.M, g.N, G, cu); S.cw = a.in[19]; S.cb = a.in[20]; S.lds = lds; S.cnt = 0;
      EpiFfn E{ACT, lds, 0};
      pg8::gemm_phase<EpiFfn, FfnOrder, true, true>(lds, g, S, E); }
    xcd_barrier(bar);
    if (pair) {
        if (PH(11)) { NEWPHASE(); const int v = PairOrder::vcu_of(cu);
            pg8::Gemm g{ACT, (const bf16_t*)(ws + WS_WDN), NT, DM, DFF}; QuadTwoKb S; S.q = v >> 2; S.j = v & 3;
            EpiLn<2, true> E{nullptr, X1B, a.out, nullptr, a.in[22], a.in[23], (unsigned long long*)(ws + WS_XG) + 128 * 4 * 256, (unsigned*)(ws + WS_CNT) + 128 * 16, lds};
            pg8::gemm_phase<EpiLn<2, true>, QuadTwoKb, true, true>(lds, g, S, E); }
    } else {
        { NEWPHASE(); pg8::Gemm g{ACT, (const bf16_t*)(ws + WS_WDN), NT, DM, DFF}; KbOrder S; S.init(g.M, g.N, G, cu);
          EpiRes2 E{a.out, a.out, STAT, a.in[16], a.in[17], lds, 0};
          pg8::gemm_phase<EpiRes2, KbOrder, true, true>(lds, g, S, E); }
        xcd_barrier(bar);
        { NEWPHASE(); ln_rows<false>(a.out, nullptr, nullptr, a.in[22], a.in[23], tid); }
    }
}

extern "C" void kernel_launch(void* const* d_in, const int* in_sizes, int n_in, void* d_out, int out_size, void* d_ws, size_t ws_size, hipStream_t stream) {
    static int grid = 0;
    if (grid == 0) {
        if (n_in != 24 || out_size != NT * DM || ws_size < WS_END) { fprintf(stderr, "kernel_launch: unexpected shapes (n_in %d, out %d, ws %zu)\n", n_in, out_size, ws_size); grid = -1; return; }
        int dev = 0, cus = 0, per_cu = 0;
        hipGetDevice(&dev); hipDeviceGetAttribute(&cus, hipDeviceAttributeMultiprocessorCount, dev);
        if (hipFuncSetAttribute((const void*)hybrid_fwd, hipFuncAttributeMaxDynamicSharedMemorySize, LDS_BYTES) != hipSuccess) { fprintf(stderr, "kernel_launch: hipFuncSetAttribute failed\n"); grid = -1; return; }
        if (hipOccupancyMaxActiveBlocksPerMultiprocessor(&per_cu, (const void*)hybrid_fwd, NTHR, LDS_BYTES) != hipSuccess || per_cu < 1) { fprintf(stderr, "kernel_launch: occupancy query says %d\n", per_cu); per_cu = 1; }
        (void)hipGetLastError();
        grid = cus * per_cu;
        fprintf(stderr, "kernel_launch: grid %d (cus %d x %d)\n", grid, cus, per_cu);
    }
    if (grid < 0) return;
    if (hipMemsetAsync((char*)d_ws + WS_BAR, 0, 32768, stream) != hipSuccess) { fprintf(stderr, "kernel_launch: memset failed\n"); return; }
    Args a{};
    for (int i = 0; i < 24; ++i) a.in[i] = (const float*)d_in[i];
    a.out = (float*)d_out; a.ws = (unsigned char*)d_ws;
    void* args[] = {&a};
    const hipError_t e = hipLaunchCooperativeKernel((const void*)hybrid_fwd, dim3(grid), dim3(NTHR), args, LDS_BYTES, stream);
    if (e != hipSuccess) fprintf(stderr, "kernel_launch: cooperative launch failed: %s (grid %d)\n", hipGetErrorString(e), grid);
}
```

```cpp
#include <hip/hip_runtime.h>
#include <hip/hip_cooperative_groups.h>
#include <cstdio>
#include <cstdint>
namespace cg = cooperative_groups;
#define LAS __attribute__((address_space(3)))
namespace pg8 {
#define PG8_LAS __attribute__((address_space(3)))
typedef unsigned short bf16_t;
typedef short bf16x8 __attribute__((ext_vector_type(8)));
typedef float f32x4 __attribute__((ext_vector_type(4)));
typedef unsigned u32x4 __attribute__((ext_vector_type(4)));
constexpr int BM = 256, BK = 64, HALF = 128, HTB = HALF * BK * 2  , STAGE_BYTES = 8 * HTB, NXCD = 8, WGM = 8;

__host__ __device__ __forceinline__ int lds_byte(int r, int c) { const int st = (r >> 4) * 2 + (c >> 5), rr = r & 15, cc = c & 31, ob = rr * 64 + cc * 2; return st * 1024 + (ob ^ (((ob >> 9) & 1) << 5)); }
__host__ __device__ __forceinline__ void stage_rc(int b, int& R, int& C) { const int st = b / 1024, sb = b % 1024, swz = sb ^ (((sb >> 9) & 1) << 5); R = (st >> 1) * 16 + swz / 64; C = (st & 1) * 32 + (swz % 64) / 2; }
__host__ __device__ __forceinline__ int perm32(int rho) { const int n = rho >> 4, i = rho & 15; return 8 * (i >> 2) + 4 * n + (i & 3); }

struct Unit { int pm, pn; };
struct Gemm { const bf16_t* A; const bf16_t* Bt; int M, N, K; };

struct StaticOrder {
    int nM, nN, nwg, G, c;
    __host__ __device__ void init(int M, int N, int G_, int c_) { nM = M / BM; nN = N / BM; nwg = nM * nN; G = G_; c = c_; }
    __host__ __device__ bool next(int i, Unit& u) const {
        const long L = (long)i * G + c; if (L >= nwg) return false;
        int wgid = (int)L; { const int q = nwg / NXCD, r = nwg % NXCD, xcd = wgid % NXCD, off = wgid / NXCD; wgid = (xcd < r ? xcd * (q + 1) : r * (q + 1) + (xcd - r) * q) + off; }
        const int nig = WGM * nN, gid = wgid / nig, fm = gid * WGM, gsz = (nM - fm) < WGM ? (nM - fm) : WGM;
        u.pm = fm + ((wgid % nig) % gsz); u.pn = (wgid % nig) / gsz; return true;
    }
    __device__ __forceinline__ void a_ready(const Unit&) const {}
    __device__ __forceinline__ void done(const Unit&) const {}
    __device__ __forceinline__ long a_off(const Unit& u, size_t tstep) const { return (long)((size_t)u.pm * tstep); }
    __device__ __forceinline__ int lda(int K) const { return K; }
    __device__ __forceinline__ size_t kstep_a() const { return (size_t)(BK * 2); }
};
template <class Epi, class Sched, bool ALIGN_EPI = false, bool SP2 = false>
__device__ __forceinline__ void gemm_phase(PG8_LAS unsigned char* lds, const Gemm g, const Sched& S, const Epi& E) {
    int tid_l = threadIdx.x; asm volatile("" : "+v"(tid_l)); const int tid = tid_l, wid = __builtin_amdgcn_readfirstlane(tid >> 6), lane = tid & 63, wr = wid >> 2, wc = wid & 3, fr = lane & 15, fq = lane >> 4;
    const int K = g.K, nt = K / BK;
    unsigned voffA[2], voffB[2];
    const int lda = S.lda(K);
#pragma unroll
    for (int i = 0; i < 2; ++i) { int R, C; stage_rc(tid * 16 + i * 8192, R, C); const int Rb = Epi::PERM ? ((R & ~31) + perm32(R & 31)) : R;
        voffA[i] = (unsigned)(R * lda + C) * 2u; voffB[i] = (unsigned)(Rb * K + C) * 2u; }
    const size_t kstep = (size_t)(BK * 2);
    const size_t hstep = (size_t)HALF * K * 2;
    const size_t tstep = 2 * hstep;
    const size_t kstepA = S.kstep_a(), hstepA = (size_t)HALF * lda * 2, tstepA = 2 * hstepA;
    const unsigned ldsw = (unsigned)wid * 1024u;
    const int aoff = lds_byte(wr * 64 + fr, fq * 8), boff = lds_byte(wc * 32 + fr, fq * 8);
#define PG8_SA(b, h) (((b) * 2 + (h)) * HTB)
#define PG8_SB(b, h) ((4 + (b) * 2 + (h)) * HTB)
#define PG8_STAGE(bufoff, gbase, voff) do { _Pragma("unroll") for (int _i = 0; _i < 2; ++_i) \
        __builtin_amdgcn_global_load_lds((const unsigned*)((const char*)(gbase) + (voff)[_i]), (PG8_LAS unsigned*)(lds + (bufoff) + ldsw + _i * 8192), 16, 0, 0); } while (0)
#define PG8_LDA(dst, b, h) do { _Pragma("unroll") for (int m = 0; m < 4; ++m) _Pragma("unroll") for (int k = 0; k < 2; ++k) dst[m][k] = *(const PG8_LAS bf16x8*)(lds + PG8_SA(b, h) + aoff + m * 2048 + k * 1024); } while (0)
#define PG8_LDB(dst, b, h) do { _Pragma("unroll") for (int n = 0; n < 2; ++n) _Pragma("unroll") for (int k = 0; k < 2; ++k) dst[n][k] = *(const PG8_LAS bf16x8*)(lds + PG8_SB(b, h) + boff + n * 2048 + k * 1024); } while (0)
#define PG8_MMA(ai, bj, At, Bt) do { __builtin_amdgcn_s_setprio(1); _Pragma("unroll") for (int m = 0; m < 4; ++m) _Pragma("unroll") for (int n = 0; n < 2; ++n) _Pragma("unroll") for (int k = 0; k < 2; ++k) \
        acc[ai][bj][m][n] = __builtin_amdgcn_mfma_f32_16x16x32_bf16(Bt[n][k], At[m][k], acc[ai][bj][m][n], 0, 0, 0); __builtin_amdgcn_s_setprio(0); } while (0)
#define PG8_WAIT_V(n) asm volatile("s_waitcnt vmcnt(" #n ")" ::: "memory")
#define PG8_WAIT_L(n) asm volatile("s_waitcnt lgkmcnt(" #n ")" ::: "memory")
#define PG8_BAR __builtin_amdgcn_s_barrier()
#define PG8_SCHED __builtin_amdgcn_sched_barrier(0)
    Unit cur, nxt; int ui = 0;
    if (!S.next(0, cur)) return;
    f32x4 acc[2][2][4][2];
#pragma unroll
    for (int a = 0; a < 2; ++a)
#pragma unroll
        for (int b = 0; b < 2; ++b)
#pragma unroll
            for (int m = 0; m < 4; ++m)
#pragma unroll
                for (int n = 0; n < 2; ++n) acc[a][b][m][n] = (f32x4){0.f, 0.f, 0.f, 0.f};
    bf16x8 At[4][2], B0[2][2], B1[2][2];
    const char* cA = (const char*)g.A + S.a_off(cur, tstepA); const char* cB = (const char*)g.Bt + (size_t)cur.pn * tstep;
    S.a_ready(cur);
    if constexpr (SP2) {
        PG8_STAGE(PG8_SB(0, 0), cB, voffB); PG8_STAGE(PG8_SB(0, 1), cB + hstep, voffB); PG8_STAGE(PG8_SA(0, 0), cA, voffA); PG8_STAGE(PG8_SA(0, 1), cA + hstepA, voffA);
        if (wr == 1) PG8_BAR;
        PG8_WAIT_V(2); PG8_BAR;
        PG8_STAGE(PG8_SB(1, 0), cB + kstep, voffB); PG8_STAGE(PG8_SA(1, 0), cA + kstepA, voffA); PG8_STAGE(PG8_SB(1, 1), cB + hstep + kstep, voffB);
        PG8_WAIT_V(6); PG8_BAR;
    } else {
        PG8_STAGE(PG8_SB(0, 0), cB, voffB); PG8_STAGE(PG8_SA(0, 0), cA, voffA); PG8_STAGE(PG8_SB(0, 1), cB + hstep, voffB); PG8_STAGE(PG8_SA(0, 1), cA + hstepA, voffA);
        if (wr == 1) PG8_BAR;
        PG8_WAIT_V(4); PG8_BAR;
        PG8_STAGE(PG8_SB(1, 0), cB + kstep, voffB); PG8_STAGE(PG8_SA(1, 0), cA + kstepA, voffA); PG8_STAGE(PG8_SB(1, 1), cB + hstep + kstep, voffB);
        PG8_WAIT_V(6); PG8_BAR;
    }
    for (;;) {
        const bool has_next = S.next(ui + 1, nxt);
        const char* nA = has_next ? (const char*)g.A + S.a_off(nxt, tstepA) : cA; const char* nB = has_next ? (const char*)g.Bt + (size_t)nxt.pn * tstep : cB;
        for (int t = 0; t < nt; t += 2) {
            const bool last = (t == nt - 2);
            const char* a1 = cA + (size_t)(t + 1) * kstepA;
            const char* a2 = last ? nA : cA + (size_t)(t + 2) * kstepA; const char* b2 = last ? nB : cB + (size_t)(t + 2) * kstep;
            const char* a3 = a2 + kstepA; const char* b3 = b2 + kstep;
            if (last && has_next) S.a_ready(nxt);
            if constexpr (SP2) {
            PG8_LDB(B0, 0, 0); PG8_LDB(B1, 0, 1); PG8_SCHED; PG8_LDA(At, 0, 0); PG8_STAGE(PG8_SA(1, 1), a1 + hstepA, voffA);
            PG8_WAIT_V(8); PG8_WAIT_L(0); PG8_BAR; PG8_MMA(0, 0, At, B0); PG8_MMA(0, 1, At, B1); PG8_BAR; PG8_SCHED;
            PG8_LDA(At, 0, 1); PG8_STAGE(PG8_SB(0, 0), b2, voffB); PG8_STAGE(PG8_SB(0, 1), b2 + hstep, voffB); PG8_STAGE(PG8_SA(0, 0), a2, voffA);
            PG8_WAIT_V(8); PG8_WAIT_L(0); PG8_BAR; PG8_MMA(1, 0, At, B0); PG8_MMA(1, 1, At, B1); PG8_BAR; PG8_SCHED;
            PG8_LDB(B0, 1, 0); PG8_LDB(B1, 1, 1); PG8_SCHED; PG8_LDA(At, 1, 0); PG8_STAGE(PG8_SA(0, 1), a2 + hstepA, voffA);
            PG8_WAIT_V(8); PG8_WAIT_L(0); PG8_BAR; PG8_MMA(0, 0, At, B0); PG8_MMA(0, 1, At, B1); PG8_BAR; PG8_SCHED;
            PG8_LDA(At, 1, 1); PG8_STAGE(PG8_SB(1, 0), b3, voffB); PG8_STAGE(PG8_SB(1, 1), b3 + hstep, voffB); PG8_STAGE(PG8_SA(1, 0), a3, voffA);
            PG8_WAIT_V(8); PG8_WAIT_L(0); PG8_BAR; PG8_MMA(1, 0, At, B0); PG8_MMA(1, 1, At, B1); PG8_BAR; PG8_SCHED;
            } else {
            PG8_LDB(B0, 0, 0); PG8_SCHED; PG8_LDA(At, 0, 0); PG8_STAGE(PG8_SA(1, 1), a1 + hstepA, voffA);
            PG8_WAIT_L(8); PG8_BAR; PG8_WAIT_L(0); PG8_MMA(0, 0, At, B0); PG8_BAR; PG8_SCHED;
            PG8_LDB(B1, 0, 1); PG8_STAGE(PG8_SB(0, 0), b2, voffB);
            PG8_BAR; PG8_WAIT_L(0); PG8_MMA(0, 1, At, B1); PG8_BAR;
            PG8_LDA(At, 0, 1); PG8_STAGE(PG8_SA(0, 0), a2, voffA);
            PG8_BAR; PG8_WAIT_L(0); PG8_MMA(1, 0, At, B0); PG8_BAR; PG8_SCHED;
            PG8_STAGE(PG8_SB(0, 1), b2 + hstep, voffB);
            PG8_WAIT_V(6); PG8_BAR; PG8_MMA(1, 1, At, B1); PG8_BAR;
            PG8_LDB(B0, 1, 0); PG8_SCHED; PG8_LDA(At, 1, 0); PG8_STAGE(PG8_SA(0, 1), a2 + hstepA, voffA);
            PG8_WAIT_L(8); PG8_BAR; PG8_WAIT_L(0); PG8_MMA(0, 0, At, B0); PG8_BAR; PG8_SCHED;
            PG8_LDB(B1, 1, 1); PG8_STAGE(PG8_SB(1, 0), b3, voffB);
            PG8_BAR; PG8_WAIT_L(0); PG8_MMA(0, 1, At, B1); PG8_BAR;
            PG8_LDA(At, 1, 1); PG8_STAGE(PG8_SA(1, 0), a3, voffA);
            PG8_BAR; PG8_WAIT_L(0); PG8_MMA(1, 0, At, B0); PG8_BAR; PG8_SCHED;
            PG8_STAGE(PG8_SB(1, 1), b3 + hstep, voffB);
            PG8_WAIT_V(6); PG8_BAR; PG8_MMA(1, 1, At, B1); PG8_BAR;
            }
        }
        if constexpr (ALIGN_EPI) { if (wr == 0) PG8_BAR; }
        if constexpr (!Epi::AFTER_DRAIN) { E(acc, cur, wr, wc, fr, fq); S.done(cur); }
        if (!has_next) break;
#pragma unroll
        for (int a = 0; a < 2; ++a)
#pragma unroll
            for (int b = 0; b < 2; ++b)
#pragma unroll
                for (int m = 0; m < 4; ++m)
#pragma unroll
                    for (int n = 0; n < 2; ++n) acc[a][b][m][n] = (f32x4){0.f, 0.f, 0.f, 0.f};
        cur = nxt; cA = nA; cB = nB; ++ui;
        if constexpr (ALIGN_EPI) { if (wr == 1) PG8_BAR; }
    }
    PG8_WAIT_V(0);
    if constexpr (!ALIGN_EPI) { if (wr == 0) PG8_BAR; }
    PG8_BAR;
    if constexpr (Epi::AFTER_DRAIN) { E.fused(acc, cur, wr, wc, fr, fq, lds, wid, lane); S.done(cur); }
#undef PG8_SA
#undef PG8_SB
#undef PG8_STAGE
#undef PG8_LDA
#undef PG8_LDB
#undef PG8_MMA
#undef PG8_WAIT_V
#undef PG8_WAIT_L
#undef PG8_BAR
#undef PG8_SCHED
}
}

using pg8::bf16_t; using pg8::bf16x8; using pg8::f32x4; using pg8::u32x4;
typedef float f32x16 __attribute__((ext_vector_type(16)));
typedef unsigned u32x2 __attribute__((ext_vector_type(2)));
typedef short bf16x4 __attribute__((ext_vector_type(4)));

constexpr int NB = 16, SEQ = 2048, DM = 1024, NT = NB * SEQ, MEMT = 256, NMT = NB * MEMT, HW = 512, INW = 3584, DFF = 2816, MIXW = 1536;
constexpr float ALPHA = 1.189207115002721f;
constexpr float LN_EPS = 1e-5f, RMS_EPS = 1e-5f;
constexpr int NTHR = 512, NWAVE = 8;
constexpr int LDS_BYTES = 155648;

constexpr size_t MiB = 1048576;
constexpr size_t WS_WALL = 0;
constexpr size_t WS_WKV  = 7 * MiB;
constexpr size_t WS_WOUT = 9 * MiB;
constexpr size_t WS_WUP  = 12 * MiB;
constexpr size_t WS_WDN  = 23 * MiB;
constexpr size_t WS_ROPE = 29 * MiB;
constexpr size_t WS_STAT = 29 * MiB + 524288;
constexpr size_t WS_XB   = 30 * MiB;
constexpr size_t WS_X1B  = 30 * MiB;
constexpr size_t WS_HTD  = 94 * MiB;
constexpr size_t WS_MEMB = 110 * MiB;
constexpr size_t WS_QKM  = 118 * MiB;
constexpr size_t WS_HT   = 214 * MiB;
constexpr size_t WS_KMEM = 342 * MiB;
constexpr size_t WS_VMT  = 346 * MiB;
constexpr size_t WS_KF   = 350 * MiB;
constexpr size_t WS_MIX  = 382 * MiB;
constexpr size_t WS_HH   = 96 * MiB;
constexpr size_t WS_ACT  = 272 * MiB;
constexpr size_t WS_BAR  = 478 * MiB;
constexpr size_t WS_CNT  = 478 * MiB + 16384;
constexpr size_t WS_XG   = 478 * MiB + 65536;
constexpr size_t WS_END  = 478 * MiB + 65536 + 2 * MiB;

__device__ __forceinline__ unsigned pk2(float lo, float hi) { unsigned r; asm volatile("v_cvt_pk_bf16_f32 %0, %1, %2" : "=v"(r) : "v"(lo), "v"(hi)); return r; }
__device__ __forceinline__ float bf2f(bf16_t v) { return __uint_as_float((unsigned)v << 16); }
__device__ __forceinline__ float lo2f(unsigned v) { return __uint_as_float(v << 16); }
__device__ __forceinline__ float hi2f(unsigned v) { return __uint_as_float(v & 0xffff0000u); }
#define LDS_WAIT() asm volatile("s_waitcnt lgkmcnt(0)" ::: "memory")
__device__ __forceinline__ float xsum16(float v) { const auto r_ = __builtin_amdgcn_permlane16_swap(__float_as_uint(v), __float_as_uint(v), false, false); return __uint_as_float(r_[0]) + __uint_as_float(r_[1]); }
__device__ __forceinline__ float xsum32(float v) { const auto r_ = __builtin_amdgcn_permlane32_swap(__float_as_uint(v), __float_as_uint(v), false, false); return __uint_as_float(r_[0]) + __uint_as_float(r_[1]); }
__device__ __forceinline__ float wave_allsum(float v, int lane) {
#pragma unroll
    for (int o = 1; o < 16; o <<= 1) v += __int_as_float(__builtin_amdgcn_ds_bpermute((lane ^ o) << 2, __float_as_int(v)));
    return xsum32(xsum16(v));
}

#ifndef FFT_HOST
#define FFT_FN __device__ __forceinline__
#define FFT_SYNC() do { asm volatile("s_waitcnt lgkmcnt(0)" ::: "memory"); __builtin_amdgcn_s_barrier(); asm volatile("" ::: "memory"); } while (0)
typedef float cplx __attribute__((ext_vector_type(2)));
typedef LAS cplx* fftbuf_t;
FFT_FN float cos2pi(float r) { return __builtin_amdgcn_cosf(r); }
FFT_FN float sin2pi(float r) { return __builtin_amdgcn_sinf(r); }
#endif
FFT_FN cplx mk2(float x, float y) { cplx r; r.x = x; r.y = y; return r; }
FFT_FN cplx cadd(cplx a, cplx b) { return mk2(a.x + b.x, a.y + b.y); }
FFT_FN cplx csub(cplx a, cplx b) { return mk2(a.x - b.x, a.y - b.y); }
#ifdef FFT_HOST
FFT_FN cplx cmul(cplx a, cplx b) { return mk2(a.x * b.x - a.y * b.y, a.x * b.y + a.y * b.x); }
FFT_FN cplx cmulc(cplx a, cplx b) { return mk2(a.x * b.x + a.y * b.y, a.y * b.x - a.x * b.y); }
#else
FFT_FN cplx cmul(cplx a, cplx b) { cplx t, r;
    asm("v_pk_mul_f32 %0, %1, %2 op_sel_hi:[1,0]" : "=v"(t) : "v"(a), "v"(b));
    asm("v_pk_fma_f32 %0, %1, %2, %3 op_sel:[1,1,0] op_sel_hi:[0,1,1] neg_lo:[1,0,0]" : "=v"(r) : "v"(a), "v"(b), "v"(t)); return r; }
FFT_FN cplx cmulc(cplx a, cplx b) { cplx t, r;
    asm("v_pk_mul_f32 %0, %1, %2 op_sel_hi:[1,0]" : "=v"(t) : "v"(a), "v"(b));
    asm("v_pk_fma_f32 %0, %1, %2, %3 op_sel:[1,1,0] op_sel_hi:[0,1,1] neg_hi:[1,0,0]" : "=v"(r) : "v"(a), "v"(b), "v"(t)); return r; }
#endif
template <bool INV> FFT_FN cplx muli(cplx a) { return INV ? mk2(-a.y, a.x) : mk2(a.y, -a.x); }
FFT_FN int padi(int i) { return i + (i >> 3); }

template <bool INV> FFT_FN void dft8(cplx (&v)[8]) {
    const float R = 0.70710678118654752f;
    const cplx a0 = cadd(v[0], v[4]), a1 = csub(v[0], v[4]), a2 = cadd(v[2], v[6]), a3 = muli<INV>(csub(v[2], v[6]));
    const cplx a4 = cadd(v[1], v[5]), a5 = csub(v[1], v[5]), a6 = cadd(v[3], v[7]), a7 = muli<INV>(csub(v[3], v[7]));
    const cplx b0 = cadd(a0, a2), b2 = csub(a0, a2), b1 = cadd(a1, a3), b3 = csub(a1, a3);
    const cplx b4 = cadd(a4, a6), b6 = muli<INV>(csub(a4, a6));
    const cplx t5 = cadd(a5, a7), t7 = csub(a5, a7);
    cplx b5, b7;
    if (!INV) { b5 = mk2((t5.x + t5.y) * R, (t5.y - t5.x) * R); b7 = mk2((t7.y - t7.x) * R, -(t7.x + t7.y) * R); }
    else      { b5 = mk2((t5.x - t5.y) * R, (t5.x + t5.y) * R); b7 = mk2(-(t7.x + t7.y) * R, (t7.x - t7.y) * R); }
    v[0] = cadd(b0, b4); v[4] = csub(b0, b4); v[1] = cadd(b1, b5); v[5] = csub(b1, b5);
    v[2] = cadd(b2, b6); v[6] = csub(b2, b6); v[3] = cadd(b3, b7); v[7] = csub(b3, b7);
}
template <int S, bool INV> FFT_FN void twid(cplx (&v)[8], int tid) {
    if (S > 1) {
        const int j = tid % S; const float rev = (float)j * (1.0f / (8.0f * S));
        const float c = cos2pi(rev), s = sin2pi(rev);
        const cplx w1 = mk2(c, INV ? s : -s);
        const cplx w2 = cmul(w1, w1), w3 = cmul(w2, w1), w4 = cmul(w2, w2), w5 = cmul(w4, w1), w6 = cmul(w4, w2), w7 = cmul(w4, w3);
        v[1] = cmul(v[1], w1); v[2] = cmul(v[2], w2); v[3] = cmul(v[3], w3); v[4] = cmul(v[4], w4);
        v[5] = cmul(v[5], w5); v[6] = cmul(v[6], w6); v[7] = cmul(v[7], w7);
    }
}
template <int S> FFT_FN void ld8(fftbuf_t X, int tid, cplx (&v)[8]) {
    const int base = (tid / S) * 8 * S + (tid % S);
#pragma unroll
    for (int k = 0; k < 8; ++k) v[k] = X[padi(base + S * k)];
}
template <int S> FFT_FN void st8(fftbuf_t X, int tid, const cplx (&v)[8]) {
    const int base = (tid / S) * 8 * S + (tid % S);
#pragma unroll
    for (int k = 0; k < 8; ++k) X[padi(base + S * k)] = v[k];
}
#ifndef FFT_HOST
template <int S> FFT_FN void twid_fill(fftbuf_t TW, int tid) {
    constexpr int P = (S == 512) ? 0 : (S == 64) ? 1 : 2;
    const int j = tid % S; const float rev = (float)j * (1.0f / (8.0f * S));
    const cplx w1 = mk2(cos2pi(rev), -sin2pi(rev)), w2 = cmul(w1, w1), w3 = cmul(w2, w1), w4 = cmul(w2, w2), w5 = cmul(w4, w1), w6 = cmul(w4, w2), w7 = cmul(w4, w3);
    TW[(7 * P + 0) * 512 + tid] = w1; TW[(7 * P + 1) * 512 + tid] = w2; TW[(7 * P + 2) * 512 + tid] = w3; TW[(7 * P + 3) * 512 + tid] = w4;
    TW[(7 * P + 4) * 512 + tid] = w5; TW[(7 * P + 5) * 512 + tid] = w6; TW[(7 * P + 6) * 512 + tid] = w7;
}
template <int S, bool INV> FFT_FN void twidL(cplx (&v)[8], fftbuf_t TW, int tid) {
    constexpr int P = (S == 512) ? 0 : (S == 64) ? 1 : 2;
#pragma unroll
    for (int q = 1; q < 8; ++q) { const cplx w = TW[(7 * P + q - 1) * 512 + tid]; v[q] = INV ? cmulc(v[q], w) : cmul(v[q], w); }
}
FFT_FN void fft_fwdL(fftbuf_t X, fftbuf_t TW, int tid, cplx (&v)[8]) {
    dft8<false>(v); twidL<512, false>(v, TW, tid); st8<512>(X, tid, v); FFT_SYNC();
    ld8<64>(X, tid, v); dft8<false>(v); twidL<64, false>(v, TW, tid); st8<64>(X, tid, v); FFT_SYNC();
    ld8<8>(X, tid, v); dft8<false>(v); twidL<8, false>(v, TW, tid); st8<8>(X, tid, v); FFT_SYNC();
    ld8<1>(X, tid, v); dft8<false>(v);
}
FFT_FN void fft_invL(fftbuf_t X, fftbuf_t TW, int tid, cplx (&v)[8]) {
    dft8<true>(v); st8<1>(X, tid, v); FFT_SYNC();
    ld8<8>(X, tid, v); twidL<8, true>(v, TW, tid); dft8<true>(v); st8<8>(X, tid, v); FFT_SYNC();
    ld8<64>(X, tid, v); twidL<64, true>(v, TW, tid); dft8<true>(v); st8<64>(X, tid, v); FFT_SYNC();
    ld8<512>(X, tid, v); twidL<512, true>(v, TW, tid); dft8<true>(v);
}
FFT_FN void fft_fwd(fftbuf_t X, int tid, cplx (&v)[8]) {
    dft8<false>(v); twid<512, false>(v, tid); st8<512>(X, tid, v); FFT_SYNC();
    ld8<64>(X, tid, v); dft8<false>(v); twid<64, false>(v, tid); st8<64>(X, tid, v); FFT_SYNC();
    ld8<8>(X, tid, v); dft8<false>(v); twid<8, false>(v, tid); st8<8>(X, tid, v); FFT_SYNC();
    ld8<1>(X, tid, v); dft8<false>(v);
}
FFT_FN void fft_inv(fftbuf_t X, int tid, cplx (&v)[8]) {
    dft8<true>(v); st8<1>(X, tid, v); FFT_SYNC();
    ld8<8>(X, tid, v); twid<8, true>(v, tid); dft8<true>(v); st8<8>(X, tid, v); FFT_SYNC();
    ld8<64>(X, tid, v); twid<64, true>(v, tid); dft8<true>(v); st8<64>(X, tid, v); FFT_SYNC();
    ld8<512>(X, tid, v); twid<512, true>(v, tid); dft8<true>(v);
}
#endif

struct OneUnit { int pm, pn; bool on;
    __device__ __forceinline__ bool next(int i, pg8::Unit& u) const { if (!on || i > 0) return false; u.pm = pm; u.pn = pn; return true; }
    __device__ __forceinline__ void a_ready(const pg8::Unit&) const {}
    __device__ __forceinline__ void done(const pg8::Unit&) const {}
    __device__ __forceinline__ long a_off(const pg8::Unit& u, size_t tstep) const { return (long)((size_t)u.pm * tstep); }
    __device__ __forceinline__ int lda(int K) const { return K; }
    __device__ __forceinline__ size_t kstep_a() const { return 128; } };

struct EpiB {
    static constexpr bool PERM = true, AFTER_DRAIN = false;
    bf16_t* O; int ldc;
    __device__ __forceinline__ void operator()(const f32x4 (&acc)[2][2][4][2], const pg8::Unit& u, int wr, int wc, int fr, int fq) const {
        const int row0 = u.pm * 256 + wr * 64 + fr, col0 = u.pn * 256 + wc * 32 + 8 * fq;
#pragma unroll
        for (int ai = 0; ai < 2; ++ai)
#pragma unroll
            for (int m = 0; m < 4; ++m) { bf16_t* rowp = O + (size_t)(row0 + ai * 128 + m * 16) * ldc + col0;
#pragma unroll
                for (int bj = 0; bj < 2; ++bj) { const f32x4 v0 = acc[ai][bj][m][0], v1 = acc[ai][bj][m][1];
                    u32x4 w; w.x = pk2(v0[0], v0[1]); w.y = pk2(v0[2], v0[3]); w.z = pk2(v1[0], v1[1]); w.w = pk2(v1[2], v1[3]);
                    *(u32x4*)(rowp + bj * 128) = w; } }
    }
};
struct EpiRope {
    static constexpr bool PERM = true, AFTER_DRAIN = false;
    bf16_t* O; const float2* rope;
    __device__ __forceinline__ void operator()(const f32x4 (&acc)[2][2][4][2], const pg8::Unit& u, int wr, int wc, int fr, int fq) const {
        const int row0 = u.pm * 256 + wr * 64 + fr, col0 = u.pn * 256 + wc * 32 + 8 * fq;
        const bool rot = u.pn < 4;
#pragma unroll
        for (int ai = 0; ai < 2; ++ai)
#pragma unroll
            for (int m = 0; m < 4; ++m) { const int row = row0 + ai * 128 + m * 16; bf16_t* rowp = O + (size_t)row * MIXW + col0;
#pragma unroll
                for (int bj = 0; bj < 2; ++bj) { f32x4 v0 = acc[ai][bj][m][0], v1 = acc[ai][bj][m][1];
                    if (rot) { const int pos = row & (SEQ - 1), i0 = ((col0 + bj * 128) & 63) >> 1;
                        const f32x4* rp = (const f32x4*)(rope + pos * 32 + i0); const f32x4 r0 = rp[0], r1 = rp[1];
                        f32x4 o0, o1;
                        o0[0] = v0[0] * r0[0] - v0[1] * r0[1]; o0[1] = v0[1] * r0[0] + v0[0] * r0[1];
                        o0[2] = v0[2] * r0[2] - v0[3] * r0[3]; o0[3] = v0[3] * r0[2] + v0[2] * r0[3];
                        o1[0] = v1[0] * r1[0] - v1[1] * r1[1]; o1[1] = v1[1] * r1[0] + v1[0] * r1[1];
                        o1[2] = v1[2] * r1[2] - v1[3] * r1[3]; o1[3] = v1[3] * r1[2] + v1[2] * r1[3];
                        v0 = o0; v1 = o1; }
                    u32x4 w; w.x = pk2(v0[0], v0[1]); w.y = pk2(v0[2], v0[3]); w.z = pk2(v1[0], v1[1]); w.w = pk2(v1[2], v1[3]);
                    *(u32x4*)(rowp + bj * 128) = w; } }
    }
};
constexpr int XCH_OFF = 131072 + 1024;
__device__ __forceinline__ void stat_put(LAS cplx* ST, int rowl, int wc, int fq, float s1, float s2, bool first) {
    s1 = xsum32(xsum16(s1)); s2 = xsum32(xsum16(s2));
    if (fq == 0) { LAS cplx* p = ST + rowl * 4 + wc; cplx v; v.x = s1; v.y = s2; if (!first) { const cplx o = *p; v.x += o.x; v.y += o.y; } *p = v; }
}
struct EpiRes {
    static constexpr bool PERM = false, AFTER_DRAIN = false;
    const float* X; float* O; LAS unsigned char* lds; mutable int ecnt;
    __device__ __forceinline__ void operator()(const f32x4 (&acc)[2][2][4][2], const pg8::Unit& u, int wr, int wc, int fr, int fq) const {
        const int row0 = u.pm * 256 + wr * 64 + fr, col0 = u.pn * 256 + wc * 32 + 4 * fq;
        LAS cplx* ST = (LAS cplx*)(lds + XCH_OFF) + (ecnt & 1) * 1024; const bool first = true; ++ecnt;
#pragma unroll
        for (int ai = 0; ai < 2; ++ai) {
            f32x4 xv[4][2][2];
#pragma unroll
            for (int m = 0; m < 4; ++m)
#pragma unroll
                for (int bj = 0; bj < 2; ++bj)
#pragma unroll
                    for (int n = 0; n < 2; ++n) xv[m][bj][n] = *(const f32x4*)(X + (size_t)(row0 + ai * 128 + m * 16) * DM + col0 + bj * 128 + 16 * n);
            asm volatile("" ::: "memory");
#pragma unroll
            for (int m = 0; m < 4; ++m) { float s1 = 0.f, s2 = 0.f;
#pragma unroll
                for (int bj = 0; bj < 2; ++bj)
#pragma unroll
                    for (int n = 0; n < 2; ++n) { const f32x4 o = acc[ai][bj][m][n] + xv[m][bj][n] * ALPHA;
                        *(f32x4*)(O + (size_t)(row0 + ai * 128 + m * 16) * DM + col0 + bj * 128 + 16 * n) = o;
                        s1 += (o[0] + o[1]) + (o[2] + o[3]); s2 += (o[0] * o[0] + o[1] * o[1]) + (o[2] * o[2] + o[3] * o[3]); }
                stat_put(ST, ai * 128 + wr * 64 + m * 16 + fr, wc, fq, s1, s2, first); }
        }
    }
};
struct EpiRes2 {
    static constexpr bool PERM = false, AFTER_DRAIN = false;
    const float* R; float* O; const float2* stat; const float* g; const float* b; LAS unsigned char* lds; mutable int ecnt;
    __device__ __forceinline__ void operator()(const f32x4 (&acc)[2][2][4][2], const pg8::Unit& u, int wr, int wc, int fr, int fq) const {
        const int row0 = u.pm * 256 + wr * 64 + fr, col0 = u.pn * 256 + wc * 32 + 4 * fq;
        LAS cplx* ST = (LAS cplx*)(lds + XCH_OFF) + (ecnt & 1) * 1024; const bool first = true; ++ecnt;
#pragma unroll
        for (int ai = 0; ai < 2; ++ai)
#pragma unroll
            for (int bj = 0; bj < 2; ++bj) {
                f32x4 rv[4][2], gv[2], bv[2]; float2 st[4];
#pragma unroll
                for (int m = 0; m < 4; ++m) { const int row = row0 + ai * 128 + m * 16; st[m] = stat[row];
#pragma unroll
                    for (int n = 0; n < 2; ++n) rv[m][n] = *(const f32x4*)(R + (size_t)row * DM + col0 + bj * 128 + 16 * n); }
#pragma unroll
                for (int n = 0; n < 2; ++n) { gv[n] = *(const f32x4*)(g + col0 + bj * 128 + 16 * n); bv[n] = *(const f32x4*)(b + col0 + bj * 128 + 16 * n); }
                asm volatile("" ::: "memory");
#pragma unroll
                for (int m = 0; m < 4; ++m) { float s1 = 0.f, s2 = 0.f;
#pragma unroll
                    for (int n = 0; n < 2; ++n) { const f32x4 x1 = (rv[m][n] - st[m].x) * st[m].y * gv[n] + bv[n]; const f32x4 o = acc[ai][bj][m][n] + x1 * ALPHA;
                        *(f32x4*)(O + (size_t)(row0 + ai * 128 + m * 16) * DM + col0 + bj * 128 + 16 * n) = o;
                        s1 += (o[0] + o[1]) + (o[2] + o[3]); s2 += (o[0] * o[0] + o[1] * o[1]) + (o[2] * o[2] + o[3] * o[3]); }
                    stat_put(ST, ai * 128 + wr * 64 + m * 16 + fr, wc, fq, s1, s2, first && bj == 0); }
            }
    }
};
template <int MODE, bool RB> struct EpiLn {
    static constexpr bool PERM = false, AFTER_DRAIN = false;
    const float* RES; const bf16_t* RESB; float* OF; bf16_t* OB; const float* g; const float* b; unsigned long long* XG; unsigned* CNT; LAS unsigned char* ldsp;
    __device__ __forceinline__ void operator()(const f32x4 (&acc)[2][2][4][2], const pg8::Unit& u, int wr, int wc, int fr, int fq) const {
        const int t_ = threadIdx.x; fused(const_cast<f32x4 (&)[2][2][4][2]>(acc), u, wr, wc, fr, fq, ldsp, __builtin_amdgcn_readfirstlane(t_ >> 6), t_ & 63); }
    __device__ __forceinline__ void fused(f32x4 (&acc)[2][2][4][2], const pg8::Unit& u, int wr, int wc, int fr, int fq, LAS unsigned char* lds, int wid, int lane) const {
        const int tid = wid * 64 + lane, row0 = u.pm * 256 + wr * 64 + fr, col0 = u.pn * 256 + wc * 32 + 4 * fq;
        LAS cplx* ST = (LAS cplx*)(lds + XCH_OFF); LAS cplx* MR = (LAS cplx*)(lds + XCH_OFF + 8192);
#pragma unroll
        for (int ai = 0; ai < 2; ++ai) {
            float s1[4], s2[4];
#pragma unroll
            for (int m = 0; m < 4; ++m) { s1[m] = 0.f; s2[m] = 0.f; }
#pragma unroll
            for (int bj = 0; bj < 2; ++bj) {
                f32x4 xv[4][2];
                if (!RB) {
#pragma unroll
                    for (int m = 0; m < 4; ++m)
#pragma unroll
                        for (int n = 0; n < 2; ++n) xv[m][n] = __builtin_nontemporal_load((const f32x4*)(RES + (size_t)(row0 + ai * 128 + m * 16) * DM + col0 + bj * 128 + 16 * n));
                } else {
                    u32x2 xb[4][2];
#pragma unroll
                    for (int m = 0; m < 4; ++m)
#pragma unroll
                        for (int n = 0; n < 2; ++n) xb[m][n] = *(const u32x2*)(RESB + (size_t)(row0 + ai * 128 + m * 16) * DM + col0 + bj * 128 + 16 * n);
#pragma unroll
                    for (int m = 0; m < 4; ++m)
#pragma unroll
                        for (int n = 0; n < 2; ++n) { xv[m][n][0] = lo2f(xb[m][n].x); xv[m][n][1] = hi2f(xb[m][n].x); xv[m][n][2] = lo2f(xb[m][n].y); xv[m][n][3] = hi2f(xb[m][n].y); }
                }
                asm volatile("" ::: "memory");
#pragma unroll
                for (int m = 0; m < 4; ++m)
#pragma unroll
                    for (int n = 0; n < 2; ++n) { const f32x4 o = acc[ai][bj][m][n] + xv[m][n] * ALPHA; acc[ai][bj][m][n] = o;
                        s1[m] += (o[0] + o[1]) + (o[2] + o[3]); s2[m] += (o[0] * o[0] + o[1] * o[1]) + (o[2] * o[2] + o[3] * o[3]); }
            }
#pragma unroll
            for (int m = 0; m < 4; ++m) stat_put(ST, ai * 128 + wr * 64 + m * 16 + fr, wc, fq, s1[m], s2[m], true);
        }
        asm volatile("s_waitcnt lgkmcnt(0)" ::: "memory"); __syncthreads();
        float m1 = 0.f, m2 = 0.f;
        if (tid < 256) { const cplx a0 = ST[tid * 4 + 0], a1 = ST[tid * 4 + 1], a2 = ST[tid * 4 + 2], a3 = ST[tid * 4 + 3];
            m1 = (a0.x + a1.x) + (a2.x + a3.x); m2 = (a0.y + a1.y) + (a2.y + a3.y);
            __hip_atomic_store(XG + (size_t)(u.pm * 4 + u.pn) * 256 + tid, ((unsigned long long)__float_as_uint(m2) << 32) | __float_as_uint(m1), __ATOMIC_RELAXED, __HIP_MEMORY_SCOPE_AGENT); }
        asm volatile("s_waitcnt vmcnt(0)" ::: "memory");
        __syncthreads();
        if (tid == 0) {
            (void)__hip_atomic_fetch_add(CNT + u.pm * 16, 1u, __ATOMIC_RELAXED, __HIP_MEMORY_SCOPE_AGENT);
            unsigned sp = 0;
            while (__hip_atomic_load(CNT + u.pm * 16, __ATOMIC_RELAXED, __HIP_MEMORY_SCOPE_AGENT) < 4u) { __builtin_amdgcn_s_sleep(1); if (++sp > (1u << 22)) break; }
            __builtin_amdgcn_fence(__ATOMIC_ACQUIRE, "agent");
            asm volatile("s_waitcnt vmcnt(0)" ::: "memory");
        }
        __syncthreads();
        if (tid < 256) { float t1 = m1, t2 = m2;
#pragma unroll
            for (int jj = 1; jj < 4; ++jj) { const unsigned long long w = __hip_atomic_load(XG + (size_t)(u.pm * 4 + ((u.pn + jj) & 3)) * 256 + tid, __ATOMIC_RELAXED, __HIP_MEMORY_SCOPE_AGENT);
                t1 += __uint_as_float((unsigned)w); t2 += __uint_as_float((unsigned)(w >> 32)); }
            const float mean = t1 * (1.0f / DM), var = fmaxf(t2 * (1.0f / DM) - mean * mean, 0.f);
            cplx mr; mr.x = mean; mr.y = rsqrtf(var + LN_EPS); MR[tid] = mr; }
        __syncthreads();
#pragma unroll
        for (int bj = 0; bj < 2; ++bj)
#pragma unroll
            for (int n = 0; n < 2; ++n) { const int c = col0 + bj * 128 + 16 * n; const f32x4 gv = *(const f32x4*)(g + c), bv = *(const f32x4*)(b + c);
#pragma unroll
                for (int ai = 0; ai < 2; ++ai)
#pragma unroll
                    for (int m = 0; m < 4; ++m) { const int rl = ai * 128 + wr * 64 + m * 16 + fr; const cplx mr = MR[rl];
                        const f32x4 y = (acc[ai][bj][m][n] - mr.x) * mr.y * gv + bv; const size_t off = (size_t)(u.pm * 256 + rl) * DM + c;
                        if (MODE == 1) { u32x2 w; w.x = pk2(y[0], y[1]); w.y = pk2(y[2], y[3]); *(u32x2*)(OB + off) = w; }
                        else __builtin_nontemporal_store(y, (f32x4*)(OF + off)); } }
    }
};
struct QuadTwo { int q, j;
    __device__ __forceinline__ bool next(int i, pg8::Unit& u) const { if (i > 1) return false; u.pm = 2 * q + i; u.pn = j; return true; }
    __device__ __forceinline__ void a_ready(const pg8::Unit&) const {}
    __device__ __forceinline__ void done(const pg8::Unit&) const {}
    __device__ __forceinline__ long a_off(const pg8::Unit& u, size_t tstep) const { return (long)((size_t)u.pm * tstep); }
    __device__ __forceinline__ int lda(int K) const { return K; }
    __device__ __forceinline__ size_t kstep_a() const { return 128; } };
struct QuadTwoKb : QuadTwo {
    __device__ __forceinline__ int lda(int) const { return 64; }
    __device__ __forceinline__ size_t kstep_a() const { return (size_t)NT * 64 * 2; } };
struct OneUnitKb : OneUnit {
    __device__ __forceinline__ int lda(int) const { return 64; }
    __device__ __forceinline__ size_t kstep_a() const { return (size_t)NT * 64 * 2; }
};
struct PairOrder : pg8::StaticOrder {
    bool pair;
    __device__ __forceinline__ static int vcu_of(int c) { return (c & 7) * 32 + (c >> 3); }
    __device__ __forceinline__ bool next(int i, pg8::Unit& u) const {
        if (!pair) return pg8::StaticOrder::next(i, u);
        if (i > 1) return false;
        const int v = vcu_of(c); u.pm = 2 * (v >> 2) + i; u.pn = v & 3; return true; }
};
struct KbOrder : pg8::StaticOrder {
    __device__ __forceinline__ int lda(int) const { return 64; }
    __device__ __forceinline__ size_t kstep_a() const { return (size_t)NT * 64 * 2; }
};
struct PairKb : PairOrder {
    __device__ __forceinline__ int lda(int) const { return 64; }
    __device__ __forceinline__ size_t kstep_a() const { return (size_t)NT * 64 * 2; }
};
struct RevOrder : pg8::StaticOrder {
    __device__ __forceinline__ bool next(int i, pg8::Unit& u) const { const int rounds = (nwg + G - 1) / G; if (i >= rounds) return false; return pg8::StaticOrder::next(rounds - 1 - i, u); }
};
constexpr int CWL_OFF = 131072 + 1024 + 8192;
struct FfnOrder : pg8::StaticOrder {
    const float* cw; const float* cb; LAS unsigned char* lds; mutable int cnt;
    __device__ __forceinline__ long a_off(const pg8::Unit& u, size_t) const { return ((long)u.pm * 254 - 1) * (long)(DM * 2); }
    __device__ __forceinline__ void a_ready(const pg8::Unit& u) const {
        const int tid = threadIdx.x, w = __builtin_amdgcn_readfirstlane(tid >> 6), lane = tid & 63, buf = cnt & 1; ++cnt;
        const float* src = (w < 3) ? cw + (size_t)w * (2 * DFF) : (w < 6) ? cw + (size_t)(w - 3) * (2 * DFF) + DFF : (w == 6) ? cb : cb + DFF;
        src += u.pn * 128 + lane * 4;
        if (lane < 32) __builtin_amdgcn_global_load_lds((const unsigned*)src, (LAS unsigned*)(lds + CWL_OFF + buf * 4096 + w * 512), 16, 0, 0);
    }
};
constexpr int FFN_MT = 130;
__device__ __forceinline__ float dpp_ror1(float v)  { return __int_as_float(__builtin_amdgcn_update_dpp(0, __float_as_int(v), 0x121, 0xF, 0xF, false)); }
__device__ __forceinline__ float dpp_ror15(float v) { return __int_as_float(__builtin_amdgcn_update_dpp(0, __float_as_int(v), 0x12F, 0xF, 0xF, false)); }
struct EpiFfn {
    static constexpr bool PERM = true, AFTER_DRAIN = false;
    bf16_t* ACT; LAS unsigned char* lds; mutable int ecnt;
    __device__ __forceinline__ void operator()(const f32x4 (&acc)[2][2][4][2], const pg8::Unit& u, int wr, int wc, int fr, int fq) const {
        LAS float* XC = (LAS float*)(lds + XCH_OFF);
        const LAS float* WL = (const LAS float*)(lds + CWL_OFF + (ecnt & 1) * 4096); ++ecnt;
        const int colw = wc * 32 + 8 * fq;
        if (fr == 0 || fr == 15) {
            const int edge = (fr == 15) ? 1 : 0, m = (fr == 15) ? 3 : 0;
#pragma unroll
            for (int ai = 0; ai < 2; ++ai)
#pragma unroll
                for (int bj = 0; bj < 2; ++bj)
#pragma unroll
                    for (int n = 0; n < 2; ++n) { const f32x4 v = (m == 0) ? acc[ai][bj][0][n] : acc[ai][bj][3][n];
                        *(LAS f32x4*)(XC + ((ai * 2 + wr) * 2 + edge) * 256 + bj * 128 + colw + 4 * n) = v; }
        }
        asm volatile("s_waitcnt lgkmcnt(0)" ::: "memory"); __builtin_amdgcn_s_barrier(); asm volatile("" ::: "memory");
        const int slot0 = wr * 64 + fr, row_base = u.pm * 254 - 1;
#pragma unroll
        for (int bj = 0; bj < 2; ++bj) {
            const int gc = (u.pn * 256 + bj * 128 + colw) >> 1;
            const LAS float* wl = WL + ((bj * 128 + colw) >> 1);
            f32x4 wg[3], wu[3];
#pragma unroll
            for (int j = 0; j < 3; ++j) { wg[j] = *(const LAS f32x4*)(wl + j * 128); wu[j] = *(const LAS f32x4*)(wl + (3 + j) * 128); }
            const f32x4 bg = *(const LAS f32x4*)(wl + 6 * 128), bu = *(const LAS f32x4*)(wl + 7 * 128);
#pragma unroll
            for (int ai = 0; ai < 2; ++ai) {
                const int gidx = ai * 2 + wr;
                f32x4 pe[2], ne[2];
#pragma unroll
                for (int n = 0; n < 2; ++n) {
                    pe[n] = (gidx > 0) ? *(const LAS f32x4*)(XC + (((gidx - 1) * 2) + 1) * 256 + bj * 128 + colw + 4 * n) : (f32x4){0.f, 0.f, 0.f, 0.f};
                    ne[n] = (gidx < 3) ? *(const LAS f32x4*)(XC + (((gidx + 1) * 2) + 0) * 256 + bj * 128 + colw + 4 * n) : (f32x4){0.f, 0.f, 0.f, 0.f}; }
                u32x2 wq[2];
#pragma unroll
                for (int m = 0; m < 4; ++m) {
                    const int slot = ai * 128 + slot0 + m * 16, row = row_base + slot, t = row & (SEQ - 1);
                    const bool padrow = __any(t == 0 || t == SEQ - 1) != 0;
                    f32x4 hv[2];
#pragma unroll
                    for (int n = 0; n < 2; ++n) {
                        const f32x4 cur = acc[ai][bj][m][n], prv = acc[ai][bj][m == 0 ? 0 : m - 1][n], nxt = acc[ai][bj][m == 3 ? 3 : m + 1][n];
                        f32x4 up, dn;
#pragma unroll
                        for (int e = 0; e < 4; ++e) { up[e] = dpp_ror1(fr == 15 ? prv[e] : cur[e]); dn[e] = dpp_ror15(fr == 0 ? nxt[e] : cur[e]); }
                        if (m == 0 && fr == 0) up = pe[n];
                        if (m == 3 && fr == 15) dn = ne[n];
                        if (padrow) {
                            if (t == 0) up = (f32x4){0.f, 0.f, 0.f, 0.f};
                            if (t == SEQ - 1) dn = (f32x4){0.f, 0.f, 0.f, 0.f}; }
                        const f32x4 w0 = n ? wu[0] : wg[0], w1 = n ? wu[1] : wg[1], w2 = n ? wu[2] : wg[2], bb = n ? bu : bg;
                        hv[n] = w0 * up + w1 * cur + w2 * dn + bb; }
                    { float o[4];
#pragma unroll
                      for (int e = 0; e < 4; ++e) { const float g = hv[0][e]; o[e] = g * __builtin_amdgcn_rcpf(1.0f + __expf(-g)) * hv[1][e]; }
                      wq[m & 1].x = pk2(o[0], o[1]); wq[m & 1].y = pk2(o[2], o[3]); }
                    if (m & 1) {
                        const auto r0 = __builtin_amdgcn_permlane16_swap(wq[0].x, wq[1].x, false, false); const auto r1 = __builtin_amdgcn_permlane16_swap(wq[0].y, wq[1].y, false, false);
                        u32x4 w; w.x = r0[0]; w.y = r1[0]; w.z = r0[1]; w.w = r1[1];
                        const int ms = (fq & 1) ? m : m - 1, slot_s = ai * 128 + slot0 + ms * 16, row_s = row_base + slot_s, gcs = gc - ((fq & 1) ? 4 : 0);
                        if (slot_s >= 1 && slot_s <= 254 && row_s < NT) *(u32x4*)(ACT + ((size_t)(gcs >> 6) * NT + row_s) * 64 + (gcs & 63)) = w; }
                }
            }
        }
    }
};

struct P1Order {
    pg8::StaticOrder sa, sb; int c;
    __device__ __forceinline__ void init(int G, int c_) { sa.init(NT, 1536, G, c_); sb.init(2048, NT, G, c_); c = c_; }
    __device__ __forceinline__ bool next(int i, pg8::Unit& u) const {
        if (i < 3) { if (!sa.next(i, u)) return false; u.pm += 60; return true; }
        if (i < 7) { if (!sb.next(i - 3, u)) return false; u.pm += 6; u.pn += 60; return true; }
        if (i == 7 && c < 64) { if (c < 32) { u.pm = 220 + (c >> 1); u.pn = 14 + (c & 1); } else { const int c2 = c - 32; u.pm = 16 + ((c2 >> 4) & 1); u.pn = 220 + (c2 & 15); } return true; }
        return false; }
    __device__ __forceinline__ void a_ready(const pg8::Unit&) const {}
    __device__ __forceinline__ void done(const pg8::Unit&) const {}
    __device__ __forceinline__ long a_off(const pg8::Unit& u, size_t tstep) const { return (long)((size_t)u.pm * tstep); }
    __device__ __forceinline__ int lda(int K) const { return K; }
    __device__ __forceinline__ size_t kstep_a() const { return 128; }
};
struct EpiP1 {
    static constexpr bool PERM = true, AFTER_DRAIN = false;
    EpiRope ea; EpiB eb, ec, ed;
    __device__ __forceinline__ void operator()(const f32x4 (&acc)[2][2][4][2], const pg8::Unit& u, int wr, int wc, int fr, int fq) const {
        pg8::Unit v;
        if (u.pm >= 220) { v.pm = u.pm - 220; v.pn = u.pn - 14; ec(acc, v, wr, wc, fr, fq); }
        else if (u.pm >= 60) { v.pm = u.pm - 60; v.pn = u.pn; ea(acc, v, wr, wc, fr, fq); }
        else if (u.pm >= 16) { v.pm = u.pm - 16; v.pn = u.pn - 220; ed(acc, v, wr, wc, fr, fq); }
        else { v.pm = u.pm - 6; v.pn = u.pn - 60; eb(acc, v, wr, wc, fr, fq); }
    }
};

__device__ __forceinline__ int win_row(int n) {
    if (n < 1536) return 1536 + n;
    if (n < 2560) { const int q = n - 1536, blk = q >> 6, d = q & 63; return blk * 64 + 2 * (d & 31) + (d >> 5); }
    if (n < 3072) return 512 + n;
    return n - 2048;
}
template <int MODE> __device__ __forceinline__ void p0_transpose_item(const float* W, int K, int N, bf16_t* WT, LAS float* scr, int item, int lane) {
    const int nblk = N / 32, kb = item / nblk, nb = item % nblk, k0 = 64 * kb, n0 = 32 * nb;
    f32x4 q[8];
#pragma unroll
    for (int i = 0; i < 8; ++i) q[i] = __builtin_nontemporal_load((const f32x4*)(W + (size_t)(k0 + 8 * i + (lane >> 3)) * N + n0 + 4 * (lane & 7)));
#pragma unroll
    for (int i = 0; i < 8; ++i) { LAS float* d = scr + (8 * i + (lane >> 3)) * 33 + 4 * (lane & 7); d[0] = q[i][0]; d[1] = q[i][1]; d[2] = q[i][2]; d[3] = q[i][3]; }
    LDS_WAIT(); asm volatile("" ::: "memory");
    const int c = lane & 7;
#pragma unroll
    for (int j = 0; j < 4; ++j) { const int n = (lane >> 3) + 8 * j; const LAS float* s = scr + (8 * c) * 33 + n;
        u32x4 o; o.x = pk2(s[0 * 33], s[1 * 33]); o.y = pk2(s[2 * 33], s[3 * 33]); o.z = pk2(s[4 * 33], s[5 * 33]); o.w = pk2(s[6 * 33], s[7 * 33]);
        const int nn = n0 + n; const int dr = (MODE == 1) ? win_row(nn) : (MODE == 2) ? ((nn < DFF) ? ((nn >> 2) * 8 + (nn & 3)) : (((nn - DFF) >> 2) * 8 + 4 + ((nn - DFF) & 3))) : nn;
        *(u32x4*)(WT + (size_t)dr * K + k0 + 8 * c) = o; }
    LDS_WAIT(); asm volatile("" ::: "memory");
}
__device__ __forceinline__ void cvt_rows(const float* src, bf16_t* dst, size_t n8, int gw, int ngw, int lane) {
    const size_t n4 = 2 * n8, stride = (size_t)ngw * 64;
    for (size_t i = (size_t)gw * 64 + lane; i < n4; i += 8 * stride) {
        f32x4 a[8];
#pragma unroll
        for (int u = 0; u < 8; ++u) { const size_t k = i + u * stride; if (k < n4) a[u] = __builtin_nontemporal_load((const f32x4*)src + k); }
#pragma unroll
        for (int u = 0; u < 8; ++u) { const size_t k = i + u * stride; if (k < n4) { u32x2 w; w.x = pk2(a[u][0], a[u][1]); w.y = pk2(a[u][2], a[u][3]); ((u32x2*)dst)[k] = w; } }
    }
}
__device__ __forceinline__ void p0_filter_item(const LAS float* w1, const float* b1, const float* fq, const LAS float* w2, const float* b2, const float* w3, float* HTD, int item, int lane) {
    const int t0 = 2 * (item >> 2), ih = item & 3; float h2v[2], tl[2];
    const float fql = fq[lane], b1l = b1[lane], b2l = b2[lane];
#pragma unroll
    for (int tt = 0; tt < 2; ++tt) { const int t = t0 + tt; tl[tt] = (float)t * (1.0f / 2047.0f);
        const float w = 6.283185307179586f * (float)t / 2048.0f;
        float zk = 0.f;
        if (lane == 0) zk = tl[tt];
        else if (lane <= 16) { const float fr = 1e-4f + (float)(lane - 1) * ((15.0f - 1e-4f) / 15.0f); zk = cosf(fr * w); }
        else if (lane <= 32) { const float fr = 1e-4f + (float)(lane - 17) * ((15.0f - 1e-4f) / 15.0f); zk = -sinf(fr * w); }
        float a = b1l;
#pragma unroll 11
        for (int k = 0; k < 33; ++k) a += __shfl(zk, k) * w1[k * 64 + lane];
        const float h1 = sinf(fql * a);
        float a2 = b2l;
#pragma unroll 16
        for (int k = 0; k < 64; ++k) a2 += __shfl(h1, k) * w2[k * 64 + lane];
        h2v[tt] = sinf(fql * a2); }
    const float dmin = -15.350567286626973f, dmax = -3.0701134573253946f;
    float acc0[8], acc1[8];
#pragma unroll
    for (int i = 0; i < 8; ++i) { acc0[i] = 0.f; acc1[i] = 0.f; }
#pragma unroll 8
    for (int j = 0; j < 64; ++j) { const float s0 = __shfl(h2v[0], j), s1 = __shfl(h2v[1], j); const float* wr = w3 + (size_t)j * 2048 + ih * 512 + lane;
#pragma unroll
        for (int i = 0; i < 8; ++i) { const float wv = wr[64 * i]; acc0[i] += s0 * wv; acc1[i] += s1 * wv; } }
#pragma unroll
    for (int i = 0; i < 8; ++i) { const int col = ih * 512 + 64 * i + lane, c = col & 511;
        const float delta = fabsf(dmin + (float)c * ((dmax - dmin) / 511.0f));
        float2 o; o.x = acc0[i] * expf(-tl[0] * delta); o.y = acc1[i] * expf(-tl[1] * delta);
        *(float2*)(HTD + (size_t)col * 2048 + t0) = o; }
}
__device__ __forceinline__ void p0_prep(const float* const* in, unsigned char* ws, LAS unsigned char* lds, int tid, unsigned long long t_start) {
#ifdef PROBE_AT
#define PROBE0(k) do { if ((k) == PROBE_AT) { const unsigned long long t_now = __builtin_amdgcn_s_memrealtime(), dt_ = t_now - t_start; while (__builtin_amdgcn_s_memrealtime() - t_now < dt_) __builtin_amdgcn_s_sleep(8); } } while (0)
#else
#define PROBE0(k) do {} while (0)
#endif
    const int lane = tid & 63, wave = __builtin_amdgcn_readfirstlane(tid >> 6), gw = blockIdx.x * NWAVE + wave, ngw = gridDim.x * NWAVE;
    LAS float* scr = (LAS float*)(lds + wave * 8704);
    LAS float* W1L = (LAS float*)(lds + 69632); LAS float* W2L = W1L + 33 * 64;
    for (int i = tid; i < 33 * 64; i += NTHR) W1L[i] = in[5][i];
    for (int i = tid; i < 64 * 64; i += NTHR) W2L[i] = in[8][i];
    __syncthreads();
    bf16_t* WALL = (bf16_t*)(ws + WS_WALL);
    constexpr int I_IN = 16 * (INW / 32), I_KV = 16 * 32, I_OUT = 24 * 32, I_UP = 16 * (2 * DFF / 32), I_DN = (DFF / 64) * 32, NIT = I_IN + I_KV + I_OUT + I_UP + I_DN;
    for (int it = gw; it < NIT; it += ngw) { int r = it;
        if (r < I_IN) { p0_transpose_item<1>(in[2], DM, INW, WALL, scr, r, lane); continue; } r -= I_IN;
        if (r < I_KV) { p0_transpose_item<0>(in[14], DM, 1024, (bf16_t*)(ws + WS_WKV), scr, r, lane); continue; } r -= I_KV;
        if (r < I_OUT) { p0_transpose_item<0>(in[15], MIXW, DM, (bf16_t*)(ws + WS_WOUT), scr, r, lane); continue; } r -= I_OUT;
        if (r < I_UP) { p0_transpose_item<2>(in[18], DM, 2 * DFF, (bf16_t*)(ws + WS_WUP), scr, r, lane); continue; } r -= I_UP;
        p0_transpose_item<0>(in[21], DFF, DM, (bf16_t*)(ws + WS_WDN), scr, r, lane); }
    PROBE0(11);
    for (int it = ngw - 1 - gw; it < 4096; it += ngw) p0_filter_item(W1L, in[6], in[7], W2L, in[9], in[10], (float*)(ws + WS_HTD), it, lane);
    PROBE0(12);
    cvt_rows(in[0], (bf16_t*)(ws + WS_XB), (size_t)NT * DM / 8, gw, ngw, lane);
    cvt_rows(in[1], (bf16_t*)(ws + WS_MEMB), (size_t)NMT * DM / 8, gw, ngw, lane);
    float2* rope = (float2*)(ws + WS_ROPE);
    for (int i = blockIdx.x * NTHR + tid; i < SEQ * 32; i += gridDim.x * NTHR) { const int pos = i >> 5, f = i & 31;
        const float invf = powf(10000.0f, -(float)(2 * f) / 64.0f); const float ang = (float)pos * invf;
        float2 cs; cs.x = cosf(ang); cs.y = sinf(ang); rope[i] = cs; }
}

__device__ __forceinline__ void filter_fft_item(const float* HTD, float2* KF, LAS unsigned char* lds, int item, int tid) {
    const int o = item >> 9, c = item & 511;
    const float* rf = HTD + (size_t)((o * 2 + 0) * 512 + c) * 2048; const float* rb = HTD + (size_t)((o * 2 + 1) * 512 + c) * 2048;
    cplx v[8];
#pragma unroll
    for (int k = 0; k < 4; ++k) v[k] = mk2(rf[tid + 512 * k], 0.f);
    v[4] = mk2(tid == 0 ? 0.f : rb[2048 - tid], 0.f); v[5] = mk2(rb[1536 - tid], 0.f); v[6] = mk2(rb[1024 - tid], 0.f); v[7] = mk2(rb[512 - tid], 0.f);
    fft_fwd((LAS cplx*)lds, tid, v);
    float2* dst = KF + (size_t)(o * 512 + c) * 4096 + 8 * tid;
#pragma unroll
    for (int m = 0; m < 8; m += 2) { f32x4 w; w[0] = v[m].x * (1.f / 4096.f); w[1] = v[m].y * (1.f / 4096.f); w[2] = v[m + 1].x * (1.f / 4096.f); w[3] = v[m + 1].y * (1.f / 4096.f); *(f32x4*)(dst + m) = w; }
    __syncthreads();
}

constexpr int HY_SEG = 2064, HY_STG_OFF = 36864;
__device__ __forceinline__ u32x4 hy_fetch_conv(const bf16_t* HT, const float* cw, const float* cb, int c, int ba, int id) {
    const int sg = id >> 8, ch = id & 255, col = (sg >> 1) * 512 + c;
    const bf16_t* p = HT + (size_t)col * NT + (ba + (sg & 1)) * SEQ + ch * 8;
    const u32x4 q = __builtin_nontemporal_load((const u32x4*)p);
    const float lf = (ch > 0) ? bf2f(p[-1]) : 0.f, rt = (ch < 255) ? bf2f(p[8]) : 0.f;
    const float w0 = cw[col], w1 = cw[1536 + col], w2 = cw[3072 + col], bb = cb[col];
    float e[10]; e[0] = lf; e[1] = lo2f(q.x); e[2] = hi2f(q.x); e[3] = lo2f(q.y); e[4] = hi2f(q.y); e[5] = lo2f(q.z); e[6] = hi2f(q.z); e[7] = lo2f(q.w); e[8] = hi2f(q.w); e[9] = rt;
    float o[8];
#pragma unroll
    for (int j = 0; j < 8; ++j) o[j] = w0 * e[j] + w1 * e[j + 1] + w2 * e[j + 2] + bb;
    u32x4 r; r.x = pk2(o[0], o[1]); r.y = pk2(o[2], o[3]); r.z = pk2(o[4], o[5]); r.w = pk2(o[6], o[7]); return r;
}
__device__ __forceinline__ void hyena_item(const bf16_t* HT, const float2* KF, const float* cw, const float* cb, const float* hb, bf16_t* MIX, LAS unsigned char* lds, int bp, int cgp, int tid0) {
    LAS cplx* X = (LAS cplx*)lds; LAS bf16_t* STG = (LAS bf16_t*)(lds + HY_STG_OFF); LAS cplx* TW = (LAS cplx*)(lds + 65536);
    const int ba = 2 * bp;
    twid_fill<512>(TW, tid0); twid_fill<64>(TW, tid0); twid_fill<8>(TW, tid0);
    u32x4 oacc[8];
#pragma unroll
    for (int i = 0; i < 8; ++i) oacc[i] = (u32x4){0u, 0u, 0u, 0u};
    {
#pragma unroll
      for (int i = 0; i < 3; ++i) { const int id = tid0 + 512 * i, sg = id >> 8, ch = id & 255;
          *(LAS u32x4*)(STG + sg * HY_SEG + 8 + ch * 8) = hy_fetch_conv(HT, cw, cb, cgp * 8, ba, id); } }
    __syncthreads();
#pragma unroll 1
    for (int cc = 0; cc < 8; ++cc) {
        const int c = cgp * 8 + cc;
        int tl_ = tid0; asm volatile("" : "+v"(tl_)); const int tid = tl_;
        const float hbv0 = hb[c], hbv1 = hb[512 + c];
        u32x4 nx[3];
        if (cc < 7) {
#pragma unroll
            for (int i = 0; i < 3; ++i) nx[i] = hy_fetch_conv(HT, cw, cb, c + 1, ba, tid + 512 * i); }
        f32x4 kf[4];
        { const f32x4* kp = (const f32x4*)(KF + (size_t)c * 4096 + 8 * tid);
#pragma unroll
          for (int m = 0; m < 4; ++m) kf[m] = kp[m]; }
        cplx v[8]; float va[4], vb[4];
        {
#pragma unroll
          for (int k = 0; k < 4; ++k) { const int n = tid + 512 * k; va[k] = bf2f(STG[8 + n]); vb[k] = bf2f(STG[HY_SEG + 8 + n]); v[k] = mk2(va[k], vb[k]); v[4 + k] = mk2(0.f, 0.f); } }
        fft_fwdL(X, TW, tid, v);
#pragma unroll
        for (int m = 0; m < 8; m += 2) { const f32x4 w = kf[m >> 1]; v[m] = cmul(v[m], mk2(w[0], w[1])); v[m + 1] = cmul(v[m + 1], mk2(w[2], w[3])); }
        { const f32x4* kp = (const f32x4*)(KF + (size_t)(512 + c) * 4096 + 8 * tid);
#pragma unroll
          for (int m = 0; m < 4; ++m) kf[m] = kp[m]; }
        fft_invL(X, TW, tid, v);
        { const float hb0 = hbv0;
#pragma unroll
          for (int k = 0; k < 4; ++k) { const int n = tid + 512 * k; const float xa = bf2f(STG[2 * HY_SEG + 8 + n]), xb = bf2f(STG[3 * HY_SEG + 8 + n]);
              va[k] = xa * (v[k].x + hb0 * va[k]); vb[k] = xb * (v[k].y + hb0 * vb[k]); v[k] = mk2(va[k], vb[k]); v[4 + k] = mk2(0.f, 0.f); } }
        fft_fwdL(X, TW, tid, v);
#pragma unroll
        for (int m = 0; m < 8; m += 2) { const f32x4 w = kf[m >> 1]; v[m] = cmul(v[m], mk2(w[0], w[1])); v[m + 1] = cmul(v[m + 1], mk2(w[2], w[3])); }
        fft_invL(X, TW, tid, v);
        { const float hb1 = hbv1;
#pragma unroll
          for (int k = 0; k < 4; ++k) { const int n = tid + 512 * k; const float xa = bf2f(STG[4 * HY_SEG + 8 + n]), xb = bf2f(STG[5 * HY_SEG + 8 + n]);
              const float oa = xa * (v[k].x + hb1 * va[k]), ob = xb * (v[k].y + hb1 * vb[k]);
              const unsigned pw = pk2(oa, ob);
#pragma unroll
              for (int hh = 0; hh < 2; ++hh) { u32x4& o = oacc[2 * k + hh]; const unsigned nw = hh ? (pw & 0xffff0000u) : (pw << 16);
                  o.x = __builtin_amdgcn_alignbit(o.y, o.x, 16); o.y = __builtin_amdgcn_alignbit(o.z, o.y, 16); o.z = __builtin_amdgcn_alignbit(o.w, o.z, 16); o.w = (o.w >> 16) | nw; } } }
        __syncthreads();
        if (cc < 7) {
#pragma unroll
            for (int i = 0; i < 3; ++i) { const int id = tid + 512 * i, sg = id >> 8, ch = id & 255; *(LAS u32x4*)(STG + sg * HY_SEG + 8 + ch * 8) = nx[i]; } }
        __syncthreads();
    }
    int tw_ = tid0; asm volatile("" : "+v"(tw_)); const int tid = tw_;
#pragma unroll
    for (int k = 0; k < 4; ++k)
#pragma unroll
        for (int hh = 0; hh < 2; ++hh) *(u32x4*)(MIX + (size_t)((ba + hh) * SEQ + tid + 512 * k) * MIXW + cgp * 8) = oacc[2 * k + hh];
}

constexpr int ATT_KP = 272, ATT_VP = 144, ATT_KB = 64 * ATT_KP, ATT_VB = 128 * ATT_VP, ATT_VOFF = 2 * ATT_KB;
__device__ __forceinline__ float half_swap_max(float v) { const auto r_ = __builtin_amdgcn_permlane32_swap(__float_as_uint(v), __float_as_uint(v), false, false); return fmaxf(__uint_as_float(r_[0]), __uint_as_float(r_[1])); }
__device__ __forceinline__ float half_swap_sum(float v) { const auto r_ = __builtin_amdgcn_permlane32_swap(__float_as_uint(v), __float_as_uint(v), false, false); return __uint_as_float(r_[0]) + __uint_as_float(r_[1]); }
__device__ __forceinline__ void att_vput(LAS unsigned char* p, u32x4 q) { u32x2 lo, hi; lo.x = q.x; lo.y = q.y; hi.x = q.z; hi.y = q.w; *(LAS u32x2*)p = lo; *(LAS u32x2*)(p + 16) = hi; }
template <int NC> __device__ __forceinline__ void attn_unit(LAS unsigned char* lds, const bf16_t* Qp, int ldq, const bf16_t* Kp, int ldk, const bf16_t* Vt, int ldv, int nkeys, float sl2,
                                                            bf16_t* Op, int ldo, float lam, const float* subg, int tid) {
    constexpr int NSTEP = (NC == 2) ? 4 : 8;
    const int lane = tid & 63, wave = tid >> 6, r = lane & 31, h = lane >> 5;
    const int qb = (NC == 2) ? (wave & 3) : wave, comp = (NC == 2) ? (wave >> 2) : 0, dbase = comp * 64;
    bf16x8 qf[NSTEP];
#pragma unroll
    for (int st = 0; st < NSTEP; ++st) qf[st] = *(const bf16x8*)(Qp + (size_t)(qb * 32 + r) * ldq + dbase + 16 * st + 8 * h);
    f32x16 o[4];
#pragma unroll
    for (int et = 0; et < 4; ++et)
#pragma unroll
        for (int i = 0; i < 16; ++i) o[et][i] = 0.f;
    float mold = -INFINITY, lsum = 0.f;
    const int kr0 = tid >> 4, kc = tid & 15, vr0 = tid >> 3, vc = tid & 7;
    const bf16_t* kg = Kp + (size_t)kr0 * ldk + kc * 8; const bf16_t* vg = Vt + (size_t)vr0 * ldv + vc * 8;
    const int kl = kr0 * ATT_KP + kc * 16, vl = ATT_VOFF + vr0 * ATT_VP + (vc >> 1) * 32 + (vc & 1) * 8;
    const int nt = nkeys / 64;
    u32x4 pk0, pk1, pv0, pv1;
    pk0 = *(const u32x4*)(kg); pk1 = *(const u32x4*)(kg + (size_t)32 * ldk); pv0 = *(const u32x4*)(vg); pv1 = *(const u32x4*)(vg + (size_t)64 * ldv);
    *(LAS u32x4*)(lds + kl) = pk0; *(LAS u32x4*)(lds + kl + 32 * ATT_KP) = pk1; att_vput(lds + vl, pv0); att_vput(lds + vl + 64 * ATT_VP, pv1);
    __syncthreads();
    for (int it = 0; it < nt; ++it) {
        const int cur = it & 1; const bool more = (it + 1 < nt);
        if (more) { const bf16_t* kg2 = kg + (size_t)(it + 1) * 64 * ldk; const bf16_t* vg2 = vg + (it + 1) * 64;
            pk0 = *(const u32x4*)(kg2); pk1 = *(const u32x4*)(kg2 + (size_t)32 * ldk); pv0 = *(const u32x4*)(vg2); pv1 = *(const u32x4*)(vg2 + (size_t)64 * ldv); }
        LAS unsigned char* Kb = lds + cur * ATT_KB; LAS unsigned char* Vb = lds + ATT_VOFF + cur * ATT_VB;
        __builtin_amdgcn_iglp_opt(0);
        f32x16 s[2];
#pragma unroll
        for (int kb = 0; kb < 2; ++kb) {
#pragma unroll
            for (int i = 0; i < 16; ++i) s[kb][i] = 0.f;
#pragma unroll
            for (int st = 0; st < NSTEP; ++st) { const bf16x8 a = *(const LAS bf16x8*)(Kb + (kb * 32 + r) * ATT_KP + (dbase + 16 * st + 8 * h) * 2);
                s[kb] = __builtin_amdgcn_mfma_f32_32x32x16_bf16(a, qf[st], s[kb], 0, 0, 0); } }
        float mx = s[0][0];
#pragma unroll
        for (int i = 1; i < 16; ++i) mx = fmaxf(mx, s[0][i]);
#pragma unroll
        for (int i = 0; i < 16; ++i) mx = fmaxf(mx, s[1][i]);
        mx = half_swap_max(mx);
        const float mnew = fmaxf(mold, mx * sl2), alpha = __builtin_amdgcn_exp2f(mold - mnew); mold = mnew;
        float ps = 0.f;
#pragma unroll
        for (int kb = 0; kb < 2; ++kb)
#pragma unroll
            for (int i = 0; i < 16; ++i) { const float p = __builtin_amdgcn_exp2f(__builtin_fmaf(s[kb][i], sl2, -mnew)); s[kb][i] = p; ps += p; }
        lsum = lsum * alpha + ps;
#pragma unroll
        for (int et = 0; et < 4; ++et)
#pragma unroll
            for (int i = 0; i < 16; ++i) o[et][i] *= alpha;
#pragma unroll
        for (int kb = 0; kb < 2; ++kb)
#pragma unroll
            for (int s2 = 0; s2 < 2; ++s2) {
                u32x4 pw; pw.x = pk2(s[kb][8 * s2 + 0], s[kb][8 * s2 + 1]); pw.y = pk2(s[kb][8 * s2 + 2], s[kb][8 * s2 + 3]); pw.z = pk2(s[kb][8 * s2 + 4], s[kb][8 * s2 + 5]); pw.w = pk2(s[kb][8 * s2 + 6], s[kb][8 * s2 + 7]);
                const bf16x8 pf = __builtin_bit_cast(bf16x8, pw);
#pragma unroll
                for (int et = 0; et < 4; ++et) { const u32x4 aw = *(const LAS u32x4*)(Vb + (et * 32 + r) * ATT_VP + (kb * 2 + s2) * 32 + h * 16);
                    o[et] = __builtin_amdgcn_mfma_f32_32x32x16_bf16(__builtin_bit_cast(bf16x8, aw), pf, o[et], 0, 0, 0); } }
        if (more) { const int nb = cur ^ 1;
            *(LAS u32x4*)(lds + nb * ATT_KB + kl) = pk0; *(LAS u32x4*)(lds + nb * ATT_KB + kl + 32 * ATT_KP) = pk1;
            att_vput(lds + nb * ATT_VB + vl, pv0); att_vput(lds + nb * ATT_VB + vl + 64 * ATT_VP, pv1); }
        __syncthreads();
    }
    lsum = half_swap_sum(lsum);
    const float inv = 1.0f / lsum;
    if (NC == 1) {
        bf16_t* orow = Op + (size_t)(qb * 32 + r) * ldo;
#pragma unroll
        for (int et = 0; et < 4; ++et)
#pragma unroll
            for (int g = 0; g < 4; ++g) { u32x2 w; w.x = pk2(o[et][4 * g] * inv, o[et][4 * g + 1] * inv); w.y = pk2(o[et][4 * g + 2] * inv, o[et][4 * g + 3] * inv);
                *(u32x2*)(orow + et * 32 + 8 * g + 4 * h) = w; }
    } else {
        LAS float* XL = (LAS float*)lds;
        if (comp == 1) {
#pragma unroll
            for (int et = 0; et < 4; ++et)
#pragma unroll
                for (int g = 0; g < 4; ++g) { f32x4 t; t[0] = o[et][4 * g] * inv; t[1] = o[et][4 * g + 1] * inv; t[2] = o[et][4 * g + 2] * inv; t[3] = o[et][4 * g + 3] * inv;
                    *(LAS f32x4*)(XL + ((qb * 16 + et * 4 + g) * 64 + lane) * 4) = t; }
        }
        __syncthreads();
        if (comp == 0) {
            float ss = 0.f;
#pragma unroll
            for (int et = 0; et < 4; ++et)
#pragma unroll
                for (int g = 0; g < 4; ++g) { const f32x4 t = *(const LAS f32x4*)(XL + ((qb * 16 + et * 4 + g) * 64 + lane) * 4);
#pragma unroll
                    for (int i2 = 0; i2 < 4; ++i2) { const float ov = o[et][4 * g + i2] * inv - lam * t[i2]; o[et][4 * g + i2] = ov; ss += ov * ov; } }
            ss = half_swap_sum(ss);
            const float rs = rsqrtf(ss * (1.0f / 128.0f) + RMS_EPS) * 0.8f;
            bf16_t* orow = Op + (size_t)(qb * 32 + r) * ldo;
#pragma unroll
            for (int et = 0; et < 4; ++et)
#pragma unroll
                for (int g = 0; g < 4; ++g) { const int e = et * 32 + 8 * g + 4 * h; const f32x4 gv = *(const f32x4*)(subg + e);
                    u32x2 w; w.x = pk2(o[et][4 * g] * rs * gv[0], o[et][4 * g + 1] * rs * gv[1]); w.y = pk2(o[et][4 * g + 2] * rs * gv[2], o[et][4 * g + 3] * rs * gv[3]);
                    *(u32x2*)(orow + e) = w; }
        }
        __syncthreads();
    }
}

template <bool TO_BF16> __device__ __forceinline__ void ln_rows(float* io, bf16_t* ob, float2* stat, const float* g, const float* b, int tid, float* alt = nullptr) {
    const int lane = tid & 63, gw = blockIdx.x * NWAVE + (tid >> 6), ngw = gridDim.x * NWAVE;
    f32x4 gv[4], bv[4];
#pragma unroll
    for (int j = 0; j < 4; ++j) { gv[j] = ((const f32x4*)g)[lane + 64 * j]; bv[j] = ((const f32x4*)b)[lane + 64 * j]; }
    for (int row0 = gw; row0 < NT; row0 += 2 * ngw) {
        f32x4 v[2][4];
#pragma unroll
        for (int u = 0; u < 2; ++u) { const int row = row0 + u * ngw; if (row < NT) { const f32x4* xr = (const f32x4*)(io + (size_t)row * DM) + lane;
#pragma unroll
            for (int j = 0; j < 4; ++j) v[u][j] = xr[64 * j]; } }
#pragma unroll
        for (int u = 0; u < 2; ++u) { const int row = row0 + u * ngw; if (row >= NT) continue;
            float s = 0.f;
#pragma unroll
            for (int j = 0; j < 4; ++j) s += (v[u][j][0] + v[u][j][1]) + (v[u][j][2] + v[u][j][3]);
            s = wave_allsum(s, lane);
            const float mean = s * (1.0f / DM); float s2 = 0.f;
#pragma unroll
            for (int j = 0; j < 4; ++j) { v[u][j] = v[u][j] - mean; s2 += (v[u][j][0] * v[u][j][0] + v[u][j][1] * v[u][j][1]) + (v[u][j][2] * v[u][j][2] + v[u][j][3] * v[u][j][3]); }
            s2 = wave_allsum(s2, lane);
            const float rstd = rsqrtf(s2 * (1.0f / DM) + LN_EPS);
            if (TO_BF16) {
                u32x2* o8 = (u32x2*)(ob + (size_t)row * DM) + lane;
#pragma unroll
                for (int j = 0; j < 4; ++j) { const f32x4 y = v[u][j] * rstd * gv[j] + bv[j]; u32x2 w; w.x = pk2(y[0], y[1]); w.y = pk2(y[2], y[3]); o8[64 * j] = w; }
                if (lane == 0) { float2 st; st.x = mean; st.y = rstd; stat[row] = st; }
            } else {
                f32x4* wr_ = (alt ? (f32x4*)(alt + (size_t)row * DM) : (f32x4*)(io + (size_t)row * DM)) + lane;
#pragma unroll
                for (int j = 0; j < 4; ++j) wr_[64 * j] = v[u][j] * rstd * gv[j] + bv[j];
            }
        }
    }
}

__device__ __forceinline__ void convgate_half(const bf16_t* HH, bf16_t* ACT, const float* cw, const float* cb, int half, int tid) {
    constexpr int NG = DFF / 8; const int total = (NT / 2) * NG;
    for (int idx = blockIdx.x * NTHR + tid; idx < total; idx += gridDim.x * NTHR) {
        const int rl = idx / NG, cg8 = idx - rl * NG, n0 = cg8 * 8, t = rl & (SEQ - 1);
        const bf16_t* hp = HH + (size_t)rl * (2 * DFF);
        float gsum[8], usum[8];
#pragma unroll
        for (int e = 0; e < 8; ++e) { gsum[e] = cb[n0 + e]; usum[e] = cb[DFF + n0 + e]; }
#pragma unroll
        for (int j = 0; j < 3; ++j) { const int tt = t + j - 1; if (tt < 0 || tt >= SEQ) continue;
            const u32x4 gq = *(const u32x4*)(hp + (ptrdiff_t)(j - 1) * (2 * DFF) + n0), uq = *(const u32x4*)(hp + (ptrdiff_t)(j - 1) * (2 * DFF) + DFF + n0);
            const float* wg = cw + (size_t)j * (2 * DFF) + n0; const float* wu = wg + DFF;
            const f32x4 wg0 = *(const f32x4*)wg, wg1 = *(const f32x4*)(wg + 4), wu0 = *(const f32x4*)wu, wu1 = *(const f32x4*)(wu + 4);
            gsum[0] += wg0[0] * lo2f(gq.x); gsum[1] += wg0[1] * hi2f(gq.x); gsum[2] += wg0[2] * lo2f(gq.y); gsum[3] += wg0[3] * hi2f(gq.y);
            gsum[4] += wg1[0] * lo2f(gq.z); gsum[5] += wg1[1] * hi2f(gq.z); gsum[6] += wg1[2] * lo2f(gq.w); gsum[7] += wg1[3] * hi2f(gq.w);
            usum[0] += wu0[0] * lo2f(uq.x); usum[1] += wu0[1] * hi2f(uq.x); usum[2] += wu0[2] * lo2f(uq.y); usum[3] += wu0[3] * hi2f(uq.y);
            usum[4] += wu1[0] * lo2f(uq.z); usum[5] += wu1[1] * hi2f(uq.z); usum[6] += wu1[2] * lo2f(uq.w); usum[7] += wu1[3] * hi2f(uq.w); }
        float a[8];
#pragma unroll
        for (int e = 0; e < 8; ++e) a[e] = gsum[e] / (1.0f + __expf(-gsum[e])) * usum[e];
        u32x4 w; w.x = pk2(a[0], a[1]); w.y = pk2(a[2], a[3]); w.z = pk2(a[4], a[5]); w.w = pk2(a[6], a[7]);
        *(u32x4*)(ACT + (size_t)(half * (NT / 2) + rl) * DFF + n0) = w;
    }
}

#define XB_TMO      128
#define XB_XCNT(j)  (256  + 64 * (j))
#define XB_XSUB(j)  (1280 + 64 * (j))
#define XB_XGEN(j)  (2304 + 64 * (j))
#define XB_TOP      3328
#define XB_TOPGEN   3392
#define XCD_BAR_WORDS 3456
#define XB_SPIN_CAP (1u << 18)

__device__ __forceinline__ unsigned xb_ld(unsigned* p)              { return __hip_atomic_load(p, __ATOMIC_RELAXED, __HIP_MEMORY_SCOPE_AGENT); }
__device__ __forceinline__ unsigned xb_add(unsigned* p, unsigned v) { return __hip_atomic_fetch_add(p, v, __ATOMIC_RELAXED, __HIP_MEMORY_SCOPE_AGENT); }
__device__ __forceinline__ unsigned xb_xcc_id() { return (unsigned)__builtin_amdgcn_s_getreg((3 << 11) | 20) & 0xFu; }
#define XB_SPIN(cond, bar) do { unsigned _sp = 0; while (cond) { __builtin_amdgcn_s_sleep(1); \
    if ((++_sp & 255u) == 0u) { if (xb_ld(&(bar)[XB_TMO])) break; if (_sp > XB_SPIN_CAP) { atomicAdd(&(bar)[XB_TMO], 1u); break; } } } } while (0)

struct XcdBarrier {
    unsigned* bar; unsigned x;
    volatile LAS unsigned* st;
};

__device__ __forceinline__ XcdBarrier xcd_barrier_post(unsigned* bar, volatile LAS unsigned* st) {
    XcdBarrier b; b.bar = bar; b.x = xb_xcc_id(); b.st = st;
    if (threadIdx.x == 0) (void)xb_add(&bar[XB_XCNT(b.x)], 1u);
    return b;
}
__device__ __forceinline__ void xcd_barrier_complete(unsigned* bar, unsigned x, unsigned& nloc, unsigned& nx) {
    const unsigned G = gridDim.x * gridDim.y * gridDim.z;
    unsigned sum, cnt, mine, sp = 0u;
    for (;;) {
        sum = 0u; cnt = 0u; mine = 0u;
#pragma unroll
        for (unsigned j = 0; j < 16; ++j) { const unsigned c = xb_ld(&bar[XB_XCNT(j)]); sum += c; cnt += (c > 0u) ? 1u : 0u; mine = (j == x) ? c : mine; }
        if (sum == G) break;
        __builtin_amdgcn_s_sleep(1);
        if ((++sp & 255u) == 0u) { if (xb_ld(&bar[XB_TMO])) break; if (sp > XB_SPIN_CAP) { atomicAdd(&bar[XB_TMO], 1u); break; } }
    }
    nloc = mine > 0u ? mine : 1u; nx = cnt > 0u ? cnt : 1u;
}

__device__ __forceinline__ void xcd_barrier(const XcdBarrier& b) {
    asm volatile("s_waitcnt vmcnt(0)" ::: "memory");
    __syncthreads();
    if (threadIdx.x == 0) {
        unsigned* bar = b.bar;
        __builtin_amdgcn_s_waitcnt(0);
        unsigned nloc = b.st[0], nx = b.st[1];
        if (nloc == 0u) { xcd_barrier_complete(bar, b.x, nloc, nx); b.st[0] = nloc; b.st[1] = nx; }
        const unsigned old = xb_add(&bar[XB_XSUB(b.x)], 1u);
        const unsigned gen = old / nloc;
        if (old + 1u == (gen + 1u) * nloc) {
            __builtin_amdgcn_fence(__ATOMIC_RELEASE, "agent");
            asm volatile("s_waitcnt vmcnt(0)" ::: "memory");
            const unsigned og = xb_add(&bar[XB_TOP], 1u);
            const unsigned tg = og / nx;
            if (og + 1u == (tg + 1u) * nx) xb_add(&bar[XB_TOPGEN], 1u);
            else XB_SPIN(xb_ld(&bar[XB_TOPGEN]) == tg, bar);
            __builtin_amdgcn_fence(__ATOMIC_ACQUIRE, "agent");
            xb_add(&bar[XB_XGEN(b.x)], 1u);
            asm volatile("s_waitcnt vmcnt(0)" ::: "memory");
        } else {
            XB_SPIN(xb_ld(&bar[XB_XGEN(b.x)]) == gen, bar);
            __builtin_amdgcn_fence(__ATOMIC_ACQUIRE, "agent");
            asm volatile("s_waitcnt vmcnt(0)" ::: "memory");
        }
    }
    __syncthreads();
}

template <int MODE> __device__ __forceinline__ void panel_finish(LAS unsigned char* lds, float* io, bf16_t* x1b, float2* stat, const float* g, const float* b, unsigned long long* XG, unsigned* CNT, int cu, int tid) {
    const int v = PairOrder::vcu_of(cu), q = v >> 2, j = v & 3, lane = tid & 63, wave = tid >> 6;
    LAS cplx* ST = (LAS cplx*)(lds + XCH_OFF); LAS cplx* MR = (LAS cplx*)lds;
    asm volatile("s_waitcnt lgkmcnt(0)" ::: "memory"); __syncthreads();
    const int ui = tid >> 8, rowl = tid & 255;
    float m1, m2;
    { const cplx a0 = ST[tid * 4 + 0], a1 = ST[tid * 4 + 1], a2 = ST[tid * 4 + 2], a3 = ST[tid * 4 + 3];
      m1 = (a0.x + a1.x) + (a2.x + a3.x); m2 = (a0.y + a1.y) + (a2.y + a3.y);
      __hip_atomic_store(XG + (size_t)((2 * q + ui) * 4 + j) * 256 + rowl, ((unsigned long long)__float_as_uint(m2) << 32) | __float_as_uint(m1), __ATOMIC_RELAXED, __HIP_MEMORY_SCOPE_AGENT); }
    asm volatile("s_waitcnt vmcnt(0)" ::: "memory");
    __syncthreads();
    if (tid == 0) {
        (void)__hip_atomic_fetch_add(CNT + (2 * q) * 16, 1u, __ATOMIC_RELAXED, __HIP_MEMORY_SCOPE_AGENT);
        (void)__hip_atomic_fetch_add(CNT + (2 * q + 1) * 16, 1u, __ATOMIC_RELAXED, __HIP_MEMORY_SCOPE_AGENT);
        unsigned sp = 0;
        while (__hip_atomic_load(CNT + (2 * q) * 16, __ATOMIC_RELAXED, __HIP_MEMORY_SCOPE_AGENT) < 4u || __hip_atomic_load(CNT + (2 * q + 1) * 16, __ATOMIC_RELAXED, __HIP_MEMORY_SCOPE_AGENT) < 4u) {
            __builtin_amdgcn_s_sleep(1); if (++sp > (1u << 22)) break; }
        __builtin_amdgcn_fence(__ATOMIC_ACQUIRE, "agent");
        asm volatile("s_waitcnt vmcnt(0)" ::: "memory");
    }
    __syncthreads();
    { float t1 = m1, t2 = m2;
#pragma unroll
      for (int jj = 1; jj < 4; ++jj) { const unsigned long long w = __hip_atomic_load(XG + (size_t)((2 * q + ui) * 4 + ((j + jj) & 3)) * 256 + rowl, __ATOMIC_RELAXED, __HIP_MEMORY_SCOPE_AGENT);
          t1 += __uint_as_float((unsigned)w); t2 += __uint_as_float((unsigned)(w >> 32)); }
      const float mean = t1 * (1.0f / DM), var = fmaxf(t2 * (1.0f / DM) - mean * mean, 0.f), rstd = rsqrtf(var + LN_EPS);
      cplx mr; mr.x = mean; mr.y = rstd; MR[tid] = mr;
      if (MODE == 1 && j == 0) { float2 sv; sv.x = mean; sv.y = rstd; stat[(2 * q + ui) * 256 + rowl] = sv; } }
    __syncthreads();
    const int cbase = j * 256 + lane * 4;
    const f32x4 g0 = *(const f32x4*)(g + cbase), b0 = *(const f32x4*)(b + cbase);
#pragma unroll 1
    for (int it = 0; it < 8; ++it) {
        const int u2 = it >> 2, rb = (it & 3) * 8; const size_t rbase = (size_t)((2 * q + u2) * 256 + wave * 32 + rb);
        f32x4 x0[8];
#pragma unroll
        for (int i = 0; i < 8; ++i) x0[i] = *(const f32x4*)(io + (rbase + i) * DM + cbase);
        asm volatile("" ::: "memory");
#pragma unroll
        for (int i = 0; i < 8; ++i) { const cplx mr = MR[u2 * 256 + wave * 32 + rb + i];
            const f32x4 y0 = (x0[i] - mr.x) * mr.y * g0 + b0;
            if (MODE == 1) { u32x2 w0; w0.x = pk2(y0[0], y0[1]); w0.y = pk2(y0[2], y0[3]); *(u32x2*)(x1b + (rbase + i) * DM + cbase) = w0; }
            else *(f32x4*)(io + (rbase + i) * DM + cbase) = y0; }
    }
}

#ifndef PH_MASK
#define PH_MASK 0xFFFFFF
#endif
#define PH(k) ((PH_MASK >> (k)) & 1)
#ifndef G3_RB
#define G3_RB false
#endif
#ifndef G5ORDER
#define G5ORDER KbOrder
#endif
#ifndef REP_P0
#define REP_P0 1
#endif
#ifndef REP_G1
#define REP_G1 1
#endif
#ifndef REP_DIFF
#define REP_DIFF 1
#endif
#ifndef REP_HY
#define REP_HY 1
#endif
#ifndef REP_MEM
#define REP_MEM 1
#endif
#ifndef REP_G3
#define REP_G3 1
#endif
#ifndef REP_G4
#define REP_G4 1
#endif
#ifndef REP_LN1
#define REP_LN1 1
#endif
struct Args { const float* in[24]; float* out; unsigned char* ws; };
__global__ void __launch_bounds__(NTHR, 2) hybrid_fwd(Args a) {
    extern __shared__ __attribute__((aligned(16))) unsigned char smem[];
    LAS unsigned char* lds = (LAS unsigned char*)smem;
    cg::grid_group grid = cg::this_grid();
    volatile LAS unsigned* bst = (volatile LAS unsigned*)(lds + LDS_BYTES - 64);
    if (threadIdx.x < 2) bst[threadIdx.x] = 0u;
    __syncthreads();
#ifdef PROBE_AT
    const unsigned long long t_start = __builtin_amdgcn_s_memrealtime();
#define PROBE(k) do { if ((k) == PROBE_AT) { const unsigned long long t_now = __builtin_amdgcn_s_memrealtime(), dt_ = t_now - t_start; while (__builtin_amdgcn_s_memrealtime() - t_now < dt_) __builtin_amdgcn_s_sleep(8); __syncthreads(); } } while (0)
#else
    const unsigned long long t_start = 0;
#define PROBE(k) do {} while (0)
#endif
    const XcdBarrier bar = xcd_barrier_post((unsigned*)(a.ws + WS_BAR), bst);
    const int G = gridDim.x;
#define NEWPHASE() int tid_ = threadIdx.x, cu_ = blockIdx.x; asm volatile("" : "+v"(tid_)); asm volatile("" : "+s"(cu_)); const int tid = tid_, cu = cu_; (void)tid; (void)cu;
    unsigned char* ws = a.ws;
    bf16_t* WALL = (bf16_t*)(ws + WS_WALL); bf16_t* XB = (bf16_t*)(ws + WS_XB); bf16_t* MEMB = (bf16_t*)(ws + WS_MEMB); bf16_t* WKV = (bf16_t*)(ws + WS_WKV);
    bf16_t* QKM = (bf16_t*)(ws + WS_QKM); bf16_t* HT = (bf16_t*)(ws + WS_HT); bf16_t* KMEM = (bf16_t*)(ws + WS_KMEM); bf16_t* VMT = (bf16_t*)(ws + WS_VMT);
    float2* KF = (float2*)(ws + WS_KF); bf16_t* MIX = (bf16_t*)(ws + WS_MIX); float2* STAT = (float2*)(ws + WS_STAT);
    bf16_t* X1B = (bf16_t*)(ws + WS_X1B); bf16_t* HH = (bf16_t*)(ws + WS_HH); bf16_t* ACT = (bf16_t*)(ws + WS_ACT);

    for (int rep = 0; rep < REP_P0; ++rep) { NEWPHASE(); if (PH(0)) p0_prep(a.in, ws, lds, tid, t_start); }
    if (a.ws == nullptr) grid.sync();
    xcd_barrier(bar);

    for (int rep = 0; rep < REP_G1; ++rep) if (PH(1)) { NEWPHASE(); pg8::Gemm g{(const bf16_t*)ws, (const bf16_t*)ws, 0, 0, DM}; P1Order S; S.init(G, cu);
      EpiP1 E{EpiRope{QKM, (const float2*)(ws + WS_ROPE)}, EpiB{HT, NT}, EpiB{KMEM, 512}, EpiB{VMT, NMT}};
      pg8::gemm_phase<EpiP1, P1Order, false, true>(lds, g, S, E); }
    if (PH(3)) { NEWPHASE(); __syncthreads();
      if (cu >= 64) for (int it = cu - 64; it < 1024; it += G - 64) filter_fft_item((const float*)(ws + WS_HTD), KF, lds, it, tid); }
    xcd_barrier(bar);

    { NEWPHASE(); const int xcd = cu & 7, j = cu >> 3;
      float lam;
      { const float* lp = a.in[12]; const int l6 = tid & 63; float s01 = lp[l6] * lp[64 + l6], s23 = lp[128 + l6] * lp[192 + l6];
        s01 = wave_allsum(s01, l6); s23 = wave_allsum(s23, l6);
        lam = expf(s01) - expf(s23) + 0.2f; }
      if (PH(6)) for (int i = 0; i < 2 * REP_HY; ++i) {
          const int cgp = ((i & 1) * 8 + xcd) * 4 + (j >> 3), bp = j & 7;
          hyena_item(HT, KF, a.in[3], a.in[4], a.in[11], MIX, lds, bp, cgp, tid); }
      if (PH(4)) for (int i = 0; i < 4 * REP_DIFF; ++i) {
          const int bh = ((i & 3) * 8 + xcd) * 2 + (j >> 4), qblk = j & 15, b = bh >> 2, hd = bh & 3;
          const size_t tok0 = (size_t)b * SEQ;
          attn_unit<2>(lds, QKM + (tok0 + qblk * 128) * MIXW + hd * 128, MIXW, QKM + tok0 * MIXW + 512 + hd * 128, MIXW,
                       HT + (size_t)(1536 + hd * 128) * NT + tok0, NT, SEQ, 0.125f * 1.4426950408889634f,
                       MIX + (tok0 + qblk * 128) * MIXW + 512 + hd * 128, MIXW, lam, a.in[13], tid); }
      if (PH(5)) for (int i = 0; i < 2 * REP_MEM; ++i) {
          const int bh = ((i & 1) * 8 + xcd) * 4 + (j >> 3), qblk = j & 7, b = bh >> 2, hd = bh & 3;
          const size_t tok0 = (size_t)b * SEQ;
          attn_unit<1>(lds, QKM + (tok0 + qblk * 256) * MIXW + 1024 + hd * 128, MIXW, KMEM + (size_t)b * MEMT * 512 + hd * 128, 512,
                       VMT + (size_t)(hd * 128) * NMT + b * MEMT, NMT, MEMT, 0.08838834764831845f * 1.4426950408889634f,
                       MIX + (tok0 + qblk * 256) * MIXW + 1024 + hd * 128, MIXW, 0.f, nullptr, tid); } }
    xcd_barrier(bar);

#ifdef REP_SYNC
    for (int rep = 0; rep < REP_SYNC; ++rep) xcd_barrier(bar);
#endif
    const bool pair = (G == 256);
    if (pair) {
        if (PH(7)) { NEWPHASE(); const int v = PairOrder::vcu_of(cu);
            pg8::Gemm g{MIX, (const bf16_t*)(ws + WS_WOUT), NT, DM, MIXW}; QuadTwo S{v >> 2, v & 3};
            EpiLn<1, G3_RB> E{a.in[0], XB, nullptr, X1B, a.in[16], a.in[17], (unsigned long long*)(ws + WS_XG), (unsigned*)(ws + WS_CNT), lds};
            pg8::gemm_phase<EpiLn<1, G3_RB>, QuadTwo, true, true>(lds, g, S, E); }
        xcd_barrier(bar);
    } else {
        { NEWPHASE(); pg8::Gemm g{MIX, (const bf16_t*)(ws + WS_WOUT), NT, DM, MIXW}; pg8::StaticOrder S; S.init(g.M, g.N, G, cu);
          EpiRes E{a.in[0], a.out, lds, 0};
          pg8::gemm_phase<EpiRes, pg8::StaticOrder, true, true>(lds, g, S, E); }
        xcd_barrier(bar);
        { NEWPHASE(); ln_rows<true>(a.out, X1B, STAT, a.in[16], a.in[17], tid); }
        xcd_barrier(bar);
    }
    for (int rep = 0; rep < REP_G4; ++rep) if (PH(9)) { NEWPHASE(); pg8::Gemm g{X1B, (const bf16_t*)(ws + WS_WUP), FFN_MT * 256, 2 * DFF, DM}; FfnOrder S; S.init(g.M, g.N, G, cu); S.cw = a.in[19]; S.cb = a.in[20]; S.lds = lds; S.cnt = 0;
      EpiFfn E{ACT, lds, 0};
      pg8::gemm_phase<EpiFfn, FfnOrder, true, true>(lds, g, S, E); }
    xcd_barrier(bar);
    if (pair) {
        if (PH(11)) { NEWPHASE(); const int v = PairOrder::vcu_of(cu);
            pg8::Gemm g{ACT, (const bf16_t*)(ws + WS_WDN), NT, DM, DFF}; QuadTwoKb S; S.q = v >> 2; S.j = v & 3;
            EpiLn<2, true> E{nullptr, X1B, a.out, nullptr, a.in[22], a.in[23], (unsigned long long*)(ws + WS_XG) + 128 * 4 * 256, (unsigned*)(ws + WS_CNT) + 128 * 16, lds};
            pg8::gemm_phase<EpiLn<2, true>, QuadTwoKb, true, true>(lds, g, S, E); }
    } else {
        { NEWPHASE(); pg8::Gemm g{ACT, (const bf16_t*)(ws + WS_WDN), NT, DM, DFF}; KbOrder S; S.init(g.M, g.N, G, cu);
          EpiRes2 E{a.out, a.out, STAT, a.in[16], a.in[17], lds, 0};
          pg8::gemm_phase<EpiRes2, KbOrder, true, true>(lds, g, S, E); }
        xcd_barrier(bar);
        { NEWPHASE(); ln_rows<false>(a.out, nullptr, nullptr, a.in[22], a.in[23], tid); }
    }
}

extern "C" void kernel_launch(void* const* d_in, const int* in_sizes, int n_in, void* d_out, int out_size, void* d_ws, size_t ws_size, hipStream_t stream) {
    static int grid = 0;
    if (grid == 0) {
        if (n_in != 24 || out_size != NT * DM || ws_size < WS_END) { fprintf(stderr, "kernel_launch: unexpected shapes (n_in %d, out %d, ws %zu)\n", n_in, out_size, ws_size); grid = -1; return; }
        int dev = 0, cus = 0, per_cu = 0;
        hipGetDevice(&dev); hipDeviceGetAttribute(&cus, hipDeviceAttributeMultiprocessorCount, dev);
        if (hipFuncSetAttribute((const void*)hybrid_fwd, hipFuncAttributeMaxDynamicSharedMemorySize, LDS_BYTES) != hipSuccess) { fprintf(stderr, "kernel_launch: hipFuncSetAttribute failed\n"); grid = -1; return; }
        if (hipOccupancyMaxActiveBlocksPerMultiprocessor(&per_cu, (const void*)hybrid_fwd, NTHR, LDS_BYTES) != hipSuccess || per_cu < 1) { fprintf(stderr, "kernel_launch: occupancy query says %d\n", per_cu); per_cu = 1; }
        (void)hipGetLastError();
        grid = cus * per_cu;
        fprintf(stderr, "kernel_launch: grid %d (cus %d x %d)\n", grid, cus, per_cu);
    }
    if (grid < 0) return;
    if (hipMemsetAsync((char*)d_ws + WS_BAR, 0, 32768, stream) != hipSuccess) { fprintf(stderr, "kernel_launch: memset failed\n"); return; }
    Args a{};
    for (int i = 0; i < 24; ++i) a.in[i] = (const float*)d_in[i];
    a.out = (float*)d_out; a.ws = (unsigned char*)d_ws;
    void* args[] = {&a};
    const hipError_t e = hipLaunchCooperativeKernel((const void*)hybrid_fwd, dim3(grid), dim3(NTHR), args, LDS_BYTES, stream);
    if (e != hipSuccess) fprintf(stderr, "kernel_launch: cooperative launch failed: %s (grid %d)\n", hipGetErrorString(e), grid);
}
```
